# Optimizing an MI355X kernel written in HIP

```python
import math
import jax
import jax.numpy as jnp
from jax import lax
import numpy as np

D_MODEL = 2048
BATCH = 4
SEQ = 2048
DEPTH = 2

HALF = D_MODEL // 2
MLA_NOPE = 128
MLA_ROPE = 64
MLA_V = 128
MLA_HEADS = HALF // MLA_V
MLA_Q_RANK = D_MODEL // 4
MLA_KV_RANK = D_MODEL // 4
LRU_WIDTH = HALF
LRU_BLOCKS = 8
LRU_CONV = 4
LRU_C = 8.0
RET_DK = 256
RET_DV = 256
RET_HEADS = HALF // RET_DV
RET_CHUNK = 128
SWA_HD = 128
SWA_HEADS = HALF // SWA_HD
SWA_KV_HEADS = 2
WINDOW = 128
REL_BUCKETS = 32
REL_MAX_DIST = 128
N_EXPERTS = 64
TOP_K = 8
N_GROUPS = 8
TOP_GROUPS = 4
EXPERT_FF = D_MODEL // 4
SHARED_FF = D_MODEL // 4
ROUTE_SCALE = 2.5
ROPE_THETA = 10000.0
EPS = 1e-6
Q_BLOCK = 128
AB_SIZES = (MLA_Q_RANK, MLA_KV_RANK, MLA_ROPE, LRU_WIDTH, LRU_WIDTH)
CD_SIZES = (RET_HEADS * RET_DK, RET_HEADS * RET_DK, RET_HEADS * RET_DV, RET_HEADS * RET_DV,
            SWA_HEADS * SWA_HD, SWA_KV_HEADS * SWA_HD, SWA_KV_HEADS * SWA_HD)

kernel_name = 'hybrid_mla_rglru_retention_swa_moe_encoder'


def rms_norm(x, g):
    xf = x.astype(jnp.float32)
    y = xf * lax.rsqrt(jnp.mean(xf * xf, axis=-1, keepdims=True) + EPS)
    return y.astype(x.dtype) * g


def modulate(x, g, shift, scale):
    return rms_norm(x, g) * (1 + scale) + shift


def split_cols(t, sizes):
    return jnp.split(t, np.cumsum(sizes)[:-1].tolist(), axis=-1)


def rope_tables(seq, dim):
    inv = ROPE_THETA ** (-jnp.arange(0, dim, 2, dtype=jnp.float32) / dim)
    ang = jnp.arange(seq, dtype=jnp.float32)[:, None] * inv[None, :]
    return jnp.cos(ang), jnp.sin(ang)


def apply_rope(x, cos, sin):
    x1, x2 = jnp.split(x, 2, axis=-1)
    cs = cos[:, None, :].astype(x.dtype)
    sn = sin[:, None, :].astype(x.dtype)
    return jnp.concatenate([x1 * cs - x2 * sn, x2 * cs + x1 * sn], axis=-1)


def t5_bucket(rel):
    half = REL_BUCKETS // 2
    max_exact = half // 2
    ret = (rel > 0).astype(jnp.int32) * half
    n = jnp.abs(rel)
    nf = jnp.maximum(n, 1).astype(jnp.float32)
    large = max_exact + (jnp.log(nf / max_exact) / math.log(REL_MAX_DIST / max_exact)
                         * (half - max_exact)).astype(jnp.int32)
    large = jnp.minimum(large, half - 1)
    return ret + jnp.where(n < max_exact, n, large)


def mla_mixer(q_lat, kv_lat, k_rope, q_norm, kv_norm, w_uq, w_ukv, cos, sin):
    B, S, _ = q_lat.shape
    H = MLA_HEADS
    q = (rms_norm(q_lat, q_norm) @ w_uq).reshape(B, S, H, MLA_NOPE + MLA_ROPE)
    q_nope = q[..., :MLA_NOPE]
    q_rope = apply_rope(q[..., MLA_NOPE:], cos, sin)
    kv = (rms_norm(kv_lat, kv_norm) @ w_ukv).reshape(B, S, H, MLA_NOPE + MLA_V)
    k_nope, v = kv[..., :MLA_NOPE], kv[..., MLA_NOPE:]
    k_rope = apply_rope(k_rope[:, :, None, :], cos, sin)[:, :, 0]
    scale = (MLA_NOPE + MLA_ROPE) ** -0.5
    nb = S // Q_BLOCK
    qn = q_nope.reshape(B, nb, Q_BLOCK, H, MLA_NOPE).transpose(1, 0, 2, 3, 4)
    qr = q_rope.reshape(B, nb, Q_BLOCK, H, MLA_ROPE).transpose(1, 0, 2, 3, 4)

    def block(args):
        qn_b, qr_b = args
        s = (jnp.einsum('bqhd,bkhd->bhqk', qn_b, k_nope, preferred_element_type=jnp.float32)
             + jnp.einsum('bqhr,bkr->bhqk', qr_b, k_rope, preferred_element_type=jnp.float32))
        p = jax.nn.softmax(s * scale, axis=-1).astype(v.dtype)
        return jnp.einsum('bhqk,bkhd->bqhd', p, v)

    o = lax.map(block, (qn, qr))
    return o.transpose(1, 0, 2, 3, 4).reshape(B, S, H * MLA_V)


def conv_centred(x, w, b):
    C = x.shape[-1]
    left = LRU_CONV // 2
    y = lax.conv_general_dilated(x, w[:, None, :].astype(x.dtype), window_strides=(1,),
                                 padding=[(left, LRU_CONV - 1 - left)],
                                 dimension_numbers=('NWC', 'WIO', 'NWC'),
                                 feature_group_count=C)
    return y + b


def rglru_scan(x, w_a, b_a, w_x, b_x, lam, reverse):
    B, S, C = x.shape
    xb = x.reshape(B, S, LRU_BLOCKS, C // LRU_BLOCKS)
    r = jax.nn.sigmoid(jnp.einsum('bsgi,gij->bsgj', xb, w_a).reshape(B, S, C) + b_a)
    i = jax.nn.sigmoid(jnp.einsum('bsgi,gij->bsgj', xb, w_x).reshape(B, S, C) + b_x)
    log_a = -LRU_C * r.astype(jnp.float32) * jax.nn.softplus(-lam.astype(jnp.float32))
    a = jnp.exp(log_a)
    u = jnp.sqrt(-jnp.expm1(2.0 * log_a)) * (i * x).astype(jnp.float32)

    def combine(left, right):
        a1, b1 = left
        a2, b2 = right
        return a1 * a2, a2 * b1 + b2

    _, h = lax.associative_scan(combine, (a, u), reverse=reverse, axis=1)
    return h.astype(x.dtype)


def retention_chunkwise(q, k, v, log_gamma, include_diag):
    B, S, H, dk = q.shape
    dv = v.shape[-1]
    C = RET_CHUNK
    nc = S // C
    pos = jnp.arange(C, dtype=jnp.float32)
    diff = pos[:, None] - pos[None, :]
    mask = (diff >= 0) if include_diag else (diff > 0)
    decay = jnp.where(mask[None], jnp.exp(log_gamma[:, None, None] * jnp.maximum(diff, 0.0)[None]), 0.0)
    xi = jnp.exp(log_gamma[None, :] * (pos[:, None] + 1.0))
    zeta = jnp.exp(log_gamma[None, :] * (C - 1.0 - pos[:, None]))
    gamma_c = jnp.exp(log_gamma * C)

    def to_chunks(t):
        return t.reshape(B, nc, C, H, t.shape[-1]).transpose(1, 0, 2, 3, 4)

    def step(R, inp):
        qi, ki, vi = inp
        qf, kf, vf = qi.astype(jnp.float32), ki.astype(jnp.float32), vi.astype(jnp.float32)
        s = jnp.einsum('bnhd,bmhd->bhnm', qf, kf) * decay
        inner = jnp.einsum('bhnm,bmhv->bnhv', s, vf)
        cross = jnp.einsum('bnhd,bhdv->bnhv', qf, R) * xi[None, :, :, None]
        R = gamma_c[None, :, None, None] * R + jnp.einsum('bmhd,bmhv->bhdv', kf * zeta[None, :, :, None], vf)
        return R, inner + cross

    R0 = jnp.zeros((B, H, dk, dv), jnp.float32)
    _, o = lax.scan(step, R0, (to_chunks(q), to_chunks(k), to_chunks(v)))
    return o.transpose(1, 0, 2, 3, 4).reshape(B, S, H, dv)


def retention_mixer(q, k, v, g, gn_gain, cos, sin):
    B, S, _ = q.shape
    H = RET_HEADS
    q = apply_rope(q.reshape(B, S, H, RET_DK), cos, sin)
    k = apply_rope(k.reshape(B, S, H, RET_DK), cos, sin) * (RET_DK ** -0.5)
    v = v.reshape(B, S, H, RET_DV)
    lg_fwd = jnp.log1p(-(2.0 ** (-5.0 - jnp.arange(H, dtype=jnp.float32))))
    lg_bwd = lg_fwd[::-1]
    fwd = retention_chunkwise(q, k, v, lg_fwd, True)
    bwd = jnp.flip(retention_chunkwise(jnp.flip(q, 1), jnp.flip(k, 1), jnp.flip(v, 1), lg_bwd, False), 1)
    y = rms_norm(fwd + bwd, gn_gain.astype(jnp.float32))
    return jax.nn.silu(g) * y.reshape(B, S, H * RET_DV).astype(g.dtype)


def swa_mixer(q, k, v, rel_table, sinks):
    B, S, _ = q.shape
    W = WINDOW
    nb = S // W
    KV = SWA_KV_HEADS
    G = SWA_HEADS // SWA_KV_HEADS
    qb = q.reshape(B, nb, W, KV, G, SWA_HD)

    def windows(t):
        tp = jnp.pad(t.reshape(B, S, KV, SWA_HD), ((0, 0), (W, W), (0, 0), (0, 0)))
        tp = tp.reshape(B, nb + 2, W, KV, SWA_HD)
        return jnp.concatenate([tp[:, :-2], tp[:, 1:-1], tp[:, 2:]], axis=2)

    kw, vw = windows(k), windows(v)
    s = jnp.einsum('bnqkgd,bnjkd->bnkgqj', qb, kw, preferred_element_type=jnp.float32) * (SWA_HD ** -0.5)
    qi = jnp.arange(W)[:, None]
    kj = jnp.arange(3 * W)[None, :]
    rel = kj - W - qi
    bias = rel_table[t5_bucket(rel)].astype(jnp.float32)
    bias = bias.transpose(2, 0, 1).reshape(KV, G, W, 3 * W)
    key_pos = jnp.arange(nb)[:, None] * W + kj - W
    valid = (jnp.abs(rel) <= W)[None] & ((key_pos >= 0) & (key_pos < S))[:, None, :]
    s = jnp.where(valid[None, :, None, None], s + bias, -jnp.inf)
    sink = jnp.broadcast_to(sinks.astype(jnp.float32).reshape(KV, G, 1, 1), s.shape[:-1] + (1,))
    p = jax.nn.softmax(jnp.concatenate([s, sink], axis=-1), axis=-1)[..., :-1].astype(v.dtype)
    o = jnp.einsum('bnkgqj,bnjkd->bnqkgd', p, vw)
    return o.reshape(B, S, SWA_HEADS * SWA_HD)


def moe(h, w_router, router_bias, w_gate, w_up, w_down, ws_gate, ws_up, ws_down):
    B, S, D = h.shape
    N = B * S
    E = N_EXPERTS
    t = h.reshape(N, D)
    scores = jax.nn.sigmoid(jnp.matmul(t, w_router, preferred_element_type=jnp.float32))
    biased = scores + router_bias.astype(jnp.float32)
    grp = biased.reshape(N, N_GROUPS, E // N_GROUPS)
    grp_score = lax.top_k(grp, 2)[0].sum(-1)
    _, gidx = lax.top_k(grp_score, TOP_GROUPS)
    gmask = jnp.sum(jax.nn.one_hot(gidx, N_GROUPS, dtype=jnp.float32), axis=1) > 0
    emask = jnp.repeat(gmask, E // N_GROUPS, axis=1)
    _, eidx = lax.top_k(jnp.where(emask, biased, -jnp.inf), TOP_K)
    w = jnp.take_along_axis(scores, eidx, axis=1)
    w = w / jnp.sum(w, axis=-1, keepdims=True) * ROUTE_SCALE
    gates = jnp.sum(jax.nn.one_hot(eidx, E, dtype=jnp.float32) * w[..., None], axis=1)

    def expert(acc, p):
        wg, wu, wd, ge = p
        a = jax.nn.silu(t @ wg) * (t @ wu)
        return acc + ge[:, None] * jnp.matmul(a, wd, preferred_element_type=jnp.float32), None

    y, _ = lax.scan(expert, jnp.zeros((N, D), jnp.float32), (w_gate, w_up, w_down, gates.T))
    shared = (jax.nn.silu(t @ ws_gate) * (t @ ws_up)) @ ws_down
    return (y.astype(h.dtype) + shared).reshape(B, S, D)


def setup_inputs(seed: int = 0) -> dict:
    key = jax.random.key(seed)
    keys = jax.random.split(key, 48)
    counter = [0]

    def nxt():
        k = keys[counter[0]]
        counter[0] += 1
        return k

    def nrm(shape, scale):
        return jax.random.normal(nxt(), shape, jnp.float32) * scale

    def gain(shape):
        return 1.0 + nrm(shape, 0.02)

    D = D_MODEL
    ne = (DEPTH + 1) // 2
    no = DEPTH // 2
    bs = LRU_WIDTH // LRU_BLOCKS
    x = nrm((BATCH, SEQ, D), 1.0)
    c = nrm((BATCH, D), 1.0)
    w_mod = nrm((DEPTH, D, 6 * D), 0.5 * D ** -0.5)
    b_mod = nrm((DEPTH, 6 * D), 0.01)
    norm_mix = gain((DEPTH, D))
    norm_ffn = gain((DEPTH, D))
    final_norm = gain((D,))
    w_in_ab = nrm((ne, D, sum(AB_SIZES)), D ** -0.5)
    q_lat_norm = gain((ne, MLA_Q_RANK))
    kv_lat_norm = gain((ne, MLA_KV_RANK))
    w_uq = nrm((ne, MLA_Q_RANK, MLA_HEADS * (MLA_NOPE + MLA_ROPE)), MLA_Q_RANK ** -0.5)
    w_ukv = nrm((ne, MLA_KV_RANK, MLA_HEADS * (MLA_NOPE + MLA_V)), MLA_KV_RANK ** -0.5)
    conv_w = nrm((ne, LRU_CONV, LRU_WIDTH), LRU_CONV ** -0.5)
    conv_b = nrm((ne, LRU_WIDTH), 0.01)
    lru_w_a = nrm((ne, 2, LRU_BLOCKS, bs, bs), bs ** -0.5)
    lru_b_a = nrm((ne, 2, LRU_WIDTH), 0.01)
    lru_w_x = nrm((ne, 2, LRU_BLOCKS, bs, bs), bs ** -0.5)
    lru_b_x = nrm((ne, 2, LRU_WIDTH), 0.01)
    u = jax.random.uniform(nxt(), (ne, 2, LRU_WIDTH), jnp.float32, 0.9, 0.999)
    a0 = u ** (1.0 / LRU_C)
    lru_lambda = jnp.log(a0) - jnp.log1p(-a0)
    w_out_ab = nrm((ne, MLA_HEADS * MLA_V + LRU_WIDTH, D), D ** -0.5)
    w_in_cd = nrm((no, D, sum(CD_SIZES)), D ** -0.5)
    ret_gn = gain((no, RET_HEADS, RET_DV))
    swa_sinks = nrm((no, SWA_HEADS), 1.0)
    w_out_cd = nrm((no, RET_HEADS * RET_DV + SWA_HEADS * SWA_HD, D), D ** -0.5)
    rel_bias = nrm((REL_BUCKETS, SWA_HEADS), 0.5)
    w_router = nrm((DEPTH, D, N_EXPERTS), D ** -0.5)
    router_bias = nrm((DEPTH, N_EXPERTS), 0.01)
    w_gate = nrm((DEPTH, N_EXPERTS, D, EXPERT_FF), D ** -0.5)
    w_up = nrm((DEPTH, N_EXPERTS, D, EXPERT_FF), D ** -0.5)
    w_down = nrm((DEPTH, N_EXPERTS, EXPERT_FF, D), EXPERT_FF ** -0.5)
    ws_gate = nrm((DEPTH, D, SHARED_FF), D ** -0.5)
    ws_up = nrm((DEPTH, D, SHARED_FF), D ** -0.5)
    ws_down = nrm((DEPTH, SHARED_FF, D), SHARED_FF ** -0.5)
    return {'x': x, 'c': c, 'w_mod': w_mod, 'b_mod': b_mod, 'norm_mix': norm_mix,
            'norm_ffn': norm_ffn, 'final_norm': final_norm, 'w_in_ab': w_in_ab,
            'q_lat_norm': q_lat_norm, 'kv_lat_norm': kv_lat_norm, 'w_uq': w_uq, 'w_ukv': w_ukv,
            'conv_w': conv_w, 'conv_b': conv_b, 'lru_w_a': lru_w_a, 'lru_b_a': lru_b_a,
            'lru_w_x': lru_w_x, 'lru_b_x': lru_b_x, 'lru_lambda': lru_lambda, 'w_out_ab': w_out_ab,
            'w_in_cd': w_in_cd, 'ret_gn': ret_gn, 'swa_sinks': swa_sinks, 'w_out_cd': w_out_cd,
            'rel_bias': rel_bias, 'w_router': w_router, 'router_bias': router_bias,
            'w_gate': w_gate, 'w_up': w_up, 'w_down': w_down,
            'ws_gate': ws_gate, 'ws_up': ws_up, 'ws_down': ws_down}


def reference(x, c, w_mod, b_mod, norm_mix, norm_ffn, final_norm, w_in_ab, q_lat_norm, kv_lat_norm,
              w_uq, w_ukv, conv_w, conv_b, lru_w_a, lru_b_a, lru_w_x, lru_b_x, lru_lambda, w_out_ab,
              w_in_cd, ret_gn, swa_sinks, w_out_cd, rel_bias, w_router, router_bias,
              w_gate, w_up, w_down, ws_gate, ws_up, ws_down):
    B, S, D = x.shape
    cos_r, sin_r = rope_tables(S, MLA_ROPE)
    cos_t, sin_t = rope_tables(S, RET_DK)
    c_act = jax.nn.silu(c)
    for layer in range(DEPTH):
        mod = c_act @ w_mod[layer] + b_mod[layer]
        sh_m, sc_m, g_m, sh_f, sc_f, g_f = [m[:, None, :] for m in jnp.split(mod, 6, axis=-1)]
        hm = modulate(x, norm_mix[layer], sh_m, sc_m)
        if layer % 2 == 0:
            i = layer // 2
            q_lat, kv_lat, k_rope, lru_x, lru_gate = split_cols(hm @ w_in_ab[i], AB_SIZES)
            a_out = mla_mixer(q_lat, kv_lat, k_rope, q_lat_norm[i], kv_lat_norm[i],
                              w_uq[i], w_ukv[i], cos_r, sin_r)
            xc = conv_centred(lru_x, conv_w[i], conv_b[i])
            h_lru = (rglru_scan(xc, lru_w_a[i, 0], lru_b_a[i, 0], lru_w_x[i, 0], lru_b_x[i, 0], lru_lambda[i, 0], False)
                     + rglru_scan(xc, lru_w_a[i, 1], lru_b_a[i, 1], lru_w_x[i, 1], lru_b_x[i, 1], lru_lambda[i, 1], True))
            b_out = jax.nn.gelu(lru_gate) * h_lru
            mixed = jnp.concatenate([a_out, b_out], axis=-1) @ w_out_ab[i]
        else:
            i = layer // 2
            rq, rk, rv, rg, sq, sk, sv = split_cols(hm @ w_in_cd[i], CD_SIZES)
            c_out = retention_mixer(rq, rk, rv, rg, ret_gn[i], cos_t, sin_t)
            d_out = swa_mixer(sq, sk, sv, rel_bias, swa_sinks[i])
            mixed = jnp.concatenate([c_out, d_out], axis=-1) @ w_out_cd[i]
        x = x + g_m * mixed
        hf = modulate(x, norm_ffn[layer], sh_f, sc_f)
        x = x + g_f * moe(hf, w_router[layer], router_bias[layer], w_gate[layer], w_up[layer],
                          w_down[layer], ws_gate[layer], ws_up[layer], ws_down[layer])
    return rms_norm(x, final_norm)
```

```cpp
#define OPT_MASK ((1u<<N_PHASES)-1u)
#define HAVE_THIN 1
#define HAVE_SKINNY 1
#define HAVE_RT 1
#define HAVE_ATT0 1
#define HAVE_RET1 1
#define HAVE_SWA1 1
#define MOE_FP8 1
#define SPREAD_CONV 1
#ifdef HOST_TEST
#include <cmath>
#include <cstring>
#include <cstdio>
#include <cstdint>
#include <cstring>
#include <cstddef>
#define HD inline
#else
#include <hip/hip_runtime.h>
#include <cstdio>
#include <cstdint>
#include <cstring>
#define HD __host__ __device__ __forceinline__
#endif

namespace cfg {
#ifdef HOST_TEST
constexpr int D = 256, NB = 2, S = 256, H_A = 4, NOPE = 16, ROPE = 16, VD = 32, QR = 64, KVR = 64, LW = 128, LBS = 16, H_C = 4, DK = 32, H_D = 8, KVH = 2, HDS = 16, WIN = 64, FF = 32;
#else
constexpr int D = 2048, NB = 4, S = 2048, H_A = 8, NOPE = 128, ROPE = 64, VD = 128, QR = 512, KVR = 512, LW = 1024, LBS = 128, H_C = 4, DK = 256, H_D = 8, KVH = 2, HDS = 128, WIN = 128, FF = 512;
#endif
constexpr int M = NB * S, QK = NOPE + ROPE, E = 64, TOPK = 8, NG = 8, TG = 4;
constexpr int AB_N = QR + KVR + ROPE + 2 * LW, P0_N = QR + KVR + 2 * LW;
constexpr int CD_N = 4 * H_C * DK + H_D * HDS + 2 * KVH * HDS;
constexpr int HALF = D / 2;
constexpr int RT = 256;
constexpr int MAXT = (M * TOPK) / RT + E + M / RT;
constexpr float EPS = 1e-6f, LOG2E = 1.4426950408889634f;
static_assert(H_A * VD == HALF && LW == HALF && H_C * DK == HALF && H_D * HDS == HALF, "half widths");
}
using namespace cfg;

enum { I_X = 0, I_C, I_WMOD, I_BMOD, I_NMIX, I_NFFN, I_FNORM, I_WINAB, I_QLN, I_KVLN, I_WUQ, I_WUKV, I_CONVW, I_CONVB, I_LWA, I_LBA, I_LWX, I_LBX, I_LLAM, I_WOUTAB,
       I_WINCD, I_RETGN, I_SINKS, I_WOUTCD, I_RELB, I_WROUTER, I_RBIAS, I_WGATE, I_WUP, I_WDOWN, I_WSG, I_WSU, I_WSD, N_IN };

typedef unsigned short bf16_t;
HD float bf2f(bf16_t v) { unsigned u = (unsigned)v << 16; float f; __builtin_memcpy(&f, &u, 4); return f; }
HD bf16_t f2bf(float f) { unsigned u; __builtin_memcpy(&u, &f, 4); u += 0x7fffu + ((u >> 16) & 1u); return (bf16_t)(u >> 16); }
HD float sigm(float x) { return 1.0f / (1.0f + expf(-x)); }
HD float siluf(float x) { return x * sigm(x); }
HD float gelu_tanh(float x) { return 0.5f * x * (1.0f + tanhf(0.7978845608028654f * (x + 0.044715f * x * x * x))); }
HD int cnt_idx(int l, int e) { return (l * E + e) * 64; }
HD float ssq8(const float* p) { return ((p[0] + p[1]) + (p[2] + p[3])) + ((p[4] + p[5]) + (p[6] + p[7])); }
HD int t5_bucket(int rel) {
    const int n = rel < 0 ? -rel : rel; const int ret = rel > 0 ? 16 : 0;
    if (n < 8) return ret + n;
    return ret + 8 + (n >= 12) + (n >= 16) + (n >= 23) + (n >= 32) + (n >= 46) + (n >= 64) + (n >= 91);
}

constexpr size_t al(size_t x) { return (x + 4095) & ~size_t(4095); }
constexpr size_t WS_CTL = 0, CTL_BYTES = 1u << 20;
constexpr size_t CTL_CNT = 65536;
constexpr size_t CTL_SSQ = 131072;
constexpr size_t WS_MOD = CTL_BYTES;
constexpr size_t WS_TAB = WS_MOD + al((size_t)2 * NB * 6 * D * 4);
constexpr size_t TAB_CR = 0, TAB_SR = (size_t)S * (ROPE / 2) * 4, TAB_CT = 2 * TAB_SR, TAB_ST = TAB_CT + (size_t)S * (DK / 2) * 4;
constexpr size_t WS_RSTD = WS_TAB + al(TAB_ST + (size_t)S * (DK / 2) * 4);
constexpr size_t WS_SELE = WS_RSTD + al((size_t)M * 4);
constexpr size_t WS_SELR = WS_SELE + al((size_t)M * 8 * 4);
constexpr size_t WS_SELW = WS_SELR + al((size_t)M * 8 * 4);
constexpr size_t WS_TOK = WS_SELW + al((size_t)M * 8 * 4);
constexpr size_t WS_WT = WS_TOK + al((size_t)E * M * 4);
constexpr size_t WS_OFFT = WS_WT + al((size_t)E * M * 4);
constexpr size_t WS_HM = WS_OFFT + 4096;
constexpr size_t WS_HM8 = WS_HM + al((size_t)M * D * 2);
constexpr size_t WS_MIX = WS_HM8 + al((size_t)M * D);
constexpr size_t WS_X1 = WS_MIX + al((size_t)M * D * 2);
constexpr size_t WS_X2 = WS_X1 + al((size_t)M * D * 4);
constexpr size_t WS_PROJ = WS_X2 + al((size_t)M * D * 4);
constexpr size_t WS_L0 = WS_PROJ + al((size_t)M * (P0_N > CD_N ? P0_N : CD_N) * 2);
constexpr size_t WS_Q = WS_L0;
constexpr size_t WS_KC = WS_Q + al((size_t)M * H_A * QK * 2);
constexpr size_t WS_V = WS_KC + al((size_t)M * H_A * QK * 2);
constexpr size_t WS_XC = WS_V + al((size_t)M * H_A * VD * 2);
constexpr size_t WS_LA = WS_XC + al((size_t)M * LW * 2);
constexpr size_t WS_U = WS_LA + al((size_t)2 * M * LW * 2);
constexpr size_t WS_HF = WS_U + al((size_t)2 * M * LW * 2);
constexpr size_t WS_LXP = WS_HF + al((size_t)M * LW * 4);
constexpr size_t WS_RET = WS_L0;
constexpr size_t WS_ACT = WS_LXP + al((size_t)NB * (S + 4) * LW * 2);
constexpr size_t WS_Y = WS_ACT + al((size_t)MAXT * RT * FF * 2);
constexpr size_t WS_T = WS_Y;
constexpr size_t WS_SC = WS_T + al((size_t)M * CD_N * 4);
static_assert(WS_SC + (size_t)8 * S * S * 4 <= WS_Y + (size_t)MAXT * RT * D * 2, "naive temps fit in the Y region");
constexpr size_t WS_W = WS_Y + al((size_t)MAXT * RT * D * 2);
constexpr size_t W_INAB = WS_W;
constexpr size_t W_UQ = W_INAB + al((size_t)AB_N * D * 2);
constexpr size_t W_UKV = W_UQ + al((size_t)H_A * QK * QR * 2);
constexpr size_t W_LRU = W_UKV + al((size_t)H_A * (NOPE + VD) * KVR * 2);
constexpr size_t W_OUTAB = W_LRU + al((size_t)2 * (LW / LBS) * 2 * LBS * 4 * LBS * 2);
constexpr size_t W_INCD = W_OUTAB + al((size_t)D * D * 2);
constexpr size_t W_OUTCD = W_INCD + al((size_t)CD_N * D * 2);
constexpr size_t W_RT = W_OUTCD + al((size_t)D * D * 2);
constexpr size_t W_GU = W_RT + al((size_t)2 * E * D * 2);
constexpr size_t W_DN = W_GU + al((size_t)2 * (E + 1) * 2 * FF * D * 2);
constexpr size_t W_GB = W_DN + al((size_t)2 * (E + 1) * D * FF * 2);
constexpr size_t WS_END = W_GB + al((size_t)6 * LW * 4);

struct Ctx { const float* in[N_IN]; float* out; unsigned char* ws; };
#define WSP(T, off) ((T*)(c.ws + (off)))
HD long lru_idx(int d, int b, int t, int ch) { return ((((long)d * NB + b) * (LW / 8) + ch / 8) * S + t) * 8 + (ch % 8); }
HD int atomic_inc(int* p) {
#ifdef HOST_TEST
    return (*p)++;
#else
#if defined(__HIP_DEVICE_COMPILE__)
    return atomicAdd(p, 1);
#else
    return (*p)++;
#endif
#endif
}

struct NGemm {
    const void* A; const void* B; void* C; const float* ks;
    long a_rs, a_ks, a_z1, a_z2, b_ks, b_ns, b_z1, b_z2, c_rs, c_z1, c_z2;
    long Mr, N, K, Z2, a_bf, b_bf, c_bf;
    HD float la(long i) const { return a_bf ? bf2f(((const bf16_t*)A)[i]) : ((const float*)A)[i]; }
    HD float lb(long i) const { return b_bf ? bf2f(((const bf16_t*)B)[i]) : ((const float*)B)[i]; }
    HD void operator()(long i) const {
        const long n4c = N / 4, m4c = Mr / 4;
        const long n0 = (i % n4c) * 4; const long r = i / n4c; const long m0 = (r % m4c) * 4; const long z = r / m4c; const long z1 = z / Z2, z2 = z % Z2;
        const long ab = z1 * a_z1 + z2 * a_z2, bb = z1 * b_z1 + z2 * b_z2, cb = z1 * c_z1 + z2 * c_z2;
        float acc[4][4];
#pragma unroll
        for (int x = 0; x < 4; ++x)
#pragma unroll
            for (int y = 0; y < 4; ++y) acc[x][y] = 0.f;
        for (long k = 0; k < K; ++k) {
            const float s = ks ? ks[k] : 1.0f;
            float av[4], bv[4];
#pragma unroll
            for (int x = 0; x < 4; ++x) av[x] = la(ab + (m0 + x) * a_rs + k * a_ks) * s;
#pragma unroll
            for (int y = 0; y < 4; ++y) bv[y] = lb(bb + k * b_ks + (n0 + y) * b_ns);
#pragma unroll
            for (int x = 0; x < 4; ++x)
#pragma unroll
                for (int y = 0; y < 4; ++y) acc[x][y] += av[x] * bv[y];
        }
#pragma unroll
        for (int x = 0; x < 4; ++x)
#pragma unroll
            for (int y = 0; y < 4; ++y) { const long ci = cb + (m0 + x) * c_rs + n0 + y; if (c_bf) ((bf16_t*)C)[ci] = f2bf(acc[x][y]); else ((float*)C)[ci] = acc[x][y]; }
    }
    long count(long Z) const { return Z * (Mr / 4) * (N / 4); }
};

struct ModF { Ctx c;
    HD void operator()(long i) const { const long n4c = 6 * D / 4; const long n = (i % n4c) * 4; const long r = i / n4c; const int b = (int)(r % NB), l = (int)(r / NB);
        float a0 = c.in[I_BMOD][l * 6 * D + n], a1 = c.in[I_BMOD][l * 6 * D + n + 1], a2 = c.in[I_BMOD][l * 6 * D + n + 2], a3 = c.in[I_BMOD][l * 6 * D + n + 3];
        const float* w = c.in[I_WMOD] + (size_t)l * D * 6 * D + n;
        for (int k = 0; k < D; ++k) { const float ca = siluf(c.in[I_C][b * D + k]); const float* wr = w + (size_t)k * 6 * D; a0 += ca * wr[0]; a1 += ca * wr[1]; a2 += ca * wr[2]; a3 += ca * wr[3]; }
        float* o = WSP(float, WS_MOD) + ((size_t)l * NB + b) * 6 * D + n; o[0] = a0; o[1] = a1; o[2] = a2; o[3] = a3; }
    long count() const { return (long)2 * NB * 6 * D / 4; } };
struct TabF { Ctx c;
    HD void operator()(long i) const { const int W = ROPE / 2 + DK / 2; const int t = (int)(i / W), j = (int)(i % W);
        if (j < ROPE / 2) { const double inv = pow(10000.0, -2.0 * j / ROPE), a = t * inv; WSP(float, WS_TAB + TAB_CR)[t * (ROPE / 2) + j] = (float)cos(a); WSP(float, WS_TAB + TAB_SR)[t * (ROPE / 2) + j] = (float)sin(a); }
        else { const int jj = j - ROPE / 2; const double inv = pow(10000.0, -2.0 * jj / DK), a = t * inv; WSP(float, WS_TAB + TAB_CT)[t * (DK / 2) + jj] = (float)cos(a); WSP(float, WS_TAB + TAB_ST)[t * (DK / 2) + jj] = (float)sin(a); } }
    long count() const { return (long)S * (ROPE / 2 + DK / 2); } };
struct RowSSF { Ctx c; const float* X; float* out; long rs, ncols, rows, os;
    HD void operator()(long i) const { const float* x = X + i * rs; float s = 0.f; for (long j = 0; j < ncols; ++j) s += x[j] * x[j]; out[i * os] = s; }
    long count() const { return rows; } };
struct ModulateF { Ctx c; const float* X; const float* gain; const float* sc; const float* sh;
    HD void operator()(long i) const { const long m = i / D, j = i % D; const int b = (int)(m / S); const float r = 1.0f / sqrtf(WSP(float, WS_RSTD)[m] / D + EPS);
        WSP(bf16_t, WS_HM)[i] = f2bf(X[i] * r * gain[j] * (1.0f + sc[(size_t)b * 6 * D + j]) + sh[(size_t)b * 6 * D + j]); }
    long count() const { return (long)M * D; } };
struct FinalF { Ctx c; const float* X;
    HD void operator()(long i) const { const long m = i / D, j = i % D; const float r = 1.0f / sqrtf(WSP(float, WS_RSTD)[m] / D + EPS); c.out[i] = X[i] * r * c.in[I_FNORM][j]; }
    long count() const { return (long)M * D; } };
struct PostG1F { Ctx c;
    HD void operator()(long i) const { const long m = i / AB_N; const int col = (int)(i % AB_N); const float v = WSP(float, WS_T)[i]; bf16_t* P = WSP(bf16_t, WS_PROJ) + m * P0_N;
        if (col < QR + KVR) P[col] = f2bf(v);
        else if (col < QR + KVR + ROPE) {}
        else if (col < QR + KVR + ROPE + LW) { P[col - ROPE] = f2bf(v); const long b = m / S, t = m % S; WSP(bf16_t, WS_LXP)[(b * (S + 4) + 2 + t) * LW + col - (QR + KVR + ROPE)] = f2bf(v); }
        else P[col - ROPE] = f2bf(gelu_tanh(v)); }
    long count() const { return (long)M * AB_N; } };
struct KRopeF { Ctx c;
    HD void operator()(long i) const { const long m = i / (ROPE / 2); const int ii = (int)(i % (ROPE / 2)); const int t = (int)(m % S); const float* T = WSP(float, WS_T) + m * AB_N + QR + KVR;
        const float x1 = T[ii], x2 = T[ROPE / 2 + ii], cs = WSP(float, WS_TAB + TAB_CR)[t * (ROPE / 2) + ii], sn = WSP(float, WS_TAB + TAB_SR)[t * (ROPE / 2) + ii];
        const bf16_t o1 = f2bf(x1 * cs - x2 * sn), o2 = f2bf(x2 * cs + x1 * sn);
        for (int h = 0; h < H_A; ++h) { bf16_t* K = WSP(bf16_t, WS_KC) + (m * H_A + h) * QK + NOPE; K[ii] = o1; K[ROPE / 2 + ii] = o2; } }
    long count() const { return (long)M * (ROPE / 2); } };
struct PostQF { Ctx c; float qs;
    HD void operator()(long i) const { const long m = i / (H_A * QK); const int r = (int)(i % (H_A * QK)), h = r / QK, j = r % QK; const int t = (int)(m % S);
        const float rstd = 1.0f / sqrtf(ssq8(WSP(float, CTL_SSQ) + m * 16) / QR + EPS) * qs; const float* T = WSP(float, WS_T) + m * (H_A * QK) + h * QK; bf16_t* Q = WSP(bf16_t, WS_Q) + (m * H_A + h) * QK;
        if (j < NOPE) Q[j] = f2bf(T[j] * rstd);
        else if (j < NOPE + ROPE / 2) { const int ii = j - NOPE; const float x1 = T[NOPE + ii] * rstd, x2 = T[NOPE + ROPE / 2 + ii] * rstd, cs = WSP(float, WS_TAB + TAB_CR)[t * (ROPE / 2) + ii], sn = WSP(float, WS_TAB + TAB_SR)[t * (ROPE / 2) + ii];
            Q[NOPE + ii] = f2bf(x1 * cs - x2 * sn); Q[NOPE + ROPE / 2 + ii] = f2bf(x2 * cs + x1 * sn); } }
    long count() const { return (long)M * H_A * QK; } };
struct PostKVF { Ctx c;
    HD void operator()(long i) const { const int W = NOPE + VD; const long m = i / (H_A * W); const int r = (int)(i % (H_A * W)), h = r / W, j = r % W;
        const float rstd = 1.0f / sqrtf(ssq8(WSP(float, CTL_SSQ) + m * 16 + 8) / KVR + EPS); const float v = WSP(float, WS_T)[i] * rstd;
        if (j < NOPE) WSP(bf16_t, WS_KC)[(m * H_A + h) * QK + j] = f2bf(v); else WSP(bf16_t, WS_V)[(m * H_A + h) * VD + j - NOPE] = f2bf(v); }
    long count() const { return (long)M * H_A * (NOPE + VD); } };
struct ConvF { Ctx c;
    HD void operator()(long i) const { const long m = i / LW; const int ch = (int)(i % LW); const int t = (int)(m % S); float a = c.in[I_CONVB][ch];
        for (int j = 0; j < 4; ++j) { const int tt = t + j - 2; if (tt >= 0 && tt < S) a += c.in[I_CONVW][j * LW + ch] * bf2f(WSP(bf16_t, WS_PROJ)[(m + j - 2) * P0_N + QR + KVR + ch]); }
        WSP(bf16_t, WS_XC)[i] = f2bf(a); }
    long count() const { return (long)M * LW; } };
struct GatesF { Ctx c;
    HD void operator()(long i) const { const int ch = (int)(i % LW); const long r = i / LW; const long m = r % M; const int d = (int)(r / M); const int g = ch / LBS, j = ch % LBS; const int b = (int)(m / S), t = (int)(m % S);
        const bf16_t* xr = WSP(bf16_t, WS_XC) + m * LW + g * LBS; const float* wa = c.in[I_LWA] + ((size_t)(d * (LW / LBS) + g) * LBS) * LBS + j; const float* wx = c.in[I_LWX] + ((size_t)(d * (LW / LBS) + g) * LBS) * LBS + j;
        float za = c.in[I_LBA][d * LW + ch], zx = c.in[I_LBX][d * LW + ch];
        for (int k = 0; k < LBS; ++k) { const float x = bf2f(xr[k]); za += x * wa[(size_t)k * LBS]; zx += x * wx[(size_t)k * LBS]; }
        const float lam = c.in[I_LLAM][d * LW + ch]; const float sp = log1pf(expf(-lam));
        const float la = -8.0f * sigm(za) * sp; const float u = sqrtf(-expm1f(2.0f * la)) * (sigm(zx) * bf2f(WSP(bf16_t, WS_XC)[m * LW + ch]));
        const long o = lru_idx(d, b, t, ch); WSP(bf16_t, WS_LA)[o] = f2bf(la); WSP(bf16_t, WS_U)[o] = f2bf(u); }
    long count() const { return (long)2 * M * LW; } };
struct ScanF { Ctx c;
    HD void operator()(long i) const { const int b = (int)(i / LW), ch = (int)(i % LW); float h = 0.f;
        for (int t = 0; t < S; ++t) { const long o = lru_idx(0, b, t, ch); h = expf(bf2f(WSP(bf16_t, WS_LA)[o])) * h + bf2f(WSP(bf16_t, WS_U)[o]); WSP(float, WS_HF)[((long)b * S + t) * LW + ch] = h; }
        h = 0.f;
        for (int t = S - 1; t >= 0; --t) { const long o = lru_idx(1, b, t, ch); h = expf(bf2f(WSP(bf16_t, WS_LA)[o])) * h + bf2f(WSP(bf16_t, WS_U)[o]); const long m = (long)b * S + t;
            WSP(bf16_t, WS_MIX)[m * D + HALF + ch] = f2bf((WSP(float, WS_HF)[m * LW + ch] + h) * bf2f(WSP(bf16_t, WS_PROJ)[m * P0_N + QR + KVR + LW + ch])); } }
    long count() const { return (long)NB * LW; } };
struct SoftmaxF { Ctx c; long rows;
    HD void operator()(long i) const { float* r = WSP(float, WS_SC) + i * S; float mx = -INFINITY; for (int k = 0; k < S; ++k) mx = fmaxf(mx, r[k]); float s = 0.f; for (int k = 0; k < S; ++k) { const float p = exp2f(r[k] - mx); r[k] = p; s += p; }
        const float inv = 1.0f / s; for (int k = 0; k < S; ++k) r[k] *= inv; }
    long count() const { return rows; } };
struct OutPostF { Ctx c; const float* Xin; float* Xout; long l;
    HD void operator()(long i) const { const long m = i / D, n = i % D; const int b = (int)(m / S); Xout[i] = Xin[i] + WSP(float, WS_MOD)[((size_t)l * NB + b) * 6 * D + 2 * D + n] * WSP(float, WS_T)[i]; }
    long count() const { return (long)M * D; } };
struct RouteF { Ctx c; long l;
    HD float bz(const float* lg, const float* bias, int e) const { return sigm(lg[e]) + bias[e]; }
    HD void operator()(long m) const { const float* lg = WSP(float, WS_T) + m * E; const float* bias = c.in[I_RBIAS] + l * E;
        unsigned gmask = 0u;
        for (int it = 0; it < TG; ++it) { float best = -INFINITY; int bi = 0;
            for (int g = 0; g < NG; ++g) if (!((gmask >> g) & 1u)) { float m1 = -INFINITY, m2 = -INFINITY; for (int j = 0; j < E / NG; ++j) { const float v = bz(lg, bias, g * (E / NG) + j); if (v > m1) { m2 = m1; m1 = v; } else if (v > m2) m2 = v; }
                const float sc = m1 + m2; if (sc > best) { best = sc; bi = g; } }
            gmask |= 1u << bi; }
        unsigned long long taken = 0ull; float wsum = 0.f; int* se = WSP(int, WS_SELE) + m * TOPK; float* sw = WSP(float, WS_SELW) + m * TOPK; int* sr = WSP(int, WS_SELR) + m * TOPK;
        for (int k = 0; k < TOPK; ++k) { float best = -INFINITY; int bi = 0;
            for (int e = 0; e < E; ++e) if (((gmask >> (e / (E / NG))) & 1u) && !((taken >> e) & 1ull)) { const float v = bz(lg, bias, e); if (v > best) { best = v; bi = e; } }
            taken |= 1ull << bi; const float s = sigm(lg[bi]); se[k] = bi; sw[k] = s; wsum += s; }
        int* cnt = WSP(int, CTL_CNT);
        for (int k = 0; k < TOPK; ++k) { const int e = se[k]; const float w = sw[k] / wsum * 2.5f; const int rank = atomic_inc(cnt + cnt_idx((int)l, e)); sr[k] = rank; sw[k] = w;
            WSP(int, WS_TOK)[(size_t)e * M + rank] = (int)m; WSP(float, WS_WT)[(size_t)e * M + rank] = w; } }
    long count() const { return M; } };
struct OffF { Ctx c; long l;
    HD void operator()(long) const { int* o = WSP(int, WS_OFFT); const int* cnt = WSP(int, CTL_CNT); o[0] = 0; for (int e = 0; e <= E; ++e) { const int n = e < E ? cnt[cnt_idx((int)l, e)] : M; o[e + 1] = o[e] + (n + RT - 1) / RT; } }
    long count() const { return 1; } };
struct Moe1F { Ctx c; long l;
    HD void operator()(long i) const { const long f4c = FF / 4; const int f = (int)(i % f4c) * 4; const long r = i / f4c; const int rank = (int)(r % M), e = (int)(r / M);
        const int n = e < E ? WSP(int, CTL_CNT)[cnt_idx((int)l, e)] : M; if (rank >= n) return;
        const int tok = e < E ? WSP(int, WS_TOK)[(size_t)e * M + rank] : rank; const long row = (long)WSP(int, WS_OFFT)[e] * RT + rank;
        const float* wg = (e < E ? c.in[I_WGATE] + ((size_t)l * E + e) * D * FF : c.in[I_WSG] + (size_t)l * D * FF) + f;
        const float* wu = (e < E ? c.in[I_WUP] + ((size_t)l * E + e) * D * FF : c.in[I_WSU] + (size_t)l * D * FF) + f;
        const bf16_t* h = WSP(bf16_t, WS_HM) + (size_t)tok * D; float g0 = 0, g1 = 0, g2 = 0, g3 = 0, u0 = 0, u1 = 0, u2 = 0, u3 = 0;
        for (int k = 0; k < D; ++k) { const float a = bf2f(h[k]); const float* pg = wg + (size_t)k * FF; const float* pu = wu + (size_t)k * FF;
            g0 += a * pg[0]; g1 += a * pg[1]; g2 += a * pg[2]; g3 += a * pg[3]; u0 += a * pu[0]; u1 += a * pu[1]; u2 += a * pu[2]; u3 += a * pu[3]; }
        bf16_t* o = WSP(bf16_t, WS_ACT) + row * FF + f; o[0] = f2bf(siluf(g0) * u0); o[1] = f2bf(siluf(g1) * u1); o[2] = f2bf(siluf(g2) * u2); o[3] = f2bf(siluf(g3) * u3); }
    long count() const { return (long)(E + 1) * M * (FF / 4); } };
struct Moe2F { Ctx c; long l;
    HD void operator()(long i) const { const long d4c = D / 4; const int d = (int)(i % d4c) * 4; const long r = i / d4c; const int rank = (int)(r % M), e = (int)(r / M);
        const int n = e < E ? WSP(int, CTL_CNT)[cnt_idx((int)l, e)] : M; if (rank >= n) return;
        const long row = (long)WSP(int, WS_OFFT)[e] * RT + rank; const float wt = e < E ? WSP(float, WS_WT)[(size_t)e * M + rank] : 1.0f;
        const float* wd = (e < E ? c.in[I_WDOWN] + ((size_t)l * E + e) * FF * D : c.in[I_WSD] + (size_t)l * FF * D) + d;
        const bf16_t* a = WSP(bf16_t, WS_ACT) + row * FF; float y0 = 0, y1 = 0, y2 = 0, y3 = 0;
        for (int f = 0; f < FF; ++f) { const float v = bf2f(a[f]); const float* p = wd + (size_t)f * D; y0 += v * p[0]; y1 += v * p[1]; y2 += v * p[2]; y3 += v * p[3]; }
        bf16_t* o = WSP(bf16_t, WS_Y) + row * D + d; o[0] = f2bf(wt * y0); o[1] = f2bf(wt * y1); o[2] = f2bf(wt * y2); o[3] = f2bf(wt * y3); }
    long count() const { return (long)(E + 1) * M * (D / 4); } };
struct CombineF { Ctx c; const float* Xin; float* Xout; long l;
    HD void operator()(long i) const { const long m = i / D, n = i % D; const int b = (int)(m / S); const int* offt = WSP(int, WS_OFFT); const bf16_t* Y = WSP(bf16_t, WS_Y); float v = 0.f;
        for (int k = 0; k < TOPK; ++k) { const int e = WSP(int, WS_SELE)[m * TOPK + k], r = WSP(int, WS_SELR)[m * TOPK + k]; v += bf2f(Y[((size_t)offt[e] * RT + r) * D + n]); }
        v += bf2f(Y[((size_t)offt[E] * RT + m) * D + n]);
        Xout[i] = Xin[i] + WSP(float, WS_MOD)[((size_t)l * NB + b) * 6 * D + 5 * D + n] * v; }
    long count() const { return (long)M * D; } };
struct PostG3F { Ctx c; float sqs;
    HD void operator()(long i) const { const long m = i / CD_N; const int col = (int)(i % CD_N); const int t = (int)(m % S); const float* T = WSP(float, WS_T) + m * CD_N; bf16_t* P = WSP(bf16_t, WS_PROJ) + m * CD_N; const int W = H_C * DK;
        if (col < 2 * W) { const int j = col % DK; if (j < DK / 2) { const float sc = col < W ? 1.0f : 1.0f / sqrtf((float)DK); const float x1 = T[col], x2 = T[col + DK / 2], cs = WSP(float, WS_TAB + TAB_CT)[t * (DK / 2) + j], sn = WSP(float, WS_TAB + TAB_ST)[t * (DK / 2) + j];
                P[col] = f2bf((x1 * cs - x2 * sn) * sc); P[col + DK / 2] = f2bf((x2 * cs + x1 * sn) * sc); } }
        else if (col < 3 * W) P[col] = f2bf(T[col]);
        else if (col < 4 * W) P[col] = f2bf(siluf(T[col]));
        else if (col < 4 * W + H_D * HDS) P[col] = f2bf(T[col] * sqs);
        else P[col] = f2bf(T[col]); }
    long count() const { return (long)M * CD_N; } };
struct DecayF { Ctx c;
    HD void operator()(long i) const { const int mm = (int)(i % S); const long r = i / S; const int n = (int)(r % S), h = (int)(r / S);
        const float lgf = log1pf(-exp2f(-5.0f - h)), lgb = log1pf(-exp2f(-5.0f - (H_C - 1 - h)));
        WSP(float, WS_SC)[i] *= (n >= mm) ? expf(lgf * (n - mm)) : expf(lgb * (mm - n)); }
    long count() const { return (long)H_C * S * S; } };
struct RetNormF { Ctx c;
    HD void operator()(long i) const { const long m = i / H_C; const int h = (int)(i % H_C); const float* r = WSP(float, WS_RET) + m * HALF + h * DK; float s = 0.f; for (int j = 0; j < DK; ++j) s += r[j] * r[j];
        const float rs = 1.0f / sqrtf(s / DK + EPS); for (int j = 0; j < DK; ++j) WSP(bf16_t, WS_MIX)[m * D + h * DK + j] = f2bf(bf2f(WSP(bf16_t, WS_PROJ)[m * CD_N + 3 * H_C * DK + h * DK + j]) * (r[j] * rs * c.in[I_RETGN][h * DK + j])); }
    long count() const { return (long)M * H_C; } };
struct SwaSoftF { Ctx c;
    HD void operator()(long i) const { const int q = (int)(i % S), hd = (int)(i / S); float* r = WSP(float, WS_SC) + i * S; const float sink = c.in[I_SINKS][hd] * LOG2E; const float* rb = c.in[I_RELB];
        const int lo = q - WIN < 0 ? 0 : q - WIN, hi = q + WIN > S - 1 ? S - 1 : q + WIN; float mx = sink;
        for (int k = lo; k <= hi; ++k) { const float s = r[k] + rb[t5_bucket(k - q) * H_D + hd] * LOG2E; r[k] = s; mx = fmaxf(mx, s); }
        float den = exp2f(sink - mx); for (int k = lo; k <= hi; ++k) { const float p = exp2f(r[k] - mx); r[k] = p; den += p; }
        const float inv = 1.0f / den; for (int k = 0; k < S; ++k) r[k] = (k >= lo && k <= hi) ? r[k] * inv : 0.f; }
    long count() const { return (long)H_D * S; } };

#ifdef HOST_TEST
struct Launcher { template <class F> void operator()(const F& f, long n) const { for (long i = 0; i < n; ++i) f(i); } };
#else
template <class F> __global__ void __launch_bounds__(256) run_k(F f, long n) { for (long i = (long)blockIdx.x * 256 + threadIdx.x; i < n; i += (long)gridDim.x * 256) f(i); }
struct Launcher { hipStream_t st; template <class F> void operator()(const F& f, long n) const { long g = (n + 255) / 256; if (g > (1 << 20)) g = 1 << 20; if (g < 1) g = 1; hipLaunchKernelGGL(run_k<F>, dim3((unsigned)g), dim3(256), 0, st, f, n); } };
#endif

template <class F> static F zf() { F f; memset((void*)&f, 0, sizeof(F)); return f; }
static NGemm mk_gemm(const void* A, int a_bf, long a_rs, const void* B, int b_bf, long b_ks, long b_ns, void* C, int c_bf, long c_rs, long Mr, long N, long K) {
    NGemm g; memset((void*)&g, 0, sizeof(g)); g.A = A; g.B = B; g.C = C; g.a_bf = a_bf; g.b_bf = b_bf; g.c_bf = c_bf; g.a_rs = a_rs; g.a_ks = 1; g.b_ks = b_ks; g.b_ns = b_ns; g.c_rs = c_rs; g.Mr = Mr; g.N = N; g.K = K; g.Z2 = 1; return g; }

template <class L> static void rowss(const L& go, const Ctx& c, const float* X, float* out, long rs, long ncols, long os = 1) { RowSSF f = zf<RowSSF>(); f.c = c; f.X = X; f.out = out; f.rs = rs; f.ncols = ncols; f.rows = M; f.os = os; go(f, f.count()); }

enum { PH_P0 = 0, PH_MOD0, PH_G1, PH_G2, PH_SCAN0, PH_ATT0, PH_OUT0, PH_RT0, PH_M1_0, PH_M2_0, PH_CMB0, PH_G3, PH_RET1, PH_SWA1, PH_RN1, PH_OUT1, PH_RT1, PH_M1_1, PH_M2_1, PH_CMB1, N_PHASES };

template <class L> static void naive_phase(const L& go, const Ctx& c, int ph) {
    float* mod = WSP(float, WS_MOD);
    const int l = ph >= PH_G3 ? 1 : 0;
    float* X1 = WSP(float, WS_X1); float* X2 = WSP(float, WS_X2);
    switch (ph) {
    case PH_P0: { { ModF f = zf<ModF>(); f.c = c; go(f, f.count()); } { TabF f = zf<TabF>(); f.c = c; go(f, f.count()); } } break;
    case PH_MOD0: { rowss(go, c, c.in[I_X], WSP(float, WS_RSTD), D, D);
        ModulateF f = zf<ModulateF>(); f.c = c; f.X = c.in[I_X]; f.gain = c.in[I_NMIX]; f.sc = mod + D; f.sh = mod; go(f, f.count()); } break;
    case PH_G1: { { NGemm g = mk_gemm(WSP(bf16_t, WS_HM), 1, D, c.in[I_WINAB], 0, AB_N, 1, WSP(float, WS_T), 0, AB_N, M, AB_N, D); go(g, g.count(1)); }
        { PostG1F f = zf<PostG1F>(); f.c = c; go(f, f.count()); }
        rowss(go, c, WSP(float, WS_T), WSP(float, CTL_SSQ), AB_N, QR, 16);
        rowss(go, c, WSP(float, WS_T) + QR, WSP(float, CTL_SSQ) + 8, AB_N, KVR, 16);
        { KRopeF f = zf<KRopeF>(); f.c = c; go(f, f.count()); } } break;
    case PH_G2: { { NGemm g = mk_gemm(WSP(bf16_t, WS_PROJ), 1, P0_N, c.in[I_WUQ], 0, H_A * QK, 1, WSP(float, WS_T), 0, H_A * QK, M, H_A * QK, QR); g.ks = c.in[I_QLN]; go(g, g.count(1)); }
        { PostQF f = zf<PostQF>(); f.c = c; f.qs = LOG2E / sqrtf((float)QK); go(f, f.count()); }
        { NGemm g = mk_gemm(WSP(bf16_t, WS_PROJ) + QR, 1, P0_N, c.in[I_WUKV], 0, H_A * (NOPE + VD), 1, WSP(float, WS_T), 0, H_A * (NOPE + VD), M, H_A * (NOPE + VD), KVR); g.ks = c.in[I_KVLN]; go(g, g.count(1)); }
        { PostKVF f = zf<PostKVF>(); f.c = c; go(f, f.count()); }
        { ConvF f = zf<ConvF>(); f.c = c; go(f, f.count()); }
        { GatesF f = zf<GatesF>(); f.c = c; go(f, f.count()); } } break;
    case PH_SCAN0: { ScanF f = zf<ScanF>(); f.c = c; go(f, f.count()); } break;
    case PH_ATT0: {
        for (int b = 0; b < NB; ++b) {
            NGemm g = mk_gemm(WSP(bf16_t, WS_Q) + (size_t)b * S * H_A * QK, 1, H_A * QK, WSP(bf16_t, WS_KC) + (size_t)b * S * H_A * QK, 1, 1, H_A * QK, WSP(float, WS_SC), 0, S, S, S, QK);
            g.a_z2 = QK; g.b_z2 = QK; g.c_z2 = (long)S * S; g.Z2 = H_A; go(g, g.count(H_A));
            { SoftmaxF f = zf<SoftmaxF>(); f.c = c; f.rows = (long)H_A * S; go(f, f.count()); }
            NGemm p = mk_gemm(WSP(float, WS_SC), 0, S, WSP(bf16_t, WS_V) + (size_t)b * S * H_A * VD, 1, H_A * VD, 1, WSP(bf16_t, WS_MIX) + (size_t)b * S * D, 1, D, S, VD, S);
            p.a_z2 = (long)S * S; p.b_z2 = VD; p.c_z2 = VD; p.Z2 = H_A; go(p, p.count(H_A)); } } break;
    case PH_OUT0: case PH_OUT1: { NGemm g = mk_gemm(WSP(bf16_t, WS_MIX), 1, D, c.in[l ? I_WOUTCD : I_WOUTAB], 0, D, 1, WSP(float, WS_T), 0, D, M, D, D); go(g, g.count(1));
        OutPostF f = zf<OutPostF>(); f.c = c; f.Xin = l ? X2 : c.in[I_X]; f.Xout = X1; f.l = l; go(f, f.count()); } break;
    case PH_RT0: case PH_RT1: { float* modl = mod + (size_t)l * NB * 6 * D;
        rowss(go, c, X1, WSP(float, WS_RSTD), D, D);
        { ModulateF f = zf<ModulateF>(); f.c = c; f.X = X1; f.gain = c.in[I_NFFN] + l * D; f.sc = modl + 4 * D; f.sh = modl + 3 * D; go(f, f.count()); }
        { NGemm g = mk_gemm(WSP(bf16_t, WS_HM), 1, D, c.in[I_WROUTER] + (size_t)l * D * E, 0, E, 1, WSP(float, WS_T), 0, E, M, E, D); go(g, g.count(1)); }
        { RouteF f = zf<RouteF>(); f.c = c; f.l = l; go(f, f.count()); } } break;
    case PH_M1_0: case PH_M1_1: { Moe1F f = zf<Moe1F>(); f.c = c; f.l = l; go(f, f.count()); } break;
    case PH_M2_0: case PH_M2_1: { Moe2F f = zf<Moe2F>(); f.c = c; f.l = l; go(f, f.count()); } break;
    case PH_CMB0: { { CombineF f = zf<CombineF>(); f.c = c; f.Xin = X1; f.Xout = X2; f.l = 0; go(f, f.count()); }
        rowss(go, c, X2, WSP(float, WS_RSTD), D, D);
        ModulateF f = zf<ModulateF>(); f.c = c; f.X = X2; f.gain = c.in[I_NMIX] + D; f.sc = mod + (size_t)NB * 6 * D + D; f.sh = mod + (size_t)NB * 6 * D; go(f, f.count()); } break;
    case PH_CMB1: { { CombineF f = zf<CombineF>(); f.c = c; f.Xin = X1; f.Xout = X2; f.l = 1; go(f, f.count()); }
        rowss(go, c, X2, WSP(float, WS_RSTD), D, D);
        FinalF f = zf<FinalF>(); f.c = c; f.X = X2; go(f, f.count()); } break;
    case PH_G3: { { NGemm g = mk_gemm(WSP(bf16_t, WS_HM), 1, D, c.in[I_WINCD], 0, CD_N, 1, WSP(float, WS_T), 0, CD_N, M, CD_N, D); go(g, g.count(1)); }
        PostG3F f = zf<PostG3F>(); f.c = c; f.sqs = LOG2E / sqrtf((float)HDS); go(f, f.count()); } break;
    case PH_RET1: {
        for (int b = 0; b < NB; ++b) {
            const bf16_t* Pb = WSP(bf16_t, WS_PROJ) + (size_t)b * S * CD_N;
            NGemm g = mk_gemm(Pb, 1, CD_N, Pb + H_C * DK, 1, 1, CD_N, WSP(float, WS_SC), 0, S, S, S, DK);
            g.a_z2 = DK; g.b_z2 = DK; g.c_z2 = (long)S * S; g.Z2 = H_C; go(g, g.count(H_C));
            { DecayF f = zf<DecayF>(); f.c = c; go(f, f.count()); }
            NGemm p = mk_gemm(WSP(float, WS_SC), 0, S, Pb + 2 * H_C * DK, 1, CD_N, 1, WSP(float, WS_RET) + (size_t)b * S * HALF, 0, HALF, S, DK, S);
            p.a_z2 = (long)S * S; p.b_z2 = DK; p.c_z2 = DK; p.Z2 = H_C; go(p, p.count(H_C)); } } break;
    case PH_SWA1: {
        for (int b = 0; b < NB; ++b) {
            const bf16_t* Pb = WSP(bf16_t, WS_PROJ) + (size_t)b * S * CD_N + 4 * H_C * DK; const int G = H_D / KVH;
            NGemm g = mk_gemm(Pb, 1, CD_N, Pb + H_D * HDS, 1, 1, CD_N, WSP(float, WS_SC), 0, S, S, S, HDS);
            g.a_z1 = (long)G * HDS; g.a_z2 = HDS; g.b_z1 = HDS; g.b_z2 = 0; g.c_z1 = (long)G * S * S; g.c_z2 = (long)S * S; g.Z2 = G; go(g, g.count(H_D));
            { SwaSoftF f = zf<SwaSoftF>(); f.c = c; go(f, f.count()); }
            NGemm p = mk_gemm(WSP(float, WS_SC), 0, S, Pb + H_D * HDS + KVH * HDS, 1, CD_N, 1, WSP(bf16_t, WS_MIX) + (size_t)b * S * D + HALF, 1, D, S, HDS, S);
            p.a_z1 = (long)G * S * S; p.a_z2 = (long)S * S; p.b_z1 = HDS; p.b_z2 = 0; p.c_z1 = (long)G * HDS; p.c_z2 = HDS; p.Z2 = G; go(p, p.count(H_D)); } } break;
    case PH_RN1: { RetNormF f = zf<RetNormF>(); f.c = c; go(f, f.count()); } break;
    default: break;
    }
}
template <class L> static void naive_offt(const L& go, const Ctx& c, int l) { OffF f = zf<OffF>(); f.c = c; f.l = l; go(f, f.count()); }

#ifdef HOST_TEST
template <class L> static void run_all(const L& go, const Ctx& c) {
    for (int ph = 0; ph < N_PHASES; ++ph) { naive_phase(go, c, ph); if (ph == PH_RT0 || ph == PH_RT1) naive_offt(go, c, ph == PH_RT1); }
}
#endif
#ifndef HOST_TEST
#define LAS __attribute__((address_space(3)))
#define GAS __attribute__((address_space(1)))
typedef unsigned v4u __attribute__((ext_vector_type(4)));
typedef unsigned u32x2 __attribute__((ext_vector_type(2)));
typedef float f32x4 __attribute__((ext_vector_type(4)));
typedef float f32x16 __attribute__((ext_vector_type(16)));
typedef short bf16x8 __attribute__((ext_vector_type(8)));
typedef short s16x4 __attribute__((ext_vector_type(4)));
typedef int v8i_t __attribute__((ext_vector_type(8)));
typedef int v4i_t __attribute__((ext_vector_type(4)));
typedef GAS unsigned gu32;
#define RLX_AGENT __ATOMIC_RELAXED, __HIP_MEMORY_SCOPE_AGENT
#define LDS_WAIT() asm volatile("s_waitcnt lgkmcnt(0)" ::: "memory")
#define VM_WAIT() asm volatile("s_waitcnt vmcnt(0)" ::: "memory")
constexpr int NWAVES = 8, NTHR = 512;
constexpr int LDS_BYTES = 147456, MISC_OFF = LDS_BYTES - 2048, TAB_OFF = MISC_OFF + 1024;
__device__ __forceinline__ int lane_id() { int l; asm volatile("v_mbcnt_lo_u32_b32 %0, -1, 0\n\tv_mbcnt_hi_u32_b32 %0, -1, %0" : "=v"(l)); return l; }
__device__ __forceinline__ unsigned cvt_pk_bf16(float lo, float hi) { unsigned r; asm volatile("v_cvt_pk_bf16_f32 %0, %1, %2" : "=v"(r) : "v"(lo), "v"(hi)); return r; }
__device__ __forceinline__ float fast_sigm(float x) { return __builtin_amdgcn_rcpf(1.0f + __builtin_amdgcn_exp2f(-1.4426950408889634f * x)); }
__device__ __forceinline__ float fast_silu(float x) { return x * fast_sigm(x); }
__device__ __forceinline__ float fast_gelu_tanh(float x) { const float z = 0.7978845608028654f * (x + 0.044715f * x * x * x); return x * fast_sigm(2.0f * z); }
__device__ __forceinline__ float wave_sum(float v) {
#pragma unroll
    for (int o = 1; o < 64; o <<= 1) v += __shfl_xor(v, o);
    return v; }

#define XB_TMO      128
#define XB_XCNT(j)  (256  + 64 * (j))
#define XB_XSUB(j)  (1280 + 64 * (j))
#define XB_XGEN(j)  (2304 + 64 * (j))
#define XB_TOP      3328
#define XB_TOPGEN   3392
#define XCD_BAR_WORDS 3456
#define XB_SPIN_CAP (1u << 20)
__device__ __forceinline__ unsigned xb_ld(unsigned* p)              { return __hip_atomic_load(p, __ATOMIC_RELAXED, __HIP_MEMORY_SCOPE_AGENT); }
__device__ __forceinline__ unsigned xb_add(unsigned* p, unsigned v) { return __hip_atomic_fetch_add(p, v, __ATOMIC_RELAXED, __HIP_MEMORY_SCOPE_AGENT); }
__device__ __forceinline__ unsigned xb_xcc_id() { return (unsigned)__builtin_amdgcn_s_getreg((3 << 11) | 20) & 0xFu; }
#define XB_SPIN(cond, bar) do { unsigned _sp = 0; while (cond) { __builtin_amdgcn_s_sleep(1); \
    if ((++_sp & 255u) == 0u) { if (xb_ld(&(bar)[XB_TMO])) break; if (_sp > XB_SPIN_CAP) { atomicAdd(&(bar)[XB_TMO], 1u); break; } } } } while (0)
struct XcdBarrier { unsigned* bar; unsigned x; volatile LAS unsigned* st; int wave; };
__device__ __forceinline__ XcdBarrier xcd_barrier_post(unsigned* bar, volatile LAS unsigned* st, int wave) {
    XcdBarrier b; b.bar = bar; b.x = xb_xcc_id(); b.st = st; b.wave = wave;
    if (wave == 0 && lane_id() == 0) (void)xb_add(&bar[XB_XCNT(b.x)], 1u);
    return b; }
__device__ __forceinline__ void xcd_barrier_complete(unsigned* bar, unsigned x, unsigned& nloc, unsigned& nx) {
    const unsigned G = gridDim.x * gridDim.y * gridDim.z;
    unsigned sum, cnt, mine, sp = 0u;
    for (;;) {
        sum = 0u; cnt = 0u; mine = 0u;
#pragma unroll
        for (unsigned j = 0; j < 16; ++j) { const unsigned c = xb_ld(&bar[XB_XCNT(j)]); sum += c; cnt += (c > 0u) ? 1u : 0u; mine = (j == x) ? c : mine; }
        if (sum == G) break;
        __builtin_amdgcn_s_sleep(1);
        if ((++sp & 255u) == 0u) { if (xb_ld(&bar[XB_TMO])) break; if (sp > XB_SPIN_CAP) { atomicAdd(&bar[XB_TMO], 1u); break; } }
    }
    nloc = mine > 0u ? mine : 1u; nx = cnt > 0u ? cnt : 1u; }
__device__ __forceinline__ void xcd_barrier(const XcdBarrier& b) {
    asm volatile("s_waitcnt vmcnt(0)" ::: "memory");
    __syncthreads();
    if (b.wave == 0 && lane_id() == 0) {
        unsigned* bar = b.bar;
        __builtin_amdgcn_s_waitcnt(0);
        unsigned nloc = b.st[0], nx = b.st[1];
        if (nloc == 0u) { xcd_barrier_complete(bar, b.x, nloc, nx); b.st[0] = nloc; b.st[1] = nx; }
        const unsigned old = xb_add(&bar[XB_XSUB(b.x)], 1u);
        const unsigned gen = old / nloc;
        if (old + 1u == (gen + 1u) * nloc) {
            __builtin_amdgcn_fence(__ATOMIC_RELEASE, "agent");
            asm volatile("s_waitcnt vmcnt(0)" ::: "memory");
            const unsigned og = xb_add(&bar[XB_TOP], 1u);
            const unsigned tg = og / nx;
            if (og + 1u == (tg + 1u) * nx) xb_add(&bar[XB_TOPGEN], 1u);
            else XB_SPIN(xb_ld(&bar[XB_TOPGEN]) == tg, bar);
            __builtin_amdgcn_fence(__ATOMIC_ACQUIRE, "agent");
            xb_add(&bar[XB_XGEN(b.x)], 1u);
            asm volatile("s_waitcnt vmcnt(0)" ::: "memory");
        } else {
            XB_SPIN(xb_ld(&bar[XB_XGEN(b.x)]) == gen, bar);
            __builtin_amdgcn_fence(__ATOMIC_ACQUIRE, "agent");
            asm volatile("s_waitcnt vmcnt(0)" ::: "memory");
        }
    }
    __syncthreads();
}

namespace pg8 {
constexpr int BM = 256, BK = 64, HALFT = 128, HTB = HALFT * BK * 2, STAGE_BYTES = 8 * HTB, NXCD = 8, WGM = 8;
__host__ __device__ __forceinline__ int lds_byte(int r, int c) { const int st = (r >> 4) * 2 + (c >> 5), rr = r & 15, cc = c & 31, ob = rr * 64 + cc * 2; return st * 1024 + (ob ^ (((ob >> 9) & 1) << 5)); }
__host__ __device__ __forceinline__ void stage_rc(int b, int& R, int& C) { const int st = b / 1024, sb = b % 1024, swz = sb ^ (((sb >> 9) & 1) << 5); R = (st >> 1) * 16 + swz / 64; C = (st & 1) * 32 + (swz % 64) / 2; }
__host__ __device__ __forceinline__ int perm32(int rho) { const int n = rho >> 4, i = rho & 15; return 8 * (i >> 2) + 4 * n + (i & 3); }
struct Unit { const char* A; const char* B; int pm, pn, e, r0; };
__device__ __forceinline__ void tile_of(int L, int nM, int nN, int& pm, int& pn) {
    const int nwg = nM * nN; int wgid = L; { const int q = nwg / NXCD, r = nwg % NXCD, xcd = wgid % NXCD, off = wgid / NXCD; wgid = (xcd < r ? xcd * (q + 1) : r * (q + 1) + (xcd - r) * q) + off; }
    const int nig = WGM * nN, gid = wgid / nig, fm = gid * WGM, gsz = (nM - fm) < WGM ? (nM - fm) : WGM;
    pm = fm + ((wgid % nig) % gsz); pn = (wgid % nig) / gsz; }
template <class E_, class = void> struct perm16_t { static constexpr bool value = false; };
template <class E_> struct perm16_t<E_, decltype((void)E_::PERM16)> { static constexpr bool value = E_::PERM16; };
template <class E_> constexpr bool perm16_v = perm16_t<E_>::value;
struct APlain { static __device__ __forceinline__ const char* kt(const char* base, int t, int) { return base + (size_t)t * (BK * 2); } };
struct AConv { static __device__ __forceinline__ const char* kt(const char* base, int t, int lda) { return base + (long)((t >> 1) - 2) * (lda * 2) + (t & 1) * (BK * 2); } };

template <class Epi, class Sched, class AP, bool GATHER, bool ALIGN_EPI, int EB = 2>
__device__ __forceinline__ void gemm_phase(LAS unsigned char* lds, const int wave, const char* base, const int lda, const int ldb, const int K, const Sched& S, const Epi& E) {
    const __amdgpu_buffer_rsrc_t rsrc = __builtin_amdgcn_make_buffer_rsrc((void*)base, (short)0, -1, 0x00020000);
    const int wid = __builtin_amdgcn_readfirstlane(wave), lane = lane_id(), tid = wid * 64 + lane, wr = wid >> 2, wc = wid & 3, fr = lane & 15, fq = lane >> 4;
    const int nt = K / BK;
    unsigned vA[2][2], vAn[2][2], vB[2], vB1[2];
#pragma unroll
    for (int i = 0; i < 2; ++i) { int R, C; stage_rc(tid * 16 + i * 8192, R, C); const int Rb = Epi::PERM ? ((R & ~31) + perm32(R & 31)) : R;
        if constexpr (perm16_v<Epi>) { const int wcR = R >> 5, rho = R & 31, n_ = rho >> 4, i_ = rho & 15; const int src0 = 64 * wcR + 16 * (i_ >> 2) + 4 * n_ + (i_ & 3);
            vB[i] = (unsigned)(src0 * ldb + C) * 2u; vB1[i] = (unsigned)((src0 + 8) * ldb + C) * 2u; }
        else { vB[i] = (unsigned)(Rb * ldb + C) * 2u; vB1[i] = 0u; }
#pragma unroll
        for (int h = 0; h < 2; ++h) { vA[h][i] = GATHER ? (unsigned)C * 2u : (h == 0 ? (unsigned)(R * lda + C) * 2u : 0u); vAn[h][i] = vA[h][i]; } }
    const size_t kstep = (size_t)(BK * 2), hstepB = (size_t)HALFT * ldb * 2, hB1 = perm16_v<Epi> ? 0 : hstepB;
    const unsigned (&vBs)[2] = perm16_v<Epi> ? vB1 : vB;
    const unsigned (&vA1)[2] = GATHER ? vA[1] : vA[0]; const size_t hA1 = GATHER ? 0 : (size_t)HALFT * lda * 2;
    const unsigned ldsw = (unsigned)wid * 1024u;
    const int aoff = lds_byte(wr * 64 + fr, fq * 8), boff = lds_byte(wc * 32 + fr, fq * 8);
#define PG8_SA(b, h) (((b) * 2 + (h)) * HTB)
#define PG8_SB(b, h) ((4 + (b) * 2 + (h)) * HTB)
#define PG8_STAGE(bufoff, gbase, voff) do { const int so_ = (int)(unsigned)(size_t)((const char*)(gbase) - base); _Pragma("unroll") for (int _i = 0; _i < 2; ++_i) \
        __builtin_amdgcn_raw_ptr_buffer_load_lds(rsrc, (LAS void*)(lds + (bufoff) + ldsw + _i * 8192), 16, (int)(voff)[_i], so_, 0, 0); } while (0)
#define PG8_LDA(dst, b, h) do { _Pragma("unroll") for (int m = 0; m < 4; ++m) { if constexpr (EB == 2) { _Pragma("unroll") for (int k = 0; k < 2; ++k) dst[m][k] = *(const LAS bf16x8*)(lds + PG8_SA(b, h) + aoff + m * 2048 + k * 1024); } \
        else { const v4i_t lo_ = *(const LAS v4i_t*)(lds + PG8_SA(b, h) + aoff + m * 2048), hi_ = *(const LAS v4i_t*)(lds + PG8_SA(b, h) + aoff + m * 2048 + 1024); dst##8[m] = __builtin_shufflevector(lo_, hi_, 0, 1, 2, 3, 4, 5, 6, 7); } } } while (0)
#define PG8_LDB(dst, b, h) do { _Pragma("unroll") for (int n = 0; n < 2; ++n) { if constexpr (EB == 2) { _Pragma("unroll") for (int k = 0; k < 2; ++k) dst[n][k] = *(const LAS bf16x8*)(lds + PG8_SB(b, h) + boff + n * 2048 + k * 1024); } \
        else { const v4i_t lo_ = *(const LAS v4i_t*)(lds + PG8_SB(b, h) + boff + n * 2048), hi_ = *(const LAS v4i_t*)(lds + PG8_SB(b, h) + boff + n * 2048 + 1024); dst##8[n] = __builtin_shufflevector(lo_, hi_, 0, 1, 2, 3, 4, 5, 6, 7); } } } while (0)
#define PG8_MMA(ai, bj, At, Bt) do { __builtin_amdgcn_s_setprio(1); _Pragma("unroll") for (int m = 0; m < 4; ++m) _Pragma("unroll") for (int n = 0; n < 2; ++n) { \
        if constexpr (EB == 2) { _Pragma("unroll") for (int k = 0; k < 2; ++k) acc[ai][bj][m][n] = __builtin_amdgcn_mfma_f32_16x16x32_bf16(Bt[n][k], At[m][k], acc[ai][bj][m][n], 0, 0, 0); } \
        else acc[ai][bj][m][n] = __builtin_amdgcn_mfma_scale_f32_16x16x128_f8f6f4(Bt##8[n], At##8[m], acc[ai][bj][m][n], 0, 0, 0, 0x7F7F7F7F, 0, 0x7F7F7F7F); } \
        __builtin_amdgcn_s_setprio(0); } while (0)
#define PG8_WAIT_V(n) asm volatile("s_waitcnt vmcnt(" #n ")" ::: "memory")
#define PG8_WAIT_L(n) asm volatile("s_waitcnt lgkmcnt(" #n ")" ::: "memory")
#define PG8_BAR __builtin_amdgcn_s_barrier()
#define PG8_SCHED __builtin_amdgcn_sched_barrier(0)
    Unit cur, nxt; int ui = 0;
    if (!S.next(0, cur)) return;
    f32x4 acc[2][2][4][2];
#pragma unroll
    for (int a = 0; a < 2; ++a)
#pragma unroll
        for (int b = 0; b < 2; ++b)
#pragma unroll
            for (int m = 0; m < 4; ++m)
#pragma unroll
                for (int n = 0; n < 2; ++n) acc[a][b][m][n] = (f32x4){0.f, 0.f, 0.f, 0.f};
    bf16x8 At[4][2], B0[2][2], B1[2][2]; v8i_t At8[4], B08[2], B18[2];
    if constexpr (GATHER) {
#pragma unroll
        for (int h = 0; h < 2; ++h)
#pragma unroll
            for (int i = 0; i < 2; ++i) { int R_, C_; stage_rc(tid * 16 + i * 8192, R_, C_); vA[h][i] = (unsigned)S.row(cur, h * HALFT + R_) * (unsigned)(lda * 2) + (unsigned)C_ * 2u; vAn[h][i] = vA[h][i]; }
        PG8_WAIT_V(0);
    }
    const char* cA = cur.A; const char* cB = cur.B;
    PG8_STAGE(PG8_SB(0, 0), cB, vB); PG8_STAGE(PG8_SB(0, 1), cB + hB1, vBs); PG8_STAGE(PG8_SA(0, 0), AP::kt(cA, 0, lda), vA[0]); PG8_STAGE(PG8_SA(0, 1), AP::kt(cA, 0, lda) + hA1, vA1);
    if (wr == 1) PG8_BAR;
    PG8_WAIT_V(2); PG8_BAR;
    PG8_STAGE(PG8_SB(1, 0), cB + kstep, vB); PG8_STAGE(PG8_SA(1, 0), AP::kt(cA, 1, lda), vA[0]); PG8_STAGE(PG8_SB(1, 1), cB + hB1 + kstep, vBs);
    PG8_WAIT_V(6); PG8_BAR;
    for (;;) {
        const bool has_next = S.next(ui + 1, nxt);
        const char* nA = has_next ? nxt.A : cA; const char* nB = has_next ? nxt.B : cB;
        if constexpr (GATHER) {
            if (has_next) {
#pragma unroll
                for (int h = 0; h < 2; ++h)
#pragma unroll
                    for (int i = 0; i < 2; ++i) { int R_, C_; stage_rc(tid * 16 + i * 8192, R_, C_); vAn[h][i] = (unsigned)S.row(nxt, h * HALFT + R_) * (unsigned)(lda * 2) + (unsigned)C_ * 2u; }
                PG8_WAIT_V(0);
            }
        }
#pragma unroll 1
        for (int t = 0; t < nt; t += 2) {
            const bool last = (t == nt - 2);
            const char* a1 = AP::kt(cA, t + 1, lda);
            const char* a2 = last ? AP::kt(nA, 0, lda) : AP::kt(cA, t + 2, lda); const char* a3 = last ? AP::kt(nA, 1, lda) : AP::kt(cA, t + 3, lda);
            const char* b2 = last ? nB : cB + (size_t)(t + 2) * kstep; const char* b3 = b2 + kstep;
            PG8_LDB(B0, 0, 0); PG8_LDB(B1, 0, 1); PG8_SCHED; PG8_LDA(At, 0, 0); PG8_STAGE(PG8_SA(1, 1), a1 + hA1, vA1);
            if constexpr (GATHER) { if (last) { _Pragma("unroll") for (int h = 0; h < 2; ++h) _Pragma("unroll") for (int i = 0; i < 2; ++i) vA[h][i] = vAn[h][i]; } }
            PG8_WAIT_V(8); PG8_WAIT_L(0); PG8_BAR; PG8_MMA(0, 0, At, B0); PG8_MMA(0, 1, At, B1); PG8_BAR; PG8_SCHED;
            PG8_LDA(At, 0, 1); PG8_STAGE(PG8_SB(0, 0), b2, vB); PG8_STAGE(PG8_SB(0, 1), b2 + hB1, vBs); PG8_STAGE(PG8_SA(0, 0), a2, vA[0]);
            PG8_WAIT_V(8); PG8_WAIT_L(0); PG8_BAR; PG8_MMA(1, 0, At, B0); PG8_MMA(1, 1, At, B1); PG8_BAR; PG8_SCHED;
            PG8_LDB(B0, 1, 0); PG8_LDB(B1, 1, 1); PG8_SCHED; PG8_LDA(At, 1, 0); PG8_STAGE(PG8_SA(0, 1), a2 + hA1, vA1);
            PG8_WAIT_V(8); PG8_WAIT_L(0); PG8_BAR; PG8_MMA(0, 0, At, B0); PG8_MMA(0, 1, At, B1); PG8_BAR; PG8_SCHED;
            PG8_LDA(At, 1, 1); PG8_STAGE(PG8_SB(1, 0), b3, vB); PG8_STAGE(PG8_SB(1, 1), b3 + hB1, vBs); PG8_STAGE(PG8_SA(1, 0), a3, vA[0]);
            PG8_WAIT_V(8); PG8_WAIT_L(0); PG8_BAR; PG8_MMA(1, 0, At, B0); PG8_MMA(1, 1, At, B1); PG8_BAR; PG8_SCHED;
        }
        if constexpr (ALIGN_EPI) { if (wr == 0) PG8_BAR; }
        { const int l2_ = lane_id();
          E(acc, cur, wr, wc, l2_ & 15, l2_ >> 4);
#ifdef PROBE_EPI2
          if (Epi::PROBE2) { asm volatile("s_waitcnt vmcnt(0)" ::: "memory"); E(acc, cur, wr, wc, l2_ & 15, l2_ >> 4); }
#endif
          }
        if (!has_next) break;
#pragma unroll
        for (int a = 0; a < 2; ++a)
#pragma unroll
            for (int b = 0; b < 2; ++b)
#pragma unroll
                for (int m = 0; m < 4; ++m)
#pragma unroll
                    for (int n = 0; n < 2; ++n) acc[a][b][m][n] = (f32x4){0.f, 0.f, 0.f, 0.f};
        cur = nxt; cA = nA; cB = nB; ++ui;
        if constexpr (GATHER) {
#pragma unroll
            for (int h = 0; h < 2; ++h)
#pragma unroll
                for (int i = 0; i < 2; ++i) vA[h][i] = vAn[h][i];
        }
        if constexpr (ALIGN_EPI) { if (wr == 1) PG8_BAR; }
    }
    PG8_WAIT_V(0);
    if constexpr (!ALIGN_EPI) { if (wr == 0) PG8_BAR; }
    PG8_BAR;
#undef PG8_SA
#undef PG8_SB
#undef PG8_STAGE
#undef PG8_LDA
#undef PG8_LDB
#undef PG8_MMA
#undef PG8_WAIT_V
#undef PG8_WAIT_L
#undef PG8_BAR
#undef PG8_SCHED
}

struct DenseOrder {
    const char* A; const char* B; int nM, nN, G, c; long a_tile, b_tile;
    __device__ __forceinline__ bool next(int i, Unit& u) const { const long L = (long)i * G + c; if (L >= (long)nM * nN) return false; int pm, pn; tile_of((int)L, nM, nN, pm, pn);
        u.pm = pm; u.pn = pn; u.e = 0; u.r0 = pm * BM; u.A = A + (size_t)pm * a_tile; u.B = B + (size_t)pn * b_tile; return true; }
    __device__ __forceinline__ int row(const Unit&, int) const { return 0; }
};
}
namespace pg8 {
typedef const f32x4 (&AccRef)[2][2][4][2];
__device__ __forceinline__ const LAS int* lds_tab() { unsigned a; asm volatile("v_mov_b32 %0, %1" : "=v"(a) : "i"(TAB_OFF)); return (const LAS int*)(size_t)a; }
__device__ __forceinline__ v4u pack8(const f32x4 a, const f32x4 b) { v4u w; w.x = cvt_pk_bf16(a[0], a[1]); w.y = cvt_pk_bf16(a[2], a[3]); w.z = cvt_pk_bf16(b[0], b[1]); w.w = cvt_pk_bf16(b[2], b[3]); return w; }

struct EpiOut {
    static constexpr bool PERM = false; static constexpr bool PROBE2 = false;
    const float* Xin; float* Xout; const float* g;
    __device__ __forceinline__ void operator()(AccRef acc, const Unit& u, int wr, int wc, int fr, int fq) const {
        const int b = u.r0 / S; const int col0 = u.pn * BM + wc * 32 + 4 * fq; f32x4 gv[2][2];
#pragma unroll
        for (int bj = 0; bj < 2; ++bj)
#pragma unroll
            for (int n = 0; n < 2; ++n) gv[bj][n] = *(const f32x4*)(g + (size_t)b * 6 * D + col0 + bj * HALFT + n * 16);
#pragma unroll
        for (int ai = 0; ai < 2; ++ai) { f32x4 xi[4][2][2];
#pragma unroll
            for (int m = 0; m < 4; ++m) { const size_t off = (size_t)(u.r0 + ai * HALFT + wr * 64 + m * 16 + fr) * D + col0;
#pragma unroll
                for (int bj = 0; bj < 2; ++bj)
#pragma unroll
                    for (int n = 0; n < 2; ++n) xi[m][bj][n] = *(const f32x4*)(Xin + off + bj * HALFT + n * 16); }
#pragma unroll
            for (int m = 0; m < 4; ++m) { const size_t off = (size_t)(u.r0 + ai * HALFT + wr * 64 + m * 16 + fr) * D + col0;
#pragma unroll
                for (int bj = 0; bj < 2; ++bj)
#pragma unroll
                    for (int n = 0; n < 2; ++n) *(f32x4*)(Xout + off + bj * HALFT + n * 16) = xi[m][bj][n] + gv[bj][n] * acc[ai][bj][m][n]; }
            asm volatile("" ::: "memory"); }
    }
};
struct EpiG1 {
    static constexpr bool PERM = true; static constexpr bool PROBE2 = false;
    bf16_t* proj; bf16_t* lxp; float* ssq;
    __device__ __forceinline__ void operator()(AccRef acc, const Unit& u, int wr, int wc, int fr, int fq) const {
        const int pn = u.pn; const int c0 = pn * BM + wc * 32 + 8 * fq; const int NT_LAT = (QR + KVR) / BM, NT_X = LW / BM;
#pragma unroll
        for (int ai = 0; ai < 2; ++ai)
#pragma unroll
            for (int m = 0; m < 4; ++m) { const int row = u.r0 + ai * HALFT + wr * 64 + m * 16 + fr; float ss = 0.f;
#pragma unroll
                for (int bj = 0; bj < 2; ++bj) { f32x4 v0 = acc[ai][bj][m][0], v1 = acc[ai][bj][m][1];
                    if (pn < NT_LAT) { ss += (v0[0] * v0[0] + v0[1] * v0[1]) + (v0[2] * v0[2] + v0[3] * v0[3]) + (v1[0] * v1[0] + v1[1] * v1[1]) + (v1[2] * v1[2] + v1[3] * v1[3]); }
                    if (pn >= NT_LAT + NT_X) {
#pragma unroll
                        for (int j = 0; j < 4; ++j) { v0[j] = fast_gelu_tanh(v0[j]); v1[j] = fast_gelu_tanh(v1[j]); } }
                    const v4u w = pack8(v0, v1);
                    *(v4u*)(proj + (size_t)row * P0_N + c0 + bj * HALFT) = w;
                    if (pn >= NT_LAT && pn < NT_LAT + NT_X) { const int b = row / S, t = row % S; *(v4u*)(lxp + ((size_t)b * (S + 4) + 2 + t) * LW + (c0 + bj * HALFT - (QR + KVR))) = w; } }
                if (pn < NT_LAT) { ss += __shfl_xor(ss, 16); ss += __shfl_xor(ss, 32); if (fq == 0) ssq[(size_t)row * 16 + pn * 4 + wc] = ss; } }
    }
};
struct EpiG2 {
    static constexpr bool PERM = true; static constexpr bool PROBE2 = false;
    bf16_t* Q; bf16_t* KC; bf16_t* V; const float* ssq; const float* cosr; const float* sinr; float qs;
    __device__ __forceinline__ void operator()(AccRef acc, const Unit& u, int wr, int wc, int fr, int fq) const {
        const int pn = u.pn; const int NQ_N = H_A * NOPE / BM, NQ = H_A * QK / BM;
#pragma unroll
        for (int ai = 0; ai < 2; ++ai)
#pragma unroll
            for (int m = 0; m < 4; ++m) { const int row = u.r0 + ai * HALFT + wr * 64 + m * 16 + fr;
                if (pn < NQ_N) { const float rs = 1.0f / sqrtf(ssq8(ssq + (size_t)row * 16) * (1.0f / QR) + EPS) * qs;
#pragma unroll
                    for (int bj = 0; bj < 2; ++bj) { const int h = 2 * pn + bj; *(v4u*)(Q + ((size_t)row * H_A + h) * QK + wc * 32 + 8 * fq) = pack8(acc[ai][bj][m][0] * rs, acc[ai][bj][m][1] * rs); } }
                else if (pn < NQ) { const float rs = 1.0f / sqrtf(ssq8(ssq + (size_t)row * 16) * (1.0f / QR) + EPS) * qs; const int h = 4 * (pn - NQ_N) + wc, t = row % S;
                    const f32x4 c0 = *(const f32x4*)(cosr + t * (ROPE / 2) + 8 * fq), c1 = *(const f32x4*)(cosr + t * (ROPE / 2) + 8 * fq + 4), s0 = *(const f32x4*)(sinr + t * (ROPE / 2) + 8 * fq), s1 = *(const f32x4*)(sinr + t * (ROPE / 2) + 8 * fq + 4);
                    const f32x4 x10 = acc[ai][0][m][0] * rs, x11 = acc[ai][0][m][1] * rs, x20 = acc[ai][1][m][0] * rs, x21 = acc[ai][1][m][1] * rs;
                    bf16_t* q = Q + ((size_t)row * H_A + h) * QK + NOPE + 8 * fq;
                    *(v4u*)q = pack8(x10 * c0 - x20 * s0, x11 * c1 - x21 * s1); *(v4u*)(q + ROPE / 2) = pack8(x20 * c0 + x10 * s0, x21 * c1 + x11 * s1); }
                else { const float rs = 1.0f / sqrtf(ssq8(ssq + (size_t)row * 16 + 8) * (1.0f / KVR) + EPS); const int h = pn - NQ;
                    *(v4u*)(KC + ((size_t)row * H_A + h) * QK + wc * 32 + 8 * fq) = pack8(acc[ai][0][m][0] * rs, acc[ai][0][m][1] * rs);
                    *(v4u*)(V + ((size_t)row * H_A + h) * VD + wc * 32 + 8 * fq) = pack8(acc[ai][1][m][0] * rs, acc[ai][1][m][1] * rs); } }
    }
};
struct OrderG2 {
    const char* A; const char* Bq; const char* Bkv; int G, c;
    __device__ __forceinline__ bool next(int i, Unit& u) const { const int nN = (H_A * QK + H_A * (NOPE + VD)) / BM, nM = M / BM; const long L = (long)i * G + c; if (L >= (long)nM * nN) return false; int pm, pn; tile_of((int)L, nM, nN, pm, pn);
        const int NQ = H_A * QK / BM; u.pm = pm; u.pn = pn; u.e = 0; u.r0 = pm * BM; u.A = A + (size_t)pm * BM * P0_N * 2 + (pn < NQ ? 0 : QR * 2);
        u.B = pn < NQ ? Bq + (size_t)pn * BM * QR * 2 : Bkv + (size_t)(pn - NQ) * BM * KVR * 2; return true; }
    __device__ __forceinline__ int row(const Unit&, int) const { return 0; }
};
struct EpiGates {
    static constexpr bool PERM = true; static constexpr bool PROBE2 = false;
    bf16_t* LA; bf16_t* U; const bf16_t* lxp; const float* gb; const float* cl; const float* convw; const float* convb;
    __device__ __forceinline__ void operator()(AccRef acc, const Unit& u, int wr, int wc, int fr, int fq) const {
        const int g = u.pn >> 1, d = u.pn & 1; const int ch0 = g * LBS + wc * 32 + 8 * fq; const int b = u.r0 / S;
        f32x4 ba[2], bx[2], clv[2], cb[2], cw[4][2];
#pragma unroll
        for (int n = 0; n < 2; ++n) { const int ch = ch0 + 4 * n; ba[n] = *(const f32x4*)(gb + (d * 2 + 0) * LW + ch); bx[n] = *(const f32x4*)(gb + (d * 2 + 1) * LW + ch); clv[n] = *(const f32x4*)(cl + d * LW + ch); cb[n] = *(const f32x4*)(convb + ch);
#pragma unroll
            for (int j = 0; j < 4; ++j) cw[j][n] = *(const f32x4*)(convw + j * LW + ch); }
#pragma unroll
        for (int ai = 0; ai < 2; ++ai)
#pragma unroll
            for (int m = 0; m < 4; ++m) { const int row = u.r0 + ai * HALFT + wr * 64 + m * 16 + fr; const int t = row % S; f32x4 la[2], uu[2], xc[2] = {cb[0], cb[1]};
                v4u raw[4];
#pragma unroll
                for (int j = 0; j < 4; ++j) raw[j] = *(const v4u*)(lxp + ((size_t)b * (S + 4) + t + j) * LW + ch0);
#pragma unroll
                for (int j = 0; j < 4; ++j)
#pragma unroll
                    for (int n = 0; n < 2; ++n) { const unsigned r0_ = raw[j][2 * n], r1_ = raw[j][2 * n + 1];
                        xc[n][0] += cw[j][n][0] * __uint_as_float(r0_ << 16); xc[n][1] += cw[j][n][1] * __uint_as_float(r0_ & 0xffff0000u); xc[n][2] += cw[j][n][2] * __uint_as_float(r1_ << 16); xc[n][3] += cw[j][n][3] * __uint_as_float(r1_ & 0xffff0000u); }
#pragma unroll
                for (int n = 0; n < 2; ++n)
#pragma unroll
                    for (int j = 0; j < 4; ++j) { const float l = clv[n][j] * fast_sigm(acc[ai][0][m][n][j] + ba[n][j]); const float x2 = 2.0f * l;
                        const float em = -x2 * (1.0f + 0.5f * x2 * (1.0f + (1.0f / 3.0f) * x2 * (1.0f + 0.25f * x2 * (1.0f + 0.2f * x2))));
                        la[n][j] = l; uu[n][j] = sqrtf(em) * fast_sigm(acc[ai][1][m][n][j] + bx[n][j]) * xc[n][j]; }
                const long o = lru_idx(d, b, t, ch0); *(v4u*)(LA + o) = pack8(la[0], la[1]); *(v4u*)(U + o) = pack8(uu[0], uu[1]); }
    }
};
struct OrderGates {
    const char* lxp; const char* B; int G, c;
    __device__ __forceinline__ bool next(int i, Unit& u) const { const int nN = 2 * (LW / LBS), nM = M / BM; const long L = (long)i * G + c; if (L >= (long)nM * nN) return false; int pm, pn; tile_of((int)L, nM, nN, pm, pn);
        u.pm = pm; u.pn = pn; u.e = 0; u.r0 = pm * BM; const int b = u.r0 / S, t0 = u.r0 % S, g = pn >> 1;
        u.A = lxp + (((size_t)b * (S + 4) + 2 + t0) * LW + g * LBS) * 2; u.B = B + (size_t)pn * BM * (4 * LBS) * 2; return true; }
    __device__ __forceinline__ int row(const Unit&, int) const { return 0; }
};
struct EpiG3 {
    static constexpr bool PERM = true; static constexpr bool PROBE2 = false;
    bf16_t* proj; const float* cost; const float* sint; float sqs;
    __device__ __forceinline__ void operator()(AccRef acc, const Unit& u, int wr, int wc, int fr, int fq) const {
        const int pn = u.pn; const int NH = H_C * DK / BM;
#pragma unroll
        for (int ai = 0; ai < 2; ++ai)
#pragma unroll
            for (int m = 0; m < 4; ++m) { const int row = u.r0 + ai * HALFT + wr * 64 + m * 16 + fr; bf16_t* p = proj + (size_t)row * CD_N + pn * BM + wc * 32 + 8 * fq;
                if (pn < 2 * NH) { const int t = row % S, i0 = wc * 32 + 8 * fq; const float sc = pn < NH ? 1.0f : 1.0f / sqrtf((float)DK);
                    const f32x4 c0 = *(const f32x4*)(cost + t * (DK / 2) + i0) * sc, c1 = *(const f32x4*)(cost + t * (DK / 2) + i0 + 4) * sc, s0 = *(const f32x4*)(sint + t * (DK / 2) + i0) * sc, s1 = *(const f32x4*)(sint + t * (DK / 2) + i0 + 4) * sc;
                    const f32x4 x10 = acc[ai][0][m][0], x11 = acc[ai][0][m][1], x20 = acc[ai][1][m][0], x21 = acc[ai][1][m][1];
                    *(v4u*)p = pack8(x10 * c0 - x20 * s0, x11 * c1 - x21 * s1); *(v4u*)(p + HALFT) = pack8(x20 * c0 + x10 * s0, x21 * c1 + x11 * s1); }
                else {
#pragma unroll
                    for (int bj = 0; bj < 2; ++bj) { f32x4 v0 = acc[ai][bj][m][0], v1 = acc[ai][bj][m][1];
                        if (pn >= 3 * NH && pn < 4 * NH) {
#pragma unroll
                            for (int j = 0; j < 4; ++j) { v0[j] = fast_silu(v0[j]); v1[j] = fast_silu(v1[j]); } }
                        else if (pn >= 4 * NH && pn < 4 * NH + H_D * HDS / BM) { v0 = v0 * sqs; v1 = v1 * sqs; }
                        *(v4u*)(p + bj * HALFT) = pack8(v0, v1); } } }
    }
};
struct OrderMoe {
    const LAS int* offt; const char* A; const char* B; const int* tok; int npn, G, c, gather; long b_exp, b_tile, a_tile;
    __device__ __forceinline__ bool next(int i, Unit& u) const { const long L = (long)i * G + c; const int T = (int)(L / npn); if (T >= offt[E + 1]) return false; const int e = ((const LAS unsigned char*)(offt + 2 * E + 4))[T];
        u.e = e; u.pn = (int)(L % npn); u.pm = T - offt[e]; u.r0 = T * BM; u.A = gather ? A : A + (size_t)T * a_tile; u.B = B + (size_t)e * b_exp + (size_t)u.pn * b_tile; return true; }
    __device__ __forceinline__ int row(const Unit& u, int r) const { const int rank = u.pm * BM + r; if (u.e == E) return rank; const int n = offt[E + 2 + u.e]; return rank < n ? tok[(size_t)u.e * M + rank] : 0; }
};
__device__ __forceinline__ float sat_fp8(float v) { return __builtin_amdgcn_fmed3f(v, -448.0f, 448.0f); }
__device__ __forceinline__ unsigned pack_fp8x4(float a, float b, float c, float d) { int w = __builtin_amdgcn_cvt_pk_fp8_f32(sat_fp8(a), sat_fp8(b), 0, false); return (unsigned)__builtin_amdgcn_cvt_pk_fp8_f32(sat_fp8(c), sat_fp8(d), w, true); }
constexpr float F8_H = 4.0f, F8_GU = 32.0f, F8_ACT = 8.0f, F8_DN = 16.0f, F8_Y = 16.0f;
struct EpiM1F8 {
    static constexpr bool PERM = true; static constexpr bool PROBE2 = false;
    unsigned char* ws;
    __device__ __forceinline__ void operator()(AccRef acc, const Unit& u, int wr, int wc, int fr, int fq) const {
        constexpr float inv = 1.0f / (F8_H * F8_GU); unsigned char* act = ws + WS_ACT;
#pragma unroll
        for (int ai = 0; ai < 2; ++ai)
#pragma unroll
            for (int m = 0; m < 4; ++m) { const int row = u.r0 + ai * HALFT + wr * 64 + m * 16 + fr; f32x4 v[2];
#pragma unroll
                for (int n = 0; n < 2; ++n)
#pragma unroll
                    for (int j = 0; j < 4; ++j) v[n][j] = fast_silu(acc[ai][0][m][n][j] * inv) * (acc[ai][1][m][n][j] * (inv * F8_ACT));
                u32x2 w; w.x = pack_fp8x4(v[0][0], v[0][1], v[0][2], v[0][3]); w.y = pack_fp8x4(v[1][0], v[1][1], v[1][2], v[1][3]);
                *(u32x2*)(act + (size_t)row * FF + u.pn * HALFT + wc * 32 + 8 * fq) = w; }
    }
};
template <int NPN, bool GATH, size_t A_OFF, size_t B_OFF, long B_EXP, long B_TILE, long A_TILE>
struct OrderMoeT {
    const unsigned char* ws; int G, c;
    __device__ __forceinline__ bool next(int i, Unit& u) const { const LAS int* offt = lds_tab();
#ifdef MOE_CONTIG
        if (i >= c) return false; const int L = G + i; const int T = L / NPN;
#else
        const long L = (long)i * G + c; const int T = (int)(L / NPN); if (T >= __builtin_amdgcn_readfirstlane(offt[E + 1])) return false;
#endif
        const int e = __builtin_amdgcn_readfirstlane((int)((const LAS unsigned char*)(offt + 2 * E + 4))[T]);
        u.e = e; u.pn = (int)(L % NPN); u.pm = T - __builtin_amdgcn_readfirstlane(offt[e]); u.r0 = T * BM; u.A = (const char*)ws + A_OFF + (GATH ? 0 : (size_t)T * A_TILE); u.B = (const char*)ws + B_OFF + (size_t)e * B_EXP + (size_t)u.pn * B_TILE; return true; }
    __device__ __forceinline__ int row(const Unit& u, int r) const { const int rank = u.pm * BM + r; if (u.e == E) return rank; const int n = lds_tab()[E + 2 + u.e]; return rank < n ? ((const int*)(ws + WS_TOK))[(size_t)u.e * M + rank] : 0; }
};
struct EpiM2F8 {
    static constexpr bool PERM = true; static constexpr bool PERM16 = true; static constexpr bool PROBE2 = false;
    unsigned char* ws;
    __device__ __forceinline__ void operator()(AccRef acc, const Unit& u, int wr, int wc, int fr, int fq) const {
        constexpr float w = F8_Y / (F8_ACT * F8_DN); unsigned char* Y = ws + WS_Y;
#pragma unroll
        for (int ai = 0; ai < 2; ++ai)
#pragma unroll
            for (int m = 0; m < 4; ++m) { const int rr = ai * HALFT + wr * 64 + m * 16 + fr; v4u o;
#pragma unroll
                for (int bj = 0; bj < 2; ++bj) { const f32x4 a = acc[ai][bj][m][0] * w, b = acc[ai][bj][m][1] * w; o[2 * bj] = pack_fp8x4(a[0], a[1], a[2], a[3]); o[2 * bj + 1] = pack_fp8x4(b[0], b[1], b[2], b[3]); }
                *(v4u*)(Y + (size_t)(u.r0 + rr) * D + u.pn * BM + wc * 64 + 16 * fq) = o; }
    }
};
struct EpiM1 {
    static constexpr bool PERM = true; static constexpr bool PROBE2 = false;
    bf16_t* act;
    __device__ __forceinline__ void operator()(AccRef acc, const Unit& u, int wr, int wc, int fr, int fq) const {
#pragma unroll
        for (int ai = 0; ai < 2; ++ai)
#pragma unroll
            for (int m = 0; m < 4; ++m) { const int row = u.r0 + ai * HALFT + wr * 64 + m * 16 + fr; f32x4 v[2];
#pragma unroll
                for (int n = 0; n < 2; ++n)
#pragma unroll
                    for (int j = 0; j < 4; ++j) v[n][j] = fast_silu(acc[ai][0][m][n][j]) * acc[ai][1][m][n][j];
                *(v4u*)(act + (size_t)row * FF + u.pn * HALFT + wc * 32 + 8 * fq) = pack8(v[0], v[1]); }
    }
};
struct EpiM2 {
    static constexpr bool PERM = true; static constexpr bool PROBE2 = false;
    bf16_t* Y; const float* wt; const LAS int* offt; float osc;
    __device__ __forceinline__ void operator()(AccRef acc, const Unit& u, int wr, int wc, int fr, int fq) const {
        float w8[2][4]; const int nrow = u.e < E ? offt[E + 2 + u.e] : M;
#pragma unroll
        for (int ai = 0; ai < 2; ++ai)
#pragma unroll
            for (int m = 0; m < 4; ++m) { const int rank = u.pm * BM + ai * HALFT + wr * 64 + m * 16 + fr; w8[ai][m] = (u.e < E ? (rank < nrow ? wt[(size_t)u.e * M + rank] : 0.f) : 1.0f) * osc; }
#pragma unroll
        for (int ai = 0; ai < 2; ++ai)
#pragma unroll
            for (int m = 0; m < 4; ++m) { const int rr = ai * HALFT + wr * 64 + m * 16 + fr; const float w = w8[ai][m];
#pragma unroll
                for (int bj = 0; bj < 2; ++bj) *(v4u*)(Y + (size_t)(u.r0 + rr) * D + u.pn * BM + bj * HALFT + wc * 32 + 8 * fq) = pack8(acc[ai][bj][m][0] * w, acc[ai][bj][m][1] * w); }
    }
};
}

struct Frame { LAS unsigned char* lds; Ctx c; int wave, vcu, G;
    __device__ __forceinline__ int lane() const { return lane_id(); }
    __device__ __forceinline__ int tid() const { return wave * 64 + lane_id(); } };

struct CvtDesc { const float* src; unsigned char* dst; const float* sc; int ldw, Kd, f8; float mul; };
__device__ __forceinline__ void cvt_load(const CvtDesc& d, float (&v)[32], int lane) {
    const float* p = d.src + (size_t)(lane >> 3) * d.ldw + 4 * (lane & 7);
#pragma unroll
    for (int i = 0; i < 8; ++i) { const f32x4 t = __builtin_nontemporal_load((const f32x4*)(p + (size_t)(8 * i) * d.ldw));     v[4 * i] = t[0]; v[4 * i + 1] = t[1]; v[4 * i + 2] = t[2]; v[4 * i + 3] = t[3]; }
}
__device__ __forceinline__ void cvt_finish(const CvtDesc& d, float (&v)[32], LAS float* scr, int lane) {
    const int kr = lane >> 3, n4 = 4 * (lane & 7);
#pragma unroll
    for (int i = 0; i < 8; ++i) { const float m = (d.sc ? d.sc[8 * i + kr] : 1.0f) * d.mul;
#pragma unroll
        for (int e = 0; e < 4; ++e) scr[(8 * i + kr) * 33 + n4 + e] = v[4 * i + e] * m; }
    LDS_WAIT(); asm volatile("" ::: "memory");
    const int cc = lane & 7;
#pragma unroll
    for (int j = 0; j < 4; ++j) { const int n = (lane >> 3) + 8 * j; const LAS float* s = scr + (8 * cc) * 33 + n;
        if (d.f8) { u32x2 o; o.x = pg8::pack_fp8x4(s[0 * 33], s[1 * 33], s[2 * 33], s[3 * 33]); o.y = pg8::pack_fp8x4(s[4 * 33], s[5 * 33], s[6 * 33], s[7 * 33]); __builtin_nontemporal_store(o, (u32x2*)(d.dst + (size_t)n * d.Kd + 8 * cc)); }
        else { v4u o; o.x = cvt_pk_bf16(s[0 * 33], s[1 * 33]); o.y = cvt_pk_bf16(s[2 * 33], s[3 * 33]); o.z = cvt_pk_bf16(s[4 * 33], s[5 * 33]); o.w = cvt_pk_bf16(s[6 * 33], s[7 * 33]); __builtin_nontemporal_store(o, (v4u*)(d.dst + (size_t)n * d.Kd + 16 * cc)); } }
    LDS_WAIT(); asm volatile("" ::: "memory");
}
__device__ __forceinline__ CvtDesc mk_desc(const float* src, int ldw, int k0, int ns0, void* dst, int Kd_elems, int nd0, int kd0, const float* sc, int f8 = 0, float mul = 1.0f) {
    CvtDesc d; d.src = src + (size_t)k0 * ldw + ns0; d.ldw = ldw; d.f8 = f8; d.mul = mul; d.sc = sc ? sc + k0 : nullptr; const int eb = f8 ? 1 : 2; d.Kd = Kd_elems * eb;
    d.dst = (unsigned char*)dst + ((size_t)nd0 * Kd_elems + kd0 + k0) * eb; return d; }
constexpr long cnt_items(int K, int N) { return (long)(K / 64) * (N / 32); }
constexpr long IT_INAB = 0, IT_UQ = IT_INAB + cnt_items(D, AB_N), IT_UKV = IT_UQ + cnt_items(QR, H_A * QK), IT_LRU = IT_UKV + cnt_items(KVR, H_A * (NOPE + VD)),
    IT_OUTAB = IT_LRU + (long)2 * (LW / LBS) * 2 * 4 * cnt_items(LBS, LBS), IT_RT = IT_OUTAB + cnt_items(D, D), IT_GU0 = IT_RT + 2 * cnt_items(D, E), IT_DN0 = IT_GU0 + (long)(E + 1) * 2 * cnt_items(D, FF),
    IT_INCD = IT_DN0 + (long)(E + 1) * cnt_items(FF, D), IT_OUTCD = IT_INCD + cnt_items(D, CD_N), IT_GU1 = IT_OUTCD + cnt_items(D, D), IT_DN1 = IT_GU1 + (long)(E + 1) * 2 * cnt_items(D, FF), IT_END = IT_DN1 + (long)(E + 1) * cnt_items(FF, D);
__device__ __forceinline__ CvtDesc p0_desc(const Ctx& c, long it) {
#ifdef MOE_FP8
    constexpr int MF8 = 1; constexpr float MGU = pg8::F8_GU, MDN = pg8::F8_DN;
#else
    constexpr int MF8 = 0; constexpr float MGU = 1.0f, MDN = 1.0f;
#endif
    const int sub = (int)(it & 1);
    if (it < IT_UQ) { const long r = (it - IT_INAB) >> 1; constexpr int NBK = AB_N / 32; const int kb = 2 * (int)(r / NBK) + sub, nb = (int)(r % NBK); const int col = nb * 32; const int drow = col < QR + KVR ? col : (col < QR + KVR + ROPE ? P0_N + col - (QR + KVR) : col - ROPE);
        return mk_desc(c.in[I_WINAB], AB_N, kb * 64, col, WSP(bf16_t, W_INAB), D, drow, 0, nullptr); }
    if (it < IT_UKV) { const long r = (it - IT_UQ) >> 1; constexpr int NBK = H_A * QK / 32; const int kb = 2 * (int)(r / NBK) + sub, db = (int)(r % NBK); const int v = db * 32; int scol;
        if (v < H_A * NOPE) { const int h = v / NOPE, d0 = v % NOPE; scol = h * QK + d0; }
        else { const int v2 = v - H_A * NOPE; const int tq = v2 / 256, half = (v2 % 256) / 128, hq = (v2 % 128) / 32; scol = (4 * tq + hq) * QK + NOPE + (ROPE / 2) * half; }
        return mk_desc(c.in[I_WUQ], H_A * QK, kb * 64, scol, WSP(bf16_t, W_UQ), QR, v, 0, c.in[I_QLN]); }
    if (it < IT_LRU) { const long r = (it - IT_UKV) >> 1; constexpr int NBK = H_A * (NOPE + VD) / 32; const int kb = 2 * (int)(r / NBK) + sub, nb = (int)(r % NBK);
        return mk_desc(c.in[I_WUKV], H_A * (NOPE + VD), kb * 64, nb * 32, WSP(bf16_t, W_UKV), KVR, nb * 32, 0, c.in[I_KVLN]); }
    if (it < IT_OUTAB) { const long r = (it - IT_LRU) >> 1; constexpr int NBK = LBS / 32, PER = (LBS / 128) * NBK; const int q = (int)(r / PER), w = (int)(r % PER); const int tap = q & 3, half = (q >> 2) & 1, tq = q >> 3, g = tq >> 1, d = tq & 1; const int kb = 2 * (w / NBK) + sub, nb = w % NBK;
        const float* src = (half ? c.in[I_LWX] : c.in[I_LWA]) + ((size_t)(d * (LW / LBS) + g) * LBS) * LBS;
        return mk_desc(src, LBS, kb * 64, nb * 32, WSP(bf16_t, W_LRU) + (size_t)tq * 2 * LBS * 4 * LBS, 4 * LBS, half * LBS + nb * 32, tap * LBS, c.in[I_CONVW] + tap * LW + g * LBS); }
    if (it < IT_RT) { const long r = (it - IT_OUTAB) >> 1; constexpr int NBK = D / 32; return mk_desc(c.in[I_WOUTAB], D, (2 * (int)(r / NBK) + sub) * 64, (int)(r % NBK) * 32, WSP(bf16_t, W_OUTAB), D, (int)(r % NBK) * 32, 0, nullptr); }
    if (it < IT_GU0) { const long r = (it - IT_RT) >> 1; constexpr int NBK = E / 32; constexpr long PER = (long)(D / 128) * NBK; const int l = (int)(r / PER); const long w = r % PER;
        return mk_desc(c.in[I_WROUTER] + (size_t)l * D * E, E, (2 * (int)(w / NBK) + sub) * 64, (int)(w % NBK) * 32, WSP(bf16_t, W_RT) + (size_t)l * E * D, D, (int)(w % NBK) * 32, 0, nullptr); }
    if (it < IT_INCD || (it >= IT_GU1)) {
        const int l = it >= IT_GU1 ? 1 : 0; const long base_gu = l ? IT_GU1 : IT_GU0, base_dn = l ? IT_DN1 : IT_DN0;
        if (it < base_dn) { const long r = (it - base_gu) >> 1; constexpr int NBK = FF / 32; constexpr long PER = (long)(D / 128) * NBK; const long q = r / PER, w = r % PER; const int up = (int)(q & 1), e = (int)(q >> 1); const int kb = 2 * (int)(w / NBK) + sub, nb = (int)(w % NBK); const int col = nb * 32;
            const float* src = e < E ? (up ? c.in[I_WUP] : c.in[I_WGATE]) + ((size_t)l * E + e) * D * FF : (up ? c.in[I_WSU] : c.in[I_WSG]) + (size_t)l * D * FF;
            return mk_desc(src, FF, kb * 64, col, c.ws + W_GU + ((size_t)l * (E + 1) + e) * 2 * FF * D * (MF8 ? 1 : 2), D, (col / 128) * 256 + up * 128 + (col % 128), 0, nullptr, MF8, MGU); }
        { const long r = (it - base_dn) >> 1; constexpr int NBK = D / 32; constexpr long PER = (long)(FF / 128) * NBK; const int e = (int)(r / PER); const long w = r % PER;
            const float* src = e < E ? c.in[I_WDOWN] + ((size_t)l * E + e) * FF * D : c.in[I_WSD] + (size_t)l * FF * D;
            return mk_desc(src, D, (2 * (int)(w / NBK) + sub) * 64, (int)(w % NBK) * 32, c.ws + W_DN + ((size_t)l * (E + 1) + e) * D * FF * (MF8 ? 1 : 2), FF, (int)(w % NBK) * 32, 0, nullptr, MF8, MDN); } }
    if (it < IT_OUTCD) { const long r = (it - IT_INCD) >> 1; constexpr int NBK = CD_N / 32; return mk_desc(c.in[I_WINCD], CD_N, (2 * (int)(r / NBK) + sub) * 64, (int)(r % NBK) * 32, WSP(bf16_t, W_INCD), D, (int)(r % NBK) * 32, 0, nullptr); }
    { const long r = (it - IT_OUTCD) >> 1; constexpr int NBK = D / 32; return mk_desc(c.in[I_WOUTCD], D, (2 * (int)(r / NBK) + sub) * 64, (int)(r % NBK) * 32, WSP(bf16_t, W_OUTCD), D, (int)(r % NBK) * 32, 0, nullptr); }
}
__device__ __forceinline__ void conv_items(Frame& F, long lo, long hi, int pidx = -1, int np = 0) {
    if (pidx < 0) { pidx = F.vcu; np = F.G; }
    const Ctx& c = F.c; LAS float* scr = (LAS float*)(F.lds + F.wave * 16384); const int lane = F.lane(); const long step = 2 * (long)np * NWAVES;
    long it = lo + 2 * ((long)pidx * NWAVES + F.wave); float va[32], vb[32];
    if (it < hi) { CvtDesc da = p0_desc(c, it); cvt_load(da, va, lane);
        for (;;) {
            CvtDesc db = p0_desc(c, it + 1); cvt_load(db, vb, lane);
            cvt_finish(da, va, scr, lane);
            const long i2 = it + step; const bool h2 = i2 < hi; if (h2) { da = p0_desc(c, i2); cvt_load(da, va, lane); }
            cvt_finish(db, vb, scr, lane); if (!h2) break;
            it = i2; } }
}
__device__ __forceinline__ void conv_slice(Frame& F, long lo, long hi, int k0, int k1, int n, int pidx = -1, int np = 0) { const long npair = (hi - lo) / 2; conv_items(F, lo + 2 * (npair * k0 / n), lo + 2 * (npair * k1 / n), pidx, np); }
__device__ __forceinline__ void mod_units(Frame& F, int l) {
    const Ctx& c = F.c; LAS float* cact = (LAS float*)F.lds; LAS float* red = (LAS float*)(F.lds + 65536);
    for (int i = F.tid(); i < NB * D; i += NTHR) cact[i] = siluf(c.in[I_C][i]);
    __syncthreads();
    constexpr int UW = 48, NU = 6 * D / UW, KW = D / NWAVES; static_assert(6 * D % UW == 0 && KW % 64 == 0 && NB * UW <= NTHR, "mod units");
    for (int u = F.vcu; u < NU; u += F.G) { const int col0 = u * UW; const int rg = F.lane() >> 4, cl = (F.lane() & 15) < 12 ? (F.lane() & 15) : 11;
        const float* w = c.in[I_WMOD] + (size_t)l * D * 6 * D + col0 + 4 * cl; f32x4 a[NB];
#pragma unroll
        for (int b = 0; b < NB; ++b) a[b] = f32x4{0.f, 0.f, 0.f, 0.f};
        const int kbeg = F.wave * KW + rg;
#pragma unroll 1
        for (int i0 = 0; i0 < KW / 4; i0 += 16) { f32x4 wv[16];
#pragma unroll
            for (int j = 0; j < 16; ++j) wv[j] = __builtin_nontemporal_load((const f32x4*)(w + (size_t)(kbeg + 4 * (i0 + j)) * 6 * D));
#pragma unroll
            for (int j = 0; j < 16; ++j) { const int k = kbeg + 4 * (i0 + j);
#pragma unroll
                for (int b = 0; b < NB; ++b) a[b] += wv[j] * cact[b * D + k]; } }
#pragma unroll
        for (int b = 0; b < NB; ++b)
#pragma unroll
            for (int q = 0; q < 4; ++q) { float s = a[b][q]; s += __shfl_xor(s, 16); s += __shfl_xor(s, 32); a[b][q] = s; }
        if (F.lane() < 12) {
#pragma unroll
            for (int b = 0; b < NB; ++b) *(LAS f32x4*)(red + (F.wave * NB + b) * UW + 4 * F.lane()) = a[b]; }
        __syncthreads();
        if (F.tid() < NB * UW) { const int b = F.tid() / UW, cc = F.tid() % UW; float s = c.in[I_BMOD][l * 6 * D + col0 + cc];
#pragma unroll
            for (int w8 = 0; w8 < NWAVES; ++w8) s += red[(w8 * NB + b) * UW + cc];
            WSP(float, WS_MOD)[((size_t)l * NB + b) * 6 * D + col0 + cc] = s; }
        __syncthreads();
    }
    __syncthreads();
}

__device__ __forceinline__ void p0_phase(Frame& F) {
    const Ctx& c = F.c;
    mod_units(F, 0);
#ifndef SPREAD_CONV
    mod_units(F, 1);
#endif
    const long gt = (long)F.vcu * NTHR + F.tid(), NGT = (long)F.G * NTHR;
    for (long i = gt; i < (long)S * (ROPE / 2 + DK / 2); i += NGT) { TabF f; f.c = c; f(i); }
    static_assert(LBS % 64 == 0 && LBS % NWAVES == 0, "gate bias units");
    for (int u = F.vcu; u < 4 * LW / 64; u += F.G) { const int i = u * 64 + F.lane(); const int ch = i % LW, half = (i / LW) & 1, d = i / (2 * LW); const int g = ch / LBS, j = ch % LBS;
        LAS float* red = (LAS float*)(F.lds + 65536);
        const float* wm = (half ? c.in[I_LWX] : c.in[I_LWA]) + ((size_t)(d * (LW / LBS) + g) * LBS) * LBS + j; float s = 0.f;
#pragma unroll
        for (int kk = 0; kk < LBS / NWAVES; ++kk) { const int k = F.wave * (LBS / NWAVES) + kk; s += c.in[I_CONVB][g * LBS + k] * wm[(size_t)k * LBS]; }
        red[F.wave * 64 + F.lane()] = s; __syncthreads();
        if (F.wave == 0) { float t = (half ? c.in[I_LBX] : c.in[I_LBA])[d * LW + ch];
#pragma unroll
            for (int w8 = 0; w8 < NWAVES; ++w8) t += red[w8 * 64 + F.lane()];
            WSP(float, W_GB)[i] = t; }
        __syncthreads(); }
    for (long i = gt; i < 2 * LW; i += NGT) WSP(float, W_GB)[4 * LW + i] = -8.0f * log1pf(expf(-c.in[I_LLAM][i]));
    for (long i = gt; i < (long)NB * 4 * LW; i += NGT) { const int b = (int)(i / (4 * LW)), rr = (int)((i / LW) % 4), ch = (int)(i % LW); WSP(bf16_t, WS_LXP)[((size_t)b * (S + 4) + (rr < 2 ? rr : S + rr)) * LW + ch] = 0; }
    __syncthreads();
#ifdef SPREAD_CONV
    conv_items(F, IT_INAB, IT_OUTAB);
#else
    conv_items(F, IT_INAB, IT_END);
#endif
}
__device__ __forceinline__ void build_offt(Frame& F, int l) {
    LAS int* offt = (LAS int*)(F.lds + TAB_OFF); static_assert(E <= 64, "one lane per routed expert");
    if (F.wave == 0) { const int lane = F.lane(); LAS unsigned char* texp = (LAS unsigned char*)(offt + 2 * E + 4);
        const int n = lane < E ? __hip_atomic_load((const int*)(F.c.ws + CTL_CNT) + cnt_idx(l, lane), RLX_AGENT) : 0; const int nt = (n + RT - 1) / RT; int inc = nt;
#pragma unroll
        for (int o = 1; o < 64; o <<= 1) { const int v = __shfl_up(inc, o); if (lane >= o) inc += v; }
        const int off = inc - nt, tot = __shfl(inc, 63); constexpr int NTS = (M + RT - 1) / RT;
        if (lane < E) { offt[lane] = off; offt[E + 2 + lane] = n; for (int t = 0; t < nt; ++t) texp[off + t] = (unsigned char)lane; }
        if (lane == 0) { offt[E] = tot; offt[E + 1] = tot + NTS; }
        for (int t = lane; t < NTS; t += 64) texp[tot + t] = (unsigned char)E; }
    __syncthreads();
}

__device__ __forceinline__ void modulate_row(const float* xrow, const float* gain, const float* sc, const float* sh, bf16_t* orow, int lane, unsigned char* orow8 = nullptr) {
    f32x4 v[D / 256]; float s = 0.f;
#pragma unroll
    for (int j = 0; j < D / 256; ++j) { v[j] = *((const f32x4*)xrow + lane + 64 * j); s += (v[j][0] * v[j][0] + v[j][1] * v[j][1]) + (v[j][2] * v[j][2] + v[j][3] * v[j][3]); }
    const float r = 1.0f / sqrtf(wave_sum(s) * (1.0f / D) + EPS);
#pragma unroll
    for (int j = 0; j < D / 256; ++j) { const int col = 4 * lane + 256 * j; const f32x4 g = *(const f32x4*)(gain + col), a = *(const f32x4*)(sc + col), b = *(const f32x4*)(sh + col);
        const f32x4 o = v[j] * r * g * (1.0f + a) + b; u32x2 w; w.x = cvt_pk_bf16(o[0], o[1]); w.y = cvt_pk_bf16(o[2], o[3]); *(u32x2*)(orow + col) = w;
        if (orow8) *(unsigned*)(orow8 + col) = pg8::pack_fp8x4(o[0] * pg8::F8_H, o[1] * pg8::F8_H, o[2] * pg8::F8_H, o[3] * pg8::F8_H); }
}
template <int NR> __device__ __forceinline__ void modulate_rows(const float* X, int m0, const float* gain, const float* sc, const float* sh, bf16_t* HM, unsigned char* HM8, int lane) {
    f32x4 v[NR][D / 256]; float s[NR];
#pragma unroll
    for (int r = 0; r < NR; ++r) { s[r] = 0.f;
#pragma unroll
        for (int j = 0; j < D / 256; ++j) v[r][j] = *((const f32x4*)(X + (size_t)(m0 + r) * D) + lane + 64 * j); }
#pragma unroll
    for (int r = 0; r < NR; ++r)
#pragma unroll
        for (int j = 0; j < D / 256; ++j) s[r] += (v[r][j][0] * v[r][j][0] + v[r][j][1] * v[r][j][1]) + (v[r][j][2] * v[r][j][2] + v[r][j][3] * v[r][j][3]);
#pragma unroll
    for (int o = 1; o < 64; o <<= 1)
#pragma unroll
        for (int r = 0; r < NR; ++r) s[r] += __shfl_xor(s[r], o);
#pragma unroll
    for (int j = 0; j < D / 256; ++j) { const int col = 4 * lane + 256 * j; const f32x4 g = *(const f32x4*)(gain + col), a = *(const f32x4*)(sc + col), b = *(const f32x4*)(sh + col);
#pragma unroll
        for (int r = 0; r < NR; ++r) { const float rs = 1.0f / sqrtf(s[r] * (1.0f / D) + EPS); const f32x4 o = v[r][j] * rs * g * (1.0f + a) + b; u32x2 w; w.x = cvt_pk_bf16(o[0], o[1]); w.y = cvt_pk_bf16(o[2], o[3]);
            *(u32x2*)(HM + (size_t)(m0 + r) * D + col) = w;
            if (HM8) *(unsigned*)(HM8 + (size_t)(m0 + r) * D + col) = pg8::pack_fp8x4(o[0] * pg8::F8_H, o[1] * pg8::F8_H, o[2] * pg8::F8_H, o[3] * pg8::F8_H); } }
}
__device__ __forceinline__ void modulate_phase(Frame& F, const float* X, const float* gain, const float* sc, const float* sh) {
    const int gw = F.vcu * NWAVES + F.wave, NGW = F.G * NWAVES;
    for (int m0 = 4 * gw; m0 < M; m0 += 4 * NGW) { const int b = m0 / S;
        modulate_rows<4>(X, m0, gain, sc + (size_t)b * 6 * D, sh + (size_t)b * 6 * D, (bf16_t*)(F.c.ws + WS_HM), nullptr, F.lane()); }
}
__device__ __forceinline__ void skinny32x64(Frame& F, const bf16_t* A, const bf16_t* Bt) {
    const int r = F.lane() & 31, h = F.lane() >> 5; constexpr int KW = D / NWAVES; const int k0 = F.wave * KW;
    f32x16 acc0 = {}, acc1 = {};
    const bf16_t* ap = A + (size_t)r * D + k0 + 8 * h; const bf16_t* b0p = Bt + (size_t)r * D + k0 + 8 * h; const bf16_t* b1p = Bt + (size_t)(32 + r) * D + k0 + 8 * h;
#pragma unroll 4
    for (int s = 0; s < KW / 16; ++s) { const bf16x8 a = *(const bf16x8*)(ap + 16 * s), b0 = *(const bf16x8*)(b0p + 16 * s), b1 = *(const bf16x8*)(b1p + 16 * s);
        acc0 = __builtin_amdgcn_mfma_f32_32x32x16_bf16(a, b0, acc0, 0, 0, 0); acc1 = __builtin_amdgcn_mfma_f32_32x32x16_bf16(a, b1, acc1, 0, 0, 0); }
    LAS float* red = (LAS float*)F.lds;
#pragma unroll
    for (int q = 0; q < 16; ++q) { const int row = (q & 3) + 8 * (q >> 2) + 4 * h; red[(F.wave * 32 + row) * 64 + r] = acc0[q]; red[(F.wave * 32 + row) * 64 + 32 + r] = acc1[q]; }
    __syncthreads();
    LAS float* res = (LAS float*)(F.lds + 65536);
    { const int row = F.tid() >> 4, c4 = (F.tid() & 15) * 4; f32x4 s = *(const LAS f32x4*)(red + row * 64 + c4);
#pragma unroll
      for (int w = 1; w < NWAVES; ++w) s += *(const LAS f32x4*)(red + (w * 32 + row) * 64 + c4);
      *(LAS f32x4*)(res + row * 64 + c4) = s; }
    __syncthreads();
}
__device__ __forceinline__ void krope_units(Frame& F) {
    const Ctx& c = F.c;
    for (int u = F.vcu; u < M / 32; u += F.G) { const int row0 = u * 32;
        skinny32x64(F, WSP(bf16_t, WS_HM) + (size_t)row0 * D, WSP(bf16_t, W_INAB) + (size_t)P0_N * D);
        const LAS float* res = (const LAS float*)(F.lds + 65536);
        { const int row = F.tid() >> 4, i0 = (F.tid() & 15) * 2; const int m = row0 + row, t = m % S; float o1[2], o2[2];
#pragma unroll
          for (int q = 0; q < 2; ++q) { const int ii = i0 + q; const float x1 = res[row * 64 + ii], x2 = res[row * 64 + 32 + ii], cs = WSP(float, WS_TAB + TAB_CR)[t * (ROPE / 2) + ii], sn = WSP(float, WS_TAB + TAB_SR)[t * (ROPE / 2) + ii];
              o1[q] = x1 * cs - x2 * sn; o2[q] = x2 * cs + x1 * sn; }
          const unsigned w1 = cvt_pk_bf16(o1[0], o1[1]), w2 = cvt_pk_bf16(o2[0], o2[1]);
#pragma unroll
          for (int hh = 0; hh < H_A; ++hh) { bf16_t* K = WSP(bf16_t, WS_KC) + ((size_t)m * H_A + hh) * QK + NOPE; *(unsigned*)(K + i0) = w1; *(unsigned*)(K + ROPE / 2 + i0) = w2; } }
        __syncthreads();
    }
}
__device__ __forceinline__ float wave_max(float v) {
#pragma unroll
    for (int o = 1; o < 64; o <<= 1) v = fmaxf(v, __shfl_xor(v, o));
    return v; }
__device__ __forceinline__ void route_phase(Frame& F, int l) {
    const Ctx& c = F.c; const float* mod = WSP(float, WS_MOD) + (size_t)l * NB * 6 * D; const float* X1 = WSP(float, WS_X1);
    for (int u = F.vcu; u < M / 32; u += F.G) { const int row0 = u * 32;
        { const int m0 = row0 + F.wave * 4; const int b = m0 / S;
          modulate_rows<4>(X1, m0, c.in[I_NFFN] + l * D, mod + (size_t)b * 6 * D + 4 * D, mod + (size_t)b * 6 * D + 3 * D, WSP(bf16_t, WS_HM), WSP(unsigned char, WS_HM8), F.lane()); }
        __syncthreads();
        skinny32x64(F, WSP(bf16_t, WS_HM) + (size_t)row0 * D, WSP(bf16_t, W_RT) + (size_t)l * E * D);
        const LAS float* res = (const LAS float*)(F.lds + 65536);
        int* cnt = WSP(int, CTL_CNT); LAS int* lcnt = (LAS int*)(F.lds + 65536 + 8192);
        if (F.tid() < E) lcnt[F.tid()] = 0;
        __syncthreads();
        int pe[4], pr[4]; float pw[4];
#pragma unroll
        for (int q = 0; q < 4; ++q) { const int row = F.wave * 4 + q; const int lane = F.lane(), grp = lane >> 3;
            const float sg = 1.0f / (1.0f + expf(-res[row * 64 + lane])); const float bz = sg + c.in[I_RBIAS][l * E + lane];
            float m1 = bz; m1 = fmaxf(m1, __shfl_xor(m1, 1)); m1 = fmaxf(m1, __shfl_xor(m1, 2)); m1 = fmaxf(m1, __shfl_xor(m1, 4));
            const unsigned long long eq1 = __ballot(bz == m1); const int first = __builtin_ctz((unsigned)((eq1 >> (grp * 8)) & 0xffull));
            float m2 = ((lane & 7) == first) ? -INFINITY : bz; m2 = fmaxf(m2, __shfl_xor(m2, 1)); m2 = fmaxf(m2, __shfl_xor(m2, 2)); m2 = fmaxf(m2, __shfl_xor(m2, 4));
            const float gs = m1 + m2; unsigned gsel = 0u;
#pragma unroll 1
            for (int it = 0; it < TG; ++it) { const float cand = ((gsel >> grp) & 1u) ? -INFINITY : gs; const float mx = wave_max(cand); const unsigned long long eq = __ballot(cand == mx);
                gsel |= 1u << (__builtin_ctzll(eq) >> 3); }
            unsigned long long taken = 0ull; float wsum = 0.f; int my_e = 0; float my_s = 0.f;
#pragma unroll 1
            for (int k = 0; k < TOPK; ++k) { const float cand = (((gsel >> grp) & 1u) && !((taken >> lane) & 1ull)) ? bz : -INFINITY; const float mx = wave_max(cand); const unsigned long long eq = __ballot(cand == mx);
                const int ek = __builtin_ctzll(eq); taken |= 1ull << ek; const float sk = __shfl(sg, ek); wsum += sk; if (lane == k) { my_e = ek; my_s = sk; } }
            pe[q] = my_e; pw[q] = my_s / wsum * 2.5f; pr[q] = 0;
            if (lane < TOPK) pr[q] = __hip_atomic_fetch_add(lcnt + my_e, 1, __ATOMIC_RELAXED, __HIP_MEMORY_SCOPE_WORKGROUP); }
        __syncthreads();
        if (F.tid() < E) { const int n = lcnt[F.tid()]; lcnt[E + F.tid()] = n > 0 ? atomicAdd(cnt + cnt_idx(l, F.tid()), n) : 0; }
        __syncthreads();
#pragma unroll
        for (int q = 0; q < 4; ++q) { const int m = row0 + F.wave * 4 + q; const int lane = F.lane();
            if (lane < TOPK) { const int rank = lcnt[E + pe[q]] + pr[q];
                WSP(int, WS_SELE)[(size_t)m * TOPK + lane] = pe[q]; WSP(int, WS_SELR)[(size_t)m * TOPK + lane] = rank; WSP(float, WS_SELW)[(size_t)m * TOPK + lane] = pw[q];
                WSP(int, WS_TOK)[(size_t)pe[q] * M + rank] = m; WSP(float, WS_WT)[(size_t)pe[q] * M + rank] = pw[q]; } }
        __syncthreads();
    }
}
__device__ __forceinline__ void combine_phase(Frame& F, int l) {
    build_offt(F, l);
    const Ctx& c = F.c; const LAS int* offt = (const LAS int*)(F.lds + TAB_OFF); const float* X1 = WSP(float, WS_X1); float* X2 = WSP(float, WS_X2);
    const float* mod = WSP(float, WS_MOD) + (size_t)l * NB * 6 * D; const float* mod1 = WSP(float, WS_MOD) + (size_t)NB * 6 * D;
    const int gw = F.vcu * NWAVES + F.wave, NGW = F.G * NWAVES; static_assert(D == 2048, "lane l owns columns 16 l .. 16 l + 15 of each 1024-column half");
    for (int m = gw; m < M; m += NGW) { const int b = m / S; const int lane = F.lane();
        int e = 0, r = 0; float wsel = 1.0f; if (lane < TOPK) { e = WSP(int, WS_SELE)[(size_t)m * TOPK + lane]; r = WSP(int, WS_SELR)[(size_t)m * TOPK + lane]; wsel = WSP(float, WS_SELW)[(size_t)m * TOPK + lane]; }
        long rowi = (lane < TOPK) ? (long)offt[e] * RT + r : (long)offt[E] * RT + m;
        f32x4 acc[2][4];
#pragma unroll
        for (int h = 0; h < 2; ++h)
#pragma unroll
            for (int q = 0; q < 4; ++q) acc[h][q] = (f32x4){0.f, 0.f, 0.f, 0.f};
#pragma unroll 3
        for (int k = 0; k <= TOPK; ++k) { const long ri = __shfl(rowi, k); const float wk = __shfl(wsel, k); const unsigned char* yr = WSP(unsigned char, WS_Y) + (size_t)ri * D + 16 * lane;
#pragma unroll
            for (int h = 0; h < 2; ++h) { const v4u raw = __builtin_nontemporal_load((const v4u*)(yr + h * 1024));
#pragma unroll
                for (int q = 0; q < 4; ++q) { const auto lo = __builtin_amdgcn_cvt_pk_f32_fp8((int)raw[q], false), hi = __builtin_amdgcn_cvt_pk_f32_fp8((int)raw[q], true);
                    acc[h][q][0] += wk * lo[0]; acc[h][q][1] += wk * lo[1]; acc[h][q][2] += wk * hi[0]; acc[h][q][3] += wk * hi[1]; } } }
        float s = 0.f;
#pragma unroll
        for (int h = 0; h < 2; ++h)
#pragma unroll
            for (int q = 0; q < 4; ++q) { const int col = h * 1024 + 16 * lane + 4 * q; const f32x4 x = *(const f32x4*)(X1 + (size_t)m * D + col), g = *(const f32x4*)(mod + (size_t)b * 6 * D + 5 * D + col);
                acc[h][q] = x + g * (acc[h][q] * (1.0f / pg8::F8_Y)); s += (acc[h][q][0] * acc[h][q][0] + acc[h][q][1] * acc[h][q][1]) + (acc[h][q][2] * acc[h][q][2] + acc[h][q][3] * acc[h][q][3]);
                if (l == 0) *(f32x4*)(X2 + (size_t)m * D + col) = acc[h][q]; }
        const float rs = 1.0f / sqrtf(wave_sum(s) * (1.0f / D) + EPS);
#pragma unroll
        for (int h = 0; h < 2; ++h) {
            if (l == 0) { v4u w[2];
#pragma unroll
                for (int q = 0; q < 4; ++q) { const int col = h * 1024 + 16 * lane + 4 * q; const f32x4 g = *(const f32x4*)(c.in[I_NMIX] + D + col), a = *(const f32x4*)(mod1 + (size_t)b * 6 * D + D + col), bb = *(const f32x4*)(mod1 + (size_t)b * 6 * D + col);
                    const f32x4 o = acc[h][q] * rs * g * (1.0f + a) + bb; w[q >> 1][2 * (q & 1)] = cvt_pk_bf16(o[0], o[1]); w[q >> 1][2 * (q & 1) + 1] = cvt_pk_bf16(o[2], o[3]); }
                bf16_t* hp = WSP(bf16_t, WS_HM) + (size_t)m * D + h * 1024 + 16 * lane; *(v4u*)hp = w[0]; *(v4u*)(hp + 8) = w[1]; }
            else {
#pragma unroll
                for (int q = 0; q < 4; ++q) { const int col = h * 1024 + 16 * lane + 4 * q; const f32x4 g = *(const f32x4*)(c.in[I_FNORM] + col); *(f32x4*)(c.out + (size_t)m * D + col) = acc[h][q] * rs * g; } } }
    }
}
__device__ __forceinline__ void retnorm_phase(Frame& F) {
    const Ctx& c = F.c; const int gw = F.vcu * NWAVES + F.wave, NGW = F.G * NWAVES; static_assert(DK == 256, "one f32x4 per lane");
    for (int m = gw; m < M; m += NGW) { f32x4 v[H_C], g[H_C]; u32x2 raw[H_C]; float s[H_C];
#pragma unroll
        for (int h = 0; h < H_C; ++h) { const int col = h * DK + 4 * F.lane(); v[h] = *(const f32x4*)(WSP(float, WS_RET) + (size_t)m * HALF + col); g[h] = *(const f32x4*)(c.in[I_RETGN] + col); raw[h] = *(const u32x2*)(WSP(bf16_t, WS_PROJ) + (size_t)m * CD_N + 3 * H_C * DK + col);
            s[h] = (v[h][0] * v[h][0] + v[h][1] * v[h][1]) + (v[h][2] * v[h][2] + v[h][3] * v[h][3]); }
#pragma unroll
        for (int o = 1; o < 64; o <<= 1)
#pragma unroll
            for (int h = 0; h < H_C; ++h) s[h] += __shfl_xor(s[h], o);
#pragma unroll
        for (int h = 0; h < H_C; ++h) { const int col = h * DK + 4 * F.lane(); const float rs = 1.0f / sqrtf(s[h] * (1.0f / DK) + EPS); f32x4 o = v[h] * rs * g[h];
            o[0] *= __uint_as_float(raw[h].x << 16); o[1] *= __uint_as_float(raw[h].x & 0xffff0000u); o[2] *= __uint_as_float(raw[h].y << 16); o[3] *= __uint_as_float(raw[h].y & 0xffff0000u);
            u32x2 w; w.x = cvt_pk_bf16(o[0], o[1]); w.y = cvt_pk_bf16(o[2], o[3]); *(u32x2*)(WSP(bf16_t, WS_MIX) + (size_t)m * D + col) = w; } }
}
__device__ __forceinline__ void scan_phase(Frame& F) {
    const Ctx& c = F.c; constexpr int NCK = 64, CL = S / NCK, BLK = S * 16 + NCK * 16; static_assert(CL == 32 && 4 * BLK + 4 * NCK * 8 * 4 <= MISC_OFF, "scan LDS map");
    LAS unsigned char* lds = F.lds; LAS float* agg = (LAS float*)(lds + 4 * BLK);
#define SIDX(t) ((t) * 16 + ((t) >> 5) * 16)
    for (int u = F.vcu; u < NB * (LW / 8); u += F.G) { const int b = u / (LW / 8), c8 = u % (LW / 8);
#pragma unroll
        for (int q = 0; q < 4; ++q) { const bf16_t* src = (q & 1 ? WSP(bf16_t, WS_U) : WSP(bf16_t, WS_LA)) + lru_idx(q >> 1, b, 0, c8 * 8);
#pragma unroll
            for (int i = 0; i < S / NTHR; ++i) { const int t = F.tid() + NTHR * i; *(LAS v4u*)(lds + q * BLK + SIDX(t)) = *(const v4u*)(src + (size_t)t * 8); } }
        __syncthreads();
        const int ch = F.tid() & 7, ck = F.tid() >> 3; const LAS bf16_t* laf = (const LAS bf16_t*)(lds) + ch; const LAS bf16_t* uf = (const LAS bf16_t*)(lds + BLK) + ch;
        const LAS bf16_t* lab = (const LAS bf16_t*)(lds + 2 * BLK) + ch; const LAS bf16_t* ub = (const LAS bf16_t*)(lds + 3 * BLK) + ch;
        { float P = 1.f, H = 0.f;
#pragma unroll 8
          for (int i = 0; i < CL; ++i) { const int o = SIDX(ck * CL + i) / 2; const float a = __builtin_amdgcn_exp2f(LOG2E * bf2f(laf[o])); H = a * H + bf2f(uf[o]); P *= a; }
          agg[(0 * NCK + ck) * 8 + ch] = P; agg[(1 * NCK + ck) * 8 + ch] = H; P = 1.f; H = 0.f;
#pragma unroll 8
          for (int i = CL - 1; i >= 0; --i) { const int o = SIDX(ck * CL + i) / 2; const float a = __builtin_amdgcn_exp2f(LOG2E * bf2f(lab[o])); H = a * H + bf2f(ub[o]); P *= a; }
          agg[(2 * NCK + ck) * 8 + ch] = P; agg[(3 * NCK + ck) * 8 + ch] = H; }
        __syncthreads();
        static_assert(NCK == 64 && NWAVES == 8, "one lane per chunk, two (direction, channel) carries per wave");
#pragma unroll
        for (int i = 0; i < 2; ++i) { const int id = F.wave * 2 + i, dir = id >> 3, cc = id & 7; const int lane = F.lane(), k = dir ? NCK - 1 - lane : lane;
            float A = agg[((2 * dir) * NCK + k) * 8 + cc], B = agg[((2 * dir + 1) * NCK + k) * 8 + cc];
#pragma unroll
            for (int o = 1; o < 64; o <<= 1) { const float A2 = __shfl_up(A, o), B2 = __shfl_up(B, o); if (lane >= o) { B = A * B2 + B; A = A * A2; } }
            const float ex = __shfl_up(B, 1); agg[((2 * dir) * NCK + k) * 8 + cc] = lane ? ex : 0.f; }
        __syncthreads();
        { float hf[CL]; float H = agg[(0 * NCK + ck) * 8 + ch];
#pragma unroll
          for (int i = 0; i < CL; ++i) { const int o = SIDX(ck * CL + i) / 2; const float a = __builtin_amdgcn_exp2f(LOG2E * bf2f(laf[o])); H = a * H + bf2f(uf[o]); hf[i] = H; }
          H = agg[(2 * NCK + ck) * 8 + ch]; LAS bf16_t* so = (LAS bf16_t*)(lds + BLK) + ch;
#pragma unroll
          for (int i = CL - 1; i >= 0; --i) { const int o = SIDX(ck * CL + i) / 2; const float a = __builtin_amdgcn_exp2f(LOG2E * bf2f(lab[o])); H = a * H + bf2f(ub[o]); so[o] = f2bf(hf[i] + H); } }
        __syncthreads();
#pragma unroll
        for (int i = 0; i < S / NTHR; ++i) { const int t = F.tid() + NTHR * i; const size_t m = (size_t)b * S + t; const v4u sv = *(const LAS v4u*)(lds + BLK + SIDX(t)); const v4u gv = *(const v4u*)(WSP(bf16_t, WS_PROJ) + m * P0_N + QR + KVR + LW + c8 * 8);
            v4u o;
#pragma unroll
            for (int q = 0; q < 4; ++q) { const float a0 = __uint_as_float(sv[q] << 16) * __uint_as_float(gv[q] << 16), a1 = __uint_as_float(sv[q] & 0xffff0000u) * __uint_as_float(gv[q] & 0xffff0000u); o[q] = cvt_pk_bf16(a0, a1); }
            *(v4u*)(WSP(bf16_t, WS_MIX) + m * D + HALF + c8 * 8) = o; }
        __syncthreads();
    }
#undef SIDX
}
namespace attn {
#define ATT_KSWZ(row, colB, RS) ((row) * (RS) + ((colB) ^ (((row) & 7) << 4)))
__device__ __forceinline__ int crow(int r, int hi) { return (r & 3) + 8 * (r >> 2) + 4 * hi; }
__device__ __forceinline__ int v_st(int k, int c) { const int kk = (k & ~0xC) | ((k & 4) << 1) | ((k & 8) >> 1); return ((kk >> 3) * 4 + (c >> 5)) * 512 + ((kk & 7) * 32 + (c & 31)) * 2; }
__device__ __forceinline__ int v_rd_base(int lane) { return ((lane & 3) << 3) | (((lane >> 2) & 3) << 6) | (((lane >> 4) & 1) << 5) | (((lane >> 5) & 1) << 8); }
constexpr int v_rd_off(int d0, int ks, int half) { return d0 * 512 + ks * 4096 + half * 2048; }
template <int OFF> __device__ __forceinline__ s16x4 tr_read(int vb) { s16x4 r; asm volatile("ds_read_b64_tr_b16 %0, %1 offset:%2" : "=&v"(r) : "v"(vb), "i"(OFF) : "memory"); return r; }
template <int D0> __device__ __forceinline__ void pv_one(f32x16& od, int vb, bf16x8 pa0, bf16x8 pa1, bf16x8 pa2, bf16x8 pa3) {
    const s16x4 l0 = tr_read<v_rd_off(D0, 0, 0)>(vb), h0 = tr_read<v_rd_off(D0, 0, 1)>(vb), l1 = tr_read<v_rd_off(D0, 1, 0)>(vb), h1 = tr_read<v_rd_off(D0, 1, 1)>(vb);
    const s16x4 l2 = tr_read<v_rd_off(D0, 2, 0)>(vb), h2 = tr_read<v_rd_off(D0, 2, 1)>(vb), l3 = tr_read<v_rd_off(D0, 3, 0)>(vb), h3 = tr_read<v_rd_off(D0, 3, 1)>(vb);
    asm volatile("s_waitcnt lgkmcnt(0)" ::: "memory"); __builtin_amdgcn_sched_barrier(0);
#define ATT_PK(L, H) (bf16x8){L[0], L[1], L[2], L[3], H[0], H[1], H[2], H[3]}
    od = __builtin_amdgcn_mfma_f32_32x32x16_bf16(pa0, ATT_PK(l0, h0), od, 0, 0, 0);
    od = __builtin_amdgcn_mfma_f32_32x32x16_bf16(pa1, ATT_PK(l1, h1), od, 0, 0, 0);
    od = __builtin_amdgcn_mfma_f32_32x32x16_bf16(pa2, ATT_PK(l2, h2), od, 0, 0, 0);
    od = __builtin_amdgcn_mfma_f32_32x32x16_bf16(pa3, ATT_PK(l3, h3), od, 0, 0, 0);
#undef ATT_PK
}
template <int DQK, int MODE>
__device__ __forceinline__ void attn_unit(LAS unsigned char* lds, const int wave, const bf16_t* Qb, int ldq, const bf16_t* Kh, int ldk, const bf16_t* Vh, int ldv, int key0, int ntiles, int q0,
                                          float pa_, float pb_, bf16_t* Ob, float* Of, int ldo) {
    constexpr int KB = 64 * DQK * 2, VB = 64 * 128 * 2, NKP = DQK / 8, KPT = DQK / 64, RS = DQK * 2;
    constexpr int OFF_V = 2 * KB, OFF_WS = OFF_V + 2 * VB, OFF_LUT = OFF_WS + NWAVES * 64 * 4;
    const int wid = __builtin_amdgcn_readfirstlane(wave), lane = lane_id(), tid = wid * 64 + lane, r32 = lane & 31, hi = lane >> 5;
    LAS unsigned char* Kl = lds; LAS unsigned char* Vl = lds + OFF_V; LAS float* wsf = (LAS float*)(lds + OFF_WS) + wid * 64; const LAS float* lut = (const LAS float*)(lds + OFF_LUT);
    float m_reg = (MODE == 1) ? pa_ : -1e30f, l_reg = (MODE == 1) ? 1.0f : 0.f;
    f32x16 o[4] = {}; bf16x8 qr[DQK / 16];
    { const bf16_t* Qw = Qb + (size_t)(wid * 32 + r32) * ldq + hi * 8;
#pragma unroll
      for (int d0 = 0; d0 < DQK / 16; ++d0) qr[d0] = *(const bf16x8*)(Qw + d0 * 16); }
    constexpr bool REGK = (NTHR % NKP == 0) && ((NTHR / NKP) % 8 == 0);
    int koff[REGK ? 1 : KPT], kdst[REGK ? 1 : KPT];
#pragma unroll
    for (int i = 0; i < (REGK ? 1 : KPT); ++i) { const int p = tid + NTHR * i, key = p / NKP, c8 = p % NKP; koff[i] = key * ldk + c8 * 8; kdst[i] = ATT_KSWZ(key, c8 * 16, RS); }
#define ATT_KOFF(i) (REGK ? koff[0] + (i) * (NTHR / NKP) * ldk : koff[REGK ? 0 : (i)])
#define ATT_KDST(i) (REGK ? kdst[0] + (i) * (NTHR / NKP) * RS : kdst[REGK ? 0 : (i)])
    const int sr = tid >> 4, sc = (tid & 15) * 8, vst0 = v_st(sr, sc), vst1 = vst0 + 8192;
    const int vb0 = (int)(unsigned)(uintptr_t)Vl + v_rd_base(lane);
    bf16x8 ks[KPT], vs0, vs1;
#define ATT_SLOAD(kb) do { _Pragma("unroll") for (int i = 0; i < KPT; ++i) ks[i] = *(const bf16x8*)(Kh + (size_t)(kb) * ldk + ATT_KOFF(i)); \
        vs0 = *(const bf16x8*)(Vh + (size_t)((kb) + sr) * ldv + sc); vs1 = *(const bf16x8*)(Vh + (size_t)((kb) + 32 + sr) * ldv + sc); } while (0)
#define ATT_SWRITE(b) do { _Pragma("unroll") for (int i = 0; i < KPT; ++i) *(LAS bf16x8*)(Kl + (b) * KB + ATT_KDST(i)) = ks[i]; \
        *(LAS bf16x8*)(Vl + (b) * VB + vst0) = vs0; *(LAS bf16x8*)(Vl + (b) * VB + vst1) = vs1; } while (0)
    ATT_SLOAD(key0); ATT_SWRITE(0); __syncthreads();
    for (int j = 0; j < ntiles; ++j) {
        const int cur = j & 1; const int kb = key0 + j * 64;
        if (j + 1 < ntiles) ATT_SLOAD(kb + 64);
        bool live = true;
        if constexpr (MODE == 1) { const int qlo = q0 + wid * 32; live = (kb + 63 >= qlo - WIN) && (kb <= qlo + 31 + WIN); }
        if (live) {
        f32x16 p0 = {}, p1 = {};
        { const LAS unsigned char* Ks = Kl + cur * KB;
#pragma unroll
          for (int d0 = 0; d0 < DQK / 16; ++d0) { const int cb = (d0 * 16 + hi * 8) * 2;
              const bf16x8 b0 = *(const LAS bf16x8*)(Ks + ATT_KSWZ(r32, cb, RS)), b1 = *(const LAS bf16x8*)(Ks + ATT_KSWZ(32 + r32, cb, RS));
              p0 = __builtin_amdgcn_mfma_f32_32x32x16_bf16(b0, qr[d0], p0, 0, 0, 0); p1 = __builtin_amdgcn_mfma_f32_32x32x16_bf16(b1, qr[d0], p1, 0, 0, 0); } }
        if constexpr (MODE == 2) {
            const int dq = kb - (q0 + wid * 32 + r32);
#pragma unroll
            for (int r = 0; r < 16; ++r) { const int rel0 = dq + crow(r, hi), rel1 = rel0 + 32;
                p0[r] *= __builtin_amdgcn_exp2f((rel0 <= 0 ? pa_ : pb_) * (float)rel0); p1[r] *= __builtin_amdgcn_exp2f((rel1 <= 0 ? pa_ : pb_) * (float)rel1); }
        } else {
            if constexpr (MODE == 1) { const LAS float* lp = lut + (kb - (q0 + wid * 32 + r32) + 383);
#pragma unroll
                for (int r = 0; r < 16; ++r) { p0[r] += lp[crow(r, hi)]; p1[r] += lp[32 + crow(r, hi)]; } }
            float pmax = p0[0];
#pragma unroll
            for (int r = 1; r < 16; ++r) pmax = fmaxf(pmax, p0[r]);
#pragma unroll
            for (int r = 0; r < 16; ++r) pmax = fmaxf(pmax, p1[r]);
            { auto rr = __builtin_amdgcn_permlane32_swap(__float_as_uint(pmax), __float_as_uint(pmax), false, false); pmax = fmaxf(__uint_as_float(rr[0]), __uint_as_float(rr[1])); }
            float mn, alpha;
            if (__builtin_expect(__all(pmax - m_reg <= 11.5f), 1)) { mn = m_reg; alpha = 1.f; }
            else { mn = fmaxf(m_reg, pmax); alpha = __builtin_amdgcn_exp2f(m_reg - mn); m_reg = mn; }
#pragma unroll
            for (int r = 0; r < 16; ++r) { p0[r] = __builtin_amdgcn_exp2f(p0[r] - mn); p1[r] = __builtin_amdgcn_exp2f(p1[r] - mn); }
            float ps = 0.f;
#pragma unroll
            for (int r = 0; r < 16; ++r) ps += p0[r];
#pragma unroll
            for (int r = 0; r < 16; ++r) ps += p1[r];
            { auto rr = __builtin_amdgcn_permlane32_swap(__float_as_uint(ps), __float_as_uint(ps), false, false); ps = __uint_as_float(rr[0]) + __uint_as_float(rr[1]); }
            l_reg = l_reg * alpha + ps;
            if (__any(alpha < 1.f)) { if (hi == 0) wsf[32 + r32] = alpha; asm volatile("s_waitcnt lgkmcnt(0)" ::: "memory");
#pragma unroll
                for (int r = 0; r < 16; ++r) { const float a = wsf[32 + crow(r, hi)];
#pragma unroll
                    for (int d = 0; d < 4; ++d) o[d][r] *= a; } }
        }
        bf16x8 pa0, pa1, pa2, pa3;
#define ATT_PK4(P, BASE, OUT) do { unsigned a0 = cvt_pk_bf16(P[BASE + 0], P[BASE + 1]), a1 = cvt_pk_bf16(P[BASE + 2], P[BASE + 3]); \
        unsigned b0_ = cvt_pk_bf16(P[BASE + 4], P[BASE + 5]), b1_ = cvt_pk_bf16(P[BASE + 6], P[BASE + 7]); \
        auto r0 = __builtin_amdgcn_permlane32_swap(a0, b0_, false, false); auto r1 = __builtin_amdgcn_permlane32_swap(a1, b1_, false, false); \
        v4u w = {r0[0], r1[0], r0[1], r1[1]}; OUT = *reinterpret_cast<bf16x8*>(&w); } while (0)
        ATT_PK4(p0, 0, pa0); ATT_PK4(p0, 8, pa1); ATT_PK4(p1, 0, pa2); ATT_PK4(p1, 8, pa3);
#undef ATT_PK4
        { const int vb = vb0 + cur * VB; pv_one<0>(o[0], vb, pa0, pa1, pa2, pa3); pv_one<1>(o[1], vb, pa0, pa1, pa2, pa3); pv_one<2>(o[2], vb, pa0, pa1, pa2, pa3); pv_one<3>(o[3], vb, pa0, pa1, pa2, pa3); }
        }
        if (j + 1 < ntiles) ATT_SWRITE(cur ^ 1);
        __syncthreads();
    }
#undef ATT_SLOAD
#undef ATT_SWRITE
#undef ATT_KOFF
#undef ATT_KDST
    if constexpr (MODE == 2) {
#pragma unroll
        for (int r = 0; r < 16; ++r) { float* orow = Of + (size_t)(wid * 32 + crow(r, hi)) * ldo + r32;
#pragma unroll
            for (int d0 = 0; d0 < 4; ++d0) orow[d0 * 32] = o[d0][r]; }
    } else {
        if (hi == 0) wsf[r32] = l_reg; asm volatile("s_waitcnt lgkmcnt(0)" ::: "memory");
#pragma unroll
        for (int r = 0; r < 16; ++r) { const float rl = __builtin_amdgcn_rcpf(wsf[crow(r, hi)]); bf16_t* orow = Ob + (size_t)(wid * 32 + crow(r, hi)) * ldo + r32;
#pragma unroll
            for (int d0 = 0; d0 < 4; ++d0) orow[d0 * 32] = f2bf(o[d0][r] * rl); }
    }
    __syncthreads();
}
#undef ATT_KSWZ
}

__device__ __forceinline__ void att0_phase(Frame& F) {
    const Ctx& c = F.c;
    for (int u = F.vcu; u < NB * H_A * (S / 256); u += F.G) { const int qb = u % (S / 256), h = (u / (S / 256)) % H_A, b = u / ((S / 256) * H_A);
        attn::attn_unit<QK, 0>(F.lds, F.wave, WSP(bf16_t, WS_Q) + ((size_t)(b * S + qb * 256) * H_A + h) * QK, H_A * QK, WSP(bf16_t, WS_KC) + ((size_t)b * S * H_A + h) * QK, H_A * QK,
                               WSP(bf16_t, WS_V) + ((size_t)b * S * H_A + h) * VD, H_A * VD, 0, S / 64, qb * 256, 0.f, 0.f, WSP(bf16_t, WS_MIX) + (size_t)(b * S + qb * 256) * D + h * VD, nullptr, D); }
}
__device__ __forceinline__ void ret1_phase(Frame& F) {
    const Ctx& c = F.c;
    for (int u = F.vcu; u < NB * H_C * (S / 256) * 2; u += F.G) { const int dvh = u & 1, qb = (u >> 1) % (S / 256), h = (u / (2 * (S / 256))) % H_C, b = u / (2 * (S / 256) * H_C);
        const bf16_t* Pb = WSP(bf16_t, WS_PROJ) + (size_t)b * S * CD_N;
        const float lgf = log2f(1.0f - exp2f(-5.0f - (float)h)), lgb = log2f(1.0f - exp2f(-5.0f - (float)(H_C - 1 - h)));
        const int df = (int)(11.0f / -lgf) + 1, db = (int)(11.0f / -lgb) + 1; int t0 = (qb * 256 - df - 63) / 64; if (t0 < 0) t0 = 0; int t1 = (qb * 256 + 255 + db) / 64 + 1; if (t1 > S / 64) t1 = S / 64;
        attn::attn_unit<DK, 2>(F.lds, F.wave, Pb + (size_t)qb * 256 * CD_N + h * DK, CD_N, Pb + H_C * DK + h * DK, CD_N, Pb + 2 * H_C * DK + h * DK + dvh * 128, CD_N, t0 * 64, t1 - t0, qb * 256, -lgf, lgb,
                               nullptr, WSP(float, WS_RET) + (size_t)(b * S + qb * 256) * HALF + h * DK + dvh * 128, HALF); }
}
__device__ __forceinline__ void swa1_phase(Frame& F) {
    const Ctx& c = F.c; constexpr int OFF_LUT = 2 * 64 * HDS * 2 + 2 * 64 * 128 * 2 + NWAVES * 64 * 4; LAS float* lut = (LAS float*)(F.lds + OFF_LUT);
    for (int u = F.vcu; u < NB * H_D * (S / 256); u += F.G) { const int qb = u % (S / 256), hd = (u / (S / 256)) % H_D, b = u / ((S / 256) * H_D); const int kvh = hd / (H_D / KVH);
        for (int i = F.tid(); i < 767; i += NTHR) { const int rel = i - 383; lut[i] = (rel < -WIN || rel > WIN) ? -1e30f : c.in[I_RELB][t5_bucket(rel) * H_D + hd] * LOG2E; }
        __syncthreads();
        const bf16_t* Pb = WSP(bf16_t, WS_PROJ) + (size_t)b * S * CD_N + 4 * H_C * DK;
        const int klo = qb * 256 - WIN < 0 ? 0 : qb * 256 - WIN, khi = qb * 256 + 256 + WIN > S ? S : qb * 256 + 256 + WIN;
        attn::attn_unit<HDS, 1>(F.lds, F.wave, Pb + (size_t)qb * 256 * CD_N + hd * HDS, CD_N, Pb + H_D * HDS + kvh * HDS, CD_N, Pb + H_D * HDS + KVH * HDS + kvh * HDS, CD_N, klo, (khi - klo) / 64, qb * 256,
                                c.in[I_SINKS][hd] * LOG2E, 0.f, WSP(bf16_t, WS_MIX) + (size_t)(b * S + qb * 256) * D + HALF + hd * HDS, nullptr, D); }
}


#ifndef OPT_MASK
#define OPT_MASK 0
#endif
struct MArgs { Ctx c; long ph_lo, ph_hi, use_bar, pad; };
__global__ void __launch_bounds__(NTHR, 2) mega_fwd(MArgs args) {
    extern __shared__ __attribute__((aligned(16))) unsigned char lds_raw[];
    Frame F; F.lds = (LAS unsigned char*)lds_raw; F.c = args.c;
    F.wave = __builtin_amdgcn_readfirstlane((int)threadIdx.x >> 6);
    F.G = gridDim.x; { const int bx = blockIdx.x; F.vcu = (F.G % 8 == 0) ? (bx % 8) * (F.G / 8) + bx / 8 : bx; }
    const Ctx& c = F.c;
    volatile LAS unsigned* MISC = (volatile LAS unsigned*)(F.lds + MISC_OFF);
    for (int u = F.tid(); u < 256; u += NTHR) MISC[u] = 0u;
    __syncthreads();
    XcdBarrier bar; bar.bar = (unsigned*)(c.ws + 16384); bar.x = 0; bar.st = MISC + 8; bar.wave = F.wave;
    if (args.use_bar) bar = xcd_barrier_post((unsigned*)(c.ws + 16384), MISC + 8, F.wave);
    const int lo = (int)args.ph_lo, hi = (int)args.ph_hi;
#define IN(k) (lo <= (k) && (k) < hi)
#define SEAM(k) do { if (IN(k) && IN((k) + 1)) xcd_barrier(bar); } while (0)
    float* mod = WSP(float, WS_MOD);
#ifdef SPREAD_CONV
#define CONV_EARLY(call) do { if (!(blockIdx.x & 1)) { call; __syncthreads(); } } while (0)
#define CONV_LATE(call)  do { if (blockIdx.x & 1) { __syncthreads(); call; __syncthreads(); } } while (0)
#else
#define CONV_EARLY(call) do { } while (0)
#define CONV_LATE(call)  do { } while (0)
#endif
#define CONV_GU0(k0, k1) conv_slice(F, IT_GU0, IT_DN0, k0, k1, 20)
#define CONV_GU1(k0, k1) conv_slice(F, IT_GU1, IT_DN1, k0, k1, 17)

    if (IN(PH_P0)) { p0_phase(F); } SEAM(PH_P0);
#ifdef HAVE_THIN
    if (IN(PH_MOD0)) { modulate_phase(F, c.in[I_X], c.in[I_NMIX], mod + D, mod); } SEAM(PH_MOD0);
#endif
    if (IN(PH_G1)) {
        pg8::DenseOrder S_; S_.A = (const char*)WSP(bf16_t, WS_HM); S_.B = (const char*)WSP(bf16_t, W_INAB); S_.nM = M / 256; S_.nN = P0_N / 256; S_.G = F.G; S_.c = (int)blockIdx.x; S_.a_tile = (long)256 * D * 2; S_.b_tile = (long)256 * D * 2;
        pg8::EpiG1 E_{WSP(bf16_t, WS_PROJ), WSP(bf16_t, WS_LXP), WSP(float, CTL_SSQ)};
        pg8::gemm_phase<pg8::EpiG1, pg8::DenseOrder, pg8::APlain, false, true>(F.lds, F.wave, (const char*)c.ws, D, D, D, S_, E_);
#ifdef HAVE_SKINNY
        krope_units(F);
#endif
#ifdef SPREAD_CONV
        if ((int)blockIdx.x >= F.G / 2) { __syncthreads(); const int pi = (int)blockIdx.x - F.G / 2, np = F.G - F.G / 2;
            conv_items(F, IT_OUTAB, IT_GU0, pi, np); conv_slice(F, IT_GU0, IT_DN0, 0, 4, 20, pi, np); __syncthreads(); }
#endif
    } SEAM(PH_G1);
    if (IN(PH_G2)) {
        CONV_EARLY(CONV_GU0(4, 8));
        { pg8::OrderG2 S_{(const char*)WSP(bf16_t, WS_PROJ), (const char*)WSP(bf16_t, W_UQ), (const char*)WSP(bf16_t, W_UKV), F.G, (int)blockIdx.x};
          pg8::EpiG2 E_{WSP(bf16_t, WS_Q), WSP(bf16_t, WS_KC), WSP(bf16_t, WS_V), WSP(float, CTL_SSQ), WSP(float, WS_TAB + TAB_CR), WSP(float, WS_TAB + TAB_SR), LOG2E / sqrtf((float)QK)};
          pg8::gemm_phase<pg8::EpiG2, pg8::OrderG2, pg8::APlain, false, true>(F.lds, F.wave, (const char*)c.ws, P0_N, QR, QR, S_, E_); }
        { pg8::OrderGates S_{(const char*)WSP(bf16_t, WS_LXP), (const char*)WSP(bf16_t, W_LRU), F.G, (int)((blockIdx.x + F.G / 2) % F.G)};
          pg8::EpiGates E_{WSP(bf16_t, WS_LA), WSP(bf16_t, WS_U), WSP(bf16_t, WS_LXP), WSP(float, W_GB), WSP(float, W_GB) + 4 * LW, c.in[I_CONVW], c.in[I_CONVB]};
          pg8::gemm_phase<pg8::EpiGates, pg8::OrderGates, pg8::AConv, false, true>(F.lds, F.wave, (const char*)c.ws, LW, 4 * LBS, 4 * LBS, S_, E_); }
        CONV_LATE(CONV_GU0(4, 8));
    } SEAM(PH_G2);
#ifdef HAVE_THIN
    if (IN(PH_SCAN0)) { CONV_EARLY(CONV_GU0(8, 10)); scan_phase(F); CONV_LATE(CONV_GU0(8, 10)); }
#endif
#ifdef HAVE_ATT0
    if (IN(PH_ATT0)) { CONV_EARLY(CONV_GU0(10, 14)); att0_phase(F); CONV_LATE(CONV_GU0(10, 14)); } SEAM(PH_ATT0);
#endif
    if (IN(PH_OUT0)) {
        CONV_EARLY(CONV_GU0(14, 17));
        pg8::DenseOrder S_; S_.A = (const char*)WSP(bf16_t, WS_MIX); S_.B = (const char*)WSP(bf16_t, W_OUTAB); S_.nM = M / 256; S_.nN = D / 256; S_.G = F.G; S_.c = (int)blockIdx.x; S_.a_tile = (long)256 * D * 2; S_.b_tile = (long)256 * D * 2;
        pg8::EpiOut E_{c.in[I_X], WSP(float, WS_X1), mod + 2 * D};
        pg8::gemm_phase<pg8::EpiOut, pg8::DenseOrder, pg8::APlain, false, true>(F.lds, F.wave, (const char*)c.ws, D, D, D, S_, E_);
        CONV_LATE(CONV_GU0(14, 17));
    } SEAM(PH_OUT0);
#ifdef HAVE_RT
    if (IN(PH_RT0)) { CONV_EARLY(CONV_GU0(17, 20)); route_phase(F, 0); CONV_LATE(CONV_GU0(17, 20)); } SEAM(PH_RT0);
#endif
    if (IN(PH_M1_0)) {
#ifdef SPREAD_CONV
        mod_units(F, 1);
#endif
        CONV_EARLY(conv_items(F, IT_DN0, IT_GU1));
        build_offt(F, 0);
#ifdef MOE_FP8
        typedef pg8::OrderMoeT<2 * FF / 256, true, WS_HM8, W_GU + (size_t)0 * (E + 1) * 2 * FF * D, (long)2 * FF * D, (long)256 * D, 0> OM1;
#ifdef MOE_CONTIG
        const int tot1_ = ((const LAS int*)(F.lds + TAB_OFF))[E + 1] * (2 * FF / 256), lo1_ = (int)((long)tot1_ * F.vcu / F.G), hi1_ = (int)((long)tot1_ * (F.vcu + 1) / F.G);
        OM1 S_{c.ws, lo1_, hi1_ - lo1_};
#else
        OM1 S_{c.ws, F.G, F.vcu};
#endif
        pg8::EpiM1F8 E_{c.ws};
        pg8::gemm_phase<pg8::EpiM1F8, OM1, pg8::APlain, true, true, 1>(F.lds, F.wave, (const char*)c.ws, D / 2, D / 2, D / 2, S_, E_);
#else
        pg8::OrderMoe S_{(const LAS int*)(F.lds + TAB_OFF), (const char*)WSP(bf16_t, WS_HM), (const char*)WSP(bf16_t, W_GU), WSP(int, WS_TOK), 2 * FF / 256, F.G, F.vcu, 1, (long)2 * FF * D * 2, (long)256 * D * 2, 0};
        pg8::EpiM1 E_{WSP(bf16_t, WS_ACT)};
        pg8::gemm_phase<pg8::EpiM1, pg8::OrderMoe, pg8::APlain, true, true>(F.lds, F.wave, (const char*)c.ws, D, D, D, S_, E_);
#endif
        CONV_LATE(conv_items(F, IT_DN0, IT_GU1));
    } SEAM(PH_M1_0);
    if (IN(PH_M2_0)) { CONV_EARLY(CONV_GU1(0, 4)); build_offt(F, 0);
#ifdef MOE_FP8
        typedef pg8::OrderMoeT<D / 256, false, WS_ACT, W_DN + (size_t)0 * (E + 1) * D * FF, (long)D * FF, (long)256 * FF, (long)256 * FF> OM2;
#ifdef MOE_CONTIG
        const int tot2_ = ((const LAS int*)(F.lds + TAB_OFF))[E + 1] * (D / 256), lo2_ = (int)((long)tot2_ * F.vcu / F.G), hi2_ = (int)((long)tot2_ * (F.vcu + 1) / F.G);
        OM2 S_{c.ws, lo2_, hi2_ - lo2_};
#else
        OM2 S_{c.ws, F.G, F.vcu};
#endif
        pg8::EpiM2F8 E_{c.ws};
        pg8::gemm_phase<pg8::EpiM2F8, OM2, pg8::APlain, false, true, 1>(F.lds, F.wave, (const char*)c.ws, FF / 2, FF / 2, FF / 2, S_, E_);
#else
        pg8::OrderMoe S_{(const LAS int*)(F.lds + TAB_OFF), (const char*)WSP(bf16_t, WS_ACT), (const char*)WSP(bf16_t, W_DN), WSP(int, WS_TOK), D / 256, F.G, F.vcu, 0, (long)D * FF * 2, (long)256 * FF * 2, (long)256 * FF * 2};
        pg8::EpiM2 E_{WSP(bf16_t, WS_Y), WSP(float, WS_WT), (const LAS int*)(F.lds + TAB_OFF), 1.0f};
        pg8::gemm_phase<pg8::EpiM2, pg8::OrderMoe, pg8::APlain, false, true>(F.lds, F.wave, (const char*)c.ws, FF, FF, FF, S_, E_);
#endif
        CONV_LATE(CONV_GU1(0, 4));
    } SEAM(PH_M2_0);
#ifdef HAVE_THIN
    if (IN(PH_CMB0)) { CONV_EARLY(CONV_GU1(4, 6)); combine_phase(F, 0); CONV_LATE(CONV_GU1(4, 6)); } SEAM(PH_CMB0);
#endif
    if (IN(PH_G3)) {
        pg8::DenseOrder S_; S_.A = (const char*)WSP(bf16_t, WS_HM); S_.B = (const char*)WSP(bf16_t, W_INCD); S_.nM = M / 256; S_.nN = CD_N / 256; S_.G = F.G; S_.c = (int)blockIdx.x; S_.a_tile = (long)256 * D * 2; S_.b_tile = (long)256 * D * 2;
        pg8::EpiG3 E_{WSP(bf16_t, WS_PROJ), WSP(float, WS_TAB + TAB_CT), WSP(float, WS_TAB + TAB_ST), LOG2E / sqrtf((float)HDS)};
        pg8::gemm_phase<pg8::EpiG3, pg8::DenseOrder, pg8::APlain, false, true>(F.lds, F.wave, (const char*)c.ws, D, D, D, S_, E_);
#ifdef SPREAD_CONV
        { const int nu = (M / 256) * (CD_N / 256), rem = nu % F.G;
          if (rem != 0 && (int)blockIdx.x >= rem) { __syncthreads(); conv_slice(F, IT_GU1, IT_DN1, 6, 8, 17, (int)blockIdx.x - rem, F.G - rem); __syncthreads(); }
          else if (rem == 0) { __syncthreads(); CONV_GU1(6, 8); __syncthreads(); } }
#endif
    } SEAM(PH_G3);
#ifdef HAVE_RET1
    if (IN(PH_RET1)) { CONV_EARLY(CONV_GU1(8, 12)); ret1_phase(F); CONV_LATE(CONV_GU1(8, 12)); }
#endif
#ifdef HAVE_SWA1
    if (IN(PH_SWA1)) { CONV_EARLY(CONV_GU1(12, 13)); swa1_phase(F); CONV_LATE(CONV_GU1(12, 13)); } SEAM(PH_SWA1);
#endif
#ifdef HAVE_THIN
    if (IN(PH_RN1)) { retnorm_phase(F); } SEAM(PH_RN1);
#endif
    if (IN(PH_OUT1)) {
        CONV_EARLY(CONV_GU1(13, 15));
        pg8::DenseOrder S_; S_.A = (const char*)WSP(bf16_t, WS_MIX); S_.B = (const char*)WSP(bf16_t, W_OUTCD); S_.nM = M / 256; S_.nN = D / 256; S_.G = F.G; S_.c = (int)blockIdx.x; S_.a_tile = (long)256 * D * 2; S_.b_tile = (long)256 * D * 2;
        pg8::EpiOut E_{WSP(float, WS_X2), WSP(float, WS_X1), mod + (size_t)NB * 6 * D + 2 * D};
        pg8::gemm_phase<pg8::EpiOut, pg8::DenseOrder, pg8::APlain, false, true>(F.lds, F.wave, (const char*)c.ws, D, D, D, S_, E_);
        CONV_LATE(CONV_GU1(13, 15));
    } SEAM(PH_OUT1);
#ifdef HAVE_RT
    if (IN(PH_RT1)) { CONV_EARLY(CONV_GU1(15, 17)); route_phase(F, 1); CONV_LATE(CONV_GU1(15, 17)); } SEAM(PH_RT1);
#endif
    if (IN(PH_M1_1)) { CONV_EARLY(conv_items(F, IT_DN1, IT_END)); build_offt(F, 1);
#ifdef MOE_FP8
        typedef pg8::OrderMoeT<2 * FF / 256, true, WS_HM8, W_GU + (size_t)1 * (E + 1) * 2 * FF * D, (long)2 * FF * D, (long)256 * D, 0> OM1;
#ifdef MOE_CONTIG
        const int tot1_ = ((const LAS int*)(F.lds + TAB_OFF))[E + 1] * (2 * FF / 256), lo1_ = (int)((long)tot1_ * F.vcu / F.G), hi1_ = (int)((long)tot1_ * (F.vcu + 1) / F.G);
        OM1 S_{c.ws, lo1_, hi1_ - lo1_};
#else
        OM1 S_{c.ws, F.G, F.vcu};
#endif
        pg8::EpiM1F8 E_{c.ws};
        pg8::gemm_phase<pg8::EpiM1F8, OM1, pg8::APlain, true, true, 1>(F.lds, F.wave, (const char*)c.ws, D / 2, D / 2, D / 2, S_, E_);
#else
        pg8::OrderMoe S_{(const LAS int*)(F.lds + TAB_OFF), (const char*)WSP(bf16_t, WS_HM), (const char*)(WSP(bf16_t, W_GU) + (size_t)(E + 1) * 2 * FF * D), WSP(int, WS_TOK), 2 * FF / 256, F.G, F.vcu, 1, (long)2 * FF * D * 2, (long)256 * D * 2, 0};
        pg8::EpiM1 E_{WSP(bf16_t, WS_ACT)};
        pg8::gemm_phase<pg8::EpiM1, pg8::OrderMoe, pg8::APlain, true, true>(F.lds, F.wave, (const char*)c.ws, D, D, D, S_, E_);
#endif
        CONV_LATE(conv_items(F, IT_DN1, IT_END));
    } SEAM(PH_M1_1);
    if (IN(PH_M2_1)) { build_offt(F, 1);
#ifdef MOE_FP8
        typedef pg8::OrderMoeT<D / 256, false, WS_ACT, W_DN + (size_t)1 * (E + 1) * D * FF, (long)D * FF, (long)256 * FF, (long)256 * FF> OM2;
#ifdef MOE_CONTIG
        const int tot2_ = ((const LAS int*)(F.lds + TAB_OFF))[E + 1] * (D / 256), lo2_ = (int)((long)tot2_ * F.vcu / F.G), hi2_ = (int)((long)tot2_ * (F.vcu + 1) / F.G);
        OM2 S_{c.ws, lo2_, hi2_ - lo2_};
#else
        OM2 S_{c.ws, F.G, F.vcu};
#endif
        pg8::EpiM2F8 E_{c.ws};
        pg8::gemm_phase<pg8::EpiM2F8, OM2, pg8::APlain, false, true, 1>(F.lds, F.wave, (const char*)c.ws, FF / 2, FF / 2, FF / 2, S_, E_);
#else
        pg8::OrderMoe S_{(const LAS int*)(F.lds + TAB_OFF), (const char*)WSP(bf16_t, WS_ACT), (const char*)(WSP(bf16_t, W_DN) + (size_t)(E + 1) * D * FF), WSP(int, WS_TOK), D / 256, F.G, F.vcu, 0, (long)D * FF * 2, (long)256 * FF * 2, (long)256 * FF * 2};
        pg8::EpiM2 E_{WSP(bf16_t, WS_Y), WSP(float, WS_WT), (const LAS int*)(F.lds + TAB_OFF), 1.0f};
        pg8::gemm_phase<pg8::EpiM2, pg8::OrderMoe, pg8::APlain, false, true>(F.lds, F.wave, (const char*)c.ws, FF, FF, FF, S_, E_);
#endif
    } SEAM(PH_M2_1);
#ifdef HAVE_THIN
    if (IN(PH_CMB1)) { combine_phase(F, 1); }
#endif
#undef IN
#undef SEAM
}

extern "C" void kernel_launch(void* const* d_in, const int* in_sizes, int n_in, void* d_out, int out_size, void* d_ws, size_t ws_size, hipStream_t stream) {
    static int grid = 0;
    if (grid == 0) {
        if (n_in != N_IN || out_size != M * D || ws_size < WS_END) { fprintf(stderr, "kernel_launch: unexpected shapes (n_in %d, out %d, ws %zu < %zu)\n", n_in, out_size, ws_size, (size_t)WS_END); grid = -1; return; }
        int dev = 0, cus = 0;
        if (hipGetDevice(&dev) != hipSuccess || hipDeviceGetAttribute(&cus, hipDeviceAttributeMultiprocessorCount, dev) != hipSuccess) { grid = -1; return; }
        if (hipFuncSetAttribute((const void*)mega_fwd, hipFuncAttributeMaxDynamicSharedMemorySize, LDS_BYTES) != hipSuccess) { fprintf(stderr, "kernel_launch: hipFuncSetAttribute failed\n"); grid = -1; return; }
        int per_cu = 0; (void)hipOccupancyMaxActiveBlocksPerMultiprocessor(&per_cu, (const void*)mega_fwd, NTHR, LDS_BYTES); (void)hipGetLastError();
        if (per_cu < 1) fprintf(stderr, "kernel_launch: occupancy query reports %d\n", per_cu);
        grid = cus;
    }
    if (grid < 0) return;
    Ctx c; memset((void*)&c, 0, sizeof(c));
    for (int i = 0; i < N_IN; ++i) c.in[i] = (const float*)d_in[i];
    c.out = (float*)d_out; c.ws = (unsigned char*)d_ws;
    (void)hipMemsetAsync((char*)d_ws + WS_CTL, 0, CTL_BYTES, stream);
    Launcher go{stream};
    const unsigned mask = (unsigned)(OPT_MASK);
    int n_mega = 0; for (int p = 0; p < N_PHASES; ++p) n_mega += (mask >> p) & 1u;
#ifdef FORCE_SPLIT
    const bool one = false;
#else
    const bool one = (mask == (1u << N_PHASES) - 1u);
#endif
    for (int ph = 0; ph < N_PHASES; ) {
        if ((mask >> ph) & 1u) {
            int hi = ph + 1; if (one) hi = N_PHASES;
            MArgs a; memset((void*)&a, 0, sizeof(a)); a.c = c; a.ph_lo = ph; a.ph_hi = hi; a.use_bar = one ? 1 : 0;
            hipLaunchKernelGGL(mega_fwd, dim3(grid), dim3(NTHR), LDS_BYTES, stream, a);
#ifdef DUP_PHASE
            if (!one && ph == (DUP_PHASE)) hipLaunchKernelGGL(mega_fwd, dim3(grid), dim3(NTHR), LDS_BYTES, stream, a);
#endif
            if (!one && (ph == PH_RT0 || ph == PH_RT1)) naive_offt(go, c, ph == PH_RT1);
            ph = hi;
        } else {
            naive_phase(go, c, ph);
            if (ph == PH_RT0 || ph == PH_RT1) naive_offt(go, c, ph == PH_RT1);
            ++ph;
        }
    }
}


#endif
```

```cpp
#define OPT_MASK ((1u<<N_PHASES)-1u)
#define HAVE_THIN 1
#define HAVE_SKINNY 1
#define HAVE_RT 1
#define HAVE_ATT0 1
#define HAVE_RET1 1
#define HAVE_SWA1 1
#define MOE_FP8 1
#define SPREAD_CONV 1
#ifdef HOST_TEST
#include <cmath>
#include <cstring>
#include <cstdio>
#include <cstdint>
#include <cstring>
#include <cstddef>
#define HD inline
#else
#include <hip/hip_runtime.h>
#include <cstdio>
#include <cstdint>
#include <cstring>
#define HD __host__ __device__ __forceinline__
#endif

namespace cfg {
#ifdef HOST_TEST
constexpr int D = 256, NB = 2, S = 256, H_A = 4, NOPE = 16, ROPE = 16, VD = 32, QR = 64, KVR = 64, LW = 128, LBS = 16, H_C = 4, DK = 32, H_D = 8, KVH = 2, HDS = 16, WIN = 64, FF = 32;
#else
constexpr int D = 2048, NB = 4, S = 2048, H_A = 8, NOPE = 128, ROPE = 64, VD = 128, QR = 512, KVR = 512, LW = 1024, LBS = 128, H_C = 4, DK = 256, H_D = 8, KVH = 2, HDS = 128, WIN = 128, FF = 512;
#endif
constexpr int M = NB * S, QK = NOPE + ROPE, E = 64, TOPK = 8, NG = 8, TG = 4;
constexpr int AB_N = QR + KVR + ROPE + 2 * LW, P0_N = QR + KVR + 2 * LW;
constexpr int CD_N = 4 * H_C * DK + H_D * HDS + 2 * KVH * HDS;
constexpr int HALF = D / 2;
constexpr int RT = 256;
constexpr int MAXT = (M * TOPK) / RT + E + M / RT;
constexpr float EPS = 1e-6f, LOG2E = 1.4426950408889634f;
static_assert(H_A * VD == HALF && LW == HALF && H_C * DK == HALF && H_D * HDS == HALF, "half widths");
}
using namespace cfg;

enum { I_X = 0, I_C, I_WMOD, I_BMOD, I_NMIX, I_NFFN, I_FNORM, I_WINAB, I_QLN, I_KVLN, I_WUQ, I_WUKV, I_CONVW, I_CONVB, I_LWA, I_LBA, I_LWX, I_LBX, I_LLAM, I_WOUTAB,
       I_WINCD, I_RETGN, I_SINKS, I_WOUTCD, I_RELB, I_WROUTER, I_RBIAS, I_WGATE, I_WUP, I_WDOWN, I_WSG, I_WSU, I_WSD, N_IN };

typedef unsigned short bf16_t;
HD float bf2f(bf16_t v) { unsigned u = (unsigned)v << 16; float f; __builtin_memcpy(&f, &u, 4); return f; }
HD bf16_t f2bf(float f) { unsigned u; __builtin_memcpy(&u, &f, 4); u += 0x7fffu + ((u >> 16) & 1u); return (bf16_t)(u >> 16); }
HD float sigm(float x) { return 1.0f / (1.0f + expf(-x)); }
HD float siluf(float x) { return x * sigm(x); }
HD float gelu_tanh(float x) { return 0.5f * x * (1.0f + tanhf(0.7978845608028654f * (x + 0.044715f * x * x * x))); }
HD int cnt_idx(int l, int e) { return (l * E + e) * 64; }
HD float ssq8(const float* p) { return ((p[0] + p[1]) + (p[2] + p[3])) + ((p[4] + p[5]) + (p[6] + p[7])); }
HD int t5_bucket(int rel) {
    const int n = rel < 0 ? -rel : rel; const int ret = rel > 0 ? 16 : 0;
    if (n < 8) return ret + n;
    return ret + 8 + (n >= 12) + (n >= 16) + (n >= 23) + (n >= 32) + (n >= 46) + (n >= 64) + (n >= 91);
}

constexpr size_t al(size_t x) { return (x + 4095) & ~size_t(4095); }
constexpr size_t WS_CTL = 0, CTL_BYTES = 1u << 20;
constexpr size_t CTL_CNT = 65536;
constexpr size_t CTL_SSQ = 131072;
constexpr size_t WS_MOD = CTL_BYTES;
constexpr size_t WS_TAB = WS_MOD + al((size_t)2 * NB * 6 * D * 4);
constexpr size_t TAB_CR = 0, TAB_SR = (size_t)S * (ROPE / 2) * 4, TAB_CT = 2 * TAB_SR, TAB_ST = TAB_CT + (size_t)S * (DK / 2) * 4;
constexpr size_t WS_RSTD = WS_TAB + al(TAB_ST + (size_t)S * (DK / 2) * 4);
constexpr size_t WS_SELE = WS_RSTD + al((size_t)M * 4);
constexpr size_t WS_SELR = WS_SELE + al((size_t)M * 8 * 4);
constexpr size_t WS_SELW = WS_SELR + al((size_t)M * 8 * 4);
constexpr size_t WS_TOK = WS_SELW + al((size_t)M * 8 * 4);
constexpr size_t WS_WT = WS_TOK + al((size_t)E * M * 4);
constexpr size_t WS_OFFT = WS_WT + al((size_t)E * M * 4);
constexpr size_t WS_HM = WS_OFFT + 4096;
constexpr size_t WS_HM8 = WS_HM + al((size_t)M * D * 2);
constexpr size_t WS_MIX = WS_HM8 + al((size_t)M * D);
constexpr size_t WS_X1 = WS_MIX + al((size_t)M * D * 2);
constexpr size_t WS_X2 = WS_X1 + al((size_t)M * D * 4);
constexpr size_t WS_PROJ = WS_X2 + al((size_t)M * D * 4);
constexpr size_t WS_L0 = WS_PROJ + al((size_t)M * (P0_N > CD_N ? P0_N : CD_N) * 2);
constexpr size_t WS_Q = WS_L0;
constexpr size_t WS_KC = WS_Q + al((size_t)M * H_A * QK * 2);
constexpr size_t WS_V = WS_KC + al((size_t)M * H_A * QK * 2);
constexpr size_t WS_XC = WS_V + al((size_t)M * H_A * VD * 2);
constexpr size_t WS_LA = WS_XC + al((size_t)M * LW * 2);
constexpr size_t WS_U = WS_LA + al((size_t)2 * M * LW * 2);
constexpr size_t WS_HF = WS_U + al((size_t)2 * M * LW * 2);
constexpr size_t WS_LXP = WS_HF + al((size_t)M * LW * 4);
constexpr size_t WS_RET = WS_L0;
constexpr size_t WS_ACT = WS_LXP + al((size_t)NB * (S + 4) * LW * 2);
constexpr size_t WS_Y = WS_ACT + al((size_t)MAXT * RT * FF * 2);
constexpr size_t WS_T = WS_Y;
constexpr size_t WS_SC = WS_T + al((size_t)M * CD_N * 4);
static_assert(WS_SC + (size_t)8 * S * S * 4 <= WS_Y + (size_t)MAXT * RT * D * 2, "naive temps fit in the Y region");
constexpr size_t WS_W = WS_Y + al((size_t)MAXT * RT * D * 2);
constexpr size_t W_INAB = WS_W;
constexpr size_t W_UQ = W_INAB + al((size_t)AB_N * D * 2);
constexpr size_t W_UKV = W_UQ + al((size_t)H_A * QK * QR * 2);
constexpr size_t W_LRU = W_UKV + al((size_t)H_A * (NOPE + VD) * KVR * 2);
constexpr size_t W_OUTAB = W_LRU + al((size_t)2 * (LW / LBS) * 2 * LBS * 4 * LBS * 2);
constexpr size_t W_INCD = W_OUTAB + al((size_t)D * D * 2);
constexpr size_t W_OUTCD = W_INCD + al((size_t)CD_N * D * 2);
constexpr size_t W_RT = W_OUTCD + al((size_t)D * D * 2);
constexpr size_t W_GU = W_RT + al((size_t)2 * E * D * 2);
constexpr size_t W_DN = W_GU + al((size_t)2 * (E + 1) * 2 * FF * D * 2);
constexpr size_t W_GB = W_DN + al((size_t)2 * (E + 1) * D * FF * 2);
constexpr size_t WS_END = W_GB + al((size_t)6 * LW * 4);

struct Ctx { const float* in[N_IN]; float* out; unsigned char* ws; };
#define WSP(T, off) ((T*)(c.ws + (off)))
HD long lru_idx(int d, int b, int t, int ch) { return ((((long)d * NB + b) * (LW / 8) + ch / 8) * S + t) * 8 + (ch % 8); }
HD int atomic_inc(int* p) {
#ifdef HOST_TEST
    return (*p)++;
#else
#if defined(__HIP_DEVICE_COMPILE__)
    return atomicAdd(p, 1);
#else
    return (*p)++;
#endif
#endif
}

struct NGemm {
    const void* A; const void* B; void* C; const float* ks;
    long a_rs, a_ks, a_z1, a_z2, b_ks, b_ns, b_z1, b_z2, c_rs, c_z1, c_z2;
    long Mr, N, K, Z2, a_bf, b_bf, c_bf;
    HD float la(long i) const { return a_bf ? bf2f(((const bf16_t*)A)[i]) : ((const float*)A)[i]; }
    HD float lb(long i) const { return b_bf ? bf2f(((const bf16_t*)B)[i]) : ((const float*)B)[i]; }
    HD void operator()(long i) const {
        const long n4c = N / 4, m4c = Mr / 4;
        const long n0 = (i % n4c) * 4; const long r = i / n4c; const long m0 = (r % m4c) * 4; const long z = r / m4c; const long z1 = z / Z2, z2 = z % Z2;
        const long ab = z1 * a_z1 + z2 * a_z2, bb = z1 * b_z1 + z2 * b_z2, cb = z1 * c_z1 + z2 * c_z2;
        float acc[4][4];
#pragma unroll
        for (int x = 0; x < 4; ++x)
#pragma unroll
            for (int y = 0; y < 4; ++y) acc[x][y] = 0.f;
        for (long k = 0; k < K; ++k) {
            const float s = ks ? ks[k] : 1.0f;
            float av[4], bv[4];
#pragma unroll
            for (int x = 0; x < 4; ++x) av[x] = la(ab + (m0 + x) * a_rs + k * a_ks) * s;
#pragma unroll
            for (int y = 0; y < 4; ++y) bv[y] = lb(bb + k * b_ks + (n0 + y) * b_ns);
#pragma unroll
            for (int x = 0; x < 4; ++x)
#pragma unroll
                for (int y = 0; y < 4; ++y) acc[x][y] += av[x] * bv[y];
        }
#pragma unroll
        for (int x = 0; x < 4; ++x)
#pragma unroll
            for (int y = 0; y < 4; ++y) { const long ci = cb + (m0 + x) * c_rs + n0 + y; if (c_bf) ((bf16_t*)C)[ci] = f2bf(acc[x][y]); else ((float*)C)[ci] = acc[x][y]; }
    }
    long count(long Z) const { return Z * (Mr / 4) * (N / 4); }
};

struct ModF { Ctx c;
    HD void operator()(long i) const { const long n4c = 6 * D / 4; const long n = (i % n4c) * 4; const long r = i / n4c; const int b = (int)(r % NB), l = (int)(r / NB);
        float a0 = c.in[I_BMOD][l * 6 * D + n], a1 = c.in[I_BMOD][l * 6 * D + n + 1], a2 = c.in[I_BMOD][l * 6 * D + n + 2], a3 = c.in[I_BMOD][l * 6 * D + n + 3];
        const float* w = c.in[I_WMOD] + (size_t)l * D * 6 * D + n;
        for (int k = 0; k < D; ++k) { const float ca = siluf(c.in[I_C][b * D + k]); const float* wr = w + (size_t)k * 6 * D; a0 += ca * wr[0]; a1 += ca * wr[1]; a2 += ca * wr[2]; a3 += ca * wr[3]; }
        float* o = WSP(float, WS_MOD) + ((size_t)l * NB + b) * 6 * D + n; o[0] = a0; o[1] = a1; o[2] = a2; o[3] = a3; }
    long count() const { return (long)2 * NB * 6 * D / 4; } };
struct TabF { Ctx c;
    HD void operator()(long i) const { const int W = ROPE / 2 + DK / 2; const int t = (int)(i / W), j = (int)(i % W);
        if (j < ROPE / 2) { const double inv = pow(10000.0, -2.0 * j / ROPE), a = t * inv; WSP(float, WS_TAB + TAB_CR)[t * (ROPE / 2) + j] = (float)cos(a); WSP(float, WS_TAB + TAB_SR)[t * (ROPE / 2) + j] = (float)sin(a); }
        else { const int jj = j - ROPE / 2; const double inv = pow(10000.0, -2.0 * jj / DK), a = t * inv; WSP(float, WS_TAB + TAB_CT)[t * (DK / 2) + jj] = (float)cos(a); WSP(float, WS_TAB + TAB_ST)[t * (DK / 2) + jj] = (float)sin(a); } }
    long count() const { return (long)S * (ROPE / 2 + DK / 2); } };
struct RowSSF { Ctx c; const float* X; float* out; long rs, ncols, rows, os;
    HD void operator()(long i) const { const float* x = X + i * rs; float s = 0.f; for (long j = 0; j < ncols; ++j) s += x[j] * x[j]; out[i * os] = s; }
    long count() const { return rows; } };
struct ModulateF { Ctx c; const float* X; const float* gain; const float* sc; const float* sh;
    HD void operator()(long i) const { const long m = i / D, j = i % D; const int b = (int)(m / S); const float r = 1.0f / sqrtf(WSP(float, WS_RSTD)[m] / D + EPS);
        WSP(bf16_t, WS_HM)[i] = f2bf(X[i] * r * gain[j] * (1.0f + sc[(size_t)b * 6 * D + j]) + sh[(size_t)b * 6 * D + j]); }
    long count() const { return (long)M * D; } };
struct FinalF { Ctx c; const float* X;
    HD void operator()(long i) const { const long m = i / D, j = i % D; const float r = 1.0f / sqrtf(WSP(float, WS_RSTD)[m] / D + EPS); c.out[i] = X[i] * r * c.in[I_FNORM][j]; }
    long count() const { return (long)M * D; } };
struct PostG1F { Ctx c;
    HD void operator()(long i) const { const long m = i / AB_N; const int col = (int)(i % AB_N); const float v = WSP(float, WS_T)[i]; bf16_t* P = WSP(bf16_t, WS_PROJ) + m * P0_N;
        if (col < QR + KVR) P[col] = f2bf(v);
        else if (col < QR + KVR + ROPE) {}
        else if (col < QR + KVR + ROPE + LW) { P[col - ROPE] = f2bf(v); const long b = m / S, t = m % S; WSP(bf16_t, WS_LXP)[(b * (S + 4) + 2 + t) * LW + col - (QR + KVR + ROPE)] = f2bf(v); }
        else P[col - ROPE] = f2bf(gelu_tanh(v)); }
    long count() const { return (long)M * AB_N; } };
struct KRopeF { Ctx c;
    HD void operator()(long i) const { const long m = i / (ROPE / 2); const int ii = (int)(i % (ROPE / 2)); const int t = (int)(m % S); const float* T = WSP(float, WS_T) + m * AB_N + QR + KVR;
        const float x1 = T[ii], x2 = T[ROPE / 2 + ii], cs = WSP(float, WS_TAB + TAB_CR)[t * (ROPE / 2) + ii], sn = WSP(float, WS_TAB + TAB_SR)[t * (ROPE / 2) + ii];
        const bf16_t o1 = f2bf(x1 * cs - x2 * sn), o2 = f2bf(x2 * cs + x1 * sn);
        for (int h = 0; h < H_A; ++h) { bf16_t* K = WSP(bf16_t, WS_KC) + (m * H_A + h) * QK + NOPE; K[ii] = o1; K[ROPE / 2 + ii] = o2; } }
    long count() const { return (long)M * (ROPE / 2); } };
struct PostQF { Ctx c; float qs;
    HD void operator()(long i) const { const long m = i / (H_A * QK); const int r = (int)(i % (H_A * QK)), h = r / QK, j = r % QK; const int t = (int)(m % S);
        const float rstd = 1.0f / sqrtf(ssq8(WSP(float, CTL_SSQ) + m * 16) / QR + EPS) * qs; const float* T = WSP(float, WS_T) + m * (H_A * QK) + h * QK; bf16_t* Q = WSP(bf16_t, WS_Q) + (m * H_A + h) * QK;
        if (j < NOPE) Q[j] = f2bf(T[j] * rstd);
        else if (j < NOPE + ROPE / 2) { const int ii = j - NOPE; const float x1 = T[NOPE + ii] * rstd, x2 = T[NOPE + ROPE / 2 + ii] * rstd, cs = WSP(float, WS_TAB + TAB_CR)[t * (ROPE / 2) + ii], sn = WSP(float, WS_TAB + TAB_SR)[t * (ROPE / 2) + ii];
            Q[NOPE + ii] = f2bf(x1 * cs - x2 * sn); Q[NOPE + ROPE / 2 + ii] = f2bf(x2 * cs + x1 * sn); } }
    long count() const { return (long)M * H_A * QK; } };
struct PostKVF { Ctx c;
    HD void operator()(long i) const { const int W = NOPE + VD; const long m = i / (H_A * W); const int r = (int)(i % (H_A * W)), h = r / W, j = r % W;
        const float rstd = 1.0f / sqrtf(ssq8(WSP(float, CTL_SSQ) + m * 16 + 8) / KVR + EPS); const float v = WSP(float, WS_T)[i] * rstd;
        if (j < NOPE) WSP(bf16_t, WS_KC)[(m * H_A + h) * QK + j] = f2bf(v); else WSP(bf16_t, WS_V)[(m * H_A + h) * VD + j - NOPE] = f2bf(v); }
    long count() const { return (long)M * H_A * (NOPE + VD); } };
struct ConvF { Ctx c;
    HD void operator()(long i) const { const long m = i / LW; const int ch = (int)(i % LW); const int t = (int)(m % S); float a = c.in[I_CONVB][ch];
        for (int j = 0; j < 4; ++j) { const int tt = t + j - 2; if (tt >= 0 && tt < S) a += c.in[I_CONVW][j * LW + ch] * bf2f(WSP(bf16_t, WS_PROJ)[(m + j - 2) * P0_N + QR + KVR + ch]); }
        WSP(bf16_t, WS_XC)[i] = f2bf(a); }
    long count() const { return (long)M * LW; } };
struct GatesF { Ctx c;
    HD void operator()(long i) const { const int ch = (int)(i % LW); const long r = i / LW; const long m = r % M; const int d = (int)(r / M); const int g = ch / LBS, j = ch % LBS; const int b = (int)(m / S), t = (int)(m % S);
        const bf16_t* xr = WSP(bf16_t, WS_XC) + m * LW + g * LBS; const float* wa = c.in[I_LWA] + ((size_t)(d * (LW / LBS) + g) * LBS) * LBS + j; const float* wx = c.in[I_LWX] + ((size_t)(d * (LW / LBS) + g) * LBS) * LBS + j;
        float za = c.in[I_LBA][d * LW + ch], zx = c.in[I_LBX][d * LW + ch];
        for (int k = 0; k < LBS; ++k) { const float x = bf2f(xr[k]); za += x * wa[(size_t)k * LBS]; zx += x * wx[(size_t)k * LBS]; }
        const float lam = c.in[I_LLAM][d * LW + ch]; const float sp = log1pf(expf(-lam));
        const float la = -8.0f * sigm(za) * sp; const float u = sqrtf(-expm1f(2.0f * la)) * (sigm(zx) * bf2f(WSP(bf16_t, WS_XC)[m * LW + ch]));
        const long o = lru_idx(d, b, t, ch); WSP(bf16_t, WS_LA)[o] = f2bf(la); WSP(bf16_t, WS_U)[o] = f2bf(u); }
    long count() const { return (long)2 * M * LW; } };
struct ScanF { Ctx c;
    HD void operator()(long i) const { const int b = (int)(i / LW), ch = (int)(i % LW); float h = 0.f;
        for (int t = 0; t < S; ++t) { const long o = lru_idx(0, b, t, ch); h = expf(bf2f(WSP(bf16_t, WS_LA)[o])) * h + bf2f(WSP(bf16_t, WS_U)[o]); WSP(float, WS_HF)[((long)b * S + t) * LW + ch] = h; }
        h = 0.f;
        for (int t = S - 1; t >= 0; --t) { const long o = lru_idx(1, b, t, ch); h = expf(bf2f(WSP(bf16_t, WS_LA)[o])) * h + bf2f(WSP(bf16_t, WS_U)[o]); const long m = (long)b * S + t;
            WSP(bf16_t, WS_MIX)[m * D + HALF + ch] = f2bf((WSP(float, WS_HF)[m * LW + ch] + h) * bf2f(WSP(bf16_t, WS_PROJ)[m * P0_N + QR + KVR + LW + ch])); } }
    long count() const { return (long)NB * LW; } };
struct SoftmaxF { Ctx c; long rows;
    HD void operator()(long i) const { float* r = WSP(float, WS_SC) + i * S; float mx = -INFINITY; for (int k = 0; k < S; ++k) mx = fmaxf(mx, r[k]); float s = 0.f; for (int k = 0; k < S; ++k) { const float p = exp2f(r[k] - mx); r[k] = p; s += p; }
        const float inv = 1.0f / s; for (int k = 0; k < S; ++k) r[k] *= inv; }
    long count() const { return rows; } };
struct OutPostF { Ctx c; const float* Xin; float* Xout; long l;
    HD void operator()(long i) const { const long m = i / D, n = i % D; const int b = (int)(m / S); Xout[i] = Xin[i] + WSP(float, WS_MOD)[((size_t)l * NB + b) * 6 * D + 2 * D + n] * WSP(float, WS_T)[i]; }
    long count() const { return (long)M * D; } };
struct RouteF { Ctx c; long l;
    HD float bz(const float* lg, const float* bias, int e) const { return sigm(lg[e]) + bias[e]; }
    HD void operator()(long m) const { const float* lg = WSP(float, WS_T) + m * E; const float* bias = c.in[I_RBIAS] + l * E;
        unsigned gmask = 0u;
        for (int it = 0; it < TG; ++it) { float best = -INFINITY; int bi = 0;
            for (int g = 0; g < NG; ++g) if (!((gmask >> g) & 1u)) { float m1 = -INFINITY, m2 = -INFINITY; for (int j = 0; j < E / NG; ++j) { const float v = bz(lg, bias, g * (E / NG) + j); if (v > m1) { m2 = m1; m1 = v; } else if (v > m2) m2 = v; }
                const float sc = m1 + m2; if (sc > best) { best = sc; bi = g; } }
            gmask |= 1u << bi; }
        unsigned long long taken = 0ull; float wsum = 0.f; int* se = WSP(int, WS_SELE) + m * TOPK; float* sw = WSP(float, WS_SELW) + m * TOPK; int* sr = WSP(int, WS_SELR) + m * TOPK;
        for (int k = 0; k < TOPK; ++k) { float best = -INFINITY; int bi = 0;
            for (int e = 0; e < E; ++e) if (((gmask >> (e / (E / NG))) & 1u) && !((taken >> e) & 1ull)) { const float v = bz(lg, bias, e); if (v > best) { best = v; bi = e; } }
            taken |= 1ull << bi; const float s = sigm(lg[bi]); se[k] = bi; sw[k] = s; wsum += s; }
        int* cnt = WSP(int, CTL_CNT);
        for (int k = 0; k < TOPK; ++k) { const int e = se[k]; const float w = sw[k] / wsum * 2.5f; const int rank = atomic_inc(cnt + cnt_idx((int)l, e)); sr[k] = rank; sw[k] = w;
            WSP(int, WS_TOK)[(size_t)e * M + rank] = (int)m; WSP(float, WS_WT)[(size_t)e * M + rank] = w; } }
    long count() const { return M; } };
struct OffF { Ctx c; long l;
    HD void operator()(long) const { int* o = WSP(int, WS_OFFT); const int* cnt = WSP(int, CTL_CNT); o[0] = 0; for (int e = 0; e <= E; ++e) { const int n = e < E ? cnt[cnt_idx((int)l, e)] : M; o[e + 1] = o[e] + (n + RT - 1) / RT; } }
    long count() const { return 1; } };
struct Moe1F { Ctx c; long l;
    HD void operator()(long i) const { const long f4c = FF / 4; const int f = (int)(i % f4c) * 4; const long r = i / f4c; const int rank = (int)(r % M), e = (int)(r / M);
        const int n = e < E ? WSP(int, CTL_CNT)[cnt_idx((int)l, e)] : M; if (rank >= n) return;
        const int tok = e < E ? WSP(int, WS_TOK)[(size_t)e * M + rank] : rank; const long row = (long)WSP(int, WS_OFFT)[e] * RT + rank;
        const float* wg = (e < E ? c.in[I_WGATE] + ((size_t)l * E + e) * D * FF : c.in[I_WSG] + (size_t)l * D * FF) + f;
        const float* wu = (e < E ? c.in[I_WUP] + ((size_t)l * E + e) * D * FF : c.in[I_WSU] + (size_t)l * D * FF) + f;
        const bf16_t* h = WSP(bf16_t, WS_HM) + (size_t)tok * D; float g0 = 0, g1 = 0, g2 = 0, g3 = 0, u0 = 0, u1 = 0, u2 = 0, u3 = 0;
        for (int k = 0; k < D; ++k) { const float a = bf2f(h[k]); const float* pg = wg + (size_t)k * FF; const float* pu = wu + (size_t)k * FF;
            g0 += a * pg[0]; g1 += a * pg[1]; g2 += a * pg[2]; g3 += a * pg[3]; u0 += a * pu[0]; u1 += a * pu[1]; u2 += a * pu[2]; u3 += a * pu[3]; }
        bf16_t* o = WSP(bf16_t, WS_ACT) + row * FF + f; o[0] = f2bf(siluf(g0) * u0); o[1] = f2bf(siluf(g1) * u1); o[2] = f2bf(siluf(g2) * u2); o[3] = f2bf(siluf(g3) * u3); }
    long count() const { return (long)(E + 1) * M * (FF / 4); } };
struct Moe2F { Ctx c; long l;
    HD void operator()(long i) const { const long d4c = D / 4; const int d = (int)(i % d4c) * 4; const long r = i / d4c; const int rank = (int)(r % M), e = (int)(r / M);
        const int n = e < E ? WSP(int, CTL_CNT)[cnt_idx((int)l, e)] : M; if (rank >= n) return;
        const long row = (long)WSP(int, WS_OFFT)[e] * RT + rank; const float wt = e < E ? WSP(float, WS_WT)[(size_t)e * M + rank] : 1.0f;
        const float* wd = (e < E ? c.in[I_WDOWN] + ((size_t)l * E + e) * FF * D : c.in[I_WSD] + (size_t)l * FF * D) + d;
        const bf16_t* a = WSP(bf16_t, WS_ACT) + row * FF; float y0 = 0, y1 = 0, y2 = 0, y3 = 0;
        for (int f = 0; f < FF; ++f) { const float v = bf2f(a[f]); const float* p = wd + (size_t)f * D; y0 += v * p[0]; y1 += v * p[1]; y2 += v * p[2]; y3 += v * p[3]; }
        bf16_t* o = WSP(bf16_t, WS_Y) + row * D + d; o[0] = f2bf(wt * y0); o[1] = f2bf(wt * y1); o[2] = f2bf(wt * y2); o[3] = f2bf(wt * y3); }
    long count() const { return (long)(E + 1) * M * (D / 4); } };
struct CombineF { Ctx c; const float* Xin; float* Xout; long l;
    HD void operator()(long i) const { const long m = i / D, n = i % D; const int b = (int)(m / S); const int* offt = WSP(int, WS_OFFT); const bf16_t* Y = WSP(bf16_t, WS_Y); float v = 0.f;
        for (int k = 0; k < TOPK; ++k) { const int e = WSP(int, WS_SELE)[m * TOPK + k], r = WSP(int, WS_SELR)[m * TOPK + k]; v += bf2f(Y[((size_t)offt[e] * RT + r) * D + n]); }
        v += bf2f(Y[((size_t)offt[E] * RT + m) * D + n]);
        Xout[i] = Xin[i] + WSP(float, WS_MOD)[((size_t)l * NB + b) * 6 * D + 5 * D + n] * v; }
    long count() const { return (long)M * D; } };
struct PostG3F { Ctx c; float sqs;
    HD void operator()(long i) const { const long m = i / CD_N; const int col = (int)(i % CD_N); const int t = (int)(m % S); const float* T = WSP(float, WS_T) + m * CD_N; bf16_t* P = WSP(bf16_t, WS_PROJ) + m * CD_N; const int W = H_C * DK;
        if (col < 2 * W) { const int j = col % DK; if (j < DK / 2) { const float sc = col < W ? 1.0f : 1.0f / sqrtf((float)DK); const float x1 = T[col], x2 = T[col + DK / 2], cs = WSP(float, WS_TAB + TAB_CT)[t * (DK / 2) + j], sn = WSP(float, WS_TAB + TAB_ST)[t * (DK / 2) + j];
                P[col] = f2bf((x1 * cs - x2 * sn) * sc); P[col + DK / 2] = f2bf((x2 * cs + x1 * sn) * sc); } }
        else if (col < 3 * W) P[col] = f2bf(T[col]);
        else if (col < 4 * W) P[col] = f2bf(siluf(T[col]));
        else if (col < 4 * W + H_D * HDS) P[col] = f2bf(T[col] * sqs);
        else P[col] = f2bf(T[col]); }
    long count() const { return (long)M * CD_N; } };
struct DecayF { Ctx c;
    HD void operator()(long i) const { const int mm = (int)(i % S); const long r = i / S; const int n = (int)(r % S), h = (int)(r / S);
        const float lgf = log1pf(-exp2f(-5.0f - h)), lgb = log1pf(-exp2f(-5.0f - (H_C - 1 - h)));
        WSP(float, WS_SC)[i] *= (n >= mm) ? expf(lgf * (n - mm)) : expf(lgb * (mm - n)); }
    long count() const { return (long)H_C * S * S; } };
struct RetNormF { Ctx c;
    HD void operator()(long i) const { const long m = i / H_C; const int h = (int)(i % H_C); const float* r = WSP(float, WS_RET) + m * HALF + h * DK; float s = 0.f; for (int j = 0; j < DK; ++j) s += r[j] * r[j];
        const float rs = 1.0f / sqrtf(s / DK + EPS); for (int j = 0; j < DK; ++j) WSP(bf16_t, WS_MIX)[m * D + h * DK + j] = f2bf(bf2f(WSP(bf16_t, WS_PROJ)[m * CD_N + 3 * H_C * DK + h * DK + j]) * (r[j] * rs * c.in[I_RETGN][h * DK + j])); }
    long count() const { return (long)M * H_C; } };
struct SwaSoftF { Ctx c;
    HD void operator()(long i) const { const int q = (int)(i % S), hd = (int)(i / S); float* r = WSP(float, WS_SC) + i * S; const float sink = c.in[I_SINKS][hd] * LOG2E; const float* rb = c.in[I_RELB];
        const int lo = q - WIN < 0 ? 0 : q - WIN, hi = q + WIN > S - 1 ? S - 1 : q + WIN; float mx = sink;
        for (int k = lo; k <= hi; ++k) { const float s = r[k] + rb[t5_bucket(k - q) * H_D + hd] * LOG2E; r[k] = s; mx = fmaxf(mx, s); }
        float den = exp2f(sink - mx); for (int k = lo; k <= hi; ++k) { const float p = exp2f(r[k] - mx); r[k] = p; den += p; }
        const float inv = 1.0f / den; for (int k = 0; k < S; ++k) r[k] = (k >= lo && k <= hi) ? r[k] * inv : 0.f; }
    long count() const { return (long)H_D * S; } };

#ifdef HOST_TEST
struct Launcher { template <class F> void operator()(const F& f, long n) const { for (long i = 0; i < n; ++i) f(i); } };
#else
template <class F> __global__ void __launch_bounds__(256) run_k(F f, long n) { for (long i = (long)blockIdx.x * 256 + threadIdx.x; i < n; i += (long)gridDim.x * 256) f(i); }
struct Launcher { hipStream_t st; template <class F> void operator()(const F& f, long n) const { long g = (n + 255) / 256; if (g > (1 << 20)) g = 1 << 20; if (g < 1) g = 1; hipLaunchKernelGGL(run_k<F>, dim3((unsigned)g), dim3(256), 0, st, f, n); } };
#endif

template <class F> static F zf() { F f; memset((void*)&f, 0, sizeof(F)); return f; }
static NGemm mk_gemm(const void* A, int a_bf, long a_rs, const void* B, int b_bf, long b_ks, long b_ns, void* C, int c_bf, long c_rs, long Mr, long N, long K) {
    NGemm g; memset((void*)&g, 0, sizeof(g)); g.A = A; g.B = B; g.C = C; g.a_bf = a_bf; g.b_bf = b_bf; g.c_bf = c_bf; g.a_rs = a_rs; g.a_ks = 1; g.b_ks = b_ks; g.b_ns = b_ns; g.c_rs = c_rs; g.Mr = Mr; g.N = N; g.K = K; g.Z2 = 1; return g; }

template <class L> static void rowss(const L& go, const Ctx& c, const float* X, float* out, long rs, long ncols, long os = 1) { RowSSF f = zf<RowSSF>(); f.c = c; f.X = X; f.out = out; f.rs = rs; f.ncols = ncols; f.rows = M; f.os = os; go(f, f.count()); }

enum { PH_P0 = 0, PH_MOD0, PH_G1, PH_G2, PH_SCAN0, PH_ATT0, PH_OUT0, PH_RT0, PH_M1_0, PH_M2_0, PH_CMB0, PH_G3, PH_RET1, PH_SWA1, PH_RN1, PH_OUT1, PH_RT1, PH_M1_1, PH_M2_1, PH_CMB1, N_PHASES };

template <class L> static void naive_phase(const L& go, const Ctx& c, int ph) {
    float* mod = WSP(float, WS_MOD);
    const int l = ph >= PH_G3 ? 1 : 0;
    float* X1 = WSP(float, WS_X1); float* X2 = WSP(float, WS_X2);
    switch (ph) {
    case PH_P0: { { ModF f = zf<ModF>(); f.c = c; go(f, f.count()); } { TabF f = zf<TabF>(); f.c = c; go(f, f.count()); } } break;
    case PH_MOD0: { rowss(go, c, c.in[I_X], WSP(float, WS_RSTD), D, D);
        ModulateF f = zf<ModulateF>(); f.c = c; f.X = c.in[I_X]; f.gain = c.in[I_NMIX]; f.sc = mod + D; f.sh = mod; go(f, f.count()); } break;
    case PH_G1: { { NGemm g = mk_gemm(WSP(bf16_t, WS_HM), 1, D, c.in[I_WINAB], 0, AB_N, 1, WSP(float, WS_T), 0, AB_N, M, AB_N, D); go(g, g.count(1)); }
        { PostG1F f = zf<PostG1F>(); f.c = c; go(f, f.count()); }
        rowss(go, c, WSP(float, WS_T), WSP(float, CTL_SSQ), AB_N, QR, 16);
        rowss(go, c, WSP(float, WS_T) + QR, WSP(float, CTL_SSQ) + 8, AB_N, KVR, 16);
        { KRopeF f = zf<KRopeF>(); f.c = c; go(f, f.count()); } } break;
    case PH_G2: { { NGemm g = mk_gemm(WSP(bf16_t, WS_PROJ), 1, P0_N, c.in[I_WUQ], 0, H_A * QK, 1, WSP(float, WS_T), 0, H_A * QK, M, H_A * QK, QR); g.ks = c.in[I_QLN]; go(g, g.count(1)); }
        { PostQF f = zf<PostQF>(); f.c = c; f.qs = LOG2E / sqrtf((float)QK); go(f, f.count()); }
        { NGemm g = mk_gemm(WSP(bf16_t, WS_PROJ) + QR, 1, P0_N, c.in[I_WUKV], 0, H_A * (NOPE + VD), 1, WSP(float, WS_T), 0, H_A * (NOPE + VD), M, H_A * (NOPE + VD), KVR); g.ks = c.in[I_KVLN]; go(g, g.count(1)); }
        { PostKVF f = zf<PostKVF>(); f.c = c; go(f, f.count()); }
        { ConvF f = zf<ConvF>(); f.c = c; go(f, f.count()); }
        { GatesF f = zf<GatesF>(); f.c = c; go(f, f.count()); } } break;
    case PH_SCAN0: { ScanF f = zf<ScanF>(); f.c = c; go(f, f.count()); } break;
    case PH_ATT0: {
        for (int b = 0; b < NB; ++b) {
            NGemm g = mk_gemm(WSP(bf16_t, WS_Q) + (size_t)b * S * H_A * QK, 1, H_A * QK, WSP(bf16_t, WS_KC) + (size_t)b * S * H_A * QK, 1, 1, H_A * QK, WSP(float, WS_SC), 0, S, S, S, QK);
            g.a_z2 = QK; g.b_z2 = QK; g.c_z2 = (long)S * S; g.Z2 = H_A; go(g, g.count(H_A));
            { SoftmaxF f = zf<SoftmaxF>(); f.c = c; f.rows = (long)H_A * S; go(f, f.count()); }
            NGemm p = mk_gemm(WSP(float, WS_SC), 0, S, WSP(bf16_t, WS_V) + (size_t)b * S * H_A * VD, 1, H_A * VD, 1, WSP(bf16_t, WS_MIX) + (size_t)b * S * D, 1, D, S, VD, S);
            p.a_z2 = (long)S * S; p.b_z2 = VD; p.c_z2 = VD; p.Z2 = H_A; go(p, p.count(H_A)); } } break;
    case PH_OUT0: case PH_OUT1: { NGemm g = mk_gemm(WSP(bf16_t, WS_MIX), 1, D, c.in[l ? I_WOUTCD : I_WOUTAB], 0, D, 1, WSP(float, WS_T), 0, D, M, D, D); go(g, g.count(1));
        OutPostF f = zf<OutPostF>(); f.c = c; f.Xin = l ? X2 : c.in[I_X]; f.Xout = X1; f.l = l; go(f, f.count()); } break;
    case PH_RT0: case PH_RT1: { float* modl = mod + (size_t)l * NB * 6 * D;
        rowss(go, c, X1, WSP(float, WS_RSTD), D, D);
        { ModulateF f = zf<ModulateF>(); f.c = c; f.X = X1; f.gain = c.in[I_NFFN] + l * D; f.sc = modl + 4 * D; f.sh = modl + 3 * D; go(f, f.count()); }
        { NGemm g = mk_gemm(WSP(bf16_t, WS_HM), 1, D, c.in[I_WROUTER] + (size_t)l * D * E, 0, E, 1, WSP(float, WS_T), 0, E, M, E, D); go(g, g.count(1)); }
        { RouteF f = zf<RouteF>(); f.c = c; f.l = l; go(f, f.count()); } } break;
    case PH_M1_0: case PH_M1_1: { Moe1F f = zf<Moe1F>(); f.c = c; f.l = l; go(f, f.count()); } break;
    case PH_M2_0: case PH_M2_1: { Moe2F f = zf<Moe2F>(); f.c = c; f.l = l; go(f, f.count()); } break;
    case PH_CMB0: { { CombineF f = zf<CombineF>(); f.c = c; f.Xin = X1; f.Xout = X2; f.l = 0; go(f, f.count()); }
        rowss(go, c, X2, WSP(float, WS_RSTD), D, D);
        ModulateF f = zf<ModulateF>(); f.c = c; f.X = X2; f.gain = c.in[I_NMIX] + D; f.sc = mod + (size_t)NB * 6 * D + D; f.sh = mod + (size_t)NB * 6 * D; go(f, f.count()); } break;
    case PH_CMB1: { { CombineF f = zf<CombineF>(); f.c = c; f.Xin = X1; f.Xout = X2; f.l = 1; go(f, f.count()); }
        rowss(go, c, X2, WSP(float, WS_RSTD), D, D);
        FinalF f = zf<FinalF>(); f.c = c; f.X = X2; go(f, f.count()); } break;
    case PH_G3: { { NGemm g = mk_gemm(WSP(bf16_t, WS_HM), 1, D, c.in[I_WINCD], 0, CD_N, 1, WSP(float, WS_T), 0, CD_N, M, CD_N, D); go(g, g.count(1)); }
        PostG3F f = zf<PostG3F>(); f.c = c; f.sqs = LOG2E / sqrtf((float)HDS); go(f, f.count()); } break;
    case PH_RET1: {
        for (int b = 0; b < NB; ++b) {
            const bf16_t* Pb = WSP(bf16_t, WS_PROJ) + (size_t)b * S * CD_N;
            NGemm g = mk_gemm(Pb, 1, CD_N, Pb + H_C * DK, 1, 1, CD_N, WSP(float, WS_SC), 0, S, S, S, DK);
            g.a_z2 = DK; g.b_z2 = DK; g.c_z2 = (long)S * S; g.Z2 = H_C; go(g, g.count(H_C));
            { DecayF f = zf<DecayF>(); f.c = c; go(f, f.count()); }
            NGemm p = mk_gemm(WSP(float, WS_SC), 0, S, Pb + 2 * H_C * DK, 1, CD_N, 1, WSP(float, WS_RET) + (size_t)b * S * HALF, 0, HALF, S, DK, S);
            p.a_z2 = (long)S * S; p.b_z2 = DK; p.c_z2 = DK; p.Z2 = H_C; go(p, p.count(H_C)); } } break;
    case PH_SWA1: {
        for (int b = 0; b < NB; ++b) {
            const bf16_t* Pb = WSP(bf16_t, WS_PROJ) + (size_t)b * S * CD_N + 4 * H_C * DK; const int G = H_D / KVH;
            NGemm g = mk_gemm(Pb, 1, CD_N, Pb + H_D * HDS, 1, 1, CD_N, WSP(float, WS_SC), 0, S, S, S, HDS);
            g.a_z1 = (long)G * HDS; g.a_z2 = HDS; g.b_z1 = HDS; g.b_z2 = 0; g.c_z1 = (long)G * S * S; g.c_z2 = (long)S * S; g.Z2 = G; go(g, g.count(H_D));
            { SwaSoftF f = zf<SwaSoftF>(); f.c = c; go(f, f.count()); }
            NGemm p = mk_gemm(WSP(float, WS_SC), 0, S, Pb + H_D * HDS + KVH * HDS, 1, CD_N, 1, WSP(bf16_t, WS_MIX) + (size_t)b * S * D + HALF, 1, D, S, HDS, S);
            p.a_z1 = (long)G * S * S; p.a_z2 = (long)S * S; p.b_z1 = HDS; p.b_z2 = 0; p.c_z1 = (long)G * HDS; p.c_z2 = HDS; p.Z2 = G; go(p, p.count(H_D)); } } break;
    case PH_RN1: { RetNormF f = zf<RetNormF>(); f.c = c; go(f, f.count()); } break;
    default: break;
    }
}
template <class L> static void naive_offt(const L& go, const Ctx& c, int l) { OffF f = zf<OffF>(); f.c = c; f.l = l; go(f, f.count()); }

#ifdef HOST_TEST
template <class L> static void run_all(const L& go, const Ctx& c) {
    for (int ph = 0; ph < N_PHASES; ++ph) { naive_phase(go, c, ph); if (ph == PH_RT0 || ph == PH_RT1) naive_offt(go, c, ph == PH_RT1); }
}
#endif
#ifndef HOST_TEST
#define LAS __attribute__((address_space(3)))
#define GAS __attribute__((address_space(1)))
typedef unsigned v4u __attribute__((ext_vector_type(4)));
typedef unsigned u32x2 __attribute__((ext_vector_type(2)));
typedef float f32x4 __attribute__((ext_vector_type(4)));
typedef float f32x16 __attribute__((ext_vector_type(16)));
typedef short bf16x8 __attribute__((ext_vector_type(8)));
typedef short s16x4 __attribute__((ext_vector_type(4)));
typedef int v8i_t __attribute__((ext_vector_type(8)));
typedef int v4i_t __attribute__((ext_vector_type(4)));
typedef GAS unsigned gu32;
#define RLX_AGENT __ATOMIC_RELAXED, __HIP_MEMORY_SCOPE_AGENT
#define LDS_WAIT() asm volatile("s_waitcnt lgkmcnt(0)" ::: "memory")
#define VM_WAIT() asm volatile("s_waitcnt vmcnt(0)" ::: "memory")
constexpr int NWAVES = 8, NTHR = 512;
constexpr int LDS_BYTES = 147456, MISC_OFF = LDS_BYTES - 2048, TAB_OFF = MISC_OFF + 1024;
__device__ __forceinline__ int lane_id() { int l; asm volatile("v_mbcnt_lo_u32_b32 %0, -1, 0\n\tv_mbcnt_hi_u32_b32 %0, -1, %0" : "=v"(l)); return l; }
__device__ __forceinline__ unsigned cvt_pk_bf16(float lo, float hi) { unsigned r; asm volatile("v_cvt_pk_bf16_f32 %0, %1, %2" : "=v"(r) : "v"(lo), "v"(hi)); return r; }
__device__ __forceinline__ float fast_sigm(float x) { return __builtin_amdgcn_rcpf(1.0f + __builtin_amdgcn_exp2f(-1.4426950408889634f * x)); }
__device__ __forceinline__ float fast_silu(float x) { return x * fast_sigm(x); }
__device__ __forceinline__ float fast_gelu_tanh(float x) { const float z = 0.7978845608028654f * (x + 0.044715f * x * x * x); return x * fast_sigm(2.0f * z); }
__device__ __forceinline__ float wave_sum(float v) {
#pragma unroll
    for (int o = 1; o < 64; o <<= 1) v += __shfl_xor(v, o);
    return v; }

#define XB_TMO      128
#define XB_XCNT(j)  (256  + 64 * (j))
#define XB_XSUB(j)  (1280 + 64 * (j))
#define XB_XGEN(j)  (2304 + 64 * (j))
#define XB_TOP      3328
#define XB_TOPGEN   3392
#define XCD_BAR_WORDS 3456
#define XB_SPIN_CAP (1u << 20)
__device__ __forceinline__ unsigned xb_ld(unsigned* p)              { return __hip_atomic_load(p, __ATOMIC_RELAXED, __HIP_MEMORY_SCOPE_AGENT); }
__device__ __forceinline__ unsigned xb_add(unsigned* p, unsigned v) { return __hip_atomic_fetch_add(p, v, __ATOMIC_RELAXED, __HIP_MEMORY_SCOPE_AGENT); }
__device__ __forceinline__ unsigned xb_xcc_id() { return (unsigned)__builtin_amdgcn_s_getreg((3 << 11) | 20) & 0xFu; }
#define XB_SPIN(cond, bar) do { unsigned _sp = 0; while (cond) { __builtin_amdgcn_s_sleep(1); \
    if ((++_sp & 255u) == 0u) { if (xb_ld(&(bar)[XB_TMO])) break; if (_sp > XB_SPIN_CAP) { atomicAdd(&(bar)[XB_TMO], 1u); break; } } } } while (0)
struct XcdBarrier { unsigned* bar; unsigned x; volatile LAS unsigned* st; int wave; };
__device__ __forceinline__ XcdBarrier xcd_barrier_post(unsigned* bar, volatile LAS unsigned* st, int wave) {
    XcdBarrier b; b.bar = bar; b.x = xb_xcc_id(); b.st = st; b.wave = wave;
    if (wave == 0 && lane_id() == 0) (void)xb_add(&bar[XB_XCNT(b.x)], 1u);
    return b; }
__device__ __forceinline__ void xcd_barrier_complete(unsigned* bar, unsigned x, unsigned& nloc, unsigned& nx) {
    const unsigned G = gridDim.x * gridDim.y * gridDim.z;
    unsigned sum, cnt, mine, sp = 0u;
    for (;;) {
        sum = 0u; cnt = 0u; mine = 0u;
#pragma unroll
        for (unsigned j = 0; j < 16; ++j) { const unsigned c = xb_ld(&bar[XB_XCNT(j)]); sum += c; cnt += (c > 0u) ? 1u : 0u; mine = (j == x) ? c : mine; }
        if (sum == G) break;
        __builtin_amdgcn_s_sleep(1);
        if ((++sp & 255u) == 0u) { if (xb_ld(&bar[XB_TMO])) break; if (sp > XB_SPIN_CAP) { atomicAdd(&bar[XB_TMO], 1u); break; } }
    }
    nloc = mine > 0u ? mine : 1u; nx = cnt > 0u ? cnt : 1u; }
__device__ __forceinline__ void xcd_barrier(const XcdBarrier& b) {
    asm volatile("s_waitcnt vmcnt(0)" ::: "memory");
    __syncthreads();
    if (b.wave == 0 && lane_id() == 0) {
        unsigned* bar = b.bar;
        __builtin_amdgcn_s_waitcnt(0);
        unsigned nloc = b.st[0], nx = b.st[1];
        if (nloc == 0u) { xcd_barrier_complete(bar, b.x, nloc, nx); b.st[0] = nloc; b.st[1] = nx; }
        const unsigned old = xb_add(&bar[XB_XSUB(b.x)], 1u);
        const unsigned gen = old / nloc;
        if (old + 1u == (gen + 1u) * nloc) {
            __builtin_amdgcn_fence(__ATOMIC_RELEASE, "agent");
            asm volatile("s_waitcnt vmcnt(0)" ::: "memory");
            const unsigned og = xb_add(&bar[XB_TOP], 1u);
            const unsigned tg = og / nx;
            if (og + 1u == (tg + 1u) * nx) xb_add(&bar[XB_TOPGEN], 1u);
            else XB_SPIN(xb_ld(&bar[XB_TOPGEN]) == tg, bar);
            __builtin_amdgcn_fence(__ATOMIC_ACQUIRE, "agent");
            xb_add(&bar[XB_XGEN(b.x)], 1u);
            asm volatile("s_waitcnt vmcnt(0)" ::: "memory");
        } else {
            XB_SPIN(xb_ld(&bar[XB_XGEN(b.x)]) == gen, bar);
            __builtin_amdgcn_fence(__ATOMIC_ACQUIRE, "agent");
            asm volatile("s_waitcnt vmcnt(0)" ::: "memory");
        }
    }
    __syncthreads();
}

namespace pg8 {
constexpr int BM = 256, BK = 64, HALFT = 128, HTB = HALFT * BK * 2, STAGE_BYTES = 8 * HTB, NXCD = 8, WGM = 8;
__host__ __device__ __forceinline__ int lds_byte(int r, int c) { const int st = (r >> 4) * 2 + (c >> 5), rr = r & 15, cc = c & 31, ob = rr * 64 + cc * 2; return st * 1024 + (ob ^ (((ob >> 9) & 1) << 5)); }
__host__ __device__ __forceinline__ void stage_rc(int b, int& R, int& C) { const int st = b / 1024, sb = b % 1024, swz = sb ^ (((sb >> 9) & 1) << 5); R = (st >> 1) * 16 + swz / 64; C = (st & 1) * 32 + (swz % 64) / 2; }
__host__ __device__ __forceinline__ int perm32(int rho) { const int n = rho >> 4, i = rho & 15; return 8 * (i >> 2) + 4 * n + (i & 3); }
struct Unit { const char* A; const char* B; int pm, pn, e, r0; };
__device__ __forceinline__ void tile_of(int L, int nM, int nN, int& pm, int& pn) {
    const int nwg = nM * nN; int wgid = L; { const int q = nwg / NXCD, r = nwg % NXCD, xcd = wgid % NXCD, off = wgid / NXCD; wgid = (xcd < r ? xcd * (q + 1) : r * (q + 1) + (xcd - r) * q) + off; }
    const int nig = WGM * nN, gid = wgid / nig, fm = gid * WGM, gsz = (nM - fm) < WGM ? (nM - fm) : WGM;
    pm = fm + ((wgid % nig) % gsz); pn = (wgid % nig) / gsz; }
template <class E_, class = void> struct perm16_t { static constexpr bool value = false; };
template <class E_> struct perm16_t<E_, decltype((void)E_::PERM16)> { static constexpr bool value = E_::PERM16; };
template <class E_> constexpr bool perm16_v = perm16_t<E_>::value;
struct APlain { static __device__ __forceinline__ const char* kt(const char* base, int t, int) { return base + (size_t)t * (BK * 2); } };
struct AConv { static __device__ __forceinline__ const char* kt(const char* base, int t, int lda) { return base + (long)((t >> 1) - 2) * (lda * 2) + (t & 1) * (BK * 2); } };

template <class Epi, class Sched, class AP, bool GATHER, bool ALIGN_EPI, int EB = 2>
__device__ __forceinline__ void gemm_phase(LAS unsigned char* lds, const int wave, const char* base, const int lda, const int ldb, const int K, const Sched& S, const Epi& E) {
    const __amdgpu_buffer_rsrc_t rsrc = __builtin_amdgcn_make_buffer_rsrc((void*)base, (short)0, -1, 0x00020000);
    const int wid = __builtin_amdgcn_readfirstlane(wave), lane = lane_id(), tid = wid * 64 + lane, wr = wid >> 2, wc = wid & 3, fr = lane & 15, fq = lane >> 4;
    const int nt = K / BK;
    unsigned vA[2][2], vAn[2][2], vB[2], vB1[2];
#pragma unroll
    for (int i = 0; i < 2; ++i) { int R, C; stage_rc(tid * 16 + i * 8192, R, C); const int Rb = Epi::PERM ? ((R & ~31) + perm32(R & 31)) : R;
        if constexpr (perm16_v<Epi>) { const int wcR = R >> 5, rho = R & 31, n_ = rho >> 4, i_ = rho & 15; const int src0 = 64 * wcR + 16 * (i_ >> 2) + 4 * n_ + (i_ & 3);
            vB[i] = (unsigned)(src0 * ldb + C) * 2u; vB1[i] = (unsigned)((src0 + 8) * ldb + C) * 2u; }
        else { vB[i] = (unsigned)(Rb * ldb + C) * 2u; vB1[i] = 0u; }
#pragma unroll
        for (int h = 0; h < 2; ++h) { vA[h][i] = GATHER ? (unsigned)C * 2u : (h == 0 ? (unsigned)(R * lda + C) * 2u : 0u); vAn[h][i] = vA[h][i]; } }
    const size_t kstep = (size_t)(BK * 2), hstepB = (size_t)HALFT * ldb * 2, hB1 = perm16_v<Epi> ? 0 : hstepB;
    const unsigned (&vBs)[2] = perm16_v<Epi> ? vB1 : vB;
    const unsigned (&vA1)[2] = GATHER ? vA[1] : vA[0]; const size_t hA1 = GATHER ? 0 : (size_t)HALFT * lda * 2;
    const unsigned ldsw = (unsigned)wid * 1024u;
    const int aoff = lds_byte(wr * 64 + fr, fq * 8), boff = lds_byte(wc * 32 + fr, fq * 8);
#define PG8_SA(b, h) (((b) * 2 + (h)) * HTB)
#define PG8_SB(b, h) ((4 + (b) * 2 + (h)) * HTB)
#define PG8_STAGE(bufoff, gbase, voff) do { const int so_ = (int)(unsigned)(size_t)((const char*)(gbase) - base); _Pragma("unroll") for (int _i = 0; _i < 2; ++_i) \
        __builtin_amdgcn_raw_ptr_buffer_load_lds(rsrc, (LAS void*)(lds + (bufoff) + ldsw + _i * 8192), 16, (int)(voff)[_i], so_, 0, 0); } while (0)
#define PG8_LDA(dst, b, h) do { _Pragma("unroll") for (int m = 0; m < 4; ++m) { if constexpr (EB == 2) { _Pragma("unroll") for (int k = 0; k < 2; ++k) dst[m][k] = *(const LAS bf16x8*)(lds + PG8_SA(b, h) + aoff + m * 2048 + k * 1024); } \
        else { const v4i_t lo_ = *(const LAS v4i_t*)(lds + PG8_SA(b, h) + aoff + m * 2048), hi_ = *(const LAS v4i_t*)(lds + PG8_SA(b, h) + aoff + m * 2048 + 1024); dst##8[m] = __builtin_shufflevector(lo_, hi_, 0, 1, 2, 3, 4, 5, 6, 7); } } } while (0)
#define PG8_LDB(dst, b, h) do { _Pragma("unroll") for (int n = 0; n < 2; ++n) { if constexpr (EB == 2) { _Pragma("unroll") for (int k = 0; k < 2; ++k) dst[n][k] = *(const LAS bf16x8*)(lds + PG8_SB(b, h) + boff + n * 2048 + k * 1024); } \
        else { const v4i_t lo_ = *(const LAS v4i_t*)(lds + PG8_SB(b, h) + boff + n * 2048), hi_ = *(const LAS v4i_t*)(lds + PG8_SB(b, h) + boff + n * 2048 + 1024); dst##8[n] = __builtin_shufflevector(lo_, hi_, 0, 1, 2, 3, 4, 5, 6, 7); } } } while (0)
#define PG8_MMA(ai, bj, At, Bt) do { __builtin_amdgcn_s_setprio(1); _Pragma("unroll") for (int m = 0; m < 4; ++m) _Pragma("unroll") for (int n = 0; n < 2; ++n) { \
        if constexpr (EB == 2) { _Pragma("unroll") for (int k = 0; k < 2; ++k) acc[ai][bj][m][n] = __builtin_amdgcn_mfma_f32_16x16x32_bf16(Bt[n][k], At[m][k], acc[ai][bj][m][n], 0, 0, 0); } \
        else acc[ai][bj][m][n] = __builtin_amdgcn_mfma_scale_f32_16x16x128_f8f6f4(Bt##8[n], At##8[m], acc[ai][bj][m][n], 0, 0, 0, 0x7F7F7F7F, 0, 0x7F7F7F7F); } \
        __builtin_amdgcn_s_setprio(0); } while (0)
#define PG8_WAIT_V(n) asm volatile("s_waitcnt vmcnt(" #n ")" ::: "memory")
#define PG8_WAIT_L(n) asm volatile("s_waitcnt lgkmcnt(" #n ")" ::: "memory")
#define PG8_BAR __builtin_amdgcn_s_barrier()
#define PG8_SCHED __builtin_amdgcn_sched_barrier(0)
    Unit cur, nxt; int ui = 0;
    if (!S.next(0, cur)) return;
    f32x4 acc[2][2][4][2];
#pragma unroll
    for (int a = 0; a < 2; ++a)
#pragma unroll
        for (int b = 0; b < 2; ++b)
#pragma unroll
            for (int m = 0; m < 4; ++m)
#pragma unroll
                for (int n = 0; n < 2; ++n) acc[a][b][m][n] = (f32x4){0.f, 0.f, 0.f, 0.f};
    bf16x8 At[4][2], B0[2][2], B1[2][2]; v8i_t At8[4], B08[2], B18[2];
    if constexpr (GATHER) {
#pragma unroll
        for (int h = 0; h < 2; ++h)
#pragma unroll
            for (int i = 0; i < 2; ++i) { int R_, C_; stage_rc(tid * 16 + i * 8192, R_, C_); vA[h][i] = (unsigned)S.row(cur, h * HALFT + R_) * (unsigned)(lda * 2) + (unsigned)C_ * 2u; vAn[h][i] = vA[h][i]; }
        PG8_WAIT_V(0);
    }
    const char* cA = cur.A; const char* cB = cur.B;
    PG8_STAGE(PG8_SB(0, 0), cB, vB); PG8_STAGE(PG8_SB(0, 1), cB + hB1, vBs); PG8_STAGE(PG8_SA(0, 0), AP::kt(cA, 0, lda), vA[0]); PG8_STAGE(PG8_SA(0, 1), AP::kt(cA, 0, lda) + hA1, vA1);
    if (wr == 1) PG8_BAR;
    PG8_WAIT_V(2); PG8_BAR;
    PG8_STAGE(PG8_SB(1, 0), cB + kstep, vB); PG8_STAGE(PG8_SA(1, 0), AP::kt(cA, 1, lda), vA[0]); PG8_STAGE(PG8_SB(1, 1), cB + hB1 + kstep, vBs);
    PG8_WAIT_V(6); PG8_BAR;
    for (;;) {
        const bool has_next = S.next(ui + 1, nxt);
        const char* nA = has_next ? nxt.A : cA; const char* nB = has_next ? nxt.B : cB;
        if constexpr (GATHER) {
            if (has_next) {
#pragma unroll
                for (int h = 0; h < 2; ++h)
#pragma unroll
                    for (int i = 0; i < 2; ++i) { int R_, C_; stage_rc(tid * 16 + i * 8192, R_, C_); vAn[h][i] = (unsigned)S.row(nxt, h * HALFT + R_) * (unsigned)(lda * 2) + (unsigned)C_ * 2u; }
                PG8_WAIT_V(0);
            }
        }
#pragma unroll 1
        for (int t = 0; t < nt; t += 2) {
            const bool last = (t == nt - 2);
            const char* a1 = AP::kt(cA, t + 1, lda);
            const char* a2 = last ? AP::kt(nA, 0, lda) : AP::kt(cA, t + 2, lda); const char* a3 = last ? AP::kt(nA, 1, lda) : AP::kt(cA, t + 3, lda);
            const char* b2 = last ? nB : cB + (size_t)(t + 2) * kstep; const char* b3 = b2 + kstep;
            PG8_LDB(B0, 0, 0); PG8_LDB(B1, 0, 1); PG8_SCHED; PG8_LDA(At, 0, 0); PG8_STAGE(PG8_SA(1, 1), a1 + hA1, vA1);
            if constexpr (GATHER) { if (last) { _Pragma("unroll") for (int h = 0; h < 2; ++h) _Pragma("unroll") for (int i = 0; i < 2; ++i) vA[h][i] = vAn[h][i]; } }
            PG8_WAIT_V(8); PG8_WAIT_L(0); PG8_BAR; PG8_MMA(0, 0, At, B0); PG8_MMA(0, 1, At, B1); PG8_BAR; PG8_SCHED;
            PG8_LDA(At, 0, 1); PG8_STAGE(PG8_SB(0, 0), b2, vB); PG8_STAGE(PG8_SB(0, 1), b2 + hB1, vBs); PG8_STAGE(PG8_SA(0, 0), a2, vA[0]);
            PG8_WAIT_V(8); PG8_WAIT_L(0); PG8_BAR; PG8_MMA(1, 0, At, B0); PG8_MMA(1, 1, At, B1); PG8_BAR; PG8_SCHED;
            PG8_LDB(B0, 1, 0); PG8_LDB(B1, 1, 1); PG8_SCHED; PG8_LDA(At, 1, 0); PG8_STAGE(PG8_SA(0, 1), a2 + hA1, vA1);
            PG8_WAIT_V(8); PG8_WAIT_L(0); PG8_BAR; PG8_MMA(0, 0, At, B0); PG8_MMA(0, 1, At, B1); PG8_BAR; PG8_SCHED;
            PG8_LDA(At, 1, 1); PG8_STAGE(PG8_SB(1, 0), b3, vB); PG8_STAGE(PG8_SB(1, 1), b3 + hB1, vBs); PG8_STAGE(PG8_SA(1, 0), a3, vA[0]);
            PG8_WAIT_V(8); PG8_WAIT_L(0); PG8_BAR; PG8_MMA(1, 0, At, B0); PG8_MMA(1, 1, At, B1); PG8_BAR; PG8_SCHED;
        }
        if constexpr (ALIGN_EPI) { if (wr == 0) PG8_BAR; }
        { const int l2_ = lane_id();
          E(acc, cur, wr, wc, l2_ & 15, l2_ >> 4);
#ifdef PROBE_EPI2
          if (Epi::PROBE2) { asm volatile("s_waitcnt vmcnt(0)" ::: "memory"); E(acc, cur, wr, wc, l2_ & 15, l2_ >> 4); }
#endif
          }
        if (!has_next) break;
#pragma unroll
        for (int a = 0; a < 2; ++a)
#pragma unroll
            for (int b = 0; b < 2; ++b)
#pragma unroll
                for (int m = 0; m < 4; ++m)
#pragma unroll
                    for (int n = 0; n < 2; ++n) acc[a][b][m][n] = (f32x4){0.f, 0.f, 0.f, 0.f};
        cur = nxt; cA = nA; cB = nB; ++ui;
        if constexpr (GATHER) {
#pragma unroll
            for (int h = 0; h < 2; ++h)
#pragma unroll
                for (int i = 0; i < 2; ++i) vA[h][i] = vAn[h][i];
        }
        if constexpr (ALIGN_EPI) { if (wr == 1) PG8_BAR; }
    }
    PG8_WAIT_V(0);
    if constexpr (!ALIGN_EPI) { if (wr == 0) PG8_BAR; }
    PG8_BAR;
#undef PG8_SA
#undef PG8_SB
#undef PG8_STAGE
#undef PG8_LDA
#undef PG8_LDB
#undef PG8_MMA
#undef PG8_WAIT_V
#undef PG8_WAIT_L
#undef PG8_BAR
#undef PG8_SCHED
}

struct DenseOrder {
    const char* A; const char* B; int nM, nN, G, c; long a_tile, b_tile;
    __device__ __forceinline__ bool next(int i, Unit& u) const { const long L = (long)i * G + c; if (L >= (long)nM * nN) return false; int pm, pn; tile_of((int)L, nM, nN, pm, pn);
        u.pm = pm; u.pn = pn; u.e = 0; u.r0 = pm * BM; u.A = A + (size_t)pm * a_tile; u.B = B + (size_t)pn * b_tile; return true; }
    __device__ __forceinline__ int row(const Unit&, int) const { return 0; }
};
}
namespace pg8 {
typedef const f32x4 (&AccRef)[2][2][4][2];
__device__ __forceinline__ const LAS int* lds_tab() { unsigned a; asm volatile("v_mov_b32 %0, %1" : "=v"(a) : "i"(TAB_OFF)); return (const LAS int*)(size_t)a; }
__device__ __forceinline__ v4u pack8(const f32x4 a, const f32x4 b) { v4u w; w.x = cvt_pk_bf16(a[0], a[1]); w.y = cvt_pk_bf16(a[2], a[3]); w.z = cvt_pk_bf16(b[0], b[1]); w.w = cvt_pk_bf16(b[2], b[3]); return w; }

struct EpiOut {
    static constexpr bool PERM = false; static constexpr bool PROBE2 = false;
    const float* Xin; float* Xout; const float* g;
    __device__ __forceinline__ void operator()(AccRef acc, const Unit& u, int wr, int wc, int fr, int fq) const {
        const int b = u.r0 / S; const int col0 = u.pn * BM + wc * 32 + 4 * fq; f32x4 gv[2][2];
#pragma unroll
        for (int bj = 0; bj < 2; ++bj)
#pragma unroll
            for (int n = 0; n < 2; ++n) gv[bj][n] = *(const f32x4*)(g + (size_t)b * 6 * D + col0 + bj * HALFT + n * 16);
#pragma unroll
        for (int ai = 0; ai < 2; ++ai) { f32x4 xi[4][2][2];
#pragma unroll
            for (int m = 0; m < 4; ++m) { const size_t off = (size_t)(u.r0 + ai * HALFT + wr * 64 + m * 16 + fr) * D + col0;
#pragma unroll
                for (int bj = 0; bj < 2; ++bj)
#pragma unroll
                    for (int n = 0; n < 2; ++n) xi[m][bj][n] = *(const f32x4*)(Xin + off + bj * HALFT + n * 16); }
#pragma unroll
            for (int m = 0; m < 4; ++m) { const size_t off = (size_t)(u.r0 + ai * HALFT + wr * 64 + m * 16 + fr) * D + col0;
#pragma unroll
                for (int bj = 0; bj < 2; ++bj)
#pragma unroll
                    for (int n = 0; n < 2; ++n) *(f32x4*)(Xout + off + bj * HALFT + n * 16) = xi[m][bj][n] + gv[bj][n] * acc[ai][bj][m][n]; }
            asm volatile("" ::: "memory"); }
    }
};
struct EpiG1 {
    static constexpr bool PERM = true; static constexpr bool PROBE2 = false;
    bf16_t* proj; bf16_t* lxp; float* ssq;
    __device__ __forceinline__ void operator()(AccRef acc, const Unit& u, int wr, int wc, int fr, int fq) const {
        const int pn = u.pn; const int c0 = pn * BM + wc * 32 + 8 * fq; const int NT_LAT = (QR + KVR) / BM, NT_X = LW / BM;
#pragma unroll
        for (int ai = 0; ai < 2; ++ai)
#pragma unroll
            for (int m = 0; m < 4; ++m) { const int row = u.r0 + ai * HALFT + wr * 64 + m * 16 + fr; float ss = 0.f;
#pragma unroll
                for (int bj = 0; bj < 2; ++bj) { f32x4 v0 = acc[ai][bj][m][0], v1 = acc[ai][bj][m][1];
                    if (pn < NT_LAT) { ss += (v0[0] * v0[0] + v0[1] * v0[1]) + (v0[2] * v0[2] + v0[3] * v0[3]) + (v1[0] * v1[0] + v1[1] * v1[1]) + (v1[2] * v1[2] + v1[3] * v1[3]); }
                    if (pn >= NT_LAT + NT_X) {
#pragma unroll
                        for (int j = 0; j < 4; ++j) { v0[j] = fast_gelu_tanh(v0[j]); v1[j] = fast_gelu_tanh(v1[j]); } }
                    const v4u w = pack8(v0, v1);
                    *(v4u*)(proj + (size_t)row * P0_N + c0 + bj * HALFT) = w;
                    if (pn >= NT_LAT && pn < NT_LAT + NT_X) { const int b = row / S, t = row % S; *(v4u*)(lxp + ((size_t)b * (S + 4) + 2 + t) * LW + (c0 + bj * HALFT - (QR + KVR))) = w; } }
                if (pn < NT_LAT) { ss += __shfl_xor(ss, 16); ss += __shfl_xor(ss, 32); if (fq == 0) ssq[(size_t)row * 16 + pn * 4 + wc] = ss; } }
    }
};
struct EpiG2 {
    static constexpr bool PERM = true; static constexpr bool PROBE2 = false;
    bf16_t* Q; bf16_t* KC; bf16_t* V; const float* ssq; const float* cosr; const float* sinr; float qs;
    __device__ __forceinline__ void operator()(AccRef acc, const Unit& u, int wr, int wc, int fr, int fq) const {
        const int pn = u.pn; const int NQ_N = H_A * NOPE / BM, NQ = H_A * QK / BM;
#pragma unroll
        for (int ai = 0; ai < 2; ++ai)
#pragma unroll
            for (int m = 0; m < 4; ++m) { const int row = u.r0 + ai * HALFT + wr * 64 + m * 16 + fr;
                if (pn < NQ_N) { const float rs = 1.0f / sqrtf(ssq8(ssq + (size_t)row * 16) * (1.0f / QR) + EPS) * qs;
#pragma unroll
                    for (int bj = 0; bj < 2; ++bj) { const int h = 2 * pn + bj; *(v4u*)(Q + ((size_t)row * H_A + h) * QK + wc * 32 + 8 * fq) = pack8(acc[ai][bj][m][0] * rs, acc[ai][bj][m][1] * rs); } }
                else if (pn < NQ) { const float rs = 1.0f / sqrtf(ssq8(ssq + (size_t)row * 16) * (1.0f / QR) + EPS) * qs; const int h = 4 * (pn - NQ_N) + wc, t = row % S;
                    const f32x4 c0 = *(const f32x4*)(cosr + t * (ROPE / 2) + 8 * fq), c1 = *(const f32x4*)(cosr + t * (ROPE / 2) + 8 * fq + 4), s0 = *(const f32x4*)(sinr + t * (ROPE / 2) + 8 * fq), s1 = *(const f32x4*)(sinr + t * (ROPE / 2) + 8 * fq + 4);
                    const f32x4 x10 = acc[ai][0][m][0] * rs, x11 = acc[ai][0][m][1] * rs, x20 = acc[ai][1][m][0] * rs, x21 = acc[ai][1][m][1] * rs;
                    bf16_t* q = Q + ((size_t)row * H_A + h) * QK + NOPE + 8 * fq;
                    *(v4u*)q = pack8(x10 * c0 - x20 * s0, x11 * c1 - x21 * s1); *(v4u*)(q + ROPE / 2) = pack8(x20 * c0 + x10 * s0, x21 * c1 + x11 * s1); }
                else { const float rs = 1.0f / sqrtf(ssq8(ssq + (size_t)row * 16 + 8) * (1.0f / KVR) + EPS); const int h = pn - NQ;
                    *(v4u*)(KC + ((size_t)row * H_A + h) * QK + wc * 32 + 8 * fq) = pack8(acc[ai][0][m][0] * rs, acc[ai][0][m][1] * rs);
                    *(v4u*)(V + ((size_t)row * H_A + h) * VD + wc * 32 + 8 * fq) = pack8(acc[ai][1][m][0] * rs, acc[ai][1][m][1] * rs); } }
    }
};
struct OrderG2 {
    const char* A; const char* Bq; const char* Bkv; int G, c;
    __device__ __forceinline__ bool next(int i, Unit& u) const { const int nN = (H_A * QK + H_A * (NOPE + VD)) / BM, nM = M / BM; const long L = (long)i * G + c; if (L >= (long)nM * nN) return false; int pm, pn; tile_of((int)L, nM, nN, pm, pn);
        const int NQ = H_A * QK / BM; u.pm = pm; u.pn = pn; u.e = 0; u.r0 = pm * BM; u.A = A + (size_t)pm * BM * P0_N * 2 + (pn < NQ ? 0 : QR * 2);
        u.B = pn < NQ ? Bq + (size_t)pn * BM * QR * 2 : Bkv + (size_t)(pn - NQ) * BM * KVR * 2; return true; }
    __device__ __forceinline__ int row(const Unit&, int) const { return 0; }
};
struct EpiGates {
    static constexpr bool PERM = true; static constexpr bool PROBE2 = false;
    bf16_t* LA; bf16_t* U; const bf16_t* lxp; const float* gb; const float* cl; const float* convw; const float* convb;
    __device__ __forceinline__ void operator()(AccRef acc, const Unit& u, int wr, int wc, int fr, int fq) const {
        const int g = u.pn >> 1, d = u.pn & 1; const int ch0 = g * LBS + wc * 32 + 8 * fq; const int b = u.r0 / S;
        f32x4 ba[2], bx[2], clv[2], cb[2], cw[4][2];
#pragma unroll
        for (int n = 0; n < 2; ++n) { const int ch = ch0 + 4 * n; ba[n] = *(const f32x4*)(gb + (d * 2 + 0) * LW + ch); bx[n] = *(const f32x4*)(gb + (d * 2 + 1) * LW + ch); clv[n] = *(const f32x4*)(cl + d * LW + ch); cb[n] = *(const f32x4*)(convb + ch);
#pragma unroll
            for (int j = 0; j < 4; ++j) cw[j][n] = *(const f32x4*)(convw + j * LW + ch); }
#pragma unroll
        for (int ai = 0; ai < 2; ++ai)
#pragma unroll
            for (int m = 0; m < 4; ++m) { const int row = u.r0 + ai * HALFT + wr * 64 + m * 16 + fr; const int t = row % S; f32x4 la[2], uu[2], xc[2] = {cb[0], cb[1]};
                v4u raw[4];
#pragma unroll
                for (int j = 0; j < 4; ++j) raw[j] = *(const v4u*)(lxp + ((size_t)b * (S + 4) + t + j) * LW + ch0);
#pragma unroll
                for (int j = 0; j < 4; ++j)
#pragma unroll
                    for (int n = 0; n < 2; ++n) { const unsigned r0_ = raw[j][2 * n], r1_ = raw[j][2 * n + 1];
                        xc[n][0] += cw[j][n][0] * __uint_as_float(r0_ << 16); xc[n][1] += cw[j][n][1] * __uint_as_float(r0_ & 0xffff0000u); xc[n][2] += cw[j][n][2] * __uint_as_float(r1_ << 16); xc[n][3] += cw[j][n][3] * __uint_as_float(r1_ & 0xffff0000u); }
#pragma unroll
                for (int n = 0; n < 2; ++n)
#pragma unroll
                    for (int j = 0; j < 4; ++j) { const float l = clv[n][j] * fast_sigm(acc[ai][0][m][n][j] + ba[n][j]); const float x2 = 2.0f * l;
                        const float em = -x2 * (1.0f + 0.5f * x2 * (1.0f + (1.0f / 3.0f) * x2 * (1.0f + 0.25f * x2 * (1.0f + 0.2f * x2))));
                        la[n][j] = l; uu[n][j] = sqrtf(em) * fast_sigm(acc[ai][1][m][n][j] + bx[n][j]) * xc[n][j]; }
                const long o = lru_idx(d, b, t, ch0); *(v4u*)(LA + o) = pack8(la[0], la[1]); *(v4u*)(U + o) = pack8(uu[0], uu[1]); }
    }
};
struct OrderGates {
    const char* lxp; const char* B; int G, c;
    __device__ __forceinline__ bool next(int i, Unit& u) const { const int nN = 2 * (LW / LBS), nM = M / BM; const long L = (long)i * G + c; if (L >= (long)nM * nN) return false; int pm, pn; tile_of((int)L, nM, nN, pm, pn);
        u.pm = pm; u.pn = pn; u.e = 0; u.r0 = pm * BM; const int b = u.r0 / S, t0 = u.r0 % S, g = pn >> 1;
        u.A = lxp + (((size_t)b * (S + 4) + 2 + t0) * LW + g * LBS) * 2; u.B = B + (size_t)pn * BM * (4 * LBS) * 2; return true; }
    __device__ __forceinline__ int row(const Unit&, int) const { return 0; }
};
struct EpiG3 {
    static constexpr bool PERM = true; static constexpr bool PROBE2 = false;
    bf16_t* proj; const float* cost; const float* sint; float sqs;
    __device__ __forceinline__ void operator()(AccRef acc, const Unit& u, int wr, int wc, int fr, int fq) const {
        const int pn = u.pn; const int NH = H_C * DK / BM;
#pragma unroll
        for (int ai = 0; ai < 2; ++ai)
#pragma unroll
            for (int m = 0; m < 4; ++m) { const int row = u.r0 + ai * HALFT + wr * 64 + m * 16 + fr; bf16_t* p = proj + (size_t)row * CD_N + pn * BM + wc * 32 + 8 * fq;
                if (pn < 2 * NH) { const int t = row % S, i0 = wc * 32 + 8 * fq; const float sc = pn < NH ? 1.0f : 1.0f / sqrtf((float)DK);
                    const f32x4 c0 = *(const f32x4*)(cost + t * (DK / 2) + i0) * sc, c1 = *(const f32x4*)(cost + t * (DK / 2) + i0 + 4) * sc, s0 = *(const f32x4*)(sint + t * (DK / 2) + i0) * sc, s1 = *(const f32x4*)(sint + t * (DK / 2) + i0 + 4) * sc;
                    const f32x4 x10 = acc[ai][0][m][0], x11 = acc[ai][0][m][1], x20 = acc[ai][1][m][0], x21 = acc[ai][1][m][1];
                    *(v4u*)p = pack8(x10 * c0 - x20 * s0, x11 * c1 - x21 * s1); *(v4u*)(p + HALFT) = pack8(x20 * c0 + x10 * s0, x21 * c1 + x11 * s1); }
                else {
#pragma unroll
                    for (int bj = 0; bj < 2; ++bj) { f32x4 v0 = acc[ai][bj][m][0], v1 = acc[ai][bj][m][1];
                        if (pn >= 3 * NH && pn < 4 * NH) {
#pragma unroll
                            for (int j = 0; j < 4; ++j) { v0[j] = fast_silu(v0[j]); v1[j] = fast_silu(v1[j]); } }
                        else if (pn >= 4 * NH && pn < 4 * NH + H_D * HDS / BM) { v0 = v0 * sqs; v1 = v1 * sqs; }
                        *(v4u*)(p + bj * HALFT) = pack8(v0, v1); } } }
    }
};
struct OrderMoe {
    const LAS int* offt; const char* A; const char* B; const int* tok; int npn, G, c, gather; long b_exp, b_tile, a_tile;
    __device__ __forceinline__ bool next(int i, Unit& u) const { const long L = (long)i * G + c; const int T = (int)(L / npn); if (T >= offt[E + 1]) return false; const int e = ((const LAS unsigned char*)(offt + 2 * E + 4))[T];
        u.e = e; u.pn = (int)(L % npn); u.pm = T - offt[e]; u.r0 = T * BM; u.A = gather ? A : A + (size_t)T * a_tile; u.B = B + (size_t)e * b_exp + (size_t)u.pn * b_tile; return true; }
    __device__ __forceinline__ int row(const Unit& u, int r) const { const int rank = u.pm * BM + r; if (u.e == E) return rank; const int n = offt[E + 2 + u.e]; return rank < n ? tok[(size_t)u.e * M + rank] : 0; }
};
__device__ __forceinline__ float sat_fp8(float v) { return __builtin_amdgcn_fmed3f(v, -448.0f, 448.0f); }
__device__ __forceinline__ unsigned pack_fp8x4(float a, float b, float c, float d) { int w = __builtin_amdgcn_cvt_pk_fp8_f32(sat_fp8(a), sat_fp8(b), 0, false); return (unsigned)__builtin_amdgcn_cvt_pk_fp8_f32(sat_fp8(c), sat_fp8(d), w, true); }
constexpr float F8_H = 4.0f, F8_GU = 32.0f, F8_ACT = 8.0f, F8_DN = 16.0f, F8_Y = 16.0f;
struct EpiM1F8 {
    static constexpr bool PERM = true; static constexpr bool PROBE2 = false;
    unsigned char* ws;
    __device__ __forceinline__ void operator()(AccRef acc, const Unit& u, int wr, int wc, int fr, int fq) const {
        constexpr float inv = 1.0f / (F8_H * F8_GU); unsigned char* act = ws + WS_ACT;
#pragma unroll
        for (int ai = 0; ai < 2; ++ai)
#pragma unroll
            for (int m = 0; m < 4; ++m) { const int row = u.r0 + ai * HALFT + wr * 64 + m * 16 + fr; f32x4 v[2];
#pragma unroll
                for (int n = 0; n < 2; ++n)
#pragma unroll
                    for (int j = 0; j < 4; ++j) v[n][j] = fast_silu(acc[ai][0][m][n][j] * inv) * (acc[ai][1][m][n][j] * (inv * F8_ACT));
                u32x2 w; w.x = pack_fp8x4(v[0][0], v[0][1], v[0][2], v[0][3]); w.y = pack_fp8x4(v[1][0], v[1][1], v[1][2], v[1][3]);
                *(u32x2*)(act + (size_t)row * FF + u.pn * HALFT + wc * 32 + 8 * fq) = w; }
    }
};
template <int NPN, bool GATH, size_t A_OFF, size_t B_OFF, long B_EXP, long B_TILE, long A_TILE>
struct OrderMoeT {
    const unsigned char* ws; int G, c;
    __device__ __forceinline__ bool next(int i, Unit& u) const { const LAS int* offt = lds_tab();
#ifdef MOE_CONTIG
        if (i >= c) return false; const int L = G + i; const int T = L / NPN;
#else
        const long L = (long)i * G + c; const int T = (int)(L / NPN); if (T >= __builtin_amdgcn_readfirstlane(offt[E + 1])) return false;
#endif
        const int e = __builtin_amdgcn_readfirstlane((int)((const LAS unsigned char*)(offt + 2 * E + 4))[T]);
        u.e = e; u.pn = (int)(L % NPN); u.pm = T - __builtin_amdgcn_readfirstlane(offt[e]); u.r0 = T * BM; u.A = (const char*)ws + A_OFF + (GATH ? 0 : (size_t)T * A_TILE); u.B = (const char*)ws + B_OFF + (size_t)e * B_EXP + (size_t)u.pn * B_TILE; return true; }
    __device__ __forceinline__ int row(const Unit& u, int r) const { const int rank = u.pm * BM + r; if (u.e == E) return rank; const int n = lds_tab()[E + 2 + u.e]; return rank < n ? ((const int*)(ws + WS_TOK))[(size_t)u.e * M + rank] : 0; }
};
struct EpiM2F8 {
    static constexpr bool PERM = true; static constexpr bool PERM16 = true; static constexpr bool PROBE2 = false;
    unsigned char* ws;
    __device__ __forceinline__ void operator()(AccRef acc, const Unit& u, int wr, int wc, int fr, int fq) const {
        constexpr float w = F8_Y / (F8_ACT * F8_DN); unsigned char* Y = ws + WS_Y;
#pragma unroll
        for (int ai = 0; ai < 2; ++ai)
#pragma unroll
            for (int m = 0; m < 4; ++m) { const int rr = ai * HALFT + wr * 64 + m * 16 + fr; v4u o;
#pragma unroll
                for (int bj = 0; bj < 2; ++bj) { const f32x4 a = acc[ai][bj][m][0] * w, b = acc[ai][bj][m][1] * w; o[2 * bj] = pack_fp8x4(a[0], a[1], a[2], a[3]); o[2 * bj + 1] = pack_fp8x4(b[0], b[1], b[2], b[3]); }
                *(v4u*)(Y + (size_t)(u.r0 + rr) * D + u.pn * BM + wc * 64 + 16 * fq) = o; }
    }
};
struct EpiM1 {
    static constexpr bool PERM = true; static constexpr bool PROBE2 = false;
    bf16_t* act;
    __device__ __forceinline__ void operator()(AccRef acc, const Unit& u, int wr, int wc, int fr, int fq) const {
#pragma unroll
        for (int ai = 0; ai < 2; ++ai)
#pragma unroll
            for (int m = 0; m < 4; ++m) { const int row = u.r0 + ai * HALFT + wr * 64 + m * 16 + fr; f32x4 v[2];
#pragma unroll
                for (int n = 0; n < 2; ++n)
#pragma unroll
                    for (int j = 0; j < 4; ++j) v[n][j] = fast_silu(acc[ai][0][m][n][j]) * acc[ai][1][m][n][j];
                *(v4u*)(act + (size_t)row * FF + u.pn * HALFT + wc * 32 + 8 * fq) = pack8(v[0], v[1]); }
    }
};
struct EpiM2 {
    static constexpr bool PERM = true; static constexpr bool PROBE2 = false;
    bf16_t* Y; const float* wt; const LAS int* offt; float osc;
    __device__ __forceinline__ void operator()(AccRef acc, const Unit& u, int wr, int wc, int fr, int fq) const {
        float w8[2][4]; const int nrow = u.e < E ? offt[E + 2 + u.e] : M;
#pragma unroll
        for (int ai = 0; ai < 2; ++ai)
#pragma unroll
            for (int m = 0; m < 4; ++m) { const int rank = u.pm * BM + ai * HALFT + wr * 64 + m * 16 + fr; w8[ai][m] = (u.e < E ? (rank < nrow ? wt[(size_t)u.e * M + rank] : 0.f) : 1.0f) * osc; }
#pragma unroll
        for (int ai = 0; ai < 2; ++ai)
#pragma unroll
            for (int m = 0; m < 4; ++m) { const int rr = ai * HALFT + wr * 64 + m * 16 + fr; const float w = w8[ai][m];
#pragma unroll
                for (int bj = 0; bj < 2; ++bj) *(v4u*)(Y + (size_t)(u.r0 + rr) * D + u.pn * BM + bj * HALFT + wc * 32 + 8 * fq) = pack8(acc[ai][bj][m][0] * w, acc[ai][bj][m][1] * w); }
    }
};
}

struct Frame { LAS unsigned char* lds; Ctx c; int wave, vcu, G;
    __device__ __forceinline__ int lane() const { return lane_id(); }
    __device__ __forceinline__ int tid() const { return wave * 64 + lane_id(); } };

struct CvtDesc { const float* src; unsigned char* dst; const float* sc; int ldw, Kd, f8; float mul; };
__device__ __forceinline__ void cvt_load(const CvtDesc& d, float (&v)[32], int lane) {
    const float* p = d.src + (size_t)(lane >> 3) * d.ldw + 4 * (lane & 7);
#pragma unroll
    for (int i = 0; i < 8; ++i) { const f32x4 t = __builtin_nontemporal_load((const f32x4*)(p + (size_t)(8 * i) * d.ldw));     v[4 * i] = t[0]; v[4 * i + 1] = t[1]; v[4 * i + 2] = t[2]; v[4 * i + 3] = t[3]; }
}
__device__ __forceinline__ void cvt_finish(const CvtDesc& d, float (&v)[32], LAS float* scr, int lane) {
    const int kr = lane >> 3, n4 = 4 * (lane & 7);
#pragma unroll
    for (int i = 0; i < 8; ++i) { const float m = (d.sc ? d.sc[8 * i + kr] : 1.0f) * d.mul;
#pragma unroll
        for (int e = 0; e < 4; ++e) scr[(8 * i + kr) * 33 + n4 + e] = v[4 * i + e] * m; }
    LDS_WAIT(); asm volatile("" ::: "memory");
    const int cc = lane & 7;
#pragma unroll
    for (int j = 0; j < 4; ++j) { const int n = (lane >> 3) + 8 * j; const LAS float* s = scr + (8 * cc) * 33 + n;
        if (d.f8) { u32x2 o; o.x = pg8::pack_fp8x4(s[0 * 33], s[1 * 33], s[2 * 33], s[3 * 33]); o.y = pg8::pack_fp8x4(s[4 * 33], s[5 * 33], s[6 * 33], s[7 * 33]); __builtin_nontemporal_store(o, (u32x2*)(d.dst + (size_t)n * d.Kd + 8 * cc)); }
        else { v4u o; o.x = cvt_pk_bf16(s[0 * 33], s[1 * 33]); o.y = cvt_pk_bf16(s[2 * 33], s[3 * 33]); o.z = cvt_pk_bf16(s[4 * 33], s[5 * 33]); o.w = cvt_pk_bf16(s[6 * 33], s[7 * 33]); __builtin_nontemporal_store(o, (v4u*)(d.dst + (size_t)n * d.Kd + 16 * cc)); } }
    LDS_WAIT(); asm volatile("" ::: "memory");
}
__device__ __forceinline__ CvtDesc mk_desc(const float* src, int ldw, int k0, int ns0, void* dst, int Kd_elems, int nd0, int kd0, const float* sc, int f8 = 0, float mul = 1.0f) {
    CvtDesc d; d.src = src + (size_t)k0 * ldw + ns0; d.ldw = ldw; d.f8 = f8; d.mul = mul; d.sc = sc ? sc + k0 : nullptr; const int eb = f8 ? 1 : 2; d.Kd = Kd_elems * eb;
    d.dst = (unsigned char*)dst + ((size_t)nd0 * Kd_elems + kd0 + k0) * eb; return d; }
constexpr long cnt_items(int K, int N) { return (long)(K / 64) * (N / 32); }
constexpr long IT_INAB = 0, IT_UQ = IT_INAB + cnt_items(D, AB_N), IT_UKV = IT_UQ + cnt_items(QR, H_A * QK), IT_LRU = IT_UKV + cnt_items(KVR, H_A * (NOPE + VD)),
    IT_OUTAB = IT_LRU + (long)2 * (LW / LBS) * 2 * 4 * cnt_items(LBS, LBS), IT_RT = IT_OUTAB + cnt_items(D, D), IT_GU0 = IT_RT + 2 * cnt_items(D, E), IT_DN0 = IT_GU0 + (long)(E + 1) * 2 * cnt_items(D, FF),
    IT_INCD = IT_DN0 + (long)(E + 1) * cnt_items(FF, D), IT_OUTCD = IT_INCD + cnt_items(D, CD_N), IT_GU1 = IT_OUTCD + cnt_items(D, D), IT_DN1 = IT_GU1 + (long)(E + 1) * 2 * cnt_items(D, FF), IT_END = IT_DN1 + (long)(E + 1) * cnt_items(FF, D);
__device__ __forceinline__ CvtDesc p0_desc(const Ctx& c, long it) {
#ifdef MOE_FP8
    constexpr int MF8 = 1; constexpr float MGU = pg8::F8_GU, MDN = pg8::F8_DN;
#else
    constexpr int MF8 = 0; constexpr float MGU = 1.0f, MDN = 1.0f;
#endif
    const int sub = (int)(it & 1);
    if (it < IT_UQ) { const long r = (it - IT_INAB) >> 1; constexpr int NBK = AB_N / 32; const int kb = 2 * (int)(r / NBK) + sub, nb = (int)(r % NBK); const int col = nb * 32; const int drow = col < QR + KVR ? col : (col < QR + KVR + ROPE ? P0_N + col - (QR + KVR) : col - ROPE);
        return mk_desc(c.in[I_WINAB], AB_N, kb * 64, col, WSP(bf16_t, W_INAB), D, drow, 0, nullptr); }
    if (it < IT_UKV) { const long r = (it - IT_UQ) >> 1; constexpr int NBK = H_A * QK / 32; const int kb = 2 * (int)(r / NBK) + sub, db = (int)(r % NBK); const int v = db * 32; int scol;
        if (v < H_A * NOPE) { const int h = v / NOPE, d0 = v % NOPE; scol = h * QK + d0; }
        else { const int v2 = v - H_A * NOPE; const int tq = v2 / 256, half = (v2 % 256) / 128, hq = (v2 % 128) / 32; scol = (4 * tq + hq) * QK + NOPE + (ROPE / 2) * half; }
        return mk_desc(c.in[I_WUQ], H_A * QK, kb * 64, scol, WSP(bf16_t, W_UQ), QR, v, 0, c.in[I_QLN]); }
    if (it < IT_LRU) { const long r = (it - IT_UKV) >> 1; constexpr int NBK = H_A * (NOPE + VD) / 32; const int kb = 2 * (int)(r / NBK) + sub, nb = (int)(r % NBK);
        return mk_desc(c.in[I_WUKV], H_A * (NOPE + VD), kb * 64, nb * 32, WSP(bf16_t, W_UKV), KVR, nb * 32, 0, c.in[I_KVLN]); }
    if (it < IT_OUTAB) { const long r = (it - IT_LRU) >> 1; constexpr int NBK = LBS / 32, PER = (LBS / 128) * NBK; const int q = (int)(r / PER), w = (int)(r % PER); const int tap = q & 3, half = (q >> 2) & 1, tq = q >> 3, g = tq >> 1, d = tq & 1; const int kb = 2 * (w / NBK) + sub, nb = w % NBK;
        const float* src = (half ? c.in[I_LWX] : c.in[I_LWA]) + ((size_t)(d * (LW / LBS) + g) * LBS) * LBS;
        return mk_desc(src, LBS, kb * 64, nb * 32, WSP(bf16_t, W_LRU) + (size_t)tq * 2 * LBS * 4 * LBS, 4 * LBS, half * LBS + nb * 32, tap * LBS, c.in[I_CONVW] + tap * LW + g * LBS); }
    if (it < IT_RT) { const long r = (it - IT_OUTAB) >> 1; constexpr int NBK = D / 32; return mk_desc(c.in[I_WOUTAB], D, (2 * (int)(r / NBK) + sub) * 64, (int)(r % NBK) * 32, WSP(bf16_t, W_OUTAB), D, (int)(r % NBK) * 32, 0, nullptr); }
    if (it < IT_GU0) { const long r = (it - IT_RT) >> 1; constexpr int NBK = E / 32; constexpr long PER = (long)(D / 128) * NBK; const int l = (int)(r / PER); const long w = r % PER;
        return mk_desc(c.in[I_WROUTER] + (size_t)l * D * E, E, (2 * (int)(w / NBK) + sub) * 64, (int)(w % NBK) * 32, WSP(bf16_t, W_RT) + (size_t)l * E * D, D, (int)(w % NBK) * 32, 0, nullptr); }
    if (it < IT_INCD || (it >= IT_GU1)) {
        const int l = it >= IT_GU1 ? 1 : 0; const long base_gu = l ? IT_GU1 : IT_GU0, base_dn = l ? IT_DN1 : IT_DN0;
        if (it < base_dn) { const long r = (it - base_gu) >> 1; constexpr int NBK = FF / 32; constexpr long PER = (long)(D / 128) * NBK; const long q = r / PER, w = r % PER; const int up = (int)(q & 1), e = (int)(q >> 1); const int kb = 2 * (int)(w / NBK) + sub, nb = (int)(w % NBK); const int col = nb * 32;
            const float* src = e < E ? (up ? c.in[I_WUP] : c.in[I_WGATE]) + ((size_t)l * E + e) * D * FF : (up ? c.in[I_WSU] : c.in[I_WSG]) + (size_t)l * D * FF;
            return mk_desc(src, FF, kb * 64, col, c.ws + W_GU + ((size_t)l * (E + 1) + e) * 2 * FF * D * (MF8 ? 1 : 2), D, (col / 128) * 256 + up * 128 + (col % 128), 0, nullptr, MF8, MGU); }
        { const long r = (it - base_dn) >> 1; constexpr int NBK = D / 32; constexpr long PER = (long)(FF / 128) * NBK; const int e = (int)(r / PER); const long w = r % PER;
            const float* src = e < E ? c.in[I_WDOWN] + ((size_t)l * E + e) * FF * D : c.in[I_WSD] + (size_t)l * FF * D;
            return mk_desc(src, D, (2 * (int)(w / NBK) + sub) * 64, (int)(w % NBK) * 32, c.ws + W_DN + ((size_t)l * (E + 1) + e) * D * FF * (MF8 ? 1 : 2), FF, (int)(w % NBK) * 32, 0, nullptr, MF8, MDN); } }
    if (it < IT_OUTCD) { const long r = (it - IT_INCD) >> 1; constexpr int NBK = CD_N / 32; return mk_desc(c.in[I_WINCD], CD_N, (2 * (int)(r / NBK) + sub) * 64, (int)(r % NBK) * 32, WSP(bf16_t, W_INCD), D, (int)(r % NBK) * 32, 0, nullptr); }
    { const long r = (it - IT_OUTCD) >> 1; constexpr int NBK = D / 32; return mk_desc(c.in[I_WOUTCD], D, (2 * (int)(r / NBK) + sub) * 64, (int)(r % NBK) * 32, WSP(bf16_t, W_OUTCD), D, (int)(r % NBK) * 32, 0, nullptr); }
}
__device__ __forceinline__ void conv_items(Frame& F, long lo, long hi, int pidx = -1, int np = 0) {
    if (pidx < 0) { pidx = F.vcu; np = F.G; }
    const Ctx& c = F.c; LAS float* scr = (LAS float*)(F.lds + F.wave * 16384); const int lane = F.lane(); const long step = 2 * (long)np * NWAVES;
    long it = lo + 2 * ((long)pidx * NWAVES + F.wave); float va[32], vb[32];
    if (it < hi) { CvtDesc da = p0_desc(c, it); cvt_load(da, va, lane);
        for (;;) {
            CvtDesc db = p0_desc(c, it + 1); cvt_load(db, vb, lane);
            cvt_finish(da, va, scr, lane);
            const long i2 = it + step; const bool h2 = i2 < hi; if (h2) { da = p0_desc(c, i2); cvt_load(da, va, lane); }
            cvt_finish(db, vb, scr, lane); if (!h2) break;
            it = i2; } }
}
__device__ __forceinline__ void conv_slice(Frame& F, long lo, long hi, int k0, int k1, int n, int pidx = -1, int np = 0) { const long npair = (hi - lo) / 2; conv_items(F, lo + 2 * (npair * k0 / n), lo + 2 * (npair * k1 / n), pidx, np); }
__device__ __forceinline__ void mod_units(Frame& F, int l) {
    const Ctx& c = F.c; LAS float* cact = (LAS float*)F.lds; LAS float* red = (LAS float*)(F.lds + 65536);
    for (int i = F.tid(); i < NB * D; i += NTHR) cact[i] = siluf(c.in[I_C][i]);
    __syncthreads();
    constexpr int UW = 48, NU = 6 * D / UW, KW = D / NWAVES; static_assert(6 * D % UW == 0 && KW % 64 == 0 && NB * UW <= NTHR, "mod units");
    for (int u = F.vcu; u < NU; u += F.G) { const int col0 = u * UW; const int rg = F.lane() >> 4, cl = (F.lane() & 15) < 12 ? (F.lane() & 15) : 11;
        const float* w = c.in[I_WMOD] + (size_t)l * D * 6 * D + col0 + 4 * cl; f32x4 a[NB];
#pragma unroll
        for (int b = 0; b < NB; ++b) a[b] = f32x4{0.f, 0.f, 0.f, 0.f};
        const int kbeg = F.wave * KW + rg;
#pragma unroll 1
        for (int i0 = 0; i0 < KW / 4; i0 += 16) { f32x4 wv[16];
#pragma unroll
            for (int j = 0; j < 16; ++j) wv[j] = __builtin_nontemporal_load((const f32x4*)(w + (size_t)(kbeg + 4 * (i0 + j)) * 6 * D));
#pragma unroll
            for (int j = 0; j < 16; ++j) { const int k = kbeg + 4 * (i0 + j);
#pragma unroll
                for (int b = 0; b < NB; ++b) a[b] += wv[j] * cact[b * D + k]; } }
#pragma unroll
        for (int b = 0; b < NB; ++b)
#pragma unroll
            for (int q = 0; q < 4; ++q) { float s = a[b][q]; s += __shfl_xor(s, 16); s += __shfl_xor(s, 32); a[b][q] = s; }
        if (F.lane() < 12) {
#pragma unroll
            for (int b = 0; b < NB; ++b) *(LAS f32x4*)(red + (F.wave * NB + b) * UW + 4 * F.lane()) = a[b]; }
        __syncthreads();
        if (F.tid() < NB * UW) { const int b = F.tid() / UW, cc = F.tid() % UW; float s = c.in[I_BMOD][l * 6 * D + col0 + cc];
#pragma unroll
            for (int w8 = 0; w8 < NWAVES; ++w8) s += red[(w8 * NB + b) * UW + cc];
            WSP(float, WS_MOD)[((size_t)l * NB + b) * 6 * D + col0 + cc] = s; }
        __syncthreads();
    }
    __syncthreads();
}

__device__ __forceinline__ void p0_phase(Frame& F) {
    const Ctx& c = F.c;
    mod_units(F, 0);
#ifndef SPREAD_CONV
    mod_units(F, 1);
#endif
    const long gt = (long)F.vcu * NTHR + F.tid(), NGT = (long)F.G * NTHR;
    for (long i = gt; i < (long)S * (ROPE / 2 + DK / 2); i += NGT) { TabF f; f.c = c; f(i); }
    static_assert(LBS % 64 == 0 && LBS % NWAVES == 0, "gate bias units");
    for (int u = F.vcu; u < 4 * LW / 64; u += F.G) { const int i = u * 64 + F.lane(); const int ch = i % LW, half = (i / LW) & 1, d = i / (2 * LW); const int g = ch / LBS, j = ch % LBS;
        LAS float* red = (LAS float*)(F.lds + 65536);
        const float* wm = (half ? c.in[I_LWX] : c.in[I_LWA]) + ((size_t)(d * (LW / LBS) + g) * LBS) * LBS + j; float s = 0.f;
#pragma unroll
        for (int kk = 0; kk < LBS / NWAVES; ++kk) { const int k = F.wave * (LBS / NWAVES) + kk; s += c.in[I_CONVB][g * LBS + k] * wm[(size_t)k * LBS]; }
        red[F.wave * 64 + F.lane()] = s; __syncthreads();
        if (F.wave == 0) { float t = (half ? c.in[I_LBX] : c.in[I_LBA])[d * LW + ch];
#pragma unroll
            for (int w8 = 0; w8 < NWAVES; ++w8) t += red[w8 * 64 + F.lane()];
            WSP(float, W_GB)[i] = t; }
        __syncthreads(); }
    for (long i = gt; i < 2 * LW; i += NGT) WSP(float, W_GB)[4 * LW + i] = -8.0f * log1pf(expf(-c.in[I_LLAM][i]));
    for (long i = gt; i < (long)NB * 4 * LW; i += NGT) { const int b = (int)(i / (4 * LW)), rr = (int)((i / LW) % 4), ch = (int)(i % LW); WSP(bf16_t, WS_LXP)[((size_t)b * (S + 4) + (rr < 2 ? rr : S + rr)) * LW + ch] = 0; }
    __syncthreads();
#ifdef SPREAD_CONV
    conv_items(F, IT_INAB, IT_OUTAB);
#else
    conv_items(F, IT_INAB, IT_END);
#endif
}
__device__ __forceinline__ void build_offt(Frame& F, int l) {
    LAS int* offt = (LAS int*)(F.lds + TAB_OFF); static_assert(E <= 64, "one lane per routed expert");
    if (F.wave == 0) { const int lane = F.lane(); LAS unsigned char* texp = (LAS unsigned char*)(offt + 2 * E + 4);
        const int n = lane < E ? __hip_atomic_load((const int*)(F.c.ws + CTL_CNT) + cnt_idx(l, lane), RLX_AGENT) : 0; const int nt = (n + RT - 1) / RT; int inc = nt;
#pragma unroll
        for (int o = 1; o < 64; o <<= 1) { const int v = __shfl_up(inc, o); if (lane >= o) inc += v; }
        const int off = inc - nt, tot = __shfl(inc, 63); constexpr int NTS = (M + RT - 1) / RT;
        if (lane < E) { offt[lane] = off; offt[E + 2 + lane] = n; for (int t = 0; t < nt; ++t) texp[off + t] = (unsigned char)lane; }
        if (lane == 0) { offt[E] = tot; offt[E + 1] = tot + NTS; }
        for (int t = lane; t < NTS; t += 64) texp[tot + t] = (unsigned char)E; }
    __syncthreads();
}

__device__ __forceinline__ void modulate_row(const float* xrow, const float* gain, const float* sc, const float* sh, bf16_t* orow, int lane, unsigned char* orow8 = nullptr) {
    f32x4 v[D / 256]; float s = 0.f;
#pragma unroll
    for (int j = 0; j < D / 256; ++j) { v[j] = *((const f32x4*)xrow + lane + 64 * j); s += (v[j][0] * v[j][0] + v[j][1] * v[j][1]) + (v[j][2] * v[j][2] + v[j][3] * v[j][3]); }
    const float r = 1.0f / sqrtf(wave_sum(s) * (1.0f / D) + EPS);
#pragma unroll
    for (int j = 0; j < D / 256; ++j) { const int col = 4 * lane + 256 * j; const f32x4 g = *(const f32x4*)(gain + col), a = *(const f32x4*)(sc + col), b = *(const f32x4*)(sh + col);
        const f32x4 o = v[j] * r * g * (1.0f + a) + b; u32x2 w; w.x = cvt_pk_bf16(o[0], o[1]); w.y = cvt_pk_bf16(o[2], o[3]); *(u32x2*)(orow + col) = w;
        if (orow8) *(unsigned*)(orow8 + col) = pg8::pack_fp8x4(o[0] * pg8::F8_H, o[1] * pg8::F8_H, o[2] * pg8::F8_H, o[3] * pg8::F8_H); }
}
template <int NR> __device__ __forceinline__ void modulate_rows(const float* X, int m0, const float* gain, const float* sc, const float* sh, bf16_t* HM, unsigned char* HM8, int lane) {
    f32x4 v[NR][D / 256]; float s[NR];
#pragma unroll
    for (int r = 0; r < NR; ++r) { s[r] = 0.f;
#pragma unroll
        for (int j = 0; j < D / 256; ++j) v[r][j] = *((const f32x4*)(X + (size_t)(m0 + r) * D) + lane + 64 * j); }
#pragma unroll
    for (int r = 0; r < NR; ++r)
#pragma unroll
        for (int j = 0; j < D / 256; ++j) s[r] += (v[r][j][0] * v[r][j][0] + v[r][j][1] * v[r][j][1]) + (v[r][j][2] * v[r][j][2] + v[r][j][3] * v[r][j][3]);
#pragma unroll
    for (int o = 1; o < 64; o <<= 1)
#pragma unroll
        for (int r = 0; r < NR; ++r) s[r] += __shfl_xor(s[r], o);
#pragma unroll
    for (int j = 0; j < D / 256; ++j) { const int col = 4 * lane + 256 * j; const f32x4 g = *(const f32x4*)(gain + col), a = *(const f32x4*)(sc + col), b = *(const f32x4*)(sh + col);
#pragma unroll
        for (int r = 0; r < NR; ++r) { const float rs = 1.0f / sqrtf(s[r] * (1.0f / D) + EPS); const f32x4 o = v[r][j] * rs * g * (1.0f + a) + b; u32x2 w; w.x = cvt_pk_bf16(o[0], o[1]); w.y = cvt_pk_bf16(o[2], o[3]);
            *(u32x2*)(HM + (size_t)(m0 + r) * D + col) = w;
            if (HM8) *(unsigned*)(HM8 + (size_t)(m0 + r) * D + col) = pg8::pack_fp8x4(o[0] * pg8::F8_H, o[1] * pg8::F8_H, o[2] * pg8::F8_H, o[3] * pg8::F8_H); } }
}
__device__ __forceinline__ void modulate_phase(Frame& F, const float* X, const float* gain, const float* sc, const float* sh) {
    const int gw = F.vcu * NWAVES + F.wave, NGW = F.G * NWAVES;
    for (int m0 = 4 * gw; m0 < M; m0 += 4 * NGW) { const int b = m0 / S;
        modulate_rows<4>(X, m0, gain, sc + (size_t)b * 6 * D, sh + (size_t)b * 6 * D, (bf16_t*)(F.c.ws + WS_HM), nullptr, F.lane()); }
}
__device__ __forceinline__ void skinny32x64(Frame& F, const bf16_t* A, const bf16_t* Bt) {
    const int r = F.lane() & 31, h = F.lane() >> 5; constexpr int KW = D / NWAVES; const int k0 = F.wave * KW;
    f32x16 acc0 = {}, acc1 = {};
    const bf16_t* ap = A + (size_t)r * D + k0 + 8 * h; const bf16_t* b0p = Bt + (size_t)r * D + k0 + 8 * h; const bf16_t* b1p = Bt + (size_t)(32 + r) * D + k0 + 8 * h;
#pragma unroll 4
    for (int s = 0; s < KW / 16; ++s) { const bf16x8 a = *(const bf16x8*)(ap + 16 * s), b0 = *(const bf16x8*)(b0p + 16 * s), b1 = *(const bf16x8*)(b1p + 16 * s);
        acc0 = __builtin_amdgcn_mfma_f32_32x32x16_bf16(a, b0, acc0, 0, 0, 0); acc1 = __builtin_amdgcn_mfma_f32_32x32x16_bf16(a, b1, acc1, 0, 0, 0); }
    LAS float* red = (LAS float*)F.lds;
#pragma unroll
    for (int q = 0; q < 16; ++q) { const int row = (q & 3) + 8 * (q >> 2) + 4 * h; red[(F.wave * 32 + row) * 64 + r] = acc0[q]; red[(F.wave * 32 + row) * 64 + 32 + r] = acc1[q]; }
    __syncthreads();
    LAS float* res = (LAS float*)(F.lds + 65536);
    { const int row = F.tid() >> 4, c4 = (F.tid() & 15) * 4; f32x4 s = *(const LAS f32x4*)(red + row * 64 + c4);
#pragma unroll
      for (int w = 1; w < NWAVES; ++w) s += *(const LAS f32x4*)(red + (w * 32 + row) * 64 + c4);
      *(LAS f32x4*)(res + row * 64 + c4) = s; }
    __syncthreads();
}
__device__ __forceinline__ void krope_units(Frame& F) {
    const Ctx& c = F.c;
    for (int u = F.vcu; u < M / 32; u += F.G) { const int row0 = u * 32;
        skinny32x64(F, WSP(bf16_t, WS_HM) + (size_t)row0 * D, WSP(bf16_t, W_INAB) + (size_t)P0_N * D);
        const LAS float* res = (const LAS float*)(F.lds + 65536);
        { const int row = F.tid() >> 4, i0 = (F.tid() & 15) * 2; const int m = row0 + row, t = m % S; float o1[2], o2[2];
#pragma unroll
          for (int q = 0; q < 2; ++q) { const int ii = i0 + q; const float x1 = res[row * 64 + ii], x2 = res[row * 64 + 32 + ii], cs = WSP(float, WS_TAB + TAB_CR)[t * (ROPE / 2) + ii], sn = WSP(float, WS_TAB + TAB_SR)[t * (ROPE / 2) + ii];
              o1[q] = x1 * cs - x2 * sn; o2[q] = x2 * cs + x1 * sn; }
          const unsigned w1 = cvt_pk_bf16(o1[0], o1[1]), w2 = cvt_pk_bf16(o2[0], o2[1]);
#pragma unroll
          for (int hh = 0; hh < H_A; ++hh) { bf16_t* K = WSP(bf16_t, WS_KC) + ((size_t)m * H_A + hh) * QK + NOPE; *(unsigned*)(K + i0) = w1; *(unsigned*)(K + ROPE / 2 + i0) = w2; } }
        __syncthreads();
    }
}
__device__ __forceinline__ float wave_max(float v) {
#pragma unroll
    for (int o = 1; o < 64; o <<= 1) v = fmaxf(v, __shfl_xor(v, o));
    return v; }
__device__ __forceinline__ void route_phase(Frame& F, int l) {
    const Ctx& c = F.c; const float* mod = WSP(float, WS_MOD) + (size_t)l * NB * 6 * D; const float* X1 = WSP(float, WS_X1);
    for (int u = F.vcu; u < M / 32; u += F.G) { const int row0 = u * 32;
        { const int m0 = row0 + F.wave * 4; const int b = m0 / S;
          modulate_rows<4>(X1, m0, c.in[I_NFFN] + l * D, mod + (size_t)b * 6 * D + 4 * D, mod + (size_t)b * 6 * D + 3 * D, WSP(bf16_t, WS_HM), WSP(unsigned char, WS_HM8), F.lane()); }
        __syncthreads();
        skinny32x64(F, WSP(bf16_t, WS_HM) + (size_t)row0 * D, WSP(bf16_t, W_RT) + (size_t)l * E * D);
        const LAS float* res = (const LAS float*)(F.lds + 65536);
        int* cnt = WSP(int, CTL_CNT); LAS int* lcnt = (LAS int*)(F.lds + 65536 + 8192);
        if (F.tid() < E) lcnt[F.tid()] = 0;
        __syncthreads();
        int pe[4], pr[4]; float pw[4];
        { const int lane = F.lane(), grp = lane >> 3; float sg[4], bz[4], gs[4]; unsigned gsel[4]; const float rb = c.in[I_RBIAS][l * E + lane];
#pragma unroll
          for (int q = 0; q < 4; ++q) { const int row = F.wave * 4 + q; sg[q] = 1.0f / (1.0f + expf(-res[row * 64 + lane])); bz[q] = sg[q] + rb; }
          { float m1[4], m2[4];
#pragma unroll
            for (int q = 0; q < 4; ++q) m1[q] = bz[q];
#pragma unroll
            for (int o = 1; o < 8; o <<= 1)
#pragma unroll
                for (int q = 0; q < 4; ++q) m1[q] = fmaxf(m1[q], __shfl_xor(m1[q], o));
#pragma unroll
            for (int q = 0; q < 4; ++q) { const unsigned long long eq1 = __ballot(bz[q] == m1[q]); const int first = __builtin_ctz((unsigned)((eq1 >> (grp * 8)) & 0xffull)); m2[q] = ((lane & 7) == first) ? -INFINITY : bz[q]; }
#pragma unroll
            for (int o = 1; o < 8; o <<= 1)
#pragma unroll
                for (int q = 0; q < 4; ++q) m2[q] = fmaxf(m2[q], __shfl_xor(m2[q], o));
#pragma unroll
            for (int q = 0; q < 4; ++q) { gs[q] = m1[q] + m2[q]; gsel[q] = 0u; } }
#pragma unroll 1
          for (int it = 0; it < TG; ++it) { float cand[4], mx[4];
#pragma unroll
              for (int q = 0; q < 4; ++q) { cand[q] = ((gsel[q] >> grp) & 1u) ? -INFINITY : gs[q]; mx[q] = cand[q]; }
#pragma unroll
              for (int o = 1; o < 64; o <<= 1)
#pragma unroll
                  for (int q = 0; q < 4; ++q) mx[q] = fmaxf(mx[q], __shfl_xor(mx[q], o));
#pragma unroll
              for (int q = 0; q < 4; ++q) { const unsigned long long eq = __ballot(cand[q] == mx[q]); gsel[q] |= 1u << (__builtin_ctzll(eq) >> 3); } }
          unsigned long long taken[4]; float wsum[4], my_s[4]; int my_e[4];
#pragma unroll
          for (int q = 0; q < 4; ++q) { taken[q] = 0ull; wsum[q] = 0.f; my_s[q] = 0.f; my_e[q] = 0; }
#pragma unroll 1
          for (int k = 0; k < TOPK; ++k) { float cand[4], mx[4];
#pragma unroll
              for (int q = 0; q < 4; ++q) { cand[q] = (((gsel[q] >> grp) & 1u) && !((taken[q] >> lane) & 1ull)) ? bz[q] : -INFINITY; mx[q] = cand[q]; }
#pragma unroll
              for (int o = 1; o < 64; o <<= 1)
#pragma unroll
                  for (int q = 0; q < 4; ++q) mx[q] = fmaxf(mx[q], __shfl_xor(mx[q], o));
#pragma unroll
              for (int q = 0; q < 4; ++q) { const unsigned long long eq = __ballot(cand[q] == mx[q]); const int ek = __builtin_ctzll(eq); taken[q] |= 1ull << ek; const float sk = __shfl(sg[q], ek); wsum[q] += sk; if (lane == k) { my_e[q] = ek; my_s[q] = sk; } } }
#pragma unroll
          for (int q = 0; q < 4; ++q) { pe[q] = my_e[q]; pw[q] = my_s[q] / wsum[q] * 2.5f; pr[q] = 0;
              if (lane < TOPK) pr[q] = __hip_atomic_fetch_add(lcnt + my_e[q], 1, __ATOMIC_RELAXED, __HIP_MEMORY_SCOPE_WORKGROUP); } }
        __syncthreads();
        if (F.tid() < E) { const int n = lcnt[F.tid()]; lcnt[E + F.tid()] = n > 0 ? atomicAdd(cnt + cnt_idx(l, F.tid()), n) : 0; }
        __syncthreads();
#pragma unroll
        for (int q = 0; q < 4; ++q) { const int m = row0 + F.wave * 4 + q; const int lane = F.lane();
            if (lane < TOPK) { const int rank = lcnt[E + pe[q]] + pr[q];
                WSP(int, WS_SELE)[(size_t)m * TOPK + lane] = pe[q]; WSP(int, WS_SELR)[(size_t)m * TOPK + lane] = rank; WSP(float, WS_SELW)[(size_t)m * TOPK + lane] = pw[q];
                WSP(int, WS_TOK)[(size_t)pe[q] * M + rank] = m; WSP(float, WS_WT)[(size_t)pe[q] * M + rank] = pw[q]; } }
        __syncthreads();
    }
}
__device__ __forceinline__ void combine_phase(Frame& F, int l) {
    build_offt(F, l);
    const Ctx& c = F.c; const LAS int* offt = (const LAS int*)(F.lds + TAB_OFF); const float* X1 = WSP(float, WS_X1); float* X2 = WSP(float, WS_X2);
    const float* mod = WSP(float, WS_MOD) + (size_t)l * NB * 6 * D; const float* mod1 = WSP(float, WS_MOD) + (size_t)NB * 6 * D;
    const int gw = F.vcu * NWAVES + F.wave, NGW = F.G * NWAVES; static_assert(D == 2048, "lane l owns columns 16 l .. 16 l + 15 of each 1024-column half");
    for (int m = gw; m < M; m += NGW) { const int b = m / S; const int lane = F.lane();
        int e = 0, r = 0; float wsel = 1.0f; if (lane < TOPK) { e = WSP(int, WS_SELE)[(size_t)m * TOPK + lane]; r = WSP(int, WS_SELR)[(size_t)m * TOPK + lane]; wsel = WSP(float, WS_SELW)[(size_t)m * TOPK + lane]; }
        long rowi = (lane < TOPK) ? (long)offt[e] * RT + r : (long)offt[E] * RT + m;
        f32x4 acc[2][4];
#pragma unroll
        for (int h = 0; h < 2; ++h)
#pragma unroll
            for (int q = 0; q < 4; ++q) acc[h][q] = (f32x4){0.f, 0.f, 0.f, 0.f};
#pragma unroll 3
        for (int k = 0; k <= TOPK; ++k) { const long ri = __shfl(rowi, k); const float wk = __shfl(wsel, k); const unsigned char* yr = WSP(unsigned char, WS_Y) + (size_t)ri * D + 16 * lane;
#pragma unroll
            for (int h = 0; h < 2; ++h) { const v4u raw = __builtin_nontemporal_load((const v4u*)(yr + h * 1024));
#pragma unroll
                for (int q = 0; q < 4; ++q) { const auto lo = __builtin_amdgcn_cvt_pk_f32_fp8((int)raw[q], false), hi = __builtin_amdgcn_cvt_pk_f32_fp8((int)raw[q], true);
                    acc[h][q][0] += wk * lo[0]; acc[h][q][1] += wk * lo[1]; acc[h][q][2] += wk * hi[0]; acc[h][q][3] += wk * hi[1]; } } }
        float s = 0.f;
#pragma unroll
        for (int h = 0; h < 2; ++h)
#pragma unroll
            for (int q = 0; q < 4; ++q) { const int col = h * 1024 + 16 * lane + 4 * q; const f32x4 x = *(const f32x4*)(X1 + (size_t)m * D + col), g = *(const f32x4*)(mod + (size_t)b * 6 * D + 5 * D + col);
                acc[h][q] = x + g * (acc[h][q] * (1.0f / pg8::F8_Y)); s += (acc[h][q][0] * acc[h][q][0] + acc[h][q][1] * acc[h][q][1]) + (acc[h][q][2] * acc[h][q][2] + acc[h][q][3] * acc[h][q][3]);
                if (l == 0) *(f32x4*)(X2 + (size_t)m * D + col) = acc[h][q]; }
        const float rs = 1.0f / sqrtf(wave_sum(s) * (1.0f / D) + EPS);
#pragma unroll
        for (int h = 0; h < 2; ++h) {
            if (l == 0) { v4u w[2];
#pragma unroll
                for (int q = 0; q < 4; ++q) { const int col = h * 1024 + 16 * lane + 4 * q; const f32x4 g = *(const f32x4*)(c.in[I_NMIX] + D + col), a = *(const f32x4*)(mod1 + (size_t)b * 6 * D + D + col), bb = *(const f32x4*)(mod1 + (size_t)b * 6 * D + col);
                    const f32x4 o = acc[h][q] * rs * g * (1.0f + a) + bb; w[q >> 1][2 * (q & 1)] = cvt_pk_bf16(o[0], o[1]); w[q >> 1][2 * (q & 1) + 1] = cvt_pk_bf16(o[2], o[3]); }
                bf16_t* hp = WSP(bf16_t, WS_HM) + (size_t)m * D + h * 1024 + 16 * lane; *(v4u*)hp = w[0]; *(v4u*)(hp + 8) = w[1]; }
            else {
#pragma unroll
                for (int q = 0; q < 4; ++q) { const int col = h * 1024 + 16 * lane + 4 * q; const f32x4 g = *(const f32x4*)(c.in[I_FNORM] + col); *(f32x4*)(c.out + (size_t)m * D + col) = acc[h][q] * rs * g; } } }
    }
}
__device__ __forceinline__ void retnorm_phase(Frame& F) {
    const Ctx& c = F.c; const int gw = F.vcu * NWAVES + F.wave, NGW = F.G * NWAVES; static_assert(DK == 256, "one f32x4 per lane");
    for (int m = gw; m < M; m += NGW) { f32x4 v[H_C], g[H_C]; u32x2 raw[H_C]; float s[H_C];
#pragma unroll
        for (int h = 0; h < H_C; ++h) { const int col = h * DK + 4 * F.lane(); v[h] = *(const f32x4*)(WSP(float, WS_RET) + (size_t)m * HALF + col); g[h] = *(const f32x4*)(c.in[I_RETGN] + col); raw[h] = *(const u32x2*)(WSP(bf16_t, WS_PROJ) + (size_t)m * CD_N + 3 * H_C * DK + col);
            s[h] = (v[h][0] * v[h][0] + v[h][1] * v[h][1]) + (v[h][2] * v[h][2] + v[h][3] * v[h][3]); }
#pragma unroll
        for (int o = 1; o < 64; o <<= 1)
#pragma unroll
            for (int h = 0; h < H_C; ++h) s[h] += __shfl_xor(s[h], o);
#pragma unroll
        for (int h = 0; h < H_C; ++h) { const int col = h * DK + 4 * F.lane(); const float rs = 1.0f / sqrtf(s[h] * (1.0f / DK) + EPS); f32x4 o = v[h] * rs * g[h];
            o[0] *= __uint_as_float(raw[h].x << 16); o[1] *= __uint_as_float(raw[h].x & 0xffff0000u); o[2] *= __uint_as_float(raw[h].y << 16); o[3] *= __uint_as_float(raw[h].y & 0xffff0000u);
            u32x2 w; w.x = cvt_pk_bf16(o[0], o[1]); w.y = cvt_pk_bf16(o[2], o[3]); *(u32x2*)(WSP(bf16_t, WS_MIX) + (size_t)m * D + col) = w; } }
}
__device__ __forceinline__ void scan_phase(Frame& F) {
    const Ctx& c = F.c; constexpr int NCK = 64, CL = S / NCK, BLK = S * 16 + NCK * 16; static_assert(CL == 32 && 4 * BLK + 4 * NCK * 8 * 4 <= MISC_OFF, "scan LDS map");
    LAS unsigned char* lds = F.lds; LAS float* agg = (LAS float*)(lds + 4 * BLK);
#define SIDX(t) ((t) * 16 + ((t) >> 5) * 16)
    for (int u = F.vcu; u < NB * (LW / 8); u += F.G) { const int b = u / (LW / 8), c8 = u % (LW / 8);
#pragma unroll
        for (int q = 0; q < 4; ++q) { const bf16_t* src = (q & 1 ? WSP(bf16_t, WS_U) : WSP(bf16_t, WS_LA)) + lru_idx(q >> 1, b, 0, c8 * 8);
#pragma unroll
            for (int i = 0; i < S / NTHR; ++i) { const int t = F.tid() + NTHR * i; *(LAS v4u*)(lds + q * BLK + SIDX(t)) = *(const v4u*)(src + (size_t)t * 8); } }
        __syncthreads();
        const int ch = F.tid() & 7, ck = F.tid() >> 3; const LAS bf16_t* laf = (const LAS bf16_t*)(lds) + ch; const LAS bf16_t* uf = (const LAS bf16_t*)(lds + BLK) + ch;
        const LAS bf16_t* lab = (const LAS bf16_t*)(lds + 2 * BLK) + ch; const LAS bf16_t* ub = (const LAS bf16_t*)(lds + 3 * BLK) + ch;
        { float P = 1.f, H = 0.f;
#pragma unroll 8
          for (int i = 0; i < CL; ++i) { const int o = SIDX(ck * CL + i) / 2; const float a = __builtin_amdgcn_exp2f(LOG2E * bf2f(laf[o])); H = a * H + bf2f(uf[o]); P *= a; }
          agg[(0 * NCK + ck) * 8 + ch] = P; agg[(1 * NCK + ck) * 8 + ch] = H; P = 1.f; H = 0.f;
#pragma unroll 8
          for (int i = CL - 1; i >= 0; --i) { const int o = SIDX(ck * CL + i) / 2; const float a = __builtin_amdgcn_exp2f(LOG2E * bf2f(lab[o])); H = a * H + bf2f(ub[o]); P *= a; }
          agg[(2 * NCK + ck) * 8 + ch] = P; agg[(3 * NCK + ck) * 8 + ch] = H; }
        __syncthreads();
        if (F.tid() < 8) { float cr = 0.f; for (int k = 0; k < NCK; ++k) { const float P = agg[(0 * NCK + k) * 8 + F.tid()], H = agg[(1 * NCK + k) * 8 + F.tid()]; agg[(0 * NCK + k) * 8 + F.tid()] = cr; cr = P * cr + H; } }
        else if (F.tid() < 16) { const int cc = F.tid() - 8; float cr = 0.f; for (int k = NCK - 1; k >= 0; --k) { const float P = agg[(2 * NCK + k) * 8 + cc], H = agg[(3 * NCK + k) * 8 + cc]; agg[(2 * NCK + k) * 8 + cc] = cr; cr = P * cr + H; } }
        __syncthreads();
        { float hf[CL]; float H = agg[(0 * NCK + ck) * 8 + ch];
#pragma unroll
          for (int i = 0; i < CL; ++i) { const int o = SIDX(ck * CL + i) / 2; const float a = __builtin_amdgcn_exp2f(LOG2E * bf2f(laf[o])); H = a * H + bf2f(uf[o]); hf[i] = H; }
          H = agg[(2 * NCK + ck) * 8 + ch]; LAS bf16_t* so = (LAS bf16_t*)(lds + BLK) + ch;
#pragma unroll
          for (int i = CL - 1; i >= 0; --i) { const int o = SIDX(ck * CL + i) / 2; const float a = __builtin_amdgcn_exp2f(LOG2E * bf2f(lab[o])); H = a * H + bf2f(ub[o]); so[o] = f2bf(hf[i] + H); } }
        __syncthreads();
#pragma unroll
        for (int i = 0; i < S / NTHR; ++i) { const int t = F.tid() + NTHR * i; const size_t m = (size_t)b * S + t; const v4u sv = *(const LAS v4u*)(lds + BLK + SIDX(t)); const v4u gv = *(const v4u*)(WSP(bf16_t, WS_PROJ) + m * P0_N + QR + KVR + LW + c8 * 8);
            v4u o;
#pragma unroll
            for (int q = 0; q < 4; ++q) { const float a0 = __uint_as_float(sv[q] << 16) * __uint_as_float(gv[q] << 16), a1 = __uint_as_float(sv[q] & 0xffff0000u) * __uint_as_float(gv[q] & 0xffff0000u); o[q] = cvt_pk_bf16(a0, a1); }
            *(v4u*)(WSP(bf16_t, WS_MIX) + m * D + HALF + c8 * 8) = o; }
        __syncthreads();
    }
#undef SIDX
}
namespace attn {
#define ATT_KSWZ(row, colB, RS) ((row) * (RS) + ((colB) ^ (((row) & 7) << 4)))
__device__ __forceinline__ int crow(int r, int hi) { return (r & 3) + 8 * (r >> 2) + 4 * hi; }
__device__ __forceinline__ int v_st(int k, int c) { const int kk = (k & ~0xC) | ((k & 4) << 1) | ((k & 8) >> 1); return ((kk >> 3) * 4 + (c >> 5)) * 512 + ((kk & 7) * 32 + (c & 31)) * 2; }
__device__ __forceinline__ int v_rd_base(int lane) { return ((lane & 3) << 3) | (((lane >> 2) & 3) << 6) | (((lane >> 4) & 1) << 5) | (((lane >> 5) & 1) << 8); }
constexpr int v_rd_off(int d0, int ks, int half) { return d0 * 512 + ks * 4096 + half * 2048; }
template <int OFF> __device__ __forceinline__ s16x4 tr_read(int vb) { s16x4 r; asm volatile("ds_read_b64_tr_b16 %0, %1 offset:%2" : "=&v"(r) : "v"(vb), "i"(OFF) : "memory"); return r; }
template <int D0> __device__ __forceinline__ void pv_one(f32x16& od, int vb, bf16x8 pa0, bf16x8 pa1, bf16x8 pa2, bf16x8 pa3) {
    const s16x4 l0 = tr_read<v_rd_off(D0, 0, 0)>(vb), h0 = tr_read<v_rd_off(D0, 0, 1)>(vb), l1 = tr_read<v_rd_off(D0, 1, 0)>(vb), h1 = tr_read<v_rd_off(D0, 1, 1)>(vb);
    const s16x4 l2 = tr_read<v_rd_off(D0, 2, 0)>(vb), h2 = tr_read<v_rd_off(D0, 2, 1)>(vb), l3 = tr_read<v_rd_off(D0, 3, 0)>(vb), h3 = tr_read<v_rd_off(D0, 3, 1)>(vb);
    asm volatile("s_waitcnt lgkmcnt(0)" ::: "memory"); __builtin_amdgcn_sched_barrier(0);
#define ATT_PK(L, H) (bf16x8){L[0], L[1], L[2], L[3], H[0], H[1], H[2], H[3]}
    od = __builtin_amdgcn_mfma_f32_32x32x16_bf16(pa0, ATT_PK(l0, h0), od, 0, 0, 0);
    od = __builtin_amdgcn_mfma_f32_32x32x16_bf16(pa1, ATT_PK(l1, h1), od, 0, 0, 0);
    od = __builtin_amdgcn_mfma_f32_32x32x16_bf16(pa2, ATT_PK(l2, h2), od, 0, 0, 0);
    od = __builtin_amdgcn_mfma_f32_32x32x16_bf16(pa3, ATT_PK(l3, h3), od, 0, 0, 0);
#undef ATT_PK
}
template <int DQK, int MODE>
__device__ __forceinline__ void attn_unit(LAS unsigned char* lds, const int wave, const bf16_t* Qb, int ldq, const bf16_t* Kh, int ldk, const bf16_t* Vh, int ldv, int key0, int ntiles, int q0,
                                          float pa_, float pb_, bf16_t* Ob, float* Of, int ldo) {
    constexpr int KB = 64 * DQK * 2, VB = 64 * 128 * 2, NKP = DQK / 8, KPT = DQK / 64, RS = DQK * 2;
    constexpr int OFF_V = 2 * KB, OFF_WS = OFF_V + 2 * VB, OFF_LUT = OFF_WS + NWAVES * 64 * 4;
    const int wid = __builtin_amdgcn_readfirstlane(wave), lane = lane_id(), tid = wid * 64 + lane, r32 = lane & 31, hi = lane >> 5;
    LAS unsigned char* Kl = lds; LAS unsigned char* Vl = lds + OFF_V; LAS float* wsf = (LAS float*)(lds + OFF_WS) + wid * 64; const LAS float* lut = (const LAS float*)(lds + OFF_LUT);
    float m_reg = (MODE == 1) ? pa_ : -1e30f, l_reg = (MODE == 1) ? 1.0f : 0.f;
    f32x16 o[4] = {}; bf16x8 qr[DQK / 16];
    { const bf16_t* Qw = Qb + (size_t)(wid * 32 + r32) * ldq + hi * 8;
#pragma unroll
      for (int d0 = 0; d0 < DQK / 16; ++d0) qr[d0] = *(const bf16x8*)(Qw + d0 * 16); }
    constexpr bool REGK = (NTHR % NKP == 0) && ((NTHR / NKP) % 8 == 0);
    int koff[REGK ? 1 : KPT], kdst[REGK ? 1 : KPT];
#pragma unroll
    for (int i = 0; i < (REGK ? 1 : KPT); ++i) { const int p = tid + NTHR * i, key = p / NKP, c8 = p % NKP; koff[i] = key * ldk + c8 * 8; kdst[i] = ATT_KSWZ(key, c8 * 16, RS); }
#define ATT_KOFF(i) (REGK ? koff[0] + (i) * (NTHR / NKP) * ldk : koff[REGK ? 0 : (i)])
#define ATT_KDST(i) (REGK ? kdst[0] + (i) * (NTHR / NKP) * RS : kdst[REGK ? 0 : (i)])
    const int sr = tid >> 4, sc = (tid & 15) * 8, vst0 = v_st(sr, sc), vst1 = vst0 + 8192;
    const int vb0 = (int)(unsigned)(uintptr_t)Vl + v_rd_base(lane);
    bf16x8 ks[KPT], vs0, vs1;
#define ATT_SLOAD(kb) do { _Pragma("unroll") for (int i = 0; i < KPT; ++i) ks[i] = *(const bf16x8*)(Kh + (size_t)(kb) * ldk + ATT_KOFF(i)); \
        vs0 = *(const bf16x8*)(Vh + (size_t)((kb) + sr) * ldv + sc); vs1 = *(const bf16x8*)(Vh + (size_t)((kb) + 32 + sr) * ldv + sc); } while (0)
#define ATT_SWRITE(b) do { _Pragma("unroll") for (int i = 0; i < KPT; ++i) *(LAS bf16x8*)(Kl + (b) * KB + ATT_KDST(i)) = ks[i]; \
        *(LAS bf16x8*)(Vl + (b) * VB + vst0) = vs0; *(LAS bf16x8*)(Vl + (b) * VB + vst1) = vs1; } while (0)
    ATT_SLOAD(key0); ATT_SWRITE(0); __syncthreads();
    for (int j = 0; j < ntiles; ++j) {
        const int cur = j & 1; const int kb = key0 + j * 64;
        if (j + 1 < ntiles) ATT_SLOAD(kb + 64);
        bool live = true;
        if constexpr (MODE == 1) { const int qlo = q0 + wid * 32; live = (kb + 63 >= qlo - WIN) && (kb <= qlo + 31 + WIN); }
        if (live) {
        f32x16 p0 = {}, p1 = {};
        { const LAS unsigned char* Ks = Kl + cur * KB;
#pragma unroll
          for (int d0 = 0; d0 < DQK / 16; ++d0) { const int cb = (d0 * 16 + hi * 8) * 2;
              const bf16x8 b0 = *(const LAS bf16x8*)(Ks + ATT_KSWZ(r32, cb, RS)), b1 = *(const LAS bf16x8*)(Ks + ATT_KSWZ(32 + r32, cb, RS));
              p0 = __builtin_amdgcn_mfma_f32_32x32x16_bf16(b0, qr[d0], p0, 0, 0, 0); p1 = __builtin_amdgcn_mfma_f32_32x32x16_bf16(b1, qr[d0], p1, 0, 0, 0); } }
        if constexpr (MODE == 2) {
            const int dq = kb - (q0 + wid * 32 + r32);
#pragma unroll
            for (int r = 0; r < 16; ++r) { const int rel0 = dq + crow(r, hi), rel1 = rel0 + 32;
                p0[r] *= __builtin_amdgcn_exp2f((rel0 <= 0 ? pa_ : pb_) * (float)rel0); p1[r] *= __builtin_amdgcn_exp2f((rel1 <= 0 ? pa_ : pb_) * (float)rel1); }
        } else {
            if constexpr (MODE == 1) { const LAS float* lp = lut + (kb - (q0 + wid * 32 + r32) + 383);
#pragma unroll
                for (int r = 0; r < 16; ++r) { p0[r] += lp[crow(r, hi)]; p1[r] += lp[32 + crow(r, hi)]; } }
            float pmax = p0[0];
#pragma unroll
            for (int r = 1; r < 16; ++r) pmax = fmaxf(pmax, p0[r]);
#pragma unroll
            for (int r = 0; r < 16; ++r) pmax = fmaxf(pmax, p1[r]);
            { auto rr = __builtin_amdgcn_permlane32_swap(__float_as_uint(pmax), __float_as_uint(pmax), false, false); pmax = fmaxf(__uint_as_float(rr[0]), __uint_as_float(rr[1])); }
            float mn, alpha;
            if (__builtin_expect(__all(pmax - m_reg <= 11.5f), 1)) { mn = m_reg; alpha = 1.f; }
            else { mn = fmaxf(m_reg, pmax); alpha = __builtin_amdgcn_exp2f(m_reg - mn); m_reg = mn; }
#pragma unroll
            for (int r = 0; r < 16; ++r) { p0[r] = __builtin_amdgcn_exp2f(p0[r] - mn); p1[r] = __builtin_amdgcn_exp2f(p1[r] - mn); }
            float ps = 0.f;
#pragma unroll
            for (int r = 0; r < 16; ++r) ps += p0[r];
#pragma unroll
            for (int r = 0; r < 16; ++r) ps += p1[r];
            { auto rr = __builtin_amdgcn_permlane32_swap(__float_as_uint(ps), __float_as_uint(ps), false, false); ps = __uint_as_float(rr[0]) + __uint_as_float(rr[1]); }
            l_reg = l_reg * alpha + ps;
            if (__any(alpha < 1.f)) { if (hi == 0) wsf[32 + r32] = alpha; asm volatile("s_waitcnt lgkmcnt(0)" ::: "memory");
#pragma unroll
                for (int r = 0; r < 16; ++r) { const float a = wsf[32 + crow(r, hi)];
#pragma unroll
                    for (int d = 0; d < 4; ++d) o[d][r] *= a; } }
        }
        bf16x8 pa0, pa1, pa2, pa3;
#define ATT_PK4(P, BASE, OUT) do { unsigned a0 = cvt_pk_bf16(P[BASE + 0], P[BASE + 1]), a1 = cvt_pk_bf16(P[BASE + 2], P[BASE + 3]); \
        unsigned b0_ = cvt_pk_bf16(P[BASE + 4], P[BASE + 5]), b1_ = cvt_pk_bf16(P[BASE + 6], P[BASE + 7]); \
        auto r0 = __builtin_amdgcn_permlane32_swap(a0, b0_, false, false); auto r1 = __builtin_amdgcn_permlane32_swap(a1, b1_, false, false); \
        v4u w = {r0[0], r1[0], r0[1], r1[1]}; OUT = *reinterpret_cast<bf16x8*>(&w); } while (0)
        ATT_PK4(p0, 0, pa0); ATT_PK4(p0, 8, pa1); ATT_PK4(p1, 0, pa2); ATT_PK4(p1, 8, pa3);
#undef ATT_PK4
        { const int vb = vb0 + cur * VB; pv_one<0>(o[0], vb, pa0, pa1, pa2, pa3); pv_one<1>(o[1], vb, pa0, pa1, pa2, pa3); pv_one<2>(o[2], vb, pa0, pa1, pa2, pa3); pv_one<3>(o[3], vb, pa0, pa1, pa2, pa3); }
        }
        if (j + 1 < ntiles) ATT_SWRITE(cur ^ 1);
        __syncthreads();
    }
#undef ATT_SLOAD
#undef ATT_SWRITE
#undef ATT_KOFF
#undef ATT_KDST
    if constexpr (MODE == 2) {
#pragma unroll
        for (int r = 0; r < 16; ++r) { float* orow = Of + (size_t)(wid * 32 + crow(r, hi)) * ldo + r32;
#pragma unroll
            for (int d0 = 0; d0 < 4; ++d0) orow[d0 * 32] = o[d0][r]; }
    } else {
        if (hi == 0) wsf[r32] = l_reg; asm volatile("s_waitcnt lgkmcnt(0)" ::: "memory");
#pragma unroll
        for (int r = 0; r < 16; ++r) { const float rl = __builtin_amdgcn_rcpf(wsf[crow(r, hi)]); bf16_t* orow = Ob + (size_t)(wid * 32 + crow(r, hi)) * ldo + r32;
#pragma unroll
            for (int d0 = 0; d0 < 4; ++d0) orow[d0 * 32] = f2bf(o[d0][r] * rl); }
    }
    __syncthreads();
}
#undef ATT_KSWZ
}

__device__ __forceinline__ void att0_phase(Frame& F) {
    const Ctx& c = F.c;
    for (int u = F.vcu; u < NB * H_A * (S / 256); u += F.G) { const int qb = u % (S / 256), h = (u / (S / 256)) % H_A, b = u / ((S / 256) * H_A);
        attn::attn_unit<QK, 0>(F.lds, F.wave, WSP(bf16_t, WS_Q) + ((size_t)(b * S + qb * 256) * H_A + h) * QK, H_A * QK, WSP(bf16_t, WS_KC) + ((size_t)b * S * H_A + h) * QK, H_A * QK,
                               WSP(bf16_t, WS_V) + ((size_t)b * S * H_A + h) * VD, H_A * VD, 0, S / 64, qb * 256, 0.f, 0.f, WSP(bf16_t, WS_MIX) + (size_t)(b * S + qb * 256) * D + h * VD, nullptr, D); }
}
__device__ __forceinline__ void ret1_phase(Frame& F) {
    const Ctx& c = F.c;
    for (int u = F.vcu; u < NB * H_C * (S / 256) * 2; u += F.G) { const int dvh = u & 1, qb = (u >> 1) % (S / 256), h = (u / (2 * (S / 256))) % H_C, b = u / (2 * (S / 256) * H_C);
        const bf16_t* Pb = WSP(bf16_t, WS_PROJ) + (size_t)b * S * CD_N;
        const float lgf = log2f(1.0f - exp2f(-5.0f - (float)h)), lgb = log2f(1.0f - exp2f(-5.0f - (float)(H_C - 1 - h)));
        const int df = (int)(11.0f / -lgf) + 1, db = (int)(11.0f / -lgb) + 1; int t0 = (qb * 256 - df - 63) / 64; if (t0 < 0) t0 = 0; int t1 = (qb * 256 + 255 + db) / 64 + 1; if (t1 > S / 64) t1 = S / 64;
        attn::attn_unit<DK, 2>(F.lds, F.wave, Pb + (size_t)qb * 256 * CD_N + h * DK, CD_N, Pb + H_C * DK + h * DK, CD_N, Pb + 2 * H_C * DK + h * DK + dvh * 128, CD_N, t0 * 64, t1 - t0, qb * 256, -lgf, lgb,
                               nullptr, WSP(float, WS_RET) + (size_t)(b * S + qb * 256) * HALF + h * DK + dvh * 128, HALF); }
}
__device__ __forceinline__ void swa1_phase(Frame& F) {
    const Ctx& c = F.c; constexpr int OFF_LUT = 2 * 64 * HDS * 2 + 2 * 64 * 128 * 2 + NWAVES * 64 * 4; LAS float* lut = (LAS float*)(F.lds + OFF_LUT);
    for (int u = F.vcu; u < NB * H_D * (S / 256); u += F.G) { const int qb = u % (S / 256), hd = (u / (S / 256)) % H_D, b = u / ((S / 256) * H_D); const int kvh = hd / (H_D / KVH);
        for (int i = F.tid(); i < 767; i += NTHR) { const int rel = i - 383; lut[i] = (rel < -WIN || rel > WIN) ? -1e30f : c.in[I_RELB][t5_bucket(rel) * H_D + hd] * LOG2E; }
        __syncthreads();
        const bf16_t* Pb = WSP(bf16_t, WS_PROJ) + (size_t)b * S * CD_N + 4 * H_C * DK;
        const int klo = qb * 256 - WIN < 0 ? 0 : qb * 256 - WIN, khi = qb * 256 + 256 + WIN > S ? S : qb * 256 + 256 + WIN;
        attn::attn_unit<HDS, 1>(F.lds, F.wave, Pb + (size_t)qb * 256 * CD_N + hd * HDS, CD_N, Pb + H_D * HDS + kvh * HDS, CD_N, Pb + H_D * HDS + KVH * HDS + kvh * HDS, CD_N, klo, (khi - klo) / 64, qb * 256,
                                c.in[I_SINKS][hd] * LOG2E, 0.f, WSP(bf16_t, WS_MIX) + (size_t)(b * S + qb * 256) * D + HALF + hd * HDS, nullptr, D); }
}


#ifndef OPT_MASK
#define OPT_MASK 0
#endif
struct MArgs { Ctx c; long ph_lo, ph_hi, use_bar, pad; };
__global__ void __launch_bounds__(NTHR, 2) mega_fwd(MArgs args) {
    extern __shared__ __attribute__((aligned(16))) unsigned char lds_raw[];
    Frame F; F.lds = (LAS unsigned char*)lds_raw; F.c = args.c;
    F.wave = __builtin_amdgcn_readfirstlane((int)threadIdx.x >> 6);
    F.G = gridDim.x; { const int bx = blockIdx.x; F.vcu = (F.G % 8 == 0) ? (bx % 8) * (F.G / 8) + bx / 8 : bx; }
    const Ctx& c = F.c;
    volatile LAS unsigned* MISC = (volatile LAS unsigned*)(F.lds + MISC_OFF);
    for (int u = F.tid(); u < 256; u += NTHR) MISC[u] = 0u;
    __syncthreads();
    XcdBarrier bar; bar.bar = (unsigned*)(c.ws + 16384); bar.x = 0; bar.st = MISC + 8; bar.wave = F.wave;
    if (args.use_bar) bar = xcd_barrier_post((unsigned*)(c.ws + 16384), MISC + 8, F.wave);
    const int lo = (int)args.ph_lo, hi = (int)args.ph_hi;
#define IN(k) (lo <= (k) && (k) < hi)
#define SEAM(k) do { if (IN(k) && IN((k) + 1)) xcd_barrier(bar); } while (0)
    float* mod = WSP(float, WS_MOD);
#ifdef SPREAD_CONV
#define CONV_EARLY(call) do { if (!(blockIdx.x & 1)) { call; __syncthreads(); } } while (0)
#define CONV_LATE(call)  do { if (blockIdx.x & 1) { __syncthreads(); call; __syncthreads(); } } while (0)
#else
#define CONV_EARLY(call) do { } while (0)
#define CONV_LATE(call)  do { } while (0)
#endif
#define CONV_GU0(k0, k1) conv_slice(F, IT_GU0, IT_DN0, k0, k1, 20)
#define CONV_GU1(k0, k1) conv_slice(F, IT_GU1, IT_DN1, k0, k1, 17)

    if (IN(PH_P0)) { p0_phase(F); } SEAM(PH_P0);
#ifdef HAVE_THIN
    if (IN(PH_MOD0)) { modulate_phase(F, c.in[I_X], c.in[I_NMIX], mod + D, mod); } SEAM(PH_MOD0);
#endif
    if (IN(PH_G1)) {
        pg8::DenseOrder S_; S_.A = (const char*)WSP(bf16_t, WS_HM); S_.B = (const char*)WSP(bf16_t, W_INAB); S_.nM = M / 256; S_.nN = P0_N / 256; S_.G = F.G; S_.c = (int)blockIdx.x; S_.a_tile = (long)256 * D * 2; S_.b_tile = (long)256 * D * 2;
        pg8::EpiG1 E_{WSP(bf16_t, WS_PROJ), WSP(bf16_t, WS_LXP), WSP(float, CTL_SSQ)};
        pg8::gemm_phase<pg8::EpiG1, pg8::DenseOrder, pg8::APlain, false, true>(F.lds, F.wave, (const char*)c.ws, D, D, D, S_, E_);
#ifdef HAVE_SKINNY
        krope_units(F);
#endif
#ifdef SPREAD_CONV
        if ((int)blockIdx.x >= F.G / 2) { __syncthreads(); const int pi = (int)blockIdx.x - F.G / 2, np = F.G - F.G / 2;
            conv_items(F, IT_OUTAB, IT_GU0, pi, np); conv_slice(F, IT_GU0, IT_DN0, 0, 4, 20, pi, np); __syncthreads(); }
#endif
    } SEAM(PH_G1);
    if (IN(PH_G2)) {
        CONV_EARLY(CONV_GU0(4, 8));
        { pg8::OrderG2 S_{(const char*)WSP(bf16_t, WS_PROJ), (const char*)WSP(bf16_t, W_UQ), (const char*)WSP(bf16_t, W_UKV), F.G, (int)blockIdx.x};
          pg8::EpiG2 E_{WSP(bf16_t, WS_Q), WSP(bf16_t, WS_KC), WSP(bf16_t, WS_V), WSP(float, CTL_SSQ), WSP(float, WS_TAB + TAB_CR), WSP(float, WS_TAB + TAB_SR), LOG2E / sqrtf((float)QK)};
          pg8::gemm_phase<pg8::EpiG2, pg8::OrderG2, pg8::APlain, false, true>(F.lds, F.wave, (const char*)c.ws, P0_N, QR, QR, S_, E_); }
        { pg8::OrderGates S_{(const char*)WSP(bf16_t, WS_LXP), (const char*)WSP(bf16_t, W_LRU), F.G, (int)((blockIdx.x + F.G / 2) % F.G)};
          pg8::EpiGates E_{WSP(bf16_t, WS_LA), WSP(bf16_t, WS_U), WSP(bf16_t, WS_LXP), WSP(float, W_GB), WSP(float, W_GB) + 4 * LW, c.in[I_CONVW], c.in[I_CONVB]};
          pg8::gemm_phase<pg8::EpiGates, pg8::OrderGates, pg8::AConv, false, true>(F.lds, F.wave, (const char*)c.ws, LW, 4 * LBS, 4 * LBS, S_, E_); }
        CONV_LATE(CONV_GU0(4, 8));
    } SEAM(PH_G2);
#ifdef HAVE_THIN
    if (IN(PH_SCAN0)) { CONV_EARLY(CONV_GU0(8, 10)); scan_phase(F); CONV_LATE(CONV_GU0(8, 10)); }
#endif
#ifdef HAVE_ATT0
    if (IN(PH_ATT0)) { CONV_EARLY(CONV_GU0(10, 14)); att0_phase(F); CONV_LATE(CONV_GU0(10, 14)); } SEAM(PH_ATT0);
#endif
    if (IN(PH_OUT0)) {
        CONV_EARLY(CONV_GU0(14, 17));
        pg8::DenseOrder S_; S_.A = (const char*)WSP(bf16_t, WS_MIX); S_.B = (const char*)WSP(bf16_t, W_OUTAB); S_.nM = M / 256; S_.nN = D / 256; S_.G = F.G; S_.c = (int)blockIdx.x; S_.a_tile = (long)256 * D * 2; S_.b_tile = (long)256 * D * 2;
        pg8::EpiOut E_{c.in[I_X], WSP(float, WS_X1), mod + 2 * D};
        pg8::gemm_phase<pg8::EpiOut, pg8::DenseOrder, pg8::APlain, false, true>(F.lds, F.wave, (const char*)c.ws, D, D, D, S_, E_);
        CONV_LATE(CONV_GU0(14, 17));
    } SEAM(PH_OUT0);
#ifdef HAVE_RT
    if (IN(PH_RT0)) { CONV_EARLY(CONV_GU0(17, 20)); route_phase(F, 0); CONV_LATE(CONV_GU0(17, 20)); } SEAM(PH_RT0);
#endif
    if (IN(PH_M1_0)) {
#ifdef SPREAD_CONV
        mod_units(F, 1);
#endif
        CONV_EARLY(conv_items(F, IT_DN0, IT_GU1));
        build_offt(F, 0);
#ifdef MOE_FP8
        typedef pg8::OrderMoeT<2 * FF / 256, true, WS_HM8, W_GU + (size_t)0 * (E + 1) * 2 * FF * D, (long)2 * FF * D, (long)256 * D, 0> OM1;
#ifdef MOE_CONTIG
        const int tot1_ = ((const LAS int*)(F.lds + TAB_OFF))[E + 1] * (2 * FF / 256), lo1_ = (int)((long)tot1_ * F.vcu / F.G), hi1_ = (int)((long)tot1_ * (F.vcu + 1) / F.G);
        OM1 S_{c.ws, lo1_, hi1_ - lo1_};
#else
        OM1 S_{c.ws, F.G, F.vcu};
#endif
        pg8::EpiM1F8 E_{c.ws};
        pg8::gemm_phase<pg8::EpiM1F8, OM1, pg8::APlain, true, true, 1>(F.lds, F.wave, (const char*)c.ws, D / 2, D / 2, D / 2, S_, E_);
#else
        pg8::OrderMoe S_{(const LAS int*)(F.lds + TAB_OFF), (const char*)WSP(bf16_t, WS_HM), (const char*)WSP(bf16_t, W_GU), WSP(int, WS_TOK), 2 * FF / 256, F.G, F.vcu, 1, (long)2 * FF * D * 2, (long)256 * D * 2, 0};
        pg8::EpiM1 E_{WSP(bf16_t, WS_ACT)};
        pg8::gemm_phase<pg8::EpiM1, pg8::OrderMoe, pg8::APlain, true, true>(F.lds, F.wave, (const char*)c.ws, D, D, D, S_, E_);
#endif
        CONV_LATE(conv_items(F, IT_DN0, IT_GU1));
    } SEAM(PH_M1_0);
    if (IN(PH_M2_0)) { CONV_EARLY(CONV_GU1(0, 4)); build_offt(F, 0);
#ifdef MOE_FP8
        typedef pg8::OrderMoeT<D / 256, false, WS_ACT, W_DN + (size_t)0 * (E + 1) * D * FF, (long)D * FF, (long)256 * FF, (long)256 * FF> OM2;
#ifdef MOE_CONTIG
        const int tot2_ = ((const LAS int*)(F.lds + TAB_OFF))[E + 1] * (D / 256), lo2_ = (int)((long)tot2_ * F.vcu / F.G), hi2_ = (int)((long)tot2_ * (F.vcu + 1) / F.G);
        OM2 S_{c.ws, lo2_, hi2_ - lo2_};
#else
        OM2 S_{c.ws, F.G, F.vcu};
#endif
        pg8::EpiM2F8 E_{c.ws};
        pg8::gemm_phase<pg8::EpiM2F8, OM2, pg8::APlain, false, true, 1>(F.lds, F.wave, (const char*)c.ws, FF / 2, FF / 2, FF / 2, S_, E_);
#else
        pg8::OrderMoe S_{(const LAS int*)(F.lds + TAB_OFF), (const char*)WSP(bf16_t, WS_ACT), (const char*)WSP(bf16_t, W_DN), WSP(int, WS_TOK), D / 256, F.G, F.vcu, 0, (long)D * FF * 2, (long)256 * FF * 2, (long)256 * FF * 2};
        pg8::EpiM2 E_{WSP(bf16_t, WS_Y), WSP(float, WS_WT), (const LAS int*)(F.lds + TAB_OFF), 1.0f};
        pg8::gemm_phase<pg8::EpiM2, pg8::OrderMoe, pg8::APlain, false, true>(F.lds, F.wave, (const char*)c.ws, FF, FF, FF, S_, E_);
#endif
        CONV_LATE(CONV_GU1(0, 4));
    } SEAM(PH_M2_0);
#ifdef HAVE_THIN
    if (IN(PH_CMB0)) { CONV_EARLY(CONV_GU1(4, 6)); combine_phase(F, 0); CONV_LATE(CONV_GU1(4, 6)); } SEAM(PH_CMB0);
#endif
    if (IN(PH_G3)) {
        pg8::DenseOrder S_; S_.A = (const char*)WSP(bf16_t, WS_HM); S_.B = (const char*)WSP(bf16_t, W_INCD); S_.nM = M / 256; S_.nN = CD_N / 256; S_.G = F.G; S_.c = (int)blockIdx.x; S_.a_tile = (long)256 * D * 2; S_.b_tile = (long)256 * D * 2;
        pg8::EpiG3 E_{WSP(bf16_t, WS_PROJ), WSP(float, WS_TAB + TAB_CT), WSP(float, WS_TAB + TAB_ST), LOG2E / sqrtf((float)HDS)};
        pg8::gemm_phase<pg8::EpiG3, pg8::DenseOrder, pg8::APlain, false, true>(F.lds, F.wave, (const char*)c.ws, D, D, D, S_, E_);
#ifdef SPREAD_CONV
        { const int nu = (M / 256) * (CD_N / 256), rem = nu % F.G;
          if (rem != 0 && (int)blockIdx.x >= rem) { __syncthreads(); conv_slice(F, IT_GU1, IT_DN1, 6, 8, 17, (int)blockIdx.x - rem, F.G - rem); __syncthreads(); }
          else if (rem == 0) { __syncthreads(); CONV_GU1(6, 8); __syncthreads(); } }
#endif
    } SEAM(PH_G3);
#ifdef HAVE_RET1
    if (IN(PH_RET1)) { CONV_EARLY(CONV_GU1(8, 12)); ret1_phase(F); CONV_LATE(CONV_GU1(8, 12)); }
#endif
#ifdef HAVE_SWA1
    if (IN(PH_SWA1)) { CONV_EARLY(CONV_GU1(12, 13)); swa1_phase(F); CONV_LATE(CONV_GU1(12, 13)); } SEAM(PH_SWA1);
#endif
#ifdef HAVE_THIN
    if (IN(PH_RN1)) { retnorm_phase(F); } SEAM(PH_RN1);
#endif
    if (IN(PH_OUT1)) {
        CONV_EARLY(CONV_GU1(13, 15));
        pg8::DenseOrder S_; S_.A = (const char*)WSP(bf16_t, WS_MIX); S_.B = (const char*)WSP(bf16_t, W_OUTCD); S_.nM = M / 256; S_.nN = D / 256; S_.G = F.G; S_.c = (int)blockIdx.x; S_.a_tile = (long)256 * D * 2; S_.b_tile = (long)256 * D * 2;
        pg8::EpiOut E_{WSP(float, WS_X2), WSP(float, WS_X1), mod + (size_t)NB * 6 * D + 2 * D};
        pg8::gemm_phase<pg8::EpiOut, pg8::DenseOrder, pg8::APlain, false, true>(F.lds, F.wave, (const char*)c.ws, D, D, D, S_, E_);
        CONV_LATE(CONV_GU1(13, 15));
    } SEAM(PH_OUT1);
#ifdef HAVE_RT
    if (IN(PH_RT1)) { CONV_EARLY(CONV_GU1(15, 17)); route_phase(F, 1); CONV_LATE(CONV_GU1(15, 17)); } SEAM(PH_RT1);
#endif
    if (IN(PH_M1_1)) { CONV_EARLY(conv_items(F, IT_DN1, IT_END)); build_offt(F, 1);
#ifdef MOE_FP8
        typedef pg8::OrderMoeT<2 * FF / 256, true, WS_HM8, W_GU + (size_t)1 * (E + 1) * 2 * FF * D, (long)2 * FF * D, (long)256 * D, 0> OM1;
#ifdef MOE_CONTIG
        const int tot1_ = ((const LAS int*)(F.lds + TAB_OFF))[E + 1] * (2 * FF / 256), lo1_ = (int)((long)tot1_ * F.vcu / F.G), hi1_ = (int)((long)tot1_ * (F.vcu + 1) / F.G);
        OM1 S_{c.ws, lo1_, hi1_ - lo1_};
#else
        OM1 S_{c.ws, F.G, F.vcu};
#endif
        pg8::EpiM1F8 E_{c.ws};
        pg8::gemm_phase<pg8::EpiM1F8, OM1, pg8::APlain, true, true, 1>(F.lds, F.wave, (const char*)c.ws, D / 2, D / 2, D / 2, S_, E_);
#else
        pg8::OrderMoe S_{(const LAS int*)(F.lds + TAB_OFF), (const char*)WSP(bf16_t, WS_HM), (const char*)(WSP(bf16_t, W_GU) + (size_t)(E + 1) * 2 * FF * D), WSP(int, WS_TOK), 2 * FF / 256, F.G, F.vcu, 1, (long)2 * FF * D * 2, (long)256 * D * 2, 0};
        pg8::EpiM1 E_{WSP(bf16_t, WS_ACT)};
        pg8::gemm_phase<pg8::EpiM1, pg8::OrderMoe, pg8::APlain, true, true>(F.lds, F.wave, (const char*)c.ws, D, D, D, S_, E_);
#endif
        CONV_LATE(conv_items(F, IT_DN1, IT_END));
    } SEAM(PH_M1_1);
    if (IN(PH_M2_1)) { build_offt(F, 1);
#ifdef MOE_FP8
        typedef pg8::OrderMoeT<D / 256, false, WS_ACT, W_DN + (size_t)1 * (E + 1) * D * FF, (long)D * FF, (long)256 * FF, (long)256 * FF> OM2;
#ifdef MOE_CONTIG
        const int tot2_ = ((const LAS int*)(F.lds + TAB_OFF))[E + 1] * (D / 256), lo2_ = (int)((long)tot2_ * F.vcu / F.G), hi2_ = (int)((long)tot2_ * (F.vcu + 1) / F.G);
        OM2 S_{c.ws, lo2_, hi2_ - lo2_};
#else
        OM2 S_{c.ws, F.G, F.vcu};
#endif
        pg8::EpiM2F8 E_{c.ws};
        pg8::gemm_phase<pg8::EpiM2F8, OM2, pg8::APlain, false, true, 1>(F.lds, F.wave, (const char*)c.ws, FF / 2, FF / 2, FF / 2, S_, E_);
#else
        pg8::OrderMoe S_{(const LAS int*)(F.lds + TAB_OFF), (const char*)WSP(bf16_t, WS_ACT), (const char*)(WSP(bf16_t, W_DN) + (size_t)(E + 1) * D * FF), WSP(int, WS_TOK), D / 256, F.G, F.vcu, 0, (long)D * FF * 2, (long)256 * FF * 2, (long)256 * FF * 2};
        pg8::EpiM2 E_{WSP(bf16_t, WS_Y), WSP(float, WS_WT), (const LAS int*)(F.lds + TAB_OFF), 1.0f};
        pg8::gemm_phase<pg8::EpiM2, pg8::OrderMoe, pg8::APlain, false, true>(F.lds, F.wave, (const char*)c.ws, FF, FF, FF, S_, E_);
#endif
    } SEAM(PH_M2_1);
#ifdef HAVE_THIN
    if (IN(PH_CMB1)) { combine_phase(F, 1); }
#endif
#undef IN
#undef SEAM
}

extern "C" void kernel_launch(void* const* d_in, const int* in_sizes, int n_in, void* d_out, int out_size, void* d_ws, size_t ws_size, hipStream_t stream) {
    static int grid = 0;
    if (grid == 0) {
        if (n_in != N_IN || out_size != M * D || ws_size < WS_END) { fprintf(stderr, "kernel_launch: unexpected shapes (n_in %d, out %d, ws %zu < %zu)\n", n_in, out_size, ws_size, (size_t)WS_END); grid = -1; return; }
        int dev = 0, cus = 0;
        if (hipGetDevice(&dev) != hipSuccess || hipDeviceGetAttribute(&cus, hipDeviceAttributeMultiprocessorCount, dev) != hipSuccess) { grid = -1; return; }
        if (hipFuncSetAttribute((const void*)mega_fwd, hipFuncAttributeMaxDynamicSharedMemorySize, LDS_BYTES) != hipSuccess) { fprintf(stderr, "kernel_launch: hipFuncSetAttribute failed\n"); grid = -1; return; }
        int per_cu = 0; (void)hipOccupancyMaxActiveBlocksPerMultiprocessor(&per_cu, (const void*)mega_fwd, NTHR, LDS_BYTES); (void)hipGetLastError();
        if (per_cu < 1) fprintf(stderr, "kernel_launch: occupancy query reports %d\n", per_cu);
        grid = cus;
    }
    if (grid < 0) return;
    Ctx c; memset((void*)&c, 0, sizeof(c));
    for (int i = 0; i < N_IN; ++i) c.in[i] = (const float*)d_in[i];
    c.out = (float*)d_out; c.ws = (unsigned char*)d_ws;
    (void)hipMemsetAsync((char*)d_ws + WS_CTL, 0, CTL_BYTES, stream);
    Launcher go{stream};
    const unsigned mask = (unsigned)(OPT_MASK);
    int n_mega = 0; for (int p = 0; p < N_PHASES; ++p) n_mega += (mask >> p) & 1u;
#ifdef FORCE_SPLIT
    const bool one = false;
#else
    const bool one = (mask == (1u << N_PHASES) - 1u);
#endif
    for (int ph = 0; ph < N_PHASES; ) {
        if ((mask >> ph) & 1u) {
            int hi = ph + 1; if (one) hi = N_PHASES;
            MArgs a; memset((void*)&a, 0, sizeof(a)); a.c = c; a.ph_lo = ph; a.ph_hi = hi; a.use_bar = one ? 1 : 0;
            hipLaunchKernelGGL(mega_fwd, dim3(grid), dim3(NTHR), LDS_BYTES, stream, a);
#ifdef DUP_PHASE
            if (!one && ph == (DUP_PHASE)) hipLaunchKernelGGL(mega_fwd, dim3(grid), dim3(NTHR), LDS_BYTES, stream, a);
#endif
            if (!one && (ph == PH_RT0 || ph == PH_RT1)) naive_offt(go, c, ph == PH_RT1);
            ph = hi;
        } else {
            naive_phase(go, c, ph);
            if (ph == PH_RT0 || ph == PH_RT1) naive_offt(go, c, ph == PH_RT1);
            ++ph;
        }
    }
}


#endif
```

```cpp
#define OPT_MASK ((1u<<N_PHASES)-1u)
#define HAVE_THIN 1
#define HAVE_SKINNY 1
#define HAVE_RT 1
#define HAVE_ATT0 1
#define HAVE_RET1 1
#define HAVE_SWA1 1
#define MOE_FP8 1
#define SPREAD_CONV 1
#ifdef HOST_TEST
#include <cmath>
#include <cstring>
#include <cstdio>
#include <cstdint>
#include <cstring>
#include <cstddef>
#define HD inline
#else
#include <hip/hip_runtime.h>
#include <cstdio>
#include <cstdint>
#include <cstring>
#define HD __host__ __device__ __forceinline__
#endif

namespace cfg {
#ifdef HOST_TEST
constexpr int D = 256, NB = 2, S = 256, H_A = 4, NOPE = 16, ROPE = 16, VD = 32, QR = 64, KVR = 64, LW = 128, LBS = 16, H_C = 4, DK = 32, H_D = 8, KVH = 2, HDS = 16, WIN = 64, FF = 32;
#else
constexpr int D = 2048, NB = 4, S = 2048, H_A = 8, NOPE = 128, ROPE = 64, VD = 128, QR = 512, KVR = 512, LW = 1024, LBS = 128, H_C = 4, DK = 256, H_D = 8, KVH = 2, HDS = 128, WIN = 128, FF = 512;
#endif
constexpr int M = NB * S, QK = NOPE + ROPE, E = 64, TOPK = 8, NG = 8, TG = 4;
constexpr int AB_N = QR + KVR + ROPE + 2 * LW, P0_N = QR + KVR + 2 * LW;
constexpr int CD_N = 4 * H_C * DK + H_D * HDS + 2 * KVH * HDS;
constexpr int HALF = D / 2;
constexpr int RT = 256;
constexpr int MAXT = (M * TOPK) / RT + E + M / RT;
constexpr float EPS = 1e-6f, LOG2E = 1.4426950408889634f;
static_assert(H_A * VD == HALF && LW == HALF && H_C * DK == HALF && H_D * HDS == HALF, "half widths");
}
using namespace cfg;

enum { I_X = 0, I_C, I_WMOD, I_BMOD, I_NMIX, I_NFFN, I_FNORM, I_WINAB, I_QLN, I_KVLN, I_WUQ, I_WUKV, I_CONVW, I_CONVB, I_LWA, I_LBA, I_LWX, I_LBX, I_LLAM, I_WOUTAB,
       I_WINCD, I_RETGN, I_SINKS, I_WOUTCD, I_RELB, I_WROUTER, I_RBIAS, I_WGATE, I_WUP, I_WDOWN, I_WSG, I_WSU, I_WSD, N_IN };

typedef unsigned short bf16_t;
HD float bf2f(bf16_t v) { unsigned u = (unsigned)v << 16; float f; __builtin_memcpy(&f, &u, 4); return f; }
HD bf16_t f2bf(float f) { unsigned u; __builtin_memcpy(&u, &f, 4); u += 0x7fffu + ((u >> 16) & 1u); return (bf16_t)(u >> 16); }
HD float sigm(float x) { return 1.0f / (1.0f + expf(-x)); }
HD float siluf(float x) { return x * sigm(x); }
HD float gelu_tanh(float x) { return 0.5f * x * (1.0f + tanhf(0.7978845608028654f * (x + 0.044715f * x * x * x))); }
HD int cnt_idx(int l, int e) { return (l * E + e) * 64; }
HD float ssq8(const float* p) { return ((p[0] + p[1]) + (p[2] + p[3])) + ((p[4] + p[5]) + (p[6] + p[7])); }
HD int t5_bucket(int rel) {
    const int n = rel < 0 ? -rel : rel; const int ret = rel > 0 ? 16 : 0;
    if (n < 8) return ret + n;
    return ret + 8 + (n >= 12) + (n >= 16) + (n >= 23) + (n >= 32) + (n >= 46) + (n >= 64) + (n >= 91);
}

constexpr size_t al(size_t x) { return (x + 4095) & ~size_t(4095); }
constexpr size_t WS_CTL = 0, CTL_BYTES = 1u << 20;
constexpr size_t CTL_CNT = 65536;
constexpr size_t CTL_SSQ = 131072;
constexpr size_t WS_MOD = CTL_BYTES;
constexpr size_t WS_TAB = WS_MOD + al((size_t)2 * NB * 6 * D * 4);
constexpr size_t TAB_CR = 0, TAB_SR = (size_t)S * (ROPE / 2) * 4, TAB_CT = 2 * TAB_SR, TAB_ST = TAB_CT + (size_t)S * (DK / 2) * 4;
constexpr size_t WS_RSTD = WS_TAB + al(TAB_ST + (size_t)S * (DK / 2) * 4);
constexpr size_t WS_SELE = WS_RSTD + al((size_t)M * 4);
constexpr size_t WS_SELR = WS_SELE + al((size_t)M * 8 * 4);
constexpr size_t WS_SELW = WS_SELR + al((size_t)M * 8 * 4);
constexpr size_t WS_TOK = WS_SELW + al((size_t)M * 8 * 4);
constexpr size_t WS_WT = WS_TOK + al((size_t)E * M * 4);
constexpr size_t WS_OFFT = WS_WT + al((size_t)E * M * 4);
constexpr size_t WS_HM = WS_OFFT + 4096;
constexpr size_t WS_HM8 = WS_HM + al((size_t)M * D * 2);
constexpr size_t WS_MIX = WS_HM8 + al((size_t)M * D);
constexpr size_t WS_X1 = WS_MIX + al((size_t)M * D * 2);
constexpr size_t WS_X2 = WS_X1 + al((size_t)M * D * 4);
constexpr size_t WS_PROJ = WS_X2 + al((size_t)M * D * 4);
constexpr size_t WS_L0 = WS_PROJ + al((size_t)M * (P0_N > CD_N ? P0_N : CD_N) * 2);
constexpr size_t WS_Q = WS_L0;
constexpr size_t WS_KC = WS_Q + al((size_t)M * H_A * QK * 2);
constexpr size_t WS_V = WS_KC + al((size_t)M * H_A * QK * 2);
constexpr size_t WS_XC = WS_V + al((size_t)M * H_A * VD * 2);
constexpr size_t WS_LA = WS_XC + al((size_t)M * LW * 2);
constexpr size_t WS_U = WS_LA + al((size_t)2 * M * LW * 2);
constexpr size_t WS_HF = WS_U + al((size_t)2 * M * LW * 2);
constexpr size_t WS_LXP = WS_HF + al((size_t)M * LW * 4);
constexpr size_t WS_RET = WS_L0;
constexpr size_t WS_ACT = WS_LXP + al((size_t)NB * (S + 4) * LW * 2);
constexpr size_t WS_Y = WS_ACT + al((size_t)MAXT * RT * FF * 2);
constexpr size_t WS_T = WS_Y;
constexpr size_t WS_SC = WS_T + al((size_t)M * CD_N * 4);
static_assert(WS_SC + (size_t)8 * S * S * 4 <= WS_Y + (size_t)MAXT * RT * D * 2, "naive temps fit in the Y region");
constexpr size_t WS_W = WS_Y + al((size_t)MAXT * RT * D * 2);
constexpr size_t W_INAB = WS_W;
constexpr size_t W_UQ = W_INAB + al((size_t)AB_N * D * 2);
constexpr size_t W_UKV = W_UQ + al((size_t)H_A * QK * QR * 2);
constexpr size_t W_LRU = W_UKV + al((size_t)H_A * (NOPE + VD) * KVR * 2);
constexpr size_t W_OUTAB = W_LRU + al((size_t)2 * (LW / LBS) * 2 * LBS * 4 * LBS * 2);
constexpr size_t W_INCD = W_OUTAB + al((size_t)D * D * 2);
constexpr size_t W_OUTCD = W_INCD + al((size_t)CD_N * D * 2);
constexpr size_t W_RT = W_OUTCD + al((size_t)D * D * 2);
constexpr size_t W_GU = W_RT + al((size_t)2 * E * D * 2);
constexpr size_t W_DN = W_GU + al((size_t)2 * (E + 1) * 2 * FF * D * 2);
constexpr size_t W_GB = W_DN + al((size_t)2 * (E + 1) * D * FF * 2);
constexpr size_t WS_END = W_GB + al((size_t)6 * LW * 4);

struct Ctx { const float* in[N_IN]; float* out; unsigned char* ws; };
#define WSP(T, off) ((T*)(c.ws + (off)))
HD long lru_idx(int d, int b, int t, int ch) { return ((((long)d * NB + b) * (LW / 8) + ch / 8) * S + t) * 8 + (ch % 8); }
HD int atomic_inc(int* p) {
#ifdef HOST_TEST
    return (*p)++;
#else
#if defined(__HIP_DEVICE_COMPILE__)
    return atomicAdd(p, 1);
#else
    return (*p)++;
#endif
#endif
}

struct NGemm {
    const void* A; const void* B; void* C; const float* ks;
    long a_rs, a_ks, a_z1, a_z2, b_ks, b_ns, b_z1, b_z2, c_rs, c_z1, c_z2;
    long Mr, N, K, Z2, a_bf, b_bf, c_bf;
    HD float la(long i) const { return a_bf ? bf2f(((const bf16_t*)A)[i]) : ((const float*)A)[i]; }
    HD float lb(long i) const { return b_bf ? bf2f(((const bf16_t*)B)[i]) : ((const float*)B)[i]; }
    HD void operator()(long i) const {
        const long n4c = N / 4, m4c = Mr / 4;
        const long n0 = (i % n4c) * 4; const long r = i / n4c; const long m0 = (r % m4c) * 4; const long z = r / m4c; const long z1 = z / Z2, z2 = z % Z2;
        const long ab = z1 * a_z1 + z2 * a_z2, bb = z1 * b_z1 + z2 * b_z2, cb = z1 * c_z1 + z2 * c_z2;
        float acc[4][4];
#pragma unroll
        for (int x = 0; x < 4; ++x)
#pragma unroll
            for (int y = 0; y < 4; ++y) acc[x][y] = 0.f;
        for (long k = 0; k < K; ++k) {
            const float s = ks ? ks[k] : 1.0f;
            float av[4], bv[4];
#pragma unroll
            for (int x = 0; x < 4; ++x) av[x] = la(ab + (m0 + x) * a_rs + k * a_ks) * s;
#pragma unroll
            for (int y = 0; y < 4; ++y) bv[y] = lb(bb + k * b_ks + (n0 + y) * b_ns);
#pragma unroll
            for (int x = 0; x < 4; ++x)
#pragma unroll
                for (int y = 0; y < 4; ++y) acc[x][y] += av[x] * bv[y];
        }
#pragma unroll
        for (int x = 0; x < 4; ++x)
#pragma unroll
            for (int y = 0; y < 4; ++y) { const long ci = cb + (m0 + x) * c_rs + n0 + y; if (c_bf) ((bf16_t*)C)[ci] = f2bf(acc[x][y]); else ((float*)C)[ci] = acc[x][y]; }
    }
    long count(long Z) const { return Z * (Mr / 4) * (N / 4); }
};

struct ModF { Ctx c;
    HD void operator()(long i) const { const long n4c = 6 * D / 4; const long n = (i % n4c) * 4; const long r = i / n4c; const int b = (int)(r % NB), l = (int)(r / NB);
        float a0 = c.in[I_BMOD][l * 6 * D + n], a1 = c.in[I_BMOD][l * 6 * D + n + 1], a2 = c.in[I_BMOD][l * 6 * D + n + 2], a3 = c.in[I_BMOD][l * 6 * D + n + 3];
        const float* w = c.in[I_WMOD] + (size_t)l * D * 6 * D + n;
        for (int k = 0; k < D; ++k) { const float ca = siluf(c.in[I_C][b * D + k]); const float* wr = w + (size_t)k * 6 * D; a0 += ca * wr[0]; a1 += ca * wr[1]; a2 += ca * wr[2]; a3 += ca * wr[3]; }
        float* o = WSP(float, WS_MOD) + ((size_t)l * NB + b) * 6 * D + n; o[0] = a0; o[1] = a1; o[2] = a2; o[3] = a3; }
    long count() const { return (long)2 * NB * 6 * D / 4; } };
struct TabF { Ctx c;
    HD void operator()(long i) const { const int W = ROPE / 2 + DK / 2; const int t = (int)(i / W), j = (int)(i % W);
        if (j < ROPE / 2) { const double inv = pow(10000.0, -2.0 * j / ROPE), a = t * inv; WSP(float, WS_TAB + TAB_CR)[t * (ROPE / 2) + j] = (float)cos(a); WSP(float, WS_TAB + TAB_SR)[t * (ROPE / 2) + j] = (float)sin(a); }
        else { const int jj = j - ROPE / 2; const double inv = pow(10000.0, -2.0 * jj / DK), a = t * inv; WSP(float, WS_TAB + TAB_CT)[t * (DK / 2) + jj] = (float)cos(a); WSP(float, WS_TAB + TAB_ST)[t * (DK / 2) + jj] = (float)sin(a); } }
    long count() const { return (long)S * (ROPE / 2 + DK / 2); } };
struct RowSSF { Ctx c; const float* X; float* out; long rs, ncols, rows, os;
    HD void operator()(long i) const { const float* x = X + i * rs; float s = 0.f; for (long j = 0; j < ncols; ++j) s += x[j] * x[j]; out[i * os] = s; }
    long count() const { return rows; } };
struct ModulateF { Ctx c; const float* X; const float* gain; const float* sc; const float* sh;
    HD void operator()(long i) const { const long m = i / D, j = i % D; const int b = (int)(m / S); const float r = 1.0f / sqrtf(WSP(float, WS_RSTD)[m] / D + EPS);
        WSP(bf16_t, WS_HM)[i] = f2bf(X[i] * r * gain[j] * (1.0f + sc[(size_t)b * 6 * D + j]) + sh[(size_t)b * 6 * D + j]); }
    long count() const { return (long)M * D; } };
struct FinalF { Ctx c; const float* X;
    HD void operator()(long i) const { const long m = i / D, j = i % D; const float r = 1.0f / sqrtf(WSP(float, WS_RSTD)[m] / D + EPS); c.out[i] = X[i] * r * c.in[I_FNORM][j]; }
    long count() const { return (long)M * D; } };
struct PostG1F { Ctx c;
    HD void operator()(long i) const { const long m = i / AB_N; const int col = (int)(i % AB_N); const float v = WSP(float, WS_T)[i]; bf16_t* P = WSP(bf16_t, WS_PROJ) + m * P0_N;
        if (col < QR + KVR) P[col] = f2bf(v);
        else if (col < QR + KVR + ROPE) {}
        else if (col < QR + KVR + ROPE + LW) { P[col - ROPE] = f2bf(v); const long b = m / S, t = m % S; WSP(bf16_t, WS_LXP)[(b * (S + 4) + 2 + t) * LW + col - (QR + KVR + ROPE)] = f2bf(v); }
        else P[col - ROPE] = f2bf(gelu_tanh(v)); }
    long count() const { return (long)M * AB_N; } };
struct KRopeF { Ctx c;
    HD void operator()(long i) const { const long m = i / (ROPE / 2); const int ii = (int)(i % (ROPE / 2)); const int t = (int)(m % S); const float* T = WSP(float, WS_T) + m * AB_N + QR + KVR;
        const float x1 = T[ii], x2 = T[ROPE / 2 + ii], cs = WSP(float, WS_TAB + TAB_CR)[t * (ROPE / 2) + ii], sn = WSP(float, WS_TAB + TAB_SR)[t * (ROPE / 2) + ii];
        const bf16_t o1 = f2bf(x1 * cs - x2 * sn), o2 = f2bf(x2 * cs + x1 * sn);
        for (int h = 0; h < H_A; ++h) { bf16_t* K = WSP(bf16_t, WS_KC) + (m * H_A + h) * QK + NOPE; K[ii] = o1; K[ROPE / 2 + ii] = o2; } }
    long count() const { return (long)M * (ROPE / 2); } };
struct PostQF { Ctx c; float qs;
    HD void operator()(long i) const { const long m = i / (H_A * QK); const int r = (int)(i % (H_A * QK)), h = r / QK, j = r % QK; const int t = (int)(m % S);
        const float rstd = 1.0f / sqrtf(ssq8(WSP(float, CTL_SSQ) + m * 16) / QR + EPS) * qs; const float* T = WSP(float, WS_T) + m * (H_A * QK) + h * QK; bf16_t* Q = WSP(bf16_t, WS_Q) + (m * H_A + h) * QK;
        if (j < NOPE) Q[j] = f2bf(T[j] * rstd);
        else if (j < NOPE + ROPE / 2) { const int ii = j - NOPE; const float x1 = T[NOPE + ii] * rstd, x2 = T[NOPE + ROPE / 2 + ii] * rstd, cs = WSP(float, WS_TAB + TAB_CR)[t * (ROPE / 2) + ii], sn = WSP(float, WS_TAB + TAB_SR)[t * (ROPE / 2) + ii];
            Q[NOPE + ii] = f2bf(x1 * cs - x2 * sn); Q[NOPE + ROPE / 2 + ii] = f2bf(x2 * cs + x1 * sn); } }
    long count() const { return (long)M * H_A * QK; } };
struct PostKVF { Ctx c;
    HD void operator()(long i) const { const int W = NOPE + VD; const long m = i / (H_A * W); const int r = (int)(i % (H_A * W)), h = r / W, j = r % W;
        const float rstd = 1.0f / sqrtf(ssq8(WSP(float, CTL_SSQ) + m * 16 + 8) / KVR + EPS); const float v = WSP(float, WS_T)[i] * rstd;
        if (j < NOPE) WSP(bf16_t, WS_KC)[(m * H_A + h) * QK + j] = f2bf(v); else WSP(bf16_t, WS_V)[(m * H_A + h) * VD + j - NOPE] = f2bf(v); }
    long count() const { return (long)M * H_A * (NOPE + VD); } };
struct ConvF { Ctx c;
    HD void operator()(long i) const { const long m = i / LW; const int ch = (int)(i % LW); const int t = (int)(m % S); float a = c.in[I_CONVB][ch];
        for (int j = 0; j < 4; ++j) { const int tt = t + j - 2; if (tt >= 0 && tt < S) a += c.in[I_CONVW][j * LW + ch] * bf2f(WSP(bf16_t, WS_PROJ)[(m + j - 2) * P0_N + QR + KVR + ch]); }
        WSP(bf16_t, WS_XC)[i] = f2bf(a); }
    long count() const { return (long)M * LW; } };
struct GatesF { Ctx c;
    HD void operator()(long i) const { const int ch = (int)(i % LW); const long r = i / LW; const long m = r % M; const int d = (int)(r / M); const int g = ch / LBS, j = ch % LBS; const int b = (int)(m / S), t = (int)(m % S);
        const bf16_t* xr = WSP(bf16_t, WS_XC) + m * LW + g * LBS; const float* wa = c.in[I_LWA] + ((size_t)(d * (LW / LBS) + g) * LBS) * LBS + j; const float* wx = c.in[I_LWX] + ((size_t)(d * (LW / LBS) + g) * LBS) * LBS + j;
        float za = c.in[I_LBA][d * LW + ch], zx = c.in[I_LBX][d * LW + ch];
        for (int k = 0; k < LBS; ++k) { const float x = bf2f(xr[k]); za += x * wa[(size_t)k * LBS]; zx += x * wx[(size_t)k * LBS]; }
        const float lam = c.in[I_LLAM][d * LW + ch]; const float sp = log1pf(expf(-lam));
        const float la = -8.0f * sigm(za) * sp; const float u = sqrtf(-expm1f(2.0f * la)) * (sigm(zx) * bf2f(WSP(bf16_t, WS_XC)[m * LW + ch]));
        const long o = lru_idx(d, b, t, ch); WSP(bf16_t, WS_LA)[o] = f2bf(la); WSP(bf16_t, WS_U)[o] = f2bf(u); }
    long count() const { return (long)2 * M * LW; } };
struct ScanF { Ctx c;
    HD void operator()(long i) const { const int b = (int)(i / LW), ch = (int)(i % LW); float h = 0.f;
        for (int t = 0; t < S; ++t) { const long o = lru_idx(0, b, t, ch); h = expf(bf2f(WSP(bf16_t, WS_LA)[o])) * h + bf2f(WSP(bf16_t, WS_U)[o]); WSP(float, WS_HF)[((long)b * S + t) * LW + ch] = h; }
        h = 0.f;
        for (int t = S - 1; t >= 0; --t) { const long o = lru_idx(1, b, t, ch); h = expf(bf2f(WSP(bf16_t, WS_LA)[o])) * h + bf2f(WSP(bf16_t, WS_U)[o]); const long m = (long)b * S + t;
            WSP(bf16_t, WS_MIX)[m * D + HALF + ch] = f2bf((WSP(float, WS_HF)[m * LW + ch] + h) * bf2f(WSP(bf16_t, WS_PROJ)[m * P0_N + QR + KVR + LW + ch])); } }
    long count() const { return (long)NB * LW; } };
struct SoftmaxF { Ctx c; long rows;
    HD void operator()(long i) const { float* r = WSP(float, WS_SC) + i * S; float mx = -INFINITY; for (int k = 0; k < S; ++k) mx = fmaxf(mx, r[k]); float s = 0.f; for (int k = 0; k < S; ++k) { const float p = exp2f(r[k] - mx); r[k] = p; s += p; }
        const float inv = 1.0f / s; for (int k = 0; k < S; ++k) r[k] *= inv; }
    long count() const { return rows; } };
struct OutPostF { Ctx c; const float* Xin; float* Xout; long l;
    HD void operator()(long i) const { const long m = i / D, n = i % D; const int b = (int)(m / S); Xout[i] = Xin[i] + WSP(float, WS_MOD)[((size_t)l * NB + b) * 6 * D + 2 * D + n] * WSP(float, WS_T)[i]; }
    long count() const { return (long)M * D; } };
struct RouteF { Ctx c; long l;
    HD float bz(const float* lg, const float* bias, int e) const { return sigm(lg[e]) + bias[e]; }
    HD void operator()(long m) const { const float* lg = WSP(float, WS_T) + m * E; const float* bias = c.in[I_RBIAS] + l * E;
        unsigned gmask = 0u;
        for (int it = 0; it < TG; ++it) { float best = -INFINITY; int bi = 0;
            for (int g = 0; g < NG; ++g) if (!((gmask >> g) & 1u)) { float m1 = -INFINITY, m2 = -INFINITY; for (int j = 0; j < E / NG; ++j) { const float v = bz(lg, bias, g * (E / NG) + j); if (v > m1) { m2 = m1; m1 = v; } else if (v > m2) m2 = v; }
                const float sc = m1 + m2; if (sc > best) { best = sc; bi = g; } }
            gmask |= 1u << bi; }
        unsigned long long taken = 0ull; float wsum = 0.f; int* se = WSP(int, WS_SELE) + m * TOPK; float* sw = WSP(float, WS_SELW) + m * TOPK; int* sr = WSP(int, WS_SELR) + m * TOPK;
        for (int k = 0; k < TOPK; ++k) { float best = -INFINITY; int bi = 0;
            for (int e = 0; e < E; ++e) if (((gmask >> (e / (E / NG))) & 1u) && !((taken >> e) & 1ull)) { const float v = bz(lg, bias, e); if (v > best) { best = v; bi = e; } }
            taken |= 1ull << bi; const float s = sigm(lg[bi]); se[k] = bi; sw[k] = s; wsum += s; }
        int* cnt = WSP(int, CTL_CNT);
        for (int k = 0; k < TOPK; ++k) { const int e = se[k]; const float w = sw[k] / wsum * 2.5f; const int rank = atomic_inc(cnt + cnt_idx((int)l, e)); sr[k] = rank; sw[k] = w;
            WSP(int, WS_TOK)[(size_t)e * M + rank] = (int)m; WSP(float, WS_WT)[(size_t)e * M + rank] = w; } }
    long count() const { return M; } };
struct OffF { Ctx c; long l;
    HD void operator()(long) const { int* o = WSP(int, WS_OFFT); const int* cnt = WSP(int, CTL_CNT); o[0] = 0; for (int e = 0; e <= E; ++e) { const int n = e < E ? cnt[cnt_idx((int)l, e)] : M; o[e + 1] = o[e] + (n + RT - 1) / RT; } }
    long count() const { return 1; } };
struct Moe1F { Ctx c; long l;
    HD void operator()(long i) const { const long f4c = FF / 4; const int f = (int)(i % f4c) * 4; const long r = i / f4c; const int rank = (int)(r % M), e = (int)(r / M);
        const int n = e < E ? WSP(int, CTL_CNT)[cnt_idx((int)l, e)] : M; if (rank >= n) return;
        const int tok = e < E ? WSP(int, WS_TOK)[(size_t)e * M + rank] : rank; const long row = (long)WSP(int, WS_OFFT)[e] * RT + rank;
        const float* wg = (e < E ? c.in[I_WGATE] + ((size_t)l * E + e) * D * FF : c.in[I_WSG] + (size_t)l * D * FF) + f;
        const float* wu = (e < E ? c.in[I_WUP] + ((size_t)l * E + e) * D * FF : c.in[I_WSU] + (size_t)l * D * FF) + f;
        const bf16_t* h = WSP(bf16_t, WS_HM) + (size_t)tok * D; float g0 = 0, g1 = 0, g2 = 0, g3 = 0, u0 = 0, u1 = 0, u2 = 0, u3 = 0;
        for (int k = 0; k < D; ++k) { const float a = bf2f(h[k]); const float* pg = wg + (size_t)k * FF; const float* pu = wu + (size_t)k * FF;
            g0 += a * pg[0]; g1 += a * pg[1]; g2 += a * pg[2]; g3 += a * pg[3]; u0 += a * pu[0]; u1 += a * pu[1]; u2 += a * pu[2]; u3 += a * pu[3]; }
        bf16_t* o = WSP(bf16_t, WS_ACT) + row * FF + f; o[0] = f2bf(siluf(g0) * u0); o[1] = f2bf(siluf(g1) * u1); o[2] = f2bf(siluf(g2) * u2); o[3] = f2bf(siluf(g3) * u3); }
    long count() const { return (long)(E + 1) * M * (FF / 4); } };
struct Moe2F { Ctx c; long l;
    HD void operator()(long i) const { const long d4c = D / 4; const int d = (int)(i % d4c) * 4; const long r = i / d4c; const int rank = (int)(r % M), e = (int)(r / M);
        const int n = e < E ? WSP(int, CTL_CNT)[cnt_idx((int)l, e)] : M; if (rank >= n) return;
        const long row = (long)WSP(int, WS_OFFT)[e] * RT + rank; const float wt = e < E ? WSP(float, WS_WT)[(size_t)e * M + rank] : 1.0f;
        const float* wd = (e < E ? c.in[I_WDOWN] + ((size_t)l * E + e) * FF * D : c.in[I_WSD] + (size_t)l * FF * D) + d;
        const bf16_t* a = WSP(bf16_t, WS_ACT) + row * FF; float y0 = 0, y1 = 0, y2 = 0, y3 = 0;
        for (int f = 0; f < FF; ++f) { const float v = bf2f(a[f]); const float* p = wd + (size_t)f * D; y0 += v * p[0]; y1 += v * p[1]; y2 += v * p[2]; y3 += v * p[3]; }
        bf16_t* o = WSP(bf16_t, WS_Y) + row * D + d; o[0] = f2bf(wt * y0); o[1] = f2bf(wt * y1); o[2] = f2bf(wt * y2); o[3] = f2bf(wt * y3); }
    long count() const { return (long)(E + 1) * M * (D / 4); } };
struct CombineF { Ctx c; const float* Xin; float* Xout; long l;
    HD void operator()(long i) const { const long m = i / D, n = i % D; const int b = (int)(m / S); const int* offt = WSP(int, WS_OFFT); const bf16_t* Y = WSP(bf16_t, WS_Y); float v = 0.f;
        for (int k = 0; k < TOPK; ++k) { const int e = WSP(int, WS_SELE)[m * TOPK + k], r = WSP(int, WS_SELR)[m * TOPK + k]; v += bf2f(Y[((size_t)offt[e] * RT + r) * D + n]); }
        v += bf2f(Y[((size_t)offt[E] * RT + m) * D + n]);
        Xout[i] = Xin[i] + WSP(float, WS_MOD)[((size_t)l * NB + b) * 6 * D + 5 * D + n] * v; }
    long count() const { return (long)M * D; } };
struct PostG3F { Ctx c; float sqs;
    HD void operator()(long i) const { const long m = i / CD_N; const int col = (int)(i % CD_N); const int t = (int)(m % S); const float* T = WSP(float, WS_T) + m * CD_N; bf16_t* P = WSP(bf16_t, WS_PROJ) + m * CD_N; const int W = H_C * DK;
        if (col < 2 * W) { const int j = col % DK; if (j < DK / 2) { const float sc = col < W ? 1.0f : 1.0f / sqrtf((float)DK); const float x1 = T[col], x2 = T[col + DK / 2], cs = WSP(float, WS_TAB + TAB_CT)[t * (DK / 2) + j], sn = WSP(float, WS_TAB + TAB_ST)[t * (DK / 2) + j];
                P[col] = f2bf((x1 * cs - x2 * sn) * sc); P[col + DK / 2] = f2bf((x2 * cs + x1 * sn) * sc); } }
        else if (col < 3 * W) P[col] = f2bf(T[col]);
        else if (col < 4 * W) P[col] = f2bf(siluf(T[col]));
        else if (col < 4 * W + H_D * HDS) P[col] = f2bf(T[col] * sqs);
        else P[col] = f2bf(T[col]); }
    long count() const { return (long)M * CD_N; } };
struct DecayF { Ctx c;
    HD void operator()(long i) const { const int mm = (int)(i % S); const long r = i / S; const int n = (int)(r % S), h = (int)(r / S);
        const float lgf = log1pf(-exp2f(-5.0f - h)), lgb = log1pf(-exp2f(-5.0f - (H_C - 1 - h)));
        WSP(float, WS_SC)[i] *= (n >= mm) ? expf(lgf * (n - mm)) : expf(lgb * (mm - n)); }
    long count() const { return (long)H_C * S * S; } };
struct RetNormF { Ctx c;
    HD void operator()(long i) const { const long m = i / H_C; const int h = (int)(i % H_C); const float* r = WSP(float, WS_RET) + m * HALF + h * DK; float s = 0.f; for (int j = 0; j < DK; ++j) s += r[j] * r[j];
        const float rs = 1.0f / sqrtf(s / DK + EPS); for (int j = 0; j < DK; ++j) WSP(bf16_t, WS_MIX)[m * D + h * DK + j] = f2bf(bf2f(WSP(bf16_t, WS_PROJ)[m * CD_N + 3 * H_C * DK + h * DK + j]) * (r[j] * rs * c.in[I_RETGN][h * DK + j])); }
    long count() const { return (long)M * H_C; } };
struct SwaSoftF { Ctx c;
    HD void operator()(long i) const { const int q = (int)(i % S), hd = (int)(i / S); float* r = WSP(float, WS_SC) + i * S; const float sink = c.in[I_SINKS][hd] * LOG2E; const float* rb = c.in[I_RELB];
        const int lo = q - WIN < 0 ? 0 : q - WIN, hi = q + WIN > S - 1 ? S - 1 : q + WIN; float mx = sink;
        for (int k = lo; k <= hi; ++k) { const float s = r[k] + rb[t5_bucket(k - q) * H_D + hd] * LOG2E; r[k] = s; mx = fmaxf(mx, s); }
        float den = exp2f(sink - mx); for (int k = lo; k <= hi; ++k) { const float p = exp2f(r[k] - mx); r[k] = p; den += p; }
        const float inv = 1.0f / den; for (int k = 0; k < S; ++k) r[k] = (k >= lo && k <= hi) ? r[k] * inv : 0.f; }
    long count() const { return (long)H_D * S; } };

#ifdef HOST_TEST
struct Launcher { template <class F> void operator()(const F& f, long n) const { for (long i = 0; i < n; ++i) f(i); } };
#else
template <class F> __global__ void __launch_bounds__(256) run_k(F f, long n) { for (long i = (long)blockIdx.x * 256 + threadIdx.x; i < n; i += (long)gridDim.x * 256) f(i); }
struct Launcher { hipStream_t st; template <class F> void operator()(const F& f, long n) const { long g = (n + 255) / 256; if (g > (1 << 20)) g = 1 << 20; if (g < 1) g = 1; hipLaunchKernelGGL(run_k<F>, dim3((unsigned)g), dim3(256), 0, st, f, n); } };
#endif

template <class F> static F zf() { F f; memset((void*)&f, 0, sizeof(F)); return f; }
static NGemm mk_gemm(const void* A, int a_bf, long a_rs, const void* B, int b_bf, long b_ks, long b_ns, void* C, int c_bf, long c_rs, long Mr, long N, long K) {
    NGemm g; memset((void*)&g, 0, sizeof(g)); g.A = A; g.B = B; g.C = C; g.a_bf = a_bf; g.b_bf = b_bf; g.c_bf = c_bf; g.a_rs = a_rs; g.a_ks = 1; g.b_ks = b_ks; g.b_ns = b_ns; g.c_rs = c_rs; g.Mr = Mr; g.N = N; g.K = K; g.Z2 = 1; return g; }

template <class L> static void rowss(const L& go, const Ctx& c, const float* X, float* out, long rs, long ncols, long os = 1) { RowSSF f = zf<RowSSF>(); f.c = c; f.X = X; f.out = out; f.rs = rs; f.ncols = ncols; f.rows = M; f.os = os; go(f, f.count()); }

enum { PH_P0 = 0, PH_MOD0, PH_G1, PH_G2, PH_SCAN0, PH_ATT0, PH_OUT0, PH_RT0, PH_M1_0, PH_M2_0, PH_CMB0, PH_G3, PH_RET1, PH_SWA1, PH_RN1, PH_OUT1, PH_RT1, PH_M1_1, PH_M2_1, PH_CMB1, N_PHASES };

template <class L> static void naive_phase(const L& go, const Ctx& c, int ph) {
    float* mod = WSP(float, WS_MOD);
    const int l = ph >= PH_G3 ? 1 : 0;
    float* X1 = WSP(float, WS_X1); float* X2 = WSP(float, WS_X2);
    switch (ph) {
    case PH_P0: { { ModF f = zf<ModF>(); f.c = c; go(f, f.count()); } { TabF f = zf<TabF>(); f.c = c; go(f, f.count()); } } break;
    case PH_MOD0: { rowss(go, c, c.in[I_X], WSP(float, WS_RSTD), D, D);
        ModulateF f = zf<ModulateF>(); f.c = c; f.X = c.in[I_X]; f.gain = c.in[I_NMIX]; f.sc = mod + D; f.sh = mod; go(f, f.count()); } break;
    case PH_G1: { { NGemm g = mk_gemm(WSP(bf16_t, WS_HM), 1, D, c.in[I_WINAB], 0, AB_N, 1, WSP(float, WS_T), 0, AB_N, M, AB_N, D); go(g, g.count(1)); }
        { PostG1F f = zf<PostG1F>(); f.c = c; go(f, f.count()); }
        rowss(go, c, WSP(float, WS_T), WSP(float, CTL_SSQ), AB_N, QR, 16);
        rowss(go, c, WSP(float, WS_T) + QR, WSP(float, CTL_SSQ) + 8, AB_N, KVR, 16);
        { KRopeF f = zf<KRopeF>(); f.c = c; go(f, f.count()); } } break;
    case PH_G2: { { NGemm g = mk_gemm(WSP(bf16_t, WS_PROJ), 1, P0_N, c.in[I_WUQ], 0, H_A * QK, 1, WSP(float, WS_T), 0, H_A * QK, M, H_A * QK, QR); g.ks = c.in[I_QLN]; go(g, g.count(1)); }
        { PostQF f = zf<PostQF>(); f.c = c; f.qs = LOG2E / sqrtf((float)QK); go(f, f.count()); }
        { NGemm g = mk_gemm(WSP(bf16_t, WS_PROJ) + QR, 1, P0_N, c.in[I_WUKV], 0, H_A * (NOPE + VD), 1, WSP(float, WS_T), 0, H_A * (NOPE + VD), M, H_A * (NOPE + VD), KVR); g.ks = c.in[I_KVLN]; go(g, g.count(1)); }
        { PostKVF f = zf<PostKVF>(); f.c = c; go(f, f.count()); }
        { ConvF f = zf<ConvF>(); f.c = c; go(f, f.count()); }
        { GatesF f = zf<GatesF>(); f.c = c; go(f, f.count()); } } break;
    case PH_SCAN0: { ScanF f = zf<ScanF>(); f.c = c; go(f, f.count()); } break;
    case PH_ATT0: {
        for (int b = 0; b < NB; ++b) {
            NGemm g = mk_gemm(WSP(bf16_t, WS_Q) + (size_t)b * S * H_A * QK, 1, H_A * QK, WSP(bf16_t, WS_KC) + (size_t)b * S * H_A * QK, 1, 1, H_A * QK, WSP(float, WS_SC), 0, S, S, S, QK);
            g.a_z2 = QK; g.b_z2 = QK; g.c_z2 = (long)S * S; g.Z2 = H_A; go(g, g.count(H_A));
            { SoftmaxF f = zf<SoftmaxF>(); f.c = c; f.rows = (long)H_A * S; go(f, f.count()); }
            NGemm p = mk_gemm(WSP(float, WS_SC), 0, S, WSP(bf16_t, WS_V) + (size_t)b * S * H_A * VD, 1, H_A * VD, 1, WSP(bf16_t, WS_MIX) + (size_t)b * S * D, 1, D, S, VD, S);
            p.a_z2 = (long)S * S; p.b_z2 = VD; p.c_z2 = VD; p.Z2 = H_A; go(p, p.count(H_A)); } } break;
    case PH_OUT0: case PH_OUT1: { NGemm g = mk_gemm(WSP(bf16_t, WS_MIX), 1, D, c.in[l ? I_WOUTCD : I_WOUTAB], 0, D, 1, WSP(float, WS_T), 0, D, M, D, D); go(g, g.count(1));
        OutPostF f = zf<OutPostF>(); f.c = c; f.Xin = l ? X2 : c.in[I_X]; f.Xout = X1; f.l = l; go(f, f.count()); } break;
    case PH_RT0: case PH_RT1: { float* modl = mod + (size_t)l * NB * 6 * D;
        rowss(go, c, X1, WSP(float, WS_RSTD), D, D);
        { ModulateF f = zf<ModulateF>(); f.c = c; f.X = X1; f.gain = c.in[I_NFFN] + l * D; f.sc = modl + 4 * D; f.sh = modl + 3 * D; go(f, f.count()); }
        { NGemm g = mk_gemm(WSP(bf16_t, WS_HM), 1, D, c.in[I_WROUTER] + (size_t)l * D * E, 0, E, 1, WSP(float, WS_T), 0, E, M, E, D); go(g, g.count(1)); }
        { RouteF f = zf<RouteF>(); f.c = c; f.l = l; go(f, f.count()); } } break;
    case PH_M1_0: case PH_M1_1: { Moe1F f = zf<Moe1F>(); f.c = c; f.l = l; go(f, f.count()); } break;
    case PH_M2_0: case PH_M2_1: { Moe2F f = zf<Moe2F>(); f.c = c; f.l = l; go(f, f.count()); } break;
    case PH_CMB0: { { CombineF f = zf<CombineF>(); f.c = c; f.Xin = X1; f.Xout = X2; f.l = 0; go(f, f.count()); }
        rowss(go, c, X2, WSP(float, WS_RSTD), D, D);
        ModulateF f = zf<ModulateF>(); f.c = c; f.X = X2; f.gain = c.in[I_NMIX] + D; f.sc = mod + (size_t)NB * 6 * D + D; f.sh = mod + (size_t)NB * 6 * D; go(f, f.count()); } break;
    case PH_CMB1: { { CombineF f = zf<CombineF>(); f.c = c; f.Xin = X1; f.Xout = X2; f.l = 1; go(f, f.count()); }
        rowss(go, c, X2, WSP(float, WS_RSTD), D, D);
        FinalF f = zf<FinalF>(); f.c = c; f.X = X2; go(f, f.count()); } break;
    case PH_G3: { { NGemm g = mk_gemm(WSP(bf16_t, WS_HM), 1, D, c.in[I_WINCD], 0, CD_N, 1, WSP(float, WS_T), 0, CD_N, M, CD_N, D); go(g, g.count(1)); }
        PostG3F f = zf<PostG3F>(); f.c = c; f.sqs = LOG2E / sqrtf((float)HDS); go(f, f.count()); } break;
    case PH_RET1: {
        for (int b = 0; b < NB; ++b) {
            const bf16_t* Pb = WSP(bf16_t, WS_PROJ) + (size_t)b * S * CD_N;
            NGemm g = mk_gemm(Pb, 1, CD_N, Pb + H_C * DK, 1, 1, CD_N, WSP(float, WS_SC), 0, S, S, S, DK);
            g.a_z2 = DK; g.b_z2 = DK; g.c_z2 = (long)S * S; g.Z2 = H_C; go(g, g.count(H_C));
            { DecayF f = zf<DecayF>(); f.c = c; go(f, f.count()); }
            NGemm p = mk_gemm(WSP(float, WS_SC), 0, S, Pb + 2 * H_C * DK, 1, CD_N, 1, WSP(float, WS_RET) + (size_t)b * S * HALF, 0, HALF, S, DK, S);
            p.a_z2 = (long)S * S; p.b_z2 = DK; p.c_z2 = DK; p.Z2 = H_C; go(p, p.count(H_C)); } } break;
    case PH_SWA1: {
        for (int b = 0; b < NB; ++b) {
            const bf16_t* Pb = WSP(bf16_t, WS_PROJ) + (size_t)b * S * CD_N + 4 * H_C * DK; const int G = H_D / KVH;
            NGemm g = mk_gemm(Pb, 1, CD_N, Pb + H_D * HDS, 1, 1, CD_N, WSP(float, WS_SC), 0, S, S, S, HDS);
            g.a_z1 = (long)G * HDS; g.a_z2 = HDS; g.b_z1 = HDS; g.b_z2 = 0; g.c_z1 = (long)G * S * S; g.c_z2 = (long)S * S; g.Z2 = G; go(g, g.count(H_D));
            { SwaSoftF f = zf<SwaSoftF>(); f.c = c; go(f, f.count()); }
            NGemm p = mk_gemm(WSP(float, WS_SC), 0, S, Pb + H_D * HDS + KVH * HDS, 1, CD_N, 1, WSP(bf16_t, WS_MIX) + (size_t)b * S * D + HALF, 1, D, S, HDS, S);
            p.a_z1 = (long)G * S * S; p.a_z2 = (long)S * S; p.b_z1 = HDS; p.b_z2 = 0; p.c_z1 = (long)G * HDS; p.c_z2 = HDS; p.Z2 = G; go(p, p.count(H_D)); } } break;
    case PH_RN1: { RetNormF f = zf<RetNormF>(); f.c = c; go(f, f.count()); } break;
    default: break;
    }
}
template <class L> static void naive_offt(const L& go, const Ctx& c, int l) { OffF f = zf<OffF>(); f.c = c; f.l = l; go(f, f.count()); }

#ifdef HOST_TEST
template <class L> static void run_all(const L& go, const Ctx& c) {
    for (int ph = 0; ph < N_PHASES; ++ph) { naive_phase(go, c, ph); if (ph == PH_RT0 || ph == PH_RT1) naive_offt(go, c, ph == PH_RT1); }
}
#endif
#ifndef HOST_TEST
#define LAS __attribute__((address_space(3)))
#define GAS __attribute__((address_space(1)))
typedef unsigned v4u __attribute__((ext_vector_type(4)));
typedef unsigned u32x2 __attribute__((ext_vector_type(2)));
typedef float f32x4 __attribute__((ext_vector_type(4)));
typedef float f32x16 __attribute__((ext_vector_type(16)));
typedef short bf16x8 __attribute__((ext_vector_type(8)));
typedef short s16x4 __attribute__((ext_vector_type(4)));
typedef int v8i_t __attribute__((ext_vector_type(8)));
typedef int v4i_t __attribute__((ext_vector_type(4)));
typedef GAS unsigned gu32;
#define RLX_AGENT __ATOMIC_RELAXED, __HIP_MEMORY_SCOPE_AGENT
#define LDS_WAIT() asm volatile("s_waitcnt lgkmcnt(0)" ::: "memory")
#define VM_WAIT() asm volatile("s_waitcnt vmcnt(0)" ::: "memory")
constexpr int NWAVES = 8, NTHR = 512;
constexpr int LDS_BYTES = 147456, MISC_OFF = LDS_BYTES - 2048, TAB_OFF = MISC_OFF + 1024;
__device__ __forceinline__ int lane_id() { int l; asm volatile("v_mbcnt_lo_u32_b32 %0, -1, 0\n\tv_mbcnt_hi_u32_b32 %0, -1, %0" : "=v"(l)); return l; }
__device__ __forceinline__ unsigned cvt_pk_bf16(float lo, float hi) { unsigned r; asm volatile("v_cvt_pk_bf16_f32 %0, %1, %2" : "=v"(r) : "v"(lo), "v"(hi)); return r; }
__device__ __forceinline__ float fast_sigm(float x) { return __builtin_amdgcn_rcpf(1.0f + __builtin_amdgcn_exp2f(-1.4426950408889634f * x)); }
__device__ __forceinline__ float fast_silu(float x) { return x * fast_sigm(x); }
__device__ __forceinline__ float fast_gelu_tanh(float x) { const float z = 0.7978845608028654f * (x + 0.044715f * x * x * x); return x * fast_sigm(2.0f * z); }
__device__ __forceinline__ float wave_sum(float v) {
#pragma unroll
    for (int o = 1; o < 64; o <<= 1) v += __shfl_xor(v, o);
    return v; }

#define XB_TMO      128
#define XB_XCNT(j)  (256  + 64 * (j))
#define XB_XSUB(j)  (1280 + 64 * (j))
#define XB_XGEN(j)  (2304 + 64 * (j))
#define XB_TOP      3328
#define XB_TOPGEN   3392
#define XCD_BAR_WORDS 3456
#define XB_SPIN_CAP (1u << 20)
__device__ __forceinline__ unsigned xb_ld(unsigned* p)              { return __hip_atomic_load(p, __ATOMIC_RELAXED, __HIP_MEMORY_SCOPE_AGENT); }
__device__ __forceinline__ unsigned xb_add(unsigned* p, unsigned v) { return __hip_atomic_fetch_add(p, v, __ATOMIC_RELAXED, __HIP_MEMORY_SCOPE_AGENT); }
__device__ __forceinline__ unsigned xb_xcc_id() { return (unsigned)__builtin_amdgcn_s_getreg((3 << 11) | 20) & 0xFu; }
#define XB_SPIN(cond, bar) do { unsigned _sp = 0; while (cond) { __builtin_amdgcn_s_sleep(1); \
    if ((++_sp & 255u) == 0u) { if (xb_ld(&(bar)[XB_TMO])) break; if (_sp > XB_SPIN_CAP) { atomicAdd(&(bar)[XB_TMO], 1u); break; } } } } while (0)
struct XcdBarrier { unsigned* bar; unsigned x; volatile LAS unsigned* st; int wave; };
__device__ __forceinline__ XcdBarrier xcd_barrier_post(unsigned* bar, volatile LAS unsigned* st, int wave) {
    XcdBarrier b; b.bar = bar; b.x = xb_xcc_id(); b.st = st; b.wave = wave;
    if (wave == 0 && lane_id() == 0) (void)xb_add(&bar[XB_XCNT(b.x)], 1u);
    return b; }
__device__ __forceinline__ void xcd_barrier_complete(unsigned* bar, unsigned x, unsigned& nloc, unsigned& nx) {
    const unsigned G = gridDim.x * gridDim.y * gridDim.z;
    unsigned sum, cnt, mine, sp = 0u;
    for (;;) {
        sum = 0u; cnt = 0u; mine = 0u;
#pragma unroll
        for (unsigned j = 0; j < 16; ++j) { const unsigned c = xb_ld(&bar[XB_XCNT(j)]); sum += c; cnt += (c > 0u) ? 1u : 0u; mine = (j == x) ? c : mine; }
        if (sum == G) break;
        __builtin_amdgcn_s_sleep(1);
        if ((++sp & 255u) == 0u) { if (xb_ld(&bar[XB_TMO])) break; if (sp > XB_SPIN_CAP) { atomicAdd(&bar[XB_TMO], 1u); break; } }
    }
    nloc = mine > 0u ? mine : 1u; nx = cnt > 0u ? cnt : 1u; }
__device__ __forceinline__ void xcd_barrier(const XcdBarrier& b) {
    asm volatile("s_waitcnt vmcnt(0)" ::: "memory");
    __syncthreads();
    if (b.wave == 0 && lane_id() == 0) {
        unsigned* bar = b.bar;
        __builtin_amdgcn_s_waitcnt(0);
        unsigned nloc = b.st[0], nx = b.st[1];
        if (nloc == 0u) { xcd_barrier_complete(bar, b.x, nloc, nx); b.st[0] = nloc; b.st[1] = nx; }
        const unsigned old = xb_add(&bar[XB_XSUB(b.x)], 1u);
        const unsigned gen = old / nloc;
        if (old + 1u == (gen + 1u) * nloc) {
            __builtin_amdgcn_fence(__ATOMIC_RELEASE, "agent");
            asm volatile("s_waitcnt vmcnt(0)" ::: "memory");
            const unsigned og = xb_add(&bar[XB_TOP], 1u);
            const unsigned tg = og / nx;
            if (og + 1u == (tg + 1u) * nx) xb_add(&bar[XB_TOPGEN], 1u);
            else XB_SPIN(xb_ld(&bar[XB_TOPGEN]) == tg, bar);
            __builtin_amdgcn_fence(__ATOMIC_ACQUIRE, "agent");
            xb_add(&bar[XB_XGEN(b.x)], 1u);
            asm volatile("s_waitcnt vmcnt(0)" ::: "memory");
        } else {
            XB_SPIN(xb_ld(&bar[XB_XGEN(b.x)]) == gen, bar);
            __builtin_amdgcn_fence(__ATOMIC_ACQUIRE, "agent");
            asm volatile("s_waitcnt vmcnt(0)" ::: "memory");
        }
    }
    __syncthreads();
}

namespace pg8 {
constexpr int BM = 256, BK = 64, HALFT = 128, HTB = HALFT * BK * 2, STAGE_BYTES = 8 * HTB, NXCD = 8, WGM = 8;
__host__ __device__ __forceinline__ int lds_byte(int r, int c) { const int st = (r >> 4) * 2 + (c >> 5), rr = r & 15, cc = c & 31, ob = rr * 64 + cc * 2; return st * 1024 + (ob ^ (((ob >> 9) & 1) << 5)); }
__host__ __device__ __forceinline__ void stage_rc(int b, int& R, int& C) { const int st = b / 1024, sb = b % 1024, swz = sb ^ (((sb >> 9) & 1) << 5); R = (st >> 1) * 16 + swz / 64; C = (st & 1) * 32 + (swz % 64) / 2; }
__host__ __device__ __forceinline__ int perm32(int rho) { const int n = rho >> 4, i = rho & 15; return 8 * (i >> 2) + 4 * n + (i & 3); }
struct Unit { const char* A; const char* B; int pm, pn, e, r0; };
__device__ __forceinline__ void tile_of(int L, int nM, int nN, int& pm, int& pn) {
    const int nwg = nM * nN; int wgid = L; { const int q = nwg / NXCD, r = nwg % NXCD, xcd = wgid % NXCD, off = wgid / NXCD; wgid = (xcd < r ? xcd * (q + 1) : r * (q + 1) + (xcd - r) * q) + off; }
    const int nig = WGM * nN, gid = wgid / nig, fm = gid * WGM, gsz = (nM - fm) < WGM ? (nM - fm) : WGM;
    pm = fm + ((wgid % nig) % gsz); pn = (wgid % nig) / gsz; }
template <class E_, class = void> struct perm16_t { static constexpr bool value = false; };
template <class E_> struct perm16_t<E_, decltype((void)E_::PERM16)> { static constexpr bool value = E_::PERM16; };
template <class E_> constexpr bool perm16_v = perm16_t<E_>::value;
struct APlain { static __device__ __forceinline__ const char* kt(const char* base, int t, int) { return base + (size_t)t * (BK * 2); } };
struct AConv { static __device__ __forceinline__ const char* kt(const char* base, int t, int lda) { return base + (long)((t >> 1) - 2) * (lda * 2) + (t & 1) * (BK * 2); } };

template <class Epi, class Sched, class AP, bool GATHER, bool ALIGN_EPI, int EB = 2>
__device__ __forceinline__ void gemm_phase(LAS unsigned char* lds, const int wave, const char* base, const int lda, const int ldb, const int K, const Sched& S, const Epi& E) {
    const __amdgpu_buffer_rsrc_t rsrc = __builtin_amdgcn_make_buffer_rsrc((void*)base, (short)0, -1, 0x00020000);
    const int wid = __builtin_amdgcn_readfirstlane(wave), lane = lane_id(), tid = wid * 64 + lane, wr = wid >> 2, wc = wid & 3, fr = lane & 15, fq = lane >> 4;
    const int nt = K / BK;
    unsigned vA[2][2], vAn[2][2], vB[2], vB1[2];
#pragma unroll
    for (int i = 0; i < 2; ++i) { int R, C; stage_rc(tid * 16 + i * 8192, R, C); const int Rb = Epi::PERM ? ((R & ~31) + perm32(R & 31)) : R;
        if constexpr (perm16_v<Epi>) { const int wcR = R >> 5, rho = R & 31, n_ = rho >> 4, i_ = rho & 15; const int src0 = 64 * wcR + 16 * (i_ >> 2) + 4 * n_ + (i_ & 3);
            vB[i] = (unsigned)(src0 * ldb + C) * 2u; vB1[i] = (unsigned)((src0 + 8) * ldb + C) * 2u; }
        else { vB[i] = (unsigned)(Rb * ldb + C) * 2u; vB1[i] = 0u; }
#pragma unroll
        for (int h = 0; h < 2; ++h) { vA[h][i] = GATHER ? (unsigned)C * 2u : (h == 0 ? (unsigned)(R * lda + C) * 2u : 0u); vAn[h][i] = vA[h][i]; } }
    const size_t kstep = (size_t)(BK * 2), hstepB = (size_t)HALFT * ldb * 2, hB1 = perm16_v<Epi> ? 0 : hstepB;
    const unsigned (&vBs)[2] = perm16_v<Epi> ? vB1 : vB;
    const unsigned (&vA1)[2] = GATHER ? vA[1] : vA[0]; const size_t hA1 = GATHER ? 0 : (size_t)HALFT * lda * 2;
    const unsigned ldsw = (unsigned)wid * 1024u;
    const int aoff = lds_byte(wr * 64 + fr, fq * 8), boff = lds_byte(wc * 32 + fr, fq * 8);
#define PG8_SA(b, h) (((b) * 2 + (h)) * HTB)
#define PG8_SB(b, h) ((4 + (b) * 2 + (h)) * HTB)
#define PG8_STAGE(bufoff, gbase, voff) do { const int so_ = (int)(unsigned)(size_t)((const char*)(gbase) - base); _Pragma("unroll") for (int _i = 0; _i < 2; ++_i) \
        __builtin_amdgcn_raw_ptr_buffer_load_lds(rsrc, (LAS void*)(lds + (bufoff) + ldsw + _i * 8192), 16, (int)(voff)[_i], so_, 0, 0); } while (0)
#define PG8_LDA(dst, b, h) do { _Pragma("unroll") for (int m = 0; m < 4; ++m) { if constexpr (EB == 2) { _Pragma("unroll") for (int k = 0; k < 2; ++k) dst[m][k] = *(const LAS bf16x8*)(lds + PG8_SA(b, h) + aoff + m * 2048 + k * 1024); } \
        else { const v4i_t lo_ = *(const LAS v4i_t*)(lds + PG8_SA(b, h) + aoff + m * 2048), hi_ = *(const LAS v4i_t*)(lds + PG8_SA(b, h) + aoff + m * 2048 + 1024); dst##8[m] = __builtin_shufflevector(lo_, hi_, 0, 1, 2, 3, 4, 5, 6, 7); } } } while (0)
#define PG8_LDB(dst, b, h) do { _Pragma("unroll") for (int n = 0; n < 2; ++n) { if constexpr (EB == 2) { _Pragma("unroll") for (int k = 0; k < 2; ++k) dst[n][k] = *(const LAS bf16x8*)(lds + PG8_SB(b, h) + boff + n * 2048 + k * 1024); } \
        else { const v4i_t lo_ = *(const LAS v4i_t*)(lds + PG8_SB(b, h) + boff + n * 2048), hi_ = *(const LAS v4i_t*)(lds + PG8_SB(b, h) + boff + n * 2048 + 1024); dst##8[n] = __builtin_shufflevector(lo_, hi_, 0, 1, 2, 3, 4, 5, 6, 7); } } } while (0)
#define PG8_MMA(ai, bj, At, Bt) do { __builtin_amdgcn_s_setprio(1); _Pragma("unroll") for (int m = 0; m < 4; ++m) _Pragma("unroll") for (int n = 0; n < 2; ++n) { \
        if constexpr (EB == 2) { _Pragma("unroll") for (int k = 0; k < 2; ++k) acc[ai][bj][m][n] = __builtin_amdgcn_mfma_f32_16x16x32_bf16(Bt[n][k], At[m][k], acc[ai][bj][m][n], 0, 0, 0); } \
        else acc[ai][bj][m][n] = __builtin_amdgcn_mfma_scale_f32_16x16x128_f8f6f4(Bt##8[n], At##8[m], acc[ai][bj][m][n], 0, 0, 0, 0x7F7F7F7F, 0, 0x7F7F7F7F); } \
        __builtin_amdgcn_s_setprio(0); } while (0)
#define PG8_WAIT_V(n) asm volatile("s_waitcnt vmcnt(" #n ")" ::: "memory")
#define PG8_WAIT_L(n) asm volatile("s_waitcnt lgkmcnt(" #n ")" ::: "memory")
#define PG8_BAR __builtin_amdgcn_s_barrier()
#define PG8_SCHED __builtin_amdgcn_sched_barrier(0)
    Unit cur, nxt; int ui = 0;
    if (!S.next(0, cur)) return;
    f32x4 acc[2][2][4][2];
#pragma unroll
    for (int a = 0; a < 2; ++a)
#pragma unroll
        for (int b = 0; b < 2; ++b)
#pragma unroll
            for (int m = 0; m < 4; ++m)
#pragma unroll
                for (int n = 0; n < 2; ++n) acc[a][b][m][n] = (f32x4){0.f, 0.f, 0.f, 0.f};
    bf16x8 At[4][2], B0[2][2], B1[2][2]; v8i_t At8[4], B08[2], B18[2];
    if constexpr (GATHER) {
#pragma unroll
        for (int h = 0; h < 2; ++h)
#pragma unroll
            for (int i = 0; i < 2; ++i) { int R_, C_; stage_rc(tid * 16 + i * 8192, R_, C_); vA[h][i] = (unsigned)S.row(cur, h * HALFT + R_) * (unsigned)(lda * 2) + (unsigned)C_ * 2u; vAn[h][i] = vA[h][i]; }
        PG8_WAIT_V(0);
    }
    const char* cA = cur.A; const char* cB = cur.B;
    PG8_STAGE(PG8_SB(0, 0), cB, vB); PG8_STAGE(PG8_SB(0, 1), cB + hB1, vBs); PG8_STAGE(PG8_SA(0, 0), AP::kt(cA, 0, lda), vA[0]); PG8_STAGE(PG8_SA(0, 1), AP::kt(cA, 0, lda) + hA1, vA1);
    if (wr == 1) PG8_BAR;
    PG8_WAIT_V(2); PG8_BAR;
    PG8_STAGE(PG8_SB(1, 0), cB + kstep, vB); PG8_STAGE(PG8_SA(1, 0), AP::kt(cA, 1, lda), vA[0]); PG8_STAGE(PG8_SB(1, 1), cB + hB1 + kstep, vBs);
    PG8_WAIT_V(6); PG8_BAR;
    for (;;) {
        const bool has_next = S.next(ui + 1, nxt);
        const char* nA = has_next ? nxt.A : cA; const char* nB = has_next ? nxt.B : cB;
        if constexpr (GATHER) {
            if (has_next) {
#pragma unroll
                for (int h = 0; h < 2; ++h)
#pragma unroll
                    for (int i = 0; i < 2; ++i) { int R_, C_; stage_rc(tid * 16 + i * 8192, R_, C_); vAn[h][i] = (unsigned)S.row(nxt, h * HALFT + R_) * (unsigned)(lda * 2) + (unsigned)C_ * 2u; }
                PG8_WAIT_V(0);
            }
        }
#pragma unroll 1
        for (int t = 0; t < nt; t += 2) {
            const bool last = (t == nt - 2);
            const char* a1 = AP::kt(cA, t + 1, lda);
            const char* a2 = last ? AP::kt(nA, 0, lda) : AP::kt(cA, t + 2, lda); const char* a3 = last ? AP::kt(nA, 1, lda) : AP::kt(cA, t + 3, lda);
            const char* b2 = last ? nB : cB + (size_t)(t + 2) * kstep; const char* b3 = b2 + kstep;
            PG8_LDB(B0, 0, 0); PG8_LDB(B1, 0, 1); PG8_SCHED; PG8_LDA(At, 0, 0); PG8_STAGE(PG8_SA(1, 1), a1 + hA1, vA1);
            if constexpr (GATHER) { if (last) { _Pragma("unroll") for (int h = 0; h < 2; ++h) _Pragma("unroll") for (int i = 0; i < 2; ++i) vA[h][i] = vAn[h][i]; } }
            PG8_WAIT_V(8); PG8_WAIT_L(0); PG8_BAR; PG8_MMA(0, 0, At, B0); PG8_MMA(0, 1, At, B1); PG8_BAR; PG8_SCHED;
            PG8_LDA(At, 0, 1); PG8_STAGE(PG8_SB(0, 0), b2, vB); PG8_STAGE(PG8_SB(0, 1), b2 + hB1, vBs); PG8_STAGE(PG8_SA(0, 0), a2, vA[0]);
            PG8_WAIT_V(8); PG8_WAIT_L(0); PG8_BAR; PG8_MMA(1, 0, At, B0); PG8_MMA(1, 1, At, B1); PG8_BAR; PG8_SCHED;
            PG8_LDB(B0, 1, 0); PG8_LDB(B1, 1, 1); PG8_SCHED; PG8_LDA(At, 1, 0); PG8_STAGE(PG8_SA(0, 1), a2 + hA1, vA1);
            PG8_WAIT_V(8); PG8_WAIT_L(0); PG8_BAR; PG8_MMA(0, 0, At, B0); PG8_MMA(0, 1, At, B1); PG8_BAR; PG8_SCHED;
            PG8_LDA(At, 1, 1); PG8_STAGE(PG8_SB(1, 0), b3, vB); PG8_STAGE(PG8_SB(1, 1), b3 + hB1, vBs); PG8_STAGE(PG8_SA(1, 0), a3, vA[0]);
            PG8_WAIT_V(8); PG8_WAIT_L(0); PG8_BAR; PG8_MMA(1, 0, At, B0); PG8_MMA(1, 1, At, B1); PG8_BAR; PG8_SCHED;
        }
        if constexpr (ALIGN_EPI) { if (wr == 0) PG8_BAR; }
        { const int l2_ = lane_id();
          E(acc, cur, wr, wc, l2_ & 15, l2_ >> 4);
#ifdef PROBE_EPI2
          if (Epi::PROBE2) { asm volatile("s_waitcnt vmcnt(0)" ::: "memory"); E(acc, cur, wr, wc, l2_ & 15, l2_ >> 4); }
#endif
          }
        if (!has_next) break;
#pragma unroll
        for (int a = 0; a < 2; ++a)
#pragma unroll
            for (int b = 0; b < 2; ++b)
#pragma unroll
                for (int m = 0; m < 4; ++m)
#pragma unroll
                    for (int n = 0; n < 2; ++n) acc[a][b][m][n] = (f32x4){0.f, 0.f, 0.f, 0.f};
        cur = nxt; cA = nA; cB = nB; ++ui;
        if constexpr (GATHER) {
#pragma unroll
            for (int h = 0; h < 2; ++h)
#pragma unroll
                for (int i = 0; i < 2; ++i) vA[h][i] = vAn[h][i];
        }
        if constexpr (ALIGN_EPI) { if (wr == 1) PG8_BAR; }
    }
    PG8_WAIT_V(0);
    if constexpr (!ALIGN_EPI) { if (wr == 0) PG8_BAR; }
    PG8_BAR;
#undef PG8_SA
#undef PG8_SB
#undef PG8_STAGE
#undef PG8_LDA
#undef PG8_LDB
#undef PG8_MMA
#undef PG8_WAIT_V
#undef PG8_WAIT_L
#undef PG8_BAR
#undef PG8_SCHED
}

struct DenseOrder {
    const char* A; const char* B; int nM, nN, G, c; long a_tile, b_tile;
    __device__ __forceinline__ bool next(int i, Unit& u) const { const long L = (long)i * G + c; if (L >= (long)nM * nN) return false; int pm, pn; tile_of((int)L, nM, nN, pm, pn);
        u.pm = pm; u.pn = pn; u.e = 0; u.r0 = pm * BM; u.A = A + (size_t)pm * a_tile; u.B = B + (size_t)pn * b_tile; return true; }
    __device__ __forceinline__ int row(const Unit&, int) const { return 0; }
};
}
namespace pg8 {
typedef const f32x4 (&AccRef)[2][2][4][2];
__device__ __forceinline__ const LAS int* lds_tab() { unsigned a; asm volatile("v_mov_b32 %0, %1" : "=v"(a) : "i"(TAB_OFF)); return (const LAS int*)(size_t)a; }
__device__ __forceinline__ v4u pack8(const f32x4 a, const f32x4 b) { v4u w; w.x = cvt_pk_bf16(a[0], a[1]); w.y = cvt_pk_bf16(a[2], a[3]); w.z = cvt_pk_bf16(b[0], b[1]); w.w = cvt_pk_bf16(b[2], b[3]); return w; }

struct EpiOut {
    static constexpr bool PERM = false; static constexpr bool PROBE2 = false;
    const float* Xin; float* Xout; const float* g;
    __device__ __forceinline__ void operator()(AccRef acc, const Unit& u, int wr, int wc, int fr, int fq) const {
        const int b = u.r0 / S; const int col0 = u.pn * BM + wc * 32 + 4 * fq; f32x4 gv[2][2];
#pragma unroll
        for (int bj = 0; bj < 2; ++bj)
#pragma unroll
            for (int n = 0; n < 2; ++n) gv[bj][n] = *(const f32x4*)(g + (size_t)b * 6 * D + col0 + bj * HALFT + n * 16);
#pragma unroll
        for (int ai = 0; ai < 2; ++ai) { f32x4 xi[4][2][2];
#pragma unroll
            for (int m = 0; m < 4; ++m) { const size_t off = (size_t)(u.r0 + ai * HALFT + wr * 64 + m * 16 + fr) * D + col0;
#pragma unroll
                for (int bj = 0; bj < 2; ++bj)
#pragma unroll
                    for (int n = 0; n < 2; ++n) xi[m][bj][n] = __builtin_nontemporal_load((const f32x4*)(Xin + off + bj * HALFT + n * 16)); }
#pragma unroll
            for (int m = 0; m < 4; ++m) { const size_t off = (size_t)(u.r0 + ai * HALFT + wr * 64 + m * 16 + fr) * D + col0;
#pragma unroll
                for (int bj = 0; bj < 2; ++bj)
#pragma unroll
                    for (int n = 0; n < 2; ++n) *(f32x4*)(Xout + off + bj * HALFT + n * 16) = xi[m][bj][n] + gv[bj][n] * acc[ai][bj][m][n]; }
            asm volatile("" ::: "memory"); }
    }
};
struct EpiG1 {
    static constexpr bool PERM = true; static constexpr bool PROBE2 = false;
    bf16_t* proj; bf16_t* lxp; float* ssq;
    __device__ __forceinline__ void operator()(AccRef acc, const Unit& u, int wr, int wc, int fr, int fq) const {
        const int pn = u.pn; const int c0 = pn * BM + wc * 32 + 8 * fq; const int NT_LAT = (QR + KVR) / BM, NT_X = LW / BM;
#pragma unroll
        for (int ai = 0; ai < 2; ++ai)
#pragma unroll
            for (int m = 0; m < 4; ++m) { const int row = u.r0 + ai * HALFT + wr * 64 + m * 16 + fr; float ss = 0.f;
#pragma unroll
                for (int bj = 0; bj < 2; ++bj) { f32x4 v0 = acc[ai][bj][m][0], v1 = acc[ai][bj][m][1];
                    if (pn < NT_LAT) { ss += (v0[0] * v0[0] + v0[1] * v0[1]) + (v0[2] * v0[2] + v0[3] * v0[3]) + (v1[0] * v1[0] + v1[1] * v1[1]) + (v1[2] * v1[2] + v1[3] * v1[3]); }
                    if (pn >= NT_LAT + NT_X) {
#pragma unroll
                        for (int j = 0; j < 4; ++j) { v0[j] = fast_gelu_tanh(v0[j]); v1[j] = fast_gelu_tanh(v1[j]); } }
                    const v4u w = pack8(v0, v1);
                    *(v4u*)(proj + (size_t)row * P0_N + c0 + bj * HALFT) = w;
                    if (pn >= NT_LAT && pn < NT_LAT + NT_X) { const int b = row / S, t = row % S; *(v4u*)(lxp + ((size_t)b * (S + 4) + 2 + t) * LW + (c0 + bj * HALFT - (QR + KVR))) = w; } }
                if (pn < NT_LAT) { ss += __shfl_xor(ss, 16); ss += __shfl_xor(ss, 32); if (fq == 0) ssq[(size_t)row * 16 + pn * 4 + wc] = ss; } }
    }
};
struct EpiG2 {
    static constexpr bool PERM = true; static constexpr bool PROBE2 = false;
    bf16_t* Q; bf16_t* KC; bf16_t* V; const float* ssq; const float* cosr; const float* sinr; float qs;
    __device__ __forceinline__ void operator()(AccRef acc, const Unit& u, int wr, int wc, int fr, int fq) const {
        const int pn = u.pn; const int NQ_N = H_A * NOPE / BM, NQ = H_A * QK / BM;
#pragma unroll
        for (int ai = 0; ai < 2; ++ai)
#pragma unroll
            for (int m = 0; m < 4; ++m) { const int row = u.r0 + ai * HALFT + wr * 64 + m * 16 + fr;
                if (pn < NQ_N) { const float rs = 1.0f / sqrtf(ssq8(ssq + (size_t)row * 16) * (1.0f / QR) + EPS) * qs;
#pragma unroll
                    for (int bj = 0; bj < 2; ++bj) { const int h = 2 * pn + bj; *(v4u*)(Q + ((size_t)row * H_A + h) * QK + wc * 32 + 8 * fq) = pack8(acc[ai][bj][m][0] * rs, acc[ai][bj][m][1] * rs); } }
                else if (pn < NQ) { const float rs = 1.0f / sqrtf(ssq8(ssq + (size_t)row * 16) * (1.0f / QR) + EPS) * qs; const int h = 4 * (pn - NQ_N) + wc, t = row % S;
                    const f32x4 c0 = *(const f32x4*)(cosr + t * (ROPE / 2) + 8 * fq), c1 = *(const f32x4*)(cosr + t * (ROPE / 2) + 8 * fq + 4), s0 = *(const f32x4*)(sinr + t * (ROPE / 2) + 8 * fq), s1 = *(const f32x4*)(sinr + t * (ROPE / 2) + 8 * fq + 4);
                    const f32x4 x10 = acc[ai][0][m][0] * rs, x11 = acc[ai][0][m][1] * rs, x20 = acc[ai][1][m][0] * rs, x21 = acc[ai][1][m][1] * rs;
                    bf16_t* q = Q + ((size_t)row * H_A + h) * QK + NOPE + 8 * fq;
                    *(v4u*)q = pack8(x10 * c0 - x20 * s0, x11 * c1 - x21 * s1); *(v4u*)(q + ROPE / 2) = pack8(x20 * c0 + x10 * s0, x21 * c1 + x11 * s1); }
                else { const float rs = 1.0f / sqrtf(ssq8(ssq + (size_t)row * 16 + 8) * (1.0f / KVR) + EPS); const int h = pn - NQ;
                    *(v4u*)(KC + ((size_t)row * H_A + h) * QK + wc * 32 + 8 * fq) = pack8(acc[ai][0][m][0] * rs, acc[ai][0][m][1] * rs);
                    *(v4u*)(V + ((size_t)row * H_A + h) * VD + wc * 32 + 8 * fq) = pack8(acc[ai][1][m][0] * rs, acc[ai][1][m][1] * rs); } }
    }
};
struct OrderG2 {
    const char* A; const char* Bq; const char* Bkv; int G, c;
    __device__ __forceinline__ bool next(int i, Unit& u) const { const int nN = (H_A * QK + H_A * (NOPE + VD)) / BM, nM = M / BM; const long L = (long)i * G + c; if (L >= (long)nM * nN) return false; int pm, pn; tile_of((int)L, nM, nN, pm, pn);
        const int NQ = H_A * QK / BM; u.pm = pm; u.pn = pn; u.e = 0; u.r0 = pm * BM; u.A = A + (size_t)pm * BM * P0_N * 2 + (pn < NQ ? 0 : QR * 2);
        u.B = pn < NQ ? Bq + (size_t)pn * BM * QR * 2 : Bkv + (size_t)(pn - NQ) * BM * KVR * 2; return true; }
    __device__ __forceinline__ int row(const Unit&, int) const { return 0; }
};
struct EpiGates {
    static constexpr bool PERM = true; static constexpr bool PROBE2 = false;
    bf16_t* LA; bf16_t* U; const bf16_t* lxp; const float* gb; const float* cl; const float* convw; const float* convb;
    __device__ __forceinline__ void operator()(AccRef acc, const Unit& u, int wr, int wc, int fr, int fq) const {
        const int g = u.pn >> 1, d = u.pn & 1; const int ch0 = g * LBS + wc * 32 + 8 * fq; const int b = u.r0 / S;
        f32x4 ba[2], bx[2], clv[2], cb[2], cw[4][2];
#pragma unroll
        for (int n = 0; n < 2; ++n) { const int ch = ch0 + 4 * n; ba[n] = *(const f32x4*)(gb + (d * 2 + 0) * LW + ch); bx[n] = *(const f32x4*)(gb + (d * 2 + 1) * LW + ch); clv[n] = *(const f32x4*)(cl + d * LW + ch); cb[n] = *(const f32x4*)(convb + ch);
#pragma unroll
            for (int j = 0; j < 4; ++j) cw[j][n] = *(const f32x4*)(convw + j * LW + ch); }
#pragma unroll
        for (int ai = 0; ai < 2; ++ai)
#pragma unroll
            for (int m = 0; m < 4; ++m) { const int row = u.r0 + ai * HALFT + wr * 64 + m * 16 + fr; const int t = row % S; f32x4 la[2], uu[2], xc[2] = {cb[0], cb[1]};
                v4u raw[4];
#pragma unroll
                for (int j = 0; j < 4; ++j) raw[j] = *(const v4u*)(lxp + ((size_t)b * (S + 4) + t + j) * LW + ch0);
#pragma unroll
                for (int j = 0; j < 4; ++j)
#pragma unroll
                    for (int n = 0; n < 2; ++n) { const unsigned r0_ = raw[j][2 * n], r1_ = raw[j][2 * n + 1];
                        xc[n][0] += cw[j][n][0] * __uint_as_float(r0_ << 16); xc[n][1] += cw[j][n][1] * __uint_as_float(r0_ & 0xffff0000u); xc[n][2] += cw[j][n][2] * __uint_as_float(r1_ << 16); xc[n][3] += cw[j][n][3] * __uint_as_float(r1_ & 0xffff0000u); }
#pragma unroll
                for (int n = 0; n < 2; ++n)
#pragma unroll
                    for (int j = 0; j < 4; ++j) { const float l = clv[n][j] * fast_sigm(acc[ai][0][m][n][j] + ba[n][j]); const float x2 = 2.0f * l;
                        const float em = -x2 * (1.0f + 0.5f * x2 * (1.0f + (1.0f / 3.0f) * x2 * (1.0f + 0.25f * x2 * (1.0f + 0.2f * x2))));
                        la[n][j] = l; uu[n][j] = sqrtf(em) * fast_sigm(acc[ai][1][m][n][j] + bx[n][j]) * xc[n][j]; }
                const long o = lru_idx(d, b, t, ch0); *(v4u*)(LA + o) = pack8(la[0], la[1]); *(v4u*)(U + o) = pack8(uu[0], uu[1]); }
    }
};
struct OrderGates {
    const char* lxp; const char* B; int G, c;
    __device__ __forceinline__ bool next(int i, Unit& u) const { const int nN = 2 * (LW / LBS), nM = M / BM; const long L = (long)i * G + c; if (L >= (long)nM * nN) return false; int pm, pn; tile_of((int)L, nM, nN, pm, pn);
        u.pm = pm; u.pn = pn; u.e = 0; u.r0 = pm * BM; const int b = u.r0 / S, t0 = u.r0 % S, g = pn >> 1;
        u.A = lxp + (((size_t)b * (S + 4) + 2 + t0) * LW + g * LBS) * 2; u.B = B + (size_t)pn * BM * (4 * LBS) * 2; return true; }
    __device__ __forceinline__ int row(const Unit&, int) const { return 0; }
};
struct EpiG3 {
    static constexpr bool PERM = true; static constexpr bool PROBE2 = false;
    bf16_t* proj; const float* cost; const float* sint; float sqs;
    __device__ __forceinline__ void operator()(AccRef acc, const Unit& u, int wr, int wc, int fr, int fq) const {
        const int pn = u.pn; const int NH = H_C * DK / BM;
#pragma unroll
        for (int ai = 0; ai < 2; ++ai)
#pragma unroll
            for (int m = 0; m < 4; ++m) { const int row = u.r0 + ai * HALFT + wr * 64 + m * 16 + fr; bf16_t* p = proj + (size_t)row * CD_N + pn * BM + wc * 32 + 8 * fq;
                if (pn < 2 * NH) { const int t = row % S, i0 = wc * 32 + 8 * fq; const float sc = pn < NH ? 1.0f : 1.0f / sqrtf((float)DK);
                    const f32x4 c0 = *(const f32x4*)(cost + t * (DK / 2) + i0) * sc, c1 = *(const f32x4*)(cost + t * (DK / 2) + i0 + 4) * sc, s0 = *(const f32x4*)(sint + t * (DK / 2) + i0) * sc, s1 = *(const f32x4*)(sint + t * (DK / 2) + i0 + 4) * sc;
                    const f32x4 x10 = acc[ai][0][m][0], x11 = acc[ai][0][m][1], x20 = acc[ai][1][m][0], x21 = acc[ai][1][m][1];
                    *(v4u*)p = pack8(x10 * c0 - x20 * s0, x11 * c1 - x21 * s1); *(v4u*)(p + HALFT) = pack8(x20 * c0 + x10 * s0, x21 * c1 + x11 * s1); }
                else {
#pragma unroll
                    for (int bj = 0; bj < 2; ++bj) { f32x4 v0 = acc[ai][bj][m][0], v1 = acc[ai][bj][m][1];
                        if (pn >= 3 * NH && pn < 4 * NH) {
#pragma unroll
                            for (int j = 0; j < 4; ++j) { v0[j] = fast_silu(v0[j]); v1[j] = fast_silu(v1[j]); } }
                        else if (pn >= 4 * NH && pn < 4 * NH + H_D * HDS / BM) { v0 = v0 * sqs; v1 = v1 * sqs; }
                        *(v4u*)(p + bj * HALFT) = pack8(v0, v1); } } }
    }
};
struct OrderMoe {
    const LAS int* offt; const char* A; const char* B; const int* tok; int npn, G, c, gather; long b_exp, b_tile, a_tile;
    __device__ __forceinline__ bool next(int i, Unit& u) const { const long L = (long)i * G + c; const int T = (int)(L / npn); if (T >= offt[E + 1]) return false; const int e = ((const LAS unsigned char*)(offt + 2 * E + 4))[T];
        u.e = e; u.pn = (int)(L % npn); u.pm = T - offt[e]; u.r0 = T * BM; u.A = gather ? A : A + (size_t)T * a_tile; u.B = B + (size_t)e * b_exp + (size_t)u.pn * b_tile; return true; }
    __device__ __forceinline__ int row(const Unit& u, int r) const { const int rank = u.pm * BM + r; if (u.e == E) return rank; const int n = offt[E + 2 + u.e]; return rank < n ? tok[(size_t)u.e * M + rank] : 0; }
};
__device__ __forceinline__ float sat_fp8(float v) { return __builtin_amdgcn_fmed3f(v, -448.0f, 448.0f); }
__device__ __forceinline__ unsigned pack_fp8x4(float a, float b, float c, float d) { int w = __builtin_amdgcn_cvt_pk_fp8_f32(sat_fp8(a), sat_fp8(b), 0, false); return (unsigned)__builtin_amdgcn_cvt_pk_fp8_f32(sat_fp8(c), sat_fp8(d), w, true); }
constexpr float F8_H = 4.0f, F8_GU = 32.0f, F8_ACT = 8.0f, F8_DN = 16.0f, F8_Y = 16.0f;
struct EpiM1F8 {
    static constexpr bool PERM = true; static constexpr bool PROBE2 = false;
    unsigned char* ws;
    __device__ __forceinline__ void operator()(AccRef acc, const Unit& u, int wr, int wc, int fr, int fq) const {
        constexpr float inv = 1.0f / (F8_H * F8_GU); unsigned char* act = ws + WS_ACT;
#pragma unroll
        for (int ai = 0; ai < 2; ++ai)
#pragma unroll
            for (int m = 0; m < 4; ++m) { const int row = u.r0 + ai * HALFT + wr * 64 + m * 16 + fr; f32x4 v[2];
#pragma unroll
                for (int n = 0; n < 2; ++n)
#pragma unroll
                    for (int j = 0; j < 4; ++j) v[n][j] = fast_silu(acc[ai][0][m][n][j] * inv) * (acc[ai][1][m][n][j] * (inv * F8_ACT));
                u32x2 w; w.x = pack_fp8x4(v[0][0], v[0][1], v[0][2], v[0][3]); w.y = pack_fp8x4(v[1][0], v[1][1], v[1][2], v[1][3]);
                *(u32x2*)(act + (size_t)row * FF + u.pn * HALFT + wc * 32 + 8 * fq) = w; }
    }
};
template <int NPN, bool GATH, size_t A_OFF, size_t B_OFF, long B_EXP, long B_TILE, long A_TILE>
struct OrderMoeT {
    const unsigned char* ws; int G, c;
    __device__ __forceinline__ bool next(int i, Unit& u) const { const LAS int* offt = lds_tab();
#ifdef MOE_CONTIG
        if (i >= c) return false; const int L = G + i; const int T = L / NPN;
#else
        const long L = (long)i * G + c; const int T = (int)(L / NPN); if (T >= __builtin_amdgcn_readfirstlane(offt[E + 1])) return false;
#endif
        const int e = __builtin_amdgcn_readfirstlane((int)((const LAS unsigned char*)(offt + 2 * E + 4))[T]);
        u.e = e; u.pn = (int)(L % NPN); u.pm = T - __builtin_amdgcn_readfirstlane(offt[e]); u.r0 = T * BM; u.A = (const char*)ws + A_OFF + (GATH ? 0 : (size_t)T * A_TILE); u.B = (const char*)ws + B_OFF + (size_t)e * B_EXP + (size_t)u.pn * B_TILE; return true; }
    __device__ __forceinline__ int row(const Unit& u, int r) const { const int rank = u.pm * BM + r; if (u.e == E) return rank; const int n = lds_tab()[E + 2 + u.e]; return rank < n ? ((const int*)(ws + WS_TOK))[(size_t)u.e * M + rank] : 0; }
};
struct EpiM2F8 {
    static constexpr bool PERM = true; static constexpr bool PERM16 = true; static constexpr bool PROBE2 = false;
    unsigned char* ws;
    __device__ __forceinline__ void operator()(AccRef acc, const Unit& u, int wr, int wc, int fr, int fq) const {
        constexpr float w = F8_Y / (F8_ACT * F8_DN); unsigned char* Y = ws + WS_Y;
#pragma unroll
        for (int ai = 0; ai < 2; ++ai)
#pragma unroll
            for (int m = 0; m < 4; ++m) { const int rr = ai * HALFT + wr * 64 + m * 16 + fr; v4u o;
#pragma unroll
                for (int bj = 0; bj < 2; ++bj) { const f32x4 a = acc[ai][bj][m][0] * w, b = acc[ai][bj][m][1] * w; o[2 * bj] = pack_fp8x4(a[0], a[1], a[2], a[3]); o[2 * bj + 1] = pack_fp8x4(b[0], b[1], b[2], b[3]); }
                *(v4u*)(Y + (size_t)(u.r0 + rr) * D + u.pn * BM + wc * 64 + 16 * fq) = o; }
    }
};
struct EpiM1 {
    static constexpr bool PERM = true; static constexpr bool PROBE2 = false;
    bf16_t* act;
    __device__ __forceinline__ void operator()(AccRef acc, const Unit& u, int wr, int wc, int fr, int fq) const {
#pragma unroll
        for (int ai = 0; ai < 2; ++ai)
#pragma unroll
            for (int m = 0; m < 4; ++m) { const int row = u.r0 + ai * HALFT + wr * 64 + m * 16 + fr; f32x4 v[2];
#pragma unroll
                for (int n = 0; n < 2; ++n)
#pragma unroll
                    for (int j = 0; j < 4; ++j) v[n][j] = fast_silu(acc[ai][0][m][n][j]) * acc[ai][1][m][n][j];
                *(v4u*)(act + (size_t)row * FF + u.pn * HALFT + wc * 32 + 8 * fq) = pack8(v[0], v[1]); }
    }
};
struct EpiM2 {
    static constexpr bool PERM = true; static constexpr bool PROBE2 = false;
    bf16_t* Y; const float* wt; const LAS int* offt; float osc;
    __device__ __forceinline__ void operator()(AccRef acc, const Unit& u, int wr, int wc, int fr, int fq) const {
        float w8[2][4]; const int nrow = u.e < E ? offt[E + 2 + u.e] : M;
#pragma unroll
        for (int ai = 0; ai < 2; ++ai)
#pragma unroll
            for (int m = 0; m < 4; ++m) { const int rank = u.pm * BM + ai * HALFT + wr * 64 + m * 16 + fr; w8[ai][m] = (u.e < E ? (rank < nrow ? wt[(size_t)u.e * M + rank] : 0.f) : 1.0f) * osc; }
#pragma unroll
        for (int ai = 0; ai < 2; ++ai)
#pragma unroll
            for (int m = 0; m < 4; ++m) { const int rr = ai * HALFT + wr * 64 + m * 16 + fr; const float w = w8[ai][m];
#pragma unroll
                for (int bj = 0; bj < 2; ++bj) *(v4u*)(Y + (size_t)(u.r0 + rr) * D + u.pn * BM + bj * HALFT + wc * 32 + 8 * fq) = pack8(acc[ai][bj][m][0] * w, acc[ai][bj][m][1] * w); }
    }
};
}

struct Frame { LAS unsigned char* lds; Ctx c; int wave, vcu, G;
    __device__ __forceinline__ int lane() const { return lane_id(); }
    __device__ __forceinline__ int tid() const { return wave * 64 + lane_id(); } };

struct CvtDesc { const float* src; unsigned char* dst; const float* sc; int ldw, Kd, f8; float mul; };
__device__ __forceinline__ void cvt_load(const CvtDesc& d, float (&v)[32], int lane) {
    const float* p = d.src + (size_t)(lane >> 3) * d.ldw + 4 * (lane & 7);
#pragma unroll
    for (int i = 0; i < 8; ++i) { const f32x4 t = __builtin_nontemporal_load((const f32x4*)(p + (size_t)(8 * i) * d.ldw));     v[4 * i] = t[0]; v[4 * i + 1] = t[1]; v[4 * i + 2] = t[2]; v[4 * i + 3] = t[3]; }
}
__device__ __forceinline__ void cvt_finish(const CvtDesc& d, float (&v)[32], LAS float* scr, int lane) {
    const int kr = lane >> 3, n4 = 4 * (lane & 7);
#pragma unroll
    for (int i = 0; i < 8; ++i) { const float m = (d.sc ? d.sc[8 * i + kr] : 1.0f) * d.mul;
#pragma unroll
        for (int e = 0; e < 4; ++e) scr[(8 * i + kr) * 33 + n4 + e] = v[4 * i + e] * m; }
    LDS_WAIT(); asm volatile("" ::: "memory");
    const int cc = lane & 7;
#pragma unroll
    for (int j = 0; j < 4; ++j) { const int n = (lane >> 3) + 8 * j; const LAS float* s = scr + (8 * cc) * 33 + n;
        if (d.f8) { u32x2 o; o.x = pg8::pack_fp8x4(s[0 * 33], s[1 * 33], s[2 * 33], s[3 * 33]); o.y = pg8::pack_fp8x4(s[4 * 33], s[5 * 33], s[6 * 33], s[7 * 33]); __builtin_nontemporal_store(o, (u32x2*)(d.dst + (size_t)n * d.Kd + 8 * cc)); }
        else { v4u o; o.x = cvt_pk_bf16(s[0 * 33], s[1 * 33]); o.y = cvt_pk_bf16(s[2 * 33], s[3 * 33]); o.z = cvt_pk_bf16(s[4 * 33], s[5 * 33]); o.w = cvt_pk_bf16(s[6 * 33], s[7 * 33]); __builtin_nontemporal_store(o, (v4u*)(d.dst + (size_t)n * d.Kd + 16 * cc)); } }
    LDS_WAIT(); asm volatile("" ::: "memory");
}
__device__ __forceinline__ CvtDesc mk_desc(const float* src, int ldw, int k0, int ns0, void* dst, int Kd_elems, int nd0, int kd0, const float* sc, int f8 = 0, float mul = 1.0f) {
    CvtDesc d; d.src = src + (size_t)k0 * ldw + ns0; d.ldw = ldw; d.f8 = f8; d.mul = mul; d.sc = sc ? sc + k0 : nullptr; const int eb = f8 ? 1 : 2; d.Kd = Kd_elems * eb;
    d.dst = (unsigned char*)dst + ((size_t)nd0 * Kd_elems + kd0 + k0) * eb; return d; }
constexpr long cnt_items(int K, int N) { return (long)(K / 64) * (N / 32); }
constexpr long IT_INAB = 0, IT_UQ = IT_INAB + cnt_items(D, AB_N), IT_UKV = IT_UQ + cnt_items(QR, H_A * QK), IT_LRU = IT_UKV + cnt_items(KVR, H_A * (NOPE + VD)),
    IT_OUTAB = IT_LRU + (long)2 * (LW / LBS) * 2 * 4 * cnt_items(LBS, LBS), IT_RT = IT_OUTAB + cnt_items(D, D), IT_GU0 = IT_RT + 2 * cnt_items(D, E), IT_DN0 = IT_GU0 + (long)(E + 1) * 2 * cnt_items(D, FF),
    IT_INCD = IT_DN0 + (long)(E + 1) * cnt_items(FF, D), IT_OUTCD = IT_INCD + cnt_items(D, CD_N), IT_GU1 = IT_OUTCD + cnt_items(D, D), IT_DN1 = IT_GU1 + (long)(E + 1) * 2 * cnt_items(D, FF), IT_END = IT_DN1 + (long)(E + 1) * cnt_items(FF, D);
__device__ __forceinline__ CvtDesc p0_desc(const Ctx& c, long it) {
#ifdef MOE_FP8
    constexpr int MF8 = 1; constexpr float MGU = pg8::F8_GU, MDN = pg8::F8_DN;
#else
    constexpr int MF8 = 0; constexpr float MGU = 1.0f, MDN = 1.0f;
#endif
    const int sub = (int)(it & 1);
    if (it < IT_UQ) { const long r = (it - IT_INAB) >> 1; constexpr int NBK = AB_N / 32; const int kb = 2 * (int)(r / NBK) + sub, nb = (int)(r % NBK); const int col = nb * 32; const int drow = col < QR + KVR ? col : (col < QR + KVR + ROPE ? P0_N + col - (QR + KVR) : col - ROPE);
        return mk_desc(c.in[I_WINAB], AB_N, kb * 64, col, WSP(bf16_t, W_INAB), D, drow, 0, nullptr); }
    if (it < IT_UKV) { const long r = (it - IT_UQ) >> 1; constexpr int NBK = H_A * QK / 32; const int kb = 2 * (int)(r / NBK) + sub, db = (int)(r % NBK); const int v = db * 32; int scol;
        if (v < H_A * NOPE) { const int h = v / NOPE, d0 = v % NOPE; scol = h * QK + d0; }
        else { const int v2 = v - H_A * NOPE; const int tq = v2 / 256, half = (v2 % 256) / 128, hq = (v2 % 128) / 32; scol = (4 * tq + hq) * QK + NOPE + (ROPE / 2) * half; }
        return mk_desc(c.in[I_WUQ], H_A * QK, kb * 64, scol, WSP(bf16_t, W_UQ), QR, v, 0, c.in[I_QLN]); }
    if (it < IT_LRU) { const long r = (it - IT_UKV) >> 1; constexpr int NBK = H_A * (NOPE + VD) / 32; const int kb = 2 * (int)(r / NBK) + sub, nb = (int)(r % NBK);
        return mk_desc(c.in[I_WUKV], H_A * (NOPE + VD), kb * 64, nb * 32, WSP(bf16_t, W_UKV), KVR, nb * 32, 0, c.in[I_KVLN]); }
    if (it < IT_OUTAB) { const long r = (it - IT_LRU) >> 1; constexpr int NBK = LBS / 32, PER = (LBS / 128) * NBK; const int q = (int)(r / PER), w = (int)(r % PER); const int tap = q & 3, half = (q >> 2) & 1, tq = q >> 3, g = tq >> 1, d = tq & 1; const int kb = 2 * (w / NBK) + sub, nb = w % NBK;
        const float* src = (half ? c.in[I_LWX] : c.in[I_LWA]) + ((size_t)(d * (LW / LBS) + g) * LBS) * LBS;
        return mk_desc(src, LBS, kb * 64, nb * 32, WSP(bf16_t, W_LRU) + (size_t)tq * 2 * LBS * 4 * LBS, 4 * LBS, half * LBS + nb * 32, tap * LBS, c.in[I_CONVW] + tap * LW + g * LBS); }
    if (it < IT_RT) { const long r = (it - IT_OUTAB) >> 1; constexpr int NBK = D / 32; return mk_desc(c.in[I_WOUTAB], D, (2 * (int)(r / NBK) + sub) * 64, (int)(r % NBK) * 32, WSP(bf16_t, W_OUTAB), D, (int)(r % NBK) * 32, 0, nullptr); }
    if (it < IT_GU0) { const long r = (it - IT_RT) >> 1; constexpr int NBK = E / 32; constexpr long PER = (long)(D / 128) * NBK; const int l = (int)(r / PER); const long w = r % PER;
        return mk_desc(c.in[I_WROUTER] + (size_t)l * D * E, E, (2 * (int)(w / NBK) + sub) * 64, (int)(w % NBK) * 32, WSP(bf16_t, W_RT) + (size_t)l * E * D, D, (int)(w % NBK) * 32, 0, nullptr); }
    if (it < IT_INCD || (it >= IT_GU1)) {
        const int l = it >= IT_GU1 ? 1 : 0; const long base_gu = l ? IT_GU1 : IT_GU0, base_dn = l ? IT_DN1 : IT_DN0;
        if (it < base_dn) { const long r = (it - base_gu) >> 1; constexpr int NBK = FF / 32; constexpr long PER = (long)(D / 128) * NBK; const long q = r / PER, w = r % PER; const int up = (int)(q & 1), e = (int)(q >> 1); const int kb = 2 * (int)(w / NBK) + sub, nb = (int)(w % NBK); const int col = nb * 32;
            const float* src = e < E ? (up ? c.in[I_WUP] : c.in[I_WGATE]) + ((size_t)l * E + e) * D * FF : (up ? c.in[I_WSU] : c.in[I_WSG]) + (size_t)l * D * FF;
            return mk_desc(src, FF, kb * 64, col, c.ws + W_GU + ((size_t)l * (E + 1) + e) * 2 * FF * D * (MF8 ? 1 : 2), D, (col / 128) * 256 + up * 128 + (col % 128), 0, nullptr, MF8, MGU); }
        { const long r = (it - base_dn) >> 1; constexpr int NBK = D / 32; constexpr long PER = (long)(FF / 128) * NBK; const int e = (int)(r / PER); const long w = r % PER;
            const float* src = e < E ? c.in[I_WDOWN] + ((size_t)l * E + e) * FF * D : c.in[I_WSD] + (size_t)l * FF * D;
            return mk_desc(src, D, (2 * (int)(w / NBK) + sub) * 64, (int)(w % NBK) * 32, c.ws + W_DN + ((size_t)l * (E + 1) + e) * D * FF * (MF8 ? 1 : 2), FF, (int)(w % NBK) * 32, 0, nullptr, MF8, MDN); } }
    if (it < IT_OUTCD) { const long r = (it - IT_INCD) >> 1; constexpr int NBK = CD_N / 32; return mk_desc(c.in[I_WINCD], CD_N, (2 * (int)(r / NBK) + sub) * 64, (int)(r % NBK) * 32, WSP(bf16_t, W_INCD), D, (int)(r % NBK) * 32, 0, nullptr); }
    { const long r = (it - IT_OUTCD) >> 1; constexpr int NBK = D / 32; return mk_desc(c.in[I_WOUTCD], D, (2 * (int)(r / NBK) + sub) * 64, (int)(r % NBK) * 32, WSP(bf16_t, W_OUTCD), D, (int)(r % NBK) * 32, 0, nullptr); }
}
__device__ __forceinline__ void conv_items(Frame& F, long lo, long hi, int pidx = -1, int np = 0) {
    if (pidx < 0) { pidx = F.vcu; np = F.G; }
    const Ctx& c = F.c; LAS float* scr = (LAS float*)(F.lds + F.wave * 16384); const int lane = F.lane(); const long step = 2 * (long)np * NWAVES;
    long it = lo + 2 * ((long)pidx * NWAVES + F.wave); float va[32], vb[32];
    if (it < hi) { CvtDesc da = p0_desc(c, it); cvt_load(da, va, lane);
        for (;;) {
            CvtDesc db = p0_desc(c, it + 1); cvt_load(db, vb, lane);
            cvt_finish(da, va, scr, lane);
            const long i2 = it + step; const bool h2 = i2 < hi; if (h2) { da = p0_desc(c, i2); cvt_load(da, va, lane); }
            cvt_finish(db, vb, scr, lane); if (!h2) break;
            it = i2; } }
}
__device__ __forceinline__ void conv_slice(Frame& F, long lo, long hi, int k0, int k1, int n, int pidx = -1, int np = 0) { const long npair = (hi - lo) / 2; conv_items(F, lo + 2 * (npair * k0 / n), lo + 2 * (npair * k1 / n), pidx, np); }
__device__ __forceinline__ void mod_units(Frame& F, int l) {
    const Ctx& c = F.c; LAS float* cact = (LAS float*)F.lds; LAS float* red = (LAS float*)(F.lds + 65536);
    for (int i = F.tid(); i < NB * D; i += NTHR) cact[i] = siluf(c.in[I_C][i]);
    __syncthreads();
    constexpr int UW = 48, NU = 6 * D / UW, KW = D / NWAVES; static_assert(6 * D % UW == 0 && KW % 64 == 0 && NB * UW <= NTHR, "mod units");
    for (int u = F.vcu; u < NU; u += F.G) { const int col0 = u * UW; const int rg = F.lane() >> 4, cl = (F.lane() & 15) < 12 ? (F.lane() & 15) : 11;
        const float* w = c.in[I_WMOD] + (size_t)l * D * 6 * D + col0 + 4 * cl; f32x4 a[NB];
#pragma unroll
        for (int b = 0; b < NB; ++b) a[b] = f32x4{0.f, 0.f, 0.f, 0.f};
        const int kbeg = F.wave * KW + rg;
#pragma unroll 1
        for (int i0 = 0; i0 < KW / 4; i0 += 16) { f32x4 wv[16];
#pragma unroll
            for (int j = 0; j < 16; ++j) wv[j] = __builtin_nontemporal_load((const f32x4*)(w + (size_t)(kbeg + 4 * (i0 + j)) * 6 * D));
#pragma unroll
            for (int j = 0; j < 16; ++j) { const int k = kbeg + 4 * (i0 + j);
#pragma unroll
                for (int b = 0; b < NB; ++b) a[b] += wv[j] * cact[b * D + k]; } }
#pragma unroll
        for (int b = 0; b < NB; ++b)
#pragma unroll
            for (int q = 0; q < 4; ++q) { float s = a[b][q]; s += __shfl_xor(s, 16); s += __shfl_xor(s, 32); a[b][q] = s; }
        if (F.lane() < 12) {
#pragma unroll
            for (int b = 0; b < NB; ++b) *(LAS f32x4*)(red + (F.wave * NB + b) * UW + 4 * F.lane()) = a[b]; }
        __syncthreads();
        if (F.tid() < NB * UW) { const int b = F.tid() / UW, cc = F.tid() % UW; float s = c.in[I_BMOD][l * 6 * D + col0 + cc];
#pragma unroll
            for (int w8 = 0; w8 < NWAVES; ++w8) s += red[(w8 * NB + b) * UW + cc];
            WSP(float, WS_MOD)[((size_t)l * NB + b) * 6 * D + col0 + cc] = s; }
        __syncthreads();
    }
    __syncthreads();
}

__device__ __forceinline__ void p0_phase(Frame& F) {
    const Ctx& c = F.c;
    mod_units(F, 0);
#ifndef SPREAD_CONV
    mod_units(F, 1);
#endif
    const long gt = (long)F.vcu * NTHR + F.tid(), NGT = (long)F.G * NTHR;
    for (long i = gt; i < (long)S * (ROPE / 2 + DK / 2); i += NGT) { TabF f; f.c = c; f(i); }
    static_assert(LBS % 64 == 0 && LBS % NWAVES == 0, "gate bias units");
    for (int u = F.vcu; u < 4 * LW / 64; u += F.G) { const int i = u * 64 + F.lane(); const int ch = i % LW, half = (i / LW) & 1, d = i / (2 * LW); const int g = ch / LBS, j = ch % LBS;
        LAS float* red = (LAS float*)(F.lds + 65536);
        const float* wm = (half ? c.in[I_LWX] : c.in[I_LWA]) + ((size_t)(d * (LW / LBS) + g) * LBS) * LBS + j; float s = 0.f;
#pragma unroll
        for (int kk = 0; kk < LBS / NWAVES; ++kk) { const int k = F.wave * (LBS / NWAVES) + kk; s += c.in[I_CONVB][g * LBS + k] * wm[(size_t)k * LBS]; }
        red[F.wave * 64 + F.lane()] = s; __syncthreads();
        if (F.wave == 0) { float t = (half ? c.in[I_LBX] : c.in[I_LBA])[d * LW + ch];
#pragma unroll
            for (int w8 = 0; w8 < NWAVES; ++w8) t += red[w8 * 64 + F.lane()];
            WSP(float, W_GB)[i] = t; }
        __syncthreads(); }
    for (long i = gt; i < 2 * LW; i += NGT) WSP(float, W_GB)[4 * LW + i] = -8.0f * log1pf(expf(-c.in[I_LLAM][i]));
    for (long i = gt; i < (long)NB * 4 * LW; i += NGT) { const int b = (int)(i / (4 * LW)), rr = (int)((i / LW) % 4), ch = (int)(i % LW); WSP(bf16_t, WS_LXP)[((size_t)b * (S + 4) + (rr < 2 ? rr : S + rr)) * LW + ch] = 0; }
    __syncthreads();
#ifdef SPREAD_CONV
    conv_items(F, IT_INAB, IT_OUTAB);
#else
    conv_items(F, IT_INAB, IT_END);
#endif
}
__device__ __forceinline__ void build_offt(Frame& F, int l) {
    LAS int* offt = (LAS int*)(F.lds + TAB_OFF); static_assert(E <= 64, "one lane per routed expert");
    if (F.wave == 0) { const int lane = F.lane(); LAS unsigned char* texp = (LAS unsigned char*)(offt + 2 * E + 4);
        const int n = lane < E ? __hip_atomic_load((const int*)(F.c.ws + CTL_CNT) + cnt_idx(l, lane), RLX_AGENT) : 0; const int nt = (n + RT - 1) / RT; int inc = nt;
#pragma unroll
        for (int o = 1; o < 64; o <<= 1) { const int v = __shfl_up(inc, o); if (lane >= o) inc += v; }
        const int off = inc - nt, tot = __shfl(inc, 63); constexpr int NTS = (M + RT - 1) / RT;
        if (lane < E) { offt[lane] = off; offt[E + 2 + lane] = n; for (int t = 0; t < nt; ++t) texp[off + t] = (unsigned char)lane; }
        if (lane == 0) { offt[E] = tot; offt[E + 1] = tot + NTS; }
        for (int t = lane; t < NTS; t += 64) texp[tot + t] = (unsigned char)E; }
    __syncthreads();
}

__device__ __forceinline__ void modulate_row(const float* xrow, const float* gain, const float* sc, const float* sh, bf16_t* orow, int lane, unsigned char* orow8 = nullptr) {
    f32x4 v[D / 256]; float s = 0.f;
#pragma unroll
    for (int j = 0; j < D / 256; ++j) { v[j] = *((const f32x4*)xrow + lane + 64 * j); s += (v[j][0] * v[j][0] + v[j][1] * v[j][1]) + (v[j][2] * v[j][2] + v[j][3] * v[j][3]); }
    const float r = 1.0f / sqrtf(wave_sum(s) * (1.0f / D) + EPS);
#pragma unroll
    for (int j = 0; j < D / 256; ++j) { const int col = 4 * lane + 256 * j; const f32x4 g = *(const f32x4*)(gain + col), a = *(const f32x4*)(sc + col), b = *(const f32x4*)(sh + col);
        const f32x4 o = v[j] * r * g * (1.0f + a) + b; u32x2 w; w.x = cvt_pk_bf16(o[0], o[1]); w.y = cvt_pk_bf16(o[2], o[3]); *(u32x2*)(orow + col) = w;
        if (orow8) *(unsigned*)(orow8 + col) = pg8::pack_fp8x4(o[0] * pg8::F8_H, o[1] * pg8::F8_H, o[2] * pg8::F8_H, o[3] * pg8::F8_H); }
}
template <int NR> __device__ __forceinline__ void modulate_rows(const float* X, int m0, const float* gain, const float* sc, const float* sh, bf16_t* HM, unsigned char* HM8, int lane) {
    f32x4 v[NR][D / 256]; float s[NR];
#pragma unroll
    for (int r = 0; r < NR; ++r) { s[r] = 0.f;
#pragma unroll
        for (int j = 0; j < D / 256; ++j) v[r][j] = __builtin_nontemporal_load((const f32x4*)(X + (size_t)(m0 + r) * D) + lane + 64 * j); }
#pragma unroll
    for (int r = 0; r < NR; ++r)
#pragma unroll
        for (int j = 0; j < D / 256; ++j) s[r] += (v[r][j][0] * v[r][j][0] + v[r][j][1] * v[r][j][1]) + (v[r][j][2] * v[r][j][2] + v[r][j][3] * v[r][j][3]);
#pragma unroll
    for (int o = 1; o < 64; o <<= 1)
#pragma unroll
        for (int r = 0; r < NR; ++r) s[r] += __shfl_xor(s[r], o);
#pragma unroll
    for (int j = 0; j < D / 256; ++j) { const int col = 4 * lane + 256 * j; const f32x4 g = *(const f32x4*)(gain + col), a = *(const f32x4*)(sc + col), b = *(const f32x4*)(sh + col);
#pragma unroll
        for (int r = 0; r < NR; ++r) { const float rs = 1.0f / sqrtf(s[r] * (1.0f / D) + EPS); const f32x4 o = v[r][j] * rs * g * (1.0f + a) + b; u32x2 w; w.x = cvt_pk_bf16(o[0], o[1]); w.y = cvt_pk_bf16(o[2], o[3]);
            *(u32x2*)(HM + (size_t)(m0 + r) * D + col) = w;
            if (HM8) *(unsigned*)(HM8 + (size_t)(m0 + r) * D + col) = pg8::pack_fp8x4(o[0] * pg8::F8_H, o[1] * pg8::F8_H, o[2] * pg8::F8_H, o[3] * pg8::F8_H); } }
}
__device__ __forceinline__ void modulate_phase(Frame& F, const float* X, const float* gain, const float* sc, const float* sh) {
    const int gw = F.vcu * NWAVES + F.wave, NGW = F.G * NWAVES;
    for (int m0 = 4 * gw; m0 < M; m0 += 4 * NGW) { const int b = m0 / S;
        modulate_rows<4>(X, m0, gain, sc + (size_t)b * 6 * D, sh + (size_t)b * 6 * D, (bf16_t*)(F.c.ws + WS_HM), nullptr, F.lane()); }
}
__device__ __forceinline__ void skinny32x64(Frame& F, const bf16_t* A, const bf16_t* Bt) {
    const int r = F.lane() & 31, h = F.lane() >> 5; constexpr int KW = D / NWAVES; const int k0 = F.wave * KW;
    f32x16 acc0 = {}, acc1 = {};
    const bf16_t* ap = A + (size_t)r * D + k0 + 8 * h; const bf16_t* b0p = Bt + (size_t)r * D + k0 + 8 * h; const bf16_t* b1p = Bt + (size_t)(32 + r) * D + k0 + 8 * h;
#pragma unroll 4
    for (int s = 0; s < KW / 16; ++s) { const bf16x8 a = *(const bf16x8*)(ap + 16 * s), b0 = *(const bf16x8*)(b0p + 16 * s), b1 = *(const bf16x8*)(b1p + 16 * s);
        acc0 = __builtin_amdgcn_mfma_f32_32x32x16_bf16(a, b0, acc0, 0, 0, 0); acc1 = __builtin_amdgcn_mfma_f32_32x32x16_bf16(a, b1, acc1, 0, 0, 0); }
    LAS float* red = (LAS float*)F.lds;
#pragma unroll
    for (int q = 0; q < 16; ++q) { const int row = (q & 3) + 8 * (q >> 2) + 4 * h; red[(F.wave * 32 + row) * 64 + r] = acc0[q]; red[(F.wave * 32 + row) * 64 + 32 + r] = acc1[q]; }
    __syncthreads();
    LAS float* res = (LAS float*)(F.lds + 65536);
    { const int row = F.tid() >> 4, c4 = (F.tid() & 15) * 4; f32x4 s = *(const LAS f32x4*)(red + row * 64 + c4);
#pragma unroll
      for (int w = 1; w < NWAVES; ++w) s += *(const LAS f32x4*)(red + (w * 32 + row) * 64 + c4);
      *(LAS f32x4*)(res + row * 64 + c4) = s; }
    __syncthreads();
}
__device__ __forceinline__ void krope_units(Frame& F) {
    const Ctx& c = F.c;
    for (int u = F.vcu; u < M / 32; u += F.G) { const int row0 = u * 32;
        skinny32x64(F, WSP(bf16_t, WS_HM) + (size_t)row0 * D, WSP(bf16_t, W_INAB) + (size_t)P0_N * D);
        const LAS float* res = (const LAS float*)(F.lds + 65536);
        { const int row = F.tid() >> 4, i0 = (F.tid() & 15) * 2; const int m = row0 + row, t = m % S; float o1[2], o2[2];
#pragma unroll
          for (int q = 0; q < 2; ++q) { const int ii = i0 + q; const float x1 = res[row * 64 + ii], x2 = res[row * 64 + 32 + ii], cs = WSP(float, WS_TAB + TAB_CR)[t * (ROPE / 2) + ii], sn = WSP(float, WS_TAB + TAB_SR)[t * (ROPE / 2) + ii];
              o1[q] = x1 * cs - x2 * sn; o2[q] = x2 * cs + x1 * sn; }
          const unsigned w1 = cvt_pk_bf16(o1[0], o1[1]), w2 = cvt_pk_bf16(o2[0], o2[1]);
#pragma unroll
          for (int hh = 0; hh < H_A; ++hh) { bf16_t* K = WSP(bf16_t, WS_KC) + ((size_t)m * H_A + hh) * QK + NOPE; *(unsigned*)(K + i0) = w1; *(unsigned*)(K + ROPE / 2 + i0) = w2; } }
        __syncthreads();
    }
}
__device__ __forceinline__ float wave_max(float v) {
#pragma unroll
    for (int o = 1; o < 64; o <<= 1) v = fmaxf(v, __shfl_xor(v, o));
    return v; }
__device__ __forceinline__ void route_phase(Frame& F, int l) {
    const Ctx& c = F.c; const float* mod = WSP(float, WS_MOD) + (size_t)l * NB * 6 * D; const float* X1 = WSP(float, WS_X1);
    for (int u = F.vcu; u < M / 32; u += F.G) { const int row0 = u * 32;
        { const int m0 = row0 + F.wave * 4; const int b = m0 / S;
          modulate_rows<4>(X1, m0, c.in[I_NFFN] + l * D, mod + (size_t)b * 6 * D + 4 * D, mod + (size_t)b * 6 * D + 3 * D, WSP(bf16_t, WS_HM), WSP(unsigned char, WS_HM8), F.lane()); }
        __syncthreads();
        skinny32x64(F, WSP(bf16_t, WS_HM) + (size_t)row0 * D, WSP(bf16_t, W_RT) + (size_t)l * E * D);
        const LAS float* res = (const LAS float*)(F.lds + 65536);
        int* cnt = WSP(int, CTL_CNT); LAS int* lcnt = (LAS int*)(F.lds + 65536 + 8192);
        if (F.tid() < E) lcnt[F.tid()] = 0;
        __syncthreads();
        int pe[4], pr[4]; float pw[4];
        { const int lane = F.lane(), grp = lane >> 3; float sg[4], bz[4], gs[4]; unsigned gsel[4]; const float rb = c.in[I_RBIAS][l * E + lane];
#pragma unroll
          for (int q = 0; q < 4; ++q) { const int row = F.wave * 4 + q; sg[q] = 1.0f / (1.0f + expf(-res[row * 64 + lane])); bz[q] = sg[q] + rb; }
          { float m1[4], m2[4];
#pragma unroll
            for (int q = 0; q < 4; ++q) m1[q] = bz[q];
#pragma unroll
            for (int o = 1; o < 8; o <<= 1)
#pragma unroll
                for (int q = 0; q < 4; ++q) m1[q] = fmaxf(m1[q], __shfl_xor(m1[q], o));
#pragma unroll
            for (int q = 0; q < 4; ++q) { const unsigned long long eq1 = __ballot(bz[q] == m1[q]); const int first = __builtin_ctz((unsigned)((eq1 >> (grp * 8)) & 0xffull)); m2[q] = ((lane & 7) == first) ? -INFINITY : bz[q]; }
#pragma unroll
            for (int o = 1; o < 8; o <<= 1)
#pragma unroll
                for (int q = 0; q < 4; ++q) m2[q] = fmaxf(m2[q], __shfl_xor(m2[q], o));
#pragma unroll
            for (int q = 0; q < 4; ++q) { gs[q] = m1[q] + m2[q]; gsel[q] = 0u; } }
#pragma unroll 1
          for (int it = 0; it < TG; ++it) { float cand[4], mx[4];
#pragma unroll
              for (int q = 0; q < 4; ++q) { cand[q] = ((gsel[q] >> grp) & 1u) ? -INFINITY : gs[q]; mx[q] = cand[q]; }
#pragma unroll
              for (int o = 1; o < 64; o <<= 1)
#pragma unroll
                  for (int q = 0; q < 4; ++q) mx[q] = fmaxf(mx[q], __shfl_xor(mx[q], o));
#pragma unroll
              for (int q = 0; q < 4; ++q) { const unsigned long long eq = __ballot(cand[q] == mx[q]); gsel[q] |= 1u << (__builtin_ctzll(eq) >> 3); } }
          unsigned long long taken[4]; float wsum[4], my_s[4]; int my_e[4];
#pragma unroll
          for (int q = 0; q < 4; ++q) { taken[q] = 0ull; wsum[q] = 0.f; my_s[q] = 0.f; my_e[q] = 0; }
#pragma unroll 1
          for (int k = 0; k < TOPK; ++k) { float cand[4], mx[4];
#pragma unroll
              for (int q = 0; q < 4; ++q) { cand[q] = (((gsel[q] >> grp) & 1u) && !((taken[q] >> lane) & 1ull)) ? bz[q] : -INFINITY; mx[q] = cand[q]; }
#pragma unroll
              for (int o = 1; o < 64; o <<= 1)
#pragma unroll
                  for (int q = 0; q < 4; ++q) mx[q] = fmaxf(mx[q], __shfl_xor(mx[q], o));
#pragma unroll
              for (int q = 0; q < 4; ++q) { const unsigned long long eq = __ballot(cand[q] == mx[q]); const int ek = __builtin_ctzll(eq); taken[q] |= 1ull << ek; const float sk = __shfl(sg[q], ek); wsum[q] += sk; if (lane == k) { my_e[q] = ek; my_s[q] = sk; } } }
#pragma unroll
          for (int q = 0; q < 4; ++q) { pe[q] = my_e[q]; pw[q] = my_s[q] / wsum[q] * 2.5f; pr[q] = 0;
              if (lane < TOPK) pr[q] = __hip_atomic_fetch_add(lcnt + my_e[q], 1, __ATOMIC_RELAXED, __HIP_MEMORY_SCOPE_WORKGROUP); } }
        __syncthreads();
        if (F.tid() < E) { const int n = lcnt[F.tid()]; lcnt[E + F.tid()] = n > 0 ? atomicAdd(cnt + cnt_idx(l, F.tid()), n) : 0; }
        __syncthreads();
#pragma unroll
        for (int q = 0; q < 4; ++q) { const int m = row0 + F.wave * 4 + q; const int lane = F.lane();
            if (lane < TOPK) { const int rank = lcnt[E + pe[q]] + pr[q];
                WSP(int, WS_SELE)[(size_t)m * TOPK + lane] = pe[q]; WSP(int, WS_SELR)[(size_t)m * TOPK + lane] = rank; WSP(float, WS_SELW)[(size_t)m * TOPK + lane] = pw[q];
                WSP(int, WS_TOK)[(size_t)pe[q] * M + rank] = m; WSP(float, WS_WT)[(size_t)pe[q] * M + rank] = pw[q]; } }
        __syncthreads();
    }
}
__device__ __forceinline__ void combine_phase(Frame& F, int l) {
    build_offt(F, l);
    const Ctx& c = F.c; const LAS int* offt = (const LAS int*)(F.lds + TAB_OFF); const float* X1 = WSP(float, WS_X1); float* X2 = WSP(float, WS_X2);
    const float* mod = WSP(float, WS_MOD) + (size_t)l * NB * 6 * D; const float* mod1 = WSP(float, WS_MOD) + (size_t)NB * 6 * D;
    const int gw = F.vcu * NWAVES + F.wave, NGW = F.G * NWAVES; static_assert(D == 2048, "lane l owns columns 16 l .. 16 l + 15 of each 1024-column half");
    for (int m = gw; m < M; m += NGW) { const int b = m / S; const int lane = F.lane();
        int e = 0, r = 0; float wsel = 1.0f; if (lane < TOPK) { e = WSP(int, WS_SELE)[(size_t)m * TOPK + lane]; r = WSP(int, WS_SELR)[(size_t)m * TOPK + lane]; wsel = WSP(float, WS_SELW)[(size_t)m * TOPK + lane]; }
        long rowi = (lane < TOPK) ? (long)offt[e] * RT + r : (long)offt[E] * RT + m;
        f32x4 acc[2][4];
#pragma unroll
        for (int h = 0; h < 2; ++h)
#pragma unroll
            for (int q = 0; q < 4; ++q) acc[h][q] = (f32x4){0.f, 0.f, 0.f, 0.f};
#pragma unroll 3
        for (int k = 0; k <= TOPK; ++k) { const long ri = __shfl(rowi, k); const float wk = __shfl(wsel, k); const unsigned char* yr = WSP(unsigned char, WS_Y) + (size_t)ri * D + 16 * lane;
#pragma unroll
            for (int h = 0; h < 2; ++h) { const v4u raw = __builtin_nontemporal_load((const v4u*)(yr + h * 1024));
#pragma unroll
                for (int q = 0; q < 4; ++q) { const auto lo = __builtin_amdgcn_cvt_pk_f32_fp8((int)raw[q], false), hi = __builtin_amdgcn_cvt_pk_f32_fp8((int)raw[q], true);
                    acc[h][q][0] += wk * lo[0]; acc[h][q][1] += wk * lo[1]; acc[h][q][2] += wk * hi[0]; acc[h][q][3] += wk * hi[1]; } } }
        float s = 0.f;
#pragma unroll
        for (int h = 0; h < 2; ++h)
#pragma unroll
            for (int q = 0; q < 4; ++q) { const int col = h * 1024 + 16 * lane + 4 * q; const f32x4 x = *(const f32x4*)(X1 + (size_t)m * D + col), g = *(const f32x4*)(mod + (size_t)b * 6 * D + 5 * D + col);
                acc[h][q] = x + g * (acc[h][q] * (1.0f / pg8::F8_Y)); s += (acc[h][q][0] * acc[h][q][0] + acc[h][q][1] * acc[h][q][1]) + (acc[h][q][2] * acc[h][q][2] + acc[h][q][3] * acc[h][q][3]);
                if (l == 0) *(f32x4*)(X2 + (size_t)m * D + col) = acc[h][q]; }
        const float rs = 1.0f / sqrtf(wave_sum(s) * (1.0f / D) + EPS);
#pragma unroll
        for (int h = 0; h < 2; ++h) {
            if (l == 0) { v4u w[2];
#pragma unroll
                for (int q = 0; q < 4; ++q) { const int col = h * 1024 + 16 * lane + 4 * q; const f32x4 g = *(const f32x4*)(c.in[I_NMIX] + D + col), a = *(const f32x4*)(mod1 + (size_t)b * 6 * D + D + col), bb = *(const f32x4*)(mod1 + (size_t)b * 6 * D + col);
                    const f32x4 o = acc[h][q] * rs * g * (1.0f + a) + bb; w[q >> 1][2 * (q & 1)] = cvt_pk_bf16(o[0], o[1]); w[q >> 1][2 * (q & 1) + 1] = cvt_pk_bf16(o[2], o[3]); }
                bf16_t* hp = WSP(bf16_t, WS_HM) + (size_t)m * D + h * 1024 + 16 * lane; *(v4u*)hp = w[0]; *(v4u*)(hp + 8) = w[1]; }
            else {
#pragma unroll
                for (int q = 0; q < 4; ++q) { const int col = h * 1024 + 16 * lane + 4 * q; const f32x4 g = *(const f32x4*)(c.in[I_FNORM] + col); *(f32x4*)(c.out + (size_t)m * D + col) = acc[h][q] * rs * g; } } }
    }
}
__device__ __forceinline__ void retnorm_phase(Frame& F) {
    const Ctx& c = F.c; const int gw = F.vcu * NWAVES + F.wave, NGW = F.G * NWAVES; static_assert(DK == 256, "one f32x4 per lane");
    for (int m = gw; m < M; m += NGW) { f32x4 v[H_C], g[H_C]; u32x2 raw[H_C]; float s[H_C];
#pragma unroll
        for (int h = 0; h < H_C; ++h) { const int col = h * DK + 4 * F.lane(); v[h] = *(const f32x4*)(WSP(float, WS_RET) + (size_t)m * HALF + col); g[h] = *(const f32x4*)(c.in[I_RETGN] + col); raw[h] = *(const u32x2*)(WSP(bf16_t, WS_PROJ) + (size_t)m * CD_N + 3 * H_C * DK + col);
            s[h] = (v[h][0] * v[h][0] + v[h][1] * v[h][1]) + (v[h][2] * v[h][2] + v[h][3] * v[h][3]); }
#pragma unroll
        for (int o = 1; o < 64; o <<= 1)
#pragma unroll
            for (int h = 0; h < H_C; ++h) s[h] += __shfl_xor(s[h], o);
#pragma unroll
        for (int h = 0; h < H_C; ++h) { const int col = h * DK + 4 * F.lane(); const float rs = 1.0f / sqrtf(s[h] * (1.0f / DK) + EPS); f32x4 o = v[h] * rs * g[h];
            o[0] *= __uint_as_float(raw[h].x << 16); o[1] *= __uint_as_float(raw[h].x & 0xffff0000u); o[2] *= __uint_as_float(raw[h].y << 16); o[3] *= __uint_as_float(raw[h].y & 0xffff0000u);
            u32x2 w; w.x = cvt_pk_bf16(o[0], o[1]); w.y = cvt_pk_bf16(o[2], o[3]); *(u32x2*)(WSP(bf16_t, WS_MIX) + (size_t)m * D + col) = w; } }
}
__device__ __forceinline__ void scan_phase(Frame& F) {
    const Ctx& c = F.c; constexpr int NCK = 64, CL = S / NCK, BLK = S * 16 + NCK * 16; static_assert(CL == 32 && 4 * BLK + 4 * NCK * 8 * 4 <= MISC_OFF, "scan LDS map");
    LAS unsigned char* lds = F.lds; LAS float* agg = (LAS float*)(lds + 4 * BLK);
#define SIDX(t) ((t) * 16 + ((t) >> 5) * 16)
    for (int u = F.vcu; u < NB * (LW / 8); u += F.G) { const int b = u / (LW / 8), c8 = u % (LW / 8);
#pragma unroll
        for (int q = 0; q < 4; ++q) { const bf16_t* src = (q & 1 ? WSP(bf16_t, WS_U) : WSP(bf16_t, WS_LA)) + lru_idx(q >> 1, b, 0, c8 * 8);
#pragma unroll
            for (int i = 0; i < S / NTHR; ++i) { const int t = F.tid() + NTHR * i; *(LAS v4u*)(lds + q * BLK + SIDX(t)) = *(const v4u*)(src + (size_t)t * 8); } }
        __syncthreads();
        const int ch = F.tid() & 7, ck = F.tid() >> 3; const LAS bf16_t* laf = (const LAS bf16_t*)(lds) + ch; const LAS bf16_t* uf = (const LAS bf16_t*)(lds + BLK) + ch;
        const LAS bf16_t* lab = (const LAS bf16_t*)(lds + 2 * BLK) + ch; const LAS bf16_t* ub = (const LAS bf16_t*)(lds + 3 * BLK) + ch;
        { float P = 1.f, H = 0.f;
#pragma unroll 8
          for (int i = 0; i < CL; ++i) { const int o = SIDX(ck * CL + i) / 2; const float a = __builtin_amdgcn_exp2f(LOG2E * bf2f(laf[o])); H = a * H + bf2f(uf[o]); P *= a; }
          agg[(0 * NCK + ck) * 8 + ch] = P; agg[(1 * NCK + ck) * 8 + ch] = H; P = 1.f; H = 0.f;
#pragma unroll 8
          for (int i = CL - 1; i >= 0; --i) { const int o = SIDX(ck * CL + i) / 2; const float a = __builtin_amdgcn_exp2f(LOG2E * bf2f(lab[o])); H = a * H + bf2f(ub[o]); P *= a; }
          agg[(2 * NCK + ck) * 8 + ch] = P; agg[(3 * NCK + ck) * 8 + ch] = H; }
        __syncthreads();
        static_assert(NCK == 64 && NWAVES == 8, "one lane per chunk, two (direction, channel) carries per wave");
#pragma unroll
        for (int i = 0; i < 2; ++i) { const int id = F.wave * 2 + i, dir = id >> 3, cc = id & 7; const int lane = F.lane(), k = dir ? NCK - 1 - lane : lane;
            float A = agg[((2 * dir) * NCK + k) * 8 + cc], B = agg[((2 * dir + 1) * NCK + k) * 8 + cc];
#pragma unroll
            for (int o = 1; o < 64; o <<= 1) { const float A2 = __shfl_up(A, o), B2 = __shfl_up(B, o); if (lane >= o) { B = A * B2 + B; A = A * A2; } }
            const float ex = __shfl_up(B, 1); agg[((2 * dir) * NCK + k) * 8 + cc] = lane ? ex : 0.f; }
        __syncthreads();
        { float hf[CL]; float H = agg[(0 * NCK + ck) * 8 + ch];
#pragma unroll
          for (int i = 0; i < CL; ++i) { const int o = SIDX(ck * CL + i) / 2; const float a = __builtin_amdgcn_exp2f(LOG2E * bf2f(laf[o])); H = a * H + bf2f(uf[o]); hf[i] = H; }
          H = agg[(2 * NCK + ck) * 8 + ch]; LAS bf16_t* so = (LAS bf16_t*)(lds + BLK) + ch;
#pragma unroll
          for (int i = CL - 1; i >= 0; --i) { const int o = SIDX(ck * CL + i) / 2; const float a = __builtin_amdgcn_exp2f(LOG2E * bf2f(lab[o])); H = a * H + bf2f(ub[o]); so[o] = f2bf(hf[i] + H); } }
        __syncthreads();
#pragma unroll
        for (int i = 0; i < S / NTHR; ++i) { const int t = F.tid() + NTHR * i; const size_t m = (size_t)b * S + t; const v4u sv = *(const LAS v4u*)(lds + BLK + SIDX(t)); const v4u gv = *(const v4u*)(WSP(bf16_t, WS_PROJ) + m * P0_N + QR + KVR + LW + c8 * 8);
            v4u o;
#pragma unroll
            for (int q = 0; q < 4; ++q) { const float a0 = __uint_as_float(sv[q] << 16) * __uint_as_float(gv[q] << 16), a1 = __uint_as_float(sv[q] & 0xffff0000u) * __uint_as_float(gv[q] & 0xffff0000u); o[q] = cvt_pk_bf16(a0, a1); }
            *(v4u*)(WSP(bf16_t, WS_MIX) + m * D + HALF + c8 * 8) = o; }
        __syncthreads();
    }
#undef SIDX
}
namespace attn {
#define ATT_KSWZ(row, colB, RS) ((row) * (RS) + ((colB) ^ (((row) & 7) << 4)))
__device__ __forceinline__ int crow(int r, int hi) { return (r & 3) + 8 * (r >> 2) + 4 * hi; }
__device__ __forceinline__ int v_st(int k, int c) { const int kk = (k & ~0xC) | ((k & 4) << 1) | ((k & 8) >> 1); return ((kk >> 3) * 4 + (c >> 5)) * 512 + ((kk & 7) * 32 + (c & 31)) * 2; }
__device__ __forceinline__ int v_rd_base(int lane) { return ((lane & 3) << 3) | (((lane >> 2) & 3) << 6) | (((lane >> 4) & 1) << 5) | (((lane >> 5) & 1) << 8); }
constexpr int v_rd_off(int d0, int ks, int half) { return d0 * 512 + ks * 4096 + half * 2048; }
template <int OFF> __device__ __forceinline__ s16x4 tr_read(int vb) { s16x4 r; asm volatile("ds_read_b64_tr_b16 %0, %1 offset:%2" : "=&v"(r) : "v"(vb), "i"(OFF) : "memory"); return r; }
template <int D0> __device__ __forceinline__ void pv_one(f32x16& od, int vb, bf16x8 pa0, bf16x8 pa1, bf16x8 pa2, bf16x8 pa3) {
    const s16x4 l0 = tr_read<v_rd_off(D0, 0, 0)>(vb), h0 = tr_read<v_rd_off(D0, 0, 1)>(vb), l1 = tr_read<v_rd_off(D0, 1, 0)>(vb), h1 = tr_read<v_rd_off(D0, 1, 1)>(vb);
    const s16x4 l2 = tr_read<v_rd_off(D0, 2, 0)>(vb), h2 = tr_read<v_rd_off(D0, 2, 1)>(vb), l3 = tr_read<v_rd_off(D0, 3, 0)>(vb), h3 = tr_read<v_rd_off(D0, 3, 1)>(vb);
    asm volatile("s_waitcnt lgkmcnt(0)" ::: "memory"); __builtin_amdgcn_sched_barrier(0);
#define ATT_PK(L, H) (bf16x8){L[0], L[1], L[2], L[3], H[0], H[1], H[2], H[3]}
    od = __builtin_amdgcn_mfma_f32_32x32x16_bf16(pa0, ATT_PK(l0, h0), od, 0, 0, 0);
    od = __builtin_amdgcn_mfma_f32_32x32x16_bf16(pa1, ATT_PK(l1, h1), od, 0, 0, 0);
    od = __builtin_amdgcn_mfma_f32_32x32x16_bf16(pa2, ATT_PK(l2, h2), od, 0, 0, 0);
    od = __builtin_amdgcn_mfma_f32_32x32x16_bf16(pa3, ATT_PK(l3, h3), od, 0, 0, 0);
#undef ATT_PK
}
template <int DQK, int MODE>
__device__ __forceinline__ void attn_unit(LAS unsigned char* lds, const int wave, const bf16_t* Qb, int ldq, const bf16_t* Kh, int ldk, const bf16_t* Vh, int ldv, int key0, int ntiles, int q0,
                                          float pa_, float pb_, bf16_t* Ob, float* Of, int ldo) {
    constexpr int KB = 64 * DQK * 2, VB = 64 * 128 * 2, NKP = DQK / 8, KPT = DQK / 64, RS = DQK * 2;
    constexpr int OFF_V = 2 * KB, OFF_WS = OFF_V + 2 * VB, OFF_LUT = OFF_WS + NWAVES * 64 * 4;
    const int wid = __builtin_amdgcn_readfirstlane(wave), lane = lane_id(), tid = wid * 64 + lane, r32 = lane & 31, hi = lane >> 5;
    LAS unsigned char* Kl = lds; LAS unsigned char* Vl = lds + OFF_V; LAS float* wsf = (LAS float*)(lds + OFF_WS) + wid * 64; const LAS float* lut = (const LAS float*)(lds + OFF_LUT);
    float m_reg = (MODE == 1) ? pa_ : -1e30f, l_reg = (MODE == 1) ? 1.0f : 0.f;
    f32x16 o[4] = {}; bf16x8 qr[DQK / 16];
    { const bf16_t* Qw = Qb + (size_t)(wid * 32 + r32) * ldq + hi * 8;
#pragma unroll
      for (int d0 = 0; d0 < DQK / 16; ++d0) qr[d0] = *(const bf16x8*)(Qw + d0 * 16); }
    constexpr bool REGK = (NTHR % NKP == 0) && ((NTHR / NKP) % 8 == 0);
    int koff[REGK ? 1 : KPT], kdst[REGK ? 1 : KPT];
#pragma unroll
    for (int i = 0; i < (REGK ? 1 : KPT); ++i) { const int p = tid + NTHR * i, key = p / NKP, c8 = p % NKP; koff[i] = key * ldk + c8 * 8; kdst[i] = ATT_KSWZ(key, c8 * 16, RS); }
#define ATT_KOFF(i) (REGK ? koff[0] + (i) * (NTHR / NKP) * ldk : koff[REGK ? 0 : (i)])
#define ATT_KDST(i) (REGK ? kdst[0] + (i) * (NTHR / NKP) * RS : kdst[REGK ? 0 : (i)])
    const int sr = tid >> 4, sc = (tid & 15) * 8, vst0 = v_st(sr, sc), vst1 = vst0 + 8192;
    const int vb0 = (int)(unsigned)(uintptr_t)Vl + v_rd_base(lane);
    bf16x8 ks[KPT], vs0, vs1;
#define ATT_SLOAD(kb) do { _Pragma("unroll") for (int i = 0; i < KPT; ++i) ks[i] = *(const bf16x8*)(Kh + (size_t)(kb) * ldk + ATT_KOFF(i)); \
        vs0 = *(const bf16x8*)(Vh + (size_t)((kb) + sr) * ldv + sc); vs1 = *(const bf16x8*)(Vh + (size_t)((kb) + 32 + sr) * ldv + sc); } while (0)
#define ATT_SWRITE(b) do { _Pragma("unroll") for (int i = 0; i < KPT; ++i) *(LAS bf16x8*)(Kl + (b) * KB + ATT_KDST(i)) = ks[i]; \
        *(LAS bf16x8*)(Vl + (b) * VB + vst0) = vs0; *(LAS bf16x8*)(Vl + (b) * VB + vst1) = vs1; } while (0)
    ATT_SLOAD(key0); ATT_SWRITE(0); __syncthreads();
    for (int j = 0; j < ntiles; ++j) {
        const int cur = j & 1; const int kb = key0 + j * 64;
        if (j + 1 < ntiles) ATT_SLOAD(kb + 64);
        bool live = true;
        if constexpr (MODE == 1) { const int qlo = q0 + wid * 32; live = (kb + 63 >= qlo - WIN) && (kb <= qlo + 31 + WIN); }
        if (live) {
        f32x16 p0 = {}, p1 = {};
        { const LAS unsigned char* Ks = Kl + cur * KB;
#pragma unroll
          for (int d0 = 0; d0 < DQK / 16; ++d0) { const int cb = (d0 * 16 + hi * 8) * 2;
              const bf16x8 b0 = *(const LAS bf16x8*)(Ks + ATT_KSWZ(r32, cb, RS)), b1 = *(const LAS bf16x8*)(Ks + ATT_KSWZ(32 + r32, cb, RS));
              p0 = __builtin_amdgcn_mfma_f32_32x32x16_bf16(b0, qr[d0], p0, 0, 0, 0); p1 = __builtin_amdgcn_mfma_f32_32x32x16_bf16(b1, qr[d0], p1, 0, 0, 0); } }
        if constexpr (MODE == 2) {
            const int dq = kb - (q0 + wid * 32 + r32);
#pragma unroll
            for (int r = 0; r < 16; ++r) { const int rel0 = dq + crow(r, hi), rel1 = rel0 + 32;
                p0[r] *= __builtin_amdgcn_exp2f((rel0 <= 0 ? pa_ : pb_) * (float)rel0); p1[r] *= __builtin_amdgcn_exp2f((rel1 <= 0 ? pa_ : pb_) * (float)rel1); }
        } else {
            if constexpr (MODE == 1) { const LAS float* lp = lut + (kb - (q0 + wid * 32 + r32) + 383);
#pragma unroll
                for (int r = 0; r < 16; ++r) { p0[r] += lp[crow(r, hi)]; p1[r] += lp[32 + crow(r, hi)]; } }
            float pmax = p0[0];
#pragma unroll
            for (int r = 1; r < 16; ++r) pmax = fmaxf(pmax, p0[r]);
#pragma unroll
            for (int r = 0; r < 16; ++r) pmax = fmaxf(pmax, p1[r]);
            { auto rr = __builtin_amdgcn_permlane32_swap(__float_as_uint(pmax), __float_as_uint(pmax), false, false); pmax = fmaxf(__uint_as_float(rr[0]), __uint_as_float(rr[1])); }
            float mn, alpha;
            if (__builtin_expect(__all(pmax - m_reg <= 11.5f), 1)) { mn = m_reg; alpha = 1.f; }
            else { mn = fmaxf(m_reg, pmax); alpha = __builtin_amdgcn_exp2f(m_reg - mn); m_reg = mn; }
#pragma unroll
            for (int r = 0; r < 16; ++r) { p0[r] = __builtin_amdgcn_exp2f(p0[r] - mn); p1[r] = __builtin_amdgcn_exp2f(p1[r] - mn); }
            float ps = 0.f;
#pragma unroll
            for (int r = 0; r < 16; ++r) ps += p0[r];
#pragma unroll
            for (int r = 0; r < 16; ++r) ps += p1[r];
            { auto rr = __builtin_amdgcn_permlane32_swap(__float_as_uint(ps), __float_as_uint(ps), false, false); ps = __uint_as_float(rr[0]) + __uint_as_float(rr[1]); }
            l_reg = l_reg * alpha + ps;
            if (__any(alpha < 1.f)) { if (hi == 0) wsf[32 + r32] = alpha; asm volatile("s_waitcnt lgkmcnt(0)" ::: "memory");
#pragma unroll
                for (int r = 0; r < 16; ++r) { const float a = wsf[32 + crow(r, hi)];
#pragma unroll
                    for (int d = 0; d < 4; ++d) o[d][r] *= a; } }
        }
        bf16x8 pa0, pa1, pa2, pa3;
#define ATT_PK4(P, BASE, OUT) do { unsigned a0 = cvt_pk_bf16(P[BASE + 0], P[BASE + 1]), a1 = cvt_pk_bf16(P[BASE + 2], P[BASE + 3]); \
        unsigned b0_ = cvt_pk_bf16(P[BASE + 4], P[BASE + 5]), b1_ = cvt_pk_bf16(P[BASE + 6], P[BASE + 7]); \
        auto r0 = __builtin_amdgcn_permlane32_swap(a0, b0_, false, false); auto r1 = __builtin_amdgcn_permlane32_swap(a1, b1_, false, false); \
        v4u w = {r0[0], r1[0], r0[1], r1[1]}; OUT = *reinterpret_cast<bf16x8*>(&w); } while (0)
        ATT_PK4(p0, 0, pa0); ATT_PK4(p0, 8, pa1); ATT_PK4(p1, 0, pa2); ATT_PK4(p1, 8, pa3);
#undef ATT_PK4
        { const int vb = vb0 + cur * VB; pv_one<0>(o[0], vb, pa0, pa1, pa2, pa3); pv_one<1>(o[1], vb, pa0, pa1, pa2, pa3); pv_one<2>(o[2], vb, pa0, pa1, pa2, pa3); pv_one<3>(o[3], vb, pa0, pa1, pa2, pa3); }
        }
        if (j + 1 < ntiles) ATT_SWRITE(cur ^ 1);
        __syncthreads();
    }
#undef ATT_SLOAD
#undef ATT_SWRITE
#undef ATT_KOFF
#undef ATT_KDST
    if constexpr (MODE == 2) {
#pragma unroll
        for (int r = 0; r < 16; ++r) { float* orow = Of + (size_t)(wid * 32 + crow(r, hi)) * ldo + r32;
#pragma unroll
            for (int d0 = 0; d0 < 4; ++d0) orow[d0 * 32] = o[d0][r]; }
    } else {
        if (hi == 0) wsf[r32] = l_reg; asm volatile("s_waitcnt lgkmcnt(0)" ::: "memory");
#pragma unroll
        for (int r = 0; r < 16; ++r) { const float rl = __builtin_amdgcn_rcpf(wsf[crow(r, hi)]); bf16_t* orow = Ob + (size_t)(wid * 32 + crow(r, hi)) * ldo + r32;
#pragma unroll
            for (int d0 = 0; d0 < 4; ++d0) orow[d0 * 32] = f2bf(o[d0][r] * rl); }
    }
    __syncthreads();
}
#undef ATT_KSWZ
}

__device__ __forceinline__ void att0_phase(Frame& F) {
    const Ctx& c = F.c;
    for (int u = F.vcu; u < NB * H_A * (S / 256); u += F.G) { const int qb = u % (S / 256), h = (u / (S / 256)) % H_A, b = u / ((S / 256) * H_A);
        attn::attn_unit<QK, 0>(F.lds, F.wave, WSP(bf16_t, WS_Q) + ((size_t)(b * S + qb * 256) * H_A + h) * QK, H_A * QK, WSP(bf16_t, WS_KC) + ((size_t)b * S * H_A + h) * QK, H_A * QK,
                               WSP(bf16_t, WS_V) + ((size_t)b * S * H_A + h) * VD, H_A * VD, 0, S / 64, qb * 256, 0.f, 0.f, WSP(bf16_t, WS_MIX) + (size_t)(b * S + qb * 256) * D + h * VD, nullptr, D); }
}
__device__ __forceinline__ void ret1_phase(Frame& F) {
    const Ctx& c = F.c;
    for (int u = F.vcu; u < NB * H_C * (S / 256) * 2; u += F.G) { const int dvh = u & 1, qb = (u >> 1) % (S / 256), h = (u / (2 * (S / 256))) % H_C, b = u / (2 * (S / 256) * H_C);
        const bf16_t* Pb = WSP(bf16_t, WS_PROJ) + (size_t)b * S * CD_N;
        const float lgf = log2f(1.0f - exp2f(-5.0f - (float)h)), lgb = log2f(1.0f - exp2f(-5.0f - (float)(H_C - 1 - h)));
        const int df = (int)(11.0f / -lgf) + 1, db = (int)(11.0f / -lgb) + 1; int t0 = (qb * 256 - df - 63) / 64; if (t0 < 0) t0 = 0; int t1 = (qb * 256 + 255 + db) / 64 + 1; if (t1 > S / 64) t1 = S / 64;
        attn::attn_unit<DK, 2>(F.lds, F.wave, Pb + (size_t)qb * 256 * CD_N + h * DK, CD_N, Pb + H_C * DK + h * DK, CD_N, Pb + 2 * H_C * DK + h * DK + dvh * 128, CD_N, t0 * 64, t1 - t0, qb * 256, -lgf, lgb,
                               nullptr, WSP(float, WS_RET) + (size_t)(b * S + qb * 256) * HALF + h * DK + dvh * 128, HALF); }
}
__device__ __forceinline__ void swa1_phase(Frame& F) {
    const Ctx& c = F.c; constexpr int OFF_LUT = 2 * 64 * HDS * 2 + 2 * 64 * 128 * 2 + NWAVES * 64 * 4; LAS float* lut = (LAS float*)(F.lds + OFF_LUT);
    for (int u = F.vcu; u < NB * H_D * (S / 256); u += F.G) { const int qb = u % (S / 256), hd = (u / (S / 256)) % H_D, b = u / ((S / 256) * H_D); const int kvh = hd / (H_D / KVH);
        for (int i = F.tid(); i < 767; i += NTHR) { const int rel = i - 383; lut[i] = (rel < -WIN || rel > WIN) ? -1e30f : c.in[I_RELB][t5_bucket(rel) * H_D + hd] * LOG2E; }
        __syncthreads();
        const bf16_t* Pb = WSP(bf16_t, WS_PROJ) + (size_t)b * S * CD_N + 4 * H_C * DK;
        const int klo = qb * 256 - WIN < 0 ? 0 : qb * 256 - WIN, khi = qb * 256 + 256 + WIN > S ? S : qb * 256 + 256 + WIN;
        attn::attn_unit<HDS, 1>(F.lds, F.wave, Pb + (size_t)qb * 256 * CD_N + hd * HDS, CD_N, Pb + H_D * HDS + kvh * HDS, CD_N, Pb + H_D * HDS + KVH * HDS + kvh * HDS, CD_N, klo, (khi - klo) / 64, qb * 256,
                                c.in[I_SINKS][hd] * LOG2E, 0.f, WSP(bf16_t, WS_MIX) + (size_t)(b * S + qb * 256) * D + HALF + hd * HDS, nullptr, D); }
}


#ifndef OPT_MASK
#define OPT_MASK 0
#endif
struct MArgs { Ctx c; long ph_lo, ph_hi, use_bar, pad; };
__global__ void __launch_bounds__(NTHR, 2) mega_fwd(MArgs args) {
    extern __shared__ __attribute__((aligned(16))) unsigned char lds_raw[];
    Frame F; F.lds = (LAS unsigned char*)lds_raw; F.c = args.c;
    F.wave = __builtin_amdgcn_readfirstlane((int)threadIdx.x >> 6);
    F.G = gridDim.x; { const int bx = blockIdx.x; F.vcu = (F.G % 8 == 0) ? (bx % 8) * (F.G / 8) + bx / 8 : bx; }
    const Ctx& c = F.c;
    volatile LAS unsigned* MISC = (volatile LAS unsigned*)(F.lds + MISC_OFF);
    for (int u = F.tid(); u < 256; u += NTHR) MISC[u] = 0u;
    __syncthreads();
    XcdBarrier bar; bar.bar = (unsigned*)(c.ws + 16384); bar.x = 0; bar.st = MISC + 8; bar.wave = F.wave;
    if (args.use_bar) bar = xcd_barrier_post((unsigned*)(c.ws + 16384), MISC + 8, F.wave);
    const int lo = (int)args.ph_lo, hi = (int)args.ph_hi;
#define IN(k) (lo <= (k) && (k) < hi)
#define SEAM(k) do { if (IN(k) && IN((k) + 1)) xcd_barrier(bar); } while (0)
    float* mod = WSP(float, WS_MOD);
#ifdef SPREAD_CONV
#define CONV_EARLY(call) do { if (!(blockIdx.x & 1)) { call; __syncthreads(); } } while (0)
#define CONV_LATE(call)  do { if (blockIdx.x & 1) { __syncthreads(); call; __syncthreads(); } } while (0)
#else
#define CONV_EARLY(call) do { } while (0)
#define CONV_LATE(call)  do { } while (0)
#endif
#define CONV_GU0(k0, k1) conv_slice(F, IT_GU0, IT_DN0, k0, k1, 20)
#define CONV_GU1(k0, k1) conv_slice(F, IT_GU1, IT_DN1, k0, k1, 17)

    if (IN(PH_P0)) { p0_phase(F); } SEAM(PH_P0);
#ifdef HAVE_THIN
    if (IN(PH_MOD0)) { modulate_phase(F, c.in[I_X], c.in[I_NMIX], mod + D, mod); } SEAM(PH_MOD0);
#endif
    if (IN(PH_G1)) {
        pg8::DenseOrder S_; S_.A = (const char*)WSP(bf16_t, WS_HM); S_.B = (const char*)WSP(bf16_t, W_INAB); S_.nM = M / 256; S_.nN = P0_N / 256; S_.G = F.G; S_.c = (int)blockIdx.x; S_.a_tile = (long)256 * D * 2; S_.b_tile = (long)256 * D * 2;
        pg8::EpiG1 E_{WSP(bf16_t, WS_PROJ), WSP(bf16_t, WS_LXP), WSP(float, CTL_SSQ)};
        pg8::gemm_phase<pg8::EpiG1, pg8::DenseOrder, pg8::APlain, false, true>(F.lds, F.wave, (const char*)c.ws, D, D, D, S_, E_);
#ifdef HAVE_SKINNY
        krope_units(F);
#endif
#ifdef SPREAD_CONV
        if ((int)blockIdx.x >= F.G / 2) { __syncthreads(); const int pi = (int)blockIdx.x - F.G / 2, np = F.G - F.G / 2;
            conv_items(F, IT_OUTAB, IT_GU0, pi, np); conv_slice(F, IT_GU0, IT_DN0, 0, 4, 20, pi, np); __syncthreads(); }
#endif
    } SEAM(PH_G1);
    if (IN(PH_G2)) {
        CONV_EARLY(CONV_GU0(4, 8));
        { pg8::OrderG2 S_{(const char*)WSP(bf16_t, WS_PROJ), (const char*)WSP(bf16_t, W_UQ), (const char*)WSP(bf16_t, W_UKV), F.G, (int)blockIdx.x};
          pg8::EpiG2 E_{WSP(bf16_t, WS_Q), WSP(bf16_t, WS_KC), WSP(bf16_t, WS_V), WSP(float, CTL_SSQ), WSP(float, WS_TAB + TAB_CR), WSP(float, WS_TAB + TAB_SR), LOG2E / sqrtf((float)QK)};
          pg8::gemm_phase<pg8::EpiG2, pg8::OrderG2, pg8::APlain, false, true>(F.lds, F.wave, (const char*)c.ws, P0_N, QR, QR, S_, E_); }
        { pg8::OrderGates S_{(const char*)WSP(bf16_t, WS_LXP), (const char*)WSP(bf16_t, W_LRU), F.G, (int)((blockIdx.x + F.G / 2) % F.G)};
          pg8::EpiGates E_{WSP(bf16_t, WS_LA), WSP(bf16_t, WS_U), WSP(bf16_t, WS_LXP), WSP(float, W_GB), WSP(float, W_GB) + 4 * LW, c.in[I_CONVW], c.in[I_CONVB]};
          pg8::gemm_phase<pg8::EpiGates, pg8::OrderGates, pg8::AConv, false, true>(F.lds, F.wave, (const char*)c.ws, LW, 4 * LBS, 4 * LBS, S_, E_); }
        CONV_LATE(CONV_GU0(4, 8));
    } SEAM(PH_G2);
#ifdef HAVE_THIN
    if (IN(PH_SCAN0)) { CONV_EARLY(CONV_GU0(8, 10)); scan_phase(F); CONV_LATE(CONV_GU0(8, 10)); }
#endif
#ifdef HAVE_ATT0
    if (IN(PH_ATT0)) { CONV_EARLY(CONV_GU0(10, 14)); att0_phase(F); CONV_LATE(CONV_GU0(10, 14)); } SEAM(PH_ATT0);
#endif
    if (IN(PH_OUT0)) {
        CONV_EARLY(CONV_GU0(14, 17));
        pg8::DenseOrder S_; S_.A = (const char*)WSP(bf16_t, WS_MIX); S_.B = (const char*)WSP(bf16_t, W_OUTAB); S_.nM = M / 256; S_.nN = D / 256; S_.G = F.G; S_.c = (int)blockIdx.x; S_.a_tile = (long)256 * D * 2; S_.b_tile = (long)256 * D * 2;
        pg8::EpiOut E_{c.in[I_X], WSP(float, WS_X1), mod + 2 * D};
        pg8::gemm_phase<pg8::EpiOut, pg8::DenseOrder, pg8::APlain, false, true>(F.lds, F.wave, (const char*)c.ws, D, D, D, S_, E_);
        CONV_LATE(CONV_GU0(14, 17));
    } SEAM(PH_OUT0);
#ifdef HAVE_RT
    if (IN(PH_RT0)) { CONV_EARLY(CONV_GU0(17, 20)); route_phase(F, 0); CONV_LATE(CONV_GU0(17, 20)); } SEAM(PH_RT0);
#endif
    if (IN(PH_M1_0)) {
#ifdef SPREAD_CONV
        mod_units(F, 1);
#endif
        CONV_EARLY(conv_items(F, IT_DN0, IT_GU1));
        build_offt(F, 0);
#ifdef MOE_FP8
        typedef pg8::OrderMoeT<2 * FF / 256, true, WS_HM8, W_GU + (size_t)0 * (E + 1) * 2 * FF * D, (long)2 * FF * D, (long)256 * D, 0> OM1;
#ifdef MOE_CONTIG
        const int tot1_ = ((const LAS int*)(F.lds + TAB_OFF))[E + 1] * (2 * FF / 256), lo1_ = (int)((long)tot1_ * F.vcu / F.G), hi1_ = (int)((long)tot1_ * (F.vcu + 1) / F.G);
        OM1 S_{c.ws, lo1_, hi1_ - lo1_};
#else
        OM1 S_{c.ws, F.G, F.vcu};
#endif
        pg8::EpiM1F8 E_{c.ws};
        pg8::gemm_phase<pg8::EpiM1F8, OM1, pg8::APlain, true, true, 1>(F.lds, F.wave, (const char*)c.ws, D / 2, D / 2, D / 2, S_, E_);
#else
        pg8::OrderMoe S_{(const LAS int*)(F.lds + TAB_OFF), (const char*)WSP(bf16_t, WS_HM), (const char*)WSP(bf16_t, W_GU), WSP(int, WS_TOK), 2 * FF / 256, F.G, F.vcu, 1, (long)2 * FF * D * 2, (long)256 * D * 2, 0};
        pg8::EpiM1 E_{WSP(bf16_t, WS_ACT)};
        pg8::gemm_phase<pg8::EpiM1, pg8::OrderMoe, pg8::APlain, true, true>(F.lds, F.wave, (const char*)c.ws, D, D, D, S_, E_);
#endif
        CONV_LATE(conv_items(F, IT_DN0, IT_GU1));
    } SEAM(PH_M1_0);
    if (IN(PH_M2_0)) { CONV_EARLY(CONV_GU1(0, 4)); build_offt(F, 0);
#ifdef MOE_FP8
        typedef pg8::OrderMoeT<D / 256, false, WS_ACT, W_DN + (size_t)0 * (E + 1) * D * FF, (long)D * FF, (long)256 * FF, (long)256 * FF> OM2;
#ifdef MOE_CONTIG
        const int tot2_ = ((const LAS int*)(F.lds + TAB_OFF))[E + 1] * (D / 256), lo2_ = (int)((long)tot2_ * F.vcu / F.G), hi2_ = (int)((long)tot2_ * (F.vcu + 1) / F.G);
        OM2 S_{c.ws, lo2_, hi2_ - lo2_};
#else
        OM2 S_{c.ws, F.G, F.vcu};
#endif
        pg8::EpiM2F8 E_{c.ws};
        pg8::gemm_phase<pg8::EpiM2F8, OM2, pg8::APlain, false, true, 1>(F.lds, F.wave, (const char*)c.ws, FF / 2, FF / 2, FF / 2, S_, E_);
#else
        pg8::OrderMoe S_{(const LAS int*)(F.lds + TAB_OFF), (const char*)WSP(bf16_t, WS_ACT), (const char*)WSP(bf16_t, W_DN), WSP(int, WS_TOK), D / 256, F.G, F.vcu, 0, (long)D * FF * 2, (long)256 * FF * 2, (long)256 * FF * 2};
        pg8::EpiM2 E_{WSP(bf16_t, WS_Y), WSP(float, WS_WT), (const LAS int*)(F.lds + TAB_OFF), 1.0f};
        pg8::gemm_phase<pg8::EpiM2, pg8::OrderMoe, pg8::APlain, false, true>(F.lds, F.wave, (const char*)c.ws, FF, FF, FF, S_, E_);
#endif
        CONV_LATE(CONV_GU1(0, 4));
    } SEAM(PH_M2_0);
#ifdef HAVE_THIN
    if (IN(PH_CMB0)) { CONV_EARLY(CONV_GU1(4, 6)); combine_phase(F, 0); CONV_LATE(CONV_GU1(4, 6)); } SEAM(PH_CMB0);
#endif
    if (IN(PH_G3)) {
        pg8::DenseOrder S_; S_.A = (const char*)WSP(bf16_t, WS_HM); S_.B = (const char*)WSP(bf16_t, W_INCD); S_.nM = M / 256; S_.nN = CD_N / 256; S_.G = F.G; S_.c = (int)blockIdx.x; S_.a_tile = (long)256 * D * 2; S_.b_tile = (long)256 * D * 2;
        pg8::EpiG3 E_{WSP(bf16_t, WS_PROJ), WSP(float, WS_TAB + TAB_CT), WSP(float, WS_TAB + TAB_ST), LOG2E / sqrtf((float)HDS)};
        pg8::gemm_phase<pg8::EpiG3, pg8::DenseOrder, pg8::APlain, false, true>(F.lds, F.wave, (const char*)c.ws, D, D, D, S_, E_);
#ifdef SPREAD_CONV
        { const int nu = (M / 256) * (CD_N / 256), rem = nu % F.G;
          if (rem != 0 && (int)blockIdx.x >= rem) { __syncthreads(); conv_slice(F, IT_GU1, IT_DN1, 6, 8, 17, (int)blockIdx.x - rem, F.G - rem); __syncthreads(); }
          else if (rem == 0) { __syncthreads(); CONV_GU1(6, 8); __syncthreads(); } }
#endif
    } SEAM(PH_G3);
#ifdef HAVE_RET1
    if (IN(PH_RET1)) { CONV_EARLY(CONV_GU1(8, 12)); ret1_phase(F); CONV_LATE(CONV_GU1(8, 12)); }
#endif
#ifdef HAVE_SWA1
    if (IN(PH_SWA1)) { CONV_EARLY(CONV_GU1(12, 13)); swa1_phase(F); CONV_LATE(CONV_GU1(12, 13)); } SEAM(PH_SWA1);
#endif
#ifdef HAVE_THIN
    if (IN(PH_RN1)) { retnorm_phase(F); } SEAM(PH_RN1);
#endif
    if (IN(PH_OUT1)) {
        CONV_EARLY(CONV_GU1(13, 15));
        pg8::DenseOrder S_; S_.A = (const char*)WSP(bf16_t, WS_MIX); S_.B = (const char*)WSP(bf16_t, W_OUTCD); S_.nM = M / 256; S_.nN = D / 256; S_.G = F.G; S_.c = (int)blockIdx.x; S_.a_tile = (long)256 * D * 2; S_.b_tile = (long)256 * D * 2;
        pg8::EpiOut E_{WSP(float, WS_X2), WSP(float, WS_X1), mod + (size_t)NB * 6 * D + 2 * D};
        pg8::gemm_phase<pg8::EpiOut, pg8::DenseOrder, pg8::APlain, false, true>(F.lds, F.wave, (const char*)c.ws, D, D, D, S_, E_);
        CONV_LATE(CONV_GU1(13, 15));
    } SEAM(PH_OUT1);
#ifdef HAVE_RT
    if (IN(PH_RT1)) { CONV_EARLY(CONV_GU1(15, 17)); route_phase(F, 1); CONV_LATE(CONV_GU1(15, 17)); } SEAM(PH_RT1);
#endif
    if (IN(PH_M1_1)) { CONV_EARLY(conv_items(F, IT_DN1, IT_END)); build_offt(F, 1);
#ifdef MOE_FP8
        typedef pg8::OrderMoeT<2 * FF / 256, true, WS_HM8, W_GU + (size_t)1 * (E + 1) * 2 * FF * D, (long)2 * FF * D, (long)256 * D, 0> OM1;
#ifdef MOE_CONTIG
        const int tot1_ = ((const LAS int*)(F.lds + TAB_OFF))[E + 1] * (2 * FF / 256), lo1_ = (int)((long)tot1_ * F.vcu / F.G), hi1_ = (int)((long)tot1_ * (F.vcu + 1) / F.G);
        OM1 S_{c.ws, lo1_, hi1_ - lo1_};
#else
        OM1 S_{c.ws, F.G, F.vcu};
#endif
        pg8::EpiM1F8 E_{c.ws};
        pg8::gemm_phase<pg8::EpiM1F8, OM1, pg8::APlain, true, true, 1>(F.lds, F.wave, (const char*)c.ws, D / 2, D / 2, D / 2, S_, E_);
#else
        pg8::OrderMoe S_{(const LAS int*)(F.lds + TAB_OFF), (const char*)WSP(bf16_t, WS_HM), (const char*)(WSP(bf16_t, W_GU) + (size_t)(E + 1) * 2 * FF * D), WSP(int, WS_TOK), 2 * FF / 256, F.G, F.vcu, 1, (long)2 * FF * D * 2, (long)256 * D * 2, 0};
        pg8::EpiM1 E_{WSP(bf16_t, WS_ACT)};
        pg8::gemm_phase<pg8::EpiM1, pg8::OrderMoe, pg8::APlain, true, true>(F.lds, F.wave, (const char*)c.ws, D, D, D, S_, E_);
#endif
        CONV_LATE(conv_items(F, IT_DN1, IT_END));
    } SEAM(PH_M1_1);
    if (IN(PH_M2_1)) { build_offt(F, 1);
#ifdef MOE_FP8
        typedef pg8::OrderMoeT<D / 256, false, WS_ACT, W_DN + (size_t)1 * (E + 1) * D * FF, (long)D * FF, (long)256 * FF, (long)256 * FF> OM2;
#ifdef MOE_CONTIG
        const int tot2_ = ((const LAS int*)(F.lds + TAB_OFF))[E + 1] * (D / 256), lo2_ = (int)((long)tot2_ * F.vcu / F.G), hi2_ = (int)((long)tot2_ * (F.vcu + 1) / F.G);
        OM2 S_{c.ws, lo2_, hi2_ - lo2_};
#else
        OM2 S_{c.ws, F.G, F.vcu};
#endif
        pg8::EpiM2F8 E_{c.ws};
        pg8::gemm_phase<pg8::EpiM2F8, OM2, pg8::APlain, false, true, 1>(F.lds, F.wave, (const char*)c.ws, FF / 2, FF / 2, FF / 2, S_, E_);
#else
        pg8::OrderMoe S_{(const LAS int*)(F.lds + TAB_OFF), (const char*)WSP(bf16_t, WS_ACT), (const char*)(WSP(bf16_t, W_DN) + (size_t)(E + 1) * D * FF), WSP(int, WS_TOK), D / 256, F.G, F.vcu, 0, (long)D * FF * 2, (long)256 * FF * 2, (long)256 * FF * 2};
        pg8::EpiM2 E_{WSP(bf16_t, WS_Y), WSP(float, WS_WT), (const LAS int*)(F.lds + TAB_OFF), 1.0f};
        pg8::gemm_phase<pg8::EpiM2, pg8::OrderMoe, pg8::APlain, false, true>(F.lds, F.wave, (const char*)c.ws, FF, FF, FF, S_, E_);
#endif
    } SEAM(PH_M2_1);
#ifdef HAVE_THIN
    if (IN(PH_CMB1)) { combine_phase(F, 1); }
#endif
#undef IN
#undef SEAM
}

extern "C" void kernel_launch(void* const* d_in, const int* in_sizes, int n_in, void* d_out, int out_size, void* d_ws, size_t ws_size, hipStream_t stream) {
    static int grid = 0;
    if (grid == 0) {
        if (n_in != N_IN || out_size != M * D || ws_size < WS_END) { fprintf(stderr, "kernel_launch: unexpected shapes (n_in %d, out %d, ws %zu < %zu)\n", n_in, out_size, ws_size, (size_t)WS_END); grid = -1; return; }
        int dev = 0, cus = 0;
        if (hipGetDevice(&dev) != hipSuccess || hipDeviceGetAttribute(&cus, hipDeviceAttributeMultiprocessorCount, dev) != hipSuccess) { grid = -1; return; }
        if (hipFuncSetAttribute((const void*)mega_fwd, hipFuncAttributeMaxDynamicSharedMemorySize, LDS_BYTES) != hipSuccess) { fprintf(stderr, "kernel_launch: hipFuncSetAttribute failed\n"); grid = -1; return; }
        int per_cu = 0; (void)hipOccupancyMaxActiveBlocksPerMultiprocessor(&per_cu, (const void*)mega_fwd, NTHR, LDS_BYTES); (void)hipGetLastError();
        if (per_cu < 1) fprintf(stderr, "kernel_launch: occupancy query reports %d\n", per_cu);
        grid = cus;
    }
    if (grid < 0) return;
    Ctx c; memset((void*)&c, 0, sizeof(c));
    for (int i = 0; i < N_IN; ++i) c.in[i] = (const float*)d_in[i];
    c.out = (float*)d_out; c.ws = (unsigned char*)d_ws;
    (void)hipMemsetAsync((char*)d_ws + WS_CTL, 0, CTL_BYTES, stream);
    Launcher go{stream};
    const unsigned mask = (unsigned)(OPT_MASK);
    int n_mega = 0; for (int p = 0; p < N_PHASES; ++p) n_mega += (mask >> p) & 1u;
#ifdef FORCE_SPLIT
    const bool one = false;
#else
    const bool one = (mask == (1u << N_PHASES) - 1u);
#endif
    for (int ph = 0; ph < N_PHASES; ) {
        if ((mask >> ph) & 1u) {
            int hi = ph + 1; if (one) hi = N_PHASES;
            MArgs a; memset((void*)&a, 0, sizeof(a)); a.c = c; a.ph_lo = ph; a.ph_hi = hi; a.use_bar = one ? 1 : 0;
            hipLaunchKernelGGL(mega_fwd, dim3(grid), dim3(NTHR), LDS_BYTES, stream, a);
#ifdef DUP_PHASE
            if (!one && ph == (DUP_PHASE)) hipLaunchKernelGGL(mega_fwd, dim3(grid), dim3(NTHR), LDS_BYTES, stream, a);
#endif
            if (!one && (ph == PH_RT0 || ph == PH_RT1)) naive_offt(go, c, ph == PH_RT1);
            ph = hi;
        } else {
            naive_phase(go, c, ph);
            if (ph == PH_RT0 || ph == PH_RT1) naive_offt(go, c, ph == PH_RT1);
            ++ph;
        }
    }
}


#endif
```

```cpp
#define OPT_MASK ((1u<<N_PHASES)-1u)
#define HAVE_THIN 1
#define HAVE_SKINNY 1
#define HAVE_RT 1
#define HAVE_ATT0 1
#define HAVE_RET1 1
#define HAVE_SWA1 1
#define MOE_FP8 1
#define SPREAD_CONV 1
#ifdef HOST_TEST
#include <cmath>
#include <cstring>
#include <cstdio>
#include <cstdint>
#include <cstring>
#include <cstddef>
#define HD inline
#else
#include <hip/hip_runtime.h>
#include <cstdio>
#include <cstdint>
#include <cstring>
#define HD __host__ __device__ __forceinline__
#endif

namespace cfg {
#ifdef HOST_TEST
constexpr int D = 256, NB = 2, S = 256, H_A = 4, NOPE = 16, ROPE = 16, VD = 32, QR = 64, KVR = 64, LW = 128, LBS = 16, H_C = 4, DK = 32, H_D = 8, KVH = 2, HDS = 16, WIN = 64, FF = 32;
#else
constexpr int D = 2048, NB = 4, S = 2048, H_A = 8, NOPE = 128, ROPE = 64, VD = 128, QR = 512, KVR = 512, LW = 1024, LBS = 128, H_C = 4, DK = 256, H_D = 8, KVH = 2, HDS = 128, WIN = 128, FF = 512;
#endif
constexpr int M = NB * S, QK = NOPE + ROPE, E = 64, TOPK = 8, NG = 8, TG = 4;
constexpr int AB_N = QR + KVR + ROPE + 2 * LW, P0_N = QR + KVR + 2 * LW;
constexpr int CD_N = 4 * H_C * DK + H_D * HDS + 2 * KVH * HDS;
constexpr int HALF = D / 2;
constexpr int RT = 256;
constexpr int MAXT = (M * TOPK) / RT + E + M / RT;
constexpr float EPS = 1e-6f, LOG2E = 1.4426950408889634f;
static_assert(H_A * VD == HALF && LW == HALF && H_C * DK == HALF && H_D * HDS == HALF, "half widths");
}
using namespace cfg;

enum { I_X = 0, I_C, I_WMOD, I_BMOD, I_NMIX, I_NFFN, I_FNORM, I_WINAB, I_QLN, I_KVLN, I_WUQ, I_WUKV, I_CONVW, I_CONVB, I_LWA, I_LBA, I_LWX, I_LBX, I_LLAM, I_WOUTAB,
       I_WINCD, I_RETGN, I_SINKS, I_WOUTCD, I_RELB, I_WROUTER, I_RBIAS, I_WGATE, I_WUP, I_WDOWN, I_WSG, I_WSU, I_WSD, N_IN };

typedef unsigned short bf16_t;
HD float bf2f(bf16_t v) { unsigned u = (unsigned)v << 16; float f; __builtin_memcpy(&f, &u, 4); return f; }
HD bf16_t f2bf(float f) { unsigned u; __builtin_memcpy(&u, &f, 4); u += 0x7fffu + ((u >> 16) & 1u); return (bf16_t)(u >> 16); }
HD float sigm(float x) { return 1.0f / (1.0f + expf(-x)); }
HD float siluf(float x) { return x * sigm(x); }
HD float gelu_tanh(float x) { return 0.5f * x * (1.0f + tanhf(0.7978845608028654f * (x + 0.044715f * x * x * x))); }
HD int cnt_idx(int l, int e) { return (l * E + e) * 64; }
HD float ssq8(const float* p) { return ((p[0] + p[1]) + (p[2] + p[3])) + ((p[4] + p[5]) + (p[6] + p[7])); }
HD int t5_bucket(int rel) {
    const int n = rel < 0 ? -rel : rel; const int ret = rel > 0 ? 16 : 0;
    if (n < 8) return ret + n;
    return ret + 8 + (n >= 12) + (n >= 16) + (n >= 23) + (n >= 32) + (n >= 46) + (n >= 64) + (n >= 91);
}

constexpr size_t al(size_t x) { return (x + 4095) & ~size_t(4095); }
constexpr size_t WS_CTL = 0, CTL_BYTES = 1u << 20;
constexpr size_t CTL_CNT = 65536;
constexpr size_t CTL_SSQ = 131072;
constexpr size_t WS_MOD = CTL_BYTES;
constexpr size_t WS_TAB = WS_MOD + al((size_t)2 * NB * 6 * D * 4);
constexpr size_t TAB_CR = 0, TAB_SR = (size_t)S * (ROPE / 2) * 4, TAB_CT = 2 * TAB_SR, TAB_ST = TAB_CT + (size_t)S * (DK / 2) * 4;
constexpr size_t WS_RSTD = WS_TAB + al(TAB_ST + (size_t)S * (DK / 2) * 4);
constexpr size_t WS_SELE = WS_RSTD + al((size_t)M * 4);
constexpr size_t WS_SELR = WS_SELE + al((size_t)M * 8 * 4);
constexpr size_t WS_SELW = WS_SELR + al((size_t)M * 8 * 4);
constexpr size_t WS_TOK = WS_SELW + al((size_t)M * 8 * 4);
constexpr size_t WS_WT = WS_TOK + al((size_t)E * M * 4);
constexpr size_t WS_OFFT = WS_WT + al((size_t)E * M * 4);
constexpr size_t WS_HM = WS_OFFT + 4096;
constexpr size_t WS_HM8 = WS_HM + al((size_t)M * D * 2);
constexpr size_t WS_MIX = WS_HM8 + al((size_t)M * D);
constexpr size_t WS_X1 = WS_MIX + al((size_t)M * D * 2);
constexpr size_t WS_X2 = WS_X1 + al((size_t)M * D * 4);
constexpr size_t WS_PROJ = WS_X2 + al((size_t)M * D * 4);
constexpr size_t WS_L0 = WS_PROJ + al((size_t)M * (P0_N > CD_N ? P0_N : CD_N) * 2);
constexpr size_t WS_Q = WS_L0;
constexpr size_t WS_KC = WS_Q + al((size_t)M * H_A * QK * 2);
constexpr size_t WS_V = WS_KC + al((size_t)M * H_A * QK * 2);
constexpr size_t WS_XC = WS_V + al((size_t)M * H_A * VD * 2);
constexpr size_t WS_LA = WS_XC + al((size_t)M * LW * 2);
constexpr size_t WS_U = WS_LA + al((size_t)2 * M * LW * 2);
constexpr size_t WS_HF = WS_U + al((size_t)2 * M * LW * 2);
constexpr size_t WS_LXP = WS_HF + al((size_t)M * LW * 4);
constexpr size_t WS_RET = WS_L0;
constexpr size_t WS_ACT = WS_LXP + al((size_t)NB * (S + 4) * LW * 2);
constexpr size_t WS_Y = WS_ACT + al((size_t)MAXT * RT * FF * 2);
constexpr size_t WS_T = WS_Y;
constexpr size_t WS_SC = WS_T + al((size_t)M * CD_N * 4);
static_assert(WS_SC + (size_t)8 * S * S * 4 <= WS_Y + (size_t)MAXT * RT * D * 2, "naive temps fit in the Y region");
constexpr size_t WS_W = WS_Y + al((size_t)MAXT * RT * D * 2);
constexpr size_t W_INAB = WS_W;
constexpr size_t W_UQ = W_INAB + al((size_t)AB_N * D * 2);
constexpr size_t W_UKV = W_UQ + al((size_t)H_A * QK * QR * 2);
constexpr size_t W_LRU = W_UKV + al((size_t)H_A * (NOPE + VD) * KVR * 2);
constexpr size_t W_OUTAB = W_LRU + al((size_t)2 * (LW / LBS) * 2 * LBS * 4 * LBS * 2);
constexpr size_t W_INCD = W_OUTAB + al((size_t)D * D * 2);
constexpr size_t W_OUTCD = W_INCD + al((size_t)CD_N * D * 2);
constexpr size_t W_RT = W_OUTCD + al((size_t)D * D * 2);
constexpr size_t W_GU = W_RT + al((size_t)2 * E * D * 2);
constexpr size_t W_DN = W_GU + al((size_t)2 * (E + 1) * 2 * FF * D * 2);
constexpr size_t W_GB = W_DN + al((size_t)2 * (E + 1) * D * FF * 2);
constexpr size_t WS_END = W_GB + al((size_t)6 * LW * 4);

struct Ctx { const float* in[N_IN]; float* out; unsigned char* ws; };
#define WSP(T, off) ((T*)(c.ws + (off)))
HD long lru_idx(int d, int b, int t, int ch) { return ((((long)d * NB + b) * (LW / 8) + ch / 8) * S + t) * 8 + (ch % 8); }
HD int atomic_inc(int* p) {
#ifdef HOST_TEST
    return (*p)++;
#else
#if defined(__HIP_DEVICE_COMPILE__)
    return atomicAdd(p, 1);
#else
    return (*p)++;
#endif
#endif
}

struct NGemm {
    const void* A; const void* B; void* C; const float* ks;
    long a_rs, a_ks, a_z1, a_z2, b_ks, b_ns, b_z1, b_z2, c_rs, c_z1, c_z2;
    long Mr, N, K, Z2, a_bf, b_bf, c_bf;
    HD float la(long i) const { return a_bf ? bf2f(((const bf16_t*)A)[i]) : ((const float*)A)[i]; }
    HD float lb(long i) const { return b_bf ? bf2f(((const bf16_t*)B)[i]) : ((const float*)B)[i]; }
    HD void operator()(long i) const {
        const long n4c = N / 4, m4c = Mr / 4;
        const long n0 = (i % n4c) * 4; const long r = i / n4c; const long m0 = (r % m4c) * 4; const long z = r / m4c; const long z1 = z / Z2, z2 = z % Z2;
        const long ab = z1 * a_z1 + z2 * a_z2, bb = z1 * b_z1 + z2 * b_z2, cb = z1 * c_z1 + z2 * c_z2;
        float acc[4][4];
#pragma unroll
        for (int x = 0; x < 4; ++x)
#pragma unroll
            for (int y = 0; y < 4; ++y) acc[x][y] = 0.f;
        for (long k = 0; k < K; ++k) {
            const float s = ks ? ks[k] : 1.0f;
            float av[4], bv[4];
#pragma unroll
            for (int x = 0; x < 4; ++x) av[x] = la(ab + (m0 + x) * a_rs + k * a_ks) * s;
#pragma unroll
            for (int y = 0; y < 4; ++y) bv[y] = lb(bb + k * b_ks + (n0 + y) * b_ns);
#pragma unroll
            for (int x = 0; x < 4; ++x)
#pragma unroll
                for (int y = 0; y < 4; ++y) acc[x][y] += av[x] * bv[y];
        }
#pragma unroll
        for (int x = 0; x < 4; ++x)
#pragma unroll
            for (int y = 0; y < 4; ++y) { const long ci = cb + (m0 + x) * c_rs + n0 + y; if (c_bf) ((bf16_t*)C)[ci] = f2bf(acc[x][y]); else ((float*)C)[ci] = acc[x][y]; }
    }
    long count(long Z) const { return Z * (Mr / 4) * (N / 4); }
};

struct ModF { Ctx c;
    HD void operator()(long i) const { const long n4c = 6 * D / 4; const long n = (i % n4c) * 4; const long r = i / n4c; const int b = (int)(r % NB), l = (int)(r / NB);
        float a0 = c.in[I_BMOD][l * 6 * D + n], a1 = c.in[I_BMOD][l * 6 * D + n + 1], a2 = c.in[I_BMOD][l * 6 * D + n + 2], a3 = c.in[I_BMOD][l * 6 * D + n + 3];
        const float* w = c.in[I_WMOD] + (size_t)l * D * 6 * D + n;
        for (int k = 0; k < D; ++k) { const float ca = siluf(c.in[I_C][b * D + k]); const float* wr = w + (size_t)k * 6 * D; a0 += ca * wr[0]; a1 += ca * wr[1]; a2 += ca * wr[2]; a3 += ca * wr[3]; }
        float* o = WSP(float, WS_MOD) + ((size_t)l * NB + b) * 6 * D + n; o[0] = a0; o[1] = a1; o[2] = a2; o[3] = a3; }
    long count() const { return (long)2 * NB * 6 * D / 4; } };
struct TabF { Ctx c;
    HD void operator()(long i) const { const int W = ROPE / 2 + DK / 2; const int t = (int)(i / W), j = (int)(i % W);
#if defined(__HIP_DEVICE_COMPILE__)
        { const bool r = j < ROPE / 2; const int jj = r ? j : j - ROPE / 2;
          const float inv = exp2f(-(2.0f * (float)jj / (float)(r ? ROPE : DK)) * 13.287712379549449f), a = (float)t * inv; const float cs = cosf(a), sn = sinf(a);
          if (r) { WSP(float, WS_TAB + TAB_CR)[t * (ROPE / 2) + jj] = cs; WSP(float, WS_TAB + TAB_SR)[t * (ROPE / 2) + jj] = sn; }
          else { WSP(float, WS_TAB + TAB_CT)[t * (DK / 2) + jj] = cs; WSP(float, WS_TAB + TAB_ST)[t * (DK / 2) + jj] = sn; }
          return; }
#endif
        if (j < ROPE / 2) { const double inv = pow(10000.0, -2.0 * j / ROPE), a = t * inv; WSP(float, WS_TAB + TAB_CR)[t * (ROPE / 2) + j] = (float)cos(a); WSP(float, WS_TAB + TAB_SR)[t * (ROPE / 2) + j] = (float)sin(a); }
        else { const int jj = j - ROPE / 2; const double inv = pow(10000.0, -2.0 * jj / DK), a = t * inv; WSP(float, WS_TAB + TAB_CT)[t * (DK / 2) + jj] = (float)cos(a); WSP(float, WS_TAB + TAB_ST)[t * (DK / 2) + jj] = (float)sin(a); } }
    long count() const { return (long)S * (ROPE / 2 + DK / 2); } };
struct RowSSF { Ctx c; const float* X; float* out; long rs, ncols, rows, os;
    HD void operator()(long i) const { const float* x = X + i * rs; float s = 0.f; for (long j = 0; j < ncols; ++j) s += x[j] * x[j]; out[i * os] = s; }
    long count() const { return rows; } };
struct ModulateF { Ctx c; const float* X; const float* gain; const float* sc; const float* sh;
    HD void operator()(long i) const { const long m = i / D, j = i % D; const int b = (int)(m / S); const float r = 1.0f / sqrtf(WSP(float, WS_RSTD)[m] / D + EPS);
        WSP(bf16_t, WS_HM)[i] = f2bf(X[i] * r * gain[j] * (1.0f + sc[(size_t)b * 6 * D + j]) + sh[(size_t)b * 6 * D + j]); }
    long count() const { return (long)M * D; } };
struct FinalF { Ctx c; const float* X;
    HD void operator()(long i) const { const long m = i / D, j = i % D; const float r = 1.0f / sqrtf(WSP(float, WS_RSTD)[m] / D + EPS); c.out[i] = X[i] * r * c.in[I_FNORM][j]; }
    long count() const { return (long)M * D; } };
struct PostG1F { Ctx c;
    HD void operator()(long i) const { const long m = i / AB_N; const int col = (int)(i % AB_N); const float v = WSP(float, WS_T)[i]; bf16_t* P = WSP(bf16_t, WS_PROJ) + m * P0_N;
        if (col < QR + KVR) P[col] = f2bf(v);
        else if (col < QR + KVR + ROPE) {}
        else if (col < QR + KVR + ROPE + LW) { P[col - ROPE] = f2bf(v); const long b = m / S, t = m % S; WSP(bf16_t, WS_LXP)[(b * (S + 4) + 2 + t) * LW + col - (QR + KVR + ROPE)] = f2bf(v); }
        else P[col - ROPE] = f2bf(gelu_tanh(v)); }
    long count() const { return (long)M * AB_N; } };
struct KRopeF { Ctx c;
    HD void operator()(long i) const { const long m = i / (ROPE / 2); const int ii = (int)(i % (ROPE / 2)); const int t = (int)(m % S); const float* T = WSP(float, WS_T) + m * AB_N + QR + KVR;
        const float x1 = T[ii], x2 = T[ROPE / 2 + ii], cs = WSP(float, WS_TAB + TAB_CR)[t * (ROPE / 2) + ii], sn = WSP(float, WS_TAB + TAB_SR)[t * (ROPE / 2) + ii];
        const bf16_t o1 = f2bf(x1 * cs - x2 * sn), o2 = f2bf(x2 * cs + x1 * sn);
        for (int h = 0; h < H_A; ++h) { bf16_t* K = WSP(bf16_t, WS_KC) + (m * H_A + h) * QK + NOPE; K[ii] = o1; K[ROPE / 2 + ii] = o2; } }
    long count() const { return (long)M * (ROPE / 2); } };
struct PostQF { Ctx c; float qs;
    HD void operator()(long i) const { const long m = i / (H_A * QK); const int r = (int)(i % (H_A * QK)), h = r / QK, j = r % QK; const int t = (int)(m % S);
        const float rstd = 1.0f / sqrtf(ssq8(WSP(float, CTL_SSQ) + m * 16) / QR + EPS) * qs; const float* T = WSP(float, WS_T) + m * (H_A * QK) + h * QK; bf16_t* Q = WSP(bf16_t, WS_Q) + (m * H_A + h) * QK;
        if (j < NOPE) Q[j] = f2bf(T[j] * rstd);
        else if (j < NOPE + ROPE / 2) { const int ii = j - NOPE; const float x1 = T[NOPE + ii] * rstd, x2 = T[NOPE + ROPE / 2 + ii] * rstd, cs = WSP(float, WS_TAB + TAB_CR)[t * (ROPE / 2) + ii], sn = WSP(float, WS_TAB + TAB_SR)[t * (ROPE / 2) + ii];
            Q[NOPE + ii] = f2bf(x1 * cs - x2 * sn); Q[NOPE + ROPE / 2 + ii] = f2bf(x2 * cs + x1 * sn); } }
    long count() const { return (long)M * H_A * QK; } };
struct PostKVF { Ctx c;
    HD void operator()(long i) const { const int W = NOPE + VD; const long m = i / (H_A * W); const int r = (int)(i % (H_A * W)), h = r / W, j = r % W;
        const float rstd = 1.0f / sqrtf(ssq8(WSP(float, CTL_SSQ) + m * 16 + 8) / KVR + EPS); const float v = WSP(float, WS_T)[i] * rstd;
        if (j < NOPE) WSP(bf16_t, WS_KC)[(m * H_A + h) * QK + j] = f2bf(v); else WSP(bf16_t, WS_V)[(m * H_A + h) * VD + j - NOPE] = f2bf(v); }
    long count() const { return (long)M * H_A * (NOPE + VD); } };
struct ConvF { Ctx c;
    HD void operator()(long i) const { const long m = i / LW; const int ch = (int)(i % LW); const int t = (int)(m % S); float a = c.in[I_CONVB][ch];
        for (int j = 0; j < 4; ++j) { const int tt = t + j - 2; if (tt >= 0 && tt < S) a += c.in[I_CONVW][j * LW + ch] * bf2f(WSP(bf16_t, WS_PROJ)[(m + j - 2) * P0_N + QR + KVR + ch]); }
        WSP(bf16_t, WS_XC)[i] = f2bf(a); }
    long count() const { return (long)M * LW; } };
struct GatesF { Ctx c;
    HD void operator()(long i) const { const int ch = (int)(i % LW); const long r = i / LW; const long m = r % M; const int d = (int)(r / M); const int g = ch / LBS, j = ch % LBS; const int b = (int)(m / S), t = (int)(m % S);
        const bf16_t* xr = WSP(bf16_t, WS_XC) + m * LW + g * LBS; const float* wa = c.in[I_LWA] + ((size_t)(d * (LW / LBS) + g) * LBS) * LBS + j; const float* wx = c.in[I_LWX] + ((size_t)(d * (LW / LBS) + g) * LBS) * LBS + j;
        float za = c.in[I_LBA][d * LW + ch], zx = c.in[I_LBX][d * LW + ch];
        for (int k = 0; k < LBS; ++k) { const float x = bf2f(xr[k]); za += x * wa[(size_t)k * LBS]; zx += x * wx[(size_t)k * LBS]; }
        const float lam = c.in[I_LLAM][d * LW + ch]; const float sp = log1pf(expf(-lam));
        const float la = -8.0f * sigm(za) * sp; const float u = sqrtf(-expm1f(2.0f * la)) * (sigm(zx) * bf2f(WSP(bf16_t, WS_XC)[m * LW + ch]));
        const long o = lru_idx(d, b, t, ch); WSP(bf16_t, WS_LA)[o] = f2bf(la); WSP(bf16_t, WS_U)[o] = f2bf(u); }
    long count() const { return (long)2 * M * LW; } };
struct ScanF { Ctx c;
    HD void operator()(long i) const { const int b = (int)(i / LW), ch = (int)(i % LW); float h = 0.f;
        for (int t = 0; t < S; ++t) { const long o = lru_idx(0, b, t, ch); h = expf(bf2f(WSP(bf16_t, WS_LA)[o])) * h + bf2f(WSP(bf16_t, WS_U)[o]); WSP(float, WS_HF)[((long)b * S + t) * LW + ch] = h; }
        h = 0.f;
        for (int t = S - 1; t >= 0; --t) { const long o = lru_idx(1, b, t, ch); h = expf(bf2f(WSP(bf16_t, WS_LA)[o])) * h + bf2f(WSP(bf16_t, WS_U)[o]); const long m = (long)b * S + t;
            WSP(bf16_t, WS_MIX)[m * D + HALF + ch] = f2bf((WSP(float, WS_HF)[m * LW + ch] + h) * bf2f(WSP(bf16_t, WS_PROJ)[m * P0_N + QR + KVR + LW + ch])); } }
    long count() const { return (long)NB * LW; } };
struct SoftmaxF { Ctx c; long rows;
    HD void operator()(long i) const { float* r = WSP(float, WS_SC) + i * S; float mx = -INFINITY; for (int k = 0; k < S; ++k) mx = fmaxf(mx, r[k]); float s = 0.f; for (int k = 0; k < S; ++k) { const float p = exp2f(r[k] - mx); r[k] = p; s += p; }
        const float inv = 1.0f / s; for (int k = 0; k < S; ++k) r[k] *= inv; }
    long count() const { return rows; } };
struct OutPostF { Ctx c; const float* Xin; float* Xout; long l;
    HD void operator()(long i) const { const long m = i / D, n = i % D; const int b = (int)(m / S); Xout[i] = Xin[i] + WSP(float, WS_MOD)[((size_t)l * NB + b) * 6 * D + 2 * D + n] * WSP(float, WS_T)[i]; }
    long count() const { return (long)M * D; } };
struct RouteF { Ctx c; long l;
    HD float bz(const float* lg, const float* bias, int e) const { return sigm(lg[e]) + bias[e]; }
    HD void operator()(long m) const { const float* lg = WSP(float, WS_T) + m * E; const float* bias = c.in[I_RBIAS] + l * E;
        unsigned gmask = 0u;
        for (int it = 0; it < TG; ++it) { float best = -INFINITY; int bi = 0;
            for (int g = 0; g < NG; ++g) if (!((gmask >> g) & 1u)) { float m1 = -INFINITY, m2 = -INFINITY; for (int j = 0; j < E / NG; ++j) { const float v = bz(lg, bias, g * (E / NG) + j); if (v > m1) { m2 = m1; m1 = v; } else if (v > m2) m2 = v; }
                const float sc = m1 + m2; if (sc > best) { best = sc; bi = g; } }
            gmask |= 1u << bi; }
        unsigned long long taken = 0ull; float wsum = 0.f; int* se = WSP(int, WS_SELE) + m * TOPK; float* sw = WSP(float, WS_SELW) + m * TOPK; int* sr = WSP(int, WS_SELR) + m * TOPK;
        for (int k = 0; k < TOPK; ++k) { float best = -INFINITY; int bi = 0;
            for (int e = 0; e < E; ++e) if (((gmask >> (e / (E / NG))) & 1u) && !((taken >> e) & 1ull)) { const float v = bz(lg, bias, e); if (v > best) { best = v; bi = e; } }
            taken |= 1ull << bi; const float s = sigm(lg[bi]); se[k] = bi; sw[k] = s; wsum += s; }
        int* cnt = WSP(int, CTL_CNT);
        for (int k = 0; k < TOPK; ++k) { const int e = se[k]; const float w = sw[k] / wsum * 2.5f; const int rank = atomic_inc(cnt + cnt_idx((int)l, e)); sr[k] = rank; sw[k] = w;
            WSP(int, WS_TOK)[(size_t)e * M + rank] = (int)m; WSP(float, WS_WT)[(size_t)e * M + rank] = w; } }
    long count() const { return M; } };
struct OffF { Ctx c; long l;
    HD void operator()(long) const { int* o = WSP(int, WS_OFFT); const int* cnt = WSP(int, CTL_CNT); o[0] = 0; for (int e = 0; e <= E; ++e) { const int n = e < E ? cnt[cnt_idx((int)l, e)] : M; o[e + 1] = o[e] + (n + RT - 1) / RT; } }
    long count() const { return 1; } };
struct Moe1F { Ctx c; long l;
    HD void operator()(long i) const { const long f4c = FF / 4; const int f = (int)(i % f4c) * 4; const long r = i / f4c; const int rank = (int)(r % M), e = (int)(r / M);
        const int n = e < E ? WSP(int, CTL_CNT)[cnt_idx((int)l, e)] : M; if (rank >= n) return;
        const int tok = e < E ? WSP(int, WS_TOK)[(size_t)e * M + rank] : rank; const long row = (long)WSP(int, WS_OFFT)[e] * RT + rank;
        const float* wg = (e < E ? c.in[I_WGATE] + ((size_t)l * E + e) * D * FF : c.in[I_WSG] + (size_t)l * D * FF) + f;
        const float* wu = (e < E ? c.in[I_WUP] + ((size_t)l * E + e) * D * FF : c.in[I_WSU] + (size_t)l * D * FF) + f;
        const bf16_t* h = WSP(bf16_t, WS_HM) + (size_t)tok * D; float g0 = 0, g1 = 0, g2 = 0, g3 = 0, u0 = 0, u1 = 0, u2 = 0, u3 = 0;
        for (int k = 0; k < D; ++k) { const float a = bf2f(h[k]); const float* pg = wg + (size_t)k * FF; const float* pu = wu + (size_t)k * FF;
            g0 += a * pg[0]; g1 += a * pg[1]; g2 += a * pg[2]; g3 += a * pg[3]; u0 += a * pu[0]; u1 += a * pu[1]; u2 += a * pu[2]; u3 += a * pu[3]; }
        bf16_t* o = WSP(bf16_t, WS_ACT) + row * FF + f; o[0] = f2bf(siluf(g0) * u0); o[1] = f2bf(siluf(g1) * u1); o[2] = f2bf(siluf(g2) * u2); o[3] = f2bf(siluf(g3) * u3); }
    long count() const { return (long)(E + 1) * M * (FF / 4); } };
struct Moe2F { Ctx c; long l;
    HD void operator()(long i) const { const long d4c = D / 4; const int d = (int)(i % d4c) * 4; const long r = i / d4c; const int rank = (int)(r % M), e = (int)(r / M);
        const int n = e < E ? WSP(int, CTL_CNT)[cnt_idx((int)l, e)] : M; if (rank >= n) return;
        const long row = (long)WSP(int, WS_OFFT)[e] * RT + rank; const float wt = e < E ? WSP(float, WS_WT)[(size_t)e * M + rank] : 1.0f;
        const float* wd = (e < E ? c.in[I_WDOWN] + ((size_t)l * E + e) * FF * D : c.in[I_WSD] + (size_t)l * FF * D) + d;
        const bf16_t* a = WSP(bf16_t, WS_ACT) + row * FF; float y0 = 0, y1 = 0, y2 = 0, y3 = 0;
        for (int f = 0; f < FF; ++f) { const float v = bf2f(a[f]); const float* p = wd + (size_t)f * D; y0 += v * p[0]; y1 += v * p[1]; y2 += v * p[2]; y3 += v * p[3]; }
        bf16_t* o = WSP(bf16_t, WS_Y) + row * D + d; o[0] = f2bf(wt * y0); o[1] = f2bf(wt * y1); o[2] = f2bf(wt * y2); o[3] = f2bf(wt * y3); }
    long count() const { return (long)(E + 1) * M * (D / 4); } };
struct CombineF { Ctx c; const float* Xin; float* Xout; long l;
    HD void operator()(long i) const { const long m = i / D, n = i % D; const int b = (int)(m / S); const int* offt = WSP(int, WS_OFFT); const bf16_t* Y = WSP(bf16_t, WS_Y); float v = 0.f;
        for (int k = 0; k < TOPK; ++k) { const int e = WSP(int, WS_SELE)[m * TOPK + k], r = WSP(int, WS_SELR)[m * TOPK + k]; v += bf2f(Y[((size_t)offt[e] * RT + r) * D + n]); }
        v += bf2f(Y[((size_t)offt[E] * RT + m) * D + n]);
        Xout[i] = Xin[i] + WSP(float, WS_MOD)[((size_t)l * NB + b) * 6 * D + 5 * D + n] * v; }
    long count() const { return (long)M * D; } };
struct PostG3F { Ctx c; float sqs;
    HD void operator()(long i) const { const long m = i / CD_N; const int col = (int)(i % CD_N); const int t = (int)(m % S); const float* T = WSP(float, WS_T) + m * CD_N; bf16_t* P = WSP(bf16_t, WS_PROJ) + m * CD_N; const int W = H_C * DK;
        if (col < 2 * W) { const int j = col % DK; if (j < DK / 2) { const float sc = col < W ? 1.0f : 1.0f / sqrtf((float)DK); const float x1 = T[col], x2 = T[col + DK / 2], cs = WSP(float, WS_TAB + TAB_CT)[t * (DK / 2) + j], sn = WSP(float, WS_TAB + TAB_ST)[t * (DK / 2) + j];
                P[col] = f2bf((x1 * cs - x2 * sn) * sc); P[col + DK / 2] = f2bf((x2 * cs + x1 * sn) * sc); } }
        else if (col < 3 * W) P[col] = f2bf(T[col]);
        else if (col < 4 * W) P[col] = f2bf(siluf(T[col]));
        else if (col < 4 * W + H_D * HDS) P[col] = f2bf(T[col] * sqs);
        else P[col] = f2bf(T[col]); }
    long count() const { return (long)M * CD_N; } };
struct DecayF { Ctx c;
    HD void operator()(long i) const { const int mm = (int)(i % S); const long r = i / S; const int n = (int)(r % S), h = (int)(r / S);
        const float lgf = log1pf(-exp2f(-5.0f - h)), lgb = log1pf(-exp2f(-5.0f - (H_C - 1 - h)));
        WSP(float, WS_SC)[i] *= (n >= mm) ? expf(lgf * (n - mm)) : expf(lgb * (mm - n)); }
    long count() const { return (long)H_C * S * S; } };
struct RetNormF { Ctx c;
    HD void operator()(long i) const { const long m = i / H_C; const int h = (int)(i % H_C); const float* r = WSP(float, WS_RET) + m * HALF + h * DK; float s = 0.f; for (int j = 0; j < DK; ++j) s += r[j] * r[j];
        const float rs = 1.0f / sqrtf(s / DK + EPS); for (int j = 0; j < DK; ++j) WSP(bf16_t, WS_MIX)[m * D + h * DK + j] = f2bf(bf2f(WSP(bf16_t, WS_PROJ)[m * CD_N + 3 * H_C * DK + h * DK + j]) * (r[j] * rs * c.in[I_RETGN][h * DK + j])); }
    long count() const { return (long)M * H_C; } };
struct SwaSoftF { Ctx c;
    HD void operator()(long i) const { const int q = (int)(i % S), hd = (int)(i / S); float* r = WSP(float, WS_SC) + i * S; const float sink = c.in[I_SINKS][hd] * LOG2E; const float* rb = c.in[I_RELB];
        const int lo = q - WIN < 0 ? 0 : q - WIN, hi = q + WIN > S - 1 ? S - 1 : q + WIN; float mx = sink;
        for (int k = lo; k <= hi; ++k) { const float s = r[k] + rb[t5_bucket(k - q) * H_D + hd] * LOG2E; r[k] = s; mx = fmaxf(mx, s); }
        float den = exp2f(sink - mx); for (int k = lo; k <= hi; ++k) { const float p = exp2f(r[k] - mx); r[k] = p; den += p; }
        const float inv = 1.0f / den; for (int k = 0; k < S; ++k) r[k] = (k >= lo && k <= hi) ? r[k] * inv : 0.f; }
    long count() const { return (long)H_D * S; } };

#ifdef HOST_TEST
struct Launcher { template <class F> void operator()(const F& f, long n) const { for (long i = 0; i < n; ++i) f(i); } };
#else
template <class F> __global__ void __launch_bounds__(256) run_k(F f, long n) { for (long i = (long)blockIdx.x * 256 + threadIdx.x; i < n; i += (long)gridDim.x * 256) f(i); }
struct Launcher { hipStream_t st; template <class F> void operator()(const F& f, long n) const { long g = (n + 255) / 256; if (g > (1 << 20)) g = 1 << 20; if (g < 1) g = 1; hipLaunchKernelGGL(run_k<F>, dim3((unsigned)g), dim3(256), 0, st, f, n); } };
#endif

template <class F> static F zf() { F f; memset((void*)&f, 0, sizeof(F)); return f; }
static NGemm mk_gemm(const void* A, int a_bf, long a_rs, const void* B, int b_bf, long b_ks, long b_ns, void* C, int c_bf, long c_rs, long Mr, long N, long K) {
    NGemm g; memset((void*)&g, 0, sizeof(g)); g.A = A; g.B = B; g.C = C; g.a_bf = a_bf; g.b_bf = b_bf; g.c_bf = c_bf; g.a_rs = a_rs; g.a_ks = 1; g.b_ks = b_ks; g.b_ns = b_ns; g.c_rs = c_rs; g.Mr = Mr; g.N = N; g.K = K; g.Z2 = 1; return g; }

template <class L> static void rowss(const L& go, const Ctx& c, const float* X, float* out, long rs, long ncols, long os = 1) { RowSSF f = zf<RowSSF>(); f.c = c; f.X = X; f.out = out; f.rs = rs; f.ncols = ncols; f.rows = M; f.os = os; go(f, f.count()); }

enum { PH_P0 = 0, PH_MOD0, PH_G1, PH_G2, PH_SCAN0, PH_ATT0, PH_OUT0, PH_RT0, PH_M1_0, PH_M2_0, PH_CMB0, PH_G3, PH_RET1, PH_SWA1, PH_RN1, PH_OUT1, PH_RT1, PH_M1_1, PH_M2_1, PH_CMB1, N_PHASES };

template <class L> static void naive_phase(const L& go, const Ctx& c, int ph) {
    float* mod = WSP(float, WS_MOD);
    const int l = ph >= PH_G3 ? 1 : 0;
    float* X1 = WSP(float, WS_X1); float* X2 = WSP(float, WS_X2);
    switch (ph) {
    case PH_P0: { { ModF f = zf<ModF>(); f.c = c; go(f, f.count()); } { TabF f = zf<TabF>(); f.c = c; go(f, f.count()); } } break;
    case PH_MOD0: { rowss(go, c, c.in[I_X], WSP(float, WS_RSTD), D, D);
        ModulateF f = zf<ModulateF>(); f.c = c; f.X = c.in[I_X]; f.gain = c.in[I_NMIX]; f.sc = mod + D; f.sh = mod; go(f, f.count()); } break;
    case PH_G1: { { NGemm g = mk_gemm(WSP(bf16_t, WS_HM), 1, D, c.in[I_WINAB], 0, AB_N, 1, WSP(float, WS_T), 0, AB_N, M, AB_N, D); go(g, g.count(1)); }
        { PostG1F f = zf<PostG1F>(); f.c = c; go(f, f.count()); }
        rowss(go, c, WSP(float, WS_T), WSP(float, CTL_SSQ), AB_N, QR, 16);
        rowss(go, c, WSP(float, WS_T) + QR, WSP(float, CTL_SSQ) + 8, AB_N, KVR, 16);
        { KRopeF f = zf<KRopeF>(); f.c = c; go(f, f.count()); } } break;
    case PH_G2: { { NGemm g = mk_gemm(WSP(bf16_t, WS_PROJ), 1, P0_N, c.in[I_WUQ], 0, H_A * QK, 1, WSP(float, WS_T), 0, H_A * QK, M, H_A * QK, QR); g.ks = c.in[I_QLN]; go(g, g.count(1)); }
        { PostQF f = zf<PostQF>(); f.c = c; f.qs = LOG2E / sqrtf((float)QK); go(f, f.count()); }
        { NGemm g = mk_gemm(WSP(bf16_t, WS_PROJ) + QR, 1, P0_N, c.in[I_WUKV], 0, H_A * (NOPE + VD), 1, WSP(float, WS_T), 0, H_A * (NOPE + VD), M, H_A * (NOPE + VD), KVR); g.ks = c.in[I_KVLN]; go(g, g.count(1)); }
        { PostKVF f = zf<PostKVF>(); f.c = c; go(f, f.count()); }
        { ConvF f = zf<ConvF>(); f.c = c; go(f, f.count()); }
        { GatesF f = zf<GatesF>(); f.c = c; go(f, f.count()); } } break;
    case PH_SCAN0: { ScanF f = zf<ScanF>(); f.c = c; go(f, f.count()); } break;
    case PH_ATT0: {
        for (int b = 0; b < NB; ++b) {
            NGemm g = mk_gemm(WSP(bf16_t, WS_Q) + (size_t)b * S * H_A * QK, 1, H_A * QK, WSP(bf16_t, WS_KC) + (size_t)b * S * H_A * QK, 1, 1, H_A * QK, WSP(float, WS_SC), 0, S, S, S, QK);
            g.a_z2 = QK; g.b_z2 = QK; g.c_z2 = (long)S * S; g.Z2 = H_A; go(g, g.count(H_A));
            { SoftmaxF f = zf<SoftmaxF>(); f.c = c; f.rows = (long)H_A * S; go(f, f.count()); }
            NGemm p = mk_gemm(WSP(float, WS_SC), 0, S, WSP(bf16_t, WS_V) + (size_t)b * S * H_A * VD, 1, H_A * VD, 1, WSP(bf16_t, WS_MIX) + (size_t)b * S * D, 1, D, S, VD, S);
            p.a_z2 = (long)S * S; p.b_z2 = VD; p.c_z2 = VD; p.Z2 = H_A; go(p, p.count(H_A)); } } break;
    case PH_OUT0: case PH_OUT1: { NGemm g = mk_gemm(WSP(bf16_t, WS_MIX), 1, D, c.in[l ? I_WOUTCD : I_WOUTAB], 0, D, 1, WSP(float, WS_T), 0, D, M, D, D); go(g, g.count(1));
        OutPostF f = zf<OutPostF>(); f.c = c; f.Xin = l ? X2 : c.in[I_X]; f.Xout = X1; f.l = l; go(f, f.count()); } break;
    case PH_RT0: case PH_RT1: { float* modl = mod + (size_t)l * NB * 6 * D;
        rowss(go, c, X1, WSP(float, WS_RSTD), D, D);
        { ModulateF f = zf<ModulateF>(); f.c = c; f.X = X1; f.gain = c.in[I_NFFN] + l * D; f.sc = modl + 4 * D; f.sh = modl + 3 * D; go(f, f.count()); }
        { NGemm g = mk_gemm(WSP(bf16_t, WS_HM), 1, D, c.in[I_WROUTER] + (size_t)l * D * E, 0, E, 1, WSP(float, WS_T), 0, E, M, E, D); go(g, g.count(1)); }
        { RouteF f = zf<RouteF>(); f.c = c; f.l = l; go(f, f.count()); } } break;
    case PH_M1_0: case PH_M1_1: { Moe1F f = zf<Moe1F>(); f.c = c; f.l = l; go(f, f.count()); } break;
    case PH_M2_0: case PH_M2_1: { Moe2F f = zf<Moe2F>(); f.c = c; f.l = l; go(f, f.count()); } break;
    case PH_CMB0: { { CombineF f = zf<CombineF>(); f.c = c; f.Xin = X1; f.Xout = X2; f.l = 0; go(f, f.count()); }
        rowss(go, c, X2, WSP(float, WS_RSTD), D, D);
        ModulateF f = zf<ModulateF>(); f.c = c; f.X = X2; f.gain = c.in[I_NMIX] + D; f.sc = mod + (size_t)NB * 6 * D + D; f.sh = mod + (size_t)NB * 6 * D; go(f, f.count()); } break;
    case PH_CMB1: { { CombineF f = zf<CombineF>(); f.c = c; f.Xin = X1; f.Xout = X2; f.l = 1; go(f, f.count()); }
        rowss(go, c, X2, WSP(float, WS_RSTD), D, D);
        FinalF f = zf<FinalF>(); f.c = c; f.X = X2; go(f, f.count()); } break;
    case PH_G3: { { NGemm g = mk_gemm(WSP(bf16_t, WS_HM), 1, D, c.in[I_WINCD], 0, CD_N, 1, WSP(float, WS_T), 0, CD_N, M, CD_N, D); go(g, g.count(1)); }
        PostG3F f = zf<PostG3F>(); f.c = c; f.sqs = LOG2E / sqrtf((float)HDS); go(f, f.count()); } break;
    case PH_RET1: {
        for (int b = 0; b < NB; ++b) {
            const bf16_t* Pb = WSP(bf16_t, WS_PROJ) + (size_t)b * S * CD_N;
            NGemm g = mk_gemm(Pb, 1, CD_N, Pb + H_C * DK, 1, 1, CD_N, WSP(float, WS_SC), 0, S, S, S, DK);
            g.a_z2 = DK; g.b_z2 = DK; g.c_z2 = (long)S * S; g.Z2 = H_C; go(g, g.count(H_C));
            { DecayF f = zf<DecayF>(); f.c = c; go(f, f.count()); }
            NGemm p = mk_gemm(WSP(float, WS_SC), 0, S, Pb + 2 * H_C * DK, 1, CD_N, 1, WSP(float, WS_RET) + (size_t)b * S * HALF, 0, HALF, S, DK, S);
            p.a_z2 = (long)S * S; p.b_z2 = DK; p.c_z2 = DK; p.Z2 = H_C; go(p, p.count(H_C)); } } break;
    case PH_SWA1: {
        for (int b = 0; b < NB; ++b) {
            const bf16_t* Pb = WSP(bf16_t, WS_PROJ) + (size_t)b * S * CD_N + 4 * H_C * DK; const int G = H_D / KVH;
            NGemm g = mk_gemm(Pb, 1, CD_N, Pb + H_D * HDS, 1, 1, CD_N, WSP(float, WS_SC), 0, S, S, S, HDS);
            g.a_z1 = (long)G * HDS; g.a_z2 = HDS; g.b_z1 = HDS; g.b_z2 = 0; g.c_z1 = (long)G * S * S; g.c_z2 = (long)S * S; g.Z2 = G; go(g, g.count(H_D));
            { SwaSoftF f = zf<SwaSoftF>(); f.c = c; go(f, f.count()); }
            NGemm p = mk_gemm(WSP(float, WS_SC), 0, S, Pb + H_D * HDS + KVH * HDS, 1, CD_N, 1, WSP(bf16_t, WS_MIX) + (size_t)b * S * D + HALF, 1, D, S, HDS, S);
            p.a_z1 = (long)G * S * S; p.a_z2 = (long)S * S; p.b_z1 = HDS; p.b_z2 = 0; p.c_z1 = (long)G * HDS; p.c_z2 = HDS; p.Z2 = G; go(p, p.count(H_D)); } } break;
    case PH_RN1: { RetNormF f = zf<RetNormF>(); f.c = c; go(f, f.count()); } break;
    default: break;
    }
}
template <class L> static void naive_offt(const L& go, const Ctx& c, int l) { OffF f = zf<OffF>(); f.c = c; f.l = l; go(f, f.count()); }

#ifdef HOST_TEST
template <class L> static void run_all(const L& go, const Ctx& c) {
    for (int ph = 0; ph < N_PHASES; ++ph) { naive_phase(go, c, ph); if (ph == PH_RT0 || ph == PH_RT1) naive_offt(go, c, ph == PH_RT1); }
}
#endif
#ifndef HOST_TEST
#define LAS __attribute__((address_space(3)))
#define GAS __attribute__((address_space(1)))
typedef unsigned v4u __attribute__((ext_vector_type(4)));
typedef unsigned u32x2 __attribute__((ext_vector_type(2)));
typedef float f32x4 __attribute__((ext_vector_type(4)));
typedef float f32x16 __attribute__((ext_vector_type(16)));
typedef short bf16x8 __attribute__((ext_vector_type(8)));
typedef short s16x4 __attribute__((ext_vector_type(4)));
typedef int v8i_t __attribute__((ext_vector_type(8)));
typedef int v4i_t __attribute__((ext_vector_type(4)));
typedef GAS unsigned gu32;
#define RLX_AGENT __ATOMIC_RELAXED, __HIP_MEMORY_SCOPE_AGENT
#define LDS_WAIT() asm volatile("s_waitcnt lgkmcnt(0)" ::: "memory")
#define VM_WAIT() asm volatile("s_waitcnt vmcnt(0)" ::: "memory")
constexpr int NWAVES = 8, NTHR = 512;
constexpr int LDS_BYTES = 147456, MISC_OFF = LDS_BYTES - 2048, TAB_OFF = MISC_OFF + 1024;
__device__ __forceinline__ int lane_id() { int l; asm volatile("v_mbcnt_lo_u32_b32 %0, -1, 0\n\tv_mbcnt_hi_u32_b32 %0, -1, %0" : "=v"(l)); return l; }
__device__ __forceinline__ unsigned cvt_pk_bf16(float lo, float hi) { unsigned r; asm volatile("v_cvt_pk_bf16_f32 %0, %1, %2" : "=v"(r) : "v"(lo), "v"(hi)); return r; }
__device__ __forceinline__ float fast_sigm(float x) { return __builtin_amdgcn_rcpf(1.0f + __builtin_amdgcn_exp2f(-1.4426950408889634f * x)); }
__device__ __forceinline__ float fast_silu(float x) { return x * fast_sigm(x); }
__device__ __forceinline__ float fast_gelu_tanh(float x) { const float z = 0.7978845608028654f * (x + 0.044715f * x * x * x); return x * fast_sigm(2.0f * z); }
__device__ __forceinline__ float wave_sum(float v) {
#pragma unroll
    for (int o = 1; o < 64; o <<= 1) v += __shfl_xor(v, o);
    return v; }

#define XB_TMO      128
#define XB_XCNT(j)  (256  + 64 * (j))
#define XB_XSUB(j)  (1280 + 64 * (j))
#define XB_XGEN(j)  (2304 + 64 * (j))
#define XB_TOP      3328
#define XB_TOPGEN   3392
#define XCD_BAR_WORDS 3456
#define XB_SPIN_CAP (1u << 20)
__device__ __forceinline__ unsigned xb_ld(unsigned* p)              { return __hip_atomic_load(p, __ATOMIC_RELAXED, __HIP_MEMORY_SCOPE_AGENT); }
__device__ __forceinline__ unsigned xb_add(unsigned* p, unsigned v) { return __hip_atomic_fetch_add(p, v, __ATOMIC_RELAXED, __HIP_MEMORY_SCOPE_AGENT); }
__device__ __forceinline__ unsigned xb_xcc_id() { return (unsigned)__builtin_amdgcn_s_getreg((3 << 11) | 20) & 0xFu; }
#define XB_SPIN(cond, bar) do { unsigned _sp = 0; while (cond) { __builtin_amdgcn_s_sleep(1); \
    if ((++_sp & 255u) == 0u) { if (xb_ld(&(bar)[XB_TMO])) break; if (_sp > XB_SPIN_CAP) { atomicAdd(&(bar)[XB_TMO], 1u); break; } } } } while (0)
struct XcdBarrier { unsigned* bar; unsigned x; volatile LAS unsigned* st; int wave; };
__device__ __forceinline__ XcdBarrier xcd_barrier_post(unsigned* bar, volatile LAS unsigned* st, int wave) {
    XcdBarrier b; b.bar = bar; b.x = xb_xcc_id(); b.st = st; b.wave = wave;
    if (wave == 0 && lane_id() == 0) (void)xb_add(&bar[XB_XCNT(b.x)], 1u);
    return b; }
__device__ __forceinline__ void xcd_barrier_complete(unsigned* bar, unsigned x, unsigned& nloc, unsigned& nx) {
    const unsigned G = gridDim.x * gridDim.y * gridDim.z;
    unsigned sum, cnt, mine, sp = 0u;
    for (;;) {
        sum = 0u; cnt = 0u; mine = 0u;
#pragma unroll
        for (unsigned j = 0; j < 16; ++j) { const unsigned c = xb_ld(&bar[XB_XCNT(j)]); sum += c; cnt += (c > 0u) ? 1u : 0u; mine = (j == x) ? c : mine; }
        if (sum == G) break;
        __builtin_amdgcn_s_sleep(1);
        if ((++sp & 255u) == 0u) { if (xb_ld(&bar[XB_TMO])) break; if (sp > XB_SPIN_CAP) { atomicAdd(&bar[XB_TMO], 1u); break; } }
    }
    nloc = mine > 0u ? mine : 1u; nx = cnt > 0u ? cnt : 1u; }
__device__ __forceinline__ void xcd_barrier(const XcdBarrier& b) {
    asm volatile("s_waitcnt vmcnt(0)" ::: "memory");
    __syncthreads();
    if (b.wave == 0 && lane_id() == 0) {
        unsigned* bar = b.bar;
        __builtin_amdgcn_s_waitcnt(0);
        unsigned nloc = b.st[0], nx = b.st[1];
        if (nloc == 0u) { xcd_barrier_complete(bar, b.x, nloc, nx); b.st[0] = nloc; b.st[1] = nx; }
        const unsigned old = xb_add(&bar[XB_XSUB(b.x)], 1u);
        const unsigned gen = old / nloc;
        if (old + 1u == (gen + 1u) * nloc) {
            __builtin_amdgcn_fence(__ATOMIC_RELEASE, "agent");
            asm volatile("s_waitcnt vmcnt(0)" ::: "memory");
            const unsigned og = xb_add(&bar[XB_TOP], 1u);
            const unsigned tg = og / nx;
            if (og + 1u == (tg + 1u) * nx) xb_add(&bar[XB_TOPGEN], 1u);
            else XB_SPIN(xb_ld(&bar[XB_TOPGEN]) == tg, bar);
            __builtin_amdgcn_fence(__ATOMIC_ACQUIRE, "agent");
            xb_add(&bar[XB_XGEN(b.x)], 1u);
            asm volatile("s_waitcnt vmcnt(0)" ::: "memory");
        } else {
            XB_SPIN(xb_ld(&bar[XB_XGEN(b.x)]) == gen, bar);
            __builtin_amdgcn_fence(__ATOMIC_ACQUIRE, "agent");
            asm volatile("s_waitcnt vmcnt(0)" ::: "memory");
        }
    }
    __syncthreads();
}

namespace pg8 {
constexpr int BM = 256, BK = 64, HALFT = 128, HTB = HALFT * BK * 2, STAGE_BYTES = 8 * HTB, NXCD = 8, WGM = 8;
__host__ __device__ __forceinline__ int lds_byte(int r, int c) { const int st = (r >> 4) * 2 + (c >> 5), rr = r & 15, cc = c & 31, ob = rr * 64 + cc * 2; return st * 1024 + (ob ^ (((ob >> 9) & 1) << 5)); }
__host__ __device__ __forceinline__ void stage_rc(int b, int& R, int& C) { const int st = b / 1024, sb = b % 1024, swz = sb ^ (((sb >> 9) & 1) << 5); R = (st >> 1) * 16 + swz / 64; C = (st & 1) * 32 + (swz % 64) / 2; }
__host__ __device__ __forceinline__ int perm32(int rho) { const int n = rho >> 4, i = rho & 15; return 8 * (i >> 2) + 4 * n + (i & 3); }
struct Unit { const char* A; const char* B; int pm, pn, e, r0; };
__device__ __forceinline__ void tile_of(int L, int nM, int nN, int& pm, int& pn) {
    const int nwg = nM * nN; int wgid = L; { const int q = nwg / NXCD, r = nwg % NXCD, xcd = wgid % NXCD, off = wgid / NXCD; wgid = (xcd < r ? xcd * (q + 1) : r * (q + 1) + (xcd - r) * q) + off; }
    const int nig = WGM * nN, gid = wgid / nig, fm = gid * WGM, gsz = (nM - fm) < WGM ? (nM - fm) : WGM;
    pm = fm + ((wgid % nig) % gsz); pn = (wgid % nig) / gsz; }
template <class E_, class = void> struct perm16_t { static constexpr bool value = false; };
template <class E_> struct perm16_t<E_, decltype((void)E_::PERM16)> { static constexpr bool value = E_::PERM16; };
template <class E_> constexpr bool perm16_v = perm16_t<E_>::value;
struct APlain { static __device__ __forceinline__ const char* kt(const char* base, int t, int) { return base + (size_t)t * (BK * 2); } };
struct AConv { static __device__ __forceinline__ const char* kt(const char* base, int t, int lda) { return base + (long)((t >> 1) - 2) * (lda * 2) + (t & 1) * (BK * 2); } };

template <class Epi, class Sched, class AP, bool GATHER, bool ALIGN_EPI, int EB = 2>
__device__ __forceinline__ void gemm_phase(LAS unsigned char* lds, const int wave, const char* base, const int lda, const int ldb, const int K, const Sched& S, const Epi& E) {
    const __amdgpu_buffer_rsrc_t rsrc = __builtin_amdgcn_make_buffer_rsrc((void*)base, (short)0, -1, 0x00020000);
    const int wid = __builtin_amdgcn_readfirstlane(wave), lane = lane_id(), tid = wid * 64 + lane, wr = wid >> 2, wc = wid & 3, fr = lane & 15, fq = lane >> 4;
    const int nt = K / BK;
    unsigned vA[2][2], vAn[2][2], vB[2], vB1[2];
#pragma unroll
    for (int i = 0; i < 2; ++i) { int R, C; stage_rc(tid * 16 + i * 8192, R, C); const int Rb = Epi::PERM ? ((R & ~31) + perm32(R & 31)) : R;
        if constexpr (perm16_v<Epi>) { const int wcR = R >> 5, rho = R & 31, n_ = rho >> 4, i_ = rho & 15; const int src0 = 64 * wcR + 16 * (i_ >> 2) + 4 * n_ + (i_ & 3);
            vB[i] = (unsigned)(src0 * ldb + C) * 2u; vB1[i] = (unsigned)((src0 + 8) * ldb + C) * 2u; }
        else { vB[i] = (unsigned)(Rb * ldb + C) * 2u; vB1[i] = 0u; }
#pragma unroll
        for (int h = 0; h < 2; ++h) { vA[h][i] = GATHER ? (unsigned)C * 2u : (h == 0 ? (unsigned)(R * lda + C) * 2u : 0u); vAn[h][i] = vA[h][i]; } }
    const size_t kstep = (size_t)(BK * 2), hstepB = (size_t)HALFT * ldb * 2, hB1 = perm16_v<Epi> ? 0 : hstepB;
    const unsigned (&vBs)[2] = perm16_v<Epi> ? vB1 : vB;
    const unsigned (&vA1)[2] = GATHER ? vA[1] : vA[0]; const size_t hA1 = GATHER ? 0 : (size_t)HALFT * lda * 2;
    const unsigned ldsw = (unsigned)wid * 1024u;
    const int aoff = lds_byte(wr * 64 + fr, fq * 8), boff = lds_byte(wc * 32 + fr, fq * 8);
#define PG8_SA(b, h) (((b) * 2 + (h)) * HTB)
#define PG8_SB(b, h) ((4 + (b) * 2 + (h)) * HTB)
#define PG8_STAGE(bufoff, gbase, voff) do { const int so_ = (int)(unsigned)(size_t)((const char*)(gbase) - base); _Pragma("unroll") for (int _i = 0; _i < 2; ++_i) \
        __builtin_amdgcn_raw_ptr_buffer_load_lds(rsrc, (LAS void*)(lds + (bufoff) + ldsw + _i * 8192), 16, (int)(voff)[_i], so_, 0, 0); } while (0)
#define PG8_LDA(dst, b, h) do { _Pragma("unroll") for (int m = 0; m < 4; ++m) { if constexpr (EB == 2) { _Pragma("unroll") for (int k = 0; k < 2; ++k) dst[m][k] = *(const LAS bf16x8*)(lds + PG8_SA(b, h) + aoff + m * 2048 + k * 1024); } \
        else { const v4i_t lo_ = *(const LAS v4i_t*)(lds + PG8_SA(b, h) + aoff + m * 2048), hi_ = *(const LAS v4i_t*)(lds + PG8_SA(b, h) + aoff + m * 2048 + 1024); dst##8[m] = __builtin_shufflevector(lo_, hi_, 0, 1, 2, 3, 4, 5, 6, 7); } } } while (0)
#define PG8_LDB(dst, b, h) do { _Pragma("unroll") for (int n = 0; n < 2; ++n) { if constexpr (EB == 2) { _Pragma("unroll") for (int k = 0; k < 2; ++k) dst[n][k] = *(const LAS bf16x8*)(lds + PG8_SB(b, h) + boff + n * 2048 + k * 1024); } \
        else { const v4i_t lo_ = *(const LAS v4i_t*)(lds + PG8_SB(b, h) + boff + n * 2048), hi_ = *(const LAS v4i_t*)(lds + PG8_SB(b, h) + boff + n * 2048 + 1024); dst##8[n] = __builtin_shufflevector(lo_, hi_, 0, 1, 2, 3, 4, 5, 6, 7); } } } while (0)
#define PG8_MMA(ai, bj, At, Bt) do { __builtin_amdgcn_s_setprio(1); _Pragma("unroll") for (int m = 0; m < 4; ++m) _Pragma("unroll") for (int n = 0; n < 2; ++n) { \
        if constexpr (EB == 2) { _Pragma("unroll") for (int k = 0; k < 2; ++k) acc[ai][bj][m][n] = __builtin_amdgcn_mfma_f32_16x16x32_bf16(Bt[n][k], At[m][k], acc[ai][bj][m][n], 0, 0, 0); } \
        else acc[ai][bj][m][n] = __builtin_amdgcn_mfma_scale_f32_16x16x128_f8f6f4(Bt##8[n], At##8[m], acc[ai][bj][m][n], 0, 0, 0, 0x7F7F7F7F, 0, 0x7F7F7F7F); } \
        __builtin_amdgcn_s_setprio(0); } while (0)
#define PG8_WAIT_V(n) asm volatile("s_waitcnt vmcnt(" #n ")" ::: "memory")
#define PG8_WAIT_L(n) asm volatile("s_waitcnt lgkmcnt(" #n ")" ::: "memory")
#define PG8_BAR __builtin_amdgcn_s_barrier()
#define PG8_SCHED __builtin_amdgcn_sched_barrier(0)
    Unit cur, nxt; int ui = 0;
    if (!S.next(0, cur)) return;
    f32x4 acc[2][2][4][2];
#pragma unroll
    for (int a = 0; a < 2; ++a)
#pragma unroll
        for (int b = 0; b < 2; ++b)
#pragma unroll
            for (int m = 0; m < 4; ++m)
#pragma unroll
                for (int n = 0; n < 2; ++n) acc[a][b][m][n] = (f32x4){0.f, 0.f, 0.f, 0.f};
    bf16x8 At[4][2], B0[2][2], B1[2][2]; v8i_t At8[4], B08[2], B18[2];
    if constexpr (GATHER) {
#pragma unroll
        for (int h = 0; h < 2; ++h)
#pragma unroll
            for (int i = 0; i < 2; ++i) { int R_, C_; stage_rc(tid * 16 + i * 8192, R_, C_); vA[h][i] = (unsigned)S.row(cur, h * HALFT + R_) * (unsigned)(lda * 2) + (unsigned)C_ * 2u; vAn[h][i] = vA[h][i]; }
        PG8_WAIT_V(0);
    }
    const char* cA = cur.A; const char* cB = cur.B;
    PG8_STAGE(PG8_SB(0, 0), cB, vB); PG8_STAGE(PG8_SB(0, 1), cB + hB1, vBs); PG8_STAGE(PG8_SA(0, 0), AP::kt(cA, 0, lda), vA[0]); PG8_STAGE(PG8_SA(0, 1), AP::kt(cA, 0, lda) + hA1, vA1);
    if (wr == 1) PG8_BAR;
    PG8_WAIT_V(2); PG8_BAR;
    PG8_STAGE(PG8_SB(1, 0), cB + kstep, vB); PG8_STAGE(PG8_SA(1, 0), AP::kt(cA, 1, lda), vA[0]); PG8_STAGE(PG8_SB(1, 1), cB + hB1 + kstep, vBs);
    PG8_WAIT_V(6); PG8_BAR;
    for (;;) {
        const bool has_next = S.next(ui + 1, nxt);
        const char* nA = has_next ? nxt.A : cA; const char* nB = has_next ? nxt.B : cB;
        if constexpr (GATHER) {
            if (has_next) {
#pragma unroll
                for (int h = 0; h < 2; ++h)
#pragma unroll
                    for (int i = 0; i < 2; ++i) { int R_, C_; stage_rc(tid * 16 + i * 8192, R_, C_); vAn[h][i] = (unsigned)S.row(nxt, h * HALFT + R_) * (unsigned)(lda * 2) + (unsigned)C_ * 2u; }
                PG8_WAIT_V(0);
            }
        }
#pragma unroll 1
        for (int t = 0; t < nt; t += 2) {
            const bool last = (t == nt - 2);
            const char* a1 = AP::kt(cA, t + 1, lda);
            const char* a2 = last ? AP::kt(nA, 0, lda) : AP::kt(cA, t + 2, lda); const char* a3 = last ? AP::kt(nA, 1, lda) : AP::kt(cA, t + 3, lda);
            const char* b2 = last ? nB : cB + (size_t)(t + 2) * kstep; const char* b3 = b2 + kstep;
            PG8_LDB(B0, 0, 0); PG8_LDB(B1, 0, 1); PG8_SCHED; PG8_LDA(At, 0, 0); PG8_STAGE(PG8_SA(1, 1), a1 + hA1, vA1);
            if constexpr (GATHER) { if (last) { _Pragma("unroll") for (int h = 0; h < 2; ++h) _Pragma("unroll") for (int i = 0; i < 2; ++i) vA[h][i] = vAn[h][i]; } }
            PG8_WAIT_V(8); PG8_WAIT_L(0); PG8_BAR; PG8_MMA(0, 0, At, B0); PG8_MMA(0, 1, At, B1); PG8_BAR; PG8_SCHED;
            PG8_LDA(At, 0, 1); PG8_STAGE(PG8_SB(0, 0), b2, vB); PG8_STAGE(PG8_SB(0, 1), b2 + hB1, vBs); PG8_STAGE(PG8_SA(0, 0), a2, vA[0]);
            PG8_WAIT_V(8); PG8_WAIT_L(0); PG8_BAR; PG8_MMA(1, 0, At, B0); PG8_MMA(1, 1, At, B1); PG8_BAR; PG8_SCHED;
            PG8_LDB(B0, 1, 0); PG8_LDB(B1, 1, 1); PG8_SCHED; PG8_LDA(At, 1, 0); PG8_STAGE(PG8_SA(0, 1), a2 + hA1, vA1);
            PG8_WAIT_V(8); PG8_WAIT_L(0); PG8_BAR; PG8_MMA(0, 0, At, B0); PG8_MMA(0, 1, At, B1); PG8_BAR; PG8_SCHED;
            PG8_LDA(At, 1, 1); PG8_STAGE(PG8_SB(1, 0), b3, vB); PG8_STAGE(PG8_SB(1, 1), b3 + hB1, vBs); PG8_STAGE(PG8_SA(1, 0), a3, vA[0]);
            PG8_WAIT_V(8); PG8_WAIT_L(0); PG8_BAR; PG8_MMA(1, 0, At, B0); PG8_MMA(1, 1, At, B1); PG8_BAR; PG8_SCHED;
        }
        if constexpr (ALIGN_EPI) { if (wr == 0) PG8_BAR; }
        { const int l2_ = lane_id();
          E(acc, cur, wr, wc, l2_ & 15, l2_ >> 4);
#ifdef PROBE_EPI2
          if (Epi::PROBE2) { asm volatile("s_waitcnt vmcnt(0)" ::: "memory"); E(acc, cur, wr, wc, l2_ & 15, l2_ >> 4); }
#endif
          }
        if (!has_next) break;
#pragma unroll
        for (int a = 0; a < 2; ++a)
#pragma unroll
            for (int b = 0; b < 2; ++b)
#pragma unroll
                for (int m = 0; m < 4; ++m)
#pragma unroll
                    for (int n = 0; n < 2; ++n) acc[a][b][m][n] = (f32x4){0.f, 0.f, 0.f, 0.f};
        cur = nxt; cA = nA; cB = nB; ++ui;
        if constexpr (GATHER) {
#pragma unroll
            for (int h = 0; h < 2; ++h)
#pragma unroll
                for (int i = 0; i < 2; ++i) vA[h][i] = vAn[h][i];
        }
        if constexpr (ALIGN_EPI) { if (wr == 1) PG8_BAR; }
    }
    PG8_WAIT_V(0);
    if constexpr (!ALIGN_EPI) { if (wr == 0) PG8_BAR; }
    PG8_BAR;
#undef PG8_SA
#undef PG8_SB
#undef PG8_STAGE
#undef PG8_LDA
#undef PG8_LDB
#undef PG8_MMA
#undef PG8_WAIT_V
#undef PG8_WAIT_L
#undef PG8_BAR
#undef PG8_SCHED
}

struct DenseOrder {
    const char* A; const char* B; int nM, nN, G, c; long a_tile, b_tile;
    __device__ __forceinline__ bool next(int i, Unit& u) const { const long L = (long)i * G + c; if (L >= (long)nM * nN) return false; int pm, pn; tile_of((int)L, nM, nN, pm, pn);
        u.pm = pm; u.pn = pn; u.e = 0; u.r0 = pm * BM; u.A = A + (size_t)pm * a_tile; u.B = B + (size_t)pn * b_tile; return true; }
    __device__ __forceinline__ int row(const Unit&, int) const { return 0; }
};
}
namespace pg8 {
typedef const f32x4 (&AccRef)[2][2][4][2];
__device__ __forceinline__ const LAS int* lds_tab() { unsigned a; asm volatile("v_mov_b32 %0, %1" : "=v"(a) : "i"(TAB_OFF)); return (const LAS int*)(size_t)a; }
__device__ __forceinline__ v4u pack8(const f32x4 a, const f32x4 b) { v4u w; w.x = cvt_pk_bf16(a[0], a[1]); w.y = cvt_pk_bf16(a[2], a[3]); w.z = cvt_pk_bf16(b[0], b[1]); w.w = cvt_pk_bf16(b[2], b[3]); return w; }

struct EpiOut {
    static constexpr bool PERM = false; static constexpr bool PROBE2 = false;
    const float* Xin; float* Xout; const float* g;
    __device__ __forceinline__ void operator()(AccRef acc, const Unit& u, int wr, int wc, int fr, int fq) const {
        const int b = u.r0 / S; const int col0 = u.pn * BM + wc * 32 + 4 * fq; f32x4 gv[2][2];
#pragma unroll
        for (int bj = 0; bj < 2; ++bj)
#pragma unroll
            for (int n = 0; n < 2; ++n) gv[bj][n] = *(const f32x4*)(g + (size_t)b * 6 * D + col0 + bj * HALFT + n * 16);
#pragma unroll
        for (int ai = 0; ai < 2; ++ai) { f32x4 xi[4][2][2];
#pragma unroll
            for (int m = 0; m < 4; ++m) { const size_t off = (size_t)(u.r0 + ai * HALFT + wr * 64 + m * 16 + fr) * D + col0;
#pragma unroll
                for (int bj = 0; bj < 2; ++bj)
#pragma unroll
                    for (int n = 0; n < 2; ++n) xi[m][bj][n] = __builtin_nontemporal_load((const f32x4*)(Xin + off + bj * HALFT + n * 16)); }
#pragma unroll
            for (int m = 0; m < 4; ++m) { const size_t off = (size_t)(u.r0 + ai * HALFT + wr * 64 + m * 16 + fr) * D + col0;
#pragma unroll
                for (int bj = 0; bj < 2; ++bj)
#pragma unroll
                    for (int n = 0; n < 2; ++n) *(f32x4*)(Xout + off + bj * HALFT + n * 16) = xi[m][bj][n] + gv[bj][n] * acc[ai][bj][m][n]; }
            asm volatile("" ::: "memory"); }
    }
};
struct EpiG1 {
    static constexpr bool PERM = true; static constexpr bool PROBE2 = false;
    bf16_t* proj; bf16_t* lxp; float* ssq;
    __device__ __forceinline__ void operator()(AccRef acc, const Unit& u, int wr, int wc, int fr, int fq) const {
        const int pn = u.pn; const int c0 = pn * BM + wc * 32 + 8 * fq; const int NT_LAT = (QR + KVR) / BM, NT_X = LW / BM;
#pragma unroll
        for (int ai = 0; ai < 2; ++ai)
#pragma unroll
            for (int m = 0; m < 4; ++m) { const int row = u.r0 + ai * HALFT + wr * 64 + m * 16 + fr; float ss = 0.f;
#pragma unroll
                for (int bj = 0; bj < 2; ++bj) { f32x4 v0 = acc[ai][bj][m][0], v1 = acc[ai][bj][m][1];
                    if (pn < NT_LAT) { ss += (v0[0] * v0[0] + v0[1] * v0[1]) + (v0[2] * v0[2] + v0[3] * v0[3]) + (v1[0] * v1[0] + v1[1] * v1[1]) + (v1[2] * v1[2] + v1[3] * v1[3]); }
                    if (pn >= NT_LAT + NT_X) {
#pragma unroll
                        for (int j = 0; j < 4; ++j) { v0[j] = fast_gelu_tanh(v0[j]); v1[j] = fast_gelu_tanh(v1[j]); } }
                    const v4u w = pack8(v0, v1);
                    *(v4u*)(proj + (size_t)row * P0_N + c0 + bj * HALFT) = w;
                    if (pn >= NT_LAT && pn < NT_LAT + NT_X) { const int b = row / S, t = row % S; *(v4u*)(lxp + ((size_t)b * (S + 4) + 2 + t) * LW + (c0 + bj * HALFT - (QR + KVR))) = w; } }
                if (pn < NT_LAT) { ss += __shfl_xor(ss, 16); ss += __shfl_xor(ss, 32); if (fq == 0) ssq[(size_t)row * 16 + pn * 4 + wc] = ss; } }
    }
};
struct EpiG2 {
    static constexpr bool PERM = true; static constexpr bool PROBE2 = false;
    bf16_t* Q; bf16_t* KC; bf16_t* V; const float* ssq; const float* cosr; const float* sinr; float qs;
    __device__ __forceinline__ void operator()(AccRef acc, const Unit& u, int wr, int wc, int fr, int fq) const {
        const int pn = u.pn; const int NQ_N = H_A * NOPE / BM, NQ = H_A * QK / BM;
#pragma unroll
        for (int ai = 0; ai < 2; ++ai)
#pragma unroll
            for (int m = 0; m < 4; ++m) { const int row = u.r0 + ai * HALFT + wr * 64 + m * 16 + fr;
                if (pn < NQ_N) { const float rs = 1.0f / sqrtf(ssq8(ssq + (size_t)row * 16) * (1.0f / QR) + EPS) * qs;
#pragma unroll
                    for (int bj = 0; bj < 2; ++bj) { const int h = 2 * pn + bj; *(v4u*)(Q + ((size_t)row * H_A + h) * QK + wc * 32 + 8 * fq) = pack8(acc[ai][bj][m][0] * rs, acc[ai][bj][m][1] * rs); } }
                else if (pn < NQ) { const float rs = 1.0f / sqrtf(ssq8(ssq + (size_t)row * 16) * (1.0f / QR) + EPS) * qs; const int h = 4 * (pn - NQ_N) + wc, t = row % S;
                    const f32x4 c0 = *(const f32x4*)(cosr + t * (ROPE / 2) + 8 * fq), c1 = *(const f32x4*)(cosr + t * (ROPE / 2) + 8 * fq + 4), s0 = *(const f32x4*)(sinr + t * (ROPE / 2) + 8 * fq), s1 = *(const f32x4*)(sinr + t * (ROPE / 2) + 8 * fq + 4);
                    const f32x4 x10 = acc[ai][0][m][0] * rs, x11 = acc[ai][0][m][1] * rs, x20 = acc[ai][1][m][0] * rs, x21 = acc[ai][1][m][1] * rs;
                    bf16_t* q = Q + ((size_t)row * H_A + h) * QK + NOPE + 8 * fq;
                    *(v4u*)q = pack8(x10 * c0 - x20 * s0, x11 * c1 - x21 * s1); *(v4u*)(q + ROPE / 2) = pack8(x20 * c0 + x10 * s0, x21 * c1 + x11 * s1); }
                else { const float rs = 1.0f / sqrtf(ssq8(ssq + (size_t)row * 16 + 8) * (1.0f / KVR) + EPS); const int h = pn - NQ;
                    *(v4u*)(KC + ((size_t)row * H_A + h) * QK + wc * 32 + 8 * fq) = pack8(acc[ai][0][m][0] * rs, acc[ai][0][m][1] * rs);
                    *(v4u*)(V + ((size_t)row * H_A + h) * VD + wc * 32 + 8 * fq) = pack8(acc[ai][1][m][0] * rs, acc[ai][1][m][1] * rs); } }
    }
};
struct OrderG2 {
    const char* A; const char* Bq; const char* Bkv; int G, c;
    __device__ __forceinline__ bool next(int i, Unit& u) const { const int nN = (H_A * QK + H_A * (NOPE + VD)) / BM, nM = M / BM; const long L = (long)i * G + c; if (L >= (long)nM * nN) return false; int pm, pn; tile_of((int)L, nM, nN, pm, pn);
        const int NQ = H_A * QK / BM; u.pm = pm; u.pn = pn; u.e = 0; u.r0 = pm * BM; u.A = A + (size_t)pm * BM * P0_N * 2 + (pn < NQ ? 0 : QR * 2);
        u.B = pn < NQ ? Bq + (size_t)pn * BM * QR * 2 : Bkv + (size_t)(pn - NQ) * BM * KVR * 2; return true; }
    __device__ __forceinline__ int row(const Unit&, int) const { return 0; }
};
struct EpiGates {
    static constexpr bool PERM = true; static constexpr bool PROBE2 = false;
    bf16_t* LA; bf16_t* U; const bf16_t* lxp; const float* gb; const float* cl; const float* convw; const float* convb;
    __device__ __forceinline__ void operator()(AccRef acc, const Unit& u, int wr, int wc, int fr, int fq) const {
        const int g = u.pn >> 1, d = u.pn & 1; const int ch0 = g * LBS + wc * 32 + 8 * fq; const int b = u.r0 / S;
        f32x4 ba[2], bx[2], clv[2], cb[2], cw[4][2];
#pragma unroll
        for (int n = 0; n < 2; ++n) { const int ch = ch0 + 4 * n; ba[n] = *(const f32x4*)(gb + (d * 2 + 0) * LW + ch); bx[n] = *(const f32x4*)(gb + (d * 2 + 1) * LW + ch); clv[n] = *(const f32x4*)(cl + d * LW + ch); cb[n] = *(const f32x4*)(convb + ch);
#pragma unroll
            for (int j = 0; j < 4; ++j) cw[j][n] = *(const f32x4*)(convw + j * LW + ch); }
#pragma unroll
        for (int ai = 0; ai < 2; ++ai)
#pragma unroll
            for (int m = 0; m < 4; ++m) { const int row = u.r0 + ai * HALFT + wr * 64 + m * 16 + fr; const int t = row % S; f32x4 la[2], uu[2], xc[2] = {cb[0], cb[1]};
                v4u raw[4];
#pragma unroll
                for (int j = 0; j < 4; ++j) raw[j] = *(const v4u*)(lxp + ((size_t)b * (S + 4) + t + j) * LW + ch0);
#pragma unroll
                for (int j = 0; j < 4; ++j)
#pragma unroll
                    for (int n = 0; n < 2; ++n) { const unsigned r0_ = raw[j][2 * n], r1_ = raw[j][2 * n + 1];
                        xc[n][0] += cw[j][n][0] * __uint_as_float(r0_ << 16); xc[n][1] += cw[j][n][1] * __uint_as_float(r0_ & 0xffff0000u); xc[n][2] += cw[j][n][2] * __uint_as_float(r1_ << 16); xc[n][3] += cw[j][n][3] * __uint_as_float(r1_ & 0xffff0000u); }
#pragma unroll
                for (int n = 0; n < 2; ++n)
#pragma unroll
                    for (int j = 0; j < 4; ++j) { const float l = clv[n][j] * fast_sigm(acc[ai][0][m][n][j] + ba[n][j]); const float x2 = 2.0f * l;
                        const float em = -x2 * (1.0f + 0.5f * x2 * (1.0f + (1.0f / 3.0f) * x2 * (1.0f + 0.25f * x2 * (1.0f + 0.2f * x2))));
                        la[n][j] = l; uu[n][j] = sqrtf(em) * fast_sigm(acc[ai][1][m][n][j] + bx[n][j]) * xc[n][j]; }
                const long o = lru_idx(d, b, t, ch0); *(v4u*)(LA + o) = pack8(la[0], la[1]); *(v4u*)(U + o) = pack8(uu[0], uu[1]); }
    }
};
struct OrderGates {
    const char* lxp; const char* B; int G, c;
    __device__ __forceinline__ bool next(int i, Unit& u) const { const int nN = 2 * (LW / LBS), nM = M / BM; const long L = (long)i * G + c; if (L >= (long)nM * nN) return false; int pm, pn; tile_of((int)L, nM, nN, pm, pn);
        u.pm = pm; u.pn = pn; u.e = 0; u.r0 = pm * BM; const int b = u.r0 / S, t0 = u.r0 % S, g = pn >> 1;
        u.A = lxp + (((size_t)b * (S + 4) + 2 + t0) * LW + g * LBS) * 2; u.B = B + (size_t)pn * BM * (4 * LBS) * 2; return true; }
    __device__ __forceinline__ int row(const Unit&, int) const { return 0; }
};
struct EpiG3 {
    static constexpr bool PERM = true; static constexpr bool PROBE2 = false;
    bf16_t* proj; const float* cost; const float* sint; float sqs;
    __device__ __forceinline__ void operator()(AccRef acc, const Unit& u, int wr, int wc, int fr, int fq) const {
        const int pn = u.pn; const int NH = H_C * DK / BM;
#pragma unroll
        for (int ai = 0; ai < 2; ++ai)
#pragma unroll
            for (int m = 0; m < 4; ++m) { const int row = u.r0 + ai * HALFT + wr * 64 + m * 16 + fr; bf16_t* p = proj + (size_t)row * CD_N + pn * BM + wc * 32 + 8 * fq;
                if (pn < 2 * NH) { const int t = row % S, i0 = wc * 32 + 8 * fq; const float sc = pn < NH ? 1.0f : 1.0f / sqrtf((float)DK);
                    const f32x4 c0 = *(const f32x4*)(cost + t * (DK / 2) + i0) * sc, c1 = *(const f32x4*)(cost + t * (DK / 2) + i0 + 4) * sc, s0 = *(const f32x4*)(sint + t * (DK / 2) + i0) * sc, s1 = *(const f32x4*)(sint + t * (DK / 2) + i0 + 4) * sc;
                    const f32x4 x10 = acc[ai][0][m][0], x11 = acc[ai][0][m][1], x20 = acc[ai][1][m][0], x21 = acc[ai][1][m][1];
                    *(v4u*)p = pack8(x10 * c0 - x20 * s0, x11 * c1 - x21 * s1); *(v4u*)(p + HALFT) = pack8(x20 * c0 + x10 * s0, x21 * c1 + x11 * s1); }
                else {
#pragma unroll
                    for (int bj = 0; bj < 2; ++bj) { f32x4 v0 = acc[ai][bj][m][0], v1 = acc[ai][bj][m][1];
                        if (pn >= 3 * NH && pn < 4 * NH) {
#pragma unroll
                            for (int j = 0; j < 4; ++j) { v0[j] = fast_silu(v0[j]); v1[j] = fast_silu(v1[j]); } }
                        else if (pn >= 4 * NH && pn < 4 * NH + H_D * HDS / BM) { v0 = v0 * sqs; v1 = v1 * sqs; }
                        *(v4u*)(p + bj * HALFT) = pack8(v0, v1); } } }
    }
};
struct OrderMoe {
    const LAS int* offt; const char* A; const char* B; const int* tok; int npn, G, c, gather; long b_exp, b_tile, a_tile;
    __device__ __forceinline__ bool next(int i, Unit& u) const { const long L = (long)i * G + c; const int T = (int)(L / npn); if (T >= offt[E + 1]) return false; const int e = ((const LAS unsigned char*)(offt + 2 * E + 4))[T];
        u.e = e; u.pn = (int)(L % npn); u.pm = T - offt[e]; u.r0 = T * BM; u.A = gather ? A : A + (size_t)T * a_tile; u.B = B + (size_t)e * b_exp + (size_t)u.pn * b_tile; return true; }
    __device__ __forceinline__ int row(const Unit& u, int r) const { const int rank = u.pm * BM + r; if (u.e == E) return rank; const int n = offt[E + 2 + u.e]; return rank < n ? tok[(size_t)u.e * M + rank] : 0; }
};
__device__ __forceinline__ float sat_fp8(float v) { return __builtin_amdgcn_fmed3f(v, -448.0f, 448.0f); }
__device__ __forceinline__ unsigned pack_fp8x4(float a, float b, float c, float d) { int w = __builtin_amdgcn_cvt_pk_fp8_f32(sat_fp8(a), sat_fp8(b), 0, false); return (unsigned)__builtin_amdgcn_cvt_pk_fp8_f32(sat_fp8(c), sat_fp8(d), w, true); }
constexpr float F8_H = 4.0f, F8_GU = 32.0f, F8_ACT = 8.0f, F8_DN = 16.0f, F8_Y = 16.0f;
struct EpiM1F8 {
    static constexpr bool PERM = true; static constexpr bool PROBE2 = false;
    unsigned char* ws;
    __device__ __forceinline__ void operator()(AccRef acc, const Unit& u, int wr, int wc, int fr, int fq) const {
        constexpr float inv = 1.0f / (F8_H * F8_GU); unsigned char* act = ws + WS_ACT;
#pragma unroll
        for (int ai = 0; ai < 2; ++ai)
#pragma unroll
            for (int m = 0; m < 4; ++m) { const int row = u.r0 + ai * HALFT + wr * 64 + m * 16 + fr; f32x4 v[2];
#pragma unroll
                for (int n = 0; n < 2; ++n)
#pragma unroll
                    for (int j = 0; j < 4; ++j) v[n][j] = fast_silu(acc[ai][0][m][n][j] * inv) * (acc[ai][1][m][n][j] * (inv * F8_ACT));
                u32x2 w; w.x = pack_fp8x4(v[0][0], v[0][1], v[0][2], v[0][3]); w.y = pack_fp8x4(v[1][0], v[1][1], v[1][2], v[1][3]);
                *(u32x2*)(act + (size_t)row * FF + u.pn * HALFT + wc * 32 + 8 * fq) = w; }
    }
};
template <int NPN, bool GATH, size_t A_OFF, size_t B_OFF, long B_EXP, long B_TILE, long A_TILE>
struct OrderMoeT {
    const unsigned char* ws; int G, c;
    __device__ __forceinline__ bool next(int i, Unit& u) const { const LAS int* offt = lds_tab();
#ifdef MOE_CONTIG
        if (i >= c) return false; const int L = G + i; const int T = L / NPN;
#else
        const long L = (long)i * G + c; const int T = (int)(L / NPN); if (T >= __builtin_amdgcn_readfirstlane(offt[E + 1])) return false;
#endif
        const int e = __builtin_amdgcn_readfirstlane((int)((const LAS unsigned char*)(offt + 2 * E + 4))[T]);
        u.e = e; u.pn = (int)(L % NPN); u.pm = T - __builtin_amdgcn_readfirstlane(offt[e]); u.r0 = T * BM; u.A = (const char*)ws + A_OFF + (GATH ? 0 : (size_t)T * A_TILE); u.B = (const char*)ws + B_OFF + (size_t)e * B_EXP + (size_t)u.pn * B_TILE; return true; }
    __device__ __forceinline__ int row(const Unit& u, int r) const { const int rank = u.pm * BM + r; if (u.e == E) return rank; const int n = lds_tab()[E + 2 + u.e]; return rank < n ? ((const int*)(ws + WS_TOK))[(size_t)u.e * M + rank] : 0; }
};
struct EpiM2F8 {
    static constexpr bool PERM = true; static constexpr bool PERM16 = true; static constexpr bool PROBE2 = false;
    unsigned char* ws;
    __device__ __forceinline__ void operator()(AccRef acc, const Unit& u, int wr, int wc, int fr, int fq) const {
        constexpr float w = F8_Y / (F8_ACT * F8_DN); unsigned char* Y = ws + WS_Y;
#pragma unroll
        for (int ai = 0; ai < 2; ++ai)
#pragma unroll
            for (int m = 0; m < 4; ++m) { const int rr = ai * HALFT + wr * 64 + m * 16 + fr; v4u o;
#pragma unroll
                for (int bj = 0; bj < 2; ++bj) { const f32x4 a = acc[ai][bj][m][0] * w, b = acc[ai][bj][m][1] * w; o[2 * bj] = pack_fp8x4(a[0], a[1], a[2], a[3]); o[2 * bj + 1] = pack_fp8x4(b[0], b[1], b[2], b[3]); }
                *(v4u*)(Y + (size_t)(u.r0 + rr) * D + u.pn * BM + wc * 64 + 16 * fq) = o; }
    }
};
struct EpiM1 {
    static constexpr bool PERM = true; static constexpr bool PROBE2 = false;
    bf16_t* act;
    __device__ __forceinline__ void operator()(AccRef acc, const Unit& u, int wr, int wc, int fr, int fq) const {
#pragma unroll
        for (int ai = 0; ai < 2; ++ai)
#pragma unroll
            for (int m = 0; m < 4; ++m) { const int row = u.r0 + ai * HALFT + wr * 64 + m * 16 + fr; f32x4 v[2];
#pragma unroll
                for (int n = 0; n < 2; ++n)
#pragma unroll
                    for (int j = 0; j < 4; ++j) v[n][j] = fast_silu(acc[ai][0][m][n][j]) * acc[ai][1][m][n][j];
                *(v4u*)(act + (size_t)row * FF + u.pn * HALFT + wc * 32 + 8 * fq) = pack8(v[0], v[1]); }
    }
};
struct EpiM2 {
    static constexpr bool PERM = true; static constexpr bool PROBE2 = false;
    bf16_t* Y; const float* wt; const LAS int* offt; float osc;
    __device__ __forceinline__ void operator()(AccRef acc, const Unit& u, int wr, int wc, int fr, int fq) const {
        float w8[2][4]; const int nrow = u.e < E ? offt[E + 2 + u.e] : M;
#pragma unroll
        for (int ai = 0; ai < 2; ++ai)
#pragma unroll
            for (int m = 0; m < 4; ++m) { const int rank = u.pm * BM + ai * HALFT + wr * 64 + m * 16 + fr; w8[ai][m] = (u.e < E ? (rank < nrow ? wt[(size_t)u.e * M + rank] : 0.f) : 1.0f) * osc; }
#pragma unroll
        for (int ai = 0; ai < 2; ++ai)
#pragma unroll
            for (int m = 0; m < 4; ++m) { const int rr = ai * HALFT + wr * 64 + m * 16 + fr; const float w = w8[ai][m];
#pragma unroll
                for (int bj = 0; bj < 2; ++bj) *(v4u*)(Y + (size_t)(u.r0 + rr) * D + u.pn * BM + bj * HALFT + wc * 32 + 8 * fq) = pack8(acc[ai][bj][m][0] * w, acc[ai][bj][m][1] * w); }
    }
};
}

struct Frame { LAS unsigned char* lds; Ctx c; int wave, vcu, G;
    __device__ __forceinline__ int lane() const { return lane_id(); }
    __device__ __forceinline__ int tid() const { return wave * 64 + lane_id(); } };

struct CvtDesc { const float* src; unsigned char* dst; const float* sc; int ldw, Kd, f8; float mul; };
__device__ __forceinline__ void cvt_load(const CvtDesc& d, float (&v)[32], int lane) {
    const float* p = d.src + (size_t)(lane >> 3) * d.ldw + 4 * (lane & 7);
#pragma unroll
    for (int i = 0; i < 8; ++i) { const f32x4 t = __builtin_nontemporal_load((const f32x4*)(p + (size_t)(8 * i) * d.ldw));     v[4 * i] = t[0]; v[4 * i + 1] = t[1]; v[4 * i + 2] = t[2]; v[4 * i + 3] = t[3]; }
}
__device__ __forceinline__ void cvt_finish(const CvtDesc& d, float (&v)[32], LAS float* scr, int lane) {
    const int kr = lane >> 3, n4 = 4 * (lane & 7);
#pragma unroll
    for (int i = 0; i < 8; ++i) { const float m = (d.sc ? d.sc[8 * i + kr] : 1.0f) * d.mul;
#pragma unroll
        for (int e = 0; e < 4; ++e) scr[(8 * i + kr) * 33 + n4 + e] = v[4 * i + e] * m; }
    LDS_WAIT(); asm volatile("" ::: "memory");
    const int cc = lane & 7;
#pragma unroll
    for (int j = 0; j < 4; ++j) { const int n = (lane >> 3) + 8 * j; const LAS float* s = scr + (8 * cc) * 33 + n;
        if (d.f8) { u32x2 o; o.x = pg8::pack_fp8x4(s[0 * 33], s[1 * 33], s[2 * 33], s[3 * 33]); o.y = pg8::pack_fp8x4(s[4 * 33], s[5 * 33], s[6 * 33], s[7 * 33]); __builtin_nontemporal_store(o, (u32x2*)(d.dst + (size_t)n * d.Kd + 8 * cc)); }
        else { v4u o; o.x = cvt_pk_bf16(s[0 * 33], s[1 * 33]); o.y = cvt_pk_bf16(s[2 * 33], s[3 * 33]); o.z = cvt_pk_bf16(s[4 * 33], s[5 * 33]); o.w = cvt_pk_bf16(s[6 * 33], s[7 * 33]); __builtin_nontemporal_store(o, (v4u*)(d.dst + (size_t)n * d.Kd + 16 * cc)); } }
    LDS_WAIT(); asm volatile("" ::: "memory");
}
__device__ __forceinline__ CvtDesc mk_desc(const float* src, int ldw, int k0, int ns0, void* dst, int Kd_elems, int nd0, int kd0, const float* sc, int f8 = 0, float mul = 1.0f) {
    CvtDesc d; d.src = src + (size_t)k0 * ldw + ns0; d.ldw = ldw; d.f8 = f8; d.mul = mul; d.sc = sc ? sc + k0 : nullptr; const int eb = f8 ? 1 : 2; d.Kd = Kd_elems * eb;
    d.dst = (unsigned char*)dst + ((size_t)nd0 * Kd_elems + kd0 + k0) * eb; return d; }
constexpr long cnt_items(int K, int N) { return (long)(K / 64) * (N / 32); }
constexpr long IT_INAB = 0, IT_UQ = IT_INAB + cnt_items(D, AB_N), IT_UKV = IT_UQ + cnt_items(QR, H_A * QK), IT_LRU = IT_UKV + cnt_items(KVR, H_A * (NOPE + VD)),
    IT_OUTAB = IT_LRU + (long)2 * (LW / LBS) * 2 * 4 * cnt_items(LBS, LBS), IT_RT = IT_OUTAB + cnt_items(D, D), IT_GU0 = IT_RT + 2 * cnt_items(D, E), IT_DN0 = IT_GU0 + (long)(E + 1) * 2 * cnt_items(D, FF),
    IT_INCD = IT_DN0 + (long)(E + 1) * cnt_items(FF, D), IT_OUTCD = IT_INCD + cnt_items(D, CD_N), IT_GU1 = IT_OUTCD + cnt_items(D, D), IT_DN1 = IT_GU1 + (long)(E + 1) * 2 * cnt_items(D, FF), IT_END = IT_DN1 + (long)(E + 1) * cnt_items(FF, D);
__device__ __forceinline__ CvtDesc p0_desc(const Ctx& c, long it) {
#ifdef MOE_FP8
    constexpr int MF8 = 1; constexpr float MGU = pg8::F8_GU, MDN = pg8::F8_DN;
#else
    constexpr int MF8 = 0; constexpr float MGU = 1.0f, MDN = 1.0f;
#endif
    const int sub = (int)(it & 1);
    if (it < IT_UQ) { const long r = (it - IT_INAB) >> 1; constexpr int NBK = AB_N / 32; const int kb = 2 * (int)(r / NBK) + sub, nb = (int)(r % NBK); const int col = nb * 32; const int drow = col < QR + KVR ? col : (col < QR + KVR + ROPE ? P0_N + col - (QR + KVR) : col - ROPE);
        return mk_desc(c.in[I_WINAB], AB_N, kb * 64, col, WSP(bf16_t, W_INAB), D, drow, 0, nullptr); }
    if (it < IT_UKV) { const long r = (it - IT_UQ) >> 1; constexpr int NBK = H_A * QK / 32; const int kb = 2 * (int)(r / NBK) + sub, db = (int)(r % NBK); const int v = db * 32; int scol;
        if (v < H_A * NOPE) { const int h = v / NOPE, d0 = v % NOPE; scol = h * QK + d0; }
        else { const int v2 = v - H_A * NOPE; const int tq = v2 / 256, half = (v2 % 256) / 128, hq = (v2 % 128) / 32; scol = (4 * tq + hq) * QK + NOPE + (ROPE / 2) * half; }
        return mk_desc(c.in[I_WUQ], H_A * QK, kb * 64, scol, WSP(bf16_t, W_UQ), QR, v, 0, c.in[I_QLN]); }
    if (it < IT_LRU) { const long r = (it - IT_UKV) >> 1; constexpr int NBK = H_A * (NOPE + VD) / 32; const int kb = 2 * (int)(r / NBK) + sub, nb = (int)(r % NBK);
        return mk_desc(c.in[I_WUKV], H_A * (NOPE + VD), kb * 64, nb * 32, WSP(bf16_t, W_UKV), KVR, nb * 32, 0, c.in[I_KVLN]); }
    if (it < IT_OUTAB) { const long r = (it - IT_LRU) >> 1; constexpr int NBK = LBS / 32, PER = (LBS / 128) * NBK; const int q = (int)(r / PER), w = (int)(r % PER); const int tap = q & 3, half = (q >> 2) & 1, tq = q >> 3, g = tq >> 1, d = tq & 1; const int kb = 2 * (w / NBK) + sub, nb = w % NBK;
        const float* src = (half ? c.in[I_LWX] : c.in[I_LWA]) + ((size_t)(d * (LW / LBS) + g) * LBS) * LBS;
        return mk_desc(src, LBS, kb * 64, nb * 32, WSP(bf16_t, W_LRU) + (size_t)tq * 2 * LBS * 4 * LBS, 4 * LBS, half * LBS + nb * 32, tap * LBS, c.in[I_CONVW] + tap * LW + g * LBS); }
    if (it < IT_RT) { const long r = (it - IT_OUTAB) >> 1; constexpr int NBK = D / 32; return mk_desc(c.in[I_WOUTAB], D, (2 * (int)(r / NBK) + sub) * 64, (int)(r % NBK) * 32, WSP(bf16_t, W_OUTAB), D, (int)(r % NBK) * 32, 0, nullptr); }
    if (it < IT_GU0) { const long r = (it - IT_RT) >> 1; constexpr int NBK = E / 32; constexpr long PER = (long)(D / 128) * NBK; const int l = (int)(r / PER); const long w = r % PER;
        return mk_desc(c.in[I_WROUTER] + (size_t)l * D * E, E, (2 * (int)(w / NBK) + sub) * 64, (int)(w % NBK) * 32, WSP(bf16_t, W_RT) + (size_t)l * E * D, D, (int)(w % NBK) * 32, 0, nullptr); }
    if (it < IT_INCD || (it >= IT_GU1)) {
        const int l = it >= IT_GU1 ? 1 : 0; const long base_gu = l ? IT_GU1 : IT_GU0, base_dn = l ? IT_DN1 : IT_DN0;
        if (it < base_dn) { const long r = (it - base_gu) >> 1; constexpr int NBK = FF / 32; constexpr long PER = (long)(D / 128) * NBK; const long q = r / PER, w = r % PER; const int up = (int)(q & 1), e = (int)(q >> 1); const int kb = 2 * (int)(w / NBK) + sub, nb = (int)(w % NBK); const int col = nb * 32;
            const float* src = e < E ? (up ? c.in[I_WUP] : c.in[I_WGATE]) + ((size_t)l * E + e) * D * FF : (up ? c.in[I_WSU] : c.in[I_WSG]) + (size_t)l * D * FF;
            return mk_desc(src, FF, kb * 64, col, c.ws + W_GU + ((size_t)l * (E + 1) + e) * 2 * FF * D * (MF8 ? 1 : 2), D, (col / 128) * 256 + up * 128 + (col % 128), 0, nullptr, MF8, MGU); }
        { const long r = (it - base_dn) >> 1; constexpr int NBK = D / 32; constexpr long PER = (long)(FF / 128) * NBK; const int e = (int)(r / PER); const long w = r % PER;
            const float* src = e < E ? c.in[I_WDOWN] + ((size_t)l * E + e) * FF * D : c.in[I_WSD] + (size_t)l * FF * D;
            return mk_desc(src, D, (2 * (int)(w / NBK) + sub) * 64, (int)(w % NBK) * 32, c.ws + W_DN + ((size_t)l * (E + 1) + e) * D * FF * (MF8 ? 1 : 2), FF, (int)(w % NBK) * 32, 0, nullptr, MF8, MDN); } }
    if (it < IT_OUTCD) { const long r = (it - IT_INCD) >> 1; constexpr int NBK = CD_N / 32; return mk_desc(c.in[I_WINCD], CD_N, (2 * (int)(r / NBK) + sub) * 64, (int)(r % NBK) * 32, WSP(bf16_t, W_INCD), D, (int)(r % NBK) * 32, 0, nullptr); }
    { const long r = (it - IT_OUTCD) >> 1; constexpr int NBK = D / 32; return mk_desc(c.in[I_WOUTCD], D, (2 * (int)(r / NBK) + sub) * 64, (int)(r % NBK) * 32, WSP(bf16_t, W_OUTCD), D, (int)(r % NBK) * 32, 0, nullptr); }
}
__device__ __forceinline__ void conv_items(Frame& F, long lo, long hi, int pidx = -1, int np = 0) {
    if (pidx < 0) { pidx = F.vcu; np = F.G; }
    const Ctx& c = F.c; LAS float* scr = (LAS float*)(F.lds + F.wave * 16384); const int lane = F.lane(); const long step = 2 * (long)np * NWAVES;
    long it = lo + 2 * ((long)pidx * NWAVES + F.wave); float va[32], vb[32];
    if (it < hi) { CvtDesc da = p0_desc(c, it); cvt_load(da, va, lane);
        for (;;) {
            CvtDesc db = p0_desc(c, it + 1); cvt_load(db, vb, lane);
            cvt_finish(da, va, scr, lane);
            const long i2 = it + step; const bool h2 = i2 < hi; if (h2) { da = p0_desc(c, i2); cvt_load(da, va, lane); }
            cvt_finish(db, vb, scr, lane); if (!h2) break;
            it = i2; } }
}
__device__ __forceinline__ void conv_slice(Frame& F, long lo, long hi, int k0, int k1, int n, int pidx = -1, int np = 0) { const long npair = (hi - lo) / 2; conv_items(F, lo + 2 * (npair * k0 / n), lo + 2 * (npair * k1 / n), pidx, np); }
__device__ __forceinline__ void mod_units(Frame& F, int l) {
    const Ctx& c = F.c; LAS float* cact = (LAS float*)F.lds; LAS float* red = (LAS float*)(F.lds + 65536);
    for (int i = F.tid(); i < NB * D; i += NTHR) cact[i] = siluf(c.in[I_C][i]);
    __syncthreads();
    constexpr int UW = 48, NU = 6 * D / UW, KW = D / NWAVES; static_assert(6 * D % UW == 0 && KW % 64 == 0 && NB * UW <= NTHR, "mod units");
    for (int u = F.vcu; u < NU; u += F.G) { const int col0 = u * UW; const int rg = F.lane() >> 4, cl = (F.lane() & 15) < 12 ? (F.lane() & 15) : 11;
        const float* w = c.in[I_WMOD] + (size_t)l * D * 6 * D + col0 + 4 * cl; f32x4 a[NB];
#pragma unroll
        for (int b = 0; b < NB; ++b) a[b] = f32x4{0.f, 0.f, 0.f, 0.f};
        const int kbeg = F.wave * KW + rg;
#pragma unroll 1
        for (int i0 = 0; i0 < KW / 4; i0 += 16) { f32x4 wv[16];
#pragma unroll
            for (int j = 0; j < 16; ++j) wv[j] = __builtin_nontemporal_load((const f32x4*)(w + (size_t)(kbeg + 4 * (i0 + j)) * 6 * D));
#pragma unroll
            for (int j = 0; j < 16; ++j) { const int k = kbeg + 4 * (i0 + j);
#pragma unroll
                for (int b = 0; b < NB; ++b) a[b] += wv[j] * cact[b * D + k]; } }
#pragma unroll
        for (int b = 0; b < NB; ++b)
#pragma unroll
            for (int q = 0; q < 4; ++q) { float s = a[b][q]; s += __shfl_xor(s, 16); s += __shfl_xor(s, 32); a[b][q] = s; }
        if (F.lane() < 12) {
#pragma unroll
            for (int b = 0; b < NB; ++b) *(LAS f32x4*)(red + (F.wave * NB + b) * UW + 4 * F.lane()) = a[b]; }
        __syncthreads();
        if (F.tid() < NB * UW) { const int b = F.tid() / UW, cc = F.tid() % UW; float s = c.in[I_BMOD][l * 6 * D + col0 + cc];
#pragma unroll
            for (int w8 = 0; w8 < NWAVES; ++w8) s += red[(w8 * NB + b) * UW + cc];
            WSP(float, WS_MOD)[((size_t)l * NB + b) * 6 * D + col0 + cc] = s; }
        __syncthreads();
    }
    __syncthreads();
}

__device__ __forceinline__ void p0_phase(Frame& F) {
    const Ctx& c = F.c;
    mod_units(F, 0);
#ifndef SPREAD_CONV
    mod_units(F, 1);
#endif
    const long gt = (long)F.vcu * NTHR + F.tid(), NGT = (long)F.G * NTHR;
    for (long i = gt; i < (long)S * (ROPE / 2 + DK / 2); i += NGT) { TabF f; f.c = c; f(i); }
    static_assert(LBS % 64 == 0 && LBS % NWAVES == 0, "gate bias units");
    for (int u = F.vcu; u < 4 * LW / 64; u += F.G) { const int i = u * 64 + F.lane(); const int ch = i % LW, half = (i / LW) & 1, d = i / (2 * LW); const int g = ch / LBS, j = ch % LBS;
        LAS float* red = (LAS float*)(F.lds + 65536);
        const float* wm = (half ? c.in[I_LWX] : c.in[I_LWA]) + ((size_t)(d * (LW / LBS) + g) * LBS) * LBS + j; float s = 0.f;
#pragma unroll
        for (int kk = 0; kk < LBS / NWAVES; ++kk) { const int k = F.wave * (LBS / NWAVES) + kk; s += c.in[I_CONVB][g * LBS + k] * wm[(size_t)k * LBS]; }
        red[F.wave * 64 + F.lane()] = s; __syncthreads();
        if (F.wave == 0) { float t = (half ? c.in[I_LBX] : c.in[I_LBA])[d * LW + ch];
#pragma unroll
            for (int w8 = 0; w8 < NWAVES; ++w8) t += red[w8 * 64 + F.lane()];
            WSP(float, W_GB)[i] = t; }
        __syncthreads(); }
    for (long i = gt; i < 2 * LW; i += NGT) WSP(float, W_GB)[4 * LW + i] = -8.0f * log1pf(expf(-c.in[I_LLAM][i]));
    for (long i = gt; i < (long)NB * 4 * LW; i += NGT) { const int b = (int)(i / (4 * LW)), rr = (int)((i / LW) % 4), ch = (int)(i % LW); WSP(bf16_t, WS_LXP)[((size_t)b * (S + 4) + (rr < 2 ? rr : S + rr)) * LW + ch] = 0; }
    __syncthreads();
#ifdef SPREAD_CONV
    conv_items(F, IT_INAB, IT_OUTAB);
#else
    conv_items(F, IT_INAB, IT_END);
#endif
}
__device__ __forceinline__ void build_offt(Frame& F, int l) {
    LAS int* offt = (LAS int*)(F.lds + TAB_OFF); static_assert(E <= 64, "one lane per routed expert");
    if (F.wave == 0) { const int lane = F.lane(); LAS unsigned char* texp = (LAS unsigned char*)(offt + 2 * E + 4);
        const int n = lane < E ? __hip_atomic_load((const int*)(F.c.ws + CTL_CNT) + cnt_idx(l, lane), RLX_AGENT) : 0; const int nt = (n + RT - 1) / RT; int inc = nt;
#pragma unroll
        for (int o = 1; o < 64; o <<= 1) { const int v = __shfl_up(inc, o); if (lane >= o) inc += v; }
        const int off = inc - nt, tot = __shfl(inc, 63); constexpr int NTS = (M + RT - 1) / RT;
        if (lane < E) { offt[lane] = off; offt[E + 2 + lane] = n; for (int t = 0; t < nt; ++t) texp[off + t] = (unsigned char)lane; }
        if (lane == 0) { offt[E] = tot; offt[E + 1] = tot + NTS; }
        for (int t = lane; t < NTS; t += 64) texp[tot + t] = (unsigned char)E; }
    __syncthreads();
}

__device__ __forceinline__ void modulate_row(const float* xrow, const float* gain, const float* sc, const float* sh, bf16_t* orow, int lane, unsigned char* orow8 = nullptr) {
    f32x4 v[D / 256]; float s = 0.f;
#pragma unroll
    for (int j = 0; j < D / 256; ++j) { v[j] = *((const f32x4*)xrow + lane + 64 * j); s += (v[j][0] * v[j][0] + v[j][1] * v[j][1]) + (v[j][2] * v[j][2] + v[j][3] * v[j][3]); }
    const float r = 1.0f / sqrtf(wave_sum(s) * (1.0f / D) + EPS);
#pragma unroll
    for (int j = 0; j < D / 256; ++j) { const int col = 4 * lane + 256 * j; const f32x4 g = *(const f32x4*)(gain + col), a = *(const f32x4*)(sc + col), b = *(const f32x4*)(sh + col);
        const f32x4 o = v[j] * r * g * (1.0f + a) + b; u32x2 w; w.x = cvt_pk_bf16(o[0], o[1]); w.y = cvt_pk_bf16(o[2], o[3]); *(u32x2*)(orow + col) = w;
        if (orow8) *(unsigned*)(orow8 + col) = pg8::pack_fp8x4(o[0] * pg8::F8_H, o[1] * pg8::F8_H, o[2] * pg8::F8_H, o[3] * pg8::F8_H); }
}
template <int NR> __device__ __forceinline__ void modulate_rows(const float* X, int m0, const float* gain, const float* sc, const float* sh, bf16_t* HM, unsigned char* HM8, int lane) {
    f32x4 v[NR][D / 256]; float s[NR];
#pragma unroll
    for (int r = 0; r < NR; ++r) { s[r] = 0.f;
#pragma unroll
        for (int j = 0; j < D / 256; ++j) v[r][j] = __builtin_nontemporal_load((const f32x4*)(X + (size_t)(m0 + r) * D) + lane + 64 * j); }
#pragma unroll
    for (int r = 0; r < NR; ++r)
#pragma unroll
        for (int j = 0; j < D / 256; ++j) s[r] += (v[r][j][0] * v[r][j][0] + v[r][j][1] * v[r][j][1]) + (v[r][j][2] * v[r][j][2] + v[r][j][3] * v[r][j][3]);
#pragma unroll
    for (int o = 1; o < 64; o <<= 1)
#pragma unroll
        for (int r = 0; r < NR; ++r) s[r] += __shfl_xor(s[r], o);
#pragma unroll
    for (int j = 0; j < D / 256; ++j) { const int col = 4 * lane + 256 * j; const f32x4 g = *(const f32x4*)(gain + col), a = *(const f32x4*)(sc + col), b = *(const f32x4*)(sh + col);
#pragma unroll
        for (int r = 0; r < NR; ++r) { const float rs = 1.0f / sqrtf(s[r] * (1.0f / D) + EPS); const f32x4 o = v[r][j] * rs * g * (1.0f + a) + b; u32x2 w; w.x = cvt_pk_bf16(o[0], o[1]); w.y = cvt_pk_bf16(o[2], o[3]);
            *(u32x2*)(HM + (size_t)(m0 + r) * D + col) = w;
            if (HM8) *(unsigned*)(HM8 + (size_t)(m0 + r) * D + col) = pg8::pack_fp8x4(o[0] * pg8::F8_H, o[1] * pg8::F8_H, o[2] * pg8::F8_H, o[3] * pg8::F8_H); } }
}
__device__ __forceinline__ void modulate_phase(Frame& F, const float* X, const float* gain, const float* sc, const float* sh) {
    const int gw = F.vcu * NWAVES + F.wave, NGW = F.G * NWAVES;
    for (int m0 = 4 * gw; m0 < M; m0 += 4 * NGW) { const int b = m0 / S;
        modulate_rows<4>(X, m0, gain, sc + (size_t)b * 6 * D, sh + (size_t)b * 6 * D, (bf16_t*)(F.c.ws + WS_HM), nullptr, F.lane()); }
}
__device__ __forceinline__ void skinny32x64(Frame& F, const bf16_t* A, const bf16_t* Bt) {
    const int r = F.lane() & 31, h = F.lane() >> 5; constexpr int KW = D / NWAVES; const int k0 = F.wave * KW;
    f32x16 acc0 = {}, acc1 = {};
    const bf16_t* ap = A + (size_t)r * D + k0 + 8 * h; const bf16_t* b0p = Bt + (size_t)r * D + k0 + 8 * h; const bf16_t* b1p = Bt + (size_t)(32 + r) * D + k0 + 8 * h;
#pragma unroll 8
    for (int s = 0; s < KW / 16; ++s) { const bf16x8 a = *(const bf16x8*)(ap + 16 * s), b0 = *(const bf16x8*)(b0p + 16 * s), b1 = *(const bf16x8*)(b1p + 16 * s);
        acc0 = __builtin_amdgcn_mfma_f32_32x32x16_bf16(a, b0, acc0, 0, 0, 0); acc1 = __builtin_amdgcn_mfma_f32_32x32x16_bf16(a, b1, acc1, 0, 0, 0); }
    LAS float* red = (LAS float*)F.lds;
#pragma unroll
    for (int q = 0; q < 16; ++q) { const int row = (q & 3) + 8 * (q >> 2) + 4 * h; red[(F.wave * 32 + row) * 64 + r] = acc0[q]; red[(F.wave * 32 + row) * 64 + 32 + r] = acc1[q]; }
    __syncthreads();
    LAS float* res = (LAS float*)(F.lds + 65536);
    { const int row = F.tid() >> 4, c4 = (F.tid() & 15) * 4; f32x4 s = *(const LAS f32x4*)(red + row * 64 + c4);
#pragma unroll
      for (int w = 1; w < NWAVES; ++w) s += *(const LAS f32x4*)(red + (w * 32 + row) * 64 + c4);
      *(LAS f32x4*)(res + row * 64 + c4) = s; }
    __syncthreads();
}
__device__ __forceinline__ void krope_units(Frame& F) {
    const Ctx& c = F.c;
    for (int u = F.vcu; u < M / 32; u += F.G) { const int row0 = u * 32;
        skinny32x64(F, WSP(bf16_t, WS_HM) + (size_t)row0 * D, WSP(bf16_t, W_INAB) + (size_t)P0_N * D);
        const LAS float* res = (const LAS float*)(F.lds + 65536);
        { const int row = F.tid() >> 4, i0 = (F.tid() & 15) * 2; const int m = row0 + row, t = m % S; float o1[2], o2[2];
#pragma unroll
          for (int q = 0; q < 2; ++q) { const int ii = i0 + q; const float x1 = res[row * 64 + ii], x2 = res[row * 64 + 32 + ii], cs = WSP(float, WS_TAB + TAB_CR)[t * (ROPE / 2) + ii], sn = WSP(float, WS_TAB + TAB_SR)[t * (ROPE / 2) + ii];
              o1[q] = x1 * cs - x2 * sn; o2[q] = x2 * cs + x1 * sn; }
          const unsigned w1 = cvt_pk_bf16(o1[0], o1[1]), w2 = cvt_pk_bf16(o2[0], o2[1]);
#pragma unroll
          for (int hh = 0; hh < H_A; ++hh) { bf16_t* K = WSP(bf16_t, WS_KC) + ((size_t)m * H_A + hh) * QK + NOPE; *(unsigned*)(K + i0) = w1; *(unsigned*)(K + ROPE / 2 + i0) = w2; } }
        __syncthreads();
    }
}
__device__ __forceinline__ float wave_max(float v) {
#pragma unroll
    for (int o = 1; o < 64; o <<= 1) v = fmaxf(v, __shfl_xor(v, o));
    return v; }
__device__ __forceinline__ void route_phase(Frame& F, int l) {
    const Ctx& c = F.c; const float* mod = WSP(float, WS_MOD) + (size_t)l * NB * 6 * D; const float* X1 = WSP(float, WS_X1);
    for (int u = F.vcu; u < M / 32; u += F.G) { const int row0 = u * 32;
        { const int m0 = row0 + F.wave * 4; const int b = m0 / S;
          modulate_rows<4>(X1, m0, c.in[I_NFFN] + l * D, mod + (size_t)b * 6 * D + 4 * D, mod + (size_t)b * 6 * D + 3 * D, WSP(bf16_t, WS_HM), WSP(unsigned char, WS_HM8), F.lane()); }
        __syncthreads();
        skinny32x64(F, WSP(bf16_t, WS_HM) + (size_t)row0 * D, WSP(bf16_t, W_RT) + (size_t)l * E * D);
        const LAS float* res = (const LAS float*)(F.lds + 65536);
        int* cnt = WSP(int, CTL_CNT); LAS int* lcnt = (LAS int*)(F.lds + 65536 + 8192);
        if (F.tid() < E) lcnt[F.tid()] = 0;
        __syncthreads();
        int pe[4], pr[4]; float pw[4];
        { const int lane = F.lane(), grp = lane >> 3; float sg[4], bz[4], gs[4]; unsigned gsel[4]; const float rb = c.in[I_RBIAS][l * E + lane];
#pragma unroll
          for (int q = 0; q < 4; ++q) { const int row = F.wave * 4 + q; sg[q] = 1.0f / (1.0f + expf(-res[row * 64 + lane])); bz[q] = sg[q] + rb; }
          { float m1[4], m2[4];
#pragma unroll
            for (int q = 0; q < 4; ++q) m1[q] = bz[q];
#pragma unroll
            for (int o = 1; o < 8; o <<= 1)
#pragma unroll
                for (int q = 0; q < 4; ++q) m1[q] = fmaxf(m1[q], __shfl_xor(m1[q], o));
#pragma unroll
            for (int q = 0; q < 4; ++q) { const unsigned long long eq1 = __ballot(bz[q] == m1[q]); const int first = __builtin_ctz((unsigned)((eq1 >> (grp * 8)) & 0xffull)); m2[q] = ((lane & 7) == first) ? -INFINITY : bz[q]; }
#pragma unroll
            for (int o = 1; o < 8; o <<= 1)
#pragma unroll
                for (int q = 0; q < 4; ++q) m2[q] = fmaxf(m2[q], __shfl_xor(m2[q], o));
#pragma unroll
            for (int q = 0; q < 4; ++q) { gs[q] = m1[q] + m2[q]; gsel[q] = 0u; } }
#pragma unroll 1
          for (int it = 0; it < TG; ++it) { float cand[4], mx[4];
#pragma unroll
              for (int q = 0; q < 4; ++q) { cand[q] = ((gsel[q] >> grp) & 1u) ? -INFINITY : gs[q]; mx[q] = cand[q]; }
#pragma unroll
              for (int o = 1; o < 64; o <<= 1)
#pragma unroll
                  for (int q = 0; q < 4; ++q) mx[q] = fmaxf(mx[q], __shfl_xor(mx[q], o));
#pragma unroll
              for (int q = 0; q < 4; ++q) { const unsigned long long eq = __ballot(cand[q] == mx[q]); gsel[q] |= 1u << (__builtin_ctzll(eq) >> 3); } }
          unsigned long long taken[4]; float wsum[4], my_s[4]; int my_e[4];
#pragma unroll
          for (int q = 0; q < 4; ++q) { taken[q] = 0ull; wsum[q] = 0.f; my_s[q] = 0.f; my_e[q] = 0; }
#pragma unroll 1
          for (int k = 0; k < TOPK; ++k) { float cand[4], mx[4];
#pragma unroll
              for (int q = 0; q < 4; ++q) { cand[q] = (((gsel[q] >> grp) & 1u) && !((taken[q] >> lane) & 1ull)) ? bz[q] : -INFINITY; mx[q] = cand[q]; }
#pragma unroll
              for (int o = 1; o < 64; o <<= 1)
#pragma unroll
                  for (int q = 0; q < 4; ++q) mx[q] = fmaxf(mx[q], __shfl_xor(mx[q], o));
#pragma unroll
              for (int q = 0; q < 4; ++q) { const unsigned long long eq = __ballot(cand[q] == mx[q]); const int ek = __builtin_ctzll(eq); taken[q] |= 1ull << ek; const float sk = __shfl(sg[q], ek); wsum[q] += sk; if (lane == k) { my_e[q] = ek; my_s[q] = sk; } } }
#pragma unroll
          for (int q = 0; q < 4; ++q) { pe[q] = my_e[q]; pw[q] = my_s[q] / wsum[q] * 2.5f; pr[q] = 0;
              if (lane < TOPK) pr[q] = __hip_atomic_fetch_add(lcnt + my_e[q], 1, __ATOMIC_RELAXED, __HIP_MEMORY_SCOPE_WORKGROUP); } }
        __syncthreads();
        if (F.tid() < E) { const int n = lcnt[F.tid()]; lcnt[E + F.tid()] = n > 0 ? atomicAdd(cnt + cnt_idx(l, F.tid()), n) : 0; }
        __syncthreads();
#pragma unroll
        for (int q = 0; q < 4; ++q) { const int m = row0 + F.wave * 4 + q; const int lane = F.lane();
            if (lane < TOPK) { const int rank = lcnt[E + pe[q]] + pr[q];
                WSP(int, WS_SELE)[(size_t)m * TOPK + lane] = pe[q]; WSP(int, WS_SELR)[(size_t)m * TOPK + lane] = rank; WSP(float, WS_SELW)[(size_t)m * TOPK + lane] = pw[q];
                WSP(int, WS_TOK)[(size_t)pe[q] * M + rank] = m; WSP(float, WS_WT)[(size_t)pe[q] * M + rank] = pw[q]; } }
        __syncthreads();
    }
}
__device__ __forceinline__ void combine_phase(Frame& F, int l) {
    build_offt(F, l);
    const Ctx& c = F.c; const LAS int* offt = (const LAS int*)(F.lds + TAB_OFF); const float* X1 = WSP(float, WS_X1); float* X2 = WSP(float, WS_X2);
    const float* mod = WSP(float, WS_MOD) + (size_t)l * NB * 6 * D; const float* mod1 = WSP(float, WS_MOD) + (size_t)NB * 6 * D;
    const int gw = F.vcu * NWAVES + F.wave, NGW = F.G * NWAVES; static_assert(D == 2048, "lane l owns columns 16 l .. 16 l + 15 of each 1024-column half");
    for (int m = gw; m < M; m += NGW) { const int b = m / S; const int lane = F.lane();
        int e = 0, r = 0; float wsel = 1.0f; if (lane < TOPK) { e = WSP(int, WS_SELE)[(size_t)m * TOPK + lane]; r = WSP(int, WS_SELR)[(size_t)m * TOPK + lane]; wsel = WSP(float, WS_SELW)[(size_t)m * TOPK + lane]; }
        long rowi = (lane < TOPK) ? (long)offt[e] * RT + r : (long)offt[E] * RT + m;
        f32x4 acc[2][4];
#pragma unroll
        for (int h = 0; h < 2; ++h)
#pragma unroll
            for (int q = 0; q < 4; ++q) acc[h][q] = (f32x4){0.f, 0.f, 0.f, 0.f};
#pragma unroll 3
        for (int k = 0; k <= TOPK; ++k) { const long ri = __shfl(rowi, k); const float wk = __shfl(wsel, k); const unsigned char* yr = WSP(unsigned char, WS_Y) + (size_t)ri * D + 16 * lane;
#pragma unroll
            for (int h = 0; h < 2; ++h) { const v4u raw = __builtin_nontemporal_load((const v4u*)(yr + h * 1024));
#pragma unroll
                for (int q = 0; q < 4; ++q) { const auto lo = __builtin_amdgcn_cvt_pk_f32_fp8((int)raw[q], false), hi = __builtin_amdgcn_cvt_pk_f32_fp8((int)raw[q], true);
                    acc[h][q][0] += wk * lo[0]; acc[h][q][1] += wk * lo[1]; acc[h][q][2] += wk * hi[0]; acc[h][q][3] += wk * hi[1]; } } }
        float s = 0.f;
#pragma unroll
        for (int h = 0; h < 2; ++h)
#pragma unroll
            for (int q = 0; q < 4; ++q) { const int col = h * 1024 + 16 * lane + 4 * q; const f32x4 x = *(const f32x4*)(X1 + (size_t)m * D + col), g = *(const f32x4*)(mod + (size_t)b * 6 * D + 5 * D + col);
                acc[h][q] = x + g * (acc[h][q] * (1.0f / pg8::F8_Y)); s += (acc[h][q][0] * acc[h][q][0] + acc[h][q][1] * acc[h][q][1]) + (acc[h][q][2] * acc[h][q][2] + acc[h][q][3] * acc[h][q][3]);
                if (l == 0) *(f32x4*)(X2 + (size_t)m * D + col) = acc[h][q]; }
        const float rs = 1.0f / sqrtf(wave_sum(s) * (1.0f / D) + EPS);
#pragma unroll
        for (int h = 0; h < 2; ++h) {
            if (l == 0) { v4u w[2];
#pragma unroll
                for (int q = 0; q < 4; ++q) { const int col = h * 1024 + 16 * lane + 4 * q; const f32x4 g = *(const f32x4*)(c.in[I_NMIX] + D + col), a = *(const f32x4*)(mod1 + (size_t)b * 6 * D + D + col), bb = *(const f32x4*)(mod1 + (size_t)b * 6 * D + col);
                    const f32x4 o = acc[h][q] * rs * g * (1.0f + a) + bb; w[q >> 1][2 * (q & 1)] = cvt_pk_bf16(o[0], o[1]); w[q >> 1][2 * (q & 1) + 1] = cvt_pk_bf16(o[2], o[3]); }
                bf16_t* hp = WSP(bf16_t, WS_HM) + (size_t)m * D + h * 1024 + 16 * lane; *(v4u*)hp = w[0]; *(v4u*)(hp + 8) = w[1]; }
            else {
#pragma unroll
                for (int q = 0; q < 4; ++q) { const int col = h * 1024 + 16 * lane + 4 * q; const f32x4 g = *(const f32x4*)(c.in[I_FNORM] + col); *(f32x4*)(c.out + (size_t)m * D + col) = acc[h][q] * rs * g; } } }
    }
}
__device__ __forceinline__ void retnorm_phase(Frame& F) {
    const Ctx& c = F.c; const int gw = F.vcu * NWAVES + F.wave, NGW = F.G * NWAVES; static_assert(DK == 256, "one f32x4 per lane");
    for (int m = gw; m < M; m += NGW) { f32x4 v[H_C], g[H_C]; u32x2 raw[H_C]; float s[H_C];
#pragma unroll
        for (int h = 0; h < H_C; ++h) { const int col = h * DK + 4 * F.lane(); v[h] = *(const f32x4*)(WSP(float, WS_RET) + (size_t)m * HALF + col); g[h] = *(const f32x4*)(c.in[I_RETGN] + col); raw[h] = *(const u32x2*)(WSP(bf16_t, WS_PROJ) + (size_t)m * CD_N + 3 * H_C * DK + col);
            s[h] = (v[h][0] * v[h][0] + v[h][1] * v[h][1]) + (v[h][2] * v[h][2] + v[h][3] * v[h][3]); }
#pragma unroll
        for (int o = 1; o < 64; o <<= 1)
#pragma unroll
            for (int h = 0; h < H_C; ++h) s[h] += __shfl_xor(s[h], o);
#pragma unroll
        for (int h = 0; h < H_C; ++h) { const int col = h * DK + 4 * F.lane(); const float rs = 1.0f / sqrtf(s[h] * (1.0f / DK) + EPS); f32x4 o = v[h] * rs * g[h];
            o[0] *= __uint_as_float(raw[h].x << 16); o[1] *= __uint_as_float(raw[h].x & 0xffff0000u); o[2] *= __uint_as_float(raw[h].y << 16); o[3] *= __uint_as_float(raw[h].y & 0xffff0000u);
            u32x2 w; w.x = cvt_pk_bf16(o[0], o[1]); w.y = cvt_pk_bf16(o[2], o[3]); *(u32x2*)(WSP(bf16_t, WS_MIX) + (size_t)m * D + col) = w; } }
}
__device__ __forceinline__ void scan_phase(Frame& F) {
    const Ctx& c = F.c; constexpr int NCK = 64, CL = S / NCK, BLK = S * 16 + NCK * 16; static_assert(CL == 32 && 4 * BLK + 4 * NCK * 8 * 4 <= MISC_OFF, "scan LDS map");
    LAS unsigned char* lds = F.lds; LAS float* agg = (LAS float*)(lds + 4 * BLK);
#define SIDX(t) ((t) * 16 + ((t) >> 5) * 16)
    for (int u = F.vcu; u < NB * (LW / 8); u += F.G) { const int b = u / (LW / 8), c8 = u % (LW / 8);
#pragma unroll
        for (int q = 0; q < 4; ++q) { const bf16_t* src = (q & 1 ? WSP(bf16_t, WS_U) : WSP(bf16_t, WS_LA)) + lru_idx(q >> 1, b, 0, c8 * 8);
#pragma unroll
            for (int i = 0; i < S / NTHR; ++i) { const int t = F.tid() + NTHR * i; *(LAS v4u*)(lds + q * BLK + SIDX(t)) = *(const v4u*)(src + (size_t)t * 8); } }
        __syncthreads();
        const int ch = F.tid() & 7, ck = F.tid() >> 3; const LAS bf16_t* laf = (const LAS bf16_t*)(lds) + ch; const LAS bf16_t* uf = (const LAS bf16_t*)(lds + BLK) + ch;
        const LAS bf16_t* lab = (const LAS bf16_t*)(lds + 2 * BLK) + ch; const LAS bf16_t* ub = (const LAS bf16_t*)(lds + 3 * BLK) + ch;
        { float P = 1.f, H = 0.f;
#pragma unroll 8
          for (int i = 0; i < CL; ++i) { const int o = SIDX(ck * CL + i) / 2; const float a = __builtin_amdgcn_exp2f(LOG2E * bf2f(laf[o])); H = a * H + bf2f(uf[o]); P *= a; }
          agg[(0 * NCK + ck) * 8 + ch] = P; agg[(1 * NCK + ck) * 8 + ch] = H; P = 1.f; H = 0.f;
#pragma unroll 8
          for (int i = CL - 1; i >= 0; --i) { const int o = SIDX(ck * CL + i) / 2; const float a = __builtin_amdgcn_exp2f(LOG2E * bf2f(lab[o])); H = a * H + bf2f(ub[o]); P *= a; }
          agg[(2 * NCK + ck) * 8 + ch] = P; agg[(3 * NCK + ck) * 8 + ch] = H; }
        __syncthreads();
        static_assert(NCK == 64 && NWAVES == 8, "one lane per chunk, two (direction, channel) carries per wave");
#pragma unroll
        for (int i = 0; i < 2; ++i) { const int id = F.wave * 2 + i, dir = id >> 3, cc = id & 7; const int lane = F.lane(), k = dir ? NCK - 1 - lane : lane;
            float A = agg[((2 * dir) * NCK + k) * 8 + cc], B = agg[((2 * dir + 1) * NCK + k) * 8 + cc];
#pragma unroll
            for (int o = 1; o < 64; o <<= 1) { const float A2 = __shfl_up(A, o), B2 = __shfl_up(B, o); if (lane >= o) { B = A * B2 + B; A = A * A2; } }
            const float ex = __shfl_up(B, 1); agg[((2 * dir) * NCK + k) * 8 + cc] = lane ? ex : 0.f; }
        __syncthreads();
        { float hf[CL]; float H = agg[(0 * NCK + ck) * 8 + ch];
#pragma unroll
          for (int i = 0; i < CL; ++i) { const int o = SIDX(ck * CL + i) / 2; const float a = __builtin_amdgcn_exp2f(LOG2E * bf2f(laf[o])); H = a * H + bf2f(uf[o]); hf[i] = H; }
          H = agg[(2 * NCK + ck) * 8 + ch]; LAS bf16_t* so = (LAS bf16_t*)(lds + BLK) + ch;
#pragma unroll
          for (int i = CL - 1; i >= 0; --i) { const int o = SIDX(ck * CL + i) / 2; const float a = __builtin_amdgcn_exp2f(LOG2E * bf2f(lab[o])); H = a * H + bf2f(ub[o]); so[o] = f2bf(hf[i] + H); } }
        __syncthreads();
#pragma unroll
        for (int i = 0; i < S / NTHR; ++i) { const int t = F.tid() + NTHR * i; const size_t m = (size_t)b * S + t; const v4u sv = *(const LAS v4u*)(lds + BLK + SIDX(t)); const v4u gv = *(const v4u*)(WSP(bf16_t, WS_PROJ) + m * P0_N + QR + KVR + LW + c8 * 8);
            v4u o;
#pragma unroll
            for (int q = 0; q < 4; ++q) { const float a0 = __uint_as_float(sv[q] << 16) * __uint_as_float(gv[q] << 16), a1 = __uint_as_float(sv[q] & 0xffff0000u) * __uint_as_float(gv[q] & 0xffff0000u); o[q] = cvt_pk_bf16(a0, a1); }
            *(v4u*)(WSP(bf16_t, WS_MIX) + m * D + HALF + c8 * 8) = o; }
        __syncthreads();
    }
#undef SIDX
}
namespace attn {
#define ATT_KSWZ(row, colB, RS) ((row) * (RS) + ((colB) ^ (((row) & 7) << 4)))
__device__ __forceinline__ int crow(int r, int hi) { return (r & 3) + 8 * (r >> 2) + 4 * hi; }
__device__ __forceinline__ int v_st(int k, int c) { const int kk = (k & ~0xC) | ((k & 4) << 1) | ((k & 8) >> 1); return ((kk >> 3) * 4 + (c >> 5)) * 512 + ((kk & 7) * 32 + (c & 31)) * 2; }
__device__ __forceinline__ int v_rd_base(int lane) { return ((lane & 3) << 3) | (((lane >> 2) & 3) << 6) | (((lane >> 4) & 1) << 5) | (((lane >> 5) & 1) << 8); }
constexpr int v_rd_off(int d0, int ks, int half) { return d0 * 512 + ks * 4096 + half * 2048; }
template <int OFF> __device__ __forceinline__ s16x4 tr_read(int vb) { s16x4 r; asm volatile("ds_read_b64_tr_b16 %0, %1 offset:%2" : "=&v"(r) : "v"(vb), "i"(OFF) : "memory"); return r; }
template <int D0> __device__ __forceinline__ void pv_one(f32x16& od, int vb, bf16x8 pa0, bf16x8 pa1, bf16x8 pa2, bf16x8 pa3) {
    const s16x4 l0 = tr_read<v_rd_off(D0, 0, 0)>(vb), h0 = tr_read<v_rd_off(D0, 0, 1)>(vb), l1 = tr_read<v_rd_off(D0, 1, 0)>(vb), h1 = tr_read<v_rd_off(D0, 1, 1)>(vb);
    const s16x4 l2 = tr_read<v_rd_off(D0, 2, 0)>(vb), h2 = tr_read<v_rd_off(D0, 2, 1)>(vb), l3 = tr_read<v_rd_off(D0, 3, 0)>(vb), h3 = tr_read<v_rd_off(D0, 3, 1)>(vb);
    asm volatile("s_waitcnt lgkmcnt(0)" ::: "memory"); __builtin_amdgcn_sched_barrier(0);
#define ATT_PK(L, H) (bf16x8){L[0], L[1], L[2], L[3], H[0], H[1], H[2], H[3]}
    od = __builtin_amdgcn_mfma_f32_32x32x16_bf16(pa0, ATT_PK(l0, h0), od, 0, 0, 0);
    od = __builtin_amdgcn_mfma_f32_32x32x16_bf16(pa1, ATT_PK(l1, h1), od, 0, 0, 0);
    od = __builtin_amdgcn_mfma_f32_32x32x16_bf16(pa2, ATT_PK(l2, h2), od, 0, 0, 0);
    od = __builtin_amdgcn_mfma_f32_32x32x16_bf16(pa3, ATT_PK(l3, h3), od, 0, 0, 0);
#undef ATT_PK
}
template <int DQK, int MODE>
__device__ __forceinline__ void attn_unit(LAS unsigned char* lds, const int wave, const bf16_t* Qb, int ldq, const bf16_t* Kh, int ldk, const bf16_t* Vh, int ldv, int key0, int ntiles, int q0,
                                          float pa_, float pb_, bf16_t* Ob, float* Of, int ldo) {
    constexpr int KB = 64 * DQK * 2, VB = 64 * 128 * 2, NKP = DQK / 8, KPT = DQK / 64, RS = DQK * 2;
    constexpr int OFF_V = 2 * KB, OFF_WS = OFF_V + 2 * VB, OFF_LUT = OFF_WS + NWAVES * 64 * 4;
    const int wid = __builtin_amdgcn_readfirstlane(wave), lane = lane_id(), tid = wid * 64 + lane, r32 = lane & 31, hi = lane >> 5;
    LAS unsigned char* Kl = lds; LAS unsigned char* Vl = lds + OFF_V; LAS float* wsf = (LAS float*)(lds + OFF_WS) + wid * 64; const LAS float* lut = (const LAS float*)(lds + OFF_LUT);
    float m_reg = (MODE == 1) ? pa_ : -1e30f, l_reg = (MODE == 1) ? 1.0f : 0.f;
    f32x16 o[4] = {}; bf16x8 qr[DQK / 16];
    { const bf16_t* Qw = Qb + (size_t)(wid * 32 + r32) * ldq + hi * 8;
#pragma unroll
      for (int d0 = 0; d0 < DQK / 16; ++d0) qr[d0] = *(const bf16x8*)(Qw + d0 * 16); }
    constexpr bool REGK = (NTHR % NKP == 0) && ((NTHR / NKP) % 8 == 0);
    int koff[REGK ? 1 : KPT], kdst[REGK ? 1 : KPT];
#pragma unroll
    for (int i = 0; i < (REGK ? 1 : KPT); ++i) { const int p = tid + NTHR * i, key = p / NKP, c8 = p % NKP; koff[i] = key * ldk + c8 * 8; kdst[i] = ATT_KSWZ(key, c8 * 16, RS); }
#define ATT_KOFF(i) (REGK ? koff[0] + (i) * (NTHR / NKP) * ldk : koff[REGK ? 0 : (i)])
#define ATT_KDST(i) (REGK ? kdst[0] + (i) * (NTHR / NKP) * RS : kdst[REGK ? 0 : (i)])
    const int sr = tid >> 4, sc = (tid & 15) * 8, vst0 = v_st(sr, sc), vst1 = vst0 + 8192;
    const int vb0 = (int)(unsigned)(uintptr_t)Vl + v_rd_base(lane);
    bf16x8 ks[KPT], vs0, vs1;
#define ATT_SLOAD(kb) do { _Pragma("unroll") for (int i = 0; i < KPT; ++i) ks[i] = *(const bf16x8*)(Kh + (size_t)(kb) * ldk + ATT_KOFF(i)); \
        vs0 = *(const bf16x8*)(Vh + (size_t)((kb) + sr) * ldv + sc); vs1 = *(const bf16x8*)(Vh + (size_t)((kb) + 32 + sr) * ldv + sc); } while (0)
#define ATT_SWRITE(b) do { _Pragma("unroll") for (int i = 0; i < KPT; ++i) *(LAS bf16x8*)(Kl + (b) * KB + ATT_KDST(i)) = ks[i]; \
        *(LAS bf16x8*)(Vl + (b) * VB + vst0) = vs0; *(LAS bf16x8*)(Vl + (b) * VB + vst1) = vs1; } while (0)
    ATT_SLOAD(key0); ATT_SWRITE(0); __syncthreads();
    for (int j = 0; j < ntiles; ++j) {
        const int cur = j & 1; const int kb = key0 + j * 64;
        if (j + 1 < ntiles) ATT_SLOAD(kb + 64);
        bool live = true;
        if constexpr (MODE == 1) { const int qlo = q0 + wid * 32; live = (kb + 63 >= qlo - WIN) && (kb <= qlo + 31 + WIN); }
        if (live) {
        f32x16 p0 = {}, p1 = {};
        { const LAS unsigned char* Ks = Kl + cur * KB;
#pragma unroll
          for (int d0 = 0; d0 < DQK / 16; ++d0) { const int cb = (d0 * 16 + hi * 8) * 2;
              const bf16x8 b0 = *(const LAS bf16x8*)(Ks + ATT_KSWZ(r32, cb, RS)), b1 = *(const LAS bf16x8*)(Ks + ATT_KSWZ(32 + r32, cb, RS));
              p0 = __builtin_amdgcn_mfma_f32_32x32x16_bf16(b0, qr[d0], p0, 0, 0, 0); p1 = __builtin_amdgcn_mfma_f32_32x32x16_bf16(b1, qr[d0], p1, 0, 0, 0); } }
        if constexpr (MODE == 2) {
            const int dq = kb - (q0 + wid * 32 + r32);
#pragma unroll
            for (int r = 0; r < 16; ++r) { const int rel0 = dq + crow(r, hi), rel1 = rel0 + 32;
                p0[r] *= __builtin_amdgcn_exp2f((rel0 <= 0 ? pa_ : pb_) * (float)rel0); p1[r] *= __builtin_amdgcn_exp2f((rel1 <= 0 ? pa_ : pb_) * (float)rel1); }
        } else {
            if constexpr (MODE == 1) { const LAS float* lp = lut + (kb - (q0 + wid * 32 + r32) + 383);
#pragma unroll
                for (int r = 0; r < 16; ++r) { p0[r] += lp[crow(r, hi)]; p1[r] += lp[32 + crow(r, hi)]; } }
            float pmax = p0[0];
#pragma unroll
            for (int r = 1; r < 16; ++r) pmax = fmaxf(pmax, p0[r]);
#pragma unroll
            for (int r = 0; r < 16; ++r) pmax = fmaxf(pmax, p1[r]);
            { auto rr = __builtin_amdgcn_permlane32_swap(__float_as_uint(pmax), __float_as_uint(pmax), false, false); pmax = fmaxf(__uint_as_float(rr[0]), __uint_as_float(rr[1])); }
            float mn, alpha;
            if (__builtin_expect(__all(pmax - m_reg <= 11.5f), 1)) { mn = m_reg; alpha = 1.f; }
            else { mn = fmaxf(m_reg, pmax); alpha = __builtin_amdgcn_exp2f(m_reg - mn); m_reg = mn; }
#pragma unroll
            for (int r = 0; r < 16; ++r) { p0[r] = __builtin_amdgcn_exp2f(p0[r] - mn); p1[r] = __builtin_amdgcn_exp2f(p1[r] - mn); }
            float ps = 0.f;
#pragma unroll
            for (int r = 0; r < 16; ++r) ps += p0[r];
#pragma unroll
            for (int r = 0; r < 16; ++r) ps += p1[r];
            { auto rr = __builtin_amdgcn_permlane32_swap(__float_as_uint(ps), __float_as_uint(ps), false, false); ps = __uint_as_float(rr[0]) + __uint_as_float(rr[1]); }
            l_reg = l_reg * alpha + ps;
            if (__any(alpha < 1.f)) { if (hi == 0) wsf[32 + r32] = alpha; asm volatile("s_waitcnt lgkmcnt(0)" ::: "memory");
#pragma unroll
                for (int r = 0; r < 16; ++r) { const float a = wsf[32 + crow(r, hi)];
#pragma unroll
                    for (int d = 0; d < 4; ++d) o[d][r] *= a; } }
        }
        bf16x8 pa0, pa1, pa2, pa3;
#define ATT_PK4(P, BASE, OUT) do { unsigned a0 = cvt_pk_bf16(P[BASE + 0], P[BASE + 1]), a1 = cvt_pk_bf16(P[BASE + 2], P[BASE + 3]); \
        unsigned b0_ = cvt_pk_bf16(P[BASE + 4], P[BASE + 5]), b1_ = cvt_pk_bf16(P[BASE + 6], P[BASE + 7]); \
        auto r0 = __builtin_amdgcn_permlane32_swap(a0, b0_, false, false); auto r1 = __builtin_amdgcn_permlane32_swap(a1, b1_, false, false); \
        v4u w = {r0[0], r1[0], r0[1], r1[1]}; OUT = *reinterpret_cast<bf16x8*>(&w); } while (0)
        ATT_PK4(p0, 0, pa0); ATT_PK4(p0, 8, pa1); ATT_PK4(p1, 0, pa2); ATT_PK4(p1, 8, pa3);
#undef ATT_PK4
        { const int vb = vb0 + cur * VB; pv_one<0>(o[0], vb, pa0, pa1, pa2, pa3); pv_one<1>(o[1], vb, pa0, pa1, pa2, pa3); pv_one<2>(o[2], vb, pa0, pa1, pa2, pa3); pv_one<3>(o[3], vb, pa0, pa1, pa2, pa3); }
        }
        if (j + 1 < ntiles) ATT_SWRITE(cur ^ 1);
        __syncthreads();
    }
#undef ATT_SLOAD
#undef ATT_SWRITE
#undef ATT_KOFF
#undef ATT_KDST
    if constexpr (MODE == 2) {
#pragma unroll
        for (int r = 0; r < 16; ++r) { float* orow = Of + (size_t)(wid * 32 + crow(r, hi)) * ldo + r32;
#pragma unroll
            for (int d0 = 0; d0 < 4; ++d0) orow[d0 * 32] = o[d0][r]; }
    } else {
        if (hi == 0) wsf[r32] = l_reg; asm volatile("s_waitcnt lgkmcnt(0)" ::: "memory");
#pragma unroll
        for (int r = 0; r < 16; ++r) { const float rl = __builtin_amdgcn_rcpf(wsf[crow(r, hi)]); bf16_t* orow = Ob + (size_t)(wid * 32 + crow(r, hi)) * ldo + r32;
#pragma unroll
            for (int d0 = 0; d0 < 4; ++d0) orow[d0 * 32] = f2bf(o[d0][r] * rl); }
    }
    __syncthreads();
}
#undef ATT_KSWZ
}

__device__ __forceinline__ void att0_phase(Frame& F) {
    const Ctx& c = F.c;
    for (int u = F.vcu; u < NB * H_A * (S / 256); u += F.G) { const int qb = u % (S / 256), h = (u / (S / 256)) % H_A, b = u / ((S / 256) * H_A);
        attn::attn_unit<QK, 0>(F.lds, F.wave, WSP(bf16_t, WS_Q) + ((size_t)(b * S + qb * 256) * H_A + h) * QK, H_A * QK, WSP(bf16_t, WS_KC) + ((size_t)b * S * H_A + h) * QK, H_A * QK,
                               WSP(bf16_t, WS_V) + ((size_t)b * S * H_A + h) * VD, H_A * VD, 0, S / 64, qb * 256, 0.f, 0.f, WSP(bf16_t, WS_MIX) + (size_t)(b * S + qb * 256) * D + h * VD, nullptr, D); }
}
__device__ __forceinline__ void ret1_phase(Frame& F) {
    const Ctx& c = F.c;
    for (int u = F.vcu; u < NB * H_C * (S / 256) * 2; u += F.G) { const int dvh = u & 1, qb = (u >> 1) % (S / 256), h = (u / (2 * (S / 256))) % H_C, b = u / (2 * (S / 256) * H_C);
        const bf16_t* Pb = WSP(bf16_t, WS_PROJ) + (size_t)b * S * CD_N;
        const float lgf = log2f(1.0f - exp2f(-5.0f - (float)h)), lgb = log2f(1.0f - exp2f(-5.0f - (float)(H_C - 1 - h)));
        const int df = (int)(11.0f / -lgf) + 1, db = (int)(11.0f / -lgb) + 1; int t0 = (qb * 256 - df - 63) / 64; if (t0 < 0) t0 = 0; int t1 = (qb * 256 + 255 + db) / 64 + 1; if (t1 > S / 64) t1 = S / 64;
        attn::attn_unit<DK, 2>(F.lds, F.wave, Pb + (size_t)qb * 256 * CD_N + h * DK, CD_N, Pb + H_C * DK + h * DK, CD_N, Pb + 2 * H_C * DK + h * DK + dvh * 128, CD_N, t0 * 64, t1 - t0, qb * 256, -lgf, lgb,
                               nullptr, WSP(float, WS_RET) + (size_t)(b * S + qb * 256) * HALF + h * DK + dvh * 128, HALF); }
}
__device__ __forceinline__ void swa1_phase(Frame& F) {
    const Ctx& c = F.c; constexpr int OFF_LUT = 2 * 64 * HDS * 2 + 2 * 64 * 128 * 2 + NWAVES * 64 * 4; LAS float* lut = (LAS float*)(F.lds + OFF_LUT);
    for (int u = F.vcu; u < NB * H_D * (S / 256); u += F.G) { const int qb = u % (S / 256), hd = (u / (S / 256)) % H_D, b = u / ((S / 256) * H_D); const int kvh = hd / (H_D / KVH);
        for (int i = F.tid(); i < 767; i += NTHR) { const int rel = i - 383; lut[i] = (rel < -WIN || rel > WIN) ? -1e30f : c.in[I_RELB][t5_bucket(rel) * H_D + hd] * LOG2E; }
        __syncthreads();
        const bf16_t* Pb = WSP(bf16_t, WS_PROJ) + (size_t)b * S * CD_N + 4 * H_C * DK;
        const int klo = qb * 256 - WIN < 0 ? 0 : qb * 256 - WIN, khi = qb * 256 + 256 + WIN > S ? S : qb * 256 + 256 + WIN;
        attn::attn_unit<HDS, 1>(F.lds, F.wave, Pb + (size_t)qb * 256 * CD_N + hd * HDS, CD_N, Pb + H_D * HDS + kvh * HDS, CD_N, Pb + H_D * HDS + KVH * HDS + kvh * HDS, CD_N, klo, (khi - klo) / 64, qb * 256,
                                c.in[I_SINKS][hd] * LOG2E, 0.f, WSP(bf16_t, WS_MIX) + (size_t)(b * S + qb * 256) * D + HALF + hd * HDS, nullptr, D); }
}


#ifndef OPT_MASK
#define OPT_MASK 0
#endif
struct MArgs { Ctx c; long ph_lo, ph_hi, use_bar, pad; };
__global__ void __launch_bounds__(NTHR, 2) mega_fwd(MArgs args) {
    extern __shared__ __attribute__((aligned(16))) unsigned char lds_raw[];
    Frame F; F.lds = (LAS unsigned char*)lds_raw; F.c = args.c;
    F.wave = __builtin_amdgcn_readfirstlane((int)threadIdx.x >> 6);
    F.G = gridDim.x; { const int bx = blockIdx.x; F.vcu = (F.G % 8 == 0) ? (bx % 8) * (F.G / 8) + bx / 8 : bx; }
    const Ctx& c = F.c;
    volatile LAS unsigned* MISC = (volatile LAS unsigned*)(F.lds + MISC_OFF);
    for (int u = F.tid(); u < 256; u += NTHR) MISC[u] = 0u;
    __syncthreads();
    XcdBarrier bar; bar.bar = (unsigned*)(c.ws + 16384); bar.x = 0; bar.st = MISC + 8; bar.wave = F.wave;
    if (args.use_bar) bar = xcd_barrier_post((unsigned*)(c.ws + 16384), MISC + 8, F.wave);
    const int lo = (int)args.ph_lo, hi = (int)args.ph_hi;
#define IN(k) (lo <= (k) && (k) < hi)
#define SEAM(k) do { if (IN(k) && IN((k) + 1)) xcd_barrier(bar); } while (0)
    float* mod = WSP(float, WS_MOD);
#ifdef SPREAD_CONV
#define CONV_EARLY(call) do { if (!(blockIdx.x & 1)) { call; __syncthreads(); } } while (0)
#define CONV_LATE(call)  do { if (blockIdx.x & 1) { __syncthreads(); call; __syncthreads(); } } while (0)
#else
#define CONV_EARLY(call) do { } while (0)
#define CONV_LATE(call)  do { } while (0)
#endif
#define CONV_GU0(k0, k1) conv_slice(F, IT_GU0, IT_DN0, k0, k1, 20)
#define CONV_GU1(k0, k1) conv_slice(F, IT_GU1, IT_DN1, k0, k1, 17)

    if (IN(PH_P0)) { p0_phase(F); } SEAM(PH_P0);
#ifdef HAVE_THIN
    if (IN(PH_MOD0)) { modulate_phase(F, c.in[I_X], c.in[I_NMIX], mod + D, mod); } SEAM(PH_MOD0);
#endif
    if (IN(PH_G1)) {
        pg8::DenseOrder S_; S_.A = (const char*)WSP(bf16_t, WS_HM); S_.B = (const char*)WSP(bf16_t, W_INAB); S_.nM = M / 256; S_.nN = P0_N / 256; S_.G = F.G; S_.c = (int)blockIdx.x; S_.a_tile = (long)256 * D * 2; S_.b_tile = (long)256 * D * 2;
        pg8::EpiG1 E_{WSP(bf16_t, WS_PROJ), WSP(bf16_t, WS_LXP), WSP(float, CTL_SSQ)};
        pg8::gemm_phase<pg8::EpiG1, pg8::DenseOrder, pg8::APlain, false, true>(F.lds, F.wave, (const char*)c.ws, D, D, D, S_, E_);
#ifdef HAVE_SKINNY
        krope_units(F);
#endif
#ifdef SPREAD_CONV
        if ((int)blockIdx.x >= F.G / 2) { __syncthreads(); const int pi = (int)blockIdx.x - F.G / 2, np = F.G - F.G / 2;
            conv_items(F, IT_OUTAB, IT_GU0, pi, np); conv_slice(F, IT_GU0, IT_DN0, 0, 4, 20, pi, np); __syncthreads(); }
#endif
    } SEAM(PH_G1);
    if (IN(PH_G2)) {
        CONV_EARLY(CONV_GU0(4, 8));
        { pg8::OrderG2 S_{(const char*)WSP(bf16_t, WS_PROJ), (const char*)WSP(bf16_t, W_UQ), (const char*)WSP(bf16_t, W_UKV), F.G, (int)blockIdx.x};
          pg8::EpiG2 E_{WSP(bf16_t, WS_Q), WSP(bf16_t, WS_KC), WSP(bf16_t, WS_V), WSP(float, CTL_SSQ), WSP(float, WS_TAB + TAB_CR), WSP(float, WS_TAB + TAB_SR), LOG2E / sqrtf((float)QK)};
          pg8::gemm_phase<pg8::EpiG2, pg8::OrderG2, pg8::APlain, false, true>(F.lds, F.wave, (const char*)c.ws, P0_N, QR, QR, S_, E_); }
        { pg8::OrderGates S_{(const char*)WSP(bf16_t, WS_LXP), (const char*)WSP(bf16_t, W_LRU), F.G, (int)((blockIdx.x + F.G / 2) % F.G)};
          pg8::EpiGates E_{WSP(bf16_t, WS_LA), WSP(bf16_t, WS_U), WSP(bf16_t, WS_LXP), WSP(float, W_GB), WSP(float, W_GB) + 4 * LW, c.in[I_CONVW], c.in[I_CONVB]};
          pg8::gemm_phase<pg8::EpiGates, pg8::OrderGates, pg8::AConv, false, true>(F.lds, F.wave, (const char*)c.ws, LW, 4 * LBS, 4 * LBS, S_, E_); }
        CONV_LATE(CONV_GU0(4, 8));
    } SEAM(PH_G2);
#ifdef HAVE_THIN
    if (IN(PH_SCAN0)) { CONV_EARLY(CONV_GU0(8, 10)); scan_phase(F); CONV_LATE(CONV_GU0(8, 10)); }
#endif
#ifdef HAVE_ATT0
    if (IN(PH_ATT0)) { CONV_EARLY(CONV_GU0(10, 14)); att0_phase(F); CONV_LATE(CONV_GU0(10, 14)); } SEAM(PH_ATT0);
#endif
    if (IN(PH_OUT0)) {
        CONV_EARLY(CONV_GU0(14, 17));
        pg8::DenseOrder S_; S_.A = (const char*)WSP(bf16_t, WS_MIX); S_.B = (const char*)WSP(bf16_t, W_OUTAB); S_.nM = M / 256; S_.nN = D / 256; S_.G = F.G; S_.c = (int)blockIdx.x; S_.a_tile = (long)256 * D * 2; S_.b_tile = (long)256 * D * 2;
        pg8::EpiOut E_{c.in[I_X], WSP(float, WS_X1), mod + 2 * D};
        pg8::gemm_phase<pg8::EpiOut, pg8::DenseOrder, pg8::APlain, false, true>(F.lds, F.wave, (const char*)c.ws, D, D, D, S_, E_);
        CONV_LATE(CONV_GU0(14, 17));
    } SEAM(PH_OUT0);
#ifdef HAVE_RT
    if (IN(PH_RT0)) { CONV_EARLY(CONV_GU0(17, 20)); route_phase(F, 0); CONV_LATE(CONV_GU0(17, 20)); } SEAM(PH_RT0);
#endif
    if (IN(PH_M1_0)) {
#ifdef SPREAD_CONV
        mod_units(F, 1);
#endif
        CONV_EARLY(conv_items(F, IT_DN0, IT_GU1));
        build_offt(F, 0);
#ifdef MOE_FP8
        typedef pg8::OrderMoeT<2 * FF / 256, true, WS_HM8, W_GU + (size_t)0 * (E + 1) * 2 * FF * D, (long)2 * FF * D, (long)256 * D, 0> OM1;
#ifdef MOE_CONTIG
        const int tot1_ = ((const LAS int*)(F.lds + TAB_OFF))[E + 1] * (2 * FF / 256), lo1_ = (int)((long)tot1_ * F.vcu / F.G), hi1_ = (int)((long)tot1_ * (F.vcu + 1) / F.G);
        OM1 S_{c.ws, lo1_, hi1_ - lo1_};
#else
        OM1 S_{c.ws, F.G, F.vcu};
#endif
        pg8::EpiM1F8 E_{c.ws};
        pg8::gemm_phase<pg8::EpiM1F8, OM1, pg8::APlain, true, true, 1>(F.lds, F.wave, (const char*)c.ws, D / 2, D / 2, D / 2, S_, E_);
#else
        pg8::OrderMoe S_{(const LAS int*)(F.lds + TAB_OFF), (const char*)WSP(bf16_t, WS_HM), (const char*)WSP(bf16_t, W_GU), WSP(int, WS_TOK), 2 * FF / 256, F.G, F.vcu, 1, (long)2 * FF * D * 2, (long)256 * D * 2, 0};
        pg8::EpiM1 E_{WSP(bf16_t, WS_ACT)};
        pg8::gemm_phase<pg8::EpiM1, pg8::OrderMoe, pg8::APlain, true, true>(F.lds, F.wave, (const char*)c.ws, D, D, D, S_, E_);
#endif
        CONV_LATE(conv_items(F, IT_DN0, IT_GU1));
    } SEAM(PH_M1_0);
    if (IN(PH_M2_0)) { CONV_EARLY(CONV_GU1(0, 4)); build_offt(F, 0);
#ifdef MOE_FP8
        typedef pg8::OrderMoeT<D / 256, false, WS_ACT, W_DN + (size_t)0 * (E + 1) * D * FF, (long)D * FF, (long)256 * FF, (long)256 * FF> OM2;
#ifdef MOE_CONTIG
        const int tot2_ = ((const LAS int*)(F.lds + TAB_OFF))[E + 1] * (D / 256), lo2_ = (int)((long)tot2_ * F.vcu / F.G), hi2_ = (int)((long)tot2_ * (F.vcu + 1) / F.G);
        OM2 S_{c.ws, lo2_, hi2_ - lo2_};
#else
        OM2 S_{c.ws, F.G, F.vcu};
#endif
        pg8::EpiM2F8 E_{c.ws};
        pg8::gemm_phase<pg8::EpiM2F8, OM2, pg8::APlain, false, true, 1>(F.lds, F.wave, (const char*)c.ws, FF / 2, FF / 2, FF / 2, S_, E_);
#else
        pg8::OrderMoe S_{(const LAS int*)(F.lds + TAB_OFF), (const char*)WSP(bf16_t, WS_ACT), (const char*)WSP(bf16_t, W_DN), WSP(int, WS_TOK), D / 256, F.G, F.vcu, 0, (long)D * FF * 2, (long)256 * FF * 2, (long)256 * FF * 2};
        pg8::EpiM2 E_{WSP(bf16_t, WS_Y), WSP(float, WS_WT), (const LAS int*)(F.lds + TAB_OFF), 1.0f};
        pg8::gemm_phase<pg8::EpiM2, pg8::OrderMoe, pg8::APlain, false, true>(F.lds, F.wave, (const char*)c.ws, FF, FF, FF, S_, E_);
#endif
        CONV_LATE(CONV_GU1(0, 4));
    } SEAM(PH_M2_0);
#ifdef HAVE_THIN
    if (IN(PH_CMB0)) { CONV_EARLY(CONV_GU1(4, 6)); combine_phase(F, 0); CONV_LATE(CONV_GU1(4, 6)); } SEAM(PH_CMB0);
#endif
    if (IN(PH_G3)) {
        pg8::DenseOrder S_; S_.A = (const char*)WSP(bf16_t, WS_HM); S_.B = (const char*)WSP(bf16_t, W_INCD); S_.nM = M / 256; S_.nN = CD_N / 256; S_.G = F.G; S_.c = (int)blockIdx.x; S_.a_tile = (long)256 * D * 2; S_.b_tile = (long)256 * D * 2;
        pg8::EpiG3 E_{WSP(bf16_t, WS_PROJ), WSP(float, WS_TAB + TAB_CT), WSP(float, WS_TAB + TAB_ST), LOG2E / sqrtf((float)HDS)};
        pg8::gemm_phase<pg8::EpiG3, pg8::DenseOrder, pg8::APlain, false, true>(F.lds, F.wave, (const char*)c.ws, D, D, D, S_, E_);
#ifdef SPREAD_CONV
        { const int nu = (M / 256) * (CD_N / 256), rem = nu % F.G;
          if (rem != 0 && (int)blockIdx.x >= rem) { __syncthreads(); conv_slice(F, IT_GU1, IT_DN1, 6, 8, 17, (int)blockIdx.x - rem, F.G - rem); __syncthreads(); }
          else if (rem == 0) { __syncthreads(); CONV_GU1(6, 8); __syncthreads(); } }
#endif
    } SEAM(PH_G3);
#ifdef HAVE_RET1
    if (IN(PH_RET1)) { CONV_EARLY(CONV_GU1(8, 12)); ret1_phase(F); CONV_LATE(CONV_GU1(8, 12)); }
#endif
#ifdef HAVE_SWA1
    if (IN(PH_SWA1)) { CONV_EARLY(CONV_GU1(12, 13)); swa1_phase(F); CONV_LATE(CONV_GU1(12, 13)); } SEAM(PH_SWA1);
#endif
#ifdef HAVE_THIN
    if (IN(PH_RN1)) { retnorm_phase(F); } SEAM(PH_RN1);
#endif
    if (IN(PH_OUT1)) {
        CONV_EARLY(CONV_GU1(13, 15));
        pg8::DenseOrder S_; S_.A = (const char*)WSP(bf16_t, WS_MIX); S_.B = (const char*)WSP(bf16_t, W_OUTCD); S_.nM = M / 256; S_.nN = D / 256; S_.G = F.G; S_.c = (int)blockIdx.x; S_.a_tile = (long)256 * D * 2; S_.b_tile = (long)256 * D * 2;
        pg8::EpiOut E_{WSP(float, WS_X2), WSP(float, WS_X1), mod + (size_t)NB * 6 * D + 2 * D};
        pg8::gemm_phase<pg8::EpiOut, pg8::DenseOrder, pg8::APlain, false, true>(F.lds, F.wave, (const char*)c.ws, D, D, D, S_, E_);
        CONV_LATE(CONV_GU1(13, 15));
    } SEAM(PH_OUT1);
#ifdef HAVE_RT
    if (IN(PH_RT1)) { CONV_EARLY(CONV_GU1(15, 17)); route_phase(F, 1); CONV_LATE(CONV_GU1(15, 17)); } SEAM(PH_RT1);
#endif
    if (IN(PH_M1_1)) { CONV_EARLY(conv_items(F, IT_DN1, IT_END)); build_offt(F, 1);
#ifdef MOE_FP8
        typedef pg8::OrderMoeT<2 * FF / 256, true, WS_HM8, W_GU + (size_t)1 * (E + 1) * 2 * FF * D, (long)2 * FF * D, (long)256 * D, 0> OM1;
#ifdef MOE_CONTIG
        const int tot1_ = ((const LAS int*)(F.lds + TAB_OFF))[E + 1] * (2 * FF / 256), lo1_ = (int)((long)tot1_ * F.vcu / F.G), hi1_ = (int)((long)tot1_ * (F.vcu + 1) / F.G);
        OM1 S_{c.ws, lo1_, hi1_ - lo1_};
#else
        OM1 S_{c.ws, F.G, F.vcu};
#endif
        pg8::EpiM1F8 E_{c.ws};
        pg8::gemm_phase<pg8::EpiM1F8, OM1, pg8::APlain, true, true, 1>(F.lds, F.wave, (const char*)c.ws, D / 2, D / 2, D / 2, S_, E_);
#else
        pg8::OrderMoe S_{(const LAS int*)(F.lds + TAB_OFF), (const char*)WSP(bf16_t, WS_HM), (const char*)(WSP(bf16_t, W_GU) + (size_t)(E + 1) * 2 * FF * D), WSP(int, WS_TOK), 2 * FF / 256, F.G, F.vcu, 1, (long)2 * FF * D * 2, (long)256 * D * 2, 0};
        pg8::EpiM1 E_{WSP(bf16_t, WS_ACT)};
        pg8::gemm_phase<pg8::EpiM1, pg8::OrderMoe, pg8::APlain, true, true>(F.lds, F.wave, (const char*)c.ws, D, D, D, S_, E_);
#endif
        CONV_LATE(conv_items(F, IT_DN1, IT_END));
    } SEAM(PH_M1_1);
    if (IN(PH_M2_1)) { build_offt(F, 1);
#ifdef MOE_FP8
        typedef pg8::OrderMoeT<D / 256, false, WS_ACT, W_DN + (size_t)1 * (E + 1) * D * FF, (long)D * FF, (long)256 * FF, (long)256 * FF> OM2;
#ifdef MOE_CONTIG
        const int tot2_ = ((const LAS int*)(F.lds + TAB_OFF))[E + 1] * (D / 256), lo2_ = (int)((long)tot2_ * F.vcu / F.G), hi2_ = (int)((long)tot2_ * (F.vcu + 1) / F.G);
        OM2 S_{c.ws, lo2_, hi2_ - lo2_};
#else
        OM2 S_{c.ws, F.G, F.vcu};
#endif
        pg8::EpiM2F8 E_{c.ws};
        pg8::gemm_phase<pg8::EpiM2F8, OM2, pg8::APlain, false, true, 1>(F.lds, F.wave, (const char*)c.ws, FF / 2, FF / 2, FF / 2, S_, E_);
#else
        pg8::OrderMoe S_{(const LAS int*)(F.lds + TAB_OFF), (const char*)WSP(bf16_t, WS_ACT), (const char*)(WSP(bf16_t, W_DN) + (size_t)(E + 1) * D * FF), WSP(int, WS_TOK), D / 256, F.G, F.vcu, 0, (long)D * FF * 2, (long)256 * FF * 2, (long)256 * FF * 2};
        pg8::EpiM2 E_{WSP(bf16_t, WS_Y), WSP(float, WS_WT), (const LAS int*)(F.lds + TAB_OFF), 1.0f};
        pg8::gemm_phase<pg8::EpiM2, pg8::OrderMoe, pg8::APlain, false, true>(F.lds, F.wave, (const char*)c.ws, FF, FF, FF, S_, E_);
#endif
    } SEAM(PH_M2_1);
#ifdef HAVE_THIN
    if (IN(PH_CMB1)) { combine_phase(F, 1); }
#endif
#undef IN
#undef SEAM
}

extern "C" void kernel_launch(void* const* d_in, const int* in_sizes, int n_in, void* d_out, int out_size, void* d_ws, size_t ws_size, hipStream_t stream) {
    static int grid = 0;
    if (grid == 0) {
        if (n_in != N_IN || out_size != M * D || ws_size < WS_END) { fprintf(stderr, "kernel_launch: unexpected shapes (n_in %d, out %d, ws %zu < %zu)\n", n_in, out_size, ws_size, (size_t)WS_END); grid = -1; return; }
        int dev = 0, cus = 0;
        if (hipGetDevice(&dev) != hipSuccess || hipDeviceGetAttribute(&cus, hipDeviceAttributeMultiprocessorCount, dev) != hipSuccess) { grid = -1; return; }
        if (hipFuncSetAttribute((const void*)mega_fwd, hipFuncAttributeMaxDynamicSharedMemorySize, LDS_BYTES) != hipSuccess) { fprintf(stderr, "kernel_launch: hipFuncSetAttribute failed\n"); grid = -1; return; }
        int per_cu = 0; (void)hipOccupancyMaxActiveBlocksPerMultiprocessor(&per_cu, (const void*)mega_fwd, NTHR, LDS_BYTES); (void)hipGetLastError();
        if (per_cu < 1) fprintf(stderr, "kernel_launch: occupancy query reports %d\n", per_cu);
        grid = cus;
    }
    if (grid < 0) return;
    Ctx c; memset((void*)&c, 0, sizeof(c));
    for (int i = 0; i < N_IN; ++i) c.in[i] = (const float*)d_in[i];
    c.out = (float*)d_out; c.ws = (unsigned char*)d_ws;
    (void)hipMemsetAsync((char*)d_ws + WS_CTL, 0, CTL_BYTES, stream);
    Launcher go{stream};
    const unsigned mask = (unsigned)(OPT_MASK);
    int n_mega = 0; for (int p = 0; p < N_PHASES; ++p) n_mega += (mask >> p) & 1u;
#ifdef FORCE_SPLIT
    const bool one = false;
#else
    const bool one = (mask == (1u << N_PHASES) - 1u);
#endif
    for (int ph = 0; ph < N_PHASES; ) {
        if ((mask >> ph) & 1u) {
            int hi = ph + 1; if (one) hi = N_PHASES;
            MArgs a; memset((void*)&a, 0, sizeof(a)); a.c = c; a.ph_lo = ph; a.ph_hi = hi; a.use_bar = one ? 1 : 0;
            hipLaunchKernelGGL(mega_fwd, dim3(grid), dim3(NTHR), LDS_BYTES, stream, a);
#ifdef DUP_PHASE
            if (!one && ph == (DUP_PHASE)) hipLaunchKernelGGL(mega_fwd, dim3(grid), dim3(NTHR), LDS_BYTES, stream, a);
#endif
            if (!one && (ph == PH_RT0 || ph == PH_RT1)) naive_offt(go, c, ph == PH_RT1);
            ph = hi;
        } else {
            naive_phase(go, c, ph);
            if (ph == PH_RT0 || ph == PH_RT1) naive_offt(go, c, ph == PH_RT1);
            ++ph;
        }
    }
}


#endif
```

```cpp
#define OPT_MASK ((1u<<N_PHASES)-1u)
#define HAVE_THIN 1
#define HAVE_SKINNY 1
#define HAVE_RT 1
#define HAVE_ATT0 1
#define HAVE_RET1 1
#define HAVE_SWA1 1
#define MOE_FP8 1
#define SPREAD_CONV 1
#ifdef HOST_TEST
#include <cmath>
#include <cstring>
#include <cstdio>
#include <cstdint>
#include <cstring>
#include <cstddef>
#define HD inline
#else
#include <hip/hip_runtime.h>
#include <cstdio>
#include <cstdint>
#include <cstring>
#define HD __host__ __device__ __forceinline__
#endif

namespace cfg {
#ifdef HOST_TEST
constexpr int D = 256, NB = 2, S = 256, H_A = 4, NOPE = 16, ROPE = 16, VD = 32, QR = 64, KVR = 64, LW = 128, LBS = 16, H_C = 4, DK = 32, H_D = 8, KVH = 2, HDS = 16, WIN = 64, FF = 32;
#else
constexpr int D = 2048, NB = 4, S = 2048, H_A = 8, NOPE = 128, ROPE = 64, VD = 128, QR = 512, KVR = 512, LW = 1024, LBS = 128, H_C = 4, DK = 256, H_D = 8, KVH = 2, HDS = 128, WIN = 128, FF = 512;
#endif
constexpr int M = NB * S, QK = NOPE + ROPE, E = 64, TOPK = 8, NG = 8, TG = 4;
constexpr int AB_N = QR + KVR + ROPE + 2 * LW, P0_N = QR + KVR + 2 * LW;
constexpr int CD_N = 4 * H_C * DK + H_D * HDS + 2 * KVH * HDS;
constexpr int HALF = D / 2;
constexpr int RT = 256;
constexpr int MAXT = (M * TOPK) / RT + E + M / RT;
constexpr float EPS = 1e-6f, LOG2E = 1.4426950408889634f;
static_assert(H_A * VD == HALF && LW == HALF && H_C * DK == HALF && H_D * HDS == HALF, "half widths");
}
using namespace cfg;

enum { I_X = 0, I_C, I_WMOD, I_BMOD, I_NMIX, I_NFFN, I_FNORM, I_WINAB, I_QLN, I_KVLN, I_WUQ, I_WUKV, I_CONVW, I_CONVB, I_LWA, I_LBA, I_LWX, I_LBX, I_LLAM, I_WOUTAB,
       I_WINCD, I_RETGN, I_SINKS, I_WOUTCD, I_RELB, I_WROUTER, I_RBIAS, I_WGATE, I_WUP, I_WDOWN, I_WSG, I_WSU, I_WSD, N_IN };

typedef unsigned short bf16_t;
HD float bf2f(bf16_t v) { unsigned u = (unsigned)v << 16; float f; __builtin_memcpy(&f, &u, 4); return f; }
HD bf16_t f2bf(float f) { unsigned u; __builtin_memcpy(&u, &f, 4); u += 0x7fffu + ((u >> 16) & 1u); return (bf16_t)(u >> 16); }
HD float sigm(float x) { return 1.0f / (1.0f + expf(-x)); }
HD float siluf(float x) { return x * sigm(x); }
HD float gelu_tanh(float x) { return 0.5f * x * (1.0f + tanhf(0.7978845608028654f * (x + 0.044715f * x * x * x))); }
HD int cnt_idx(int l, int e) { return (l * E + e) * 64; }
HD float ssq8(const float* p) { return ((p[0] + p[1]) + (p[2] + p[3])) + ((p[4] + p[5]) + (p[6] + p[7])); }
HD int t5_bucket(int rel) {
    const int n = rel < 0 ? -rel : rel; const int ret = rel > 0 ? 16 : 0;
    if (n < 8) return ret + n;
    return ret + 8 + (n >= 12) + (n >= 16) + (n >= 23) + (n >= 32) + (n >= 46) + (n >= 64) + (n >= 91);
}

constexpr size_t al(size_t x) { return (x + 4095) & ~size_t(4095); }
constexpr size_t WS_CTL = 0, CTL_BYTES = 1u << 20;
constexpr size_t CTL_CNT = 65536;
constexpr size_t CTL_SSQ = 131072;
constexpr size_t WS_MOD = CTL_BYTES;
constexpr size_t WS_TAB = WS_MOD + al((size_t)2 * NB * 6 * D * 4);
constexpr size_t TAB_CR = 0, TAB_SR = (size_t)S * (ROPE / 2) * 4, TAB_CT = 2 * TAB_SR, TAB_ST = TAB_CT + (size_t)S * (DK / 2) * 4;
constexpr size_t WS_RSTD = WS_TAB + al(TAB_ST + (size_t)S * (DK / 2) * 4);
constexpr size_t WS_SELE = WS_RSTD + al((size_t)M * 4);
constexpr size_t WS_SELR = WS_SELE + al((size_t)M * 8 * 4);
constexpr size_t WS_SELW = WS_SELR + al((size_t)M * 8 * 4);
constexpr size_t WS_TOK = WS_SELW + al((size_t)M * 8 * 4);
constexpr size_t WS_WT = WS_TOK + al((size_t)E * M * 4);
constexpr size_t WS_OFFT = WS_WT + al((size_t)E * M * 4);
constexpr size_t WS_HM = WS_OFFT + 4096;
constexpr size_t WS_HM8 = WS_HM + al((size_t)M * D * 2);
constexpr size_t WS_MIX = WS_HM8 + al((size_t)M * D);
constexpr size_t WS_X1 = WS_MIX + al((size_t)M * D * 2);
constexpr size_t WS_X2 = WS_X1 + al((size_t)M * D * 4);
constexpr size_t WS_PROJ = WS_X2 + al((size_t)M * D * 4);
constexpr size_t WS_L0 = WS_PROJ + al((size_t)M * (P0_N > CD_N ? P0_N : CD_N) * 2);
constexpr size_t WS_Q = WS_L0;
constexpr size_t WS_KC = WS_Q + al((size_t)M * H_A * QK * 2);
constexpr size_t WS_V = WS_KC + al((size_t)M * H_A * QK * 2);
constexpr size_t WS_XC = WS_V + al((size_t)M * H_A * VD * 2);
constexpr size_t WS_LA = WS_XC + al((size_t)M * LW * 2);
constexpr size_t WS_U = WS_LA + al((size_t)2 * M * LW * 2);
constexpr size_t WS_HF = WS_U + al((size_t)2 * M * LW * 2);
constexpr size_t WS_LXP = WS_HF + al((size_t)M * LW * 4);
constexpr size_t WS_RET = WS_L0;
constexpr size_t WS_ACT = WS_LXP + al((size_t)NB * (S + 4) * LW * 2);
constexpr size_t WS_Y = WS_ACT + al((size_t)MAXT * RT * FF * 2);
constexpr size_t WS_T = WS_Y;
constexpr size_t WS_SC = WS_T + al((size_t)M * CD_N * 4);
static_assert(WS_SC + (size_t)8 * S * S * 4 <= WS_Y + (size_t)MAXT * RT * D * 2, "naive temps fit in the Y region");
constexpr size_t WS_W = WS_Y + al((size_t)MAXT * RT * D * 2);
constexpr size_t W_INAB = WS_W;
constexpr size_t W_UQ = W_INAB + al((size_t)AB_N * D * 2);
constexpr size_t W_UKV = W_UQ + al((size_t)H_A * QK * QR * 2);
constexpr size_t W_LRU = W_UKV + al((size_t)H_A * (NOPE + VD) * KVR * 2);
constexpr size_t W_OUTAB = W_LRU + al((size_t)2 * (LW / LBS) * 2 * LBS * 4 * LBS * 2);
constexpr size_t W_INCD = W_OUTAB + al((size_t)D * D * 2);
constexpr size_t W_OUTCD = W_INCD + al((size_t)CD_N * D * 2);
constexpr size_t W_RT = W_OUTCD + al((size_t)D * D * 2);
constexpr size_t W_GU = W_RT + al((size_t)2 * E * D * 2);
constexpr size_t W_DN = W_GU + al((size_t)2 * (E + 1) * 2 * FF * D * 2);
constexpr size_t W_GB = W_DN + al((size_t)2 * (E + 1) * D * FF * 2);
constexpr size_t WS_END = W_GB + al((size_t)6 * LW * 4);

struct Ctx { const float* in[N_IN]; float* out; unsigned char* ws; };
#define WSP(T, off) ((T*)(c.ws + (off)))
HD long lru_idx(int d, int b, int t, int ch) { return ((((long)d * NB + b) * (LW / 8) + ch / 8) * S + t) * 8 + (ch % 8); }
HD int atomic_inc(int* p) {
#ifdef HOST_TEST
    return (*p)++;
#else
#if defined(__HIP_DEVICE_COMPILE__)
    return atomicAdd(p, 1);
#else
    return (*p)++;
#endif
#endif
}

struct NGemm {
    const void* A; const void* B; void* C; const float* ks;
    long a_rs, a_ks, a_z1, a_z2, b_ks, b_ns, b_z1, b_z2, c_rs, c_z1, c_z2;
    long Mr, N, K, Z2, a_bf, b_bf, c_bf;
    HD float la(long i) const { return a_bf ? bf2f(((const bf16_t*)A)[i]) : ((const float*)A)[i]; }
    HD float lb(long i) const { return b_bf ? bf2f(((const bf16_t*)B)[i]) : ((const float*)B)[i]; }
    HD void operator()(long i) const {
        const long n4c = N / 4, m4c = Mr / 4;
        const long n0 = (i % n4c) * 4; const long r = i / n4c; const long m0 = (r % m4c) * 4; const long z = r / m4c; const long z1 = z / Z2, z2 = z % Z2;
        const long ab = z1 * a_z1 + z2 * a_z2, bb = z1 * b_z1 + z2 * b_z2, cb = z1 * c_z1 + z2 * c_z2;
        float acc[4][4];
#pragma unroll
        for (int x = 0; x < 4; ++x)
#pragma unroll
            for (int y = 0; y < 4; ++y) acc[x][y] = 0.f;
        for (long k = 0; k < K; ++k) {
            const float s = ks ? ks[k] : 1.0f;
            float av[4], bv[4];
#pragma unroll
            for (int x = 0; x < 4; ++x) av[x] = la(ab + (m0 + x) * a_rs + k * a_ks) * s;
#pragma unroll
            for (int y = 0; y < 4; ++y) bv[y] = lb(bb + k * b_ks + (n0 + y) * b_ns);
#pragma unroll
            for (int x = 0; x < 4; ++x)
#pragma unroll
                for (int y = 0; y < 4; ++y) acc[x][y] += av[x] * bv[y];
        }
#pragma unroll
        for (int x = 0; x < 4; ++x)
#pragma unroll
            for (int y = 0; y < 4; ++y) { const long ci = cb + (m0 + x) * c_rs + n0 + y; if (c_bf) ((bf16_t*)C)[ci] = f2bf(acc[x][y]); else ((float*)C)[ci] = acc[x][y]; }
    }
    long count(long Z) const { return Z * (Mr / 4) * (N / 4); }
};

struct ModF { Ctx c;
    HD void operator()(long i) const { const long n4c = 6 * D / 4; const long n = (i % n4c) * 4; const long r = i / n4c; const int b = (int)(r % NB), l = (int)(r / NB);
        float a0 = c.in[I_BMOD][l * 6 * D + n], a1 = c.in[I_BMOD][l * 6 * D + n + 1], a2 = c.in[I_BMOD][l * 6 * D + n + 2], a3 = c.in[I_BMOD][l * 6 * D + n + 3];
        const float* w = c.in[I_WMOD] + (size_t)l * D * 6 * D + n;
        for (int k = 0; k < D; ++k) { const float ca = siluf(c.in[I_C][b * D + k]); const float* wr = w + (size_t)k * 6 * D; a0 += ca * wr[0]; a1 += ca * wr[1]; a2 += ca * wr[2]; a3 += ca * wr[3]; }
        float* o = WSP(float, WS_MOD) + ((size_t)l * NB + b) * 6 * D + n; o[0] = a0; o[1] = a1; o[2] = a2; o[3] = a3; }
    long count() const { return (long)2 * NB * 6 * D / 4; } };
struct TabF { Ctx c;
    HD void operator()(long i) const { const int W = ROPE / 2 + DK / 2; const int t = (int)(i / W), j = (int)(i % W);
#if defined(__HIP_DEVICE_COMPILE__)
        { const bool r = j < ROPE / 2; const int jj = r ? j : j - ROPE / 2;
          const float inv = exp2f(-(2.0f * (float)jj / (float)(r ? ROPE : DK)) * 13.287712379549449f), a = (float)t * inv; const float cs = cosf(a), sn = sinf(a);
          if (r) { WSP(float, WS_TAB + TAB_CR)[t * (ROPE / 2) + jj] = cs; WSP(float, WS_TAB + TAB_SR)[t * (ROPE / 2) + jj] = sn; }
          else { WSP(float, WS_TAB + TAB_CT)[t * (DK / 2) + jj] = cs; WSP(float, WS_TAB + TAB_ST)[t * (DK / 2) + jj] = sn; }
          return; }
#endif
        if (j < ROPE / 2) { const double inv = pow(10000.0, -2.0 * j / ROPE), a = t * inv; WSP(float, WS_TAB + TAB_CR)[t * (ROPE / 2) + j] = (float)cos(a); WSP(float, WS_TAB + TAB_SR)[t * (ROPE / 2) + j] = (float)sin(a); }
        else { const int jj = j - ROPE / 2; const double inv = pow(10000.0, -2.0 * jj / DK), a = t * inv; WSP(float, WS_TAB + TAB_CT)[t * (DK / 2) + jj] = (float)cos(a); WSP(float, WS_TAB + TAB_ST)[t * (DK / 2) + jj] = (float)sin(a); } }
    long count() const { return (long)S * (ROPE / 2 + DK / 2); } };
struct RowSSF { Ctx c; const float* X; float* out; long rs, ncols, rows, os;
    HD void operator()(long i) const { const float* x = X + i * rs; float s = 0.f; for (long j = 0; j < ncols; ++j) s += x[j] * x[j]; out[i * os] = s; }
    long count() const { return rows; } };
struct ModulateF { Ctx c; const float* X; const float* gain; const float* sc; const float* sh;
    HD void operator()(long i) const { const long m = i / D, j = i % D; const int b = (int)(m / S); const float r = 1.0f / sqrtf(WSP(float, WS_RSTD)[m] / D + EPS);
        WSP(bf16_t, WS_HM)[i] = f2bf(X[i] * r * gain[j] * (1.0f + sc[(size_t)b * 6 * D + j]) + sh[(size_t)b * 6 * D + j]); }
    long count() const { return (long)M * D; } };
struct FinalF { Ctx c; const float* X;
    HD void operator()(long i) const { const long m = i / D, j = i % D; const float r = 1.0f / sqrtf(WSP(float, WS_RSTD)[m] / D + EPS); c.out[i] = X[i] * r * c.in[I_FNORM][j]; }
    long count() const { return (long)M * D; } };
struct PostG1F { Ctx c;
    HD void operator()(long i) const { const long m = i / AB_N; const int col = (int)(i % AB_N); const float v = WSP(float, WS_T)[i]; bf16_t* P = WSP(bf16_t, WS_PROJ) + m * P0_N;
        if (col < QR + KVR) P[col] = f2bf(v);
        else if (col < QR + KVR + ROPE) {}
        else if (col < QR + KVR + ROPE + LW) { P[col - ROPE] = f2bf(v); const long b = m / S, t = m % S; WSP(bf16_t, WS_LXP)[(b * (S + 4) + 2 + t) * LW + col - (QR + KVR + ROPE)] = f2bf(v); }
        else P[col - ROPE] = f2bf(gelu_tanh(v)); }
    long count() const { return (long)M * AB_N; } };
struct KRopeF { Ctx c;
    HD void operator()(long i) const { const long m = i / (ROPE / 2); const int ii = (int)(i % (ROPE / 2)); const int t = (int)(m % S); const float* T = WSP(float, WS_T) + m * AB_N + QR + KVR;
        const float x1 = T[ii], x2 = T[ROPE / 2 + ii], cs = WSP(float, WS_TAB + TAB_CR)[t * (ROPE / 2) + ii], sn = WSP(float, WS_TAB + TAB_SR)[t * (ROPE / 2) + ii];
        const bf16_t o1 = f2bf(x1 * cs - x2 * sn), o2 = f2bf(x2 * cs + x1 * sn);
        for (int h = 0; h < H_A; ++h) { bf16_t* K = WSP(bf16_t, WS_KC) + (m * H_A + h) * QK + NOPE; K[ii] = o1; K[ROPE / 2 + ii] = o2; } }
    long count() const { return (long)M * (ROPE / 2); } };
struct PostQF { Ctx c; float qs;
    HD void operator()(long i) const { const long m = i / (H_A * QK); const int r = (int)(i % (H_A * QK)), h = r / QK, j = r % QK; const int t = (int)(m % S);
        const float rstd = 1.0f / sqrtf(ssq8(WSP(float, CTL_SSQ) + m * 16) / QR + EPS) * qs; const float* T = WSP(float, WS_T) + m * (H_A * QK) + h * QK; bf16_t* Q = WSP(bf16_t, WS_Q) + (m * H_A + h) * QK;
        if (j < NOPE) Q[j] = f2bf(T[j] * rstd);
        else if (j < NOPE + ROPE / 2) { const int ii = j - NOPE; const float x1 = T[NOPE + ii] * rstd, x2 = T[NOPE + ROPE / 2 + ii] * rstd, cs = WSP(float, WS_TAB + TAB_CR)[t * (ROPE / 2) + ii], sn = WSP(float, WS_TAB + TAB_SR)[t * (ROPE / 2) + ii];
            Q[NOPE + ii] = f2bf(x1 * cs - x2 * sn); Q[NOPE + ROPE / 2 + ii] = f2bf(x2 * cs + x1 * sn); } }
    long count() const { return (long)M * H_A * QK; } };
struct PostKVF { Ctx c;
    HD void operator()(long i) const { const int W = NOPE + VD; const long m = i / (H_A * W); const int r = (int)(i % (H_A * W)), h = r / W, j = r % W;
        const float rstd = 1.0f / sqrtf(ssq8(WSP(float, CTL_SSQ) + m * 16 + 8) / KVR + EPS); const float v = WSP(float, WS_T)[i] * rstd;
        if (j < NOPE) WSP(bf16_t, WS_KC)[(m * H_A + h) * QK + j] = f2bf(v); else WSP(bf16_t, WS_V)[(m * H_A + h) * VD + j - NOPE] = f2bf(v); }
    long count() const { return (long)M * H_A * (NOPE + VD); } };
struct ConvF { Ctx c;
    HD void operator()(long i) const { const long m = i / LW; const int ch = (int)(i % LW); const int t = (int)(m % S); float a = c.in[I_CONVB][ch];
        for (int j = 0; j < 4; ++j) { const int tt = t + j - 2; if (tt >= 0 && tt < S) a += c.in[I_CONVW][j * LW + ch] * bf2f(WSP(bf16_t, WS_PROJ)[(m + j - 2) * P0_N + QR + KVR + ch]); }
        WSP(bf16_t, WS_XC)[i] = f2bf(a); }
    long count() const { return (long)M * LW; } };
struct GatesF { Ctx c;
    HD void operator()(long i) const { const int ch = (int)(i % LW); const long r = i / LW; const long m = r % M; const int d = (int)(r / M); const int g = ch / LBS, j = ch % LBS; const int b = (int)(m / S), t = (int)(m % S);
        const bf16_t* xr = WSP(bf16_t, WS_XC) + m * LW + g * LBS; const float* wa = c.in[I_LWA] + ((size_t)(d * (LW / LBS) + g) * LBS) * LBS + j; const float* wx = c.in[I_LWX] + ((size_t)(d * (LW / LBS) + g) * LBS) * LBS + j;
        float za = c.in[I_LBA][d * LW + ch], zx = c.in[I_LBX][d * LW + ch];
        for (int k = 0; k < LBS; ++k) { const float x = bf2f(xr[k]); za += x * wa[(size_t)k * LBS]; zx += x * wx[(size_t)k * LBS]; }
        const float lam = c.in[I_LLAM][d * LW + ch]; const float sp = log1pf(expf(-lam));
        const float la = -8.0f * sigm(za) * sp; const float u = sqrtf(-expm1f(2.0f * la)) * (sigm(zx) * bf2f(WSP(bf16_t, WS_XC)[m * LW + ch]));
        const long o = lru_idx(d, b, t, ch); WSP(bf16_t, WS_LA)[o] = f2bf(la); WSP(bf16_t, WS_U)[o] = f2bf(u); }
    long count() const { return (long)2 * M * LW; } };
struct ScanF { Ctx c;
    HD void operator()(long i) const { const int b = (int)(i / LW), ch = (int)(i % LW); float h = 0.f;
        for (int t = 0; t < S; ++t) { const long o = lru_idx(0, b, t, ch); h = expf(bf2f(WSP(bf16_t, WS_LA)[o])) * h + bf2f(WSP(bf16_t, WS_U)[o]); WSP(float, WS_HF)[((long)b * S + t) * LW + ch] = h; }
        h = 0.f;
        for (int t = S - 1; t >= 0; --t) { const long o = lru_idx(1, b, t, ch); h = expf(bf2f(WSP(bf16_t, WS_LA)[o])) * h + bf2f(WSP(bf16_t, WS_U)[o]); const long m = (long)b * S + t;
            WSP(bf16_t, WS_MIX)[m * D + HALF + ch] = f2bf((WSP(float, WS_HF)[m * LW + ch] + h) * bf2f(WSP(bf16_t, WS_PROJ)[m * P0_N + QR + KVR + LW + ch])); } }
    long count() const { return (long)NB * LW; } };
struct SoftmaxF { Ctx c; long rows;
    HD void operator()(long i) const { float* r = WSP(float, WS_SC) + i * S; float mx = -INFINITY; for (int k = 0; k < S; ++k) mx = fmaxf(mx, r[k]); float s = 0.f; for (int k = 0; k < S; ++k) { const float p = exp2f(r[k] - mx); r[k] = p; s += p; }
        const float inv = 1.0f / s; for (int k = 0; k < S; ++k) r[k] *= inv; }
    long count() const { return rows; } };
struct OutPostF { Ctx c; const float* Xin; float* Xout; long l;
    HD void operator()(long i) const { const long m = i / D, n = i % D; const int b = (int)(m / S); Xout[i] = Xin[i] + WSP(float, WS_MOD)[((size_t)l * NB + b) * 6 * D + 2 * D + n] * WSP(float, WS_T)[i]; }
    long count() const { return (long)M * D; } };
struct RouteF { Ctx c; long l;
    HD float bz(const float* lg, const float* bias, int e) const { return sigm(lg[e]) + bias[e]; }
    HD void operator()(long m) const { const float* lg = WSP(float, WS_T) + m * E; const float* bias = c.in[I_RBIAS] + l * E;
        unsigned gmask = 0u;
        for (int it = 0; it < TG; ++it) { float best = -INFINITY; int bi = 0;
            for (int g = 0; g < NG; ++g) if (!((gmask >> g) & 1u)) { float m1 = -INFINITY, m2 = -INFINITY; for (int j = 0; j < E / NG; ++j) { const float v = bz(lg, bias, g * (E / NG) + j); if (v > m1) { m2 = m1; m1 = v; } else if (v > m2) m2 = v; }
                const float sc = m1 + m2; if (sc > best) { best = sc; bi = g; } }
            gmask |= 1u << bi; }
        unsigned long long taken = 0ull; float wsum = 0.f; int* se = WSP(int, WS_SELE) + m * TOPK; float* sw = WSP(float, WS_SELW) + m * TOPK; int* sr = WSP(int, WS_SELR) + m * TOPK;
        for (int k = 0; k < TOPK; ++k) { float best = -INFINITY; int bi = 0;
            for (int e = 0; e < E; ++e) if (((gmask >> (e / (E / NG))) & 1u) && !((taken >> e) & 1ull)) { const float v = bz(lg, bias, e); if (v > best) { best = v; bi = e; } }
            taken |= 1ull << bi; const float s = sigm(lg[bi]); se[k] = bi; sw[k] = s; wsum += s; }
        int* cnt = WSP(int, CTL_CNT);
        for (int k = 0; k < TOPK; ++k) { const int e = se[k]; const float w = sw[k] / wsum * 2.5f; const int rank = atomic_inc(cnt + cnt_idx((int)l, e)); sr[k] = rank; sw[k] = w;
            WSP(int, WS_TOK)[(size_t)e * M + rank] = (int)m; WSP(float, WS_WT)[(size_t)e * M + rank] = w; } }
    long count() const { return M; } };
struct OffF { Ctx c; long l;
    HD void operator()(long) const { int* o = WSP(int, WS_OFFT); const int* cnt = WSP(int, CTL_CNT); o[0] = 0; for (int e = 0; e <= E; ++e) { const int n = e < E ? cnt[cnt_idx((int)l, e)] : M; o[e + 1] = o[e] + (n + RT - 1) / RT; } }
    long count() const { return 1; } };
struct Moe1F { Ctx c; long l;
    HD void operator()(long i) const { const long f4c = FF / 4; const int f = (int)(i % f4c) * 4; const long r = i / f4c; const int rank = (int)(r % M), e = (int)(r / M);
        const int n = e < E ? WSP(int, CTL_CNT)[cnt_idx((int)l, e)] : M; if (rank >= n) return;
        const int tok = e < E ? WSP(int, WS_TOK)[(size_t)e * M + rank] : rank; const long row = (long)WSP(int, WS_OFFT)[e] * RT + rank;
        const float* wg = (e < E ? c.in[I_WGATE] + ((size_t)l * E + e) * D * FF : c.in[I_WSG] + (size_t)l * D * FF) + f;
        const float* wu = (e < E ? c.in[I_WUP] + ((size_t)l * E + e) * D * FF : c.in[I_WSU] + (size_t)l * D * FF) + f;
        const bf16_t* h = WSP(bf16_t, WS_HM) + (size_t)tok * D; float g0 = 0, g1 = 0, g2 = 0, g3 = 0, u0 = 0, u1 = 0, u2 = 0, u3 = 0;
        for (int k = 0; k < D; ++k) { const float a = bf2f(h[k]); const float* pg = wg + (size_t)k * FF; const float* pu = wu + (size_t)k * FF;
            g0 += a * pg[0]; g1 += a * pg[1]; g2 += a * pg[2]; g3 += a * pg[3]; u0 += a * pu[0]; u1 += a * pu[1]; u2 += a * pu[2]; u3 += a * pu[3]; }
        bf16_t* o = WSP(bf16_t, WS_ACT) + row * FF + f; o[0] = f2bf(siluf(g0) * u0); o[1] = f2bf(siluf(g1) * u1); o[2] = f2bf(siluf(g2) * u2); o[3] = f2bf(siluf(g3) * u3); }
    long count() const { return (long)(E + 1) * M * (FF / 4); } };
struct Moe2F { Ctx c; long l;
    HD void operator()(long i) const { const long d4c = D / 4; const int d = (int)(i % d4c) * 4; const long r = i / d4c; const int rank = (int)(r % M), e = (int)(r / M);
        const int n = e < E ? WSP(int, CTL_CNT)[cnt_idx((int)l, e)] : M; if (rank >= n) return;
        const long row = (long)WSP(int, WS_OFFT)[e] * RT + rank; const float wt = e < E ? WSP(float, WS_WT)[(size_t)e * M + rank] : 1.0f;
        const float* wd = (e < E ? c.in[I_WDOWN] + ((size_t)l * E + e) * FF * D : c.in[I_WSD] + (size_t)l * FF * D) + d;
        const bf16_t* a = WSP(bf16_t, WS_ACT) + row * FF; float y0 = 0, y1 = 0, y2 = 0, y3 = 0;
        for (int f = 0; f < FF; ++f) { const float v = bf2f(a[f]); const float* p = wd + (size_t)f * D; y0 += v * p[0]; y1 += v * p[1]; y2 += v * p[2]; y3 += v * p[3]; }
        bf16_t* o = WSP(bf16_t, WS_Y) + row * D + d; o[0] = f2bf(wt * y0); o[1] = f2bf(wt * y1); o[2] = f2bf(wt * y2); o[3] = f2bf(wt * y3); }
    long count() const { return (long)(E + 1) * M * (D / 4); } };
struct CombineF { Ctx c; const float* Xin; float* Xout; long l;
    HD void operator()(long i) const { const long m = i / D, n = i % D; const int b = (int)(m / S); const int* offt = WSP(int, WS_OFFT); const bf16_t* Y = WSP(bf16_t, WS_Y); float v = 0.f;
        for (int k = 0; k < TOPK; ++k) { const int e = WSP(int, WS_SELE)[m * TOPK + k], r = WSP(int, WS_SELR)[m * TOPK + k]; v += bf2f(Y[((size_t)offt[e] * RT + r) * D + n]); }
        v += bf2f(Y[((size_t)offt[E] * RT + m) * D + n]);
        Xout[i] = Xin[i] + WSP(float, WS_MOD)[((size_t)l * NB + b) * 6 * D + 5 * D + n] * v; }
    long count() const { return (long)M * D; } };
struct PostG3F { Ctx c; float sqs;
    HD void operator()(long i) const { const long m = i / CD_N; const int col = (int)(i % CD_N); const int t = (int)(m % S); const float* T = WSP(float, WS_T) + m * CD_N; bf16_t* P = WSP(bf16_t, WS_PROJ) + m * CD_N; const int W = H_C * DK;
        if (col < 2 * W) { const int j = col % DK; if (j < DK / 2) { const float sc = col < W ? 1.0f : 1.0f / sqrtf((float)DK); const float x1 = T[col], x2 = T[col + DK / 2], cs = WSP(float, WS_TAB + TAB_CT)[t * (DK / 2) + j], sn = WSP(float, WS_TAB + TAB_ST)[t * (DK / 2) + j];
                P[col] = f2bf((x1 * cs - x2 * sn) * sc); P[col + DK / 2] = f2bf((x2 * cs + x1 * sn) * sc); } }
        else if (col < 3 * W) P[col] = f2bf(T[col]);
        else if (col < 4 * W) P[col] = f2bf(siluf(T[col]));
        else if (col < 4 * W + H_D * HDS) P[col] = f2bf(T[col] * sqs);
        else P[col] = f2bf(T[col]); }
    long count() const { return (long)M * CD_N; } };
struct DecayF { Ctx c;
    HD void operator()(long i) const { const int mm = (int)(i % S); const long r = i / S; const int n = (int)(r % S), h = (int)(r / S);
        const float lgf = log1pf(-exp2f(-5.0f - h)), lgb = log1pf(-exp2f(-5.0f - (H_C - 1 - h)));
        WSP(float, WS_SC)[i] *= (n >= mm) ? expf(lgf * (n - mm)) : expf(lgb * (mm - n)); }
    long count() const { return (long)H_C * S * S; } };
struct RetNormF { Ctx c;
    HD void operator()(long i) const { const long m = i / H_C; const int h = (int)(i % H_C); const float* r = WSP(float, WS_RET) + m * HALF + h * DK; float s = 0.f; for (int j = 0; j < DK; ++j) s += r[j] * r[j];
        const float rs = 1.0f / sqrtf(s / DK + EPS); for (int j = 0; j < DK; ++j) WSP(bf16_t, WS_MIX)[m * D + h * DK + j] = f2bf(bf2f(WSP(bf16_t, WS_PROJ)[m * CD_N + 3 * H_C * DK + h * DK + j]) * (r[j] * rs * c.in[I_RETGN][h * DK + j])); }
    long count() const { return (long)M * H_C; } };
struct SwaSoftF { Ctx c;
    HD void operator()(long i) const { const int q = (int)(i % S), hd = (int)(i / S); float* r = WSP(float, WS_SC) + i * S; const float sink = c.in[I_SINKS][hd] * LOG2E; const float* rb = c.in[I_RELB];
        const int lo = q - WIN < 0 ? 0 : q - WIN, hi = q + WIN > S - 1 ? S - 1 : q + WIN; float mx = sink;
        for (int k = lo; k <= hi; ++k) { const float s = r[k] + rb[t5_bucket(k - q) * H_D + hd] * LOG2E; r[k] = s; mx = fmaxf(mx, s); }
        float den = exp2f(sink - mx); for (int k = lo; k <= hi; ++k) { const float p = exp2f(r[k] - mx); r[k] = p; den += p; }
        const float inv = 1.0f / den; for (int k = 0; k < S; ++k) r[k] = (k >= lo && k <= hi) ? r[k] * inv : 0.f; }
    long count() const { return (long)H_D * S; } };

#ifdef HOST_TEST
struct Launcher { template <class F> void operator()(const F& f, long n) const { for (long i = 0; i < n; ++i) f(i); } };
#else
template <class F> __global__ void __launch_bounds__(256) run_k(F f, long n) { for (long i = (long)blockIdx.x * 256 + threadIdx.x; i < n; i += (long)gridDim.x * 256) f(i); }
struct Launcher { hipStream_t st; template <class F> void operator()(const F& f, long n) const { long g = (n + 255) / 256; if (g > (1 << 20)) g = 1 << 20; if (g < 1) g = 1; hipLaunchKernelGGL(run_k<F>, dim3((unsigned)g), dim3(256), 0, st, f, n); } };
#endif

template <class F> static F zf() { F f; memset((void*)&f, 0, sizeof(F)); return f; }
static NGemm mk_gemm(const void* A, int a_bf, long a_rs, const void* B, int b_bf, long b_ks, long b_ns, void* C, int c_bf, long c_rs, long Mr, long N, long K) {
    NGemm g; memset((void*)&g, 0, sizeof(g)); g.A = A; g.B = B; g.C = C; g.a_bf = a_bf; g.b_bf = b_bf; g.c_bf = c_bf; g.a_rs = a_rs; g.a_ks = 1; g.b_ks = b_ks; g.b_ns = b_ns; g.c_rs = c_rs; g.Mr = Mr; g.N = N; g.K = K; g.Z2 = 1; return g; }

template <class L> static void rowss(const L& go, const Ctx& c, const float* X, float* out, long rs, long ncols, long os = 1) { RowSSF f = zf<RowSSF>(); f.c = c; f.X = X; f.out = out; f.rs = rs; f.ncols = ncols; f.rows = M; f.os = os; go(f, f.count()); }

enum { PH_P0 = 0, PH_MOD0, PH_G1, PH_G2, PH_SCAN0, PH_ATT0, PH_OUT0, PH_RT0, PH_M1_0, PH_M2_0, PH_CMB0, PH_G3, PH_RET1, PH_SWA1, PH_RN1, PH_OUT1, PH_RT1, PH_M1_1, PH_M2_1, PH_CMB1, N_PHASES };

template <class L> static void naive_phase(const L& go, const Ctx& c, int ph) {
    float* mod = WSP(float, WS_MOD);
    const int l = ph >= PH_G3 ? 1 : 0;
    float* X1 = WSP(float, WS_X1); float* X2 = WSP(float, WS_X2);
    switch (ph) {
    case PH_P0: { { ModF f = zf<ModF>(); f.c = c; go(f, f.count()); } { TabF f = zf<TabF>(); f.c = c; go(f, f.count()); } } break;
    case PH_MOD0: { rowss(go, c, c.in[I_X], WSP(float, WS_RSTD), D, D);
        ModulateF f = zf<ModulateF>(); f.c = c; f.X = c.in[I_X]; f.gain = c.in[I_NMIX]; f.sc = mod + D; f.sh = mod; go(f, f.count()); } break;
    case PH_G1: { { NGemm g = mk_gemm(WSP(bf16_t, WS_HM), 1, D, c.in[I_WINAB], 0, AB_N, 1, WSP(float, WS_T), 0, AB_N, M, AB_N, D); go(g, g.count(1)); }
        { PostG1F f = zf<PostG1F>(); f.c = c; go(f, f.count()); }
        rowss(go, c, WSP(float, WS_T), WSP(float, CTL_SSQ), AB_N, QR, 16);
        rowss(go, c, WSP(float, WS_T) + QR, WSP(float, CTL_SSQ) + 8, AB_N, KVR, 16);
        { KRopeF f = zf<KRopeF>(); f.c = c; go(f, f.count()); } } break;
    case PH_G2: { { NGemm g = mk_gemm(WSP(bf16_t, WS_PROJ), 1, P0_N, c.in[I_WUQ], 0, H_A * QK, 1, WSP(float, WS_T), 0, H_A * QK, M, H_A * QK, QR); g.ks = c.in[I_QLN]; go(g, g.count(1)); }
        { PostQF f = zf<PostQF>(); f.c = c; f.qs = LOG2E / sqrtf((float)QK); go(f, f.count()); }
        { NGemm g = mk_gemm(WSP(bf16_t, WS_PROJ) + QR, 1, P0_N, c.in[I_WUKV], 0, H_A * (NOPE + VD), 1, WSP(float, WS_T), 0, H_A * (NOPE + VD), M, H_A * (NOPE + VD), KVR); g.ks = c.in[I_KVLN]; go(g, g.count(1)); }
        { PostKVF f = zf<PostKVF>(); f.c = c; go(f, f.count()); }
        { ConvF f = zf<ConvF>(); f.c = c; go(f, f.count()); }
        { GatesF f = zf<GatesF>(); f.c = c; go(f, f.count()); } } break;
    case PH_SCAN0: { ScanF f = zf<ScanF>(); f.c = c; go(f, f.count()); } break;
    case PH_ATT0: {
        for (int b = 0; b < NB; ++b) {
            NGemm g = mk_gemm(WSP(bf16_t, WS_Q) + (size_t)b * S * H_A * QK, 1, H_A * QK, WSP(bf16_t, WS_KC) + (size_t)b * S * H_A * QK, 1, 1, H_A * QK, WSP(float, WS_SC), 0, S, S, S, QK);
            g.a_z2 = QK; g.b_z2 = QK; g.c_z2 = (long)S * S; g.Z2 = H_A; go(g, g.count(H_A));
            { SoftmaxF f = zf<SoftmaxF>(); f.c = c; f.rows = (long)H_A * S; go(f, f.count()); }
            NGemm p = mk_gemm(WSP(float, WS_SC), 0, S, WSP(bf16_t, WS_V) + (size_t)b * S * H_A * VD, 1, H_A * VD, 1, WSP(bf16_t, WS_MIX) + (size_t)b * S * D, 1, D, S, VD, S);
            p.a_z2 = (long)S * S; p.b_z2 = VD; p.c_z2 = VD; p.Z2 = H_A; go(p, p.count(H_A)); } } break;
    case PH_OUT0: case PH_OUT1: { NGemm g = mk_gemm(WSP(bf16_t, WS_MIX), 1, D, c.in[l ? I_WOUTCD : I_WOUTAB], 0, D, 1, WSP(float, WS_T), 0, D, M, D, D); go(g, g.count(1));
        OutPostF f = zf<OutPostF>(); f.c = c; f.Xin = l ? X2 : c.in[I_X]; f.Xout = X1; f.l = l; go(f, f.count()); } break;
    case PH_RT0: case PH_RT1: { float* modl = mod + (size_t)l * NB * 6 * D;
        rowss(go, c, X1, WSP(float, WS_RSTD), D, D);
        { ModulateF f = zf<ModulateF>(); f.c = c; f.X = X1; f.gain = c.in[I_NFFN] + l * D; f.sc = modl + 4 * D; f.sh = modl + 3 * D; go(f, f.count()); }
        { NGemm g = mk_gemm(WSP(bf16_t, WS_HM), 1, D, c.in[I_WROUTER] + (size_t)l * D * E, 0, E, 1, WSP(float, WS_T), 0, E, M, E, D); go(g, g.count(1)); }
        { RouteF f = zf<RouteF>(); f.c = c; f.l = l; go(f, f.count()); } } break;
    case PH_M1_0: case PH_M1_1: { Moe1F f = zf<Moe1F>(); f.c = c; f.l = l; go(f, f.count()); } break;
    case PH_M2_0: case PH_M2_1: { Moe2F f = zf<Moe2F>(); f.c = c; f.l = l; go(f, f.count()); } break;
    case PH_CMB0: { { CombineF f = zf<CombineF>(); f.c = c; f.Xin = X1; f.Xout = X2; f.l = 0; go(f, f.count()); }
        rowss(go, c, X2, WSP(float, WS_RSTD), D, D);
        ModulateF f = zf<ModulateF>(); f.c = c; f.X = X2; f.gain = c.in[I_NMIX] + D; f.sc = mod + (size_t)NB * 6 * D + D; f.sh = mod + (size_t)NB * 6 * D; go(f, f.count()); } break;
    case PH_CMB1: { { CombineF f = zf<CombineF>(); f.c = c; f.Xin = X1; f.Xout = X2; f.l = 1; go(f, f.count()); }
        rowss(go, c, X2, WSP(float, WS_RSTD), D, D);
        FinalF f = zf<FinalF>(); f.c = c; f.X = X2; go(f, f.count()); } break;
    case PH_G3: { { NGemm g = mk_gemm(WSP(bf16_t, WS_HM), 1, D, c.in[I_WINCD], 0, CD_N, 1, WSP(float, WS_T), 0, CD_N, M, CD_N, D); go(g, g.count(1)); }
        PostG3F f = zf<PostG3F>(); f.c = c; f.sqs = LOG2E / sqrtf((float)HDS); go(f, f.count()); } break;
    case PH_RET1: {
        for (int b = 0; b < NB; ++b) {
            const bf16_t* Pb = WSP(bf16_t, WS_PROJ) + (size_t)b * S * CD_N;
            NGemm g = mk_gemm(Pb, 1, CD_N, Pb + H_C * DK, 1, 1, CD_N, WSP(float, WS_SC), 0, S, S, S, DK);
            g.a_z2 = DK; g.b_z2 = DK; g.c_z2 = (long)S * S; g.Z2 = H_C; go(g, g.count(H_C));
            { DecayF f = zf<DecayF>(); f.c = c; go(f, f.count()); }
            NGemm p = mk_gemm(WSP(float, WS_SC), 0, S, Pb + 2 * H_C * DK, 1, CD_N, 1, WSP(float, WS_RET) + (size_t)b * S * HALF, 0, HALF, S, DK, S);
            p.a_z2 = (long)S * S; p.b_z2 = DK; p.c_z2 = DK; p.Z2 = H_C; go(p, p.count(H_C)); } } break;
    case PH_SWA1: {
        for (int b = 0; b < NB; ++b) {
            const bf16_t* Pb = WSP(bf16_t, WS_PROJ) + (size_t)b * S * CD_N + 4 * H_C * DK; const int G = H_D / KVH;
            NGemm g = mk_gemm(Pb, 1, CD_N, Pb + H_D * HDS, 1, 1, CD_N, WSP(float, WS_SC), 0, S, S, S, HDS);
            g.a_z1 = (long)G * HDS; g.a_z2 = HDS; g.b_z1 = HDS; g.b_z2 = 0; g.c_z1 = (long)G * S * S; g.c_z2 = (long)S * S; g.Z2 = G; go(g, g.count(H_D));
            { SwaSoftF f = zf<SwaSoftF>(); f.c = c; go(f, f.count()); }
            NGemm p = mk_gemm(WSP(float, WS_SC), 0, S, Pb + H_D * HDS + KVH * HDS, 1, CD_N, 1, WSP(bf16_t, WS_MIX) + (size_t)b * S * D + HALF, 1, D, S, HDS, S);
            p.a_z1 = (long)G * S * S; p.a_z2 = (long)S * S; p.b_z1 = HDS; p.b_z2 = 0; p.c_z1 = (long)G * HDS; p.c_z2 = HDS; p.Z2 = G; go(p, p.count(H_D)); } } break;
    case PH_RN1: { RetNormF f = zf<RetNormF>(); f.c = c; go(f, f.count()); } break;
    default: break;
    }
}
template <class L> static void naive_offt(const L& go, const Ctx& c, int l) { OffF f = zf<OffF>(); f.c = c; f.l = l; go(f, f.count()); }

#ifdef HOST_TEST
template <class L> static void run_all(const L& go, const Ctx& c) {
    for (int ph = 0; ph < N_PHASES; ++ph) { naive_phase(go, c, ph); if (ph == PH_RT0 || ph == PH_RT1) naive_offt(go, c, ph == PH_RT1); }
}
#endif
#ifndef HOST_TEST
#define LAS __attribute__((address_space(3)))
#define GAS __attribute__((address_space(1)))
typedef unsigned v4u __attribute__((ext_vector_type(4)));
typedef unsigned u32x2 __attribute__((ext_vector_type(2)));
typedef float f32x4 __attribute__((ext_vector_type(4)));
typedef float f32x16 __attribute__((ext_vector_type(16)));
typedef short bf16x8 __attribute__((ext_vector_type(8)));
typedef short s16x4 __attribute__((ext_vector_type(4)));
typedef int v8i_t __attribute__((ext_vector_type(8)));
typedef int v4i_t __attribute__((ext_vector_type(4)));
typedef GAS unsigned gu32;
#define RLX_AGENT __ATOMIC_RELAXED, __HIP_MEMORY_SCOPE_AGENT
#define LDS_WAIT() asm volatile("s_waitcnt lgkmcnt(0)" ::: "memory")
#define VM_WAIT() asm volatile("s_waitcnt vmcnt(0)" ::: "memory")
constexpr int NWAVES = 8, NTHR = 512;
constexpr int LDS_BYTES = 147456, MISC_OFF = LDS_BYTES - 2048, TAB_OFF = MISC_OFF + 1024;
__device__ __forceinline__ int lane_id() { int l; asm volatile("v_mbcnt_lo_u32_b32 %0, -1, 0\n\tv_mbcnt_hi_u32_b32 %0, -1, %0" : "=v"(l)); return l; }
__device__ __forceinline__ unsigned cvt_pk_bf16(float lo, float hi) { unsigned r; asm volatile("v_cvt_pk_bf16_f32 %0, %1, %2" : "=v"(r) : "v"(lo), "v"(hi)); return r; }
__device__ __forceinline__ float fast_sigm(float x) { return __builtin_amdgcn_rcpf(1.0f + __builtin_amdgcn_exp2f(-1.4426950408889634f * x)); }
__device__ __forceinline__ float fast_silu(float x) { return x * fast_sigm(x); }
__device__ __forceinline__ float fast_gelu_tanh(float x) { const float z = 0.7978845608028654f * (x + 0.044715f * x * x * x); return x * fast_sigm(2.0f * z); }
__device__ __forceinline__ float wave_sum(float v) {
#pragma unroll
    for (int o = 1; o < 64; o <<= 1) v += __shfl_xor(v, o);
    return v; }

#define XB_TMO      128
#define XB_XCNT(j)  (256  + 64 * (j))
#define XB_XSUB(j)  (1280 + 64 * (j))
#define XB_XGEN(j)  (2304 + 64 * (j))
#define XB_TOP      3328
#define XB_TOPGEN   3392
#define XCD_BAR_WORDS 3456
#define XB_SPIN_CAP (1u << 20)
__device__ __forceinline__ unsigned xb_ld(unsigned* p)              { return __hip_atomic_load(p, __ATOMIC_RELAXED, __HIP_MEMORY_SCOPE_AGENT); }
__device__ __forceinline__ unsigned xb_add(unsigned* p, unsigned v) { return __hip_atomic_fetch_add(p, v, __ATOMIC_RELAXED, __HIP_MEMORY_SCOPE_AGENT); }
__device__ __forceinline__ unsigned xb_xcc_id() { return (unsigned)__builtin_amdgcn_s_getreg((3 << 11) | 20) & 0xFu; }
#define XB_SPIN(cond, bar) do { unsigned _sp = 0; while (cond) { __builtin_amdgcn_s_sleep(1); \
    if ((++_sp & 255u) == 0u) { if (xb_ld(&(bar)[XB_TMO])) break; if (_sp > XB_SPIN_CAP) { atomicAdd(&(bar)[XB_TMO], 1u); break; } } } } while (0)
struct XcdBarrier { unsigned* bar; unsigned x; volatile LAS unsigned* st; int wave; };
__device__ __forceinline__ XcdBarrier xcd_barrier_post(unsigned* bar, volatile LAS unsigned* st, int wave) {
    XcdBarrier b; b.bar = bar; b.x = xb_xcc_id(); b.st = st; b.wave = wave;
    if (wave == 0 && lane_id() == 0) (void)xb_add(&bar[XB_XCNT(b.x)], 1u);
    return b; }
__device__ __forceinline__ void xcd_barrier_complete(unsigned* bar, unsigned x, unsigned& nloc, unsigned& nx) {
    const unsigned G = gridDim.x * gridDim.y * gridDim.z;
    unsigned sum, cnt, mine, sp = 0u;
    for (;;) {
        sum = 0u; cnt = 0u; mine = 0u;
#pragma unroll
        for (unsigned j = 0; j < 16; ++j) { const unsigned c = xb_ld(&bar[XB_XCNT(j)]); sum += c; cnt += (c > 0u) ? 1u : 0u; mine = (j == x) ? c : mine; }
        if (sum == G) break;
        __builtin_amdgcn_s_sleep(1);
        if ((++sp & 255u) == 0u) { if (xb_ld(&bar[XB_TMO])) break; if (sp > XB_SPIN_CAP) { atomicAdd(&bar[XB_TMO], 1u); break; } }
    }
    nloc = mine > 0u ? mine : 1u; nx = cnt > 0u ? cnt : 1u; }
__device__ __forceinline__ void xcd_barrier(const XcdBarrier& b) {
    asm volatile("s_waitcnt vmcnt(0)" ::: "memory");
    __syncthreads();
    if (b.wave == 0 && lane_id() == 0) {
        unsigned* bar = b.bar;
        __builtin_amdgcn_s_waitcnt(0);
        unsigned nloc = b.st[0], nx = b.st[1];
        if (nloc == 0u) { xcd_barrier_complete(bar, b.x, nloc, nx); b.st[0] = nloc; b.st[1] = nx; }
        const unsigned old = xb_add(&bar[XB_XSUB(b.x)], 1u);
        const unsigned gen = old / nloc;
        if (old + 1u == (gen + 1u) * nloc) {
            __builtin_amdgcn_fence(__ATOMIC_RELEASE, "agent");
            asm volatile("s_waitcnt vmcnt(0)" ::: "memory");
            const unsigned og = xb_add(&bar[XB_TOP], 1u);
            const unsigned tg = og / nx;
            if (og + 1u == (tg + 1u) * nx) xb_add(&bar[XB_TOPGEN], 1u);
            else XB_SPIN(xb_ld(&bar[XB_TOPGEN]) == tg, bar);
            __builtin_amdgcn_fence(__ATOMIC_ACQUIRE, "agent");
            xb_add(&bar[XB_XGEN(b.x)], 1u);
            asm volatile("s_waitcnt vmcnt(0)" ::: "memory");
        } else {
            XB_SPIN(xb_ld(&bar[XB_XGEN(b.x)]) == gen, bar);
            __builtin_amdgcn_fence(__ATOMIC_ACQUIRE, "agent");
            asm volatile("s_waitcnt vmcnt(0)" ::: "memory");
        }
    }
    __syncthreads();
}

namespace pg8 {
constexpr int BM = 256, BK = 64, HALFT = 128, HTB = HALFT * BK * 2, STAGE_BYTES = 8 * HTB, NXCD = 8, WGM = 8;
__host__ __device__ __forceinline__ int lds_byte(int r, int c) { const int st = (r >> 4) * 2 + (c >> 5), rr = r & 15, cc = c & 31, ob = rr * 64 + cc * 2; return st * 1024 + (ob ^ (((ob >> 9) & 1) << 5)); }
__host__ __device__ __forceinline__ void stage_rc(int b, int& R, int& C) { const int st = b / 1024, sb = b % 1024, swz = sb ^ (((sb >> 9) & 1) << 5); R = (st >> 1) * 16 + swz / 64; C = (st & 1) * 32 + (swz % 64) / 2; }
__host__ __device__ __forceinline__ int perm32(int rho) { const int n = rho >> 4, i = rho & 15; return 8 * (i >> 2) + 4 * n + (i & 3); }
struct Unit { const char* A; const char* B; int pm, pn, e, r0; };
__device__ __forceinline__ void tile_of(int L, int nM, int nN, int& pm, int& pn) {
    const int nwg = nM * nN; int wgid = L; { const int q = nwg / NXCD, r = nwg % NXCD, xcd = wgid % NXCD, off = wgid / NXCD; wgid = (xcd < r ? xcd * (q + 1) : r * (q + 1) + (xcd - r) * q) + off; }
    const int nig = WGM * nN, gid = wgid / nig, fm = gid * WGM, gsz = (nM - fm) < WGM ? (nM - fm) : WGM;
    pm = fm + ((wgid % nig) % gsz); pn = (wgid % nig) / gsz; }
template <class E_, class = void> struct perm16_t { static constexpr bool value = false; };
template <class E_> struct perm16_t<E_, decltype((void)E_::PERM16)> { static constexpr bool value = E_::PERM16; };
template <class E_> constexpr bool perm16_v = perm16_t<E_>::value;
struct APlain { static __device__ __forceinline__ const char* kt(const char* base, int t, int) { return base + (size_t)t * (BK * 2); } };
struct AConv { static __device__ __forceinline__ const char* kt(const char* base, int t, int lda) { return base + (long)((t >> 1) - 2) * (lda * 2) + (t & 1) * (BK * 2); } };

template <class Epi, class Sched, class AP, bool GATHER, bool ALIGN_EPI, int EB = 2>
__device__ __forceinline__ void gemm_phase(LAS unsigned char* lds, const int wave, const char* base, const int lda, const int ldb, const int K, const Sched& S, const Epi& E) {
    const __amdgpu_buffer_rsrc_t rsrc = __builtin_amdgcn_make_buffer_rsrc((void*)base, (short)0, -1, 0x00020000);
    const int wid = __builtin_amdgcn_readfirstlane(wave), lane = lane_id(), tid = wid * 64 + lane, wr = wid >> 2, wc = wid & 3, fr = lane & 15, fq = lane >> 4;
    const int nt = K / BK;
    unsigned vA[2][2], vAn[2][2], vB[2], vB1[2];
#pragma unroll
    for (int i = 0; i < 2; ++i) { int R, C; stage_rc(tid * 16 + i * 8192, R, C); const int Rb = Epi::PERM ? ((R & ~31) + perm32(R & 31)) : R;
        if constexpr (perm16_v<Epi>) { const int wcR = R >> 5, rho = R & 31, n_ = rho >> 4, i_ = rho & 15; const int src0 = 64 * wcR + 16 * (i_ >> 2) + 4 * n_ + (i_ & 3);
            vB[i] = (unsigned)(src0 * ldb + C) * 2u; vB1[i] = (unsigned)((src0 + 8) * ldb + C) * 2u; }
        else { vB[i] = (unsigned)(Rb * ldb + C) * 2u; vB1[i] = 0u; }
#pragma unroll
        for (int h = 0; h < 2; ++h) { vA[h][i] = GATHER ? (unsigned)C * 2u : (h == 0 ? (unsigned)(R * lda + C) * 2u : 0u); vAn[h][i] = vA[h][i]; } }
    const size_t kstep = (size_t)(BK * 2), hstepB = (size_t)HALFT * ldb * 2, hB1 = perm16_v<Epi> ? 0 : hstepB;
    const unsigned (&vBs)[2] = perm16_v<Epi> ? vB1 : vB;
    const unsigned (&vA1)[2] = GATHER ? vA[1] : vA[0]; const size_t hA1 = GATHER ? 0 : (size_t)HALFT * lda * 2;
    const unsigned ldsw = (unsigned)wid * 1024u;
    const int aoff = lds_byte(wr * 64 + fr, fq * 8), boff = lds_byte(wc * 32 + fr, fq * 8);
#define PG8_SA(b, h) (((b) * 2 + (h)) * HTB)
#define PG8_SB(b, h) ((4 + (b) * 2 + (h)) * HTB)
#define PG8_STAGE(bufoff, gbase, voff) do { const int so_ = (int)(unsigned)(size_t)((const char*)(gbase) - base); _Pragma("unroll") for (int _i = 0; _i < 2; ++_i) \
        __builtin_amdgcn_raw_ptr_buffer_load_lds(rsrc, (LAS void*)(lds + (bufoff) + ldsw + _i * 8192), 16, (int)(voff)[_i], so_, 0, 0); } while (0)
#define PG8_LDA(dst, b, h) do { _Pragma("unroll") for (int m = 0; m < 4; ++m) { if constexpr (EB == 2) { _Pragma("unroll") for (int k = 0; k < 2; ++k) dst[m][k] = *(const LAS bf16x8*)(lds + PG8_SA(b, h) + aoff + m * 2048 + k * 1024); } \
        else { const v4i_t lo_ = *(const LAS v4i_t*)(lds + PG8_SA(b, h) + aoff + m * 2048), hi_ = *(const LAS v4i_t*)(lds + PG8_SA(b, h) + aoff + m * 2048 + 1024); dst##8[m] = __builtin_shufflevector(lo_, hi_, 0, 1, 2, 3, 4, 5, 6, 7); } } } while (0)
#define PG8_LDB(dst, b, h) do { _Pragma("unroll") for (int n = 0; n < 2; ++n) { if constexpr (EB == 2) { _Pragma("unroll") for (int k = 0; k < 2; ++k) dst[n][k] = *(const LAS bf16x8*)(lds + PG8_SB(b, h) + boff + n * 2048 + k * 1024); } \
        else { const v4i_t lo_ = *(const LAS v4i_t*)(lds + PG8_SB(b, h) + boff + n * 2048), hi_ = *(const LAS v4i_t*)(lds + PG8_SB(b, h) + boff + n * 2048 + 1024); dst##8[n] = __builtin_shufflevector(lo_, hi_, 0, 1, 2, 3, 4, 5, 6, 7); } } } while (0)
#define PG8_MMA(ai, bj, At, Bt) do { __builtin_amdgcn_s_setprio(1); _Pragma("unroll") for (int m = 0; m < 4; ++m) _Pragma("unroll") for (int n = 0; n < 2; ++n) { \
        if constexpr (EB == 2) { _Pragma("unroll") for (int k = 0; k < 2; ++k) acc[ai][bj][m][n] = __builtin_amdgcn_mfma_f32_16x16x32_bf16(Bt[n][k], At[m][k], acc[ai][bj][m][n], 0, 0, 0); } \
        else acc[ai][bj][m][n] = __builtin_amdgcn_mfma_scale_f32_16x16x128_f8f6f4(Bt##8[n], At##8[m], acc[ai][bj][m][n], 0, 0, 0, 0x7F7F7F7F, 0, 0x7F7F7F7F); } \
        __builtin_amdgcn_s_setprio(0); } while (0)
#define PG8_WAIT_V(n) asm volatile("s_waitcnt vmcnt(" #n ")" ::: "memory")
#define PG8_WAIT_L(n) asm volatile("s_waitcnt lgkmcnt(" #n ")" ::: "memory")
#define PG8_BAR __builtin_amdgcn_s_barrier()
#define PG8_SCHED __builtin_amdgcn_sched_barrier(0)
    Unit cur, nxt; int ui = 0;
    if (!S.next(0, cur)) return;
    f32x4 acc[2][2][4][2];
#pragma unroll
    for (int a = 0; a < 2; ++a)
#pragma unroll
        for (int b = 0; b < 2; ++b)
#pragma unroll
            for (int m = 0; m < 4; ++m)
#pragma unroll
                for (int n = 0; n < 2; ++n) acc[a][b][m][n] = (f32x4){0.f, 0.f, 0.f, 0.f};
    bf16x8 At[4][2], B0[2][2], B1[2][2]; v8i_t At8[4], B08[2], B18[2];
    if constexpr (GATHER) {
#pragma unroll
        for (int h = 0; h < 2; ++h)
#pragma unroll
            for (int i = 0; i < 2; ++i) { int R_, C_; stage_rc(tid * 16 + i * 8192, R_, C_); vA[h][i] = (unsigned)S.row(cur, h * HALFT + R_) * (unsigned)(lda * 2) + (unsigned)C_ * 2u; vAn[h][i] = vA[h][i]; }
        PG8_WAIT_V(0);
    }
    const char* cA = cur.A; const char* cB = cur.B;
    PG8_STAGE(PG8_SB(0, 0), cB, vB); PG8_STAGE(PG8_SB(0, 1), cB + hB1, vBs); PG8_STAGE(PG8_SA(0, 0), AP::kt(cA, 0, lda), vA[0]); PG8_STAGE(PG8_SA(0, 1), AP::kt(cA, 0, lda) + hA1, vA1);
    if (wr == 1) PG8_BAR;
    PG8_WAIT_V(2); PG8_BAR;
    PG8_STAGE(PG8_SB(1, 0), cB + kstep, vB); PG8_STAGE(PG8_SA(1, 0), AP::kt(cA, 1, lda), vA[0]); PG8_STAGE(PG8_SB(1, 1), cB + hB1 + kstep, vBs);
    PG8_WAIT_V(6); PG8_BAR;
    for (;;) {
        const bool has_next = S.next(ui + 1, nxt);
        const char* nA = has_next ? nxt.A : cA; const char* nB = has_next ? nxt.B : cB;
        if constexpr (GATHER) {
            if (has_next) {
#pragma unroll
                for (int h = 0; h < 2; ++h)
#pragma unroll
                    for (int i = 0; i < 2; ++i) { int R_, C_; stage_rc(tid * 16 + i * 8192, R_, C_); vAn[h][i] = (unsigned)S.row(nxt, h * HALFT + R_) * (unsigned)(lda * 2) + (unsigned)C_ * 2u; }
                PG8_WAIT_V(0);
            }
        }
#pragma unroll 1
        for (int t = 0; t < nt; t += 2) {
            const bool last = (t == nt - 2);
            const char* a1 = AP::kt(cA, t + 1, lda);
            const char* a2 = last ? AP::kt(nA, 0, lda) : AP::kt(cA, t + 2, lda); const char* a3 = last ? AP::kt(nA, 1, lda) : AP::kt(cA, t + 3, lda);
            const char* b2 = last ? nB : cB + (size_t)(t + 2) * kstep; const char* b3 = b2 + kstep;
            PG8_LDB(B0, 0, 0); PG8_LDB(B1, 0, 1); PG8_SCHED; PG8_LDA(At, 0, 0); PG8_STAGE(PG8_SA(1, 1), a1 + hA1, vA1);
            if constexpr (GATHER) { if (last) { _Pragma("unroll") for (int h = 0; h < 2; ++h) _Pragma("unroll") for (int i = 0; i < 2; ++i) vA[h][i] = vAn[h][i]; } }
            PG8_WAIT_V(8); PG8_WAIT_L(0); PG8_BAR; PG8_MMA(0, 0, At, B0); PG8_MMA(0, 1, At, B1); PG8_BAR; PG8_SCHED;
            PG8_LDA(At, 0, 1); PG8_STAGE(PG8_SB(0, 0), b2, vB); PG8_STAGE(PG8_SB(0, 1), b2 + hB1, vBs); PG8_STAGE(PG8_SA(0, 0), a2, vA[0]);
            PG8_WAIT_V(8); PG8_WAIT_L(0); PG8_BAR; PG8_MMA(1, 0, At, B0); PG8_MMA(1, 1, At, B1); PG8_BAR; PG8_SCHED;
            PG8_LDB(B0, 1, 0); PG8_LDB(B1, 1, 1); PG8_SCHED; PG8_LDA(At, 1, 0); PG8_STAGE(PG8_SA(0, 1), a2 + hA1, vA1);
            PG8_WAIT_V(8); PG8_WAIT_L(0); PG8_BAR; PG8_MMA(0, 0, At, B0); PG8_MMA(0, 1, At, B1); PG8_BAR; PG8_SCHED;
            PG8_LDA(At, 1, 1); PG8_STAGE(PG8_SB(1, 0), b3, vB); PG8_STAGE(PG8_SB(1, 1), b3 + hB1, vBs); PG8_STAGE(PG8_SA(1, 0), a3, vA[0]);
            PG8_WAIT_V(8); PG8_WAIT_L(0); PG8_BAR; PG8_MMA(1, 0, At, B0); PG8_MMA(1, 1, At, B1); PG8_BAR; PG8_SCHED;
        }
        if constexpr (ALIGN_EPI) { if (wr == 0) PG8_BAR; }
        { const int l2_ = lane_id();
          E(acc, cur, wr, wc, l2_ & 15, l2_ >> 4);
#ifdef PROBE_EPI2
          if (Epi::PROBE2) { asm volatile("s_waitcnt vmcnt(0)" ::: "memory"); E(acc, cur, wr, wc, l2_ & 15, l2_ >> 4); }
#endif
          }
        if (!has_next) break;
#pragma unroll
        for (int a = 0; a < 2; ++a)
#pragma unroll
            for (int b = 0; b < 2; ++b)
#pragma unroll
                for (int m = 0; m < 4; ++m)
#pragma unroll
                    for (int n = 0; n < 2; ++n) acc[a][b][m][n] = (f32x4){0.f, 0.f, 0.f, 0.f};
        cur = nxt; cA = nA; cB = nB; ++ui;
        if constexpr (GATHER) {
#pragma unroll
            for (int h = 0; h < 2; ++h)
#pragma unroll
                for (int i = 0; i < 2; ++i) vA[h][i] = vAn[h][i];
        }
        if constexpr (ALIGN_EPI) { if (wr == 1) PG8_BAR; }
    }
    PG8_WAIT_V(0);
    if constexpr (!ALIGN_EPI) { if (wr == 0) PG8_BAR; }
    PG8_BAR;
#undef PG8_SA
#undef PG8_SB
#undef PG8_STAGE
#undef PG8_LDA
#undef PG8_LDB
#undef PG8_MMA
#undef PG8_WAIT_V
#undef PG8_WAIT_L
#undef PG8_BAR
#undef PG8_SCHED
}

struct DenseOrder {
    const char* A; const char* B; int nM, nN, G, c; long a_tile, b_tile;
    __device__ __forceinline__ bool next(int i, Unit& u) const { const long L = (long)i * G + c; if (L >= (long)nM * nN) return false; int pm, pn; tile_of((int)L, nM, nN, pm, pn);
        u.pm = pm; u.pn = pn; u.e = 0; u.r0 = pm * BM; u.A = A + (size_t)pm * a_tile; u.B = B + (size_t)pn * b_tile; return true; }
    __device__ __forceinline__ int row(const Unit&, int) const { return 0; }
};
}
namespace pg8 {
typedef const f32x4 (&AccRef)[2][2][4][2];
__device__ __forceinline__ const LAS int* lds_tab() { unsigned a; asm volatile("v_mov_b32 %0, %1" : "=v"(a) : "i"(TAB_OFF)); return (const LAS int*)(size_t)a; }
__device__ __forceinline__ v4u pack8(const f32x4 a, const f32x4 b) { v4u w; w.x = cvt_pk_bf16(a[0], a[1]); w.y = cvt_pk_bf16(a[2], a[3]); w.z = cvt_pk_bf16(b[0], b[1]); w.w = cvt_pk_bf16(b[2], b[3]); return w; }

struct EpiOut {
    static constexpr bool PERM = false; static constexpr bool PROBE2 = false;
    const float* Xin; float* Xout; const float* g;
    __device__ __forceinline__ void operator()(AccRef acc, const Unit& u, int wr, int wc, int fr, int fq) const {
        const int b = u.r0 / S; const int col0 = u.pn * BM + wc * 32 + 4 * fq; f32x4 gv[2][2];
#pragma unroll
        for (int bj = 0; bj < 2; ++bj)
#pragma unroll
            for (int n = 0; n < 2; ++n) gv[bj][n] = *(const f32x4*)(g + (size_t)b * 6 * D + col0 + bj * HALFT + n * 16);
#pragma unroll
        for (int ai = 0; ai < 2; ++ai) { f32x4 xi[4][2][2];
#pragma unroll
            for (int m = 0; m < 4; ++m) { const size_t off = (size_t)(u.r0 + ai * HALFT + wr * 64 + m * 16 + fr) * D + col0;
#pragma unroll
                for (int bj = 0; bj < 2; ++bj)
#pragma unroll
                    for (int n = 0; n < 2; ++n) xi[m][bj][n] = __builtin_nontemporal_load((const f32x4*)(Xin + off + bj * HALFT + n * 16)); }
#pragma unroll
            for (int m = 0; m < 4; ++m) { const size_t off = (size_t)(u.r0 + ai * HALFT + wr * 64 + m * 16 + fr) * D + col0;
#pragma unroll
                for (int bj = 0; bj < 2; ++bj)
#pragma unroll
                    for (int n = 0; n < 2; ++n) *(f32x4*)(Xout + off + bj * HALFT + n * 16) = xi[m][bj][n] + gv[bj][n] * acc[ai][bj][m][n]; }
            asm volatile("" ::: "memory"); }
    }
};
struct EpiG1 {
    static constexpr bool PERM = true; static constexpr bool PROBE2 = false;
    bf16_t* proj; bf16_t* lxp; float* ssq;
    __device__ __forceinline__ void operator()(AccRef acc, const Unit& u, int wr, int wc, int fr, int fq) const {
        const int pn = u.pn; const int c0 = pn * BM + wc * 32 + 8 * fq; const int NT_LAT = (QR + KVR) / BM, NT_X = LW / BM;
#pragma unroll
        for (int ai = 0; ai < 2; ++ai)
#pragma unroll
            for (int m = 0; m < 4; ++m) { const int row = u.r0 + ai * HALFT + wr * 64 + m * 16 + fr; float ss = 0.f;
#pragma unroll
                for (int bj = 0; bj < 2; ++bj) { f32x4 v0 = acc[ai][bj][m][0], v1 = acc[ai][bj][m][1];
                    if (pn < NT_LAT) { ss += (v0[0] * v0[0] + v0[1] * v0[1]) + (v0[2] * v0[2] + v0[3] * v0[3]) + (v1[0] * v1[0] + v1[1] * v1[1]) + (v1[2] * v1[2] + v1[3] * v1[3]); }
                    if (pn >= NT_LAT + NT_X) {
#pragma unroll
                        for (int j = 0; j < 4; ++j) { v0[j] = fast_gelu_tanh(v0[j]); v1[j] = fast_gelu_tanh(v1[j]); } }
                    const v4u w = pack8(v0, v1);
                    *(v4u*)(proj + (size_t)row * P0_N + c0 + bj * HALFT) = w;
                    if (pn >= NT_LAT && pn < NT_LAT + NT_X) { const int b = row / S, t = row % S; *(v4u*)(lxp + ((size_t)b * (S + 4) + 2 + t) * LW + (c0 + bj * HALFT - (QR + KVR))) = w; } }
                if (pn < NT_LAT) { ss += __shfl_xor(ss, 16); ss += __shfl_xor(ss, 32); if (fq == 0) ssq[(size_t)row * 16 + pn * 4 + wc] = ss; } }
    }
};
struct EpiG2 {
    static constexpr bool PERM = true; static constexpr bool PROBE2 = false;
    bf16_t* Q; bf16_t* KC; bf16_t* V; const float* ssq; const float* cosr; const float* sinr; float qs;
    __device__ __forceinline__ void operator()(AccRef acc, const Unit& u, int wr, int wc, int fr, int fq) const {
        const int pn = u.pn; const int NQ_N = H_A * NOPE / BM, NQ = H_A * QK / BM;
#pragma unroll
        for (int ai = 0; ai < 2; ++ai)
#pragma unroll
            for (int m = 0; m < 4; ++m) { const int row = u.r0 + ai * HALFT + wr * 64 + m * 16 + fr;
                if (pn < NQ_N) { const float rs = 1.0f / sqrtf(ssq8(ssq + (size_t)row * 16) * (1.0f / QR) + EPS) * qs;
#pragma unroll
                    for (int bj = 0; bj < 2; ++bj) { const int h = 2 * pn + bj; *(v4u*)(Q + ((size_t)row * H_A + h) * QK + wc * 32 + 8 * fq) = pack8(acc[ai][bj][m][0] * rs, acc[ai][bj][m][1] * rs); } }
                else if (pn < NQ) { const float rs = 1.0f / sqrtf(ssq8(ssq + (size_t)row * 16) * (1.0f / QR) + EPS) * qs; const int h = 4 * (pn - NQ_N) + wc, t = row % S;
                    const f32x4 c0 = *(const f32x4*)(cosr + t * (ROPE / 2) + 8 * fq), c1 = *(const f32x4*)(cosr + t * (ROPE / 2) + 8 * fq + 4), s0 = *(const f32x4*)(sinr + t * (ROPE / 2) + 8 * fq), s1 = *(const f32x4*)(sinr + t * (ROPE / 2) + 8 * fq + 4);
                    const f32x4 x10 = acc[ai][0][m][0] * rs, x11 = acc[ai][0][m][1] * rs, x20 = acc[ai][1][m][0] * rs, x21 = acc[ai][1][m][1] * rs;
                    bf16_t* q = Q + ((size_t)row * H_A + h) * QK + NOPE + 8 * fq;
                    *(v4u*)q = pack8(x10 * c0 - x20 * s0, x11 * c1 - x21 * s1); *(v4u*)(q + ROPE / 2) = pack8(x20 * c0 + x10 * s0, x21 * c1 + x11 * s1); }
                else { const float rs = 1.0f / sqrtf(ssq8(ssq + (size_t)row * 16 + 8) * (1.0f / KVR) + EPS); const int h = pn - NQ;
                    *(v4u*)(KC + ((size_t)row * H_A + h) * QK + wc * 32 + 8 * fq) = pack8(acc[ai][0][m][0] * rs, acc[ai][0][m][1] * rs);
                    *(v4u*)(V + ((size_t)row * H_A + h) * VD + wc * 32 + 8 * fq) = pack8(acc[ai][1][m][0] * rs, acc[ai][1][m][1] * rs); } }
    }
};
struct OrderG2 {
    const char* A; const char* Bq; const char* Bkv; int G, c;
    __device__ __forceinline__ bool next(int i, Unit& u) const { const int nN = (H_A * QK + H_A * (NOPE + VD)) / BM, nM = M / BM; const long L = (long)i * G + c; if (L >= (long)nM * nN) return false; int pm, pn; tile_of((int)L, nM, nN, pm, pn);
        const int NQ = H_A * QK / BM; u.pm = pm; u.pn = pn; u.e = 0; u.r0 = pm * BM; u.A = A + (size_t)pm * BM * P0_N * 2 + (pn < NQ ? 0 : QR * 2);
        u.B = pn < NQ ? Bq + (size_t)pn * BM * QR * 2 : Bkv + (size_t)(pn - NQ) * BM * KVR * 2; return true; }
    __device__ __forceinline__ int row(const Unit&, int) const { return 0; }
};
struct EpiGates {
    static constexpr bool PERM = true; static constexpr bool PROBE2 = false;
    bf16_t* LA; bf16_t* U; const bf16_t* lxp; const float* gb; const float* cl; const float* convw; const float* convb;
    __device__ __forceinline__ void operator()(AccRef acc, const Unit& u, int wr, int wc, int fr, int fq) const {
        const int g = u.pn >> 1, d = u.pn & 1; const int ch0 = g * LBS + wc * 32 + 8 * fq; const int b = u.r0 / S;
        f32x4 ba[2], bx[2], clv[2], cb[2], cw[4][2];
#pragma unroll
        for (int n = 0; n < 2; ++n) { const int ch = ch0 + 4 * n; ba[n] = *(const f32x4*)(gb + (d * 2 + 0) * LW + ch); bx[n] = *(const f32x4*)(gb + (d * 2 + 1) * LW + ch); clv[n] = *(const f32x4*)(cl + d * LW + ch); cb[n] = *(const f32x4*)(convb + ch);
#pragma unroll
            for (int j = 0; j < 4; ++j) cw[j][n] = *(const f32x4*)(convw + j * LW + ch); }
#pragma unroll
        for (int ai = 0; ai < 2; ++ai)
#pragma unroll
            for (int m = 0; m < 4; ++m) { const int row = u.r0 + ai * HALFT + wr * 64 + m * 16 + fr; const int t = row % S; f32x4 la[2], uu[2], xc[2] = {cb[0], cb[1]};
                v4u raw[4];
#pragma unroll
                for (int j = 0; j < 4; ++j) raw[j] = *(const v4u*)(lxp + ((size_t)b * (S + 4) + t + j) * LW + ch0);
#pragma unroll
                for (int j = 0; j < 4; ++j)
#pragma unroll
                    for (int n = 0; n < 2; ++n) { const unsigned r0_ = raw[j][2 * n], r1_ = raw[j][2 * n + 1];
                        xc[n][0] += cw[j][n][0] * __uint_as_float(r0_ << 16); xc[n][1] += cw[j][n][1] * __uint_as_float(r0_ & 0xffff0000u); xc[n][2] += cw[j][n][2] * __uint_as_float(r1_ << 16); xc[n][3] += cw[j][n][3] * __uint_as_float(r1_ & 0xffff0000u); }
#pragma unroll
                for (int n = 0; n < 2; ++n)
#pragma unroll
                    for (int j = 0; j < 4; ++j) { const float l = clv[n][j] * fast_sigm(acc[ai][0][m][n][j] + ba[n][j]); const float x2 = 2.0f * l;
                        const float em = -x2 * (1.0f + 0.5f * x2 * (1.0f + (1.0f / 3.0f) * x2 * (1.0f + 0.25f * x2 * (1.0f + 0.2f * x2))));
                        la[n][j] = l; uu[n][j] = sqrtf(em) * fast_sigm(acc[ai][1][m][n][j] + bx[n][j]) * xc[n][j]; }
                const long o = lru_idx(d, b, t, ch0); *(v4u*)(LA + o) = pack8(la[0], la[1]); *(v4u*)(U + o) = pack8(uu[0], uu[1]); }
    }
};
struct OrderGates {
    const char* lxp; const char* B; int G, c;
    __device__ __forceinline__ bool next(int i, Unit& u) const { const int nN = 2 * (LW / LBS), nM = M / BM; const long L = (long)i * G + c; if (L >= (long)nM * nN) return false; int pm, pn; tile_of((int)L, nM, nN, pm, pn);
        u.pm = pm; u.pn = pn; u.e = 0; u.r0 = pm * BM; const int b = u.r0 / S, t0 = u.r0 % S, g = pn >> 1;
        u.A = lxp + (((size_t)b * (S + 4) + 2 + t0) * LW + g * LBS) * 2; u.B = B + (size_t)pn * BM * (4 * LBS) * 2; return true; }
    __device__ __forceinline__ int row(const Unit&, int) const { return 0; }
};
struct EpiG3 {
    static constexpr bool PERM = true; static constexpr bool PROBE2 = false;
    bf16_t* proj; const float* cost; const float* sint; float sqs;
    __device__ __forceinline__ void operator()(AccRef acc, const Unit& u, int wr, int wc, int fr, int fq) const {
        const int pn = u.pn; const int NH = H_C * DK / BM;
#pragma unroll
        for (int ai = 0; ai < 2; ++ai)
#pragma unroll
            for (int m = 0; m < 4; ++m) { const int row = u.r0 + ai * HALFT + wr * 64 + m * 16 + fr; bf16_t* p = proj + (size_t)row * CD_N + pn * BM + wc * 32 + 8 * fq;
                if (pn < 2 * NH) { const int t = row % S, i0 = wc * 32 + 8 * fq; const float sc = pn < NH ? 1.0f : 1.0f / sqrtf((float)DK);
                    const f32x4 c0 = *(const f32x4*)(cost + t * (DK / 2) + i0) * sc, c1 = *(const f32x4*)(cost + t * (DK / 2) + i0 + 4) * sc, s0 = *(const f32x4*)(sint + t * (DK / 2) + i0) * sc, s1 = *(const f32x4*)(sint + t * (DK / 2) + i0 + 4) * sc;
                    const f32x4 x10 = acc[ai][0][m][0], x11 = acc[ai][0][m][1], x20 = acc[ai][1][m][0], x21 = acc[ai][1][m][1];
                    *(v4u*)p = pack8(x10 * c0 - x20 * s0, x11 * c1 - x21 * s1); *(v4u*)(p + HALFT) = pack8(x20 * c0 + x10 * s0, x21 * c1 + x11 * s1); }
                else {
#pragma unroll
                    for (int bj = 0; bj < 2; ++bj) { f32x4 v0 = acc[ai][bj][m][0], v1 = acc[ai][bj][m][1];
                        if (pn >= 3 * NH && pn < 4 * NH) {
#pragma unroll
                            for (int j = 0; j < 4; ++j) { v0[j] = fast_silu(v0[j]); v1[j] = fast_silu(v1[j]); } }
                        else if (pn >= 4 * NH && pn < 4 * NH + H_D * HDS / BM) { v0 = v0 * sqs; v1 = v1 * sqs; }
                        *(v4u*)(p + bj * HALFT) = pack8(v0, v1); } } }
    }
};
struct OrderMoe {
    const LAS int* offt; const char* A; const char* B; const int* tok; int npn, G, c, gather; long b_exp, b_tile, a_tile;
    __device__ __forceinline__ bool next(int i, Unit& u) const { const long L = (long)i * G + c; const int T = (int)(L / npn); if (T >= offt[E + 1]) return false; const int e = ((const LAS unsigned char*)(offt + 2 * E + 4))[T];
        u.e = e; u.pn = (int)(L % npn); u.pm = T - offt[e]; u.r0 = T * BM; u.A = gather ? A : A + (size_t)T * a_tile; u.B = B + (size_t)e * b_exp + (size_t)u.pn * b_tile; return true; }
    __device__ __forceinline__ int row(const Unit& u, int r) const { const int rank = u.pm * BM + r; if (u.e == E) return rank; const int n = offt[E + 2 + u.e]; return rank < n ? tok[(size_t)u.e * M + rank] : 0; }
};
__device__ __forceinline__ float sat_fp8(float v) { return __builtin_amdgcn_fmed3f(v, -448.0f, 448.0f); }
__device__ __forceinline__ unsigned pack_fp8x4(float a, float b, float c, float d) { int w = __builtin_amdgcn_cvt_pk_fp8_f32(sat_fp8(a), sat_fp8(b), 0, false); return (unsigned)__builtin_amdgcn_cvt_pk_fp8_f32(sat_fp8(c), sat_fp8(d), w, true); }
constexpr float F8_H = 4.0f, F8_GU = 32.0f, F8_ACT = 8.0f, F8_DN = 16.0f, F8_Y = 16.0f;
struct EpiM1F8 {
    static constexpr bool PERM = true; static constexpr bool PROBE2 = false;
    unsigned char* ws;
    __device__ __forceinline__ void operator()(AccRef acc, const Unit& u, int wr, int wc, int fr, int fq) const {
        constexpr float inv = 1.0f / (F8_H * F8_GU); unsigned char* act = ws + WS_ACT;
#pragma unroll
        for (int ai = 0; ai < 2; ++ai)
#pragma unroll
            for (int m = 0; m < 4; ++m) { const int row = u.r0 + ai * HALFT + wr * 64 + m * 16 + fr; f32x4 v[2];
#pragma unroll
                for (int n = 0; n < 2; ++n)
#pragma unroll
                    for (int j = 0; j < 4; ++j) v[n][j] = fast_silu(acc[ai][0][m][n][j] * inv) * (acc[ai][1][m][n][j] * (inv * F8_ACT));
                u32x2 w; w.x = pack_fp8x4(v[0][0], v[0][1], v[0][2], v[0][3]); w.y = pack_fp8x4(v[1][0], v[1][1], v[1][2], v[1][3]);
                *(u32x2*)(act + (size_t)row * FF + u.pn * HALFT + wc * 32 + 8 * fq) = w; }
    }
};
template <int NPN, bool GATH, size_t A_OFF, size_t B_OFF, long B_EXP, long B_TILE, long A_TILE>
struct OrderMoeT {
    const unsigned char* ws; int G, c;
    __device__ __forceinline__ bool next(int i, Unit& u) const { const LAS int* offt = lds_tab();
#ifdef MOE_CONTIG
        if (i >= c) return false; const int L = G + i; const int T = L / NPN;
#else
        const long L = (long)i * G + c; const int T = (int)(L / NPN); if (T >= __builtin_amdgcn_readfirstlane(offt[E + 1])) return false;
#endif
        const int e = __builtin_amdgcn_readfirstlane((int)((const LAS unsigned char*)(offt + 2 * E + 4))[T]);
        u.e = e; u.pn = (int)(L % NPN); u.pm = T - __builtin_amdgcn_readfirstlane(offt[e]); u.r0 = T * BM; u.A = (const char*)ws + A_OFF + (GATH ? 0 : (size_t)T * A_TILE); u.B = (const char*)ws + B_OFF + (size_t)e * B_EXP + (size_t)u.pn * B_TILE; return true; }
    __device__ __forceinline__ int row(const Unit& u, int r) const { const int rank = u.pm * BM + r; if (u.e == E) return rank; const int n = lds_tab()[E + 2 + u.e]; return rank < n ? ((const int*)(ws + WS_TOK))[(size_t)u.e * M + rank] : 0; }
};
struct EpiM2F8 {
    static constexpr bool PERM = true; static constexpr bool PERM16 = true; static constexpr bool PROBE2 = false;
    unsigned char* ws;
    __device__ __forceinline__ void operator()(AccRef acc, const Unit& u, int wr, int wc, int fr, int fq) const {
        constexpr float w = F8_Y / (F8_ACT * F8_DN); unsigned char* Y = ws + WS_Y;
#pragma unroll
        for (int ai = 0; ai < 2; ++ai)
#pragma unroll
            for (int m = 0; m < 4; ++m) { const int rr = ai * HALFT + wr * 64 + m * 16 + fr; v4u o;
#pragma unroll
                for (int bj = 0; bj < 2; ++bj) { const f32x4 a = acc[ai][bj][m][0] * w, b = acc[ai][bj][m][1] * w; o[2 * bj] = pack_fp8x4(a[0], a[1], a[2], a[3]); o[2 * bj + 1] = pack_fp8x4(b[0], b[1], b[2], b[3]); }
                *(v4u*)(Y + (size_t)(u.r0 + rr) * D + u.pn * BM + wc * 64 + 16 * fq) = o; }
    }
};
struct EpiM1 {
    static constexpr bool PERM = true; static constexpr bool PROBE2 = false;
    bf16_t* act;
    __device__ __forceinline__ void operator()(AccRef acc, const Unit& u, int wr, int wc, int fr, int fq) const {
#pragma unroll
        for (int ai = 0; ai < 2; ++ai)
#pragma unroll
            for (int m = 0; m < 4; ++m) { const int row = u.r0 + ai * HALFT + wr * 64 + m * 16 + fr; f32x4 v[2];
#pragma unroll
                for (int n = 0; n < 2; ++n)
#pragma unroll
                    for (int j = 0; j < 4; ++j) v[n][j] = fast_silu(acc[ai][0][m][n][j]) * acc[ai][1][m][n][j];
                *(v4u*)(act + (size_t)row * FF + u.pn * HALFT + wc * 32 + 8 * fq) = pack8(v[0], v[1]); }
    }
};
struct EpiM2 {
    static constexpr bool PERM = true; static constexpr bool PROBE2 = false;
    bf16_t* Y; const float* wt; const LAS int* offt; float osc;
    __device__ __forceinline__ void operator()(AccRef acc, const Unit& u, int wr, int wc, int fr, int fq) const {
        float w8[2][4]; const int nrow = u.e < E ? offt[E + 2 + u.e] : M;
#pragma unroll
        for (int ai = 0; ai < 2; ++ai)
#pragma unroll
            for (int m = 0; m < 4; ++m) { const int rank = u.pm * BM + ai * HALFT + wr * 64 + m * 16 + fr; w8[ai][m] = (u.e < E ? (rank < nrow ? wt[(size_t)u.e * M + rank] : 0.f) : 1.0f) * osc; }
#pragma unroll
        for (int ai = 0; ai < 2; ++ai)
#pragma unroll
            for (int m = 0; m < 4; ++m) { const int rr = ai * HALFT + wr * 64 + m * 16 + fr; const float w = w8[ai][m];
#pragma unroll
                for (int bj = 0; bj < 2; ++bj) *(v4u*)(Y + (size_t)(u.r0 + rr) * D + u.pn * BM + bj * HALFT + wc * 32 + 8 * fq) = pack8(acc[ai][bj][m][0] * w, acc[ai][bj][m][1] * w); }
    }
};
}

struct Frame { LAS unsigned char* lds; Ctx c; int wave, vcu, G;
    __device__ __forceinline__ int lane() const { return lane_id(); }
    __device__ __forceinline__ int tid() const { return wave * 64 + lane_id(); } };

struct CvtDesc { const float* src; unsigned char* dst; const float* sc; int ldw, Kd, f8; float mul; };
__device__ __forceinline__ void cvt_load(const CvtDesc& d, float (&v)[32], int lane) {
    const float* p = d.src + (size_t)(lane >> 3) * d.ldw + 4 * (lane & 7);
#pragma unroll
    for (int i = 0; i < 8; ++i) { const f32x4 t = __builtin_nontemporal_load((const f32x4*)(p + (size_t)(8 * i) * d.ldw));     v[4 * i] = t[0]; v[4 * i + 1] = t[1]; v[4 * i + 2] = t[2]; v[4 * i + 3] = t[3]; }
}
__device__ __forceinline__ void cvt_finish(const CvtDesc& d, float (&v)[32], LAS float* scr, int lane) {
    const int kr = lane >> 3, n4 = 4 * (lane & 7);
#pragma unroll
    for (int i = 0; i < 8; ++i) { const float m = (d.sc ? d.sc[8 * i + kr] : 1.0f) * d.mul;
#pragma unroll
        for (int e = 0; e < 4; ++e) scr[(8 * i + kr) * 33 + n4 + e] = v[4 * i + e] * m; }
    LDS_WAIT(); asm volatile("" ::: "memory");
    const int cc = lane & 7;
#pragma unroll
    for (int j = 0; j < 4; ++j) { const int n = (lane >> 3) + 8 * j; const LAS float* s = scr + (8 * cc) * 33 + n;
        if (d.f8) { u32x2 o; o.x = pg8::pack_fp8x4(s[0 * 33], s[1 * 33], s[2 * 33], s[3 * 33]); o.y = pg8::pack_fp8x4(s[4 * 33], s[5 * 33], s[6 * 33], s[7 * 33]); __builtin_nontemporal_store(o, (u32x2*)(d.dst + (size_t)n * d.Kd + 8 * cc)); }
        else { v4u o; o.x = cvt_pk_bf16(s[0 * 33], s[1 * 33]); o.y = cvt_pk_bf16(s[2 * 33], s[3 * 33]); o.z = cvt_pk_bf16(s[4 * 33], s[5 * 33]); o.w = cvt_pk_bf16(s[6 * 33], s[7 * 33]); __builtin_nontemporal_store(o, (v4u*)(d.dst + (size_t)n * d.Kd + 16 * cc)); } }
    LDS_WAIT(); asm volatile("" ::: "memory");
}
__device__ __forceinline__ CvtDesc mk_desc(const float* src, int ldw, int k0, int ns0, void* dst, int Kd_elems, int nd0, int kd0, const float* sc, int f8 = 0, float mul = 1.0f) {
    CvtDesc d; d.src = src + (size_t)k0 * ldw + ns0; d.ldw = ldw; d.f8 = f8; d.mul = mul; d.sc = sc ? sc + k0 : nullptr; const int eb = f8 ? 1 : 2; d.Kd = Kd_elems * eb;
    d.dst = (unsigned char*)dst + ((size_t)nd0 * Kd_elems + kd0 + k0) * eb; return d; }
constexpr long cnt_items(int K, int N) { return (long)(K / 64) * (N / 32); }
constexpr long IT_INAB = 0, IT_UQ = IT_INAB + cnt_items(D, AB_N), IT_UKV = IT_UQ + cnt_items(QR, H_A * QK), IT_LRU = IT_UKV + cnt_items(KVR, H_A * (NOPE + VD)),
    IT_OUTAB = IT_LRU + (long)2 * (LW / LBS) * 2 * 4 * cnt_items(LBS, LBS), IT_RT = IT_OUTAB + cnt_items(D, D), IT_GU0 = IT_RT + 2 * cnt_items(D, E), IT_DN0 = IT_GU0 + (long)(E + 1) * 2 * cnt_items(D, FF),
    IT_INCD = IT_DN0 + (long)(E + 1) * cnt_items(FF, D), IT_OUTCD = IT_INCD + cnt_items(D, CD_N), IT_GU1 = IT_OUTCD + cnt_items(D, D), IT_DN1 = IT_GU1 + (long)(E + 1) * 2 * cnt_items(D, FF), IT_END = IT_DN1 + (long)(E + 1) * cnt_items(FF, D);
__device__ __forceinline__ CvtDesc p0_desc(const Ctx& c, long it) {
#ifdef MOE_FP8
    constexpr int MF8 = 1; constexpr float MGU = pg8::F8_GU, MDN = pg8::F8_DN;
#else
    constexpr int MF8 = 0; constexpr float MGU = 1.0f, MDN = 1.0f;
#endif
    const int sub = (int)(it & 1);
    if (it < IT_UQ) { const long r = (it - IT_INAB) >> 1; constexpr int NBK = AB_N / 32; const int kb = 2 * (int)(r / NBK) + sub, nb = (int)(r % NBK); const int col = nb * 32; const int drow = col < QR + KVR ? col : (col < QR + KVR + ROPE ? P0_N + col - (QR + KVR) : col - ROPE);
        return mk_desc(c.in[I_WINAB], AB_N, kb * 64, col, WSP(bf16_t, W_INAB), D, drow, 0, nullptr); }
    if (it < IT_UKV) { const long r = (it - IT_UQ) >> 1; constexpr int NBK = H_A * QK / 32; const int kb = 2 * (int)(r / NBK) + sub, db = (int)(r % NBK); const int v = db * 32; int scol;
        if (v < H_A * NOPE) { const int h = v / NOPE, d0 = v % NOPE; scol = h * QK + d0; }
        else { const int v2 = v - H_A * NOPE; const int tq = v2 / 256, half = (v2 % 256) / 128, hq = (v2 % 128) / 32; scol = (4 * tq + hq) * QK + NOPE + (ROPE / 2) * half; }
        return mk_desc(c.in[I_WUQ], H_A * QK, kb * 64, scol, WSP(bf16_t, W_UQ), QR, v, 0, c.in[I_QLN]); }
    if (it < IT_LRU) { const long r = (it - IT_UKV) >> 1; constexpr int NBK = H_A * (NOPE + VD) / 32; const int kb = 2 * (int)(r / NBK) + sub, nb = (int)(r % NBK);
        return mk_desc(c.in[I_WUKV], H_A * (NOPE + VD), kb * 64, nb * 32, WSP(bf16_t, W_UKV), KVR, nb * 32, 0, c.in[I_KVLN]); }
    if (it < IT_OUTAB) { const long r = (it - IT_LRU) >> 1; constexpr int NBK = LBS / 32, PER = (LBS / 128) * NBK; const int q = (int)(r / PER), w = (int)(r % PER); const int tap = q & 3, half = (q >> 2) & 1, tq = q >> 3, g = tq >> 1, d = tq & 1; const int kb = 2 * (w / NBK) + sub, nb = w % NBK;
        const float* src = (half ? c.in[I_LWX] : c.in[I_LWA]) + ((size_t)(d * (LW / LBS) + g) * LBS) * LBS;
        return mk_desc(src, LBS, kb * 64, nb * 32, WSP(bf16_t, W_LRU) + (size_t)tq * 2 * LBS * 4 * LBS, 4 * LBS, half * LBS + nb * 32, tap * LBS, c.in[I_CONVW] + tap * LW + g * LBS); }
    if (it < IT_RT) { const long r = (it - IT_OUTAB) >> 1; constexpr int NBK = D / 32; return mk_desc(c.in[I_WOUTAB], D, (2 * (int)(r / NBK) + sub) * 64, (int)(r % NBK) * 32, WSP(bf16_t, W_OUTAB), D, (int)(r % NBK) * 32, 0, nullptr); }
    if (it < IT_GU0) { const long r = (it - IT_RT) >> 1; constexpr int NBK = E / 32; constexpr long PER = (long)(D / 128) * NBK; const int l = (int)(r / PER); const long w = r % PER;
        return mk_desc(c.in[I_WROUTER] + (size_t)l * D * E, E, (2 * (int)(w / NBK) + sub) * 64, (int)(w % NBK) * 32, WSP(bf16_t, W_RT) + (size_t)l * E * D, D, (int)(w % NBK) * 32, 0, nullptr); }
    if (it < IT_INCD || (it >= IT_GU1)) {
        const int l = it >= IT_GU1 ? 1 : 0; const long base_gu = l ? IT_GU1 : IT_GU0, base_dn = l ? IT_DN1 : IT_DN0;
        if (it < base_dn) { const long r = (it - base_gu) >> 1; constexpr int NBK = FF / 32; constexpr long PER = (long)(D / 128) * NBK; const long q = r / PER, w = r % PER; const int up = (int)(q & 1), e = (int)(q >> 1); const int kb = 2 * (int)(w / NBK) + sub, nb = (int)(w % NBK); const int col = nb * 32;
            const float* src = e < E ? (up ? c.in[I_WUP] : c.in[I_WGATE]) + ((size_t)l * E + e) * D * FF : (up ? c.in[I_WSU] : c.in[I_WSG]) + (size_t)l * D * FF;
            return mk_desc(src, FF, kb * 64, col, c.ws + W_GU + ((size_t)l * (E + 1) + e) * 2 * FF * D * (MF8 ? 1 : 2), D, (col / 128) * 256 + up * 128 + (col % 128), 0, nullptr, MF8, MGU); }
        { const long r = (it - base_dn) >> 1; constexpr int NBK = D / 32; constexpr long PER = (long)(FF / 128) * NBK; const int e = (int)(r / PER); const long w = r % PER;
            const float* src = e < E ? c.in[I_WDOWN] + ((size_t)l * E + e) * FF * D : c.in[I_WSD] + (size_t)l * FF * D;
            return mk_desc(src, D, (2 * (int)(w / NBK) + sub) * 64, (int)(w % NBK) * 32, c.ws + W_DN + ((size_t)l * (E + 1) + e) * D * FF * (MF8 ? 1 : 2), FF, (int)(w % NBK) * 32, 0, nullptr, MF8, MDN); } }
    if (it < IT_OUTCD) { const long r = (it - IT_INCD) >> 1; constexpr int NBK = CD_N / 32; return mk_desc(c.in[I_WINCD], CD_N, (2 * (int)(r / NBK) + sub) * 64, (int)(r % NBK) * 32, WSP(bf16_t, W_INCD), D, (int)(r % NBK) * 32, 0, nullptr); }
    { const long r = (it - IT_OUTCD) >> 1; constexpr int NBK = D / 32; return mk_desc(c.in[I_WOUTCD], D, (2 * (int)(r / NBK) + sub) * 64, (int)(r % NBK) * 32, WSP(bf16_t, W_OUTCD), D, (int)(r % NBK) * 32, 0, nullptr); }
}
__device__ __forceinline__ void conv_items(Frame& F, long lo, long hi, int pidx = -1, int np = 0) {
    if (pidx < 0) { pidx = F.vcu; np = F.G; }
    const Ctx& c = F.c; LAS float* scr = (LAS float*)(F.lds + F.wave * 16384); const int lane = F.lane(); const long step = 2 * (long)np * NWAVES;
    long it = lo + 2 * ((long)pidx * NWAVES + F.wave); float va[32], vb[32];
    if (it < hi) { CvtDesc da = p0_desc(c, it); cvt_load(da, va, lane);
        for (;;) {
            CvtDesc db = p0_desc(c, it + 1); cvt_load(db, vb, lane);
            cvt_finish(da, va, scr, lane);
            const long i2 = it + step; const bool h2 = i2 < hi; if (h2) { da = p0_desc(c, i2); cvt_load(da, va, lane); }
            cvt_finish(db, vb, scr, lane); if (!h2) break;
            it = i2; } }
}
__device__ __forceinline__ void conv_slice(Frame& F, long lo, long hi, int k0, int k1, int n, int pidx = -1, int np = 0) { const long npair = (hi - lo) / 2; conv_items(F, lo + 2 * (npair * k0 / n), lo + 2 * (npair * k1 / n), pidx, np); }
__device__ __forceinline__ void mod_units(Frame& F, int l) {
    const Ctx& c = F.c; LAS float* cact = (LAS float*)F.lds; LAS float* red = (LAS float*)(F.lds + 65536);
    for (int i = F.tid(); i < NB * D; i += NTHR) cact[i] = siluf(c.in[I_C][i]);
    __syncthreads();
    constexpr int UW = 48, NU = 6 * D / UW, KW = D / NWAVES; static_assert(6 * D % UW == 0 && KW % 64 == 0 && NB * UW <= NTHR, "mod units");
    for (int u = F.vcu; u < NU; u += F.G) { const int col0 = u * UW; const int rg = F.lane() >> 4, cl = (F.lane() & 15) < 12 ? (F.lane() & 15) : 11;
        const float* w = c.in[I_WMOD] + (size_t)l * D * 6 * D + col0 + 4 * cl; f32x4 a[NB];
#pragma unroll
        for (int b = 0; b < NB; ++b) a[b] = f32x4{0.f, 0.f, 0.f, 0.f};
        const int kbeg = F.wave * KW + rg;
#pragma unroll 1
        for (int i0 = 0; i0 < KW / 4; i0 += 16) { f32x4 wv[16];
#pragma unroll
            for (int j = 0; j < 16; ++j) wv[j] = __builtin_nontemporal_load((const f32x4*)(w + (size_t)(kbeg + 4 * (i0 + j)) * 6 * D));
#pragma unroll
            for (int j = 0; j < 16; ++j) { const int k = kbeg + 4 * (i0 + j);
#pragma unroll
                for (int b = 0; b < NB; ++b) a[b] += wv[j] * cact[b * D + k]; } }
#pragma unroll
        for (int b = 0; b < NB; ++b)
#pragma unroll
            for (int q = 0; q < 4; ++q) { float s = a[b][q]; s += __shfl_xor(s, 16); s += __shfl_xor(s, 32); a[b][q] = s; }
        if (F.lane() < 12) {
#pragma unroll
            for (int b = 0; b < NB; ++b) *(LAS f32x4*)(red + (F.wave * NB + b) * UW + 4 * F.lane()) = a[b]; }
        __syncthreads();
        if (F.tid() < NB * UW) { const int b = F.tid() / UW, cc = F.tid() % UW; float s = c.in[I_BMOD][l * 6 * D + col0 + cc];
#pragma unroll
            for (int w8 = 0; w8 < NWAVES; ++w8) s += red[(w8 * NB + b) * UW + cc];
            WSP(float, WS_MOD)[((size_t)l * NB + b) * 6 * D + col0 + cc] = s; }
        __syncthreads();
    }
    __syncthreads();
}

__device__ __forceinline__ void p0_phase(Frame& F) {
    const Ctx& c = F.c;
    mod_units(F, 0);
#ifndef SPREAD_CONV
    mod_units(F, 1);
#endif
    const long gt = (long)F.vcu * NTHR + F.tid(), NGT = (long)F.G * NTHR;
    for (long i = gt; i < (long)S * (ROPE / 2 + DK / 2); i += NGT) { TabF f; f.c = c; f(i); }
    static_assert(LBS % 64 == 0 && LBS % NWAVES == 0, "gate bias units");
    for (int u = F.vcu; u < 4 * LW / 64; u += F.G) { const int i = u * 64 + F.lane(); const int ch = i % LW, half = (i / LW) & 1, d = i / (2 * LW); const int g = ch / LBS, j = ch % LBS;
        LAS float* red = (LAS float*)(F.lds + 65536);
        const float* wm = (half ? c.in[I_LWX] : c.in[I_LWA]) + ((size_t)(d * (LW / LBS) + g) * LBS) * LBS + j; float s = 0.f;
#pragma unroll
        for (int kk = 0; kk < LBS / NWAVES; ++kk) { const int k = F.wave * (LBS / NWAVES) + kk; s += c.in[I_CONVB][g * LBS + k] * wm[(size_t)k * LBS]; }
        red[F.wave * 64 + F.lane()] = s; __syncthreads();
        if (F.wave == 0) { float t = (half ? c.in[I_LBX] : c.in[I_LBA])[d * LW + ch];
#pragma unroll
            for (int w8 = 0; w8 < NWAVES; ++w8) t += red[w8 * 64 + F.lane()];
            WSP(float, W_GB)[i] = t; }
        __syncthreads(); }
    for (long i = gt; i < 2 * LW; i += NGT) WSP(float, W_GB)[4 * LW + i] = -8.0f * log1pf(expf(-c.in[I_LLAM][i]));
    for (long i = gt; i < (long)NB * 4 * LW; i += NGT) { const int b = (int)(i / (4 * LW)), rr = (int)((i / LW) % 4), ch = (int)(i % LW); WSP(bf16_t, WS_LXP)[((size_t)b * (S + 4) + (rr < 2 ? rr : S + rr)) * LW + ch] = 0; }
    __syncthreads();
#ifdef SPREAD_CONV
    conv_items(F, IT_INAB, IT_OUTAB);
#else
    conv_items(F, IT_INAB, IT_END);
#endif
}
__device__ __forceinline__ void build_offt(Frame& F, int l) {
    LAS int* offt = (LAS int*)(F.lds + TAB_OFF); static_assert(E <= 64, "one lane per routed expert");
    if (F.wave == 0) { const int lane = F.lane(); LAS unsigned char* texp = (LAS unsigned char*)(offt + 2 * E + 4);
        const int n = lane < E ? __hip_atomic_load((const int*)(F.c.ws + CTL_CNT) + cnt_idx(l, lane), RLX_AGENT) : 0; const int nt = (n + RT - 1) / RT; int inc = nt;
#pragma unroll
        for (int o = 1; o < 64; o <<= 1) { const int v = __shfl_up(inc, o); if (lane >= o) inc += v; }
        const int off = inc - nt, tot = __shfl(inc, 63); constexpr int NTS = (M + RT - 1) / RT;
        if (lane < E) { offt[lane] = off; offt[E + 2 + lane] = n; for (int t = 0; t < nt; ++t) texp[off + t] = (unsigned char)lane; }
        if (lane == 0) { offt[E] = tot; offt[E + 1] = tot + NTS; }
        for (int t = lane; t < NTS; t += 64) texp[tot + t] = (unsigned char)E; }
    __syncthreads();
}

__device__ __forceinline__ void modulate_row(const float* xrow, const float* gain, const float* sc, const float* sh, bf16_t* orow, int lane, unsigned char* orow8 = nullptr) {
    f32x4 v[D / 256]; float s = 0.f;
#pragma unroll
    for (int j = 0; j < D / 256; ++j) { v[j] = *((const f32x4*)xrow + lane + 64 * j); s += (v[j][0] * v[j][0] + v[j][1] * v[j][1]) + (v[j][2] * v[j][2] + v[j][3] * v[j][3]); }
    const float r = 1.0f / sqrtf(wave_sum(s) * (1.0f / D) + EPS);
#pragma unroll
    for (int j = 0; j < D / 256; ++j) { const int col = 4 * lane + 256 * j; const f32x4 g = *(const f32x4*)(gain + col), a = *(const f32x4*)(sc + col), b = *(const f32x4*)(sh + col);
        const f32x4 o = v[j] * r * g * (1.0f + a) + b; u32x2 w; w.x = cvt_pk_bf16(o[0], o[1]); w.y = cvt_pk_bf16(o[2], o[3]); *(u32x2*)(orow + col) = w;
        if (orow8) *(unsigned*)(orow8 + col) = pg8::pack_fp8x4(o[0] * pg8::F8_H, o[1] * pg8::F8_H, o[2] * pg8::F8_H, o[3] * pg8::F8_H); }
}
template <int NR> __device__ __forceinline__ void modulate_rows(const float* X, int m0, const float* gain, const float* sc, const float* sh, bf16_t* HM, unsigned char* HM8, int lane) {
    f32x4 v[NR][D / 256]; float s[NR];
#pragma unroll
    for (int r = 0; r < NR; ++r) { s[r] = 0.f;
#pragma unroll
        for (int j = 0; j < D / 256; ++j) v[r][j] = __builtin_nontemporal_load((const f32x4*)(X + (size_t)(m0 + r) * D) + lane + 64 * j); }
#pragma unroll
    for (int r = 0; r < NR; ++r)
#pragma unroll
        for (int j = 0; j < D / 256; ++j) s[r] += (v[r][j][0] * v[r][j][0] + v[r][j][1] * v[r][j][1]) + (v[r][j][2] * v[r][j][2] + v[r][j][3] * v[r][j][3]);
#pragma unroll
    for (int o = 1; o < 64; o <<= 1)
#pragma unroll
        for (int r = 0; r < NR; ++r) s[r] += __shfl_xor(s[r], o);
#pragma unroll
    for (int j = 0; j < D / 256; ++j) { const int col = 4 * lane + 256 * j; const f32x4 g = *(const f32x4*)(gain + col), a = *(const f32x4*)(sc + col), b = *(const f32x4*)(sh + col);
#pragma unroll
        for (int r = 0; r < NR; ++r) { const float rs = 1.0f / sqrtf(s[r] * (1.0f / D) + EPS); const f32x4 o = v[r][j] * rs * g * (1.0f + a) + b; u32x2 w; w.x = cvt_pk_bf16(o[0], o[1]); w.y = cvt_pk_bf16(o[2], o[3]);
            *(u32x2*)(HM + (size_t)(m0 + r) * D + col) = w;
            if (HM8) *(unsigned*)(HM8 + (size_t)(m0 + r) * D + col) = pg8::pack_fp8x4(o[0] * pg8::F8_H, o[1] * pg8::F8_H, o[2] * pg8::F8_H, o[3] * pg8::F8_H); } }
}
__device__ __forceinline__ void modulate_phase(Frame& F, const float* X, const float* gain, const float* sc, const float* sh) {
    const int gw = F.vcu * NWAVES + F.wave, NGW = F.G * NWAVES;
    for (int m0 = 4 * gw; m0 < M; m0 += 4 * NGW) { const int b = m0 / S;
        modulate_rows<4>(X, m0, gain, sc + (size_t)b * 6 * D, sh + (size_t)b * 6 * D, (bf16_t*)(F.c.ws + WS_HM), nullptr, F.lane()); }
}
__device__ __forceinline__ void skinny32x64(Frame& F, const bf16_t* A, const bf16_t* Bt) {
    const int r = F.lane() & 31, h = F.lane() >> 5; constexpr int KW = D / NWAVES; const int k0 = F.wave * KW;
    f32x16 acc0 = {}, acc1 = {};
    const bf16_t* ap = A + (size_t)r * D + k0 + 8 * h; const bf16_t* b0p = Bt + (size_t)r * D + k0 + 8 * h; const bf16_t* b1p = Bt + (size_t)(32 + r) * D + k0 + 8 * h;
#pragma unroll 8
    for (int s = 0; s < KW / 16; ++s) { const bf16x8 a = *(const bf16x8*)(ap + 16 * s), b0 = *(const bf16x8*)(b0p + 16 * s), b1 = *(const bf16x8*)(b1p + 16 * s);
        acc0 = __builtin_amdgcn_mfma_f32_32x32x16_bf16(a, b0, acc0, 0, 0, 0); acc1 = __builtin_amdgcn_mfma_f32_32x32x16_bf16(a, b1, acc1, 0, 0, 0); }
    LAS float* red = (LAS float*)F.lds;
#pragma unroll
    for (int q = 0; q < 16; ++q) { const int row = (q & 3) + 8 * (q >> 2) + 4 * h; red[(F.wave * 32 + row) * 64 + r] = acc0[q]; red[(F.wave * 32 + row) * 64 + 32 + r] = acc1[q]; }
    __syncthreads();
    LAS float* res = (LAS float*)(F.lds + 65536);
    { const int row = F.tid() >> 4, c4 = (F.tid() & 15) * 4; f32x4 s = *(const LAS f32x4*)(red + row * 64 + c4);
#pragma unroll
      for (int w = 1; w < NWAVES; ++w) s += *(const LAS f32x4*)(red + (w * 32 + row) * 64 + c4);
      *(LAS f32x4*)(res + row * 64 + c4) = s; }
    __syncthreads();
}
__device__ __forceinline__ void krope_units(Frame& F) {
    const Ctx& c = F.c;
    for (int u = F.vcu; u < M / 32; u += F.G) { const int row0 = u * 32;
        skinny32x64(F, WSP(bf16_t, WS_HM) + (size_t)row0 * D, WSP(bf16_t, W_INAB) + (size_t)P0_N * D);
        const LAS float* res = (const LAS float*)(F.lds + 65536);
        { const int row = F.tid() >> 4, i0 = (F.tid() & 15) * 2; const int m = row0 + row, t = m % S; float o1[2], o2[2];
#pragma unroll
          for (int q = 0; q < 2; ++q) { const int ii = i0 + q; const float x1 = res[row * 64 + ii], x2 = res[row * 64 + 32 + ii], cs = WSP(float, WS_TAB + TAB_CR)[t * (ROPE / 2) + ii], sn = WSP(float, WS_TAB + TAB_SR)[t * (ROPE / 2) + ii];
              o1[q] = x1 * cs - x2 * sn; o2[q] = x2 * cs + x1 * sn; }
          const unsigned w1 = cvt_pk_bf16(o1[0], o1[1]), w2 = cvt_pk_bf16(o2[0], o2[1]);
#pragma unroll
          for (int hh = 0; hh < H_A; ++hh) { bf16_t* K = WSP(bf16_t, WS_KC) + ((size_t)m * H_A + hh) * QK + NOPE; *(unsigned*)(K + i0) = w1; *(unsigned*)(K + ROPE / 2 + i0) = w2; } }
        __syncthreads();
    }
}
__device__ __forceinline__ float wave_max(float v) {
#pragma unroll
    for (int o = 1; o < 64; o <<= 1) v = fmaxf(v, __shfl_xor(v, o));
    return v; }
__device__ __forceinline__ void route_phase(Frame& F, int l) {
    const Ctx& c = F.c; const float* mod = WSP(float, WS_MOD) + (size_t)l * NB * 6 * D; const float* X1 = WSP(float, WS_X1);
    for (int u = F.vcu; u < M / 32; u += F.G) { const int row0 = u * 32;
        { const int m0 = row0 + F.wave * 4; const int b = m0 / S;
          modulate_rows<4>(X1, m0, c.in[I_NFFN] + l * D, mod + (size_t)b * 6 * D + 4 * D, mod + (size_t)b * 6 * D + 3 * D, WSP(bf16_t, WS_HM), WSP(unsigned char, WS_HM8), F.lane()); }
        __syncthreads();
        skinny32x64(F, WSP(bf16_t, WS_HM) + (size_t)row0 * D, WSP(bf16_t, W_RT) + (size_t)l * E * D);
        const LAS float* res = (const LAS float*)(F.lds + 65536);
        int* cnt = WSP(int, CTL_CNT); LAS int* lcnt = (LAS int*)(F.lds + 65536 + 8192);
        if (F.tid() < E) lcnt[F.tid()] = 0;
        __syncthreads();
        int pe[4], pr[4]; float pw[4];
        { const int lane = F.lane(), grp = lane >> 3; float sg[4], bz[4], gs[4]; unsigned gsel[4]; const float rb = c.in[I_RBIAS][l * E + lane];
#pragma unroll
          for (int q = 0; q < 4; ++q) { const int row = F.wave * 4 + q; sg[q] = 1.0f / (1.0f + expf(-res[row * 64 + lane])); bz[q] = sg[q] + rb; }
          { float m1[4], m2[4];
#pragma unroll
            for (int q = 0; q < 4; ++q) m1[q] = bz[q];
#pragma unroll
            for (int o = 1; o < 8; o <<= 1)
#pragma unroll
                for (int q = 0; q < 4; ++q) m1[q] = fmaxf(m1[q], __shfl_xor(m1[q], o));
#pragma unroll
            for (int q = 0; q < 4; ++q) { const unsigned long long eq1 = __ballot(bz[q] == m1[q]); const int first = __builtin_ctz((unsigned)((eq1 >> (grp * 8)) & 0xffull)); m2[q] = ((lane & 7) == first) ? -INFINITY : bz[q]; }
#pragma unroll
            for (int o = 1; o < 8; o <<= 1)
#pragma unroll
                for (int q = 0; q < 4; ++q) m2[q] = fmaxf(m2[q], __shfl_xor(m2[q], o));
#pragma unroll
            for (int q = 0; q < 4; ++q) { gs[q] = m1[q] + m2[q]; gsel[q] = 0u; } }
#pragma unroll 1
          for (int it = 0; it < TG; ++it) { float cand[4], mx[4];
#pragma unroll
              for (int q = 0; q < 4; ++q) { cand[q] = ((gsel[q] >> grp) & 1u) ? -INFINITY : gs[q]; mx[q] = cand[q]; }
#pragma unroll
              for (int o = 1; o < 64; o <<= 1)
#pragma unroll
                  for (int q = 0; q < 4; ++q) mx[q] = fmaxf(mx[q], __shfl_xor(mx[q], o));
#pragma unroll
              for (int q = 0; q < 4; ++q) { const unsigned long long eq = __ballot(cand[q] == mx[q]); gsel[q] |= 1u << (__builtin_ctzll(eq) >> 3); } }
          unsigned long long taken[4]; float wsum[4], my_s[4]; int my_e[4];
#pragma unroll
          for (int q = 0; q < 4; ++q) { taken[q] = 0ull; wsum[q] = 0.f; my_s[q] = 0.f; my_e[q] = 0; }
#pragma unroll 1
          for (int k = 0; k < TOPK; ++k) { float cand[4], mx[4];
#pragma unroll
              for (int q = 0; q < 4; ++q) { cand[q] = (((gsel[q] >> grp) & 1u) && !((taken[q] >> lane) & 1ull)) ? bz[q] : -INFINITY; mx[q] = cand[q]; }
#pragma unroll
              for (int o = 1; o < 64; o <<= 1)
#pragma unroll
                  for (int q = 0; q < 4; ++q) mx[q] = fmaxf(mx[q], __shfl_xor(mx[q], o));
#pragma unroll
              for (int q = 0; q < 4; ++q) { const unsigned long long eq = __ballot(cand[q] == mx[q]); const int ek = __builtin_ctzll(eq); taken[q] |= 1ull << ek; const float sk = __shfl(sg[q], ek); wsum[q] += sk; if (lane == k) { my_e[q] = ek; my_s[q] = sk; } } }
#pragma unroll
          for (int q = 0; q < 4; ++q) { pe[q] = my_e[q]; pw[q] = my_s[q] / wsum[q] * 2.5f; pr[q] = 0;
              if (lane < TOPK) pr[q] = __hip_atomic_fetch_add(lcnt + my_e[q], 1, __ATOMIC_RELAXED, __HIP_MEMORY_SCOPE_WORKGROUP); } }
        __syncthreads();
        if (F.tid() < E) { const int n = lcnt[F.tid()]; lcnt[E + F.tid()] = n > 0 ? atomicAdd(cnt + cnt_idx(l, F.tid()), n) : 0; }
        __syncthreads();
#pragma unroll
        for (int q = 0; q < 4; ++q) { const int m = row0 + F.wave * 4 + q; const int lane = F.lane();
            if (lane < TOPK) { const int rank = lcnt[E + pe[q]] + pr[q];
                WSP(int, WS_SELE)[(size_t)m * TOPK + lane] = pe[q]; WSP(int, WS_SELR)[(size_t)m * TOPK + lane] = rank; WSP(float, WS_SELW)[(size_t)m * TOPK + lane] = pw[q];
                WSP(int, WS_TOK)[(size_t)pe[q] * M + rank] = m; WSP(float, WS_WT)[(size_t)pe[q] * M + rank] = pw[q]; } }
        __syncthreads();
    }
}
__device__ __forceinline__ void combine_phase(Frame& F, int l) {
    build_offt(F, l);
    const Ctx& c = F.c; const LAS int* offt = (const LAS int*)(F.lds + TAB_OFF); const float* X1 = WSP(float, WS_X1); float* X2 = WSP(float, WS_X2);
    const float* mod = WSP(float, WS_MOD) + (size_t)l * NB * 6 * D; const float* mod1 = WSP(float, WS_MOD) + (size_t)NB * 6 * D;
    const int gw = F.vcu * NWAVES + F.wave, NGW = F.G * NWAVES; static_assert(D == 2048, "lane l owns columns 16 l .. 16 l + 15 of each 1024-column half");
    for (int m = gw; m < M; m += NGW) { const int b = m / S; const int lane = F.lane();
        int e = 0, r = 0; float wsel = 1.0f; if (lane < TOPK) { e = WSP(int, WS_SELE)[(size_t)m * TOPK + lane]; r = WSP(int, WS_SELR)[(size_t)m * TOPK + lane]; wsel = WSP(float, WS_SELW)[(size_t)m * TOPK + lane]; }
        long rowi = (lane < TOPK) ? (long)offt[e] * RT + r : (long)offt[E] * RT + m;
        f32x4 acc[2][4];
#pragma unroll
        for (int h = 0; h < 2; ++h)
#pragma unroll
            for (int q = 0; q < 4; ++q) acc[h][q] = (f32x4){0.f, 0.f, 0.f, 0.f};
#pragma unroll 3
        for (int k = 0; k <= TOPK; ++k) { const long ri = __shfl(rowi, k); const float wk = __shfl(wsel, k); const unsigned char* yr = WSP(unsigned char, WS_Y) + (size_t)ri * D + 16 * lane;
#pragma unroll
            for (int h = 0; h < 2; ++h) { const v4u raw = __builtin_nontemporal_load((const v4u*)(yr + h * 1024));
#pragma unroll
                for (int q = 0; q < 4; ++q) { const auto lo = __builtin_amdgcn_cvt_pk_f32_fp8((int)raw[q], false), hi = __builtin_amdgcn_cvt_pk_f32_fp8((int)raw[q], true);
                    acc[h][q][0] += wk * lo[0]; acc[h][q][1] += wk * lo[1]; acc[h][q][2] += wk * hi[0]; acc[h][q][3] += wk * hi[1]; } } }
        float s = 0.f;
#pragma unroll
        for (int h = 0; h < 2; ++h)
#pragma unroll
            for (int q = 0; q < 4; ++q) { const int col = h * 1024 + 16 * lane + 4 * q; const f32x4 x = *(const f32x4*)(X1 + (size_t)m * D + col), g = *(const f32x4*)(mod + (size_t)b * 6 * D + 5 * D + col);
                acc[h][q] = x + g * (acc[h][q] * (1.0f / pg8::F8_Y)); s += (acc[h][q][0] * acc[h][q][0] + acc[h][q][1] * acc[h][q][1]) + (acc[h][q][2] * acc[h][q][2] + acc[h][q][3] * acc[h][q][3]);
                if (l == 0) *(f32x4*)(X2 + (size_t)m * D + col) = acc[h][q]; }
        const float rs = 1.0f / sqrtf(wave_sum(s) * (1.0f / D) + EPS);
#pragma unroll
        for (int h = 0; h < 2; ++h) {
            if (l == 0) { v4u w[2];
#pragma unroll
                for (int q = 0; q < 4; ++q) { const int col = h * 1024 + 16 * lane + 4 * q; const f32x4 g = *(const f32x4*)(c.in[I_NMIX] + D + col), a = *(const f32x4*)(mod1 + (size_t)b * 6 * D + D + col), bb = *(const f32x4*)(mod1 + (size_t)b * 6 * D + col);
                    const f32x4 o = acc[h][q] * rs * g * (1.0f + a) + bb; w[q >> 1][2 * (q & 1)] = cvt_pk_bf16(o[0], o[1]); w[q >> 1][2 * (q & 1) + 1] = cvt_pk_bf16(o[2], o[3]); }
                bf16_t* hp = WSP(bf16_t, WS_HM) + (size_t)m * D + h * 1024 + 16 * lane; *(v4u*)hp = w[0]; *(v4u*)(hp + 8) = w[1]; }
            else {
#pragma unroll
                for (int q = 0; q < 4; ++q) { const int col = h * 1024 + 16 * lane + 4 * q; const f32x4 g = *(const f32x4*)(c.in[I_FNORM] + col); *(f32x4*)(c.out + (size_t)m * D + col) = acc[h][q] * rs * g; } } }
    }
}
__device__ __forceinline__ void retnorm_phase(Frame& F) {
    const Ctx& c = F.c; const int gw = F.vcu * NWAVES + F.wave, NGW = F.G * NWAVES; static_assert(DK == 256, "one f32x4 per lane");
    for (int m0 = gw; m0 < M; m0 += 2 * NGW) { f32x4 v[2][H_C], g[H_C]; u32x2 raw[2][H_C]; float s[2][H_C];
#pragma unroll
        for (int h = 0; h < H_C; ++h) g[h] = *(const f32x4*)(c.in[I_RETGN] + h * DK + 4 * F.lane());
#pragma unroll
        for (int r = 0; r < 2; ++r) { const int m = m0 + r * NGW; const bool ok = m < M;
#pragma unroll
            for (int h = 0; h < H_C; ++h) { const int col = h * DK + 4 * F.lane(); v[r][h] = (f32x4){0.f, 0.f, 0.f, 0.f}; raw[r][h] = (u32x2){0u, 0u};
                if (ok) { v[r][h] = *(const f32x4*)(WSP(float, WS_RET) + (size_t)m * HALF + col); raw[r][h] = *(const u32x2*)(WSP(bf16_t, WS_PROJ) + (size_t)m * CD_N + 3 * H_C * DK + col); }
                s[r][h] = (v[r][h][0] * v[r][h][0] + v[r][h][1] * v[r][h][1]) + (v[r][h][2] * v[r][h][2] + v[r][h][3] * v[r][h][3]); } }
#pragma unroll
        for (int o = 1; o < 64; o <<= 1)
#pragma unroll
            for (int r = 0; r < 2; ++r)
#pragma unroll
                for (int h = 0; h < H_C; ++h) s[r][h] += __shfl_xor(s[r][h], o);
#pragma unroll
        for (int r = 0; r < 2; ++r) { const int m = m0 + r * NGW; if (m < M) {
#pragma unroll
            for (int h = 0; h < H_C; ++h) { const int col = h * DK + 4 * F.lane(); const float rs = 1.0f / sqrtf(s[r][h] * (1.0f / DK) + EPS); f32x4 o = v[r][h] * rs * g[h];
                o[0] *= __uint_as_float(raw[r][h].x << 16); o[1] *= __uint_as_float(raw[r][h].x & 0xffff0000u); o[2] *= __uint_as_float(raw[r][h].y << 16); o[3] *= __uint_as_float(raw[r][h].y & 0xffff0000u);
                u32x2 w; w.x = cvt_pk_bf16(o[0], o[1]); w.y = cvt_pk_bf16(o[2], o[3]); *(u32x2*)(WSP(bf16_t, WS_MIX) + (size_t)m * D + col) = w; } } } }
}
__device__ __forceinline__ void scan_phase(Frame& F) {
    const Ctx& c = F.c; constexpr int NCK = 64, CL = S / NCK, BLK = S * 16 + NCK * 16; static_assert(CL == 32 && 4 * BLK + 4 * NCK * 8 * 4 <= MISC_OFF, "scan LDS map");
    LAS unsigned char* lds = F.lds; LAS float* agg = (LAS float*)(lds + 4 * BLK);
#define SIDX(t) ((t) * 16 + ((t) >> 5) * 16)
    for (int u = F.vcu; u < NB * (LW / 8); u += F.G) { const int b = u / (LW / 8), c8 = u % (LW / 8);
        v4u gvp[S / NTHR];
#pragma unroll
        for (int i = 0; i < S / NTHR; ++i) { const int t = F.tid() + NTHR * i; gvp[i] = *(const v4u*)(WSP(bf16_t, WS_PROJ) + ((size_t)b * S + t) * P0_N + QR + KVR + LW + c8 * 8); }
#pragma unroll
        for (int q = 0; q < 4; ++q) { const bf16_t* src = (q & 1 ? WSP(bf16_t, WS_U) : WSP(bf16_t, WS_LA)) + lru_idx(q >> 1, b, 0, c8 * 8);
#pragma unroll
            for (int i = 0; i < S / NTHR; ++i) { const int t = F.tid() + NTHR * i; *(LAS v4u*)(lds + q * BLK + SIDX(t)) = *(const v4u*)(src + (size_t)t * 8); } }
        __syncthreads();
        const int ch = F.tid() & 7, ck = F.tid() >> 3; const LAS bf16_t* laf = (const LAS bf16_t*)(lds) + ch; const LAS bf16_t* uf = (const LAS bf16_t*)(lds + BLK) + ch;
        const LAS bf16_t* lab = (const LAS bf16_t*)(lds + 2 * BLK) + ch; const LAS bf16_t* ub = (const LAS bf16_t*)(lds + 3 * BLK) + ch;
        { float P = 1.f, H = 0.f;
#pragma unroll 8
          for (int i = 0; i < CL; ++i) { const int o = SIDX(ck * CL + i) / 2; const float a = __builtin_amdgcn_exp2f(LOG2E * bf2f(laf[o])); H = a * H + bf2f(uf[o]); P *= a; }
          agg[(0 * NCK + ck) * 8 + ch] = P; agg[(1 * NCK + ck) * 8 + ch] = H; P = 1.f; H = 0.f;
#pragma unroll 8
          for (int i = CL - 1; i >= 0; --i) { const int o = SIDX(ck * CL + i) / 2; const float a = __builtin_amdgcn_exp2f(LOG2E * bf2f(lab[o])); H = a * H + bf2f(ub[o]); P *= a; }
          agg[(2 * NCK + ck) * 8 + ch] = P; agg[(3 * NCK + ck) * 8 + ch] = H; }
        __syncthreads();
        static_assert(NCK == 64 && NWAVES == 8, "one lane per chunk, two (direction, channel) carries per wave");
#pragma unroll
        for (int i = 0; i < 2; ++i) { const int id = F.wave * 2 + i, dir = id >> 3, cc = id & 7; const int lane = F.lane(), k = dir ? NCK - 1 - lane : lane;
            float A = agg[((2 * dir) * NCK + k) * 8 + cc], B = agg[((2 * dir + 1) * NCK + k) * 8 + cc];
#pragma unroll
            for (int o = 1; o < 64; o <<= 1) { const float A2 = __shfl_up(A, o), B2 = __shfl_up(B, o); if (lane >= o) { B = A * B2 + B; A = A * A2; } }
            const float ex = __shfl_up(B, 1); agg[((2 * dir) * NCK + k) * 8 + cc] = lane ? ex : 0.f; }
        __syncthreads();
        { float hf[CL]; float H = agg[(0 * NCK + ck) * 8 + ch];
#pragma unroll
          for (int i = 0; i < CL; ++i) { const int o = SIDX(ck * CL + i) / 2; const float a = __builtin_amdgcn_exp2f(LOG2E * bf2f(laf[o])); H = a * H + bf2f(uf[o]); hf[i] = H; }
          H = agg[(2 * NCK + ck) * 8 + ch]; LAS bf16_t* so = (LAS bf16_t*)(lds + BLK) + ch;
#pragma unroll
          for (int i = CL - 1; i >= 0; --i) { const int o = SIDX(ck * CL + i) / 2; const float a = __builtin_amdgcn_exp2f(LOG2E * bf2f(lab[o])); H = a * H + bf2f(ub[o]); so[o] = f2bf(hf[i] + H); } }
        __syncthreads();
#pragma unroll
        for (int i = 0; i < S / NTHR; ++i) { const int t = F.tid() + NTHR * i; const size_t m = (size_t)b * S + t; const v4u sv = *(const LAS v4u*)(lds + BLK + SIDX(t)); const v4u gv = gvp[i];
            v4u o;
#pragma unroll
            for (int q = 0; q < 4; ++q) { const float a0 = __uint_as_float(sv[q] << 16) * __uint_as_float(gv[q] << 16), a1 = __uint_as_float(sv[q] & 0xffff0000u) * __uint_as_float(gv[q] & 0xffff0000u); o[q] = cvt_pk_bf16(a0, a1); }
            *(v4u*)(WSP(bf16_t, WS_MIX) + m * D + HALF + c8 * 8) = o; }
        __syncthreads();
    }
#undef SIDX
}
namespace attn {
#define ATT_KSWZ(row, colB, RS) ((row) * (RS) + ((colB) ^ (((row) & 7) << 4)))
__device__ __forceinline__ int crow(int r, int hi) { return (r & 3) + 8 * (r >> 2) + 4 * hi; }
__device__ __forceinline__ int v_st(int k, int c) { const int kk = (k & ~0xC) | ((k & 4) << 1) | ((k & 8) >> 1); return ((kk >> 3) * 4 + (c >> 5)) * 512 + ((kk & 7) * 32 + (c & 31)) * 2; }
__device__ __forceinline__ int v_rd_base(int lane) { return ((lane & 3) << 3) | (((lane >> 2) & 3) << 6) | (((lane >> 4) & 1) << 5) | (((lane >> 5) & 1) << 8); }
constexpr int v_rd_off(int d0, int ks, int half) { return d0 * 512 + ks * 4096 + half * 2048; }
template <int OFF> __device__ __forceinline__ s16x4 tr_read(int vb) { s16x4 r; asm volatile("ds_read_b64_tr_b16 %0, %1 offset:%2" : "=&v"(r) : "v"(vb), "i"(OFF) : "memory"); return r; }
template <int D0> __device__ __forceinline__ void pv_one(f32x16& od, int vb, bf16x8 pa0, bf16x8 pa1, bf16x8 pa2, bf16x8 pa3) {
    const s16x4 l0 = tr_read<v_rd_off(D0, 0, 0)>(vb), h0 = tr_read<v_rd_off(D0, 0, 1)>(vb), l1 = tr_read<v_rd_off(D0, 1, 0)>(vb), h1 = tr_read<v_rd_off(D0, 1, 1)>(vb);
    const s16x4 l2 = tr_read<v_rd_off(D0, 2, 0)>(vb), h2 = tr_read<v_rd_off(D0, 2, 1)>(vb), l3 = tr_read<v_rd_off(D0, 3, 0)>(vb), h3 = tr_read<v_rd_off(D0, 3, 1)>(vb);
    asm volatile("s_waitcnt lgkmcnt(0)" ::: "memory"); __builtin_amdgcn_sched_barrier(0);
#define ATT_PK(L, H) (bf16x8){L[0], L[1], L[2], L[3], H[0], H[1], H[2], H[3]}
    od = __builtin_amdgcn_mfma_f32_32x32x16_bf16(pa0, ATT_PK(l0, h0), od, 0, 0, 0);
    od = __builtin_amdgcn_mfma_f32_32x32x16_bf16(pa1, ATT_PK(l1, h1), od, 0, 0, 0);
    od = __builtin_amdgcn_mfma_f32_32x32x16_bf16(pa2, ATT_PK(l2, h2), od, 0, 0, 0);
    od = __builtin_amdgcn_mfma_f32_32x32x16_bf16(pa3, ATT_PK(l3, h3), od, 0, 0, 0);
#undef ATT_PK
}
template <int DQK, int MODE>
__device__ __forceinline__ void attn_unit(LAS unsigned char* lds, const int wave, const bf16_t* Qb, int ldq, const bf16_t* Kh, int ldk, const bf16_t* Vh, int ldv, int key0, int ntiles, int q0,
                                          float pa_, float pb_, bf16_t* Ob, float* Of, int ldo) {
    constexpr int KB = 64 * DQK * 2, VB = 64 * 128 * 2, NKP = DQK / 8, KPT = DQK / 64, RS = DQK * 2;
    constexpr int OFF_V = 2 * KB, OFF_WS = OFF_V + 2 * VB, OFF_LUT = OFF_WS + NWAVES * 64 * 4;
    const int wid = __builtin_amdgcn_readfirstlane(wave), lane = lane_id(), tid = wid * 64 + lane, r32 = lane & 31, hi = lane >> 5;
    LAS unsigned char* Kl = lds; LAS unsigned char* Vl = lds + OFF_V; LAS float* wsf = (LAS float*)(lds + OFF_WS) + wid * 64; const LAS float* lut = (const LAS float*)(lds + OFF_LUT);
    float m_reg = (MODE == 1) ? pa_ : -1e30f, l_reg = (MODE == 1) ? 1.0f : 0.f;
    f32x16 o[4] = {}; bf16x8 qr[DQK / 16];
    { const bf16_t* Qw = Qb + (size_t)(wid * 32 + r32) * ldq + hi * 8;
#pragma unroll
      for (int d0 = 0; d0 < DQK / 16; ++d0) qr[d0] = *(const bf16x8*)(Qw + d0 * 16); }
    constexpr bool REGK = (NTHR % NKP == 0) && ((NTHR / NKP) % 8 == 0);
    int koff[REGK ? 1 : KPT], kdst[REGK ? 1 : KPT];
#pragma unroll
    for (int i = 0; i < (REGK ? 1 : KPT); ++i) { const int p = tid + NTHR * i, key = p / NKP, c8 = p % NKP; koff[i] = key * ldk + c8 * 8; kdst[i] = ATT_KSWZ(key, c8 * 16, RS); }
#define ATT_KOFF(i) (REGK ? koff[0] + (i) * (NTHR / NKP) * ldk : koff[REGK ? 0 : (i)])
#define ATT_KDST(i) (REGK ? kdst[0] + (i) * (NTHR / NKP) * RS : kdst[REGK ? 0 : (i)])
    const int sr = tid >> 4, sc = (tid & 15) * 8, vst0 = v_st(sr, sc), vst1 = vst0 + 8192;
    const int vb0 = (int)(unsigned)(uintptr_t)Vl + v_rd_base(lane);
    bf16x8 ks[KPT], vs0, vs1;
#define ATT_SLOAD(kb) do { _Pragma("unroll") for (int i = 0; i < KPT; ++i) ks[i] = *(const bf16x8*)(Kh + (size_t)(kb) * ldk + ATT_KOFF(i)); \
        vs0 = *(const bf16x8*)(Vh + (size_t)((kb) + sr) * ldv + sc); vs1 = *(const bf16x8*)(Vh + (size_t)((kb) + 32 + sr) * ldv + sc); } while (0)
#define ATT_SWRITE(b) do { _Pragma("unroll") for (int i = 0; i < KPT; ++i) *(LAS bf16x8*)(Kl + (b) * KB + ATT_KDST(i)) = ks[i]; \
        *(LAS bf16x8*)(Vl + (b) * VB + vst0) = vs0; *(LAS bf16x8*)(Vl + (b) * VB + vst1) = vs1; } while (0)
    ATT_SLOAD(key0); ATT_SWRITE(0); __syncthreads();
    for (int j = 0; j < ntiles; ++j) {
        const int cur = j & 1; const int kb = key0 + j * 64;
        if (j + 1 < ntiles) ATT_SLOAD(kb + 64);
        bool live = true;
        if constexpr (MODE == 1) { const int qlo = q0 + wid * 32; live = (kb + 63 >= qlo - WIN) && (kb <= qlo + 31 + WIN); }
        if (live) {
        f32x16 p0 = {}, p1 = {};
        { const LAS unsigned char* Ks = Kl + cur * KB;
#pragma unroll
          for (int d0 = 0; d0 < DQK / 16; ++d0) { const int cb = (d0 * 16 + hi * 8) * 2;
              const bf16x8 b0 = *(const LAS bf16x8*)(Ks + ATT_KSWZ(r32, cb, RS)), b1 = *(const LAS bf16x8*)(Ks + ATT_KSWZ(32 + r32, cb, RS));
              p0 = __builtin_amdgcn_mfma_f32_32x32x16_bf16(b0, qr[d0], p0, 0, 0, 0); p1 = __builtin_amdgcn_mfma_f32_32x32x16_bf16(b1, qr[d0], p1, 0, 0, 0); } }
        if constexpr (MODE == 2) {
            const int dq = kb - (q0 + wid * 32 + r32);
#pragma unroll
            for (int r = 0; r < 16; ++r) { const int rel0 = dq + crow(r, hi), rel1 = rel0 + 32;
                p0[r] *= __builtin_amdgcn_exp2f((rel0 <= 0 ? pa_ : pb_) * (float)rel0); p1[r] *= __builtin_amdgcn_exp2f((rel1 <= 0 ? pa_ : pb_) * (float)rel1); }
        } else {
            if constexpr (MODE == 1) { const LAS float* lp = lut + (kb - (q0 + wid * 32 + r32) + 383);
#pragma unroll
                for (int r = 0; r < 16; ++r) { p0[r] += lp[crow(r, hi)]; p1[r] += lp[32 + crow(r, hi)]; } }
            float pmax = p0[0];
#pragma unroll
            for (int r = 1; r < 16; ++r) pmax = fmaxf(pmax, p0[r]);
#pragma unroll
            for (int r = 0; r < 16; ++r) pmax = fmaxf(pmax, p1[r]);
            { auto rr = __builtin_amdgcn_permlane32_swap(__float_as_uint(pmax), __float_as_uint(pmax), false, false); pmax = fmaxf(__uint_as_float(rr[0]), __uint_as_float(rr[1])); }
            float mn, alpha;
            if (__builtin_expect(__all(pmax - m_reg <= 11.5f), 1)) { mn = m_reg; alpha = 1.f; }
            else { mn = fmaxf(m_reg, pmax); alpha = __builtin_amdgcn_exp2f(m_reg - mn); m_reg = mn; }
#pragma unroll
            for (int r = 0; r < 16; ++r) { p0[r] = __builtin_amdgcn_exp2f(p0[r] - mn); p1[r] = __builtin_amdgcn_exp2f(p1[r] - mn); }
            float ps = 0.f;
#pragma unroll
            for (int r = 0; r < 16; ++r) ps += p0[r];
#pragma unroll
            for (int r = 0; r < 16; ++r) ps += p1[r];
            { auto rr = __builtin_amdgcn_permlane32_swap(__float_as_uint(ps), __float_as_uint(ps), false, false); ps = __uint_as_float(rr[0]) + __uint_as_float(rr[1]); }
            l_reg = l_reg * alpha + ps;
            if (__any(alpha < 1.f)) { if (hi == 0) wsf[32 + r32] = alpha; asm volatile("s_waitcnt lgkmcnt(0)" ::: "memory");
#pragma unroll
                for (int r = 0; r < 16; ++r) { const float a = wsf[32 + crow(r, hi)];
#pragma unroll
                    for (int d = 0; d < 4; ++d) o[d][r] *= a; } }
        }
        bf16x8 pa0, pa1, pa2, pa3;
#define ATT_PK4(P, BASE, OUT) do { unsigned a0 = cvt_pk_bf16(P[BASE + 0], P[BASE + 1]), a1 = cvt_pk_bf16(P[BASE + 2], P[BASE + 3]); \
        unsigned b0_ = cvt_pk_bf16(P[BASE + 4], P[BASE + 5]), b1_ = cvt_pk_bf16(P[BASE + 6], P[BASE + 7]); \
        auto r0 = __builtin_amdgcn_permlane32_swap(a0, b0_, false, false); auto r1 = __builtin_amdgcn_permlane32_swap(a1, b1_, false, false); \
        v4u w = {r0[0], r1[0], r0[1], r1[1]}; OUT = *reinterpret_cast<bf16x8*>(&w); } while (0)
        ATT_PK4(p0, 0, pa0); ATT_PK4(p0, 8, pa1); ATT_PK4(p1, 0, pa2); ATT_PK4(p1, 8, pa3);
#undef ATT_PK4
        { const int vb = vb0 + cur * VB; pv_one<0>(o[0], vb, pa0, pa1, pa2, pa3); pv_one<1>(o[1], vb, pa0, pa1, pa2, pa3); pv_one<2>(o[2], vb, pa0, pa1, pa2, pa3); pv_one<3>(o[3], vb, pa0, pa1, pa2, pa3); }
        }
        if (j + 1 < ntiles) ATT_SWRITE(cur ^ 1);
        __syncthreads();
    }
#undef ATT_SLOAD
#undef ATT_SWRITE
#undef ATT_KOFF
#undef ATT_KDST
    if constexpr (MODE == 2) {
#pragma unroll
        for (int r = 0; r < 16; ++r) { float* orow = Of + (size_t)(wid * 32 + crow(r, hi)) * ldo + r32;
#pragma unroll
            for (int d0 = 0; d0 < 4; ++d0) orow[d0 * 32] = o[d0][r]; }
    } else {
        if (hi == 0) wsf[r32] = l_reg; asm volatile("s_waitcnt lgkmcnt(0)" ::: "memory");
#pragma unroll
        for (int r = 0; r < 16; ++r) { const float rl = __builtin_amdgcn_rcpf(wsf[crow(r, hi)]); bf16_t* orow = Ob + (size_t)(wid * 32 + crow(r, hi)) * ldo + r32;
#pragma unroll
            for (int d0 = 0; d0 < 4; ++d0) orow[d0 * 32] = f2bf(o[d0][r] * rl); }
    }
    __syncthreads();
}
#undef ATT_KSWZ
}

__device__ __forceinline__ void att0_phase(Frame& F) {
    const Ctx& c = F.c;
    for (int u = F.vcu; u < NB * H_A * (S / 256); u += F.G) { const int qb = u % (S / 256), h = (u / (S / 256)) % H_A, b = u / ((S / 256) * H_A);
        attn::attn_unit<QK, 0>(F.lds, F.wave, WSP(bf16_t, WS_Q) + ((size_t)(b * S + qb * 256) * H_A + h) * QK, H_A * QK, WSP(bf16_t, WS_KC) + ((size_t)b * S * H_A + h) * QK, H_A * QK,
                               WSP(bf16_t, WS_V) + ((size_t)b * S * H_A + h) * VD, H_A * VD, 0, S / 64, qb * 256, 0.f, 0.f, WSP(bf16_t, WS_MIX) + (size_t)(b * S + qb * 256) * D + h * VD, nullptr, D); }
}
__device__ __forceinline__ void ret1_phase(Frame& F) {
    const Ctx& c = F.c;
    for (int u = F.vcu; u < NB * H_C * (S / 256) * 2; u += F.G) { const int dvh = u & 1, qb = (u >> 1) % (S / 256), h = (u / (2 * (S / 256))) % H_C, b = u / (2 * (S / 256) * H_C);
        const bf16_t* Pb = WSP(bf16_t, WS_PROJ) + (size_t)b * S * CD_N;
        const float lgf = log2f(1.0f - exp2f(-5.0f - (float)h)), lgb = log2f(1.0f - exp2f(-5.0f - (float)(H_C - 1 - h)));
        const int df = (int)(11.0f / -lgf) + 1, db = (int)(11.0f / -lgb) + 1; int t0 = (qb * 256 - df - 63) / 64; if (t0 < 0) t0 = 0; int t1 = (qb * 256 + 255 + db) / 64 + 1; if (t1 > S / 64) t1 = S / 64;
        attn::attn_unit<DK, 2>(F.lds, F.wave, Pb + (size_t)qb * 256 * CD_N + h * DK, CD_N, Pb + H_C * DK + h * DK, CD_N, Pb + 2 * H_C * DK + h * DK + dvh * 128, CD_N, t0 * 64, t1 - t0, qb * 256, -lgf, lgb,
                               nullptr, WSP(float, WS_RET) + (size_t)(b * S + qb * 256) * HALF + h * DK + dvh * 128, HALF); }
}
__device__ __forceinline__ void swa1_phase(Frame& F) {
    const Ctx& c = F.c; constexpr int OFF_LUT = 2 * 64 * HDS * 2 + 2 * 64 * 128 * 2 + NWAVES * 64 * 4; LAS float* lut = (LAS float*)(F.lds + OFF_LUT);
    for (int u = F.vcu; u < NB * H_D * (S / 256); u += F.G) { const int qb = u % (S / 256), hd = (u / (S / 256)) % H_D, b = u / ((S / 256) * H_D); const int kvh = hd / (H_D / KVH);
        for (int i = F.tid(); i < 767; i += NTHR) { const int rel = i - 383; lut[i] = (rel < -WIN || rel > WIN) ? -1e30f : c.in[I_RELB][t5_bucket(rel) * H_D + hd] * LOG2E; }
        __syncthreads();
        const bf16_t* Pb = WSP(bf16_t, WS_PROJ) + (size_t)b * S * CD_N + 4 * H_C * DK;
        const int klo = qb * 256 - WIN < 0 ? 0 : qb * 256 - WIN, khi = qb * 256 + 256 + WIN > S ? S : qb * 256 + 256 + WIN;
        attn::attn_unit<HDS, 1>(F.lds, F.wave, Pb + (size_t)qb * 256 * CD_N + hd * HDS, CD_N, Pb + H_D * HDS + kvh * HDS, CD_N, Pb + H_D * HDS + KVH * HDS + kvh * HDS, CD_N, klo, (khi - klo) / 64, qb * 256,
                                c.in[I_SINKS][hd] * LOG2E, 0.f, WSP(bf16_t, WS_MIX) + (size_t)(b * S + qb * 256) * D + HALF + hd * HDS, nullptr, D); }
}


#ifndef OPT_MASK
#define OPT_MASK 0
#endif
struct MArgs { Ctx c; long ph_lo, ph_hi, use_bar, pad; };
__global__ void __launch_bounds__(NTHR, 2) mega_fwd(MArgs args) {
    extern __shared__ __attribute__((aligned(16))) unsigned char lds_raw[];
    Frame F; F.lds = (LAS unsigned char*)lds_raw; F.c = args.c;
    F.wave = __builtin_amdgcn_readfirstlane((int)threadIdx.x >> 6);
    F.G = gridDim.x; { const int bx = blockIdx.x; F.vcu = (F.G % 8 == 0) ? (bx % 8) * (F.G / 8) + bx / 8 : bx; }
    const Ctx& c = F.c;
    volatile LAS unsigned* MISC = (volatile LAS unsigned*)(F.lds + MISC_OFF);
    for (int u = F.tid(); u < 256; u += NTHR) MISC[u] = 0u;
    __syncthreads();
    XcdBarrier bar; bar.bar = (unsigned*)(c.ws + 16384); bar.x = 0; bar.st = MISC + 8; bar.wave = F.wave;
    if (args.use_bar) bar = xcd_barrier_post((unsigned*)(c.ws + 16384), MISC + 8, F.wave);
    const int lo = (int)args.ph_lo, hi = (int)args.ph_hi;
#define IN(k) (lo <= (k) && (k) < hi)
#define SEAM(k) do { if (IN(k) && IN((k) + 1)) xcd_barrier(bar); } while (0)
    float* mod = WSP(float, WS_MOD);
#ifdef SPREAD_CONV
#define CONV_EARLY(call) do { if (!(blockIdx.x & 1)) { call; __syncthreads(); } } while (0)
#define CONV_LATE(call)  do { if (blockIdx.x & 1) { __syncthreads(); call; __syncthreads(); } } while (0)
#else
#define CONV_EARLY(call) do { } while (0)
#define CONV_LATE(call)  do { } while (0)
#endif
#define CONV_GU0(k0, k1) conv_slice(F, IT_GU0, IT_DN0, k0, k1, 20)
#define CONV_GU1(k0, k1) conv_slice(F, IT_GU1, IT_DN1, k0, k1, 17)

    if (IN(PH_P0)) { p0_phase(F); } SEAM(PH_P0);
#ifdef HAVE_THIN
    if (IN(PH_MOD0)) { modulate_phase(F, c.in[I_X], c.in[I_NMIX], mod + D, mod); } SEAM(PH_MOD0);
#endif
    if (IN(PH_G1)) {
        pg8::DenseOrder S_; S_.A = (const char*)WSP(bf16_t, WS_HM); S_.B = (const char*)WSP(bf16_t, W_INAB); S_.nM = M / 256; S_.nN = P0_N / 256; S_.G = F.G; S_.c = (int)blockIdx.x; S_.a_tile = (long)256 * D * 2; S_.b_tile = (long)256 * D * 2;
        pg8::EpiG1 E_{WSP(bf16_t, WS_PROJ), WSP(bf16_t, WS_LXP), WSP(float, CTL_SSQ)};
        pg8::gemm_phase<pg8::EpiG1, pg8::DenseOrder, pg8::APlain, false, true>(F.lds, F.wave, (const char*)c.ws, D, D, D, S_, E_);
#ifdef HAVE_SKINNY
        krope_units(F);
#endif
#ifdef SPREAD_CONV
        if ((int)blockIdx.x >= F.G / 2) { __syncthreads(); const int pi = (int)blockIdx.x - F.G / 2, np = F.G - F.G / 2;
            conv_items(F, IT_OUTAB, IT_GU0, pi, np); conv_slice(F, IT_GU0, IT_DN0, 0, 4, 20, pi, np); __syncthreads(); }
#endif
    } SEAM(PH_G1);
    if (IN(PH_G2)) {
        CONV_EARLY(CONV_GU0(4, 8));
        { pg8::OrderG2 S_{(const char*)WSP(bf16_t, WS_PROJ), (const char*)WSP(bf16_t, W_UQ), (const char*)WSP(bf16_t, W_UKV), F.G, (int)blockIdx.x};
          pg8::EpiG2 E_{WSP(bf16_t, WS_Q), WSP(bf16_t, WS_KC), WSP(bf16_t, WS_V), WSP(float, CTL_SSQ), WSP(float, WS_TAB + TAB_CR), WSP(float, WS_TAB + TAB_SR), LOG2E / sqrtf((float)QK)};
          pg8::gemm_phase<pg8::EpiG2, pg8::OrderG2, pg8::APlain, false, true>(F.lds, F.wave, (const char*)c.ws, P0_N, QR, QR, S_, E_); }
        { pg8::OrderGates S_{(const char*)WSP(bf16_t, WS_LXP), (const char*)WSP(bf16_t, W_LRU), F.G, (int)((blockIdx.x + F.G / 2) % F.G)};
          pg8::EpiGates E_{WSP(bf16_t, WS_LA), WSP(bf16_t, WS_U), WSP(bf16_t, WS_LXP), WSP(float, W_GB), WSP(float, W_GB) + 4 * LW, c.in[I_CONVW], c.in[I_CONVB]};
          pg8::gemm_phase<pg8::EpiGates, pg8::OrderGates, pg8::AConv, false, true>(F.lds, F.wave, (const char*)c.ws, LW, 4 * LBS, 4 * LBS, S_, E_); }
        CONV_LATE(CONV_GU0(4, 8));
    } SEAM(PH_G2);
#ifdef HAVE_THIN
    if (IN(PH_SCAN0)) { CONV_EARLY(CONV_GU0(8, 10)); scan_phase(F); CONV_LATE(CONV_GU0(8, 10)); }
#endif
#ifdef HAVE_ATT0
    if (IN(PH_ATT0)) { CONV_EARLY(CONV_GU0(10, 14)); att0_phase(F); CONV_LATE(CONV_GU0(10, 14)); } SEAM(PH_ATT0);
#endif
    if (IN(PH_OUT0)) {
        CONV_EARLY(CONV_GU0(14, 17));
        pg8::DenseOrder S_; S_.A = (const char*)WSP(bf16_t, WS_MIX); S_.B = (const char*)WSP(bf16_t, W_OUTAB); S_.nM = M / 256; S_.nN = D / 256; S_.G = F.G; S_.c = (int)blockIdx.x; S_.a_tile = (long)256 * D * 2; S_.b_tile = (long)256 * D * 2;
        pg8::EpiOut E_{c.in[I_X], WSP(float, WS_X1), mod + 2 * D};
        pg8::gemm_phase<pg8::EpiOut, pg8::DenseOrder, pg8::APlain, false, true>(F.lds, F.wave, (const char*)c.ws, D, D, D, S_, E_);
        CONV_LATE(CONV_GU0(14, 17));
    } SEAM(PH_OUT0);
#ifdef HAVE_RT
    if (IN(PH_RT0)) { CONV_EARLY(CONV_GU0(17, 20)); route_phase(F, 0); CONV_LATE(CONV_GU0(17, 20)); } SEAM(PH_RT0);
#endif
    if (IN(PH_M1_0)) {
#ifdef SPREAD_CONV
        mod_units(F, 1);
#endif
        CONV_EARLY(conv_items(F, IT_DN0, IT_GU1));
        build_offt(F, 0);
#ifdef MOE_FP8
        typedef pg8::OrderMoeT<2 * FF / 256, true, WS_HM8, W_GU + (size_t)0 * (E + 1) * 2 * FF * D, (long)2 * FF * D, (long)256 * D, 0> OM1;
#ifdef MOE_CONTIG
        const int tot1_ = ((const LAS int*)(F.lds + TAB_OFF))[E + 1] * (2 * FF / 256), lo1_ = (int)((long)tot1_ * F.vcu / F.G), hi1_ = (int)((long)tot1_ * (F.vcu + 1) / F.G);
        OM1 S_{c.ws, lo1_, hi1_ - lo1_};
#else
        OM1 S_{c.ws, F.G, F.vcu};
#endif
        pg8::EpiM1F8 E_{c.ws};
        pg8::gemm_phase<pg8::EpiM1F8, OM1, pg8::APlain, true, true, 1>(F.lds, F.wave, (const char*)c.ws, D / 2, D / 2, D / 2, S_, E_);
#else
        pg8::OrderMoe S_{(const LAS int*)(F.lds + TAB_OFF), (const char*)WSP(bf16_t, WS_HM), (const char*)WSP(bf16_t, W_GU), WSP(int, WS_TOK), 2 * FF / 256, F.G, F.vcu, 1, (long)2 * FF * D * 2, (long)256 * D * 2, 0};
        pg8::EpiM1 E_{WSP(bf16_t, WS_ACT)};
        pg8::gemm_phase<pg8::EpiM1, pg8::OrderMoe, pg8::APlain, true, true>(F.lds, F.wave, (const char*)c.ws, D, D, D, S_, E_);
#endif
        CONV_LATE(conv_items(F, IT_DN0, IT_GU1));
    } SEAM(PH_M1_0);
    if (IN(PH_M2_0)) { CONV_EARLY(CONV_GU1(0, 4)); build_offt(F, 0);
#ifdef MOE_FP8
        typedef pg8::OrderMoeT<D / 256, false, WS_ACT, W_DN + (size_t)0 * (E + 1) * D * FF, (long)D * FF, (long)256 * FF, (long)256 * FF> OM2;
#ifdef MOE_CONTIG
        const int tot2_ = ((const LAS int*)(F.lds + TAB_OFF))[E + 1] * (D / 256), lo2_ = (int)((long)tot2_ * F.vcu / F.G), hi2_ = (int)((long)tot2_ * (F.vcu + 1) / F.G);
        OM2 S_{c.ws, lo2_, hi2_ - lo2_};
#else
        OM2 S_{c.ws, F.G, F.vcu};
#endif
        pg8::EpiM2F8 E_{c.ws};
        pg8::gemm_phase<pg8::EpiM2F8, OM2, pg8::APlain, false, true, 1>(F.lds, F.wave, (const char*)c.ws, FF / 2, FF / 2, FF / 2, S_, E_);
#else
        pg8::OrderMoe S_{(const LAS int*)(F.lds + TAB_OFF), (const char*)WSP(bf16_t, WS_ACT), (const char*)WSP(bf16_t, W_DN), WSP(int, WS_TOK), D / 256, F.G, F.vcu, 0, (long)D * FF * 2, (long)256 * FF * 2, (long)256 * FF * 2};
        pg8::EpiM2 E_{WSP(bf16_t, WS_Y), WSP(float, WS_WT), (const LAS int*)(F.lds + TAB_OFF), 1.0f};
        pg8::gemm_phase<pg8::EpiM2, pg8::OrderMoe, pg8::APlain, false, true>(F.lds, F.wave, (const char*)c.ws, FF, FF, FF, S_, E_);
#endif
        CONV_LATE(CONV_GU1(0, 4));
    } SEAM(PH_M2_0);
#ifdef HAVE_THIN
    if (IN(PH_CMB0)) { CONV_EARLY(CONV_GU1(4, 6)); combine_phase(F, 0); CONV_LATE(CONV_GU1(4, 6)); } SEAM(PH_CMB0);
#endif
    if (IN(PH_G3)) {
        pg8::DenseOrder S_; S_.A = (const char*)WSP(bf16_t, WS_HM); S_.B = (const char*)WSP(bf16_t, W_INCD); S_.nM = M / 256; S_.nN = CD_N / 256; S_.G = F.G; S_.c = (int)blockIdx.x; S_.a_tile = (long)256 * D * 2; S_.b_tile = (long)256 * D * 2;
        pg8::EpiG3 E_{WSP(bf16_t, WS_PROJ), WSP(float, WS_TAB + TAB_CT), WSP(float, WS_TAB + TAB_ST), LOG2E / sqrtf((float)HDS)};
        pg8::gemm_phase<pg8::EpiG3, pg8::DenseOrder, pg8::APlain, false, true>(F.lds, F.wave, (const char*)c.ws, D, D, D, S_, E_);
#ifdef SPREAD_CONV
        { const int nu = (M / 256) * (CD_N / 256), rem = nu % F.G;
          if (rem != 0 && (int)blockIdx.x >= rem) { __syncthreads(); conv_slice(F, IT_GU1, IT_DN1, 6, 8, 17, (int)blockIdx.x - rem, F.G - rem); __syncthreads(); }
          else if (rem == 0) { __syncthreads(); CONV_GU1(6, 8); __syncthreads(); } }
#endif
    } SEAM(PH_G3);
#ifdef HAVE_RET1
    if (IN(PH_RET1)) { CONV_EARLY(CONV_GU1(8, 12)); ret1_phase(F); CONV_LATE(CONV_GU1(8, 12)); }
#endif
#ifdef HAVE_SWA1
    if (IN(PH_SWA1)) { CONV_EARLY(CONV_GU1(12, 13)); swa1_phase(F); CONV_LATE(CONV_GU1(12, 13)); } SEAM(PH_SWA1);
#endif
#ifdef HAVE_THIN
    if (IN(PH_RN1)) { retnorm_phase(F); } SEAM(PH_RN1);
#endif
    if (IN(PH_OUT1)) {
        CONV_EARLY(CONV_GU1(13, 15));
        pg8::DenseOrder S_; S_.A = (const char*)WSP(bf16_t, WS_MIX); S_.B = (const char*)WSP(bf16_t, W_OUTCD); S_.nM = M / 256; S_.nN = D / 256; S_.G = F.G; S_.c = (int)blockIdx.x; S_.a_tile = (long)256 * D * 2; S_.b_tile = (long)256 * D * 2;
        pg8::EpiOut E_{WSP(float, WS_X2), WSP(float, WS_X1), mod + (size_t)NB * 6 * D + 2 * D};
        pg8::gemm_phase<pg8::EpiOut, pg8::DenseOrder, pg8::APlain, false, true>(F.lds, F.wave, (const char*)c.ws, D, D, D, S_, E_);
        CONV_LATE(CONV_GU1(13, 15));
    } SEAM(PH_OUT1);
#ifdef HAVE_RT
    if (IN(PH_RT1)) { CONV_EARLY(CONV_GU1(15, 17)); route_phase(F, 1); CONV_LATE(CONV_GU1(15, 17)); } SEAM(PH_RT1);
#endif
    if (IN(PH_M1_1)) { CONV_EARLY(conv_items(F, IT_DN1, IT_END)); build_offt(F, 1);
#ifdef MOE_FP8
        typedef pg8::OrderMoeT<2 * FF / 256, true, WS_HM8, W_GU + (size_t)1 * (E + 1) * 2 * FF * D, (long)2 * FF * D, (long)256 * D, 0> OM1;
#ifdef MOE_CONTIG
        const int tot1_ = ((const LAS int*)(F.lds + TAB_OFF))[E + 1] * (2 * FF / 256), lo1_ = (int)((long)tot1_ * F.vcu / F.G), hi1_ = (int)((long)tot1_ * (F.vcu + 1) / F.G);
        OM1 S_{c.ws, lo1_, hi1_ - lo1_};
#else
        OM1 S_{c.ws, F.G, F.vcu};
#endif
        pg8::EpiM1F8 E_{c.ws};
        pg8::gemm_phase<pg8::EpiM1F8, OM1, pg8::APlain, true, true, 1>(F.lds, F.wave, (const char*)c.ws, D / 2, D / 2, D / 2, S_, E_);
#else
        pg8::OrderMoe S_{(const LAS int*)(F.lds + TAB_OFF), (const char*)WSP(bf16_t, WS_HM), (const char*)(WSP(bf16_t, W_GU) + (size_t)(E + 1) * 2 * FF * D), WSP(int, WS_TOK), 2 * FF / 256, F.G, F.vcu, 1, (long)2 * FF * D * 2, (long)256 * D * 2, 0};
        pg8::EpiM1 E_{WSP(bf16_t, WS_ACT)};
        pg8::gemm_phase<pg8::EpiM1, pg8::OrderMoe, pg8::APlain, true, true>(F.lds, F.wave, (const char*)c.ws, D, D, D, S_, E_);
#endif
        CONV_LATE(conv_items(F, IT_DN1, IT_END));
    } SEAM(PH_M1_1);
    if (IN(PH_M2_1)) { build_offt(F, 1);
#ifdef MOE_FP8
        typedef pg8::OrderMoeT<D / 256, false, WS_ACT, W_DN + (size_t)1 * (E + 1) * D * FF, (long)D * FF, (long)256 * FF, (long)256 * FF> OM2;
#ifdef MOE_CONTIG
        const int tot2_ = ((const LAS int*)(F.lds + TAB_OFF))[E + 1] * (D / 256), lo2_ = (int)((long)tot2_ * F.vcu / F.G), hi2_ = (int)((long)tot2_ * (F.vcu + 1) / F.G);
        OM2 S_{c.ws, lo2_, hi2_ - lo2_};
#else
        OM2 S_{c.ws, F.G, F.vcu};
#endif
        pg8::EpiM2F8 E_{c.ws};
        pg8::gemm_phase<pg8::EpiM2F8, OM2, pg8::APlain, false, true, 1>(F.lds, F.wave, (const char*)c.ws, FF / 2, FF / 2, FF / 2, S_, E_);
#else
        pg8::OrderMoe S_{(const LAS int*)(F.lds + TAB_OFF), (const char*)WSP(bf16_t, WS_ACT), (const char*)(WSP(bf16_t, W_DN) + (size_t)(E + 1) * D * FF), WSP(int, WS_TOK), D / 256, F.G, F.vcu, 0, (long)D * FF * 2, (long)256 * FF * 2, (long)256 * FF * 2};
        pg8::EpiM2 E_{WSP(bf16_t, WS_Y), WSP(float, WS_WT), (const LAS int*)(F.lds + TAB_OFF), 1.0f};
        pg8::gemm_phase<pg8::EpiM2, pg8::OrderMoe, pg8::APlain, false, true>(F.lds, F.wave, (const char*)c.ws, FF, FF, FF, S_, E_);
#endif
    } SEAM(PH_M2_1);
#ifdef HAVE_THIN
    if (IN(PH_CMB1)) { combine_phase(F, 1); }
#endif
#undef IN
#undef SEAM
}

extern "C" void kernel_launch(void* const* d_in, const int* in_sizes, int n_in, void* d_out, int out_size, void* d_ws, size_t ws_size, hipStream_t stream) {
    static int grid = 0;
    if (grid == 0) {
        if (n_in != N_IN || out_size != M * D || ws_size < WS_END) { fprintf(stderr, "kernel_launch: unexpected shapes (n_in %d, out %d, ws %zu < %zu)\n", n_in, out_size, ws_size, (size_t)WS_END); grid = -1; return; }
        int dev = 0, cus = 0;
        if (hipGetDevice(&dev) != hipSuccess || hipDeviceGetAttribute(&cus, hipDeviceAttributeMultiprocessorCount, dev) != hipSuccess) { grid = -1; return; }
        if (hipFuncSetAttribute((const void*)mega_fwd, hipFuncAttributeMaxDynamicSharedMemorySize, LDS_BYTES) != hipSuccess) { fprintf(stderr, "kernel_launch: hipFuncSetAttribute failed\n"); grid = -1; return; }
        int per_cu = 0; (void)hipOccupancyMaxActiveBlocksPerMultiprocessor(&per_cu, (const void*)mega_fwd, NTHR, LDS_BYTES); (void)hipGetLastError();
        if (per_cu < 1) fprintf(stderr, "kernel_launch: occupancy query reports %d\n", per_cu);
        grid = cus;
    }
    if (grid < 0) return;
    Ctx c; memset((void*)&c, 0, sizeof(c));
    for (int i = 0; i < N_IN; ++i) c.in[i] = (const float*)d_in[i];
    c.out = (float*)d_out; c.ws = (unsigned char*)d_ws;
    (void)hipMemsetAsync((char*)d_ws + WS_CTL, 0, CTL_BYTES, stream);
    Launcher go{stream};
    const unsigned mask = (unsigned)(OPT_MASK);
    int n_mega = 0; for (int p = 0; p < N_PHASES; ++p) n_mega += (mask >> p) & 1u;
#ifdef FORCE_SPLIT
    const bool one = false;
#else
    const bool one = (mask == (1u << N_PHASES) - 1u);
#endif
    for (int ph = 0; ph < N_PHASES; ) {
        if ((mask >> ph) & 1u) {
            int hi = ph + 1; if (one) hi = N_PHASES;
            MArgs a; memset((void*)&a, 0, sizeof(a)); a.c = c; a.ph_lo = ph; a.ph_hi = hi; a.use_bar = one ? 1 : 0;
            hipLaunchKernelGGL(mega_fwd, dim3(grid), dim3(NTHR), LDS_BYTES, stream, a);
#ifdef DUP_PHASE
            if (!one && ph == (DUP_PHASE)) hipLaunchKernelGGL(mega_fwd, dim3(grid), dim3(NTHR), LDS_BYTES, stream, a);
#endif
            if (!one && (ph == PH_RT0 || ph == PH_RT1)) naive_offt(go, c, ph == PH_RT1);
            ph = hi;
        } else {
            naive_phase(go, c, ph);
            if (ph == PH_RT0 || ph == PH_RT1) naive_offt(go, c, ph == PH_RT1);
            ++ph;
        }
    }
}


#endif
```

```cpp
#define OPT_MASK ((1u<<N_PHASES)-1u)
#define HAVE_THIN 1
#define HAVE_SKINNY 1
#define HAVE_RT 1
#define HAVE_ATT0 1
#define HAVE_RET1 1
#define HAVE_SWA1 1
#define MOE_FP8 1
#define SPREAD_CONV 1
#ifdef HOST_TEST
#include <cmath>
#include <cstring>
#include <cstdio>
#include <cstdint>
#include <cstring>
#include <cstddef>
#define HD inline
#else
#include <hip/hip_runtime.h>
#include <cstdio>
#include <cstdint>
#include <cstring>
#define HD __host__ __device__ __forceinline__
#endif

namespace cfg {
#ifdef HOST_TEST
constexpr int D = 256, NB = 2, S = 256, H_A = 4, NOPE = 16, ROPE = 16, VD = 32, QR = 64, KVR = 64, LW = 128, LBS = 16, H_C = 4, DK = 32, H_D = 8, KVH = 2, HDS = 16, WIN = 64, FF = 32;
#else
constexpr int D = 2048, NB = 4, S = 2048, H_A = 8, NOPE = 128, ROPE = 64, VD = 128, QR = 512, KVR = 512, LW = 1024, LBS = 128, H_C = 4, DK = 256, H_D = 8, KVH = 2, HDS = 128, WIN = 128, FF = 512;
#endif
constexpr int M = NB * S, QK = NOPE + ROPE, E = 64, TOPK = 8, NG = 8, TG = 4;
constexpr int AB_N = QR + KVR + ROPE + 2 * LW, P0_N = QR + KVR + 2 * LW;
constexpr int CD_N = 4 * H_C * DK + H_D * HDS + 2 * KVH * HDS;
constexpr int HALF = D / 2;
constexpr int RT = 256;
constexpr int MAXT = (M * TOPK) / RT + E + M / RT;
constexpr float EPS = 1e-6f, LOG2E = 1.4426950408889634f;
static_assert(H_A * VD == HALF && LW == HALF && H_C * DK == HALF && H_D * HDS == HALF, "half widths");
}
using namespace cfg;

enum { I_X = 0, I_C, I_WMOD, I_BMOD, I_NMIX, I_NFFN, I_FNORM, I_WINAB, I_QLN, I_KVLN, I_WUQ, I_WUKV, I_CONVW, I_CONVB, I_LWA, I_LBA, I_LWX, I_LBX, I_LLAM, I_WOUTAB,
       I_WINCD, I_RETGN, I_SINKS, I_WOUTCD, I_RELB, I_WROUTER, I_RBIAS, I_WGATE, I_WUP, I_WDOWN, I_WSG, I_WSU, I_WSD, N_IN };

typedef unsigned short bf16_t;
HD float bf2f(bf16_t v) { unsigned u = (unsigned)v << 16; float f; __builtin_memcpy(&f, &u, 4); return f; }
HD bf16_t f2bf(float f) { unsigned u; __builtin_memcpy(&u, &f, 4); u += 0x7fffu + ((u >> 16) & 1u); return (bf16_t)(u >> 16); }
HD float sigm(float x) { return 1.0f / (1.0f + expf(-x)); }
HD float siluf(float x) { return x * sigm(x); }
HD float gelu_tanh(float x) { return 0.5f * x * (1.0f + tanhf(0.7978845608028654f * (x + 0.044715f * x * x * x))); }
HD int cnt_idx(int l, int e) { return (l * E + e) * 64; }
HD float ssq8(const float* p) { return ((p[0] + p[1]) + (p[2] + p[3])) + ((p[4] + p[5]) + (p[6] + p[7])); }
HD int t5_bucket(int rel) {
    const int n = rel < 0 ? -rel : rel; const int ret = rel > 0 ? 16 : 0;
    if (n < 8) return ret + n;
    return ret + 8 + (n >= 12) + (n >= 16) + (n >= 23) + (n >= 32) + (n >= 46) + (n >= 64) + (n >= 91);
}

constexpr size_t al(size_t x) { return (x + 4095) & ~size_t(4095); }
constexpr size_t WS_CTL = 0, CTL_BYTES = 1u << 20;
constexpr size_t CTL_CNT = 65536;
constexpr size_t CTL_SSQ = 131072;
constexpr size_t WS_MOD = CTL_BYTES;
constexpr size_t WS_TAB = WS_MOD + al((size_t)2 * NB * 6 * D * 4);
constexpr size_t TAB_CR = 0, TAB_SR = (size_t)S * (ROPE / 2) * 4, TAB_CT = 2 * TAB_SR, TAB_ST = TAB_CT + (size_t)S * (DK / 2) * 4;
constexpr size_t WS_RSTD = WS_TAB + al(TAB_ST + (size_t)S * (DK / 2) * 4);
constexpr size_t WS_SELE = WS_RSTD + al((size_t)M * 4);
constexpr size_t WS_SELR = WS_SELE + al((size_t)M * 8 * 4);
constexpr size_t WS_SELW = WS_SELR + al((size_t)M * 8 * 4);
constexpr size_t WS_TOK = WS_SELW + al((size_t)M * 8 * 4);
constexpr size_t WS_WT = WS_TOK + al((size_t)E * M * 4);
constexpr size_t WS_OFFT = WS_WT + al((size_t)E * M * 4);
constexpr size_t WS_HM = WS_OFFT + 4096;
constexpr size_t WS_HM8 = WS_HM + al((size_t)M * D * 2);
constexpr size_t WS_MIX = WS_HM8 + al((size_t)M * D);
constexpr size_t WS_X1 = WS_MIX + al((size_t)M * D * 2);
constexpr size_t WS_X2 = WS_X1 + al((size_t)M * D * 4);
constexpr size_t WS_PROJ = WS_X2 + al((size_t)M * D * 4);
constexpr size_t WS_L0 = WS_PROJ + al((size_t)M * (P0_N > CD_N ? P0_N : CD_N) * 2);
constexpr size_t WS_Q = WS_L0;
constexpr size_t WS_KC = WS_Q + al((size_t)M * H_A * QK * 2);
constexpr size_t WS_V = WS_KC + al((size_t)M * H_A * QK * 2);
constexpr size_t WS_XC = WS_V + al((size_t)M * H_A * VD * 2);
constexpr size_t WS_LA = WS_XC + al((size_t)M * LW * 2);
constexpr size_t WS_U = WS_LA + al((size_t)2 * M * LW * 2);
constexpr size_t WS_HF = WS_U + al((size_t)2 * M * LW * 2);
constexpr size_t WS_LXP = WS_HF + al((size_t)M * LW * 4);
constexpr size_t WS_RET = WS_L0;
constexpr size_t WS_ACT = WS_LXP + al((size_t)NB * (S + 4) * LW * 2);
constexpr size_t WS_Y = WS_ACT + al((size_t)MAXT * RT * FF * 2);
constexpr size_t WS_T = WS_Y;
constexpr size_t WS_SC = WS_T + al((size_t)M * CD_N * 4);
static_assert(WS_SC + (size_t)8 * S * S * 4 <= WS_Y + (size_t)MAXT * RT * D * 2, "naive temps fit in the Y region");
constexpr size_t WS_W = WS_Y + al((size_t)MAXT * RT * D * 2);
constexpr size_t W_INAB = WS_W;
constexpr size_t W_UQ = W_INAB + al((size_t)AB_N * D * 2);
constexpr size_t W_UKV = W_UQ + al((size_t)H_A * QK * QR * 2);
constexpr size_t W_LRU = W_UKV + al((size_t)H_A * (NOPE + VD) * KVR * 2);
constexpr size_t W_OUTAB = W_LRU + al((size_t)2 * (LW / LBS) * 2 * LBS * 4 * LBS * 2);
constexpr size_t W_INCD = W_OUTAB + al((size_t)D * D * 2);
constexpr size_t W_OUTCD = W_INCD + al((size_t)CD_N * D * 2);
constexpr size_t W_RT = W_OUTCD + al((size_t)D * D * 2);
constexpr size_t W_GU = W_RT + al((size_t)2 * E * D * 2);
constexpr size_t W_DN = W_GU + al((size_t)2 * (E + 1) * 2 * FF * D * 2);
constexpr size_t W_GB = W_DN + al((size_t)2 * (E + 1) * D * FF * 2);
constexpr size_t WS_END = W_GB + al((size_t)6 * LW * 4);

struct Ctx { const float* in[N_IN]; float* out; unsigned char* ws; };
#define WSP(T, off) ((T*)(c.ws + (off)))
HD long lru_idx(int d, int b, int t, int ch) { return ((((long)d * NB + b) * (LW / 8) + ch / 8) * S + t) * 8 + (ch % 8); }
HD int atomic_inc(int* p) {
#ifdef HOST_TEST
    return (*p)++;
#else
#if defined(__HIP_DEVICE_COMPILE__)
    return atomicAdd(p, 1);
#else
    return (*p)++;
#endif
#endif
}

struct NGemm {
    const void* A; const void* B; void* C; const float* ks;
    long a_rs, a_ks, a_z1, a_z2, b_ks, b_ns, b_z1, b_z2, c_rs, c_z1, c_z2;
    long Mr, N, K, Z2, a_bf, b_bf, c_bf;
    HD float la(long i) const { return a_bf ? bf2f(((const bf16_t*)A)[i]) : ((const float*)A)[i]; }
    HD float lb(long i) const { return b_bf ? bf2f(((const bf16_t*)B)[i]) : ((const float*)B)[i]; }
    HD void operator()(long i) const {
        const long n4c = N / 4, m4c = Mr / 4;
        const long n0 = (i % n4c) * 4; const long r = i / n4c; const long m0 = (r % m4c) * 4; const long z = r / m4c; const long z1 = z / Z2, z2 = z % Z2;
        const long ab = z1 * a_z1 + z2 * a_z2, bb = z1 * b_z1 + z2 * b_z2, cb = z1 * c_z1 + z2 * c_z2;
        float acc[4][4];
#pragma unroll
        for (int x = 0; x < 4; ++x)
#pragma unroll
            for (int y = 0; y < 4; ++y) acc[x][y] = 0.f;
        for (long k = 0; k < K; ++k) {
            const float s = ks ? ks[k] : 1.0f;
            float av[4], bv[4];
#pragma unroll
            for (int x = 0; x < 4; ++x) av[x] = la(ab + (m0 + x) * a_rs + k * a_ks) * s;
#pragma unroll
            for (int y = 0; y < 4; ++y) bv[y] = lb(bb + k * b_ks + (n0 + y) * b_ns);
#pragma unroll
            for (int x = 0; x < 4; ++x)
#pragma unroll
                for (int y = 0; y < 4; ++y) acc[x][y] += av[x] * bv[y];
        }
#pragma unroll
        for (int x = 0; x < 4; ++x)
#pragma unroll
            for (int y = 0; y < 4; ++y) { const long ci = cb + (m0 + x) * c_rs + n0 + y; if (c_bf) ((bf16_t*)C)[ci] = f2bf(acc[x][y]); else ((float*)C)[ci] = acc[x][y]; }
    }
    long count(long Z) const { return Z * (Mr / 4) * (N / 4); }
};

struct ModF { Ctx c;
    HD void operator()(long i) const { const long n4c = 6 * D / 4; const long n = (i % n4c) * 4; const long r = i / n4c; const int b = (int)(r % NB), l = (int)(r / NB);
        float a0 = c.in[I_BMOD][l * 6 * D + n], a1 = c.in[I_BMOD][l * 6 * D + n + 1], a2 = c.in[I_BMOD][l * 6 * D + n + 2], a3 = c.in[I_BMOD][l * 6 * D + n + 3];
        const float* w = c.in[I_WMOD] + (size_t)l * D * 6 * D + n;
        for (int k = 0; k < D; ++k) { const float ca = siluf(c.in[I_C][b * D + k]); const float* wr = w + (size_t)k * 6 * D; a0 += ca * wr[0]; a1 += ca * wr[1]; a2 += ca * wr[2]; a3 += ca * wr[3]; }
        float* o = WSP(float, WS_MOD) + ((size_t)l * NB + b) * 6 * D + n; o[0] = a0; o[1] = a1; o[2] = a2; o[3] = a3; }
    long count() const { return (long)2 * NB * 6 * D / 4; } };
struct TabF { Ctx c;
    HD void operator()(long i) const { const int W = ROPE / 2 + DK / 2; const int t = (int)(i / W), j = (int)(i % W);
#if defined(__HIP_DEVICE_COMPILE__)
        { const bool r = j < ROPE / 2; const int jj = r ? j : j - ROPE / 2;
          const float inv = exp2f(-(2.0f * (float)jj / (float)(r ? ROPE : DK)) * 13.287712379549449f), a = (float)t * inv; const float cs = cosf(a), sn = sinf(a);
          if (r) { WSP(float, WS_TAB + TAB_CR)[t * (ROPE / 2) + jj] = cs; WSP(float, WS_TAB + TAB_SR)[t * (ROPE / 2) + jj] = sn; }
          else { WSP(float, WS_TAB + TAB_CT)[t * (DK / 2) + jj] = cs; WSP(float, WS_TAB + TAB_ST)[t * (DK / 2) + jj] = sn; }
          return; }
#endif
        if (j < ROPE / 2) { const double inv = pow(10000.0, -2.0 * j / ROPE), a = t * inv; WSP(float, WS_TAB + TAB_CR)[t * (ROPE / 2) + j] = (float)cos(a); WSP(float, WS_TAB + TAB_SR)[t * (ROPE / 2) + j] = (float)sin(a); }
        else { const int jj = j - ROPE / 2; const double inv = pow(10000.0, -2.0 * jj / DK), a = t * inv; WSP(float, WS_TAB + TAB_CT)[t * (DK / 2) + jj] = (float)cos(a); WSP(float, WS_TAB + TAB_ST)[t * (DK / 2) + jj] = (float)sin(a); } }
    long count() const { return (long)S * (ROPE / 2 + DK / 2); } };
struct RowSSF { Ctx c; const float* X; float* out; long rs, ncols, rows, os;
    HD void operator()(long i) const { const float* x = X + i * rs; float s = 0.f; for (long j = 0; j < ncols; ++j) s += x[j] * x[j]; out[i * os] = s; }
    long count() const { return rows; } };
struct ModulateF { Ctx c; const float* X; const float* gain; const float* sc; const float* sh;
    HD void operator()(long i) const { const long m = i / D, j = i % D; const int b = (int)(m / S); const float r = 1.0f / sqrtf(WSP(float, WS_RSTD)[m] / D + EPS);
        WSP(bf16_t, WS_HM)[i] = f2bf(X[i] * r * gain[j] * (1.0f + sc[(size_t)b * 6 * D + j]) + sh[(size_t)b * 6 * D + j]); }
    long count() const { return (long)M * D; } };
struct FinalF { Ctx c; const float* X;
    HD void operator()(long i) const { const long m = i / D, j = i % D; const float r = 1.0f / sqrtf(WSP(float, WS_RSTD)[m] / D + EPS); c.out[i] = X[i] * r * c.in[I_FNORM][j]; }
    long count() const { return (long)M * D; } };
struct PostG1F { Ctx c;
    HD void operator()(long i) const { const long m = i / AB_N; const int col = (int)(i % AB_N); const float v = WSP(float, WS_T)[i]; bf16_t* P = WSP(bf16_t, WS_PROJ) + m * P0_N;
        if (col < QR + KVR) P[col] = f2bf(v);
        else if (col < QR + KVR + ROPE) {}
        else if (col < QR + KVR + ROPE + LW) { P[col - ROPE] = f2bf(v); const long b = m / S, t = m % S; WSP(bf16_t, WS_LXP)[(b * (S + 4) + 2 + t) * LW + col - (QR + KVR + ROPE)] = f2bf(v); }
        else P[col - ROPE] = f2bf(gelu_tanh(v)); }
    long count() const { return (long)M * AB_N; } };
struct KRopeF { Ctx c;
    HD void operator()(long i) const { const long m = i / (ROPE / 2); const int ii = (int)(i % (ROPE / 2)); const int t = (int)(m % S); const float* T = WSP(float, WS_T) + m * AB_N + QR + KVR;
        const float x1 = T[ii], x2 = T[ROPE / 2 + ii], cs = WSP(float, WS_TAB + TAB_CR)[t * (ROPE / 2) + ii], sn = WSP(float, WS_TAB + TAB_SR)[t * (ROPE / 2) + ii];
        const bf16_t o1 = f2bf(x1 * cs - x2 * sn), o2 = f2bf(x2 * cs + x1 * sn);
        for (int h = 0; h < H_A; ++h) { bf16_t* K = WSP(bf16_t, WS_KC) + (m * H_A + h) * QK + NOPE; K[ii] = o1; K[ROPE / 2 + ii] = o2; } }
    long count() const { return (long)M * (ROPE / 2); } };
struct PostQF { Ctx c; float qs;
    HD void operator()(long i) const { const long m = i / (H_A * QK); const int r = (int)(i % (H_A * QK)), h = r / QK, j = r % QK; const int t = (int)(m % S);
        const float rstd = 1.0f / sqrtf(ssq8(WSP(float, CTL_SSQ) + m * 16) / QR + EPS) * qs; const float* T = WSP(float, WS_T) + m * (H_A * QK) + h * QK; bf16_t* Q = WSP(bf16_t, WS_Q) + (m * H_A + h) * QK;
        if (j < NOPE) Q[j] = f2bf(T[j] * rstd);
        else if (j < NOPE + ROPE / 2) { const int ii = j - NOPE; const float x1 = T[NOPE + ii] * rstd, x2 = T[NOPE + ROPE / 2 + ii] * rstd, cs = WSP(float, WS_TAB + TAB_CR)[t * (ROPE / 2) + ii], sn = WSP(float, WS_TAB + TAB_SR)[t * (ROPE / 2) + ii];
            Q[NOPE + ii] = f2bf(x1 * cs - x2 * sn); Q[NOPE + ROPE / 2 + ii] = f2bf(x2 * cs + x1 * sn); } }
    long count() const { return (long)M * H_A * QK; } };
struct PostKVF { Ctx c;
    HD void operator()(long i) const { const int W = NOPE + VD; const long m = i / (H_A * W); const int r = (int)(i % (H_A * W)), h = r / W, j = r % W;
        const float rstd = 1.0f / sqrtf(ssq8(WSP(float, CTL_SSQ) + m * 16 + 8) / KVR + EPS); const float v = WSP(float, WS_T)[i] * rstd;
        if (j < NOPE) WSP(bf16_t, WS_KC)[(m * H_A + h) * QK + j] = f2bf(v); else WSP(bf16_t, WS_V)[(m * H_A + h) * VD + j - NOPE] = f2bf(v); }
    long count() const { return (long)M * H_A * (NOPE + VD); } };
struct ConvF { Ctx c;
    HD void operator()(long i) const { const long m = i / LW; const int ch = (int)(i % LW); const int t = (int)(m % S); float a = c.in[I_CONVB][ch];
        for (int j = 0; j < 4; ++j) { const int tt = t + j - 2; if (tt >= 0 && tt < S) a += c.in[I_CONVW][j * LW + ch] * bf2f(WSP(bf16_t, WS_PROJ)[(m + j - 2) * P0_N + QR + KVR + ch]); }
        WSP(bf16_t, WS_XC)[i] = f2bf(a); }
    long count() const { return (long)M * LW; } };
struct GatesF { Ctx c;
    HD void operator()(long i) const { const int ch = (int)(i % LW); const long r = i / LW; const long m = r % M; const int d = (int)(r / M); const int g = ch / LBS, j = ch % LBS; const int b = (int)(m / S), t = (int)(m % S);
        const bf16_t* xr = WSP(bf16_t, WS_XC) + m * LW + g * LBS; const float* wa = c.in[I_LWA] + ((size_t)(d * (LW / LBS) + g) * LBS) * LBS + j; const float* wx = c.in[I_LWX] + ((size_t)(d * (LW / LBS) + g) * LBS) * LBS + j;
        float za = c.in[I_LBA][d * LW + ch], zx = c.in[I_LBX][d * LW + ch];
        for (int k = 0; k < LBS; ++k) { const float x = bf2f(xr[k]); za += x * wa[(size_t)k * LBS]; zx += x * wx[(size_t)k * LBS]; }
        const float lam = c.in[I_LLAM][d * LW + ch]; const float sp = log1pf(expf(-lam));
        const float la = -8.0f * sigm(za) * sp; const float u = sqrtf(-expm1f(2.0f * la)) * (sigm(zx) * bf2f(WSP(bf16_t, WS_XC)[m * LW + ch]));
        const long o = lru_idx(d, b, t, ch); WSP(bf16_t, WS_LA)[o] = f2bf(la); WSP(bf16_t, WS_U)[o] = f2bf(u); }
    long count() const { return (long)2 * M * LW; } };
struct ScanF { Ctx c;
    HD void operator()(long i) const { const int b = (int)(i / LW), ch = (int)(i % LW); float h = 0.f;
        for (int t = 0; t < S; ++t) { const long o = lru_idx(0, b, t, ch); h = expf(bf2f(WSP(bf16_t, WS_LA)[o])) * h + bf2f(WSP(bf16_t, WS_U)[o]); WSP(float, WS_HF)[((long)b * S + t) * LW + ch] = h; }
        h = 0.f;
        for (int t = S - 1; t >= 0; --t) { const long o = lru_idx(1, b, t, ch); h = expf(bf2f(WSP(bf16_t, WS_LA)[o])) * h + bf2f(WSP(bf16_t, WS_U)[o]); const long m = (long)b * S + t;
            WSP(bf16_t, WS_MIX)[m * D + HALF + ch] = f2bf((WSP(float, WS_HF)[m * LW + ch] + h) * bf2f(WSP(bf16_t, WS_PROJ)[m * P0_N + QR + KVR + LW + ch])); } }
    long count() const { return (long)NB * LW; } };
struct SoftmaxF { Ctx c; long rows;
    HD void operator()(long i) const { float* r = WSP(float, WS_SC) + i * S; float mx = -INFINITY; for (int k = 0; k < S; ++k) mx = fmaxf(mx, r[k]); float s = 0.f; for (int k = 0; k < S; ++k) { const float p = exp2f(r[k] - mx); r[k] = p; s += p; }
        const float inv = 1.0f / s; for (int k = 0; k < S; ++k) r[k] *= inv; }
    long count() const { return rows; } };
struct OutPostF { Ctx c; const float* Xin; float* Xout; long l;
    HD void operator()(long i) const { const long m = i / D, n = i % D; const int b = (int)(m / S); Xout[i] = Xin[i] + WSP(float, WS_MOD)[((size_t)l * NB + b) * 6 * D + 2 * D + n] * WSP(float, WS_T)[i]; }
    long count() const { return (long)M * D; } };
struct RouteF { Ctx c; long l;
    HD float bz(const float* lg, const float* bias, int e) const { return sigm(lg[e]) + bias[e]; }
    HD void operator()(long m) const { const float* lg = WSP(float, WS_T) + m * E; const float* bias = c.in[I_RBIAS] + l * E;
        unsigned gmask = 0u;
        for (int it = 0; it < TG; ++it) { float best = -INFINITY; int bi = 0;
            for (int g = 0; g < NG; ++g) if (!((gmask >> g) & 1u)) { float m1 = -INFINITY, m2 = -INFINITY; for (int j = 0; j < E / NG; ++j) { const float v = bz(lg, bias, g * (E / NG) + j); if (v > m1) { m2 = m1; m1 = v; } else if (v > m2) m2 = v; }
                const float sc = m1 + m2; if (sc > best) { best = sc; bi = g; } }
            gmask |= 1u << bi; }
        unsigned long long taken = 0ull; float wsum = 0.f; int* se = WSP(int, WS_SELE) + m * TOPK; float* sw = WSP(float, WS_SELW) + m * TOPK; int* sr = WSP(int, WS_SELR) + m * TOPK;
        for (int k = 0; k < TOPK; ++k) { float best = -INFINITY; int bi = 0;
            for (int e = 0; e < E; ++e) if (((gmask >> (e / (E / NG))) & 1u) && !((taken >> e) & 1ull)) { const float v = bz(lg, bias, e); if (v > best) { best = v; bi = e; } }
            taken |= 1ull << bi; const float s = sigm(lg[bi]); se[k] = bi; sw[k] = s; wsum += s; }
        int* cnt = WSP(int, CTL_CNT);
        for (int k = 0; k < TOPK; ++k) { const int e = se[k]; const float w = sw[k] / wsum * 2.5f; const int rank = atomic_inc(cnt + cnt_idx((int)l, e)); sr[k] = rank; sw[k] = w;
            WSP(int, WS_TOK)[(size_t)e * M + rank] = (int)m; WSP(float, WS_WT)[(size_t)e * M + rank] = w; } }
    long count() const { return M; } };
struct OffF { Ctx c; long l;
    HD void operator()(long) const { int* o = WSP(int, WS_OFFT); const int* cnt = WSP(int, CTL_CNT); o[0] = 0; for (int e = 0; e <= E; ++e) { const int n = e < E ? cnt[cnt_idx((int)l, e)] : M; o[e + 1] = o[e] + (n + RT - 1) / RT; } }
    long count() const { return 1; } };
struct Moe1F { Ctx c; long l;
    HD void operator()(long i) const { const long f4c = FF / 4; const int f = (int)(i % f4c) * 4; const long r = i / f4c; const int rank = (int)(r % M), e = (int)(r / M);
        const int n = e < E ? WSP(int, CTL_CNT)[cnt_idx((int)l, e)] : M; if (rank >= n) return;
        const int tok = e < E ? WSP(int, WS_TOK)[(size_t)e * M + rank] : rank; const long row = (long)WSP(int, WS_OFFT)[e] * RT + rank;
        const float* wg = (e < E ? c.in[I_WGATE] + ((size_t)l * E + e) * D * FF : c.in[I_WSG] + (size_t)l * D * FF) + f;
        const float* wu = (e < E ? c.in[I_WUP] + ((size_t)l * E + e) * D * FF : c.in[I_WSU] + (size_t)l * D * FF) + f;
        const bf16_t* h = WSP(bf16_t, WS_HM) + (size_t)tok * D; float g0 = 0, g1 = 0, g2 = 0, g3 = 0, u0 = 0, u1 = 0, u2 = 0, u3 = 0;
        for (int k = 0; k < D; ++k) { const float a = bf2f(h[k]); const float* pg = wg + (size_t)k * FF; const float* pu = wu + (size_t)k * FF;
            g0 += a * pg[0]; g1 += a * pg[1]; g2 += a * pg[2]; g3 += a * pg[3]; u0 += a * pu[0]; u1 += a * pu[1]; u2 += a * pu[2]; u3 += a * pu[3]; }
        bf16_t* o = WSP(bf16_t, WS_ACT) + row * FF + f; o[0] = f2bf(siluf(g0) * u0); o[1] = f2bf(siluf(g1) * u1); o[2] = f2bf(siluf(g2) * u2); o[3] = f2bf(siluf(g3) * u3); }
    long count() const { return (long)(E + 1) * M * (FF / 4); } };
struct Moe2F { Ctx c; long l;
    HD void operator()(long i) const { const long d4c = D / 4; const int d = (int)(i % d4c) * 4; const long r = i / d4c; const int rank = (int)(r % M), e = (int)(r / M);
        const int n = e < E ? WSP(int, CTL_CNT)[cnt_idx((int)l, e)] : M; if (rank >= n) return;
        const long row = (long)WSP(int, WS_OFFT)[e] * RT + rank; const float wt = e < E ? WSP(float, WS_WT)[(size_t)e * M + rank] : 1.0f;
        const float* wd = (e < E ? c.in[I_WDOWN] + ((size_t)l * E + e) * FF * D : c.in[I_WSD] + (size_t)l * FF * D) + d;
        const bf16_t* a = WSP(bf16_t, WS_ACT) + row * FF; float y0 = 0, y1 = 0, y2 = 0, y3 = 0;
        for (int f = 0; f < FF; ++f) { const float v = bf2f(a[f]); const float* p = wd + (size_t)f * D; y0 += v * p[0]; y1 += v * p[1]; y2 += v * p[2]; y3 += v * p[3]; }
        bf16_t* o = WSP(bf16_t, WS_Y) + row * D + d; o[0] = f2bf(wt * y0); o[1] = f2bf(wt * y1); o[2] = f2bf(wt * y2); o[3] = f2bf(wt * y3); }
    long count() const { return (long)(E + 1) * M * (D / 4); } };
struct CombineF { Ctx c; const float* Xin; float* Xout; long l;
    HD void operator()(long i) const { const long m = i / D, n = i % D; const int b = (int)(m / S); const int* offt = WSP(int, WS_OFFT); const bf16_t* Y = WSP(bf16_t, WS_Y); float v = 0.f;
        for (int k = 0; k < TOPK; ++k) { const int e = WSP(int, WS_SELE)[m * TOPK + k], r = WSP(int, WS_SELR)[m * TOPK + k]; v += bf2f(Y[((size_t)offt[e] * RT + r) * D + n]); }
        v += bf2f(Y[((size_t)offt[E] * RT + m) * D + n]);
        Xout[i] = Xin[i] + WSP(float, WS_MOD)[((size_t)l * NB + b) * 6 * D + 5 * D + n] * v; }
    long count() const { return (long)M * D; } };
struct PostG3F { Ctx c; float sqs;
    HD void operator()(long i) const { const long m = i / CD_N; const int col = (int)(i % CD_N); const int t = (int)(m % S); const float* T = WSP(float, WS_T) + m * CD_N; bf16_t* P = WSP(bf16_t, WS_PROJ) + m * CD_N; const int W = H_C * DK;
        if (col < 2 * W) { const int j = col % DK; if (j < DK / 2) { const float sc = col < W ? 1.0f : 1.0f / sqrtf((float)DK); const float x1 = T[col], x2 = T[col + DK / 2], cs = WSP(float, WS_TAB + TAB_CT)[t * (DK / 2) + j], sn = WSP(float, WS_TAB + TAB_ST)[t * (DK / 2) + j];
                P[col] = f2bf((x1 * cs - x2 * sn) * sc); P[col + DK / 2] = f2bf((x2 * cs + x1 * sn) * sc); } }
        else if (col < 3 * W) P[col] = f2bf(T[col]);
        else if (col < 4 * W) P[col] = f2bf(siluf(T[col]));
        else if (col < 4 * W + H_D * HDS) P[col] = f2bf(T[col] * sqs);
        else P[col] = f2bf(T[col]); }
    long count() const { return (long)M * CD_N; } };
struct DecayF { Ctx c;
    HD void operator()(long i) const { const int mm = (int)(i % S); const long r = i / S; const int n = (int)(r % S), h = (int)(r / S);
        const float lgf = log1pf(-exp2f(-5.0f - h)), lgb = log1pf(-exp2f(-5.0f - (H_C - 1 - h)));
        WSP(float, WS_SC)[i] *= (n >= mm) ? expf(lgf * (n - mm)) : expf(lgb * (mm - n)); }
    long count() const { return (long)H_C * S * S; } };
struct RetNormF { Ctx c;
    HD void operator()(long i) const { const long m = i / H_C; const int h = (int)(i % H_C); const float* r = WSP(float, WS_RET) + m * HALF + h * DK; float s = 0.f; for (int j = 0; j < DK; ++j) s += r[j] * r[j];
        const float rs = 1.0f / sqrtf(s / DK + EPS); for (int j = 0; j < DK; ++j) WSP(bf16_t, WS_MIX)[m * D + h * DK + j] = f2bf(bf2f(WSP(bf16_t, WS_PROJ)[m * CD_N + 3 * H_C * DK + h * DK + j]) * (r[j] * rs * c.in[I_RETGN][h * DK + j])); }
    long count() const { return (long)M * H_C; } };
struct SwaSoftF { Ctx c;
    HD void operator()(long i) const { const int q = (int)(i % S), hd = (int)(i / S); float* r = WSP(float, WS_SC) + i * S; const float sink = c.in[I_SINKS][hd] * LOG2E; const float* rb = c.in[I_RELB];
        const int lo = q - WIN < 0 ? 0 : q - WIN, hi = q + WIN > S - 1 ? S - 1 : q + WIN; float mx = sink;
        for (int k = lo; k <= hi; ++k) { const float s = r[k] + rb[t5_bucket(k - q) * H_D + hd] * LOG2E; r[k] = s; mx = fmaxf(mx, s); }
        float den = exp2f(sink - mx); for (int k = lo; k <= hi; ++k) { const float p = exp2f(r[k] - mx); r[k] = p; den += p; }
        const float inv = 1.0f / den; for (int k = 0; k < S; ++k) r[k] = (k >= lo && k <= hi) ? r[k] * inv : 0.f; }
    long count() const { return (long)H_D * S; } };

#ifdef HOST_TEST
struct Launcher { template <class F> void operator()(const F& f, long n) const { for (long i = 0; i < n; ++i) f(i); } };
#else
template <class F> __global__ void __launch_bounds__(256) run_k(F f, long n) { for (long i = (long)blockIdx.x * 256 + threadIdx.x; i < n; i += (long)gridDim.x * 256) f(i); }
struct Launcher { hipStream_t st; template <class F> void operator()(const F& f, long n) const { long g = (n + 255) / 256; if (g > (1 << 20)) g = 1 << 20; if (g < 1) g = 1; hipLaunchKernelGGL(run_k<F>, dim3((unsigned)g), dim3(256), 0, st, f, n); } };
#endif

template <class F> static F zf() { F f; memset((void*)&f, 0, sizeof(F)); return f; }
static NGemm mk_gemm(const void* A, int a_bf, long a_rs, const void* B, int b_bf, long b_ks, long b_ns, void* C, int c_bf, long c_rs, long Mr, long N, long K) {
    NGemm g; memset((void*)&g, 0, sizeof(g)); g.A = A; g.B = B; g.C = C; g.a_bf = a_bf; g.b_bf = b_bf; g.c_bf = c_bf; g.a_rs = a_rs; g.a_ks = 1; g.b_ks = b_ks; g.b_ns = b_ns; g.c_rs = c_rs; g.Mr = Mr; g.N = N; g.K = K; g.Z2 = 1; return g; }

template <class L> static void rowss(const L& go, const Ctx& c, const float* X, float* out, long rs, long ncols, long os = 1) { RowSSF f = zf<RowSSF>(); f.c = c; f.X = X; f.out = out; f.rs = rs; f.ncols = ncols; f.rows = M; f.os = os; go(f, f.count()); }

enum { PH_P0 = 0, PH_MOD0, PH_G1, PH_G2, PH_SCAN0, PH_ATT0, PH_OUT0, PH_RT0, PH_M1_0, PH_M2_0, PH_CMB0, PH_G3, PH_RET1, PH_SWA1, PH_RN1, PH_OUT1, PH_RT1, PH_M1_1, PH_M2_1, PH_CMB1, N_PHASES };

template <class L> static void naive_phase(const L& go, const Ctx& c, int ph) {
    float* mod = WSP(float, WS_MOD);
    const int l = ph >= PH_G3 ? 1 : 0;
    float* X1 = WSP(float, WS_X1); float* X2 = WSP(float, WS_X2);
    switch (ph) {
    case PH_P0: { { ModF f = zf<ModF>(); f.c = c; go(f, f.count()); } { TabF f = zf<TabF>(); f.c = c; go(f, f.count()); } } break;
    case PH_MOD0: { rowss(go, c, c.in[I_X], WSP(float, WS_RSTD), D, D);
        ModulateF f = zf<ModulateF>(); f.c = c; f.X = c.in[I_X]; f.gain = c.in[I_NMIX]; f.sc = mod + D; f.sh = mod; go(f, f.count()); } break;
    case PH_G1: { { NGemm g = mk_gemm(WSP(bf16_t, WS_HM), 1, D, c.in[I_WINAB], 0, AB_N, 1, WSP(float, WS_T), 0, AB_N, M, AB_N, D); go(g, g.count(1)); }
        { PostG1F f = zf<PostG1F>(); f.c = c; go(f, f.count()); }
        rowss(go, c, WSP(float, WS_T), WSP(float, CTL_SSQ), AB_N, QR, 16);
        rowss(go, c, WSP(float, WS_T) + QR, WSP(float, CTL_SSQ) + 8, AB_N, KVR, 16);
        { KRopeF f = zf<KRopeF>(); f.c = c; go(f, f.count()); } } break;
    case PH_G2: { { NGemm g = mk_gemm(WSP(bf16_t, WS_PROJ), 1, P0_N, c.in[I_WUQ], 0, H_A * QK, 1, WSP(float, WS_T), 0, H_A * QK, M, H_A * QK, QR); g.ks = c.in[I_QLN]; go(g, g.count(1)); }
        { PostQF f = zf<PostQF>(); f.c = c; f.qs = LOG2E / sqrtf((float)QK); go(f, f.count()); }
        { NGemm g = mk_gemm(WSP(bf16_t, WS_PROJ) + QR, 1, P0_N, c.in[I_WUKV], 0, H_A * (NOPE + VD), 1, WSP(float, WS_T), 0, H_A * (NOPE + VD), M, H_A * (NOPE + VD), KVR); g.ks = c.in[I_KVLN]; go(g, g.count(1)); }
        { PostKVF f = zf<PostKVF>(); f.c = c; go(f, f.count()); }
        { ConvF f = zf<ConvF>(); f.c = c; go(f, f.count()); }
        { GatesF f = zf<GatesF>(); f.c = c; go(f, f.count()); } } break;
    case PH_SCAN0: { ScanF f = zf<ScanF>(); f.c = c; go(f, f.count()); } break;
    case PH_ATT0: {
        for (int b = 0; b < NB; ++b) {
            NGemm g = mk_gemm(WSP(bf16_t, WS_Q) + (size_t)b * S * H_A * QK, 1, H_A * QK, WSP(bf16_t, WS_KC) + (size_t)b * S * H_A * QK, 1, 1, H_A * QK, WSP(float, WS_SC), 0, S, S, S, QK);
            g.a_z2 = QK; g.b_z2 = QK; g.c_z2 = (long)S * S; g.Z2 = H_A; go(g, g.count(H_A));
            { SoftmaxF f = zf<SoftmaxF>(); f.c = c; f.rows = (long)H_A * S; go(f, f.count()); }
            NGemm p = mk_gemm(WSP(float, WS_SC), 0, S, WSP(bf16_t, WS_V) + (size_t)b * S * H_A * VD, 1, H_A * VD, 1, WSP(bf16_t, WS_MIX) + (size_t)b * S * D, 1, D, S, VD, S);
            p.a_z2 = (long)S * S; p.b_z2 = VD; p.c_z2 = VD; p.Z2 = H_A; go(p, p.count(H_A)); } } break;
    case PH_OUT0: case PH_OUT1: { NGemm g = mk_gemm(WSP(bf16_t, WS_MIX), 1, D, c.in[l ? I_WOUTCD : I_WOUTAB], 0, D, 1, WSP(float, WS_T), 0, D, M, D, D); go(g, g.count(1));
        OutPostF f = zf<OutPostF>(); f.c = c; f.Xin = l ? X2 : c.in[I_X]; f.Xout = X1; f.l = l; go(f, f.count()); } break;
    case PH_RT0: case PH_RT1: { float* modl = mod + (size_t)l * NB * 6 * D;
        rowss(go, c, X1, WSP(float, WS_RSTD), D, D);
        { ModulateF f = zf<ModulateF>(); f.c = c; f.X = X1; f.gain = c.in[I_NFFN] + l * D; f.sc = modl + 4 * D; f.sh = modl + 3 * D; go(f, f.count()); }
        { NGemm g = mk_gemm(WSP(bf16_t, WS_HM), 1, D, c.in[I_WROUTER] + (size_t)l * D * E, 0, E, 1, WSP(float, WS_T), 0, E, M, E, D); go(g, g.count(1)); }
        { RouteF f = zf<RouteF>(); f.c = c; f.l = l; go(f, f.count()); } } break;
    case PH_M1_0: case PH_M1_1: { Moe1F f = zf<Moe1F>(); f.c = c; f.l = l; go(f, f.count()); } break;
    case PH_M2_0: case PH_M2_1: { Moe2F f = zf<Moe2F>(); f.c = c; f.l = l; go(f, f.count()); } break;
    case PH_CMB0: { { CombineF f = zf<CombineF>(); f.c = c; f.Xin = X1; f.Xout = X2; f.l = 0; go(f, f.count()); }
        rowss(go, c, X2, WSP(float, WS_RSTD), D, D);
        ModulateF f = zf<ModulateF>(); f.c = c; f.X = X2; f.gain = c.in[I_NMIX] + D; f.sc = mod + (size_t)NB * 6 * D + D; f.sh = mod + (size_t)NB * 6 * D; go(f, f.count()); } break;
    case PH_CMB1: { { CombineF f = zf<CombineF>(); f.c = c; f.Xin = X1; f.Xout = X2; f.l = 1; go(f, f.count()); }
        rowss(go, c, X2, WSP(float, WS_RSTD), D, D);
        FinalF f = zf<FinalF>(); f.c = c; f.X = X2; go(f, f.count()); } break;
    case PH_G3: { { NGemm g = mk_gemm(WSP(bf16_t, WS_HM), 1, D, c.in[I_WINCD], 0, CD_N, 1, WSP(float, WS_T), 0, CD_N, M, CD_N, D); go(g, g.count(1)); }
        PostG3F f = zf<PostG3F>(); f.c = c; f.sqs = LOG2E / sqrtf((float)HDS); go(f, f.count()); } break;
    case PH_RET1: {
        for (int b = 0; b < NB; ++b) {
            const bf16_t* Pb = WSP(bf16_t, WS_PROJ) + (size_t)b * S * CD_N;
            NGemm g = mk_gemm(Pb, 1, CD_N, Pb + H_C * DK, 1, 1, CD_N, WSP(float, WS_SC), 0, S, S, S, DK);
            g.a_z2 = DK; g.b_z2 = DK; g.c_z2 = (long)S * S; g.Z2 = H_C; go(g, g.count(H_C));
            { DecayF f = zf<DecayF>(); f.c = c; go(f, f.count()); }
            NGemm p = mk_gemm(WSP(float, WS_SC), 0, S, Pb + 2 * H_C * DK, 1, CD_N, 1, WSP(float, WS_RET) + (size_t)b * S * HALF, 0, HALF, S, DK, S);
            p.a_z2 = (long)S * S; p.b_z2 = DK; p.c_z2 = DK; p.Z2 = H_C; go(p, p.count(H_C)); } } break;
    case PH_SWA1: {
        for (int b = 0; b < NB; ++b) {
            const bf16_t* Pb = WSP(bf16_t, WS_PROJ) + (size_t)b * S * CD_N + 4 * H_C * DK; const int G = H_D / KVH;
            NGemm g = mk_gemm(Pb, 1, CD_N, Pb + H_D * HDS, 1, 1, CD_N, WSP(float, WS_SC), 0, S, S, S, HDS);
            g.a_z1 = (long)G * HDS; g.a_z2 = HDS; g.b_z1 = HDS; g.b_z2 = 0; g.c_z1 = (long)G * S * S; g.c_z2 = (long)S * S; g.Z2 = G; go(g, g.count(H_D));
            { SwaSoftF f = zf<SwaSoftF>(); f.c = c; go(f, f.count()); }
            NGemm p = mk_gemm(WSP(float, WS_SC), 0, S, Pb + H_D * HDS + KVH * HDS, 1, CD_N, 1, WSP(bf16_t, WS_MIX) + (size_t)b * S * D + HALF, 1, D, S, HDS, S);
            p.a_z1 = (long)G * S * S; p.a_z2 = (long)S * S; p.b_z1 = HDS; p.b_z2 = 0; p.c_z1 = (long)G * HDS; p.c_z2 = HDS; p.Z2 = G; go(p, p.count(H_D)); } } break;
    case PH_RN1: { RetNormF f = zf<RetNormF>(); f.c = c; go(f, f.count()); } break;
    default: break;
    }
}
template <class L> static void naive_offt(const L& go, const Ctx& c, int l) { OffF f = zf<OffF>(); f.c = c; f.l = l; go(f, f.count()); }

#ifdef HOST_TEST
template <class L> static void run_all(const L& go, const Ctx& c) {
    for (int ph = 0; ph < N_PHASES; ++ph) { naive_phase(go, c, ph); if (ph == PH_RT0 || ph == PH_RT1) naive_offt(go, c, ph == PH_RT1); }
}
#endif
#ifndef HOST_TEST
#define LAS __attribute__((address_space(3)))
#define GAS __attribute__((address_space(1)))
typedef unsigned v4u __attribute__((ext_vector_type(4)));
typedef unsigned u32x2 __attribute__((ext_vector_type(2)));
typedef float f32x4 __attribute__((ext_vector_type(4)));
typedef float f32x16 __attribute__((ext_vector_type(16)));
typedef short bf16x8 __attribute__((ext_vector_type(8)));
typedef short s16x4 __attribute__((ext_vector_type(4)));
typedef int v8i_t __attribute__((ext_vector_type(8)));
typedef int v4i_t __attribute__((ext_vector_type(4)));
typedef GAS unsigned gu32;
#define RLX_AGENT __ATOMIC_RELAXED, __HIP_MEMORY_SCOPE_AGENT
#define LDS_WAIT() asm volatile("s_waitcnt lgkmcnt(0)" ::: "memory")
#define VM_WAIT() asm volatile("s_waitcnt vmcnt(0)" ::: "memory")
constexpr int NWAVES = 8, NTHR = 512;
constexpr int LDS_BYTES = 147456, MISC_OFF = LDS_BYTES - 2048, TAB_OFF = MISC_OFF + 1024;
__device__ __forceinline__ int lane_id() { int l; asm volatile("v_mbcnt_lo_u32_b32 %0, -1, 0\n\tv_mbcnt_hi_u32_b32 %0, -1, %0" : "=v"(l)); return l; }
__device__ __forceinline__ unsigned cvt_pk_bf16(float lo, float hi) { unsigned r; asm volatile("v_cvt_pk_bf16_f32 %0, %1, %2" : "=v"(r) : "v"(lo), "v"(hi)); return r; }
__device__ __forceinline__ float fast_sigm(float x) { return __builtin_amdgcn_rcpf(1.0f + __builtin_amdgcn_exp2f(-1.4426950408889634f * x)); }
__device__ __forceinline__ float fast_silu(float x) { return x * fast_sigm(x); }
__device__ __forceinline__ float fast_gelu_tanh(float x) { const float z = 0.7978845608028654f * (x + 0.044715f * x * x * x); return x * fast_sigm(2.0f * z); }
__device__ __forceinline__ float wave_sum(float v) {
#pragma unroll
    for (int o = 1; o < 64; o <<= 1) v += __shfl_xor(v, o);
    return v; }

#define XB_TMO      128
#define XB_XCNT(j)  (256  + 64 * (j))
#define XB_XSUB(j)  (1280 + 64 * (j))
#define XB_XGEN(j)  (2304 + 64 * (j))
#define XB_TOP      3328
#define XB_TOPGEN   3392
#define XCD_BAR_WORDS 3456
#define XB_SPIN_CAP (1u << 20)
__device__ __forceinline__ unsigned xb_ld(unsigned* p)              { return __hip_atomic_load(p, __ATOMIC_RELAXED, __HIP_MEMORY_SCOPE_AGENT); }
__device__ __forceinline__ unsigned xb_add(unsigned* p, unsigned v) { return __hip_atomic_fetch_add(p, v, __ATOMIC_RELAXED, __HIP_MEMORY_SCOPE_AGENT); }
__device__ __forceinline__ unsigned xb_xcc_id() { return (unsigned)__builtin_amdgcn_s_getreg((3 << 11) | 20) & 0xFu; }
#define XB_SPIN(cond, bar) do { unsigned _sp = 0; while (cond) { __builtin_amdgcn_s_sleep(1); \
    if ((++_sp & 255u) == 0u) { if (xb_ld(&(bar)[XB_TMO])) break; if (_sp > XB_SPIN_CAP) { atomicAdd(&(bar)[XB_TMO], 1u); break; } } } } while (0)
struct XcdBarrier { unsigned* bar; unsigned x; volatile LAS unsigned* st; int wave; };
__device__ __forceinline__ XcdBarrier xcd_barrier_post(unsigned* bar, volatile LAS unsigned* st, int wave) {
    XcdBarrier b; b.bar = bar; b.x = xb_xcc_id(); b.st = st; b.wave = wave;
    if (wave == 0 && lane_id() == 0) (void)xb_add(&bar[XB_XCNT(b.x)], 1u);
    return b; }
__device__ __forceinline__ void xcd_barrier_complete(unsigned* bar, unsigned x, unsigned& nloc, unsigned& nx) {
    const unsigned G = gridDim.x * gridDim.y * gridDim.z;
    unsigned sum, cnt, mine, sp = 0u;
    for (;;) {
        sum = 0u; cnt = 0u; mine = 0u;
#pragma unroll
        for (unsigned j = 0; j < 16; ++j) { const unsigned c = xb_ld(&bar[XB_XCNT(j)]); sum += c; cnt += (c > 0u) ? 1u : 0u; mine = (j == x) ? c : mine; }
        if (sum == G) break;
        __builtin_amdgcn_s_sleep(1);
        if ((++sp & 255u) == 0u) { if (xb_ld(&bar[XB_TMO])) break; if (sp > XB_SPIN_CAP) { atomicAdd(&bar[XB_TMO], 1u); break; } }
    }
    nloc = mine > 0u ? mine : 1u; nx = cnt > 0u ? cnt : 1u; }
__device__ __forceinline__ void xcd_barrier(const XcdBarrier& b) {
    asm volatile("s_waitcnt vmcnt(0)" ::: "memory");
    __syncthreads();
    if (b.wave == 0 && lane_id() == 0) {
        unsigned* bar = b.bar;
        __builtin_amdgcn_s_waitcnt(0);
        unsigned nloc = b.st[0], nx = b.st[1];
        if (nloc == 0u) { xcd_barrier_complete(bar, b.x, nloc, nx); b.st[0] = nloc; b.st[1] = nx; }
        const unsigned old = xb_add(&bar[XB_XSUB(b.x)], 1u);
        const unsigned gen = old / nloc;
        if (old + 1u == (gen + 1u) * nloc) {
            __builtin_amdgcn_fence(__ATOMIC_RELEASE, "agent");
            asm volatile("s_waitcnt vmcnt(0)" ::: "memory");
            const unsigned og = xb_add(&bar[XB_TOP], 1u);
            const unsigned tg = og / nx;
            if (og + 1u == (tg + 1u) * nx) xb_add(&bar[XB_TOPGEN], 1u);
            else XB_SPIN(xb_ld(&bar[XB_TOPGEN]) == tg, bar);
            __builtin_amdgcn_fence(__ATOMIC_ACQUIRE, "agent");
            xb_add(&bar[XB_XGEN(b.x)], 1u);
            asm volatile("s_waitcnt vmcnt(0)" ::: "memory");
        } else {
            XB_SPIN(xb_ld(&bar[XB_XGEN(b.x)]) == gen, bar);
            __builtin_amdgcn_fence(__ATOMIC_ACQUIRE, "agent");
            asm volatile("s_waitcnt vmcnt(0)" ::: "memory");
        }
    }
    __syncthreads();
}

namespace pg8 {
constexpr int BM = 256, BK = 64, HALFT = 128, HTB = HALFT * BK * 2, STAGE_BYTES = 8 * HTB, NXCD = 8, WGM = 8;
__host__ __device__ __forceinline__ int lds_byte(int r, int c) { const int st = (r >> 4) * 2 + (c >> 5), rr = r & 15, cc = c & 31, ob = rr * 64 + cc * 2; return st * 1024 + (ob ^ (((ob >> 9) & 1) << 5)); }
__host__ __device__ __forceinline__ void stage_rc(int b, int& R, int& C) { const int st = b / 1024, sb = b % 1024, swz = sb ^ (((sb >> 9) & 1) << 5); R = (st >> 1) * 16 + swz / 64; C = (st & 1) * 32 + (swz % 64) / 2; }
__host__ __device__ __forceinline__ int perm32(int rho) { const int n = rho >> 4, i = rho & 15; return 8 * (i >> 2) + 4 * n + (i & 3); }
struct Unit { const char* A; const char* B; int pm, pn, e, r0; };
__device__ __forceinline__ void tile_of(int L, int nM, int nN, int& pm, int& pn) {
    const int nwg = nM * nN; int wgid = L; { const int q = nwg / NXCD, r = nwg % NXCD, xcd = wgid % NXCD, off = wgid / NXCD; wgid = (xcd < r ? xcd * (q + 1) : r * (q + 1) + (xcd - r) * q) + off; }
    const int nig = WGM * nN, gid = wgid / nig, fm = gid * WGM, gsz = (nM - fm) < WGM ? (nM - fm) : WGM;
    pm = fm + ((wgid % nig) % gsz); pn = (wgid % nig) / gsz; }
template <class E_, class = void> struct perm16_t { static constexpr bool value = false; };
template <class E_> struct perm16_t<E_, decltype((void)E_::PERM16)> { static constexpr bool value = E_::PERM16; };
template <class E_> constexpr bool perm16_v = perm16_t<E_>::value;
struct APlain { static __device__ __forceinline__ const char* kt(const char* base, int t, int) { return base + (size_t)t * (BK * 2); } };
struct AConv { static __device__ __forceinline__ const char* kt(const char* base, int t, int lda) { return base + (long)((t >> 1) - 2) * (lda * 2) + (t & 1) * (BK * 2); } };

template <class Epi, class Sched, class AP, bool GATHER, bool ALIGN_EPI, int EB = 2>
__device__ __forceinline__ void gemm_phase(LAS unsigned char* lds, const int wave, const char* base, const int lda, const int ldb, const int K, const Sched& S, const Epi& E) {
    const __amdgpu_buffer_rsrc_t rsrc = __builtin_amdgcn_make_buffer_rsrc((void*)base, (short)0, -1, 0x00020000);
    const int wid = __builtin_amdgcn_readfirstlane(wave), lane = lane_id(), tid = wid * 64 + lane, wr = wid >> 2, wc = wid & 3, fr = lane & 15, fq = lane >> 4;
    const int nt = K / BK;
    unsigned vA[2][2], vAn[2][2], vB[2], vB1[2];
#pragma unroll
    for (int i = 0; i < 2; ++i) { int R, C; stage_rc(tid * 16 + i * 8192, R, C); const int Rb = Epi::PERM ? ((R & ~31) + perm32(R & 31)) : R;
        if constexpr (perm16_v<Epi>) { const int wcR = R >> 5, rho = R & 31, n_ = rho >> 4, i_ = rho & 15; const int src0 = 64 * wcR + 16 * (i_ >> 2) + 4 * n_ + (i_ & 3);
            vB[i] = (unsigned)(src0 * ldb + C) * 2u; vB1[i] = (unsigned)((src0 + 8) * ldb + C) * 2u; }
        else { vB[i] = (unsigned)(Rb * ldb + C) * 2u; vB1[i] = 0u; }
#pragma unroll
        for (int h = 0; h < 2; ++h) { vA[h][i] = GATHER ? (unsigned)C * 2u : (h == 0 ? (unsigned)(R * lda + C) * 2u : 0u); vAn[h][i] = vA[h][i]; } }
    const size_t kstep = (size_t)(BK * 2), hstepB = (size_t)HALFT * ldb * 2, hB1 = perm16_v<Epi> ? 0 : hstepB;
    const unsigned (&vBs)[2] = perm16_v<Epi> ? vB1 : vB;
    const unsigned (&vA1)[2] = GATHER ? vA[1] : vA[0]; const size_t hA1 = GATHER ? 0 : (size_t)HALFT * lda * 2;
    const unsigned ldsw = (unsigned)wid * 1024u;
    const int aoff = lds_byte(wr * 64 + fr, fq * 8), boff = lds_byte(wc * 32 + fr, fq * 8);
#define PG8_SA(b, h) (((b) * 2 + (h)) * HTB)
#define PG8_SB(b, h) ((4 + (b) * 2 + (h)) * HTB)
#define PG8_STAGE(bufoff, gbase, voff) do { const int so_ = (int)(unsigned)(size_t)((const char*)(gbase) - base); _Pragma("unroll") for (int _i = 0; _i < 2; ++_i) \
        __builtin_amdgcn_raw_ptr_buffer_load_lds(rsrc, (LAS void*)(lds + (bufoff) + ldsw + _i * 8192), 16, (int)(voff)[_i], so_, 0, 0); } while (0)
#define PG8_LDA(dst, b, h) do { _Pragma("unroll") for (int m = 0; m < 4; ++m) { if constexpr (EB == 2) { _Pragma("unroll") for (int k = 0; k < 2; ++k) dst[m][k] = *(const LAS bf16x8*)(lds + PG8_SA(b, h) + aoff + m * 2048 + k * 1024); } \
        else { const v4i_t lo_ = *(const LAS v4i_t*)(lds + PG8_SA(b, h) + aoff + m * 2048), hi_ = *(const LAS v4i_t*)(lds + PG8_SA(b, h) + aoff + m * 2048 + 1024); dst##8[m] = __builtin_shufflevector(lo_, hi_, 0, 1, 2, 3, 4, 5, 6, 7); } } } while (0)
#define PG8_LDB(dst, b, h) do { _Pragma("unroll") for (int n = 0; n < 2; ++n) { if constexpr (EB == 2) { _Pragma("unroll") for (int k = 0; k < 2; ++k) dst[n][k] = *(const LAS bf16x8*)(lds + PG8_SB(b, h) + boff + n * 2048 + k * 1024); } \
        else { const v4i_t lo_ = *(const LAS v4i_t*)(lds + PG8_SB(b, h) + boff + n * 2048), hi_ = *(const LAS v4i_t*)(lds + PG8_SB(b, h) + boff + n * 2048 + 1024); dst##8[n] = __builtin_shufflevector(lo_, hi_, 0, 1, 2, 3, 4, 5, 6, 7); } } } while (0)
#define PG8_MMA(ai, bj, At, Bt) do { __builtin_amdgcn_s_setprio(1); _Pragma("unroll") for (int m = 0; m < 4; ++m) _Pragma("unroll") for (int n = 0; n < 2; ++n) { \
        if constexpr (EB == 2) { _Pragma("unroll") for (int k = 0; k < 2; ++k) acc[ai][bj][m][n] = __builtin_amdgcn_mfma_f32_16x16x32_bf16(Bt[n][k], At[m][k], acc[ai][bj][m][n], 0, 0, 0); } \
        else acc[ai][bj][m][n] = __builtin_amdgcn_mfma_scale_f32_16x16x128_f8f6f4(Bt##8[n], At##8[m], acc[ai][bj][m][n], 0, 0, 0, 0x7F7F7F7F, 0, 0x7F7F7F7F); } \
        __builtin_amdgcn_s_setprio(0); } while (0)
#define PG8_WAIT_V(n) asm volatile("s_waitcnt vmcnt(" #n ")" ::: "memory")
#define PG8_WAIT_L(n) asm volatile("s_waitcnt lgkmcnt(" #n ")" ::: "memory")
#define PG8_BAR __builtin_amdgcn_s_barrier()
#define PG8_SCHED __builtin_amdgcn_sched_barrier(0)
    Unit cur, nxt; int ui = 0;
    if (!S.next(0, cur)) return;
    f32x4 acc[2][2][4][2];
#pragma unroll
    for (int a = 0; a < 2; ++a)
#pragma unroll
        for (int b = 0; b < 2; ++b)
#pragma unroll
            for (int m = 0; m < 4; ++m)
#pragma unroll
                for (int n = 0; n < 2; ++n) acc[a][b][m][n] = (f32x4){0.f, 0.f, 0.f, 0.f};
    bf16x8 At[4][2], B0[2][2], B1[2][2]; v8i_t At8[4], B08[2], B18[2];
    if constexpr (GATHER) {
#pragma unroll
        for (int h = 0; h < 2; ++h)
#pragma unroll
            for (int i = 0; i < 2; ++i) { int R_, C_; stage_rc(tid * 16 + i * 8192, R_, C_); vA[h][i] = (unsigned)S.row(cur, h * HALFT + R_) * (unsigned)(lda * 2) + (unsigned)C_ * 2u; vAn[h][i] = vA[h][i]; }
        PG8_WAIT_V(0);
    }
    const char* cA = cur.A; const char* cB = cur.B;
    PG8_STAGE(PG8_SB(0, 0), cB, vB); PG8_STAGE(PG8_SB(0, 1), cB + hB1, vBs); PG8_STAGE(PG8_SA(0, 0), AP::kt(cA, 0, lda), vA[0]); PG8_STAGE(PG8_SA(0, 1), AP::kt(cA, 0, lda) + hA1, vA1);
    if (wr == 1) PG8_BAR;
    PG8_WAIT_V(2); PG8_BAR;
    PG8_STAGE(PG8_SB(1, 0), cB + kstep, vB); PG8_STAGE(PG8_SA(1, 0), AP::kt(cA, 1, lda), vA[0]); PG8_STAGE(PG8_SB(1, 1), cB + hB1 + kstep, vBs);
    PG8_WAIT_V(6); PG8_BAR;
    for (;;) {
        const bool has_next = S.next(ui + 1, nxt);
        const char* nA = has_next ? nxt.A : cA; const char* nB = has_next ? nxt.B : cB;
        if constexpr (GATHER) {
            if (has_next) {
#pragma unroll
                for (int h = 0; h < 2; ++h)
#pragma unroll
                    for (int i = 0; i < 2; ++i) { int R_, C_; stage_rc(tid * 16 + i * 8192, R_, C_); vAn[h][i] = (unsigned)S.row(nxt, h * HALFT + R_) * (unsigned)(lda * 2) + (unsigned)C_ * 2u; }
                PG8_WAIT_V(0);
            }
        }
#pragma unroll 1
        for (int t = 0; t < nt; t += 2) {
            const bool last = (t == nt - 2);
            const char* a1 = AP::kt(cA, t + 1, lda);
            const char* a2 = last ? AP::kt(nA, 0, lda) : AP::kt(cA, t + 2, lda); const char* a3 = last ? AP::kt(nA, 1, lda) : AP::kt(cA, t + 3, lda);
            const char* b2 = last ? nB : cB + (size_t)(t + 2) * kstep; const char* b3 = b2 + kstep;
            PG8_LDB(B0, 0, 0); PG8_LDB(B1, 0, 1); PG8_SCHED; PG8_LDA(At, 0, 0); PG8_STAGE(PG8_SA(1, 1), a1 + hA1, vA1);
            if constexpr (GATHER) { if (last) { _Pragma("unroll") for (int h = 0; h < 2; ++h) _Pragma("unroll") for (int i = 0; i < 2; ++i) vA[h][i] = vAn[h][i]; } }
            PG8_WAIT_V(8); PG8_WAIT_L(0); PG8_BAR; PG8_MMA(0, 0, At, B0); PG8_MMA(0, 1, At, B1); PG8_BAR; PG8_SCHED;
            PG8_LDA(At, 0, 1); PG8_STAGE(PG8_SB(0, 0), b2, vB); PG8_STAGE(PG8_SB(0, 1), b2 + hB1, vBs); PG8_STAGE(PG8_SA(0, 0), a2, vA[0]);
            PG8_WAIT_V(8); PG8_WAIT_L(0); PG8_BAR; PG8_MMA(1, 0, At, B0); PG8_MMA(1, 1, At, B1); PG8_BAR; PG8_SCHED;
            PG8_LDB(B0, 1, 0); PG8_LDB(B1, 1, 1); PG8_SCHED; PG8_LDA(At, 1, 0); PG8_STAGE(PG8_SA(0, 1), a2 + hA1, vA1);
            PG8_WAIT_V(8); PG8_WAIT_L(0); PG8_BAR; PG8_MMA(0, 0, At, B0); PG8_MMA(0, 1, At, B1); PG8_BAR; PG8_SCHED;
            PG8_LDA(At, 1, 1); PG8_STAGE(PG8_SB(1, 0), b3, vB); PG8_STAGE(PG8_SB(1, 1), b3 + hB1, vBs); PG8_STAGE(PG8_SA(1, 0), a3, vA[0]);
            PG8_WAIT_V(8); PG8_WAIT_L(0); PG8_BAR; PG8_MMA(1, 0, At, B0); PG8_MMA(1, 1, At, B1); PG8_BAR; PG8_SCHED;
        }
        if constexpr (ALIGN_EPI) { if (wr == 0) PG8_BAR; }
        { const int l2_ = lane_id();
          E(acc, cur, wr, wc, l2_ & 15, l2_ >> 4);
#ifdef PROBE_EPI2
          if (Epi::PROBE2) { asm volatile("s_waitcnt vmcnt(0)" ::: "memory"); E(acc, cur, wr, wc, l2_ & 15, l2_ >> 4); }
#endif
          }
        if (!has_next) break;
#pragma unroll
        for (int a = 0; a < 2; ++a)
#pragma unroll
            for (int b = 0; b < 2; ++b)
#pragma unroll
                for (int m = 0; m < 4; ++m)
#pragma unroll
                    for (int n = 0; n < 2; ++n) acc[a][b][m][n] = (f32x4){0.f, 0.f, 0.f, 0.f};
        cur = nxt; cA = nA; cB = nB; ++ui;
        if constexpr (GATHER) {
#pragma unroll
            for (int h = 0; h < 2; ++h)
#pragma unroll
                for (int i = 0; i < 2; ++i) vA[h][i] = vAn[h][i];
        }
        if constexpr (ALIGN_EPI) { if (wr == 1) PG8_BAR; }
    }
    PG8_WAIT_V(0);
    if constexpr (!ALIGN_EPI) { if (wr == 0) PG8_BAR; }
    PG8_BAR;
#undef PG8_SA
#undef PG8_SB
#undef PG8_STAGE
#undef PG8_LDA
#undef PG8_LDB
#undef PG8_MMA
#undef PG8_WAIT_V
#undef PG8_WAIT_L
#undef PG8_BAR
#undef PG8_SCHED
}

struct DenseOrder {
    const char* A; const char* B; int nM, nN, G, c; long a_tile, b_tile;
    __device__ __forceinline__ bool next(int i, Unit& u) const { const long L = (long)i * G + c; if (L >= (long)nM * nN) return false; int pm, pn; tile_of((int)L, nM, nN, pm, pn);
        u.pm = pm; u.pn = pn; u.e = 0; u.r0 = pm * BM; u.A = A + (size_t)pm * a_tile; u.B = B + (size_t)pn * b_tile; return true; }
    __device__ __forceinline__ int row(const Unit&, int) const { return 0; }
};
}
namespace pg8 {
typedef const f32x4 (&AccRef)[2][2][4][2];
__device__ __forceinline__ const LAS int* lds_tab() { unsigned a; asm volatile("v_mov_b32 %0, %1" : "=v"(a) : "i"(TAB_OFF)); return (const LAS int*)(size_t)a; }
__device__ __forceinline__ v4u pack8(const f32x4 a, const f32x4 b) { v4u w; w.x = cvt_pk_bf16(a[0], a[1]); w.y = cvt_pk_bf16(a[2], a[3]); w.z = cvt_pk_bf16(b[0], b[1]); w.w = cvt_pk_bf16(b[2], b[3]); return w; }

struct EpiOut {
    static constexpr bool PERM = false; static constexpr bool PROBE2 = false;
    const float* Xin; float* Xout; const float* g;
    __device__ __forceinline__ void operator()(AccRef acc, const Unit& u, int wr, int wc, int fr, int fq) const {
        const int b = u.r0 / S; const int col0 = u.pn * BM + wc * 32 + 4 * fq; f32x4 gv[2][2];
#pragma unroll
        for (int bj = 0; bj < 2; ++bj)
#pragma unroll
            for (int n = 0; n < 2; ++n) gv[bj][n] = *(const f32x4*)(g + (size_t)b * 6 * D + col0 + bj * HALFT + n * 16);
#pragma unroll
        for (int ai = 0; ai < 2; ++ai) { f32x4 xi[4][2][2];
#pragma unroll
            for (int m = 0; m < 4; ++m) { const size_t off = (size_t)(u.r0 + ai * HALFT + wr * 64 + m * 16 + fr) * D + col0;
#pragma unroll
                for (int bj = 0; bj < 2; ++bj)
#pragma unroll
                    for (int n = 0; n < 2; ++n) xi[m][bj][n] = __builtin_nontemporal_load((const f32x4*)(Xin + off + bj * HALFT + n * 16)); }
#pragma unroll
            for (int m = 0; m < 4; ++m) { const size_t off = (size_t)(u.r0 + ai * HALFT + wr * 64 + m * 16 + fr) * D + col0;
#pragma unroll
                for (int bj = 0; bj < 2; ++bj)
#pragma unroll
                    for (int n = 0; n < 2; ++n) *(f32x4*)(Xout + off + bj * HALFT + n * 16) = xi[m][bj][n] + gv[bj][n] * acc[ai][bj][m][n]; }
            asm volatile("" ::: "memory"); }
    }
};
struct EpiG1 {
    static constexpr bool PERM = true; static constexpr bool PROBE2 = false;
    bf16_t* proj; bf16_t* lxp; float* ssq;
    __device__ __forceinline__ void operator()(AccRef acc, const Unit& u, int wr, int wc, int fr, int fq) const {
        const int pn = u.pn; const int c0 = pn * BM + wc * 32 + 8 * fq; const int NT_LAT = (QR + KVR) / BM, NT_X = LW / BM;
#pragma unroll
        for (int ai = 0; ai < 2; ++ai)
#pragma unroll
            for (int m = 0; m < 4; ++m) { const int row = u.r0 + ai * HALFT + wr * 64 + m * 16 + fr; float ss = 0.f;
#pragma unroll
                for (int bj = 0; bj < 2; ++bj) { f32x4 v0 = acc[ai][bj][m][0], v1 = acc[ai][bj][m][1];
                    if (pn < NT_LAT) { ss += (v0[0] * v0[0] + v0[1] * v0[1]) + (v0[2] * v0[2] + v0[3] * v0[3]) + (v1[0] * v1[0] + v1[1] * v1[1]) + (v1[2] * v1[2] + v1[3] * v1[3]); }
                    if (pn >= NT_LAT + NT_X) {
#pragma unroll
                        for (int j = 0; j < 4; ++j) { v0[j] = fast_gelu_tanh(v0[j]); v1[j] = fast_gelu_tanh(v1[j]); } }
                    const v4u w = pack8(v0, v1);
                    *(v4u*)(proj + (size_t)row * P0_N + c0 + bj * HALFT) = w;
                    if (pn >= NT_LAT && pn < NT_LAT + NT_X) { const int b = row / S, t = row % S; *(v4u*)(lxp + ((size_t)b * (S + 4) + 2 + t) * LW + (c0 + bj * HALFT - (QR + KVR))) = w; } }
                if (pn < NT_LAT) { ss += __shfl_xor(ss, 16); ss += __shfl_xor(ss, 32); if (fq == 0) ssq[(size_t)row * 16 + pn * 4 + wc] = ss; } }
    }
};
struct EpiG2 {
    static constexpr bool PERM = true; static constexpr bool PROBE2 = false;
    bf16_t* Q; bf16_t* KC; bf16_t* V; const float* ssq; const float* cosr; const float* sinr; float qs;
    __device__ __forceinline__ void operator()(AccRef acc, const Unit& u, int wr, int wc, int fr, int fq) const {
        const int pn = u.pn; const int NQ_N = H_A * NOPE / BM, NQ = H_A * QK / BM;
#pragma unroll
        for (int ai = 0; ai < 2; ++ai)
#pragma unroll
            for (int m = 0; m < 4; ++m) { const int row = u.r0 + ai * HALFT + wr * 64 + m * 16 + fr;
                if (pn < NQ_N) { const float rs = 1.0f / sqrtf(ssq8(ssq + (size_t)row * 16) * (1.0f / QR) + EPS) * qs;
#pragma unroll
                    for (int bj = 0; bj < 2; ++bj) { const int h = 2 * pn + bj; *(v4u*)(Q + ((size_t)row * H_A + h) * QK + wc * 32 + 8 * fq) = pack8(acc[ai][bj][m][0] * rs, acc[ai][bj][m][1] * rs); } }
                else if (pn < NQ) { const float rs = 1.0f / sqrtf(ssq8(ssq + (size_t)row * 16) * (1.0f / QR) + EPS) * qs; const int h = 4 * (pn - NQ_N) + wc, t = row % S;
                    const f32x4 c0 = *(const f32x4*)(cosr + t * (ROPE / 2) + 8 * fq), c1 = *(const f32x4*)(cosr + t * (ROPE / 2) + 8 * fq + 4), s0 = *(const f32x4*)(sinr + t * (ROPE / 2) + 8 * fq), s1 = *(const f32x4*)(sinr + t * (ROPE / 2) + 8 * fq + 4);
                    const f32x4 x10 = acc[ai][0][m][0] * rs, x11 = acc[ai][0][m][1] * rs, x20 = acc[ai][1][m][0] * rs, x21 = acc[ai][1][m][1] * rs;
                    bf16_t* q = Q + ((size_t)row * H_A + h) * QK + NOPE + 8 * fq;
                    *(v4u*)q = pack8(x10 * c0 - x20 * s0, x11 * c1 - x21 * s1); *(v4u*)(q + ROPE / 2) = pack8(x20 * c0 + x10 * s0, x21 * c1 + x11 * s1); }
                else { const float rs = 1.0f / sqrtf(ssq8(ssq + (size_t)row * 16 + 8) * (1.0f / KVR) + EPS); const int h = pn - NQ;
                    *(v4u*)(KC + ((size_t)row * H_A + h) * QK + wc * 32 + 8 * fq) = pack8(acc[ai][0][m][0] * rs, acc[ai][0][m][1] * rs);
                    *(v4u*)(V + ((size_t)row * H_A + h) * VD + wc * 32 + 8 * fq) = pack8(acc[ai][1][m][0] * rs, acc[ai][1][m][1] * rs); } }
    }
};
struct OrderG2 {
    const char* A; const char* Bq; const char* Bkv; int G, c;
    __device__ __forceinline__ bool next(int i, Unit& u) const { const int nN = (H_A * QK + H_A * (NOPE + VD)) / BM, nM = M / BM; const long L = (long)i * G + c; if (L >= (long)nM * nN) return false; int pm, pn; tile_of((int)L, nM, nN, pm, pn);
        const int NQ = H_A * QK / BM; u.pm = pm; u.pn = pn; u.e = 0; u.r0 = pm * BM; u.A = A + (size_t)pm * BM * P0_N * 2 + (pn < NQ ? 0 : QR * 2);
        u.B = pn < NQ ? Bq + (size_t)pn * BM * QR * 2 : Bkv + (size_t)(pn - NQ) * BM * KVR * 2; return true; }
    __device__ __forceinline__ int row(const Unit&, int) const { return 0; }
};
struct EpiGates {
    static constexpr bool PERM = true; static constexpr bool PROBE2 = false;
    bf16_t* LA; bf16_t* U; const bf16_t* lxp; const float* gb; const float* cl; const float* convw; const float* convb;
    __device__ __forceinline__ void operator()(AccRef acc, const Unit& u, int wr, int wc, int fr, int fq) const {
        const int g = u.pn >> 1, d = u.pn & 1; const int ch0 = g * LBS + wc * 32 + 8 * fq; const int b = u.r0 / S;
        f32x4 ba[2], bx[2], clv[2], cb[2], cw[4][2];
#pragma unroll
        for (int n = 0; n < 2; ++n) { const int ch = ch0 + 4 * n; ba[n] = *(const f32x4*)(gb + (d * 2 + 0) * LW + ch); bx[n] = *(const f32x4*)(gb + (d * 2 + 1) * LW + ch); clv[n] = *(const f32x4*)(cl + d * LW + ch); cb[n] = *(const f32x4*)(convb + ch);
#pragma unroll
            for (int j = 0; j < 4; ++j) cw[j][n] = *(const f32x4*)(convw + j * LW + ch); }
#pragma unroll
        for (int ai = 0; ai < 2; ++ai)
#pragma unroll
            for (int m = 0; m < 4; ++m) { const int row = u.r0 + ai * HALFT + wr * 64 + m * 16 + fr; const int t = row % S; f32x4 la[2], uu[2], xc[2] = {cb[0], cb[1]};
                v4u raw[4];
#pragma unroll
                for (int j = 0; j < 4; ++j) raw[j] = *(const v4u*)(lxp + ((size_t)b * (S + 4) + t + j) * LW + ch0);
#pragma unroll
                for (int j = 0; j < 4; ++j)
#pragma unroll
                    for (int n = 0; n < 2; ++n) { const unsigned r0_ = raw[j][2 * n], r1_ = raw[j][2 * n + 1];
                        xc[n][0] += cw[j][n][0] * __uint_as_float(r0_ << 16); xc[n][1] += cw[j][n][1] * __uint_as_float(r0_ & 0xffff0000u); xc[n][2] += cw[j][n][2] * __uint_as_float(r1_ << 16); xc[n][3] += cw[j][n][3] * __uint_as_float(r1_ & 0xffff0000u); }
#pragma unroll
                for (int n = 0; n < 2; ++n)
#pragma unroll
                    for (int j = 0; j < 4; ++j) { const float l = clv[n][j] * fast_sigm(acc[ai][0][m][n][j] + ba[n][j]); const float x2 = 2.0f * l;
                        const float em = -x2 * (1.0f + 0.5f * x2 * (1.0f + (1.0f / 3.0f) * x2 * (1.0f + 0.25f * x2 * (1.0f + 0.2f * x2))));
                        la[n][j] = l; uu[n][j] = sqrtf(em) * fast_sigm(acc[ai][1][m][n][j] + bx[n][j]) * xc[n][j]; }
                const long o = lru_idx(d, b, t, ch0); *(v4u*)(LA + o) = pack8(la[0], la[1]); *(v4u*)(U + o) = pack8(uu[0], uu[1]); }
    }
};
struct OrderGates {
    const char* lxp; const char* B; int G, c;
    __device__ __forceinline__ bool next(int i, Unit& u) const { const int nN = 2 * (LW / LBS), nM = M / BM; const long L = (long)i * G + c; if (L >= (long)nM * nN) return false; int pm, pn; tile_of((int)L, nM, nN, pm, pn);
        u.pm = pm; u.pn = pn; u.e = 0; u.r0 = pm * BM; const int b = u.r0 / S, t0 = u.r0 % S, g = pn >> 1;
        u.A = lxp + (((size_t)b * (S + 4) + 2 + t0) * LW + g * LBS) * 2; u.B = B + (size_t)pn * BM * (4 * LBS) * 2; return true; }
    __device__ __forceinline__ int row(const Unit&, int) const { return 0; }
};
struct EpiG3 {
    static constexpr bool PERM = true; static constexpr bool PROBE2 = false;
    bf16_t* proj; const float* cost; const float* sint; float sqs;
    __device__ __forceinline__ void operator()(AccRef acc, const Unit& u, int wr, int wc, int fr, int fq) const {
        const int pn = u.pn; const int NH = H_C * DK / BM;
#pragma unroll
        for (int ai = 0; ai < 2; ++ai)
#pragma unroll
            for (int m = 0; m < 4; ++m) { const int row = u.r0 + ai * HALFT + wr * 64 + m * 16 + fr; bf16_t* p = proj + (size_t)row * CD_N + pn * BM + wc * 32 + 8 * fq;
                if (pn < 2 * NH) { const int t = row % S, i0 = wc * 32 + 8 * fq; const float sc = pn < NH ? 1.0f : 1.0f / sqrtf((float)DK);
                    const f32x4 c0 = *(const f32x4*)(cost + t * (DK / 2) + i0) * sc, c1 = *(const f32x4*)(cost + t * (DK / 2) + i0 + 4) * sc, s0 = *(const f32x4*)(sint + t * (DK / 2) + i0) * sc, s1 = *(const f32x4*)(sint + t * (DK / 2) + i0 + 4) * sc;
                    const f32x4 x10 = acc[ai][0][m][0], x11 = acc[ai][0][m][1], x20 = acc[ai][1][m][0], x21 = acc[ai][1][m][1];
                    *(v4u*)p = pack8(x10 * c0 - x20 * s0, x11 * c1 - x21 * s1); *(v4u*)(p + HALFT) = pack8(x20 * c0 + x10 * s0, x21 * c1 + x11 * s1); }
                else {
#pragma unroll
                    for (int bj = 0; bj < 2; ++bj) { f32x4 v0 = acc[ai][bj][m][0], v1 = acc[ai][bj][m][1];
                        if (pn >= 3 * NH && pn < 4 * NH) {
#pragma unroll
                            for (int j = 0; j < 4; ++j) { v0[j] = fast_silu(v0[j]); v1[j] = fast_silu(v1[j]); } }
                        else if (pn >= 4 * NH && pn < 4 * NH + H_D * HDS / BM) { v0 = v0 * sqs; v1 = v1 * sqs; }
                        *(v4u*)(p + bj * HALFT) = pack8(v0, v1); } } }
    }
};
struct OrderMoe {
    const LAS int* offt; const char* A; const char* B; const int* tok; int npn, G, c, gather; long b_exp, b_tile, a_tile;
    __device__ __forceinline__ bool next(int i, Unit& u) const { const long L = (long)i * G + c; const int T = (int)(L / npn); if (T >= offt[E + 1]) return false; const int e = ((const LAS unsigned char*)(offt + 2 * E + 4))[T];
        u.e = e; u.pn = (int)(L % npn); u.pm = T - offt[e]; u.r0 = T * BM; u.A = gather ? A : A + (size_t)T * a_tile; u.B = B + (size_t)e * b_exp + (size_t)u.pn * b_tile; return true; }
    __device__ __forceinline__ int row(const Unit& u, int r) const { const int rank = u.pm * BM + r; if (u.e == E) return rank; const int n = offt[E + 2 + u.e]; return rank < n ? tok[(size_t)u.e * M + rank] : 0; }
};
__device__ __forceinline__ float sat_fp8(float v) { return __builtin_amdgcn_fmed3f(v, -448.0f, 448.0f); }
__device__ __forceinline__ unsigned pack_fp8x4(float a, float b, float c, float d) { int w = __builtin_amdgcn_cvt_pk_fp8_f32(sat_fp8(a), sat_fp8(b), 0, false); return (unsigned)__builtin_amdgcn_cvt_pk_fp8_f32(sat_fp8(c), sat_fp8(d), w, true); }
constexpr float F8_H = 4.0f, F8_GU = 32.0f, F8_ACT = 8.0f, F8_DN = 16.0f, F8_Y = 16.0f;
struct EpiM1F8 {
    static constexpr bool PERM = true; static constexpr bool PROBE2 = false;
    unsigned char* ws;
    __device__ __forceinline__ void operator()(AccRef acc, const Unit& u, int wr, int wc, int fr, int fq) const {
        constexpr float inv = 1.0f / (F8_H * F8_GU); unsigned char* act = ws + WS_ACT;
#pragma unroll
        for (int ai = 0; ai < 2; ++ai)
#pragma unroll
            for (int m = 0; m < 4; ++m) { const int row = u.r0 + ai * HALFT + wr * 64 + m * 16 + fr; f32x4 v[2];
#pragma unroll
                for (int n = 0; n < 2; ++n)
#pragma unroll
                    for (int j = 0; j < 4; ++j) v[n][j] = fast_silu(acc[ai][0][m][n][j] * inv) * (acc[ai][1][m][n][j] * (inv * F8_ACT));
                u32x2 w; w.x = pack_fp8x4(v[0][0], v[0][1], v[0][2], v[0][3]); w.y = pack_fp8x4(v[1][0], v[1][1], v[1][2], v[1][3]);
                *(u32x2*)(act + (size_t)row * FF + u.pn * HALFT + wc * 32 + 8 * fq) = w; }
    }
};
template <int NPN, bool GATH, size_t A_OFF, size_t B_OFF, long B_EXP, long B_TILE, long A_TILE>
struct OrderMoeT {
    const unsigned char* ws; int G, c;
    __device__ __forceinline__ bool next(int i, Unit& u) const { const LAS int* offt = lds_tab();
#ifdef MOE_CONTIG
        if (i >= c) return false; const int L = G + i; const int T = L / NPN;
#else
        const long L = (long)i * G + c; const int T = (int)(L / NPN); if (T >= __builtin_amdgcn_readfirstlane(offt[E + 1])) return false;
#endif
        const int e = __builtin_amdgcn_readfirstlane((int)((const LAS unsigned char*)(offt + 2 * E + 4))[T]);
        u.e = e; u.pn = (int)(L % NPN); u.pm = T - __builtin_amdgcn_readfirstlane(offt[e]); u.r0 = T * BM; u.A = (const char*)ws + A_OFF + (GATH ? 0 : (size_t)T * A_TILE); u.B = (const char*)ws + B_OFF + (size_t)e * B_EXP + (size_t)u.pn * B_TILE; return true; }
    __device__ __forceinline__ int row(const Unit& u, int r) const { const int rank = u.pm * BM + r; if (u.e == E) return rank; const int n = lds_tab()[E + 2 + u.e]; return rank < n ? ((const int*)(ws + WS_TOK))[(size_t)u.e * M + rank] : 0; }
};
struct EpiM2F8 {
    static constexpr bool PERM = true; static constexpr bool PERM16 = true; static constexpr bool PROBE2 = false;
    unsigned char* ws;
    __device__ __forceinline__ void operator()(AccRef acc, const Unit& u, int wr, int wc, int fr, int fq) const {
        constexpr float w = F8_Y / (F8_ACT * F8_DN); unsigned char* Y = ws + WS_Y;
#pragma unroll
        for (int ai = 0; ai < 2; ++ai)
#pragma unroll
            for (int m = 0; m < 4; ++m) { const int rr = ai * HALFT + wr * 64 + m * 16 + fr; v4u o;
#pragma unroll
                for (int bj = 0; bj < 2; ++bj) { const f32x4 a = acc[ai][bj][m][0] * w, b = acc[ai][bj][m][1] * w; o[2 * bj] = pack_fp8x4(a[0], a[1], a[2], a[3]); o[2 * bj + 1] = pack_fp8x4(b[0], b[1], b[2], b[3]); }
                *(v4u*)(Y + (size_t)(u.r0 + rr) * D + u.pn * BM + wc * 64 + 16 * fq) = o; }
    }
};
struct EpiM1 {
    static constexpr bool PERM = true; static constexpr bool PROBE2 = false;
    bf16_t* act;
    __device__ __forceinline__ void operator()(AccRef acc, const Unit& u, int wr, int wc, int fr, int fq) const {
#pragma unroll
        for (int ai = 0; ai < 2; ++ai)
#pragma unroll
            for (int m = 0; m < 4; ++m) { const int row = u.r0 + ai * HALFT + wr * 64 + m * 16 + fr; f32x4 v[2];
#pragma unroll
                for (int n = 0; n < 2; ++n)
#pragma unroll
                    for (int j = 0; j < 4; ++j) v[n][j] = fast_silu(acc[ai][0][m][n][j]) * acc[ai][1][m][n][j];
                *(v4u*)(act + (size_t)row * FF + u.pn * HALFT + wc * 32 + 8 * fq) = pack8(v[0], v[1]); }
    }
};
struct EpiM2 {
    static constexpr bool PERM = true; static constexpr bool PROBE2 = false;
    bf16_t* Y; const float* wt; const LAS int* offt; float osc;
    __device__ __forceinline__ void operator()(AccRef acc, const Unit& u, int wr, int wc, int fr, int fq) const {
        float w8[2][4]; const int nrow = u.e < E ? offt[E + 2 + u.e] : M;
#pragma unroll
        for (int ai = 0; ai < 2; ++ai)
#pragma unroll
            for (int m = 0; m < 4; ++m) { const int rank = u.pm * BM + ai * HALFT + wr * 64 + m * 16 + fr; w8[ai][m] = (u.e < E ? (rank < nrow ? wt[(size_t)u.e * M + rank] : 0.f) : 1.0f) * osc; }
#pragma unroll
        for (int ai = 0; ai < 2; ++ai)
#pragma unroll
            for (int m = 0; m < 4; ++m) { const int rr = ai * HALFT + wr * 64 + m * 16 + fr; const float w = w8[ai][m];
#pragma unroll
                for (int bj = 0; bj < 2; ++bj) *(v4u*)(Y + (size_t)(u.r0 + rr) * D + u.pn * BM + bj * HALFT + wc * 32 + 8 * fq) = pack8(acc[ai][bj][m][0] * w, acc[ai][bj][m][1] * w); }
    }
};
}

struct Frame { LAS unsigned char* lds; Ctx c; int wave, vcu, G;
    __device__ __forceinline__ int lane() const { return lane_id(); }
    __device__ __forceinline__ int tid() const { return wave * 64 + lane_id(); } };

struct CvtDesc { const float* src; unsigned char* dst; const float* sc; int ldw, Kd, f8; float mul; };
__device__ __forceinline__ void cvt_load(const CvtDesc& d, float (&v)[32], int lane) {
    const float* p = d.src + (size_t)(lane >> 3) * d.ldw + 4 * (lane & 7);
#pragma unroll
    for (int i = 0; i < 8; ++i) { const f32x4 t = __builtin_nontemporal_load((const f32x4*)(p + (size_t)(8 * i) * d.ldw));     v[4 * i] = t[0]; v[4 * i + 1] = t[1]; v[4 * i + 2] = t[2]; v[4 * i + 3] = t[3]; }
}
__device__ __forceinline__ void cvt_finish(const CvtDesc& d, float (&v)[32], LAS float* scr, int lane) {
    const int kr = lane >> 3, n4 = 4 * (lane & 7);
#pragma unroll
    for (int i = 0; i < 8; ++i) { const float m = (d.sc ? d.sc[8 * i + kr] : 1.0f) * d.mul;
#pragma unroll
        for (int e = 0; e < 4; ++e) scr[(8 * i + kr) * 33 + n4 + e] = v[4 * i + e] * m; }
    LDS_WAIT(); asm volatile("" ::: "memory");
    const int cc = lane & 7;
#pragma unroll
    for (int j = 0; j < 4; ++j) { const int n = (lane >> 3) + 8 * j; const LAS float* s = scr + (8 * cc) * 33 + n;
        if (d.f8) { u32x2 o; o.x = pg8::pack_fp8x4(s[0 * 33], s[1 * 33], s[2 * 33], s[3 * 33]); o.y = pg8::pack_fp8x4(s[4 * 33], s[5 * 33], s[6 * 33], s[7 * 33]); __builtin_nontemporal_store(o, (u32x2*)(d.dst + (size_t)n * d.Kd + 8 * cc)); }
        else { v4u o; o.x = cvt_pk_bf16(s[0 * 33], s[1 * 33]); o.y = cvt_pk_bf16(s[2 * 33], s[3 * 33]); o.z = cvt_pk_bf16(s[4 * 33], s[5 * 33]); o.w = cvt_pk_bf16(s[6 * 33], s[7 * 33]); __builtin_nontemporal_store(o, (v4u*)(d.dst + (size_t)n * d.Kd + 16 * cc)); } }
    LDS_WAIT(); asm volatile("" ::: "memory");
}
__device__ __forceinline__ CvtDesc mk_desc(const float* src, int ldw, int k0, int ns0, void* dst, int Kd_elems, int nd0, int kd0, const float* sc, int f8 = 0, float mul = 1.0f) {
    CvtDesc d; d.src = src + (size_t)k0 * ldw + ns0; d.ldw = ldw; d.f8 = f8; d.mul = mul; d.sc = sc ? sc + k0 : nullptr; const int eb = f8 ? 1 : 2; d.Kd = Kd_elems * eb;
    d.dst = (unsigned char*)dst + ((size_t)nd0 * Kd_elems + kd0 + k0) * eb; return d; }
constexpr long cnt_items(int K, int N) { return (long)(K / 64) * (N / 32); }
constexpr long IT_INAB = 0, IT_UQ = IT_INAB + cnt_items(D, AB_N), IT_UKV = IT_UQ + cnt_items(QR, H_A * QK), IT_LRU = IT_UKV + cnt_items(KVR, H_A * (NOPE + VD)),
    IT_OUTAB = IT_LRU + (long)2 * (LW / LBS) * 2 * 4 * cnt_items(LBS, LBS), IT_RT = IT_OUTAB + cnt_items(D, D), IT_GU0 = IT_RT + 2 * cnt_items(D, E), IT_DN0 = IT_GU0 + (long)(E + 1) * 2 * cnt_items(D, FF),
    IT_INCD = IT_DN0 + (long)(E + 1) * cnt_items(FF, D), IT_OUTCD = IT_INCD + cnt_items(D, CD_N), IT_GU1 = IT_OUTCD + cnt_items(D, D), IT_DN1 = IT_GU1 + (long)(E + 1) * 2 * cnt_items(D, FF), IT_END = IT_DN1 + (long)(E + 1) * cnt_items(FF, D);
__device__ __forceinline__ CvtDesc p0_desc(const Ctx& c, long it) {
#ifdef MOE_FP8
    constexpr int MF8 = 1; constexpr float MGU = pg8::F8_GU, MDN = pg8::F8_DN;
#else
    constexpr int MF8 = 0; constexpr float MGU = 1.0f, MDN = 1.0f;
#endif
    const int sub = (int)(it & 1);
    if (it < IT_UQ) { const long r = (it - IT_INAB) >> 1; constexpr int NBK = AB_N / 32; const int kb = 2 * (int)(r / NBK) + sub, nb = (int)(r % NBK); const int col = nb * 32; const int drow = col < QR + KVR ? col : (col < QR + KVR + ROPE ? P0_N + col - (QR + KVR) : col - ROPE);
        return mk_desc(c.in[I_WINAB], AB_N, kb * 64, col, WSP(bf16_t, W_INAB), D, drow, 0, nullptr); }
    if (it < IT_UKV) { const long r = (it - IT_UQ) >> 1; constexpr int NBK = H_A * QK / 32; const int kb = 2 * (int)(r / NBK) + sub, db = (int)(r % NBK); const int v = db * 32; int scol;
        if (v < H_A * NOPE) { const int h = v / NOPE, d0 = v % NOPE; scol = h * QK + d0; }
        else { const int v2 = v - H_A * NOPE; const int tq = v2 / 256, half = (v2 % 256) / 128, hq = (v2 % 128) / 32; scol = (4 * tq + hq) * QK + NOPE + (ROPE / 2) * half; }
        return mk_desc(c.in[I_WUQ], H_A * QK, kb * 64, scol, WSP(bf16_t, W_UQ), QR, v, 0, c.in[I_QLN]); }
    if (it < IT_LRU) { const long r = (it - IT_UKV) >> 1; constexpr int NBK = H_A * (NOPE + VD) / 32; const int kb = 2 * (int)(r / NBK) + sub, nb = (int)(r % NBK);
        return mk_desc(c.in[I_WUKV], H_A * (NOPE + VD), kb * 64, nb * 32, WSP(bf16_t, W_UKV), KVR, nb * 32, 0, c.in[I_KVLN]); }
    if (it < IT_OUTAB) { const long r = (it - IT_LRU) >> 1; constexpr int NBK = LBS / 32, PER = (LBS / 128) * NBK; const int q = (int)(r / PER), w = (int)(r % PER); const int tap = q & 3, half = (q >> 2) & 1, tq = q >> 3, g = tq >> 1, d = tq & 1; const int kb = 2 * (w / NBK) + sub, nb = w % NBK;
        const float* src = (half ? c.in[I_LWX] : c.in[I_LWA]) + ((size_t)(d * (LW / LBS) + g) * LBS) * LBS;
        return mk_desc(src, LBS, kb * 64, nb * 32, WSP(bf16_t, W_LRU) + (size_t)tq * 2 * LBS * 4 * LBS, 4 * LBS, half * LBS + nb * 32, tap * LBS, c.in[I_CONVW] + tap * LW + g * LBS); }
    if (it < IT_RT) { const long r = (it - IT_OUTAB) >> 1; constexpr int NBK = D / 32; return mk_desc(c.in[I_WOUTAB], D, (2 * (int)(r / NBK) + sub) * 64, (int)(r % NBK) * 32, WSP(bf16_t, W_OUTAB), D, (int)(r % NBK) * 32, 0, nullptr); }
    if (it < IT_GU0) { const long r = (it - IT_RT) >> 1; constexpr int NBK = E / 32; constexpr long PER = (long)(D / 128) * NBK; const int l = (int)(r / PER); const long w = r % PER;
        return mk_desc(c.in[I_WROUTER] + (size_t)l * D * E, E, (2 * (int)(w / NBK) + sub) * 64, (int)(w % NBK) * 32, WSP(bf16_t, W_RT) + (size_t)l * E * D, D, (int)(w % NBK) * 32, 0, nullptr); }
    if (it < IT_INCD || (it >= IT_GU1)) {
        const int l = it >= IT_GU1 ? 1 : 0; const long base_gu = l ? IT_GU1 : IT_GU0, base_dn = l ? IT_DN1 : IT_DN0;
        if (it < base_dn) { const long r = (it - base_gu) >> 1; constexpr int NBK = FF / 32; constexpr long PER = (long)(D / 128) * NBK; const long q = r / PER, w = r % PER; const int up = (int)(q & 1), e = (int)(q >> 1); const int kb = 2 * (int)(w / NBK) + sub, nb = (int)(w % NBK); const int col = nb * 32;
            const float* src = e < E ? (up ? c.in[I_WUP] : c.in[I_WGATE]) + ((size_t)l * E + e) * D * FF : (up ? c.in[I_WSU] : c.in[I_WSG]) + (size_t)l * D * FF;
            return mk_desc(src, FF, kb * 64, col, c.ws + W_GU + ((size_t)l * (E + 1) + e) * 2 * FF * D * (MF8 ? 1 : 2), D, (col / 128) * 256 + up * 128 + (col % 128), 0, nullptr, MF8, MGU); }
        { const long r = (it - base_dn) >> 1; constexpr int NBK = D / 32; constexpr long PER = (long)(FF / 128) * NBK; const int e = (int)(r / PER); const long w = r % PER;
            const float* src = e < E ? c.in[I_WDOWN] + ((size_t)l * E + e) * FF * D : c.in[I_WSD] + (size_t)l * FF * D;
            return mk_desc(src, D, (2 * (int)(w / NBK) + sub) * 64, (int)(w % NBK) * 32, c.ws + W_DN + ((size_t)l * (E + 1) + e) * D * FF * (MF8 ? 1 : 2), FF, (int)(w % NBK) * 32, 0, nullptr, MF8, MDN); } }
    if (it < IT_OUTCD) { const long r = (it - IT_INCD) >> 1; constexpr int NBK = CD_N / 32; return mk_desc(c.in[I_WINCD], CD_N, (2 * (int)(r / NBK) + sub) * 64, (int)(r % NBK) * 32, WSP(bf16_t, W_INCD), D, (int)(r % NBK) * 32, 0, nullptr); }
    { const long r = (it - IT_OUTCD) >> 1; constexpr int NBK = D / 32; return mk_desc(c.in[I_WOUTCD], D, (2 * (int)(r / NBK) + sub) * 64, (int)(r % NBK) * 32, WSP(bf16_t, W_OUTCD), D, (int)(r % NBK) * 32, 0, nullptr); }
}
__device__ __forceinline__ void conv_items(Frame& F, long lo, long hi, int pidx = -1, int np = 0) {
    if (pidx < 0) { pidx = F.vcu; np = F.G; }
    const Ctx& c = F.c; LAS float* scr = (LAS float*)(F.lds + F.wave * 16384); const int lane = F.lane(); const long step = 2 * (long)np * NWAVES;
    long it = lo + 2 * ((long)pidx * NWAVES + F.wave); float va[32], vb[32];
    if (it < hi) { CvtDesc da = p0_desc(c, it); cvt_load(da, va, lane);
        for (;;) {
            CvtDesc db = p0_desc(c, it + 1); cvt_load(db, vb, lane);
            cvt_finish(da, va, scr, lane);
            const long i2 = it + step; const bool h2 = i2 < hi; if (h2) { da = p0_desc(c, i2); cvt_load(da, va, lane); }
            cvt_finish(db, vb, scr, lane); if (!h2) break;
            it = i2; } }
}
__device__ __forceinline__ void conv_slice(Frame& F, long lo, long hi, int k0, int k1, int n, int pidx = -1, int np = 0) { const long npair = (hi - lo) / 2; conv_items(F, lo + 2 * (npair * k0 / n), lo + 2 * (npair * k1 / n), pidx, np); }
__device__ __forceinline__ void mod_units(Frame& F, int l) {
    const Ctx& c = F.c; LAS float* cact = (LAS float*)F.lds; LAS float* red = (LAS float*)(F.lds + 65536);
    for (int i = F.tid(); i < NB * D; i += NTHR) cact[i] = siluf(c.in[I_C][i]);
    __syncthreads();
    constexpr int UW = 48, NU = 6 * D / UW, KW = D / NWAVES; static_assert(6 * D % UW == 0 && KW % 64 == 0 && NB * UW <= NTHR, "mod units");
    for (int u = F.vcu; u < NU; u += F.G) { const int col0 = u * UW; const int rg = F.lane() >> 4, cl = (F.lane() & 15) < 12 ? (F.lane() & 15) : 11;
        const float* w = c.in[I_WMOD] + (size_t)l * D * 6 * D + col0 + 4 * cl; f32x4 a[NB];
#pragma unroll
        for (int b = 0; b < NB; ++b) a[b] = f32x4{0.f, 0.f, 0.f, 0.f};
        const int kbeg = F.wave * KW + rg;
#pragma unroll 1
        for (int i0 = 0; i0 < KW / 4; i0 += 16) { f32x4 wv[16];
#pragma unroll
            for (int j = 0; j < 16; ++j) wv[j] = __builtin_nontemporal_load((const f32x4*)(w + (size_t)(kbeg + 4 * (i0 + j)) * 6 * D));
#pragma unroll
            for (int j = 0; j < 16; ++j) { const int k = kbeg + 4 * (i0 + j);
#pragma unroll
                for (int b = 0; b < NB; ++b) a[b] += wv[j] * cact[b * D + k]; } }
#pragma unroll
        for (int b = 0; b < NB; ++b)
#pragma unroll
            for (int q = 0; q < 4; ++q) { float s = a[b][q]; s += __shfl_xor(s, 16); s += __shfl_xor(s, 32); a[b][q] = s; }
        if (F.lane() < 12) {
#pragma unroll
            for (int b = 0; b < NB; ++b) *(LAS f32x4*)(red + (F.wave * NB + b) * UW + 4 * F.lane()) = a[b]; }
        __syncthreads();
        if (F.tid() < NB * UW) { const int b = F.tid() / UW, cc = F.tid() % UW; float s = c.in[I_BMOD][l * 6 * D + col0 + cc];
#pragma unroll
            for (int w8 = 0; w8 < NWAVES; ++w8) s += red[(w8 * NB + b) * UW + cc];
            WSP(float, WS_MOD)[((size_t)l * NB + b) * 6 * D + col0 + cc] = s; }
        __syncthreads();
    }
    __syncthreads();
}

__device__ __forceinline__ void p0_phase(Frame& F) {
    const Ctx& c = F.c;
    mod_units(F, 0);
#ifndef SPREAD_CONV
    mod_units(F, 1);
#endif
    const long gt = (long)F.vcu * NTHR + F.tid(), NGT = (long)F.G * NTHR;
    for (long i = gt; i < (long)S * (ROPE / 2 + DK / 2); i += NGT) { TabF f; f.c = c; f(i); }
    static_assert(LBS % 64 == 0 && LBS % NWAVES == 0, "gate bias units");
    for (int u = F.vcu; u < 4 * LW / 64; u += F.G) { const int i = u * 64 + F.lane(); const int ch = i % LW, half = (i / LW) & 1, d = i / (2 * LW); const int g = ch / LBS, j = ch % LBS;
        LAS float* red = (LAS float*)(F.lds + 65536);
        const float* wm = (half ? c.in[I_LWX] : c.in[I_LWA]) + ((size_t)(d * (LW / LBS) + g) * LBS) * LBS + j; float s = 0.f;
#pragma unroll
        for (int kk = 0; kk < LBS / NWAVES; ++kk) { const int k = F.wave * (LBS / NWAVES) + kk; s += c.in[I_CONVB][g * LBS + k] * wm[(size_t)k * LBS]; }
        red[F.wave * 64 + F.lane()] = s; __syncthreads();
        if (F.wave == 0) { float t = (half ? c.in[I_LBX] : c.in[I_LBA])[d * LW + ch];
#pragma unroll
            for (int w8 = 0; w8 < NWAVES; ++w8) t += red[w8 * 64 + F.lane()];
            WSP(float, W_GB)[i] = t; }
        __syncthreads(); }
    for (long i = gt; i < 2 * LW; i += NGT) WSP(float, W_GB)[4 * LW + i] = -8.0f * log1pf(expf(-c.in[I_LLAM][i]));
    for (long i = gt; i < (long)NB * 4 * LW; i += NGT) { const int b = (int)(i / (4 * LW)), rr = (int)((i / LW) % 4), ch = (int)(i % LW); WSP(bf16_t, WS_LXP)[((size_t)b * (S + 4) + (rr < 2 ? rr : S + rr)) * LW + ch] = 0; }
    __syncthreads();
#ifdef SPREAD_CONV
    conv_items(F, IT_INAB, IT_OUTAB);
#else
    conv_items(F, IT_INAB, IT_END);
#endif
}
__device__ __forceinline__ void build_offt(Frame& F, int l) {
    LAS int* offt = (LAS int*)(F.lds + TAB_OFF); static_assert(E <= 64, "one lane per routed expert");
    if (F.wave == 0) { const int lane = F.lane(); LAS unsigned char* texp = (LAS unsigned char*)(offt + 2 * E + 4);
        const int n = lane < E ? __hip_atomic_load((const int*)(F.c.ws + CTL_CNT) + cnt_idx(l, lane), RLX_AGENT) : 0; const int nt = (n + RT - 1) / RT; int inc = nt;
#pragma unroll
        for (int o = 1; o < 64; o <<= 1) { const int v = __shfl_up(inc, o); if (lane >= o) inc += v; }
        const int off = inc - nt, tot = __shfl(inc, 63); constexpr int NTS = (M + RT - 1) / RT;
        if (lane < E) { offt[lane] = off; offt[E + 2 + lane] = n; for (int t = 0; t < nt; ++t) texp[off + t] = (unsigned char)lane; }
        if (lane == 0) { offt[E] = tot; offt[E + 1] = tot + NTS; }
        for (int t = lane; t < NTS; t += 64) texp[tot + t] = (unsigned char)E; }
    __syncthreads();
}

__device__ __forceinline__ void modulate_row(const float* xrow, const float* gain, const float* sc, const float* sh, bf16_t* orow, int lane, unsigned char* orow8 = nullptr) {
    f32x4 v[D / 256]; float s = 0.f;
#pragma unroll
    for (int j = 0; j < D / 256; ++j) { v[j] = *((const f32x4*)xrow + lane + 64 * j); s += (v[j][0] * v[j][0] + v[j][1] * v[j][1]) + (v[j][2] * v[j][2] + v[j][3] * v[j][3]); }
    const float r = 1.0f / sqrtf(wave_sum(s) * (1.0f / D) + EPS);
#pragma unroll
    for (int j = 0; j < D / 256; ++j) { const int col = 4 * lane + 256 * j; const f32x4 g = *(const f32x4*)(gain + col), a = *(const f32x4*)(sc + col), b = *(const f32x4*)(sh + col);
        const f32x4 o = v[j] * r * g * (1.0f + a) + b; u32x2 w; w.x = cvt_pk_bf16(o[0], o[1]); w.y = cvt_pk_bf16(o[2], o[3]); *(u32x2*)(orow + col) = w;
        if (orow8) *(unsigned*)(orow8 + col) = pg8::pack_fp8x4(o[0] * pg8::F8_H, o[1] * pg8::F8_H, o[2] * pg8::F8_H, o[3] * pg8::F8_H); }
}
template <int NR> __device__ __forceinline__ void modulate_rows(const float* X, int m0, const float* gain, const float* sc, const float* sh, bf16_t* HM, unsigned char* HM8, int lane) {
    f32x4 v[NR][D / 256]; float s[NR];
#pragma unroll
    for (int r = 0; r < NR; ++r) { s[r] = 0.f;
#pragma unroll
        for (int j = 0; j < D / 256; ++j) v[r][j] = __builtin_nontemporal_load((const f32x4*)(X + (size_t)(m0 + r) * D) + lane + 64 * j); }
#pragma unroll
    for (int r = 0; r < NR; ++r)
#pragma unroll
        for (int j = 0; j < D / 256; ++j) s[r] += (v[r][j][0] * v[r][j][0] + v[r][j][1] * v[r][j][1]) + (v[r][j][2] * v[r][j][2] + v[r][j][3] * v[r][j][3]);
#pragma unroll
    for (int o = 1; o < 64; o <<= 1)
#pragma unroll
        for (int r = 0; r < NR; ++r) s[r] += __shfl_xor(s[r], o);
#pragma unroll
    for (int j = 0; j < D / 256; ++j) { const int col = 4 * lane + 256 * j; const f32x4 g = *(const f32x4*)(gain + col), a = *(const f32x4*)(sc + col), b = *(const f32x4*)(sh + col);
#pragma unroll
        for (int r = 0; r < NR; ++r) { const float rs = 1.0f / sqrtf(s[r] * (1.0f / D) + EPS); const f32x4 o = v[r][j] * rs * g * (1.0f + a) + b; u32x2 w; w.x = cvt_pk_bf16(o[0], o[1]); w.y = cvt_pk_bf16(o[2], o[3]);
            *(u32x2*)(HM + (size_t)(m0 + r) * D + col) = w;
            if (HM8) *(unsigned*)(HM8 + (size_t)(m0 + r) * D + col) = pg8::pack_fp8x4(o[0] * pg8::F8_H, o[1] * pg8::F8_H, o[2] * pg8::F8_H, o[3] * pg8::F8_H); } }
}
__device__ __forceinline__ void modulate_phase(Frame& F, const float* X, const float* gain, const float* sc, const float* sh) {
    const int gw = F.vcu * NWAVES + F.wave, NGW = F.G * NWAVES;
    for (int m0 = 4 * gw; m0 < M; m0 += 4 * NGW) { const int b = m0 / S;
        modulate_rows<4>(X, m0, gain, sc + (size_t)b * 6 * D, sh + (size_t)b * 6 * D, (bf16_t*)(F.c.ws + WS_HM), nullptr, F.lane()); }
}
__device__ __forceinline__ void skinny32x64(Frame& F, const bf16_t* A, const bf16_t* Bt) {
    const int r = F.lane() & 31, h = F.lane() >> 5; constexpr int KW = D / NWAVES; const int k0 = F.wave * KW;
    f32x16 acc0 = {}, acc1 = {};
    const bf16_t* ap = A + (size_t)r * D + k0 + 8 * h; const bf16_t* b0p = Bt + (size_t)r * D + k0 + 8 * h; const bf16_t* b1p = Bt + (size_t)(32 + r) * D + k0 + 8 * h;
#pragma unroll 8
    for (int s = 0; s < KW / 16; ++s) { const bf16x8 a = *(const bf16x8*)(ap + 16 * s), b0 = *(const bf16x8*)(b0p + 16 * s), b1 = *(const bf16x8*)(b1p + 16 * s);
        acc0 = __builtin_amdgcn_mfma_f32_32x32x16_bf16(a, b0, acc0, 0, 0, 0); acc1 = __builtin_amdgcn_mfma_f32_32x32x16_bf16(a, b1, acc1, 0, 0, 0); }
    LAS float* red = (LAS float*)F.lds;
#pragma unroll
    for (int q = 0; q < 16; ++q) { const int row = (q & 3) + 8 * (q >> 2) + 4 * h; red[(F.wave * 32 + row) * 64 + r] = acc0[q]; red[(F.wave * 32 + row) * 64 + 32 + r] = acc1[q]; }
    __syncthreads();
    LAS float* res = (LAS float*)(F.lds + 65536);
    { const int row = F.tid() >> 4, c4 = (F.tid() & 15) * 4; f32x4 s = *(const LAS f32x4*)(red + row * 64 + c4);
#pragma unroll
      for (int w = 1; w < NWAVES; ++w) s += *(const LAS f32x4*)(red + (w * 32 + row) * 64 + c4);
      *(LAS f32x4*)(res + row * 64 + c4) = s; }
    __syncthreads();
}
__device__ __forceinline__ void krope_units(Frame& F) {
    const Ctx& c = F.c;
    for (int u = F.vcu; u < M / 32; u += F.G) { const int row0 = u * 32;
        skinny32x64(F, WSP(bf16_t, WS_HM) + (size_t)row0 * D, WSP(bf16_t, W_INAB) + (size_t)P0_N * D);
        const LAS float* res = (const LAS float*)(F.lds + 65536);
        { const int row = F.tid() >> 4, i0 = (F.tid() & 15) * 2; const int m = row0 + row, t = m % S; float o1[2], o2[2];
#pragma unroll
          for (int q = 0; q < 2; ++q) { const int ii = i0 + q; const float x1 = res[row * 64 + ii], x2 = res[row * 64 + 32 + ii], cs = WSP(float, WS_TAB + TAB_CR)[t * (ROPE / 2) + ii], sn = WSP(float, WS_TAB + TAB_SR)[t * (ROPE / 2) + ii];
              o1[q] = x1 * cs - x2 * sn; o2[q] = x2 * cs + x1 * sn; }
          const unsigned w1 = cvt_pk_bf16(o1[0], o1[1]), w2 = cvt_pk_bf16(o2[0], o2[1]);
#pragma unroll
          for (int hh = 0; hh < H_A; ++hh) { bf16_t* K = WSP(bf16_t, WS_KC) + ((size_t)m * H_A + hh) * QK + NOPE; *(unsigned*)(K + i0) = w1; *(unsigned*)(K + ROPE / 2 + i0) = w2; } }
        __syncthreads();
    }
}
__device__ __forceinline__ float wave_max(float v) {
#pragma unroll
    for (int o = 1; o < 64; o <<= 1) v = fmaxf(v, __shfl_xor(v, o));
    return v; }
__device__ __forceinline__ void route_phase(Frame& F, int l) {
    const Ctx& c = F.c; const float* mod = WSP(float, WS_MOD) + (size_t)l * NB * 6 * D; const float* X1 = WSP(float, WS_X1);
    for (int u = F.vcu; u < M / 32; u += F.G) { const int row0 = u * 32;
        { const int m0 = row0 + F.wave * 4; const int b = m0 / S;
          modulate_rows<4>(X1, m0, c.in[I_NFFN] + l * D, mod + (size_t)b * 6 * D + 4 * D, mod + (size_t)b * 6 * D + 3 * D, WSP(bf16_t, WS_HM), WSP(unsigned char, WS_HM8), F.lane()); }
        __syncthreads();
        skinny32x64(F, WSP(bf16_t, WS_HM) + (size_t)row0 * D, WSP(bf16_t, W_RT) + (size_t)l * E * D);
        const LAS float* res = (const LAS float*)(F.lds + 65536);
        int* cnt = WSP(int, CTL_CNT); LAS int* lcnt = (LAS int*)(F.lds + 65536 + 8192);
        if (F.tid() < E) lcnt[F.tid()] = 0;
        __syncthreads();
        int pe[4], pr[4]; float pw[4];
        { const int lane = F.lane(), grp = lane >> 3; float sg[4], bz[4], gs[4]; unsigned gsel[4]; const float rb = c.in[I_RBIAS][l * E + lane];
#pragma unroll
          for (int q = 0; q < 4; ++q) { const int row = F.wave * 4 + q; sg[q] = 1.0f / (1.0f + expf(-res[row * 64 + lane])); bz[q] = sg[q] + rb; }
          { float m1[4], m2[4];
#pragma unroll
            for (int q = 0; q < 4; ++q) m1[q] = bz[q];
#pragma unroll
            for (int o = 1; o < 8; o <<= 1)
#pragma unroll
                for (int q = 0; q < 4; ++q) m1[q] = fmaxf(m1[q], __shfl_xor(m1[q], o));
#pragma unroll
            for (int q = 0; q < 4; ++q) { const unsigned long long eq1 = __ballot(bz[q] == m1[q]); const int first = __builtin_ctz((unsigned)((eq1 >> (grp * 8)) & 0xffull)); m2[q] = ((lane & 7) == first) ? -INFINITY : bz[q]; }
#pragma unroll
            for (int o = 1; o < 8; o <<= 1)
#pragma unroll
                for (int q = 0; q < 4; ++q) m2[q] = fmaxf(m2[q], __shfl_xor(m2[q], o));
#pragma unroll
            for (int q = 0; q < 4; ++q) { gs[q] = m1[q] + m2[q]; gsel[q] = 0u; } }
#pragma unroll 1
          for (int it = 0; it < TG; ++it) { float cand[4], mx[4];
#pragma unroll
              for (int q = 0; q < 4; ++q) { cand[q] = ((gsel[q] >> grp) & 1u) ? -INFINITY : gs[q]; mx[q] = cand[q]; }
#pragma unroll
              for (int o = 1; o < 64; o <<= 1)
#pragma unroll
                  for (int q = 0; q < 4; ++q) mx[q] = fmaxf(mx[q], __shfl_xor(mx[q], o));
#pragma unroll
              for (int q = 0; q < 4; ++q) { const unsigned long long eq = __ballot(cand[q] == mx[q]); gsel[q] |= 1u << (__builtin_ctzll(eq) >> 3); } }
          unsigned long long taken[4]; float wsum[4], my_s[4]; int my_e[4];
#pragma unroll
          for (int q = 0; q < 4; ++q) { taken[q] = 0ull; wsum[q] = 0.f; my_s[q] = 0.f; my_e[q] = 0; }
#pragma unroll 1
          for (int k = 0; k < TOPK; ++k) { float cand[4], mx[4];
#pragma unroll
              for (int q = 0; q < 4; ++q) { cand[q] = (((gsel[q] >> grp) & 1u) && !((taken[q] >> lane) & 1ull)) ? bz[q] : -INFINITY; mx[q] = cand[q]; }
#pragma unroll
              for (int o = 1; o < 64; o <<= 1)
#pragma unroll
                  for (int q = 0; q < 4; ++q) mx[q] = fmaxf(mx[q], __shfl_xor(mx[q], o));
#pragma unroll
              for (int q = 0; q < 4; ++q) { const unsigned long long eq = __ballot(cand[q] == mx[q]); const int ek = __builtin_ctzll(eq); taken[q] |= 1ull << ek; const float sk = __shfl(sg[q], ek); wsum[q] += sk; if (lane == k) { my_e[q] = ek; my_s[q] = sk; } } }
#pragma unroll
          for (int q = 0; q < 4; ++q) { pe[q] = my_e[q]; pw[q] = my_s[q] / wsum[q] * 2.5f; pr[q] = 0;
              if (lane < TOPK) pr[q] = __hip_atomic_fetch_add(lcnt + my_e[q], 1, __ATOMIC_RELAXED, __HIP_MEMORY_SCOPE_WORKGROUP); } }
        __syncthreads();
        if (F.tid() < E) { const int n = lcnt[F.tid()]; lcnt[E + F.tid()] = n > 0 ? atomicAdd(cnt + cnt_idx(l, F.tid()), n) : 0; }
        __syncthreads();
#pragma unroll
        for (int q = 0; q < 4; ++q) { const int m = row0 + F.wave * 4 + q; const int lane = F.lane();
            if (lane < TOPK) { const int rank = lcnt[E + pe[q]] + pr[q];
                WSP(int, WS_SELE)[(size_t)m * TOPK + lane] = pe[q]; WSP(int, WS_SELR)[(size_t)m * TOPK + lane] = rank; WSP(float, WS_SELW)[(size_t)m * TOPK + lane] = pw[q];
                WSP(int, WS_TOK)[(size_t)pe[q] * M + rank] = m; WSP(float, WS_WT)[(size_t)pe[q] * M + rank] = pw[q]; } }
        __syncthreads();
    }
}
__device__ __forceinline__ void combine_phase(Frame& F, int l) {
    build_offt(F, l);
    const Ctx& c = F.c; const LAS int* offt = (const LAS int*)(F.lds + TAB_OFF); const float* X1 = WSP(float, WS_X1); float* X2 = WSP(float, WS_X2);
    const float* mod = WSP(float, WS_MOD) + (size_t)l * NB * 6 * D; const float* mod1 = WSP(float, WS_MOD) + (size_t)NB * 6 * D;
    const int gw = F.vcu * NWAVES + F.wave, NGW = F.G * NWAVES; static_assert(D == 2048, "lane l owns columns 16 l .. 16 l + 15 of each 1024-column half");
    for (int m = gw; m < M; m += NGW) { const int b = m / S; const int lane = F.lane();
        int e = 0, r = 0; float wsel = 1.0f; if (lane < TOPK) { e = WSP(int, WS_SELE)[(size_t)m * TOPK + lane]; r = WSP(int, WS_SELR)[(size_t)m * TOPK + lane]; wsel = WSP(float, WS_SELW)[(size_t)m * TOPK + lane]; }
        long rowi = (lane < TOPK) ? (long)offt[e] * RT + r : (long)offt[E] * RT + m;
        f32x4 acc[2][4];
#pragma unroll
        for (int h = 0; h < 2; ++h)
#pragma unroll
            for (int q = 0; q < 4; ++q) acc[h][q] = (f32x4){0.f, 0.f, 0.f, 0.f};
#pragma unroll 3
        for (int k = 0; k <= TOPK; ++k) { const long ri = __shfl(rowi, k); const float wk = __shfl(wsel, k); const unsigned char* yr = WSP(unsigned char, WS_Y) + (size_t)ri * D + 16 * lane;
#pragma unroll
            for (int h = 0; h < 2; ++h) { const v4u raw = __builtin_nontemporal_load((const v4u*)(yr + h * 1024));
#pragma unroll
                for (int q = 0; q < 4; ++q) { const auto lo = __builtin_amdgcn_cvt_pk_f32_fp8((int)raw[q], false), hi = __builtin_amdgcn_cvt_pk_f32_fp8((int)raw[q], true);
                    acc[h][q][0] += wk * lo[0]; acc[h][q][1] += wk * lo[1]; acc[h][q][2] += wk * hi[0]; acc[h][q][3] += wk * hi[1]; } } }
        float s = 0.f;
#pragma unroll
        for (int h = 0; h < 2; ++h)
#pragma unroll
            for (int q = 0; q < 4; ++q) { const int col = h * 1024 + 16 * lane + 4 * q; const f32x4 x = *(const f32x4*)(X1 + (size_t)m * D + col), g = *(const f32x4*)(mod + (size_t)b * 6 * D + 5 * D + col);
                acc[h][q] = x + g * (acc[h][q] * (1.0f / pg8::F8_Y)); s += (acc[h][q][0] * acc[h][q][0] + acc[h][q][1] * acc[h][q][1]) + (acc[h][q][2] * acc[h][q][2] + acc[h][q][3] * acc[h][q][3]);
                if (l == 0) *(f32x4*)(X2 + (size_t)m * D + col) = acc[h][q]; }
        const float rs = 1.0f / sqrtf(wave_sum(s) * (1.0f / D) + EPS);
#pragma unroll
        for (int h = 0; h < 2; ++h) {
            if (l == 0) { v4u w[2];
#pragma unroll
                for (int q = 0; q < 4; ++q) { const int col = h * 1024 + 16 * lane + 4 * q; const f32x4 g = *(const f32x4*)(c.in[I_NMIX] + D + col), a = *(const f32x4*)(mod1 + (size_t)b * 6 * D + D + col), bb = *(const f32x4*)(mod1 + (size_t)b * 6 * D + col);
                    const f32x4 o = acc[h][q] * rs * g * (1.0f + a) + bb; w[q >> 1][2 * (q & 1)] = cvt_pk_bf16(o[0], o[1]); w[q >> 1][2 * (q & 1) + 1] = cvt_pk_bf16(o[2], o[3]); }
                bf16_t* hp = WSP(bf16_t, WS_HM) + (size_t)m * D + h * 1024 + 16 * lane; *(v4u*)hp = w[0]; *(v4u*)(hp + 8) = w[1]; }
            else {
#pragma unroll
                for (int q = 0; q < 4; ++q) { const int col = h * 1024 + 16 * lane + 4 * q; const f32x4 g = *(const f32x4*)(c.in[I_FNORM] + col); *(f32x4*)(c.out + (size_t)m * D + col) = acc[h][q] * rs * g; } } }
    }
}
__device__ __forceinline__ void retnorm_phase(Frame& F) {
    const Ctx& c = F.c; const int gw = F.vcu * NWAVES + F.wave, NGW = F.G * NWAVES; static_assert(DK == 256, "one f32x4 per lane");
    for (int m0 = gw; m0 < M; m0 += 2 * NGW) { f32x4 v[2][H_C], g[H_C]; u32x2 raw[2][H_C]; float s[2][H_C];
#pragma unroll
        for (int h = 0; h < H_C; ++h) g[h] = *(const f32x4*)(c.in[I_RETGN] + h * DK + 4 * F.lane());
#pragma unroll
        for (int r = 0; r < 2; ++r) { const int m = m0 + r * NGW; const bool ok = m < M;
#pragma unroll
            for (int h = 0; h < H_C; ++h) { const int col = h * DK + 4 * F.lane(); v[r][h] = (f32x4){0.f, 0.f, 0.f, 0.f}; raw[r][h] = (u32x2){0u, 0u};
                if (ok) { v[r][h] = *(const f32x4*)(WSP(float, WS_RET) + (size_t)m * HALF + col); raw[r][h] = *(const u32x2*)(WSP(bf16_t, WS_PROJ) + (size_t)m * CD_N + 3 * H_C * DK + col); }
                s[r][h] = (v[r][h][0] * v[r][h][0] + v[r][h][1] * v[r][h][1]) + (v[r][h][2] * v[r][h][2] + v[r][h][3] * v[r][h][3]); } }
#pragma unroll
        for (int o = 1; o < 64; o <<= 1)
#pragma unroll
            for (int r = 0; r < 2; ++r)
#pragma unroll
                for (int h = 0; h < H_C; ++h) s[r][h] += __shfl_xor(s[r][h], o);
#pragma unroll
        for (int r = 0; r < 2; ++r) { const int m = m0 + r * NGW; if (m < M) {
#pragma unroll
            for (int h = 0; h < H_C; ++h) { const int col = h * DK + 4 * F.lane(); const float rs = 1.0f / sqrtf(s[r][h] * (1.0f / DK) + EPS); f32x4 o = v[r][h] * rs * g[h];
                o[0] *= __uint_as_float(raw[r][h].x << 16); o[1] *= __uint_as_float(raw[r][h].x & 0xffff0000u); o[2] *= __uint_as_float(raw[r][h].y << 16); o[3] *= __uint_as_float(raw[r][h].y & 0xffff0000u);
                u32x2 w; w.x = cvt_pk_bf16(o[0], o[1]); w.y = cvt_pk_bf16(o[2], o[3]); *(u32x2*)(WSP(bf16_t, WS_MIX) + (size_t)m * D + col) = w; } } } }
}
__device__ __forceinline__ void scan_phase(Frame& F) {
    const Ctx& c = F.c; constexpr int NCK = 64, CL = S / NCK, BLK = S * 16 + NCK * 16; static_assert(CL == 32 && 4 * BLK + 4 * NCK * 8 * 4 <= MISC_OFF, "scan LDS map");
    LAS unsigned char* lds = F.lds; LAS float* agg = (LAS float*)(lds + 4 * BLK);
#define SIDX(t) ((t) * 16 + ((t) >> 5) * 16)
    for (int u = F.vcu; u < NB * (LW / 8); u += F.G) { const int b = u / (LW / 8), c8 = u % (LW / 8);
        v4u gvp[S / NTHR];
#pragma unroll
        for (int i = 0; i < S / NTHR; ++i) { const int t = F.tid() + NTHR * i; gvp[i] = *(const v4u*)(WSP(bf16_t, WS_PROJ) + ((size_t)b * S + t) * P0_N + QR + KVR + LW + c8 * 8); }
#pragma unroll
        for (int q = 0; q < 4; ++q) { const bf16_t* src = (q & 1 ? WSP(bf16_t, WS_U) : WSP(bf16_t, WS_LA)) + lru_idx(q >> 1, b, 0, c8 * 8);
#pragma unroll
            for (int i = 0; i < S / NTHR; ++i) { const int t = F.tid() + NTHR * i; *(LAS v4u*)(lds + q * BLK + SIDX(t)) = *(const v4u*)(src + (size_t)t * 8); } }
        __syncthreads();
        const int ch = F.tid() & 7, ck = F.tid() >> 3; const LAS bf16_t* laf = (const LAS bf16_t*)(lds) + ch; const LAS bf16_t* uf = (const LAS bf16_t*)(lds + BLK) + ch;
        const LAS bf16_t* lab = (const LAS bf16_t*)(lds + 2 * BLK) + ch; const LAS bf16_t* ub = (const LAS bf16_t*)(lds + 3 * BLK) + ch;
        { float P = 1.f, H = 0.f;
#pragma unroll 8
          for (int i = 0; i < CL; ++i) { const int o = SIDX(ck * CL + i) / 2; const float a = __builtin_amdgcn_exp2f(LOG2E * bf2f(laf[o])); H = a * H + bf2f(uf[o]); P *= a; }
          agg[(0 * NCK + ck) * 8 + ch] = P; agg[(1 * NCK + ck) * 8 + ch] = H; P = 1.f; H = 0.f;
#pragma unroll 8
          for (int i = CL - 1; i >= 0; --i) { const int o = SIDX(ck * CL + i) / 2; const float a = __builtin_amdgcn_exp2f(LOG2E * bf2f(lab[o])); H = a * H + bf2f(ub[o]); P *= a; }
          agg[(2 * NCK + ck) * 8 + ch] = P; agg[(3 * NCK + ck) * 8 + ch] = H; }
        __syncthreads();
        static_assert(NCK == 64 && NWAVES == 8, "one lane per chunk, two (direction, channel) carries per wave");
#pragma unroll
        for (int i = 0; i < 2; ++i) { const int id = F.wave * 2 + i, dir = id >> 3, cc = id & 7; const int lane = F.lane(), k = dir ? NCK - 1 - lane : lane;
            float A = agg[((2 * dir) * NCK + k) * 8 + cc], B = agg[((2 * dir + 1) * NCK + k) * 8 + cc];
#pragma unroll
            for (int o = 1; o < 64; o <<= 1) { const float A2 = __shfl_up(A, o), B2 = __shfl_up(B, o); if (lane >= o) { B = A * B2 + B; A = A * A2; } }
            const float ex = __shfl_up(B, 1); agg[((2 * dir) * NCK + k) * 8 + cc] = lane ? ex : 0.f; }
        __syncthreads();
        { float hf[CL]; float H = agg[(0 * NCK + ck) * 8 + ch];
#pragma unroll
          for (int i = 0; i < CL; ++i) { const int o = SIDX(ck * CL + i) / 2; const float a = __builtin_amdgcn_exp2f(LOG2E * bf2f(laf[o])); H = a * H + bf2f(uf[o]); hf[i] = H; }
          H = agg[(2 * NCK + ck) * 8 + ch]; LAS bf16_t* so = (LAS bf16_t*)(lds + BLK) + ch;
#pragma unroll
          for (int i = CL - 1; i >= 0; --i) { const int o = SIDX(ck * CL + i) / 2; const float a = __builtin_amdgcn_exp2f(LOG2E * bf2f(lab[o])); H = a * H + bf2f(ub[o]); so[o] = f2bf(hf[i] + H); } }
        __syncthreads();
#pragma unroll
        for (int i = 0; i < S / NTHR; ++i) { const int t = F.tid() + NTHR * i; const size_t m = (size_t)b * S + t; const v4u sv = *(const LAS v4u*)(lds + BLK + SIDX(t)); const v4u gv = gvp[i];
            v4u o;
#pragma unroll
            for (int q = 0; q < 4; ++q) { const float a0 = __uint_as_float(sv[q] << 16) * __uint_as_float(gv[q] << 16), a1 = __uint_as_float(sv[q] & 0xffff0000u) * __uint_as_float(gv[q] & 0xffff0000u); o[q] = cvt_pk_bf16(a0, a1); }
            *(v4u*)(WSP(bf16_t, WS_MIX) + m * D + HALF + c8 * 8) = o; }
        __syncthreads();
    }
#undef SIDX
}
namespace attn {
#define ATT_KSWZ(row, colB, RS) ((row) * (RS) + ((colB) ^ (((row) & 7) << 4)))
__device__ __forceinline__ int crow(int r, int hi) { return (r & 3) + 8 * (r >> 2) + 4 * hi; }
__device__ __forceinline__ int v_st(int k, int c) { const int kk = (k & ~0xC) | ((k & 4) << 1) | ((k & 8) >> 1); return ((kk >> 3) * 4 + (c >> 5)) * 512 + ((kk & 7) * 32 + (c & 31)) * 2; }
__device__ __forceinline__ int v_rd_base(int lane) { return ((lane & 3) << 3) | (((lane >> 2) & 3) << 6) | (((lane >> 4) & 1) << 5) | (((lane >> 5) & 1) << 8); }
constexpr int v_rd_off(int d0, int ks, int half) { return d0 * 512 + ks * 4096 + half * 2048; }
template <int OFF> __device__ __forceinline__ s16x4 tr_read(int vb) { s16x4 r; asm volatile("ds_read_b64_tr_b16 %0, %1 offset:%2" : "=&v"(r) : "v"(vb), "i"(OFF) : "memory"); return r; }
template <int D0> __device__ __forceinline__ void pv_one(f32x16& od, int vb, bf16x8 pa0, bf16x8 pa1, bf16x8 pa2, bf16x8 pa3) {
    const s16x4 l0 = tr_read<v_rd_off(D0, 0, 0)>(vb), h0 = tr_read<v_rd_off(D0, 0, 1)>(vb), l1 = tr_read<v_rd_off(D0, 1, 0)>(vb), h1 = tr_read<v_rd_off(D0, 1, 1)>(vb);
    const s16x4 l2 = tr_read<v_rd_off(D0, 2, 0)>(vb), h2 = tr_read<v_rd_off(D0, 2, 1)>(vb), l3 = tr_read<v_rd_off(D0, 3, 0)>(vb), h3 = tr_read<v_rd_off(D0, 3, 1)>(vb);
    asm volatile("s_waitcnt lgkmcnt(0)" ::: "memory"); __builtin_amdgcn_sched_barrier(0);
#define ATT_PK(L, H) (bf16x8){L[0], L[1], L[2], L[3], H[0], H[1], H[2], H[3]}
    od = __builtin_amdgcn_mfma_f32_32x32x16_bf16(pa0, ATT_PK(l0, h0), od, 0, 0, 0);
    od = __builtin_amdgcn_mfma_f32_32x32x16_bf16(pa1, ATT_PK(l1, h1), od, 0, 0, 0);
    od = __builtin_amdgcn_mfma_f32_32x32x16_bf16(pa2, ATT_PK(l2, h2), od, 0, 0, 0);
    od = __builtin_amdgcn_mfma_f32_32x32x16_bf16(pa3, ATT_PK(l3, h3), od, 0, 0, 0);
#undef ATT_PK
}
template <int DQK, int MODE>
__device__ __forceinline__ void attn_unit(LAS unsigned char* lds, const int wave, const bf16_t* Qb, int ldq, const bf16_t* Kh, int ldk, const bf16_t* Vh, int ldv, int key0, int ntiles, int q0,
                                          float pa_, float pb_, bf16_t* Ob, float* Of, int ldo) {
    constexpr int KB = 64 * DQK * 2, VB = 64 * 128 * 2, NKP = DQK / 8, KPT = DQK / 64, RS = DQK * 2;
    constexpr int OFF_V = 2 * KB, OFF_WS = OFF_V + 2 * VB, OFF_LUT = OFF_WS + NWAVES * 64 * 4;
    const int wid = __builtin_amdgcn_readfirstlane(wave), lane = lane_id(), tid = wid * 64 + lane, r32 = lane & 31, hi = lane >> 5;
    LAS unsigned char* Kl = lds; LAS unsigned char* Vl = lds + OFF_V; LAS float* wsf = (LAS float*)(lds + OFF_WS) + wid * 64; const LAS float* lut = (const LAS float*)(lds + OFF_LUT);
    float m_reg = (MODE == 1) ? pa_ : -1e30f, l_reg = (MODE == 1) ? 1.0f : 0.f;
    f32x16 o[4] = {}; bf16x8 qr[DQK / 16];
    { const bf16_t* Qw = Qb + (size_t)(wid * 32 + r32) * ldq + hi * 8;
#pragma unroll
      for (int d0 = 0; d0 < DQK / 16; ++d0) qr[d0] = *(const bf16x8*)(Qw + d0 * 16); }
    constexpr bool REGK = (NTHR % NKP == 0) && ((NTHR / NKP) % 8 == 0);
    int koff[REGK ? 1 : KPT], kdst[REGK ? 1 : KPT];
#pragma unroll
    for (int i = 0; i < (REGK ? 1 : KPT); ++i) { const int p = tid + NTHR * i, key = p / NKP, c8 = p % NKP; koff[i] = key * ldk + c8 * 8; kdst[i] = ATT_KSWZ(key, c8 * 16, RS); }
#define ATT_KOFF(i) (REGK ? koff[0] + (i) * (NTHR / NKP) * ldk : koff[REGK ? 0 : (i)])
#define ATT_KDST(i) (REGK ? kdst[0] + (i) * (NTHR / NKP) * RS : kdst[REGK ? 0 : (i)])
    const int sr = tid >> 4, sc = (tid & 15) * 8, vst0 = v_st(sr, sc), vst1 = vst0 + 8192;
    const int vb0 = (int)(unsigned)(uintptr_t)Vl + v_rd_base(lane);
    bf16x8 ks[KPT], vs0, vs1;
#define ATT_SLOAD(kb) do { _Pragma("unroll") for (int i = 0; i < KPT; ++i) ks[i] = *(const bf16x8*)(Kh + (size_t)(kb) * ldk + ATT_KOFF(i)); \
        vs0 = *(const bf16x8*)(Vh + (size_t)((kb) + sr) * ldv + sc); vs1 = *(const bf16x8*)(Vh + (size_t)((kb) + 32 + sr) * ldv + sc); } while (0)
#define ATT_SWRITE(b) do { _Pragma("unroll") for (int i = 0; i < KPT; ++i) *(LAS bf16x8*)(Kl + (b) * KB + ATT_KDST(i)) = ks[i]; \
        *(LAS bf16x8*)(Vl + (b) * VB + vst0) = vs0; *(LAS bf16x8*)(Vl + (b) * VB + vst1) = vs1; } while (0)
    ATT_SLOAD(key0); ATT_SWRITE(0); __syncthreads();
    for (int j = 0; j < ntiles; ++j) {
        const int cur = j & 1; const int kb = key0 + j * 64;
        if (j + 1 < ntiles) ATT_SLOAD(kb + 64);
        bool live = true;
        if constexpr (MODE == 1) { const int qlo = q0 + wid * 32; live = (kb + 63 >= qlo - WIN) && (kb <= qlo + 31 + WIN); }
        if (live) {
        f32x16 p0 = {}, p1 = {};
        { const LAS unsigned char* Ks = Kl + cur * KB;
#pragma unroll
          for (int d0 = 0; d0 < DQK / 16; ++d0) { const int cb = (d0 * 16 + hi * 8) * 2;
              const bf16x8 b0 = *(const LAS bf16x8*)(Ks + ATT_KSWZ(r32, cb, RS)), b1 = *(const LAS bf16x8*)(Ks + ATT_KSWZ(32 + r32, cb, RS));
              p0 = __builtin_amdgcn_mfma_f32_32x32x16_bf16(b0, qr[d0], p0, 0, 0, 0); p1 = __builtin_amdgcn_mfma_f32_32x32x16_bf16(b1, qr[d0], p1, 0, 0, 0); } }
        if constexpr (MODE == 2) {
            const int dq = kb - (q0 + wid * 32 + r32);
#pragma unroll
            for (int r = 0; r < 16; ++r) { const int rel0 = dq + crow(r, hi), rel1 = rel0 + 32;
                p0[r] *= __builtin_amdgcn_exp2f((rel0 <= 0 ? pa_ : pb_) * (float)rel0); p1[r] *= __builtin_amdgcn_exp2f((rel1 <= 0 ? pa_ : pb_) * (float)rel1); }
        } else {
            if constexpr (MODE == 1) { const LAS float* lp = lut + (kb - (q0 + wid * 32 + r32) + 383);
#pragma unroll
                for (int r = 0; r < 16; ++r) { p0[r] += lp[crow(r, hi)]; p1[r] += lp[32 + crow(r, hi)]; } }
            float pmax = p0[0];
#pragma unroll
            for (int r = 1; r < 16; ++r) pmax = fmaxf(pmax, p0[r]);
#pragma unroll
            for (int r = 0; r < 16; ++r) pmax = fmaxf(pmax, p1[r]);
            { auto rr = __builtin_amdgcn_permlane32_swap(__float_as_uint(pmax), __float_as_uint(pmax), false, false); pmax = fmaxf(__uint_as_float(rr[0]), __uint_as_float(rr[1])); }
            float mn, alpha;
            if (__builtin_expect(__all(pmax - m_reg <= 11.5f), 1)) { mn = m_reg; alpha = 1.f; }
            else { mn = fmaxf(m_reg, pmax); alpha = __builtin_amdgcn_exp2f(m_reg - mn); m_reg = mn; }
#pragma unroll
            for (int r = 0; r < 16; ++r) { p0[r] = __builtin_amdgcn_exp2f(p0[r] - mn); p1[r] = __builtin_amdgcn_exp2f(p1[r] - mn); }
            float ps = 0.f;
#pragma unroll
            for (int r = 0; r < 16; ++r) ps += p0[r];
#pragma unroll
            for (int r = 0; r < 16; ++r) ps += p1[r];
            { auto rr = __builtin_amdgcn_permlane32_swap(__float_as_uint(ps), __float_as_uint(ps), false, false); ps = __uint_as_float(rr[0]) + __uint_as_float(rr[1]); }
            l_reg = l_reg * alpha + ps;
            if (__any(alpha < 1.f)) { if (hi == 0) wsf[32 + r32] = alpha; asm volatile("s_waitcnt lgkmcnt(0)" ::: "memory");
#pragma unroll
                for (int r = 0; r < 16; ++r) { const float a = wsf[32 + crow(r, hi)];
#pragma unroll
                    for (int d = 0; d < 4; ++d) o[d][r] *= a; } }
        }
        bf16x8 pa0, pa1, pa2, pa3;
#define ATT_PK4(P, BASE, OUT) do { unsigned a0 = cvt_pk_bf16(P[BASE + 0], P[BASE + 1]), a1 = cvt_pk_bf16(P[BASE + 2], P[BASE + 3]); \
        unsigned b0_ = cvt_pk_bf16(P[BASE + 4], P[BASE + 5]), b1_ = cvt_pk_bf16(P[BASE + 6], P[BASE + 7]); \
        auto r0 = __builtin_amdgcn_permlane32_swap(a0, b0_, false, false); auto r1 = __builtin_amdgcn_permlane32_swap(a1, b1_, false, false); \
        v4u w = {r0[0], r1[0], r0[1], r1[1]}; OUT = *reinterpret_cast<bf16x8*>(&w); } while (0)
        ATT_PK4(p0, 0, pa0); ATT_PK4(p0, 8, pa1); ATT_PK4(p1, 0, pa2); ATT_PK4(p1, 8, pa3);
#undef ATT_PK4
        { const int vb = vb0 + cur * VB; pv_one<0>(o[0], vb, pa0, pa1, pa2, pa3); pv_one<1>(o[1], vb, pa0, pa1, pa2, pa3); pv_one<2>(o[2], vb, pa0, pa1, pa2, pa3); pv_one<3>(o[3], vb, pa0, pa1, pa2, pa3); }
        }
        if (j + 1 < ntiles) ATT_SWRITE(cur ^ 1);
        __syncthreads();
    }
#undef ATT_SLOAD
#undef ATT_SWRITE
#undef ATT_KOFF
#undef ATT_KDST
    if constexpr (MODE == 2) {
#pragma unroll
        for (int r = 0; r < 16; ++r) { float* orow = Of + (size_t)(wid * 32 + crow(r, hi)) * ldo + r32;
#pragma unroll
            for (int d0 = 0; d0 < 4; ++d0) orow[d0 * 32] = o[d0][r]; }
    } else {
        if (hi == 0) wsf[r32] = l_reg; asm volatile("s_waitcnt lgkmcnt(0)" ::: "memory");
#pragma unroll
        for (int r = 0; r < 16; ++r) { const float rl = __builtin_amdgcn_rcpf(wsf[crow(r, hi)]); bf16_t* orow = Ob + (size_t)(wid * 32 + crow(r, hi)) * ldo + r32;
#pragma unroll
            for (int d0 = 0; d0 < 4; ++d0) orow[d0 * 32] = f2bf(o[d0][r] * rl); }
    }
    __syncthreads();
}
#undef ATT_KSWZ
}

__device__ __forceinline__ void att0_phase(Frame& F) {
    const Ctx& c = F.c;
    for (int u = F.vcu; u < NB * H_A * (S / 256); u += F.G) { const int qb = u % (S / 256), h = (u / (S / 256)) % H_A, b = u / ((S / 256) * H_A);
        attn::attn_unit<QK, 0>(F.lds, F.wave, WSP(bf16_t, WS_Q) + ((size_t)(b * S + qb * 256) * H_A + h) * QK, H_A * QK, WSP(bf16_t, WS_KC) + ((size_t)b * S * H_A + h) * QK, H_A * QK,
                               WSP(bf16_t, WS_V) + ((size_t)b * S * H_A + h) * VD, H_A * VD, 0, S / 64, qb * 256, 0.f, 0.f, WSP(bf16_t, WS_MIX) + (size_t)(b * S + qb * 256) * D + h * VD, nullptr, D); }
}
__device__ __forceinline__ void ret1_phase(Frame& F) {
    const Ctx& c = F.c;
    for (int u = F.vcu; u < NB * H_C * (S / 256) * 2; u += F.G) { const int dvh = u & 1, qb = (u >> 1) % (S / 256), h = (u / (2 * (S / 256))) % H_C, b = u / (2 * (S / 256) * H_C);
        const bf16_t* Pb = WSP(bf16_t, WS_PROJ) + (size_t)b * S * CD_N;
        const float lgf = log2f(1.0f - exp2f(-5.0f - (float)h)), lgb = log2f(1.0f - exp2f(-5.0f - (float)(H_C - 1 - h)));
        const int df = (int)(11.0f / -lgf) + 1, db = (int)(11.0f / -lgb) + 1; int t0 = (qb * 256 - df - 63) / 64; if (t0 < 0) t0 = 0; int t1 = (qb * 256 + 255 + db) / 64 + 1; if (t1 > S / 64) t1 = S / 64;
        attn::attn_unit<DK, 2>(F.lds, F.wave, Pb + (size_t)qb * 256 * CD_N + h * DK, CD_N, Pb + H_C * DK + h * DK, CD_N, Pb + 2 * H_C * DK + h * DK + dvh * 128, CD_N, t0 * 64, t1 - t0, qb * 256, -lgf, lgb,
                               nullptr, WSP(float, WS_RET) + (size_t)(b * S + qb * 256) * HALF + h * DK + dvh * 128, HALF); }
}
__device__ __forceinline__ void swa1_phase(Frame& F) {
    const Ctx& c = F.c; constexpr int OFF_LUT = 2 * 64 * HDS * 2 + 2 * 64 * 128 * 2 + NWAVES * 64 * 4; LAS float* lut = (LAS float*)(F.lds + OFF_LUT);
    for (int u = F.vcu; u < NB * H_D * (S / 256); u += F.G) { const int qb = u % (S / 256), hd = (u / (S / 256)) % H_D, b = u / ((S / 256) * H_D); const int kvh = hd / (H_D / KVH);
        for (int i = F.tid(); i < 767; i += NTHR) { const int rel = i - 383; lut[i] = (rel < -WIN || rel > WIN) ? -1e30f : c.in[I_RELB][t5_bucket(rel) * H_D + hd] * LOG2E; }
        __syncthreads();
        const bf16_t* Pb = WSP(bf16_t, WS_PROJ) + (size_t)b * S * CD_N + 4 * H_C * DK;
        const int klo = qb * 256 - WIN < 0 ? 0 : qb * 256 - WIN, khi = qb * 256 + 256 + WIN > S ? S : qb * 256 + 256 + WIN;
        attn::attn_unit<HDS, 1>(F.lds, F.wave, Pb + (size_t)qb * 256 * CD_N + hd * HDS, CD_N, Pb + H_D * HDS + kvh * HDS, CD_N, Pb + H_D * HDS + KVH * HDS + kvh * HDS, CD_N, klo, (khi - klo) / 64, qb * 256,
                                c.in[I_SINKS][hd] * LOG2E, 0.f, WSP(bf16_t, WS_MIX) + (size_t)(b * S + qb * 256) * D + HALF + hd * HDS, nullptr, D); }
}


#ifndef OPT_MASK
#define OPT_MASK 0
#endif
struct MArgs { Ctx c; long ph_lo, ph_hi, use_bar, pad; };
__global__ void __launch_bounds__(NTHR, 2) mega_fwd(MArgs args) {
    extern __shared__ __attribute__((aligned(16))) unsigned char lds_raw[];
    Frame F; F.lds = (LAS unsigned char*)lds_raw; F.c = args.c;
    F.wave = __builtin_amdgcn_readfirstlane((int)threadIdx.x >> 6);
    F.G = gridDim.x; { const int bx = blockIdx.x; F.vcu = (F.G % 8 == 0) ? (bx % 8) * (F.G / 8) + bx / 8 : bx; }
    const Ctx& c = F.c;
    volatile LAS unsigned* MISC = (volatile LAS unsigned*)(F.lds + MISC_OFF);
    for (int u = F.tid(); u < 256; u += NTHR) MISC[u] = 0u;
    __syncthreads();
    XcdBarrier bar; bar.bar = (unsigned*)(c.ws + 16384); bar.x = 0; bar.st = MISC + 8; bar.wave = F.wave;
    if (args.use_bar) bar = xcd_barrier_post((unsigned*)(c.ws + 16384), MISC + 8, F.wave);
    const int lo = (int)args.ph_lo, hi = (int)args.ph_hi;
#define IN(k) (lo <= (k) && (k) < hi)
#define SEAM(k) do { if (IN(k) && IN((k) + 1)) xcd_barrier(bar); } while (0)
    float* mod = WSP(float, WS_MOD);
#ifdef SPREAD_CONV
#define CONV_EARLY(call) do { if (!(blockIdx.x & 1)) { call; __syncthreads(); } } while (0)
#define CONV_LATE(call)  do { if (blockIdx.x & 1) { __syncthreads(); call; __syncthreads(); } } while (0)
#else
#define CONV_EARLY(call) do { } while (0)
#define CONV_LATE(call)  do { } while (0)
#endif
#define CONV_GU0(k0, k1) conv_slice(F, IT_GU0, IT_DN0, k0, k1, 20)
#define CONV_GU1(k0, k1) conv_slice(F, IT_GU1, IT_DN1, k0, k1, 17)

    if (IN(PH_P0)) { p0_phase(F); } SEAM(PH_P0);
#ifdef HAVE_THIN
    if (IN(PH_MOD0)) { modulate_phase(F, c.in[I_X], c.in[I_NMIX], mod + D, mod); } SEAM(PH_MOD0);
#endif
    if (IN(PH_G1)) {
        pg8::DenseOrder S_; S_.A = (const char*)WSP(bf16_t, WS_HM); S_.B = (const char*)WSP(bf16_t, W_INAB); S_.nM = M / 256; S_.nN = P0_N / 256; S_.G = F.G; S_.c = (int)blockIdx.x; S_.a_tile = (long)256 * D * 2; S_.b_tile = (long)256 * D * 2;
        pg8::EpiG1 E_{WSP(bf16_t, WS_PROJ), WSP(bf16_t, WS_LXP), WSP(float, CTL_SSQ)};
        pg8::gemm_phase<pg8::EpiG1, pg8::DenseOrder, pg8::APlain, false, true>(F.lds, F.wave, (const char*)c.ws, D, D, D, S_, E_);
#ifdef HAVE_SKINNY
        krope_units(F);
#endif
#ifdef SPREAD_CONV
        if ((int)blockIdx.x >= F.G / 2) { __syncthreads(); const int pi = (int)blockIdx.x - F.G / 2, np = F.G - F.G / 2;
            conv_items(F, IT_OUTAB, IT_GU0, pi, np); conv_slice(F, IT_GU0, IT_DN0, 0, 4, 20, pi, np); __syncthreads(); }
#endif
    } SEAM(PH_G1);
    if (IN(PH_G2)) {
        CONV_EARLY(CONV_GU0(4, 8));
        { pg8::OrderG2 S_{(const char*)WSP(bf16_t, WS_PROJ), (const char*)WSP(bf16_t, W_UQ), (const char*)WSP(bf16_t, W_UKV), F.G, (int)blockIdx.x};
          pg8::EpiG2 E_{WSP(bf16_t, WS_Q), WSP(bf16_t, WS_KC), WSP(bf16_t, WS_V), WSP(float, CTL_SSQ), WSP(float, WS_TAB + TAB_CR), WSP(float, WS_TAB + TAB_SR), LOG2E / sqrtf((float)QK)};
          pg8::gemm_phase<pg8::EpiG2, pg8::OrderG2, pg8::APlain, false, true>(F.lds, F.wave, (const char*)c.ws, P0_N, QR, QR, S_, E_); }
        { pg8::OrderGates S_{(const char*)WSP(bf16_t, WS_LXP), (const char*)WSP(bf16_t, W_LRU), F.G, (int)((blockIdx.x + F.G / 2) % F.G)};
          pg8::EpiGates E_{WSP(bf16_t, WS_LA), WSP(bf16_t, WS_U), WSP(bf16_t, WS_LXP), WSP(float, W_GB), WSP(float, W_GB) + 4 * LW, c.in[I_CONVW], c.in[I_CONVB]};
          pg8::gemm_phase<pg8::EpiGates, pg8::OrderGates, pg8::AConv, false, true>(F.lds, F.wave, (const char*)c.ws, LW, 4 * LBS, 4 * LBS, S_, E_); }
        CONV_LATE(CONV_GU0(4, 8));
    } SEAM(PH_G2);
#ifdef HAVE_THIN
    if (IN(PH_SCAN0)) { scan_phase(F); }
#endif
#ifdef HAVE_ATT0
    if (IN(PH_ATT0)) { CONV_EARLY(CONV_GU0(8, 14)); att0_phase(F); CONV_LATE(CONV_GU0(8, 14)); } SEAM(PH_ATT0);
#endif
    if (IN(PH_OUT0)) {
        CONV_EARLY(CONV_GU0(14, 17));
        pg8::DenseOrder S_; S_.A = (const char*)WSP(bf16_t, WS_MIX); S_.B = (const char*)WSP(bf16_t, W_OUTAB); S_.nM = M / 256; S_.nN = D / 256; S_.G = F.G; S_.c = (int)blockIdx.x; S_.a_tile = (long)256 * D * 2; S_.b_tile = (long)256 * D * 2;
        pg8::EpiOut E_{c.in[I_X], WSP(float, WS_X1), mod + 2 * D};
        pg8::gemm_phase<pg8::EpiOut, pg8::DenseOrder, pg8::APlain, false, true>(F.lds, F.wave, (const char*)c.ws, D, D, D, S_, E_);
        CONV_LATE(CONV_GU0(14, 17));
    } SEAM(PH_OUT0);
#ifdef HAVE_RT
    if (IN(PH_RT0)) { CONV_EARLY(CONV_GU0(17, 20)); route_phase(F, 0); CONV_LATE(CONV_GU0(17, 20)); } SEAM(PH_RT0);
#endif
    if (IN(PH_M1_0)) {
#ifdef SPREAD_CONV
        mod_units(F, 1);
#endif
        CONV_EARLY(conv_items(F, IT_DN0, IT_GU1));
        build_offt(F, 0);
#ifdef MOE_FP8
        typedef pg8::OrderMoeT<2 * FF / 256, true, WS_HM8, W_GU + (size_t)0 * (E + 1) * 2 * FF * D, (long)2 * FF * D, (long)256 * D, 0> OM1;
#ifdef MOE_CONTIG
        const int tot1_ = ((const LAS int*)(F.lds + TAB_OFF))[E + 1] * (2 * FF / 256), lo1_ = (int)((long)tot1_ * F.vcu / F.G), hi1_ = (int)((long)tot1_ * (F.vcu + 1) / F.G);
        OM1 S_{c.ws, lo1_, hi1_ - lo1_};
#else
        OM1 S_{c.ws, F.G, F.vcu};
#endif
        pg8::EpiM1F8 E_{c.ws};
        pg8::gemm_phase<pg8::EpiM1F8, OM1, pg8::APlain, true, true, 1>(F.lds, F.wave, (const char*)c.ws, D / 2, D / 2, D / 2, S_, E_);
#else
        pg8::OrderMoe S_{(const LAS int*)(F.lds + TAB_OFF), (const char*)WSP(bf16_t, WS_HM), (const char*)WSP(bf16_t, W_GU), WSP(int, WS_TOK), 2 * FF / 256, F.G, F.vcu, 1, (long)2 * FF * D * 2, (long)256 * D * 2, 0};
        pg8::EpiM1 E_{WSP(bf16_t, WS_ACT)};
        pg8::gemm_phase<pg8::EpiM1, pg8::OrderMoe, pg8::APlain, true, true>(F.lds, F.wave, (const char*)c.ws, D, D, D, S_, E_);
#endif
        CONV_LATE(conv_items(F, IT_DN0, IT_GU1));
    } SEAM(PH_M1_0);
    if (IN(PH_M2_0)) { CONV_EARLY(CONV_GU1(0, 4)); build_offt(F, 0);
#ifdef MOE_FP8
        typedef pg8::OrderMoeT<D / 256, false, WS_ACT, W_DN + (size_t)0 * (E + 1) * D * FF, (long)D * FF, (long)256 * FF, (long)256 * FF> OM2;
#ifdef MOE_CONTIG
        const int tot2_ = ((const LAS int*)(F.lds + TAB_OFF))[E + 1] * (D / 256), lo2_ = (int)((long)tot2_ * F.vcu / F.G), hi2_ = (int)((long)tot2_ * (F.vcu + 1) / F.G);
        OM2 S_{c.ws, lo2_, hi2_ - lo2_};
#else
        OM2 S_{c.ws, F.G, F.vcu};
#endif
        pg8::EpiM2F8 E_{c.ws};
        pg8::gemm_phase<pg8::EpiM2F8, OM2, pg8::APlain, false, true, 1>(F.lds, F.wave, (const char*)c.ws, FF / 2, FF / 2, FF / 2, S_, E_);
#else
        pg8::OrderMoe S_{(const LAS int*)(F.lds + TAB_OFF), (const char*)WSP(bf16_t, WS_ACT), (const char*)WSP(bf16_t, W_DN), WSP(int, WS_TOK), D / 256, F.G, F.vcu, 0, (long)D * FF * 2, (long)256 * FF * 2, (long)256 * FF * 2};
        pg8::EpiM2 E_{WSP(bf16_t, WS_Y), WSP(float, WS_WT), (const LAS int*)(F.lds + TAB_OFF), 1.0f};
        pg8::gemm_phase<pg8::EpiM2, pg8::OrderMoe, pg8::APlain, false, true>(F.lds, F.wave, (const char*)c.ws, FF, FF, FF, S_, E_);
#endif
        CONV_LATE(CONV_GU1(0, 4));
    } SEAM(PH_M2_0);
#ifdef HAVE_THIN
    if (IN(PH_CMB0)) { CONV_EARLY(CONV_GU1(4, 6)); combine_phase(F, 0); CONV_LATE(CONV_GU1(4, 6)); } SEAM(PH_CMB0);
#endif
    if (IN(PH_G3)) {
        pg8::DenseOrder S_; S_.A = (const char*)WSP(bf16_t, WS_HM); S_.B = (const char*)WSP(bf16_t, W_INCD); S_.nM = M / 256; S_.nN = CD_N / 256; S_.G = F.G; S_.c = (int)blockIdx.x; S_.a_tile = (long)256 * D * 2; S_.b_tile = (long)256 * D * 2;
        pg8::EpiG3 E_{WSP(bf16_t, WS_PROJ), WSP(float, WS_TAB + TAB_CT), WSP(float, WS_TAB + TAB_ST), LOG2E / sqrtf((float)HDS)};
        pg8::gemm_phase<pg8::EpiG3, pg8::DenseOrder, pg8::APlain, false, true>(F.lds, F.wave, (const char*)c.ws, D, D, D, S_, E_);
#ifdef SPREAD_CONV
        { const int nu = (M / 256) * (CD_N / 256), rem = nu % F.G;
          if (rem != 0 && (int)blockIdx.x >= rem) { __syncthreads(); conv_slice(F, IT_GU1, IT_DN1, 6, 8, 17, (int)blockIdx.x - rem, F.G - rem); __syncthreads(); }
          else if (rem == 0) { __syncthreads(); CONV_GU1(6, 8); __syncthreads(); } }
#endif
    } SEAM(PH_G3);
#ifdef HAVE_RET1
    if (IN(PH_RET1)) { CONV_EARLY(CONV_GU1(8, 12)); ret1_phase(F); CONV_LATE(CONV_GU1(8, 12)); }
#endif
#ifdef HAVE_SWA1
    if (IN(PH_SWA1)) { CONV_EARLY(CONV_GU1(12, 13)); swa1_phase(F); CONV_LATE(CONV_GU1(12, 13)); } SEAM(PH_SWA1);
#endif
#ifdef HAVE_THIN
    if (IN(PH_RN1)) { retnorm_phase(F); } SEAM(PH_RN1);
#endif
    if (IN(PH_OUT1)) {
        CONV_EARLY(CONV_GU1(13, 15));
        pg8::DenseOrder S_; S_.A = (const char*)WSP(bf16_t, WS_MIX); S_.B = (const char*)WSP(bf16_t, W_OUTCD); S_.nM = M / 256; S_.nN = D / 256; S_.G = F.G; S_.c = (int)blockIdx.x; S_.a_tile = (long)256 * D * 2; S_.b_tile = (long)256 * D * 2;
        pg8::EpiOut E_{WSP(float, WS_X2), WSP(float, WS_X1), mod + (size_t)NB * 6 * D + 2 * D};
        pg8::gemm_phase<pg8::EpiOut, pg8::DenseOrder, pg8::APlain, false, true>(F.lds, F.wave, (const char*)c.ws, D, D, D, S_, E_);
        CONV_LATE(CONV_GU1(13, 15));
    } SEAM(PH_OUT1);
#ifdef HAVE_RT
    if (IN(PH_RT1)) { CONV_EARLY(CONV_GU1(15, 17)); route_phase(F, 1); CONV_LATE(CONV_GU1(15, 17)); } SEAM(PH_RT1);
#endif
    if (IN(PH_M1_1)) { CONV_EARLY(conv_items(F, IT_DN1, IT_END)); build_offt(F, 1);
#ifdef MOE_FP8
        typedef pg8::OrderMoeT<2 * FF / 256, true, WS_HM8, W_GU + (size_t)1 * (E + 1) * 2 * FF * D, (long)2 * FF * D, (long)256 * D, 0> OM1;
#ifdef MOE_CONTIG
        const int tot1_ = ((const LAS int*)(F.lds + TAB_OFF))[E + 1] * (2 * FF / 256), lo1_ = (int)((long)tot1_ * F.vcu / F.G), hi1_ = (int)((long)tot1_ * (F.vcu + 1) / F.G);
        OM1 S_{c.ws, lo1_, hi1_ - lo1_};
#else
        OM1 S_{c.ws, F.G, F.vcu};
#endif
        pg8::EpiM1F8 E_{c.ws};
        pg8::gemm_phase<pg8::EpiM1F8, OM1, pg8::APlain, true, true, 1>(F.lds, F.wave, (const char*)c.ws, D / 2, D / 2, D / 2, S_, E_);
#else
        pg8::OrderMoe S_{(const LAS int*)(F.lds + TAB_OFF), (const char*)WSP(bf16_t, WS_HM), (const char*)(WSP(bf16_t, W_GU) + (size_t)(E + 1) * 2 * FF * D), WSP(int, WS_TOK), 2 * FF / 256, F.G, F.vcu, 1, (long)2 * FF * D * 2, (long)256 * D * 2, 0};
        pg8::EpiM1 E_{WSP(bf16_t, WS_ACT)};
        pg8::gemm_phase<pg8::EpiM1, pg8::OrderMoe, pg8::APlain, true, true>(F.lds, F.wave, (const char*)c.ws, D, D, D, S_, E_);
#endif
        CONV_LATE(conv_items(F, IT_DN1, IT_END));
    } SEAM(PH_M1_1);
    if (IN(PH_M2_1)) { build_offt(F, 1);
#ifdef MOE_FP8
        typedef pg8::OrderMoeT<D / 256, false, WS_ACT, W_DN + (size_t)1 * (E + 1) * D * FF, (long)D * FF, (long)256 * FF, (long)256 * FF> OM2;
#ifdef MOE_CONTIG
        const int tot2_ = ((const LAS int*)(F.lds + TAB_OFF))[E + 1] * (D / 256), lo2_ = (int)((long)tot2_ * F.vcu / F.G), hi2_ = (int)((long)tot2_ * (F.vcu + 1) / F.G);
        OM2 S_{c.ws, lo2_, hi2_ - lo2_};
#else
        OM2 S_{c.ws, F.G, F.vcu};
#endif
        pg8::EpiM2F8 E_{c.ws};
        pg8::gemm_phase<pg8::EpiM2F8, OM2, pg8::APlain, false, true, 1>(F.lds, F.wave, (const char*)c.ws, FF / 2, FF / 2, FF / 2, S_, E_);
#else
        pg8::OrderMoe S_{(const LAS int*)(F.lds + TAB_OFF), (const char*)WSP(bf16_t, WS_ACT), (const char*)(WSP(bf16_t, W_DN) + (size_t)(E + 1) * D * FF), WSP(int, WS_TOK), D / 256, F.G, F.vcu, 0, (long)D * FF * 2, (long)256 * FF * 2, (long)256 * FF * 2};
        pg8::EpiM2 E_{WSP(bf16_t, WS_Y), WSP(float, WS_WT), (const LAS int*)(F.lds + TAB_OFF), 1.0f};
        pg8::gemm_phase<pg8::EpiM2, pg8::OrderMoe, pg8::APlain, false, true>(F.lds, F.wave, (const char*)c.ws, FF, FF, FF, S_, E_);
#endif
    } SEAM(PH_M2_1);
#ifdef HAVE_THIN
    if (IN(PH_CMB1)) { combine_phase(F, 1); }
#endif
#undef IN
#undef SEAM
}

extern "C" void kernel_launch(void* const* d_in, const int* in_sizes, int n_in, void* d_out, int out_size, void* d_ws, size_t ws_size, hipStream_t stream) {
    static int grid = 0;
    if (grid == 0) {
        if (n_in != N_IN || out_size != M * D || ws_size < WS_END) { fprintf(stderr, "kernel_launch: unexpected shapes (n_in %d, out %d, ws %zu < %zu)\n", n_in, out_size, ws_size, (size_t)WS_END); grid = -1; return; }
        int dev = 0, cus = 0;
        if (hipGetDevice(&dev) != hipSuccess || hipDeviceGetAttribute(&cus, hipDeviceAttributeMultiprocessorCount, dev) != hipSuccess) { grid = -1; return; }
        if (hipFuncSetAttribute((const void*)mega_fwd, hipFuncAttributeMaxDynamicSharedMemorySize, LDS_BYTES) != hipSuccess) { fprintf(stderr, "kernel_launch: hipFuncSetAttribute failed\n"); grid = -1; return; }
        int per_cu = 0; (void)hipOccupancyMaxActiveBlocksPerMultiprocessor(&per_cu, (const void*)mega_fwd, NTHR, LDS_BYTES); (void)hipGetLastError();
        if (per_cu < 1) fprintf(stderr, "kernel_launch: occupancy query reports %d\n", per_cu);
        grid = cus;
    }
    if (grid < 0) return;
    Ctx c; memset((void*)&c, 0, sizeof(c));
    for (int i = 0; i < N_IN; ++i) c.in[i] = (const float*)d_in[i];
    c.out = (float*)d_out; c.ws = (unsigned char*)d_ws;
    (void)hipMemsetAsync((char*)d_ws + WS_CTL, 0, CTL_BYTES, stream);
    Launcher go{stream};
    const unsigned mask = (unsigned)(OPT_MASK);
    int n_mega = 0; for (int p = 0; p < N_PHASES; ++p) n_mega += (mask >> p) & 1u;
#ifdef FORCE_SPLIT
    const bool one = false;
#else
    const bool one = (mask == (1u << N_PHASES) - 1u);
#endif
    for (int ph = 0; ph < N_PHASES; ) {
        if ((mask >> ph) & 1u) {
            int hi = ph + 1; if (one) hi = N_PHASES;
            MArgs a; memset((void*)&a, 0, sizeof(a)); a.c = c; a.ph_lo = ph; a.ph_hi = hi; a.use_bar = one ? 1 : 0;
            hipLaunchKernelGGL(mega_fwd, dim3(grid), dim3(NTHR), LDS_BYTES, stream, a);
#ifdef DUP_PHASE
            if (!one && ph == (DUP_PHASE)) hipLaunchKernelGGL(mega_fwd, dim3(grid), dim3(NTHR), LDS_BYTES, stream, a);
#endif
            if (!one && (ph == PH_RT0 || ph == PH_RT1)) naive_offt(go, c, ph == PH_RT1);
            ph = hi;
        } else {
            naive_phase(go, c, ph);
            if (ph == PH_RT0 || ph == PH_RT1) naive_offt(go, c, ph == PH_RT1);
            ++ph;
        }
    }
}


#endif
```

```cpp
#define OPT_MASK ((1u<<N_PHASES)-1u)
#define HAVE_THIN 1
#define HAVE_SKINNY 1
#define HAVE_RT 1
#define HAVE_ATT0 1
#define HAVE_RET1 1
#define HAVE_SWA1 1
#define MOE_FP8 1
#define SPREAD_CONV 1
#ifdef HOST_TEST
#include <cmath>
#include <cstring>
#include <cstdio>
#include <cstdint>
#include <cstring>
#include <cstddef>
#define HD inline
#else
#include <hip/hip_runtime.h>
#include <cstdio>
#include <cstdint>
#include <cstring>
#define HD __host__ __device__ __forceinline__
#endif

namespace cfg {
#ifdef HOST_TEST
constexpr int D = 256, NB = 2, S = 256, H_A = 4, NOPE = 16, ROPE = 16, VD = 32, QR = 64, KVR = 64, LW = 128, LBS = 16, H_C = 4, DK = 32, H_D = 8, KVH = 2, HDS = 16, WIN = 64, FF = 32;
#else
constexpr int D = 2048, NB = 4, S = 2048, H_A = 8, NOPE = 128, ROPE = 64, VD = 128, QR = 512, KVR = 512, LW = 1024, LBS = 128, H_C = 4, DK = 256, H_D = 8, KVH = 2, HDS = 128, WIN = 128, FF = 512;
#endif
constexpr int M = NB * S, QK = NOPE + ROPE, E = 64, TOPK = 8, NG = 8, TG = 4;
constexpr int AB_N = QR + KVR + ROPE + 2 * LW, P0_N = QR + KVR + 2 * LW;
constexpr int CD_N = 4 * H_C * DK + H_D * HDS + 2 * KVH * HDS;
constexpr int HALF = D / 2;
constexpr int RT = 256;
constexpr int MAXT = (M * TOPK) / RT + E + M / RT;
constexpr float EPS = 1e-6f, LOG2E = 1.4426950408889634f;
static_assert(H_A * VD == HALF && LW == HALF && H_C * DK == HALF && H_D * HDS == HALF, "half widths");
}
using namespace cfg;

enum { I_X = 0, I_C, I_WMOD, I_BMOD, I_NMIX, I_NFFN, I_FNORM, I_WINAB, I_QLN, I_KVLN, I_WUQ, I_WUKV, I_CONVW, I_CONVB, I_LWA, I_LBA, I_LWX, I_LBX, I_LLAM, I_WOUTAB,
       I_WINCD, I_RETGN, I_SINKS, I_WOUTCD, I_RELB, I_WROUTER, I_RBIAS, I_WGATE, I_WUP, I_WDOWN, I_WSG, I_WSU, I_WSD, N_IN };

typedef unsigned short bf16_t;
HD float bf2f(bf16_t v) { unsigned u = (unsigned)v << 16; float f; __builtin_memcpy(&f, &u, 4); return f; }
HD bf16_t f2bf(float f) { unsigned u; __builtin_memcpy(&u, &f, 4); u += 0x7fffu + ((u >> 16) & 1u); return (bf16_t)(u >> 16); }
HD float sigm(float x) { return 1.0f / (1.0f + expf(-x)); }
HD float siluf(float x) { return x * sigm(x); }
HD float gelu_tanh(float x) { return 0.5f * x * (1.0f + tanhf(0.7978845608028654f * (x + 0.044715f * x * x * x))); }
HD int cnt_idx(int l, int e) { return (l * E + e) * 64; }
HD float ssq8(const float* p) { return ((p[0] + p[1]) + (p[2] + p[3])) + ((p[4] + p[5]) + (p[6] + p[7])); }
HD int t5_bucket(int rel) {
    const int n = rel < 0 ? -rel : rel; const int ret = rel > 0 ? 16 : 0;
    if (n < 8) return ret + n;
    return ret + 8 + (n >= 12) + (n >= 16) + (n >= 23) + (n >= 32) + (n >= 46) + (n >= 64) + (n >= 91);
}

constexpr size_t al(size_t x) { return (x + 4095) & ~size_t(4095); }
constexpr size_t WS_CTL = 0, CTL_BYTES = 1u << 20;
constexpr size_t CTL_CNT = 65536;
constexpr size_t CTL_SSQ = 131072;
constexpr size_t WS_MOD = CTL_BYTES;
constexpr size_t WS_TAB = WS_MOD + al((size_t)2 * NB * 6 * D * 4);
constexpr size_t TAB_CR = 0, TAB_SR = (size_t)S * (ROPE / 2) * 4, TAB_CT = 2 * TAB_SR, TAB_ST = TAB_CT + (size_t)S * (DK / 2) * 4;
constexpr size_t WS_RSTD = WS_TAB + al(TAB_ST + (size_t)S * (DK / 2) * 4);
constexpr size_t WS_SELE = WS_RSTD + al((size_t)M * 4);
constexpr size_t WS_SELR = WS_SELE + al((size_t)M * 8 * 4);
constexpr size_t WS_SELW = WS_SELR + al((size_t)M * 8 * 4);
constexpr size_t WS_TOK = WS_SELW + al((size_t)M * 8 * 4);
constexpr size_t WS_WT = WS_TOK + al((size_t)E * M * 4);
constexpr size_t WS_OFFT = WS_WT + al((size_t)E * M * 4);
constexpr size_t WS_HM = WS_OFFT + 4096;
constexpr size_t WS_HM8 = WS_HM + al((size_t)M * D * 2);
constexpr size_t WS_MIX = WS_HM8 + al((size_t)M * D);
constexpr size_t WS_X1 = WS_MIX + al((size_t)M * D * 2);
constexpr size_t WS_X2 = WS_X1 + al((size_t)M * D * 4);
constexpr size_t WS_PROJ = WS_X2 + al((size_t)M * D * 4);
constexpr size_t WS_L0 = WS_PROJ + al((size_t)M * (P0_N > CD_N ? P0_N : CD_N) * 2);
constexpr size_t WS_Q = WS_L0;
constexpr size_t WS_KC = WS_Q + al((size_t)M * H_A * QK * 2);
constexpr size_t WS_V = WS_KC + al((size_t)M * H_A * QK * 2);
constexpr size_t WS_XC = WS_V + al((size_t)M * H_A * VD * 2);
constexpr size_t WS_LA = WS_XC + al((size_t)M * LW * 2);
constexpr size_t WS_U = WS_LA + al((size_t)2 * M * LW * 2);
constexpr size_t WS_HF = WS_U + al((size_t)2 * M * LW * 2);
constexpr size_t WS_LXP = WS_HF + al((size_t)M * LW * 4);
constexpr size_t WS_RET = WS_L0;
constexpr size_t WS_ACT = WS_LXP + al((size_t)NB * (S + 4) * LW * 2);
constexpr size_t WS_Y = WS_ACT + al((size_t)MAXT * RT * FF * 2);
constexpr size_t WS_T = WS_Y;
constexpr size_t WS_SC = WS_T + al((size_t)M * CD_N * 4);
static_assert(WS_SC + (size_t)8 * S * S * 4 <= WS_Y + (size_t)MAXT * RT * D * 2, "naive temps fit in the Y region");
constexpr size_t WS_W = WS_Y + al((size_t)MAXT * RT * D * 2);
constexpr size_t W_INAB = WS_W;
constexpr size_t W_UQ = W_INAB + al((size_t)AB_N * D * 2);
constexpr size_t W_UKV = W_UQ + al((size_t)H_A * QK * QR * 2);
constexpr size_t W_LRU = W_UKV + al((size_t)H_A * (NOPE + VD) * KVR * 2);
constexpr size_t W_OUTAB = W_LRU + al((size_t)2 * (LW / LBS) * 2 * LBS * 4 * LBS * 2);
constexpr size_t W_INCD = W_OUTAB + al((size_t)D * D * 2);
constexpr size_t W_OUTCD = W_INCD + al((size_t)CD_N * D * 2);
constexpr size_t W_RT = W_OUTCD + al((size_t)D * D * 2);
constexpr size_t W_GU = W_RT + al((size_t)2 * E * D * 2);
constexpr size_t W_DN = W_GU + al((size_t)2 * (E + 1) * 2 * FF * D * 2);
constexpr size_t W_GB = W_DN + al((size_t)2 * (E + 1) * D * FF * 2);
constexpr size_t WS_END = W_GB + al((size_t)6 * LW * 4);

struct Ctx { const float* in[N_IN]; float* out; unsigned char* ws; };
#define WSP(T, off) ((T*)(c.ws + (off)))
HD long lru_idx(int d, int b, int t, int ch) { return ((((long)d * NB + b) * (LW / 8) + ch / 8) * S + t) * 8 + (ch % 8); }
HD int atomic_inc(int* p) {
#ifdef HOST_TEST
    return (*p)++;
#else
#if defined(__HIP_DEVICE_COMPILE__)
    return atomicAdd(p, 1);
#else
    return (*p)++;
#endif
#endif
}

struct NGemm {
    const void* A; const void* B; void* C; const float* ks;
    long a_rs, a_ks, a_z1, a_z2, b_ks, b_ns, b_z1, b_z2, c_rs, c_z1, c_z2;
    long Mr, N, K, Z2, a_bf, b_bf, c_bf;
    HD float la(long i) const { return a_bf ? bf2f(((const bf16_t*)A)[i]) : ((const float*)A)[i]; }
    HD float lb(long i) const { return b_bf ? bf2f(((const bf16_t*)B)[i]) : ((const float*)B)[i]; }
    HD void operator()(long i) const {
        const long n4c = N / 4, m4c = Mr / 4;
        const long n0 = (i % n4c) * 4; const long r = i / n4c; const long m0 = (r % m4c) * 4; const long z = r / m4c; const long z1 = z / Z2, z2 = z % Z2;
        const long ab = z1 * a_z1 + z2 * a_z2, bb = z1 * b_z1 + z2 * b_z2, cb = z1 * c_z1 + z2 * c_z2;
        float acc[4][4];
#pragma unroll
        for (int x = 0; x < 4; ++x)
#pragma unroll
            for (int y = 0; y < 4; ++y) acc[x][y] = 0.f;
        for (long k = 0; k < K; ++k) {
            const float s = ks ? ks[k] : 1.0f;
            float av[4], bv[4];
#pragma unroll
            for (int x = 0; x < 4; ++x) av[x] = la(ab + (m0 + x) * a_rs + k * a_ks) * s;
#pragma unroll
            for (int y = 0; y < 4; ++y) bv[y] = lb(bb + k * b_ks + (n0 + y) * b_ns);
#pragma unroll
            for (int x = 0; x < 4; ++x)
#pragma unroll
                for (int y = 0; y < 4; ++y) acc[x][y] += av[x] * bv[y];
        }
#pragma unroll
        for (int x = 0; x < 4; ++x)
#pragma unroll
            for (int y = 0; y < 4; ++y) { const long ci = cb + (m0 + x) * c_rs + n0 + y; if (c_bf) ((bf16_t*)C)[ci] = f2bf(acc[x][y]); else ((float*)C)[ci] = acc[x][y]; }
    }
    long count(long Z) const { return Z * (Mr / 4) * (N / 4); }
};

struct ModF { Ctx c;
    HD void operator()(long i) const { const long n4c = 6 * D / 4; const long n = (i % n4c) * 4; const long r = i / n4c; const int b = (int)(r % NB), l = (int)(r / NB);
        float a0 = c.in[I_BMOD][l * 6 * D + n], a1 = c.in[I_BMOD][l * 6 * D + n + 1], a2 = c.in[I_BMOD][l * 6 * D + n + 2], a3 = c.in[I_BMOD][l * 6 * D + n + 3];
        const float* w = c.in[I_WMOD] + (size_t)l * D * 6 * D + n;
        for (int k = 0; k < D; ++k) { const float ca = siluf(c.in[I_C][b * D + k]); const float* wr = w + (size_t)k * 6 * D; a0 += ca * wr[0]; a1 += ca * wr[1]; a2 += ca * wr[2]; a3 += ca * wr[3]; }
        float* o = WSP(float, WS_MOD) + ((size_t)l * NB + b) * 6 * D + n; o[0] = a0; o[1] = a1; o[2] = a2; o[3] = a3; }
    long count() const { return (long)2 * NB * 6 * D / 4; } };
struct TabF { Ctx c;
    HD void operator()(long i) const { const int W = ROPE / 2 + DK / 2; const int t = (int)(i / W), j = (int)(i % W);
#if defined(__HIP_DEVICE_COMPILE__)
        { const bool r = j < ROPE / 2; const int jj = r ? j : j - ROPE / 2;
          const float inv = exp2f(-(2.0f * (float)jj / (float)(r ? ROPE : DK)) * 13.287712379549449f), a = (float)t * inv; const float cs = cosf(a), sn = sinf(a);
          if (r) { WSP(float, WS_TAB + TAB_CR)[t * (ROPE / 2) + jj] = cs; WSP(float, WS_TAB + TAB_SR)[t * (ROPE / 2) + jj] = sn; }
          else { WSP(float, WS_TAB + TAB_CT)[t * (DK / 2) + jj] = cs; WSP(float, WS_TAB + TAB_ST)[t * (DK / 2) + jj] = sn; }
          return; }
#endif
        if (j < ROPE / 2) { const double inv = pow(10000.0, -2.0 * j / ROPE), a = t * inv; WSP(float, WS_TAB + TAB_CR)[t * (ROPE / 2) + j] = (float)cos(a); WSP(float, WS_TAB + TAB_SR)[t * (ROPE / 2) + j] = (float)sin(a); }
        else { const int jj = j - ROPE / 2; const double inv = pow(10000.0, -2.0 * jj / DK), a = t * inv; WSP(float, WS_TAB + TAB_CT)[t * (DK / 2) + jj] = (float)cos(a); WSP(float, WS_TAB + TAB_ST)[t * (DK / 2) + jj] = (float)sin(a); } }
    long count() const { return (long)S * (ROPE / 2 + DK / 2); } };
struct RowSSF { Ctx c; const float* X; float* out; long rs, ncols, rows, os;
    HD void operator()(long i) const { const float* x = X + i * rs; float s = 0.f; for (long j = 0; j < ncols; ++j) s += x[j] * x[j]; out[i * os] = s; }
    long count() const { return rows; } };
struct ModulateF { Ctx c; const float* X; const float* gain; const float* sc; const float* sh;
    HD void operator()(long i) const { const long m = i / D, j = i % D; const int b = (int)(m / S); const float r = 1.0f / sqrtf(WSP(float, WS_RSTD)[m] / D + EPS);
        WSP(bf16_t, WS_HM)[i] = f2bf(X[i] * r * gain[j] * (1.0f + sc[(size_t)b * 6 * D + j]) + sh[(size_t)b * 6 * D + j]); }
    long count() const { return (long)M * D; } };
struct FinalF { Ctx c; const float* X;
    HD void operator()(long i) const { const long m = i / D, j = i % D; const float r = 1.0f / sqrtf(WSP(float, WS_RSTD)[m] / D + EPS); c.out[i] = X[i] * r * c.in[I_FNORM][j]; }
    long count() const { return (long)M * D; } };
struct PostG1F { Ctx c;
    HD void operator()(long i) const { const long m = i / AB_N; const int col = (int)(i % AB_N); const float v = WSP(float, WS_T)[i]; bf16_t* P = WSP(bf16_t, WS_PROJ) + m * P0_N;
        if (col < QR + KVR) P[col] = f2bf(v);
        else if (col < QR + KVR + ROPE) {}
        else if (col < QR + KVR + ROPE + LW) { P[col - ROPE] = f2bf(v); const long b = m / S, t = m % S; WSP(bf16_t, WS_LXP)[(b * (S + 4) + 2 + t) * LW + col - (QR + KVR + ROPE)] = f2bf(v); }
        else P[col - ROPE] = f2bf(gelu_tanh(v)); }
    long count() const { return (long)M * AB_N; } };
struct KRopeF { Ctx c;
    HD void operator()(long i) const { const long m = i / (ROPE / 2); const int ii = (int)(i % (ROPE / 2)); const int t = (int)(m % S); const float* T = WSP(float, WS_T) + m * AB_N + QR + KVR;
        const float x1 = T[ii], x2 = T[ROPE / 2 + ii], cs = WSP(float, WS_TAB + TAB_CR)[t * (ROPE / 2) + ii], sn = WSP(float, WS_TAB + TAB_SR)[t * (ROPE / 2) + ii];
        const bf16_t o1 = f2bf(x1 * cs - x2 * sn), o2 = f2bf(x2 * cs + x1 * sn);
        for (int h = 0; h < H_A; ++h) { bf16_t* K = WSP(bf16_t, WS_KC) + (m * H_A + h) * QK + NOPE; K[ii] = o1; K[ROPE / 2 + ii] = o2; } }
    long count() const { return (long)M * (ROPE / 2); } };
struct PostQF { Ctx c; float qs;
    HD void operator()(long i) const { const long m = i / (H_A * QK); const int r = (int)(i % (H_A * QK)), h = r / QK, j = r % QK; const int t = (int)(m % S);
        const float rstd = 1.0f / sqrtf(ssq8(WSP(float, CTL_SSQ) + m * 16) / QR + EPS) * qs; const float* T = WSP(float, WS_T) + m * (H_A * QK) + h * QK; bf16_t* Q = WSP(bf16_t, WS_Q) + (m * H_A + h) * QK;
        if (j < NOPE) Q[j] = f2bf(T[j] * rstd);
        else if (j < NOPE + ROPE / 2) { const int ii = j - NOPE; const float x1 = T[NOPE + ii] * rstd, x2 = T[NOPE + ROPE / 2 + ii] * rstd, cs = WSP(float, WS_TAB + TAB_CR)[t * (ROPE / 2) + ii], sn = WSP(float, WS_TAB + TAB_SR)[t * (ROPE / 2) + ii];
            Q[NOPE + ii] = f2bf(x1 * cs - x2 * sn); Q[NOPE + ROPE / 2 + ii] = f2bf(x2 * cs + x1 * sn); } }
    long count() const { return (long)M * H_A * QK; } };
struct PostKVF { Ctx c;
    HD void operator()(long i) const { const int W = NOPE + VD; const long m = i / (H_A * W); const int r = (int)(i % (H_A * W)), h = r / W, j = r % W;
        const float rstd = 1.0f / sqrtf(ssq8(WSP(float, CTL_SSQ) + m * 16 + 8) / KVR + EPS); const float v = WSP(float, WS_T)[i] * rstd;
        if (j < NOPE) WSP(bf16_t, WS_KC)[(m * H_A + h) * QK + j] = f2bf(v); else WSP(bf16_t, WS_V)[(m * H_A + h) * VD + j - NOPE] = f2bf(v); }
    long count() const { return (long)M * H_A * (NOPE + VD); } };
struct ConvF { Ctx c;
    HD void operator()(long i) const { const long m = i / LW; const int ch = (int)(i % LW); const int t = (int)(m % S); float a = c.in[I_CONVB][ch];
        for (int j = 0; j < 4; ++j) { const int tt = t + j - 2; if (tt >= 0 && tt < S) a += c.in[I_CONVW][j * LW + ch] * bf2f(WSP(bf16_t, WS_PROJ)[(m + j - 2) * P0_N + QR + KVR + ch]); }
        WSP(bf16_t, WS_XC)[i] = f2bf(a); }
    long count() const { return (long)M * LW; } };
struct GatesF { Ctx c;
    HD void operator()(long i) const { const int ch = (int)(i % LW); const long r = i / LW; const long m = r % M; const int d = (int)(r / M); const int g = ch / LBS, j = ch % LBS; const int b = (int)(m / S), t = (int)(m % S);
        const bf16_t* xr = WSP(bf16_t, WS_XC) + m * LW + g * LBS; const float* wa = c.in[I_LWA] + ((size_t)(d * (LW / LBS) + g) * LBS) * LBS + j; const float* wx = c.in[I_LWX] + ((size_t)(d * (LW / LBS) + g) * LBS) * LBS + j;
        float za = c.in[I_LBA][d * LW + ch], zx = c.in[I_LBX][d * LW + ch];
        for (int k = 0; k < LBS; ++k) { const float x = bf2f(xr[k]); za += x * wa[(size_t)k * LBS]; zx += x * wx[(size_t)k * LBS]; }
        const float lam = c.in[I_LLAM][d * LW + ch]; const float sp = log1pf(expf(-lam));
        const float la = -8.0f * sigm(za) * sp; const float u = sqrtf(-expm1f(2.0f * la)) * (sigm(zx) * bf2f(WSP(bf16_t, WS_XC)[m * LW + ch]));
        const long o = lru_idx(d, b, t, ch); WSP(bf16_t, WS_LA)[o] = f2bf(la); WSP(bf16_t, WS_U)[o] = f2bf(u); }
    long count() const { return (long)2 * M * LW; } };
struct ScanF { Ctx c;
    HD void operator()(long i) const { const int b = (int)(i / LW), ch = (int)(i % LW); float h = 0.f;
        for (int t = 0; t < S; ++t) { const long o = lru_idx(0, b, t, ch); h = expf(bf2f(WSP(bf16_t, WS_LA)[o])) * h + bf2f(WSP(bf16_t, WS_U)[o]); WSP(float, WS_HF)[((long)b * S + t) * LW + ch] = h; }
        h = 0.f;
        for (int t = S - 1; t >= 0; --t) { const long o = lru_idx(1, b, t, ch); h = expf(bf2f(WSP(bf16_t, WS_LA)[o])) * h + bf2f(WSP(bf16_t, WS_U)[o]); const long m = (long)b * S + t;
            WSP(bf16_t, WS_MIX)[m * D + HALF + ch] = f2bf((WSP(float, WS_HF)[m * LW + ch] + h) * bf2f(WSP(bf16_t, WS_PROJ)[m * P0_N + QR + KVR + LW + ch])); } }
    long count() const { return (long)NB * LW; } };
struct SoftmaxF { Ctx c; long rows;
    HD void operator()(long i) const { float* r = WSP(float, WS_SC) + i * S; float mx = -INFINITY; for (int k = 0; k < S; ++k) mx = fmaxf(mx, r[k]); float s = 0.f; for (int k = 0; k < S; ++k) { const float p = exp2f(r[k] - mx); r[k] = p; s += p; }
        const float inv = 1.0f / s; for (int k = 0; k < S; ++k) r[k] *= inv; }
    long count() const { return rows; } };
struct OutPostF { Ctx c; const float* Xin; float* Xout; long l;
    HD void operator()(long i) const { const long m = i / D, n = i % D; const int b = (int)(m / S); Xout[i] = Xin[i] + WSP(float, WS_MOD)[((size_t)l * NB + b) * 6 * D + 2 * D + n] * WSP(float, WS_T)[i]; }
    long count() const { return (long)M * D; } };
struct RouteF { Ctx c; long l;
    HD float bz(const float* lg, const float* bias, int e) const { return sigm(lg[e]) + bias[e]; }
    HD void operator()(long m) const { const float* lg = WSP(float, WS_T) + m * E; const float* bias = c.in[I_RBIAS] + l * E;
        unsigned gmask = 0u;
        for (int it = 0; it < TG; ++it) { float best = -INFINITY; int bi = 0;
            for (int g = 0; g < NG; ++g) if (!((gmask >> g) & 1u)) { float m1 = -INFINITY, m2 = -INFINITY; for (int j = 0; j < E / NG; ++j) { const float v = bz(lg, bias, g * (E / NG) + j); if (v > m1) { m2 = m1; m1 = v; } else if (v > m2) m2 = v; }
                const float sc = m1 + m2; if (sc > best) { best = sc; bi = g; } }
            gmask |= 1u << bi; }
        unsigned long long taken = 0ull; float wsum = 0.f; int* se = WSP(int, WS_SELE) + m * TOPK; float* sw = WSP(float, WS_SELW) + m * TOPK; int* sr = WSP(int, WS_SELR) + m * TOPK;
        for (int k = 0; k < TOPK; ++k) { float best = -INFINITY; int bi = 0;
            for (int e = 0; e < E; ++e) if (((gmask >> (e / (E / NG))) & 1u) && !((taken >> e) & 1ull)) { const float v = bz(lg, bias, e); if (v > best) { best = v; bi = e; } }
            taken |= 1ull << bi; const float s = sigm(lg[bi]); se[k] = bi; sw[k] = s; wsum += s; }
        int* cnt = WSP(int, CTL_CNT);
        for (int k = 0; k < TOPK; ++k) { const int e = se[k]; const float w = sw[k] / wsum * 2.5f; const int rank = atomic_inc(cnt + cnt_idx((int)l, e)); sr[k] = rank; sw[k] = w;
            WSP(int, WS_TOK)[(size_t)e * M + rank] = (int)m; WSP(float, WS_WT)[(size_t)e * M + rank] = w; } }
    long count() const { return M; } };
struct OffF { Ctx c; long l;
    HD void operator()(long) const { int* o = WSP(int, WS_OFFT); const int* cnt = WSP(int, CTL_CNT); o[0] = 0; for (int e = 0; e <= E; ++e) { const int n = e < E ? cnt[cnt_idx((int)l, e)] : M; o[e + 1] = o[e] + (n + RT - 1) / RT; } }
    long count() const { return 1; } };
struct Moe1F { Ctx c; long l;
    HD void operator()(long i) const { const long f4c = FF / 4; const int f = (int)(i % f4c) * 4; const long r = i / f4c; const int rank = (int)(r % M), e = (int)(r / M);
        const int n = e < E ? WSP(int, CTL_CNT)[cnt_idx((int)l, e)] : M; if (rank >= n) return;
        const int tok = e < E ? WSP(int, WS_TOK)[(size_t)e * M + rank] : rank; const long row = (long)WSP(int, WS_OFFT)[e] * RT + rank;
        const float* wg = (e < E ? c.in[I_WGATE] + ((size_t)l * E + e) * D * FF : c.in[I_WSG] + (size_t)l * D * FF) + f;
        const float* wu = (e < E ? c.in[I_WUP] + ((size_t)l * E + e) * D * FF : c.in[I_WSU] + (size_t)l * D * FF) + f;
        const bf16_t* h = WSP(bf16_t, WS_HM) + (size_t)tok * D; float g0 = 0, g1 = 0, g2 = 0, g3 = 0, u0 = 0, u1 = 0, u2 = 0, u3 = 0;
        for (int k = 0; k < D; ++k) { const float a = bf2f(h[k]); const float* pg = wg + (size_t)k * FF; const float* pu = wu + (size_t)k * FF;
            g0 += a * pg[0]; g1 += a * pg[1]; g2 += a * pg[2]; g3 += a * pg[3]; u0 += a * pu[0]; u1 += a * pu[1]; u2 += a * pu[2]; u3 += a * pu[3]; }
        bf16_t* o = WSP(bf16_t, WS_ACT) + row * FF + f; o[0] = f2bf(siluf(g0) * u0); o[1] = f2bf(siluf(g1) * u1); o[2] = f2bf(siluf(g2) * u2); o[3] = f2bf(siluf(g3) * u3); }
    long count() const { return (long)(E + 1) * M * (FF / 4); } };
struct Moe2F { Ctx c; long l;
    HD void operator()(long i) const { const long d4c = D / 4; const int d = (int)(i % d4c) * 4; const long r = i / d4c; const int rank = (int)(r % M), e = (int)(r / M);
        const int n = e < E ? WSP(int, CTL_CNT)[cnt_idx((int)l, e)] : M; if (rank >= n) return;
        const long row = (long)WSP(int, WS_OFFT)[e] * RT + rank; const float wt = e < E ? WSP(float, WS_WT)[(size_t)e * M + rank] : 1.0f;
        const float* wd = (e < E ? c.in[I_WDOWN] + ((size_t)l * E + e) * FF * D : c.in[I_WSD] + (size_t)l * FF * D) + d;
        const bf16_t* a = WSP(bf16_t, WS_ACT) + row * FF; float y0 = 0, y1 = 0, y2 = 0, y3 = 0;
        for (int f = 0; f < FF; ++f) { const float v = bf2f(a[f]); const float* p = wd + (size_t)f * D; y0 += v * p[0]; y1 += v * p[1]; y2 += v * p[2]; y3 += v * p[3]; }
        bf16_t* o = WSP(bf16_t, WS_Y) + row * D + d; o[0] = f2bf(wt * y0); o[1] = f2bf(wt * y1); o[2] = f2bf(wt * y2); o[3] = f2bf(wt * y3); }
    long count() const { return (long)(E + 1) * M * (D / 4); } };
struct CombineF { Ctx c; const float* Xin; float* Xout; long l;
    HD void operator()(long i) const { const long m = i / D, n = i % D; const int b = (int)(m / S); const int* offt = WSP(int, WS_OFFT); const bf16_t* Y = WSP(bf16_t, WS_Y); float v = 0.f;
        for (int k = 0; k < TOPK; ++k) { const int e = WSP(int, WS_SELE)[m * TOPK + k], r = WSP(int, WS_SELR)[m * TOPK + k]; v += bf2f(Y[((size_t)offt[e] * RT + r) * D + n]); }
        v += bf2f(Y[((size_t)offt[E] * RT + m) * D + n]);
        Xout[i] = Xin[i] + WSP(float, WS_MOD)[((size_t)l * NB + b) * 6 * D + 5 * D + n] * v; }
    long count() const { return (long)M * D; } };
struct PostG3F { Ctx c; float sqs;
    HD void operator()(long i) const { const long m = i / CD_N; const int col = (int)(i % CD_N); const int t = (int)(m % S); const float* T = WSP(float, WS_T) + m * CD_N; bf16_t* P = WSP(bf16_t, WS_PROJ) + m * CD_N; const int W = H_C * DK;
        if (col < 2 * W) { const int j = col % DK; if (j < DK / 2) { const float sc = col < W ? 1.0f : 1.0f / sqrtf((float)DK); const float x1 = T[col], x2 = T[col + DK / 2], cs = WSP(float, WS_TAB + TAB_CT)[t * (DK / 2) + j], sn = WSP(float, WS_TAB + TAB_ST)[t * (DK / 2) + j];
                P[col] = f2bf((x1 * cs - x2 * sn) * sc); P[col + DK / 2] = f2bf((x2 * cs + x1 * sn) * sc); } }
        else if (col < 3 * W) P[col] = f2bf(T[col]);
        else if (col < 4 * W) P[col] = f2bf(siluf(T[col]));
        else if (col < 4 * W + H_D * HDS) P[col] = f2bf(T[col] * sqs);
        else P[col] = f2bf(T[col]); }
    long count() const { return (long)M * CD_N; } };
struct DecayF { Ctx c;
    HD void operator()(long i) const { const int mm = (int)(i % S); const long r = i / S; const int n = (int)(r % S), h = (int)(r / S);
        const float lgf = log1pf(-exp2f(-5.0f - h)), lgb = log1pf(-exp2f(-5.0f - (H_C - 1 - h)));
        WSP(float, WS_SC)[i] *= (n >= mm) ? expf(lgf * (n - mm)) : expf(lgb * (mm - n)); }
    long count() const { return (long)H_C * S * S; } };
struct RetNormF { Ctx c;
    HD void operator()(long i) const { const long m = i / H_C; const int h = (int)(i % H_C); const float* r = WSP(float, WS_RET) + m * HALF + h * DK; float s = 0.f; for (int j = 0; j < DK; ++j) s += r[j] * r[j];
        const float rs = 1.0f / sqrtf(s / DK + EPS); for (int j = 0; j < DK; ++j) WSP(bf16_t, WS_MIX)[m * D + h * DK + j] = f2bf(bf2f(WSP(bf16_t, WS_PROJ)[m * CD_N + 3 * H_C * DK + h * DK + j]) * (r[j] * rs * c.in[I_RETGN][h * DK + j])); }
    long count() const { return (long)M * H_C; } };
struct SwaSoftF { Ctx c;
    HD void operator()(long i) const { const int q = (int)(i % S), hd = (int)(i / S); float* r = WSP(float, WS_SC) + i * S; const float sink = c.in[I_SINKS][hd] * LOG2E; const float* rb = c.in[I_RELB];
        const int lo = q - WIN < 0 ? 0 : q - WIN, hi = q + WIN > S - 1 ? S - 1 : q + WIN; float mx = sink;
        for (int k = lo; k <= hi; ++k) { const float s = r[k] + rb[t5_bucket(k - q) * H_D + hd] * LOG2E; r[k] = s; mx = fmaxf(mx, s); }
        float den = exp2f(sink - mx); for (int k = lo; k <= hi; ++k) { const float p = exp2f(r[k] - mx); r[k] = p; den += p; }
        const float inv = 1.0f / den; for (int k = 0; k < S; ++k) r[k] = (k >= lo && k <= hi) ? r[k] * inv : 0.f; }
    long count() const { return (long)H_D * S; } };

#ifdef HOST_TEST
struct Launcher { template <class F> void operator()(const F& f, long n) const { for (long i = 0; i < n; ++i) f(i); } };
#else
template <class F> __global__ void __launch_bounds__(256) run_k(F f, long n) { for (long i = (long)blockIdx.x * 256 + threadIdx.x; i < n; i += (long)gridDim.x * 256) f(i); }
struct Launcher { hipStream_t st; template <class F> void operator()(const F& f, long n) const { long g = (n + 255) / 256; if (g > (1 << 20)) g = 1 << 20; if (g < 1) g = 1; hipLaunchKernelGGL(run_k<F>, dim3((unsigned)g), dim3(256), 0, st, f, n); } };
#endif

template <class F> static F zf() { F f; memset((void*)&f, 0, sizeof(F)); return f; }
static NGemm mk_gemm(const void* A, int a_bf, long a_rs, const void* B, int b_bf, long b_ks, long b_ns, void* C, int c_bf, long c_rs, long Mr, long N, long K) {
    NGemm g; memset((void*)&g, 0, sizeof(g)); g.A = A; g.B = B; g.C = C; g.a_bf = a_bf; g.b_bf = b_bf; g.c_bf = c_bf; g.a_rs = a_rs; g.a_ks = 1; g.b_ks = b_ks; g.b_ns = b_ns; g.c_rs = c_rs; g.Mr = Mr; g.N = N; g.K = K; g.Z2 = 1; return g; }

template <class L> static void rowss(const L& go, const Ctx& c, const float* X, float* out, long rs, long ncols, long os = 1) { RowSSF f = zf<RowSSF>(); f.c = c; f.X = X; f.out = out; f.rs = rs; f.ncols = ncols; f.rows = M; f.os = os; go(f, f.count()); }

enum { PH_P0 = 0, PH_MOD0, PH_G1, PH_G2, PH_SCAN0, PH_ATT0, PH_OUT0, PH_RT0, PH_M1_0, PH_M2_0, PH_CMB0, PH_G3, PH_RET1, PH_SWA1, PH_RN1, PH_OUT1, PH_RT1, PH_M1_1, PH_M2_1, PH_CMB1, N_PHASES };

template <class L> static void naive_phase(const L& go, const Ctx& c, int ph) {
    float* mod = WSP(float, WS_MOD);
    const int l = ph >= PH_G3 ? 1 : 0;
    float* X1 = WSP(float, WS_X1); float* X2 = WSP(float, WS_X2);
    switch (ph) {
    case PH_P0: { { ModF f = zf<ModF>(); f.c = c; go(f, f.count()); } { TabF f = zf<TabF>(); f.c = c; go(f, f.count()); } } break;
    case PH_MOD0: { rowss(go, c, c.in[I_X], WSP(float, WS_RSTD), D, D);
        ModulateF f = zf<ModulateF>(); f.c = c; f.X = c.in[I_X]; f.gain = c.in[I_NMIX]; f.sc = mod + D; f.sh = mod; go(f, f.count()); } break;
    case PH_G1: { { NGemm g = mk_gemm(WSP(bf16_t, WS_HM), 1, D, c.in[I_WINAB], 0, AB_N, 1, WSP(float, WS_T), 0, AB_N, M, AB_N, D); go(g, g.count(1)); }
        { PostG1F f = zf<PostG1F>(); f.c = c; go(f, f.count()); }
        rowss(go, c, WSP(float, WS_T), WSP(float, CTL_SSQ), AB_N, QR, 16);
        rowss(go, c, WSP(float, WS_T) + QR, WSP(float, CTL_SSQ) + 8, AB_N, KVR, 16);
        { KRopeF f = zf<KRopeF>(); f.c = c; go(f, f.count()); } } break;
    case PH_G2: { { NGemm g = mk_gemm(WSP(bf16_t, WS_PROJ), 1, P0_N, c.in[I_WUQ], 0, H_A * QK, 1, WSP(float, WS_T), 0, H_A * QK, M, H_A * QK, QR); g.ks = c.in[I_QLN]; go(g, g.count(1)); }
        { PostQF f = zf<PostQF>(); f.c = c; f.qs = LOG2E / sqrtf((float)QK); go(f, f.count()); }
        { NGemm g = mk_gemm(WSP(bf16_t, WS_PROJ) + QR, 1, P0_N, c.in[I_WUKV], 0, H_A * (NOPE + VD), 1, WSP(float, WS_T), 0, H_A * (NOPE + VD), M, H_A * (NOPE + VD), KVR); g.ks = c.in[I_KVLN]; go(g, g.count(1)); }
        { PostKVF f = zf<PostKVF>(); f.c = c; go(f, f.count()); }
        { ConvF f = zf<ConvF>(); f.c = c; go(f, f.count()); }
        { GatesF f = zf<GatesF>(); f.c = c; go(f, f.count()); } } break;
    case PH_SCAN0: { ScanF f = zf<ScanF>(); f.c = c; go(f, f.count()); } break;
    case PH_ATT0: {
        for (int b = 0; b < NB; ++b) {
            NGemm g = mk_gemm(WSP(bf16_t, WS_Q) + (size_t)b * S * H_A * QK, 1, H_A * QK, WSP(bf16_t, WS_KC) + (size_t)b * S * H_A * QK, 1, 1, H_A * QK, WSP(float, WS_SC), 0, S, S, S, QK);
            g.a_z2 = QK; g.b_z2 = QK; g.c_z2 = (long)S * S; g.Z2 = H_A; go(g, g.count(H_A));
            { SoftmaxF f = zf<SoftmaxF>(); f.c = c; f.rows = (long)H_A * S; go(f, f.count()); }
            NGemm p = mk_gemm(WSP(float, WS_SC), 0, S, WSP(bf16_t, WS_V) + (size_t)b * S * H_A * VD, 1, H_A * VD, 1, WSP(bf16_t, WS_MIX) + (size_t)b * S * D, 1, D, S, VD, S);
            p.a_z2 = (long)S * S; p.b_z2 = VD; p.c_z2 = VD; p.Z2 = H_A; go(p, p.count(H_A)); } } break;
    case PH_OUT0: case PH_OUT1: { NGemm g = mk_gemm(WSP(bf16_t, WS_MIX), 1, D, c.in[l ? I_WOUTCD : I_WOUTAB], 0, D, 1, WSP(float, WS_T), 0, D, M, D, D); go(g, g.count(1));
        OutPostF f = zf<OutPostF>(); f.c = c; f.Xin = l ? X2 : c.in[I_X]; f.Xout = X1; f.l = l; go(f, f.count()); } break;
    case PH_RT0: case PH_RT1: { float* modl = mod + (size_t)l * NB * 6 * D;
        rowss(go, c, X1, WSP(float, WS_RSTD), D, D);
        { ModulateF f = zf<ModulateF>(); f.c = c; f.X = X1; f.gain = c.in[I_NFFN] + l * D; f.sc = modl + 4 * D; f.sh = modl + 3 * D; go(f, f.count()); }
        { NGemm g = mk_gemm(WSP(bf16_t, WS_HM), 1, D, c.in[I_WROUTER] + (size_t)l * D * E, 0, E, 1, WSP(float, WS_T), 0, E, M, E, D); go(g, g.count(1)); }
        { RouteF f = zf<RouteF>(); f.c = c; f.l = l; go(f, f.count()); } } break;
    case PH_M1_0: case PH_M1_1: { Moe1F f = zf<Moe1F>(); f.c = c; f.l = l; go(f, f.count()); } break;
    case PH_M2_0: case PH_M2_1: { Moe2F f = zf<Moe2F>(); f.c = c; f.l = l; go(f, f.count()); } break;
    case PH_CMB0: { { CombineF f = zf<CombineF>(); f.c = c; f.Xin = X1; f.Xout = X2; f.l = 0; go(f, f.count()); }
        rowss(go, c, X2, WSP(float, WS_RSTD), D, D);
        ModulateF f = zf<ModulateF>(); f.c = c; f.X = X2; f.gain = c.in[I_NMIX] + D; f.sc = mod + (size_t)NB * 6 * D + D; f.sh = mod + (size_t)NB * 6 * D; go(f, f.count()); } break;
    case PH_CMB1: { { CombineF f = zf<CombineF>(); f.c = c; f.Xin = X1; f.Xout = X2; f.l = 1; go(f, f.count()); }
        rowss(go, c, X2, WSP(float, WS_RSTD), D, D);
        FinalF f = zf<FinalF>(); f.c = c; f.X = X2; go(f, f.count()); } break;
    case PH_G3: { { NGemm g = mk_gemm(WSP(bf16_t, WS_HM), 1, D, c.in[I_WINCD], 0, CD_N, 1, WSP(float, WS_T), 0, CD_N, M, CD_N, D); go(g, g.count(1)); }
        PostG3F f = zf<PostG3F>(); f.c = c; f.sqs = LOG2E / sqrtf((float)HDS); go(f, f.count()); } break;
    case PH_RET1: {
        for (int b = 0; b < NB; ++b) {
            const bf16_t* Pb = WSP(bf16_t, WS_PROJ) + (size_t)b * S * CD_N;
            NGemm g = mk_gemm(Pb, 1, CD_N, Pb + H_C * DK, 1, 1, CD_N, WSP(float, WS_SC), 0, S, S, S, DK);
            g.a_z2 = DK; g.b_z2 = DK; g.c_z2 = (long)S * S; g.Z2 = H_C; go(g, g.count(H_C));
            { DecayF f = zf<DecayF>(); f.c = c; go(f, f.count()); }
            NGemm p = mk_gemm(WSP(float, WS_SC), 0, S, Pb + 2 * H_C * DK, 1, CD_N, 1, WSP(float, WS_RET) + (size_t)b * S * HALF, 0, HALF, S, DK, S);
            p.a_z2 = (long)S * S; p.b_z2 = DK; p.c_z2 = DK; p.Z2 = H_C; go(p, p.count(H_C)); } } break;
    case PH_SWA1: {
        for (int b = 0; b < NB; ++b) {
            const bf16_t* Pb = WSP(bf16_t, WS_PROJ) + (size_t)b * S * CD_N + 4 * H_C * DK; const int G = H_D / KVH;
            NGemm g = mk_gemm(Pb, 1, CD_N, Pb + H_D * HDS, 1, 1, CD_N, WSP(float, WS_SC), 0, S, S, S, HDS);
            g.a_z1 = (long)G * HDS; g.a_z2 = HDS; g.b_z1 = HDS; g.b_z2 = 0; g.c_z1 = (long)G * S * S; g.c_z2 = (long)S * S; g.Z2 = G; go(g, g.count(H_D));
            { SwaSoftF f = zf<SwaSoftF>(); f.c = c; go(f, f.count()); }
            NGemm p = mk_gemm(WSP(float, WS_SC), 0, S, Pb + H_D * HDS + KVH * HDS, 1, CD_N, 1, WSP(bf16_t, WS_MIX) + (size_t)b * S * D + HALF, 1, D, S, HDS, S);
            p.a_z1 = (long)G * S * S; p.a_z2 = (long)S * S; p.b_z1 = HDS; p.b_z2 = 0; p.c_z1 = (long)G * HDS; p.c_z2 = HDS; p.Z2 = G; go(p, p.count(H_D)); } } break;
    case PH_RN1: { RetNormF f = zf<RetNormF>(); f.c = c; go(f, f.count()); } break;
    default: break;
    }
}
template <class L> static void naive_offt(const L& go, const Ctx& c, int l) { OffF f = zf<OffF>(); f.c = c; f.l = l; go(f, f.count()); }

#ifdef HOST_TEST
template <class L> static void run_all(const L& go, const Ctx& c) {
    for (int ph = 0; ph < N_PHASES; ++ph) { naive_phase(go, c, ph); if (ph == PH_RT0 || ph == PH_RT1) naive_offt(go, c, ph == PH_RT1); }
}
#endif
#ifndef HOST_TEST
#define LAS __attribute__((address_space(3)))
#define GAS __attribute__((address_space(1)))
typedef unsigned v4u __attribute__((ext_vector_type(4)));
typedef unsigned u32x2 __attribute__((ext_vector_type(2)));
typedef float f32x4 __attribute__((ext_vector_type(4)));
typedef float f32x16 __attribute__((ext_vector_type(16)));
typedef short bf16x8 __attribute__((ext_vector_type(8)));
typedef short s16x4 __attribute__((ext_vector_type(4)));
typedef int v8i_t __attribute__((ext_vector_type(8)));
typedef int v4i_t __attribute__((ext_vector_type(4)));
typedef GAS unsigned gu32;
#define RLX_AGENT __ATOMIC_RELAXED, __HIP_MEMORY_SCOPE_AGENT
#define LDS_WAIT() asm volatile("s_waitcnt lgkmcnt(0)" ::: "memory")
#define VM_WAIT() asm volatile("s_waitcnt vmcnt(0)" ::: "memory")
constexpr int NWAVES = 8, NTHR = 512;
constexpr int LDS_BYTES = 147456, MISC_OFF = LDS_BYTES - 2048, TAB_OFF = MISC_OFF + 1024;
__device__ __forceinline__ int lane_id() { int l; asm volatile("v_mbcnt_lo_u32_b32 %0, -1, 0\n\tv_mbcnt_hi_u32_b32 %0, -1, %0" : "=v"(l)); return l; }
__device__ __forceinline__ unsigned cvt_pk_bf16(float lo, float hi) { unsigned r; asm volatile("v_cvt_pk_bf16_f32 %0, %1, %2" : "=v"(r) : "v"(lo), "v"(hi)); return r; }
__device__ __forceinline__ float fast_sigm(float x) { return __builtin_amdgcn_rcpf(1.0f + __builtin_amdgcn_exp2f(-1.4426950408889634f * x)); }
__device__ __forceinline__ float fast_silu(float x) { return x * fast_sigm(x); }
__device__ __forceinline__ float fast_gelu_tanh(float x) { const float z = 0.7978845608028654f * (x + 0.044715f * x * x * x); return x * fast_sigm(2.0f * z); }
__device__ __forceinline__ float wave_sum(float v) {
#pragma unroll
    for (int o = 1; o < 64; o <<= 1) v += __shfl_xor(v, o);
    return v; }

#define XB_TMO      128
#define XB_XCNT(j)  (256  + 64 * (j))
#define XB_XSUB(j)  (1280 + 64 * (j))
#define XB_XGEN(j)  (2304 + 64 * (j))
#define XB_TOP      3328
#define XB_TOPGEN   3392
#define XCD_BAR_WORDS 3456
#define XB_SPIN_CAP (1u << 20)
__device__ __forceinline__ unsigned xb_ld(unsigned* p)              { return __hip_atomic_load(p, __ATOMIC_RELAXED, __HIP_MEMORY_SCOPE_AGENT); }
__device__ __forceinline__ unsigned xb_add(unsigned* p, unsigned v) { return __hip_atomic_fetch_add(p, v, __ATOMIC_RELAXED, __HIP_MEMORY_SCOPE_AGENT); }
__device__ __forceinline__ unsigned xb_xcc_id() { return (unsigned)__builtin_amdgcn_s_getreg((3 << 11) | 20) & 0xFu; }
#define XB_SPIN(cond, bar) do { unsigned _sp = 0; while (cond) { __builtin_amdgcn_s_sleep(1); \
    if ((++_sp & 255u) == 0u) { if (xb_ld(&(bar)[XB_TMO])) break; if (_sp > XB_SPIN_CAP) { atomicAdd(&(bar)[XB_TMO], 1u); break; } } } } while (0)
struct XcdBarrier { unsigned* bar; unsigned x; volatile LAS unsigned* st; int wave; };
__device__ __forceinline__ XcdBarrier xcd_barrier_post(unsigned* bar, volatile LAS unsigned* st, int wave) {
    XcdBarrier b; b.bar = bar; b.x = xb_xcc_id(); b.st = st; b.wave = wave;
    if (wave == 0 && lane_id() == 0) (void)xb_add(&bar[XB_XCNT(b.x)], 1u);
    return b; }
__device__ __forceinline__ void xcd_barrier_complete(unsigned* bar, unsigned x, unsigned& nloc, unsigned& nx) {
    const unsigned G = gridDim.x * gridDim.y * gridDim.z;
    unsigned sum, cnt, mine, sp = 0u;
    for (;;) {
        sum = 0u; cnt = 0u; mine = 0u;
#pragma unroll
        for (unsigned j = 0; j < 16; ++j) { const unsigned c = xb_ld(&bar[XB_XCNT(j)]); sum += c; cnt += (c > 0u) ? 1u : 0u; mine = (j == x) ? c : mine; }
        if (sum == G) break;
        __builtin_amdgcn_s_sleep(1);
        if ((++sp & 255u) == 0u) { if (xb_ld(&bar[XB_TMO])) break; if (sp > XB_SPIN_CAP) { atomicAdd(&bar[XB_TMO], 1u); break; } }
    }
    nloc = mine > 0u ? mine : 1u; nx = cnt > 0u ? cnt : 1u; }
__device__ __forceinline__ void xcd_barrier(const XcdBarrier& b) {
    asm volatile("s_waitcnt vmcnt(0)" ::: "memory");
    __syncthreads();
    if (b.wave == 0 && lane_id() == 0) {
        unsigned* bar = b.bar;
        __builtin_amdgcn_s_waitcnt(0);
        unsigned nloc = b.st[0], nx = b.st[1];
        if (nloc == 0u) { xcd_barrier_complete(bar, b.x, nloc, nx); b.st[0] = nloc; b.st[1] = nx; }
        const unsigned old = xb_add(&bar[XB_XSUB(b.x)], 1u);
        const unsigned gen = old / nloc;
        if (old + 1u == (gen + 1u) * nloc) {
            __builtin_amdgcn_fence(__ATOMIC_RELEASE, "agent");
            asm volatile("s_waitcnt vmcnt(0)" ::: "memory");
            const unsigned og = xb_add(&bar[XB_TOP], 1u);
            const unsigned tg = og / nx;
            if (og + 1u == (tg + 1u) * nx) xb_add(&bar[XB_TOPGEN], 1u);
            else XB_SPIN(xb_ld(&bar[XB_TOPGEN]) == tg, bar);
            __builtin_amdgcn_fence(__ATOMIC_ACQUIRE, "agent");
            xb_add(&bar[XB_XGEN(b.x)], 1u);
            asm volatile("s_waitcnt vmcnt(0)" ::: "memory");
        } else {
            XB_SPIN(xb_ld(&bar[XB_XGEN(b.x)]) == gen, bar);
            __builtin_amdgcn_fence(__ATOMIC_ACQUIRE, "agent");
            asm volatile("s_waitcnt vmcnt(0)" ::: "memory");
        }
    }
    __syncthreads();
}

namespace pg8 {
constexpr int BM = 256, BK = 64, HALFT = 128, HTB = HALFT * BK * 2, STAGE_BYTES = 8 * HTB, NXCD = 8, WGM = 8;
__host__ __device__ __forceinline__ int lds_byte(int r, int c) { const int st = (r >> 4) * 2 + (c >> 5), rr = r & 15, cc = c & 31, ob = rr * 64 + cc * 2; return st * 1024 + (ob ^ (((ob >> 9) & 1) << 5)); }
__host__ __device__ __forceinline__ void stage_rc(int b, int& R, int& C) { const int st = b / 1024, sb = b % 1024, swz = sb ^ (((sb >> 9) & 1) << 5); R = (st >> 1) * 16 + swz / 64; C = (st & 1) * 32 + (swz % 64) / 2; }
__host__ __device__ __forceinline__ int perm32(int rho) { const int n = rho >> 4, i = rho & 15; return 8 * (i >> 2) + 4 * n + (i & 3); }
struct Unit { const char* A; const char* B; int pm, pn, e, r0; };
__device__ __forceinline__ void tile_of(int L, int nM, int nN, int& pm, int& pn) {
    const int nwg = nM * nN; int wgid = L; { const int q = nwg / NXCD, r = nwg % NXCD, xcd = wgid % NXCD, off = wgid / NXCD; wgid = (xcd < r ? xcd * (q + 1) : r * (q + 1) + (xcd - r) * q) + off; }
    const int nig = WGM * nN, gid = wgid / nig, fm = gid * WGM, gsz = (nM - fm) < WGM ? (nM - fm) : WGM;
    pm = fm + ((wgid % nig) % gsz); pn = (wgid % nig) / gsz; }
template <class E_, class = void> struct perm16_t { static constexpr bool value = false; };
template <class E_> struct perm16_t<E_, decltype((void)E_::PERM16)> { static constexpr bool value = E_::PERM16; };
template <class E_> constexpr bool perm16_v = perm16_t<E_>::value;
struct APlain { static __device__ __forceinline__ const char* kt(const char* base, int t, int) { return base + (size_t)t * (BK * 2); } };
struct AConv { static __device__ __forceinline__ const char* kt(const char* base, int t, int lda) { return base + (long)((t >> 1) - 2) * (lda * 2) + (t & 1) * (BK * 2); } };

template <class Epi, class Sched, class AP, bool GATHER, bool ALIGN_EPI, int EB = 2>
__device__ __forceinline__ void gemm_phase(LAS unsigned char* lds, const int wave, const char* base, const int lda, const int ldb, const int K, const Sched& S, const Epi& E) {
    const __amdgpu_buffer_rsrc_t rsrc = __builtin_amdgcn_make_buffer_rsrc((void*)base, (short)0, -1, 0x00020000);
    const int wid = __builtin_amdgcn_readfirstlane(wave), lane = lane_id(), tid = wid * 64 + lane, wr = wid >> 2, wc = wid & 3, fr = lane & 15, fq = lane >> 4;
    const int nt = K / BK;
    unsigned vA[2][2], vAn[2][2], vB[2], vB1[2];
#pragma unroll
    for (int i = 0; i < 2; ++i) { int R, C; stage_rc(tid * 16 + i * 8192, R, C); const int Rb = Epi::PERM ? ((R & ~31) + perm32(R & 31)) : R;
        if constexpr (perm16_v<Epi>) { const int wcR = R >> 5, rho = R & 31, n_ = rho >> 4, i_ = rho & 15; const int src0 = 64 * wcR + 16 * (i_ >> 2) + 4 * n_ + (i_ & 3);
            vB[i] = (unsigned)(src0 * ldb + C) * 2u; vB1[i] = (unsigned)((src0 + 8) * ldb + C) * 2u; }
        else { vB[i] = (unsigned)(Rb * ldb + C) * 2u; vB1[i] = 0u; }
#pragma unroll
        for (int h = 0; h < 2; ++h) { vA[h][i] = GATHER ? (unsigned)C * 2u : (h == 0 ? (unsigned)(R * lda + C) * 2u : 0u); vAn[h][i] = vA[h][i]; } }
    const size_t kstep = (size_t)(BK * 2), hstepB = (size_t)HALFT * ldb * 2, hB1 = perm16_v<Epi> ? 0 : hstepB;
    const unsigned (&vBs)[2] = perm16_v<Epi> ? vB1 : vB;
    const unsigned (&vA1)[2] = GATHER ? vA[1] : vA[0]; const size_t hA1 = GATHER ? 0 : (size_t)HALFT * lda * 2;
    const unsigned ldsw = (unsigned)wid * 1024u;
    const int aoff = lds_byte(wr * 64 + fr, fq * 8), boff = lds_byte(wc * 32 + fr, fq * 8);
#define PG8_SA(b, h) (((b) * 2 + (h)) * HTB)
#define PG8_SB(b, h) ((4 + (b) * 2 + (h)) * HTB)
#define PG8_STAGE(bufoff, gbase, voff) do { const int so_ = (int)(unsigned)(size_t)((const char*)(gbase) - base); _Pragma("unroll") for (int _i = 0; _i < 2; ++_i) \
        __builtin_amdgcn_raw_ptr_buffer_load_lds(rsrc, (LAS void*)(lds + (bufoff) + ldsw + _i * 8192), 16, (int)(voff)[_i], so_, 0, 0); } while (0)
#define PG8_LDA(dst, b, h) do { _Pragma("unroll") for (int m = 0; m < 4; ++m) { if constexpr (EB == 2) { _Pragma("unroll") for (int k = 0; k < 2; ++k) dst[m][k] = *(const LAS bf16x8*)(lds + PG8_SA(b, h) + aoff + m * 2048 + k * 1024); } \
        else { const v4i_t lo_ = *(const LAS v4i_t*)(lds + PG8_SA(b, h) + aoff + m * 2048), hi_ = *(const LAS v4i_t*)(lds + PG8_SA(b, h) + aoff + m * 2048 + 1024); dst##8[m] = __builtin_shufflevector(lo_, hi_, 0, 1, 2, 3, 4, 5, 6, 7); } } } while (0)
#define PG8_LDB(dst, b, h) do { _Pragma("unroll") for (int n = 0; n < 2; ++n) { if constexpr (EB == 2) { _Pragma("unroll") for (int k = 0; k < 2; ++k) dst[n][k] = *(const LAS bf16x8*)(lds + PG8_SB(b, h) + boff + n * 2048 + k * 1024); } \
        else { const v4i_t lo_ = *(const LAS v4i_t*)(lds + PG8_SB(b, h) + boff + n * 2048), hi_ = *(const LAS v4i_t*)(lds + PG8_SB(b, h) + boff + n * 2048 + 1024); dst##8[n] = __builtin_shufflevector(lo_, hi_, 0, 1, 2, 3, 4, 5, 6, 7); } } } while (0)
#define PG8_MMA(ai, bj, At, Bt) do { __builtin_amdgcn_s_setprio(1); _Pragma("unroll") for (int m = 0; m < 4; ++m) _Pragma("unroll") for (int n = 0; n < 2; ++n) { \
        if constexpr (EB == 2) { _Pragma("unroll") for (int k = 0; k < 2; ++k) acc[ai][bj][m][n] = __builtin_amdgcn_mfma_f32_16x16x32_bf16(Bt[n][k], At[m][k], acc[ai][bj][m][n], 0, 0, 0); } \
        else acc[ai][bj][m][n] = __builtin_amdgcn_mfma_scale_f32_16x16x128_f8f6f4(Bt##8[n], At##8[m], acc[ai][bj][m][n], 0, 0, 0, 0x7F7F7F7F, 0, 0x7F7F7F7F); } \
        __builtin_amdgcn_s_setprio(0); } while (0)
#define PG8_WAIT_V(n) asm volatile("s_waitcnt vmcnt(" #n ")" ::: "memory")
#define PG8_WAIT_L(n) asm volatile("s_waitcnt lgkmcnt(" #n ")" ::: "memory")
#define PG8_BAR __builtin_amdgcn_s_barrier()
#define PG8_SCHED __builtin_amdgcn_sched_barrier(0)
    Unit cur, nxt; int ui = 0;
    if (!S.next(0, cur)) return;
    f32x4 acc[2][2][4][2];
#pragma unroll
    for (int a = 0; a < 2; ++a)
#pragma unroll
        for (int b = 0; b < 2; ++b)
#pragma unroll
            for (int m = 0; m < 4; ++m)
#pragma unroll
                for (int n = 0; n < 2; ++n) acc[a][b][m][n] = (f32x4){0.f, 0.f, 0.f, 0.f};
    bf16x8 At[4][2], B0[2][2], B1[2][2]; v8i_t At8[4], B08[2], B18[2];
    if constexpr (GATHER) {
#pragma unroll
        for (int h = 0; h < 2; ++h)
#pragma unroll
            for (int i = 0; i < 2; ++i) { int R_, C_; stage_rc(tid * 16 + i * 8192, R_, C_); vA[h][i] = (unsigned)S.row(cur, h * HALFT + R_) * (unsigned)(lda * 2) + (unsigned)C_ * 2u; vAn[h][i] = vA[h][i]; }
        PG8_WAIT_V(0);
    }
    const char* cA = cur.A; const char* cB = cur.B;
    PG8_STAGE(PG8_SB(0, 0), cB, vB); PG8_STAGE(PG8_SB(0, 1), cB + hB1, vBs); PG8_STAGE(PG8_SA(0, 0), AP::kt(cA, 0, lda), vA[0]); PG8_STAGE(PG8_SA(0, 1), AP::kt(cA, 0, lda) + hA1, vA1);
    if (wr == 1) PG8_BAR;
    PG8_WAIT_V(2); PG8_BAR;
    PG8_STAGE(PG8_SB(1, 0), cB + kstep, vB); PG8_STAGE(PG8_SA(1, 0), AP::kt(cA, 1, lda), vA[0]); PG8_STAGE(PG8_SB(1, 1), cB + hB1 + kstep, vBs);
    PG8_WAIT_V(6); PG8_BAR;
    for (;;) {
        const bool has_next = S.next(ui + 1, nxt);
        const char* nA = has_next ? nxt.A : cA; const char* nB = has_next ? nxt.B : cB;
        if constexpr (GATHER) {
            if (has_next) {
#pragma unroll
                for (int h = 0; h < 2; ++h)
#pragma unroll
                    for (int i = 0; i < 2; ++i) { int R_, C_; stage_rc(tid * 16 + i * 8192, R_, C_); vAn[h][i] = (unsigned)S.row(nxt, h * HALFT + R_) * (unsigned)(lda * 2) + (unsigned)C_ * 2u; }
                PG8_WAIT_V(0);
            }
        }
#pragma unroll 1
        for (int t = 0; t < nt; t += 2) {
            const bool last = (t == nt - 2);
            const char* a1 = AP::kt(cA, t + 1, lda);
            const char* a2 = last ? AP::kt(nA, 0, lda) : AP::kt(cA, t + 2, lda); const char* a3 = last ? AP::kt(nA, 1, lda) : AP::kt(cA, t + 3, lda);
            const char* b2 = last ? nB : cB + (size_t)(t + 2) * kstep; const char* b3 = b2 + kstep;
            PG8_LDB(B0, 0, 0); PG8_LDB(B1, 0, 1); PG8_SCHED; PG8_LDA(At, 0, 0); PG8_STAGE(PG8_SA(1, 1), a1 + hA1, vA1);
            if constexpr (GATHER) { if (last) { _Pragma("unroll") for (int h = 0; h < 2; ++h) _Pragma("unroll") for (int i = 0; i < 2; ++i) vA[h][i] = vAn[h][i]; } }
            PG8_WAIT_V(8); PG8_WAIT_L(0); PG8_BAR; PG8_MMA(0, 0, At, B0); PG8_MMA(0, 1, At, B1); PG8_BAR; PG8_SCHED;
            PG8_LDA(At, 0, 1); PG8_STAGE(PG8_SB(0, 0), b2, vB); PG8_STAGE(PG8_SB(0, 1), b2 + hB1, vBs); PG8_STAGE(PG8_SA(0, 0), a2, vA[0]);
            PG8_WAIT_V(8); PG8_WAIT_L(0); PG8_BAR; PG8_MMA(1, 0, At, B0); PG8_MMA(1, 1, At, B1); PG8_BAR; PG8_SCHED;
            PG8_LDB(B0, 1, 0); PG8_LDB(B1, 1, 1); PG8_SCHED; PG8_LDA(At, 1, 0); PG8_STAGE(PG8_SA(0, 1), a2 + hA1, vA1);
            PG8_WAIT_V(8); PG8_WAIT_L(0); PG8_BAR; PG8_MMA(0, 0, At, B0); PG8_MMA(0, 1, At, B1); PG8_BAR; PG8_SCHED;
            PG8_LDA(At, 1, 1); PG8_STAGE(PG8_SB(1, 0), b3, vB); PG8_STAGE(PG8_SB(1, 1), b3 + hB1, vBs); PG8_STAGE(PG8_SA(1, 0), a3, vA[0]);
            PG8_WAIT_V(8); PG8_WAIT_L(0); PG8_BAR; PG8_MMA(1, 0, At, B0); PG8_MMA(1, 1, At, B1); PG8_BAR; PG8_SCHED;
        }
        if constexpr (ALIGN_EPI) { if (wr == 0) PG8_BAR; }
        { const int l2_ = lane_id();
          E(acc, cur, wr, wc, l2_ & 15, l2_ >> 4);
#ifdef PROBE_EPI2
          if (Epi::PROBE2) { asm volatile("s_waitcnt vmcnt(0)" ::: "memory"); E(acc, cur, wr, wc, l2_ & 15, l2_ >> 4); }
#endif
          }
        if (!has_next) break;
#pragma unroll
        for (int a = 0; a < 2; ++a)
#pragma unroll
            for (int b = 0; b < 2; ++b)
#pragma unroll
                for (int m = 0; m < 4; ++m)
#pragma unroll
                    for (int n = 0; n < 2; ++n) acc[a][b][m][n] = (f32x4){0.f, 0.f, 0.f, 0.f};
        cur = nxt; cA = nA; cB = nB; ++ui;
        if constexpr (GATHER) {
#pragma unroll
            for (int h = 0; h < 2; ++h)
#pragma unroll
                for (int i = 0; i < 2; ++i) vA[h][i] = vAn[h][i];
        }
        if constexpr (ALIGN_EPI) { if (wr == 1) PG8_BAR; }
    }
    PG8_WAIT_V(0);
    if constexpr (!ALIGN_EPI) { if (wr == 0) PG8_BAR; }
    PG8_BAR;
#undef PG8_SA
#undef PG8_SB
#undef PG8_STAGE
#undef PG8_LDA
#undef PG8_LDB
#undef PG8_MMA
#undef PG8_WAIT_V
#undef PG8_WAIT_L
#undef PG8_BAR
#undef PG8_SCHED
}

struct DenseOrder {
    const char* A; const char* B; int nM, nN, G, c; long a_tile, b_tile;
    __device__ __forceinline__ bool next(int i, Unit& u) const { const long L = (long)i * G + c; if (L >= (long)nM * nN) return false; int pm, pn; tile_of((int)L, nM, nN, pm, pn);
        u.pm = pm; u.pn = pn; u.e = 0; u.r0 = pm * BM; u.A = A + (size_t)pm * a_tile; u.B = B + (size_t)pn * b_tile; return true; }
    __device__ __forceinline__ int row(const Unit&, int) const { return 0; }
};
}
namespace pg8 {
typedef const f32x4 (&AccRef)[2][2][4][2];
__device__ __forceinline__ const LAS int* lds_tab() { unsigned a; asm volatile("v_mov_b32 %0, %1" : "=v"(a) : "i"(TAB_OFF)); return (const LAS int*)(size_t)a; }
__device__ __forceinline__ v4u pack8(const f32x4 a, const f32x4 b) { v4u w; w.x = cvt_pk_bf16(a[0], a[1]); w.y = cvt_pk_bf16(a[2], a[3]); w.z = cvt_pk_bf16(b[0], b[1]); w.w = cvt_pk_bf16(b[2], b[3]); return w; }

struct EpiOut {
    static constexpr bool PERM = false; static constexpr bool PROBE2 = false;
    const float* Xin; float* Xout; const float* g;
    __device__ __forceinline__ void operator()(AccRef acc, const Unit& u, int wr, int wc, int fr, int fq) const {
        const int b = u.r0 / S; const int col0 = u.pn * BM + wc * 32 + 4 * fq; f32x4 gv[2][2];
#pragma unroll
        for (int bj = 0; bj < 2; ++bj)
#pragma unroll
            for (int n = 0; n < 2; ++n) gv[bj][n] = *(const f32x4*)(g + (size_t)b * 6 * D + col0 + bj * HALFT + n * 16);
#pragma unroll
        for (int ai = 0; ai < 2; ++ai) { f32x4 xi[4][2][2];
#pragma unroll
            for (int m = 0; m < 4; ++m) { const size_t off = (size_t)(u.r0 + ai * HALFT + wr * 64 + m * 16 + fr) * D + col0;
#pragma unroll
                for (int bj = 0; bj < 2; ++bj)
#pragma unroll
                    for (int n = 0; n < 2; ++n) xi[m][bj][n] = __builtin_nontemporal_load((const f32x4*)(Xin + off + bj * HALFT + n * 16)); }
#pragma unroll
            for (int m = 0; m < 4; ++m) { const size_t off = (size_t)(u.r0 + ai * HALFT + wr * 64 + m * 16 + fr) * D + col0;
#pragma unroll
                for (int bj = 0; bj < 2; ++bj)
#pragma unroll
                    for (int n = 0; n < 2; ++n) *(f32x4*)(Xout + off + bj * HALFT + n * 16) = xi[m][bj][n] + gv[bj][n] * acc[ai][bj][m][n]; }
            asm volatile("" ::: "memory"); }
    }
};
struct EpiG1 {
    static constexpr bool PERM = true; static constexpr bool PROBE2 = false;
    bf16_t* proj; bf16_t* lxp; float* ssq;
    __device__ __forceinline__ void operator()(AccRef acc, const Unit& u, int wr, int wc, int fr, int fq) const {
        const int pn = u.pn; const int c0 = pn * BM + wc * 32 + 8 * fq; const int NT_LAT = (QR + KVR) / BM, NT_X = LW / BM;
#pragma unroll
        for (int ai = 0; ai < 2; ++ai)
#pragma unroll
            for (int m = 0; m < 4; ++m) { const int row = u.r0 + ai * HALFT + wr * 64 + m * 16 + fr; float ss = 0.f;
#pragma unroll
                for (int bj = 0; bj < 2; ++bj) { f32x4 v0 = acc[ai][bj][m][0], v1 = acc[ai][bj][m][1];
                    if (pn < NT_LAT) { ss += (v0[0] * v0[0] + v0[1] * v0[1]) + (v0[2] * v0[2] + v0[3] * v0[3]) + (v1[0] * v1[0] + v1[1] * v1[1]) + (v1[2] * v1[2] + v1[3] * v1[3]); }
                    if (pn >= NT_LAT + NT_X) {
#pragma unroll
                        for (int j = 0; j < 4; ++j) { v0[j] = fast_gelu_tanh(v0[j]); v1[j] = fast_gelu_tanh(v1[j]); } }
                    const v4u w = pack8(v0, v1);
                    *(v4u*)(proj + (size_t)row * P0_N + c0 + bj * HALFT) = w;
                    if (pn >= NT_LAT && pn < NT_LAT + NT_X) { const int b = row / S, t = row % S; *(v4u*)(lxp + ((size_t)b * (S + 4) + 2 + t) * LW + (c0 + bj * HALFT - (QR + KVR))) = w; } }
                if (pn < NT_LAT) { ss += __shfl_xor(ss, 16); ss += __shfl_xor(ss, 32); if (fq == 0) ssq[(size_t)row * 16 + pn * 4 + wc] = ss; } }
    }
};
struct EpiG2 {
    static constexpr bool PERM = true; static constexpr bool PROBE2 = false;
    bf16_t* Q; bf16_t* KC; bf16_t* V; const float* ssq; const float* cosr; const float* sinr; float qs;
    __device__ __forceinline__ void operator()(AccRef acc, const Unit& u, int wr, int wc, int fr, int fq) const {
        const int pn = u.pn; const int NQ_N = H_A * NOPE / BM, NQ = H_A * QK / BM;
#pragma unroll
        for (int ai = 0; ai < 2; ++ai)
#pragma unroll
            for (int m = 0; m < 4; ++m) { const int row = u.r0 + ai * HALFT + wr * 64 + m * 16 + fr;
                if (pn < NQ_N) { const float rs = 1.0f / sqrtf(ssq8(ssq + (size_t)row * 16) * (1.0f / QR) + EPS) * qs;
#pragma unroll
                    for (int bj = 0; bj < 2; ++bj) { const int h = 2 * pn + bj; *(v4u*)(Q + ((size_t)row * H_A + h) * QK + wc * 32 + 8 * fq) = pack8(acc[ai][bj][m][0] * rs, acc[ai][bj][m][1] * rs); } }
                else if (pn < NQ) { const float rs = 1.0f / sqrtf(ssq8(ssq + (size_t)row * 16) * (1.0f / QR) + EPS) * qs; const int h = 4 * (pn - NQ_N) + wc, t = row % S;
                    const f32x4 c0 = *(const f32x4*)(cosr + t * (ROPE / 2) + 8 * fq), c1 = *(const f32x4*)(cosr + t * (ROPE / 2) + 8 * fq + 4), s0 = *(const f32x4*)(sinr + t * (ROPE / 2) + 8 * fq), s1 = *(const f32x4*)(sinr + t * (ROPE / 2) + 8 * fq + 4);
                    const f32x4 x10 = acc[ai][0][m][0] * rs, x11 = acc[ai][0][m][1] * rs, x20 = acc[ai][1][m][0] * rs, x21 = acc[ai][1][m][1] * rs;
                    bf16_t* q = Q + ((size_t)row * H_A + h) * QK + NOPE + 8 * fq;
                    *(v4u*)q = pack8(x10 * c0 - x20 * s0, x11 * c1 - x21 * s1); *(v4u*)(q + ROPE / 2) = pack8(x20 * c0 + x10 * s0, x21 * c1 + x11 * s1); }
                else { const float rs = 1.0f / sqrtf(ssq8(ssq + (size_t)row * 16 + 8) * (1.0f / KVR) + EPS); const int h = pn - NQ;
                    *(v4u*)(KC + ((size_t)row * H_A + h) * QK + wc * 32 + 8 * fq) = pack8(acc[ai][0][m][0] * rs, acc[ai][0][m][1] * rs);
                    *(v4u*)(V + ((size_t)row * H_A + h) * VD + wc * 32 + 8 * fq) = pack8(acc[ai][1][m][0] * rs, acc[ai][1][m][1] * rs); } }
    }
};
struct OrderG2 {
    const char* A; const char* Bq; const char* Bkv; int G, c;
    __device__ __forceinline__ bool next(int i, Unit& u) const { const int nN = (H_A * QK + H_A * (NOPE + VD)) / BM, nM = M / BM; const long L = (long)i * G + c; if (L >= (long)nM * nN) return false; int pm, pn; tile_of((int)L, nM, nN, pm, pn);
        const int NQ = H_A * QK / BM; u.pm = pm; u.pn = pn; u.e = 0; u.r0 = pm * BM; u.A = A + (size_t)pm * BM * P0_N * 2 + (pn < NQ ? 0 : QR * 2);
        u.B = pn < NQ ? Bq + (size_t)pn * BM * QR * 2 : Bkv + (size_t)(pn - NQ) * BM * KVR * 2; return true; }
    __device__ __forceinline__ int row(const Unit&, int) const { return 0; }
};
struct EpiGates {
    static constexpr bool PERM = true; static constexpr bool PROBE2 = false;
    bf16_t* LA; bf16_t* U; const bf16_t* lxp; const float* gb; const float* cl; const float* convw; const float* convb;
    __device__ __forceinline__ void operator()(AccRef acc, const Unit& u, int wr, int wc, int fr, int fq) const {
        const int g = u.pn >> 1, d = u.pn & 1; const int ch0 = g * LBS + wc * 32 + 8 * fq; const int b = u.r0 / S;
        f32x4 ba[2], bx[2], clv[2], cb[2], cw[4][2];
#pragma unroll
        for (int n = 0; n < 2; ++n) { const int ch = ch0 + 4 * n; ba[n] = *(const f32x4*)(gb + (d * 2 + 0) * LW + ch); bx[n] = *(const f32x4*)(gb + (d * 2 + 1) * LW + ch); clv[n] = *(const f32x4*)(cl + d * LW + ch); cb[n] = *(const f32x4*)(convb + ch);
#pragma unroll
            for (int j = 0; j < 4; ++j) cw[j][n] = *(const f32x4*)(convw + j * LW + ch); }
#pragma unroll
        for (int ai = 0; ai < 2; ++ai)
#pragma unroll
            for (int m = 0; m < 4; ++m) { const int row = u.r0 + ai * HALFT + wr * 64 + m * 16 + fr; const int t = row % S; f32x4 la[2], uu[2], xc[2] = {cb[0], cb[1]};
                v4u raw[4];
#pragma unroll
                for (int j = 0; j < 4; ++j) raw[j] = *(const v4u*)(lxp + ((size_t)b * (S + 4) + t + j) * LW + ch0);
#pragma unroll
                for (int j = 0; j < 4; ++j)
#pragma unroll
                    for (int n = 0; n < 2; ++n) { const unsigned r0_ = raw[j][2 * n], r1_ = raw[j][2 * n + 1];
                        xc[n][0] += cw[j][n][0] * __uint_as_float(r0_ << 16); xc[n][1] += cw[j][n][1] * __uint_as_float(r0_ & 0xffff0000u); xc[n][2] += cw[j][n][2] * __uint_as_float(r1_ << 16); xc[n][3] += cw[j][n][3] * __uint_as_float(r1_ & 0xffff0000u); }
#pragma unroll
                for (int n = 0; n < 2; ++n)
#pragma unroll
                    for (int j = 0; j < 4; ++j) { const float l = clv[n][j] * fast_sigm(acc[ai][0][m][n][j] + ba[n][j]); const float x2 = 2.0f * l;
                        const float em = -x2 * (1.0f + 0.5f * x2 * (1.0f + (1.0f / 3.0f) * x2 * (1.0f + 0.25f * x2 * (1.0f + 0.2f * x2))));
                        la[n][j] = l; uu[n][j] = sqrtf(em) * fast_sigm(acc[ai][1][m][n][j] + bx[n][j]) * xc[n][j]; }
                const long o = lru_idx(d, b, t, ch0); *(v4u*)(LA + o) = pack8(la[0], la[1]); *(v4u*)(U + o) = pack8(uu[0], uu[1]); }
    }
};
struct OrderGates {
    const char* lxp; const char* B; int G, c;
    __device__ __forceinline__ bool next(int i, Unit& u) const { const int nN = 2 * (LW / LBS), nM = M / BM; const long L = (long)i * G + c; if (L >= (long)nM * nN) return false; int pm, pn; tile_of((int)L, nM, nN, pm, pn);
        u.pm = pm; u.pn = pn; u.e = 0; u.r0 = pm * BM; const int b = u.r0 / S, t0 = u.r0 % S, g = pn >> 1;
        u.A = lxp + (((size_t)b * (S + 4) + 2 + t0) * LW + g * LBS) * 2; u.B = B + (size_t)pn * BM * (4 * LBS) * 2; return true; }
    __device__ __forceinline__ int row(const Unit&, int) const { return 0; }
};
struct EpiG3 {
    static constexpr bool PERM = true; static constexpr bool PROBE2 = false;
    bf16_t* proj; const float* cost; const float* sint; float sqs;
    __device__ __forceinline__ void operator()(AccRef acc, const Unit& u, int wr, int wc, int fr, int fq) const {
        const int pn = u.pn; const int NH = H_C * DK / BM;
#pragma unroll
        for (int ai = 0; ai < 2; ++ai)
#pragma unroll
            for (int m = 0; m < 4; ++m) { const int row = u.r0 + ai * HALFT + wr * 64 + m * 16 + fr; bf16_t* p = proj + (size_t)row * CD_N + pn * BM + wc * 32 + 8 * fq;
                if (pn < 2 * NH) { const int t = row % S, i0 = wc * 32 + 8 * fq; const float sc = pn < NH ? 1.0f : 1.0f / sqrtf((float)DK);
                    const f32x4 c0 = *(const f32x4*)(cost + t * (DK / 2) + i0) * sc, c1 = *(const f32x4*)(cost + t * (DK / 2) + i0 + 4) * sc, s0 = *(const f32x4*)(sint + t * (DK / 2) + i0) * sc, s1 = *(const f32x4*)(sint + t * (DK / 2) + i0 + 4) * sc;
                    const f32x4 x10 = acc[ai][0][m][0], x11 = acc[ai][0][m][1], x20 = acc[ai][1][m][0], x21 = acc[ai][1][m][1];
                    *(v4u*)p = pack8(x10 * c0 - x20 * s0, x11 * c1 - x21 * s1); *(v4u*)(p + HALFT) = pack8(x20 * c0 + x10 * s0, x21 * c1 + x11 * s1); }
                else {
#pragma unroll
                    for (int bj = 0; bj < 2; ++bj) { f32x4 v0 = acc[ai][bj][m][0], v1 = acc[ai][bj][m][1];
                        if (pn >= 3 * NH && pn < 4 * NH) {
#pragma unroll
                            for (int j = 0; j < 4; ++j) { v0[j] = fast_silu(v0[j]); v1[j] = fast_silu(v1[j]); } }
                        else if (pn >= 4 * NH && pn < 4 * NH + H_D * HDS / BM) { v0 = v0 * sqs; v1 = v1 * sqs; }
                        *(v4u*)(p + bj * HALFT) = pack8(v0, v1); } } }
    }
};
struct OrderMoe {
    const LAS int* offt; const char* A; const char* B; const int* tok; int npn, G, c, gather; long b_exp, b_tile, a_tile;
    __device__ __forceinline__ bool next(int i, Unit& u) const { const long L = (long)i * G + c; const int T = (int)(L / npn); if (T >= offt[E + 1]) return false; const int e = ((const LAS unsigned char*)(offt + 2 * E + 4))[T];
        u.e = e; u.pn = (int)(L % npn); u.pm = T - offt[e]; u.r0 = T * BM; u.A = gather ? A : A + (size_t)T * a_tile; u.B = B + (size_t)e * b_exp + (size_t)u.pn * b_tile; return true; }
    __device__ __forceinline__ int row(const Unit& u, int r) const { const int rank = u.pm * BM + r; if (u.e == E) return rank; const int n = offt[E + 2 + u.e]; return rank < n ? tok[(size_t)u.e * M + rank] : 0; }
};
__device__ __forceinline__ float sat_fp8(float v) { return __builtin_amdgcn_fmed3f(v, -448.0f, 448.0f); }
__device__ __forceinline__ unsigned pack_fp8x4(float a, float b, float c, float d) { int w = __builtin_amdgcn_cvt_pk_fp8_f32(sat_fp8(a), sat_fp8(b), 0, false); return (unsigned)__builtin_amdgcn_cvt_pk_fp8_f32(sat_fp8(c), sat_fp8(d), w, true); }
constexpr float F8_H = 4.0f, F8_GU = 32.0f, F8_ACT = 8.0f, F8_DN = 16.0f, F8_Y = 16.0f;
struct EpiM1F8 {
    static constexpr bool PERM = true; static constexpr bool PROBE2 = false;
    unsigned char* ws;
    __device__ __forceinline__ void operator()(AccRef acc, const Unit& u, int wr, int wc, int fr, int fq) const {
        constexpr float inv = 1.0f / (F8_H * F8_GU); unsigned char* act = ws + WS_ACT;
#pragma unroll
        for (int ai = 0; ai < 2; ++ai)
#pragma unroll
            for (int m = 0; m < 4; ++m) { const int row = u.r0 + ai * HALFT + wr * 64 + m * 16 + fr; f32x4 v[2];
#pragma unroll
                for (int n = 0; n < 2; ++n)
#pragma unroll
                    for (int j = 0; j < 4; ++j) v[n][j] = fast_silu(acc[ai][0][m][n][j] * inv) * (acc[ai][1][m][n][j] * (inv * F8_ACT));
                u32x2 w; w.x = pack_fp8x4(v[0][0], v[0][1], v[0][2], v[0][3]); w.y = pack_fp8x4(v[1][0], v[1][1], v[1][2], v[1][3]);
                *(u32x2*)(act + (size_t)row * FF + u.pn * HALFT + wc * 32 + 8 * fq) = w; }
    }
};
template <int NPN, bool GATH, size_t A_OFF, size_t B_OFF, long B_EXP, long B_TILE, long A_TILE>
struct OrderMoeT {
    const unsigned char* ws; int G, c;
    __device__ __forceinline__ bool next(int i, Unit& u) const { const LAS int* offt = lds_tab();
#ifdef MOE_CONTIG
        if (i >= c) return false; const int L = G + i; const int T = L / NPN;
#else
        const long L = (long)i * G + c; const int T = (int)(L / NPN); if (T >= __builtin_amdgcn_readfirstlane(offt[E + 1])) return false;
#endif
        const int e = __builtin_amdgcn_readfirstlane((int)((const LAS unsigned char*)(offt + 2 * E + 4))[T]);
        u.e = e; u.pn = (int)(L % NPN); u.pm = T - __builtin_amdgcn_readfirstlane(offt[e]); u.r0 = T * BM; u.A = (const char*)ws + A_OFF + (GATH ? 0 : (size_t)T * A_TILE); u.B = (const char*)ws + B_OFF + (size_t)e * B_EXP + (size_t)u.pn * B_TILE; return true; }
    __device__ __forceinline__ int row(const Unit& u, int r) const { const int rank = u.pm * BM + r; if (u.e == E) return rank; const int n = lds_tab()[E + 2 + u.e]; return rank < n ? ((const int*)(ws + WS_TOK))[(size_t)u.e * M + rank] : 0; }
};
struct EpiM2F8 {
    static constexpr bool PERM = true; static constexpr bool PERM16 = true; static constexpr bool PROBE2 = false;
    unsigned char* ws;
    __device__ __forceinline__ void operator()(AccRef acc, const Unit& u, int wr, int wc, int fr, int fq) const {
        constexpr float w = F8_Y / (F8_ACT * F8_DN); unsigned char* Y = ws + WS_Y;
#pragma unroll
        for (int ai = 0; ai < 2; ++ai)
#pragma unroll
            for (int m = 0; m < 4; ++m) { const int rr = ai * HALFT + wr * 64 + m * 16 + fr; v4u o;
#pragma unroll
                for (int bj = 0; bj < 2; ++bj) { const f32x4 a = acc[ai][bj][m][0] * w, b = acc[ai][bj][m][1] * w; o[2 * bj] = pack_fp8x4(a[0], a[1], a[2], a[3]); o[2 * bj + 1] = pack_fp8x4(b[0], b[1], b[2], b[3]); }
                *(v4u*)(Y + (size_t)(u.r0 + rr) * D + u.pn * BM + wc * 64 + 16 * fq) = o; }
    }
};
struct EpiM1 {
    static constexpr bool PERM = true; static constexpr bool PROBE2 = false;
    bf16_t* act;
    __device__ __forceinline__ void operator()(AccRef acc, const Unit& u, int wr, int wc, int fr, int fq) const {
#pragma unroll
        for (int ai = 0; ai < 2; ++ai)
#pragma unroll
            for (int m = 0; m < 4; ++m) { const int row = u.r0 + ai * HALFT + wr * 64 + m * 16 + fr; f32x4 v[2];
#pragma unroll
                for (int n = 0; n < 2; ++n)
#pragma unroll
                    for (int j = 0; j < 4; ++j) v[n][j] = fast_silu(acc[ai][0][m][n][j]) * acc[ai][1][m][n][j];
                *(v4u*)(act + (size_t)row * FF + u.pn * HALFT + wc * 32 + 8 * fq) = pack8(v[0], v[1]); }
    }
};
struct EpiM2 {
    static constexpr bool PERM = true; static constexpr bool PROBE2 = false;
    bf16_t* Y; const float* wt; const LAS int* offt; float osc;
    __device__ __forceinline__ void operator()(AccRef acc, const Unit& u, int wr, int wc, int fr, int fq) const {
        float w8[2][4]; const int nrow = u.e < E ? offt[E + 2 + u.e] : M;
#pragma unroll
        for (int ai = 0; ai < 2; ++ai)
#pragma unroll
            for (int m = 0; m < 4; ++m) { const int rank = u.pm * BM + ai * HALFT + wr * 64 + m * 16 + fr; w8[ai][m] = (u.e < E ? (rank < nrow ? wt[(size_t)u.e * M + rank] : 0.f) : 1.0f) * osc; }
#pragma unroll
        for (int ai = 0; ai < 2; ++ai)
#pragma unroll
            for (int m = 0; m < 4; ++m) { const int rr = ai * HALFT + wr * 64 + m * 16 + fr; const float w = w8[ai][m];
#pragma unroll
                for (int bj = 0; bj < 2; ++bj) *(v4u*)(Y + (size_t)(u.r0 + rr) * D + u.pn * BM + bj * HALFT + wc * 32 + 8 * fq) = pack8(acc[ai][bj][m][0] * w, acc[ai][bj][m][1] * w); }
    }
};
}

struct Frame { LAS unsigned char* lds; Ctx c; int wave, vcu, G;
    __device__ __forceinline__ int lane() const { return lane_id(); }
    __device__ __forceinline__ int tid() const { return wave * 64 + lane_id(); } };

struct CvtDesc { const float* src; unsigned char* dst; const float* sc; int ldw, Kd, f8; float mul; };
__device__ __forceinline__ void cvt_load(const CvtDesc& d, float (&v)[32], int lane) {
    const float* p = d.src + (size_t)(lane >> 3) * d.ldw + 4 * (lane & 7);
#pragma unroll
    for (int i = 0; i < 8; ++i) { const f32x4 t = __builtin_nontemporal_load((const f32x4*)(p + (size_t)(8 * i) * d.ldw));     v[4 * i] = t[0]; v[4 * i + 1] = t[1]; v[4 * i + 2] = t[2]; v[4 * i + 3] = t[3]; }
}
__device__ __forceinline__ void cvt_finish(const CvtDesc& d, float (&v)[32], LAS float* scr, int lane) {
    const int kr = lane >> 3, n4 = 4 * (lane & 7);
#pragma unroll
    for (int i = 0; i < 8; ++i) { const float m = (d.sc ? d.sc[8 * i + kr] : 1.0f) * d.mul;
#pragma unroll
        for (int e = 0; e < 4; ++e) scr[(8 * i + kr) * 33 + n4 + e] = v[4 * i + e] * m; }
    LDS_WAIT(); asm volatile("" ::: "memory");
    const int cc = lane & 7;
#pragma unroll
    for (int j = 0; j < 4; ++j) { const int n = (lane >> 3) + 8 * j; const LAS float* s = scr + (8 * cc) * 33 + n;
        if (d.f8) { u32x2 o; o.x = pg8::pack_fp8x4(s[0 * 33], s[1 * 33], s[2 * 33], s[3 * 33]); o.y = pg8::pack_fp8x4(s[4 * 33], s[5 * 33], s[6 * 33], s[7 * 33]); __builtin_nontemporal_store(o, (u32x2*)(d.dst + (size_t)n * d.Kd + 8 * cc)); }
        else { v4u o; o.x = cvt_pk_bf16(s[0 * 33], s[1 * 33]); o.y = cvt_pk_bf16(s[2 * 33], s[3 * 33]); o.z = cvt_pk_bf16(s[4 * 33], s[5 * 33]); o.w = cvt_pk_bf16(s[6 * 33], s[7 * 33]); __builtin_nontemporal_store(o, (v4u*)(d.dst + (size_t)n * d.Kd + 16 * cc)); } }
    LDS_WAIT(); asm volatile("" ::: "memory");
}
__device__ __forceinline__ CvtDesc mk_desc(const float* src, int ldw, int k0, int ns0, void* dst, int Kd_elems, int nd0, int kd0, const float* sc, int f8 = 0, float mul = 1.0f) {
    CvtDesc d; d.src = src + (size_t)k0 * ldw + ns0; d.ldw = ldw; d.f8 = f8; d.mul = mul; d.sc = sc ? sc + k0 : nullptr; const int eb = f8 ? 1 : 2; d.Kd = Kd_elems * eb;
    d.dst = (unsigned char*)dst + ((size_t)nd0 * Kd_elems + kd0 + k0) * eb; return d; }
constexpr long cnt_items(int K, int N) { return (long)(K / 64) * (N / 32); }
constexpr long IT_INAB = 0, IT_UQ = IT_INAB + cnt_items(D, AB_N), IT_UKV = IT_UQ + cnt_items(QR, H_A * QK), IT_LRU = IT_UKV + cnt_items(KVR, H_A * (NOPE + VD)),
    IT_OUTAB = IT_LRU + (long)2 * (LW / LBS) * 2 * 4 * cnt_items(LBS, LBS), IT_RT = IT_OUTAB + cnt_items(D, D), IT_GU0 = IT_RT + 2 * cnt_items(D, E), IT_DN0 = IT_GU0 + (long)(E + 1) * 2 * cnt_items(D, FF),
    IT_INCD = IT_DN0 + (long)(E + 1) * cnt_items(FF, D), IT_OUTCD = IT_INCD + cnt_items(D, CD_N), IT_GU1 = IT_OUTCD + cnt_items(D, D), IT_DN1 = IT_GU1 + (long)(E + 1) * 2 * cnt_items(D, FF), IT_END = IT_DN1 + (long)(E + 1) * cnt_items(FF, D);
__device__ __forceinline__ CvtDesc p0_desc(const Ctx& c, long it) {
#ifdef MOE_FP8
    constexpr int MF8 = 1; constexpr float MGU = pg8::F8_GU, MDN = pg8::F8_DN;
#else
    constexpr int MF8 = 0; constexpr float MGU = 1.0f, MDN = 1.0f;
#endif
    const int sub = (int)(it & 1);
    if (it < IT_UQ) { const long r = (it - IT_INAB) >> 1; constexpr int NBK = AB_N / 32; const int kb = 2 * (int)(r / NBK) + sub, nb = (int)(r % NBK); const int col = nb * 32; const int drow = col < QR + KVR ? col : (col < QR + KVR + ROPE ? P0_N + col - (QR + KVR) : col - ROPE);
        return mk_desc(c.in[I_WINAB], AB_N, kb * 64, col, WSP(bf16_t, W_INAB), D, drow, 0, nullptr); }
    if (it < IT_UKV) { const long r = (it - IT_UQ) >> 1; constexpr int NBK = H_A * QK / 32; const int kb = 2 * (int)(r / NBK) + sub, db = (int)(r % NBK); const int v = db * 32; int scol;
        if (v < H_A * NOPE) { const int h = v / NOPE, d0 = v % NOPE; scol = h * QK + d0; }
        else { const int v2 = v - H_A * NOPE; const int tq = v2 / 256, half = (v2 % 256) / 128, hq = (v2 % 128) / 32; scol = (4 * tq + hq) * QK + NOPE + (ROPE / 2) * half; }
        return mk_desc(c.in[I_WUQ], H_A * QK, kb * 64, scol, WSP(bf16_t, W_UQ), QR, v, 0, c.in[I_QLN]); }
    if (it < IT_LRU) { const long r = (it - IT_UKV) >> 1; constexpr int NBK = H_A * (NOPE + VD) / 32; const int kb = 2 * (int)(r / NBK) + sub, nb = (int)(r % NBK);
        return mk_desc(c.in[I_WUKV], H_A * (NOPE + VD), kb * 64, nb * 32, WSP(bf16_t, W_UKV), KVR, nb * 32, 0, c.in[I_KVLN]); }
    if (it < IT_OUTAB) { const long r = (it - IT_LRU) >> 1; constexpr int NBK = LBS / 32, PER = (LBS / 128) * NBK; const int q = (int)(r / PER), w = (int)(r % PER); const int tap = q & 3, half = (q >> 2) & 1, tq = q >> 3, g = tq >> 1, d = tq & 1; const int kb = 2 * (w / NBK) + sub, nb = w % NBK;
        const float* src = (half ? c.in[I_LWX] : c.in[I_LWA]) + ((size_t)(d * (LW / LBS) + g) * LBS) * LBS;
        return mk_desc(src, LBS, kb * 64, nb * 32, WSP(bf16_t, W_LRU) + (size_t)tq * 2 * LBS * 4 * LBS, 4 * LBS, half * LBS + nb * 32, tap * LBS, c.in[I_CONVW] + tap * LW + g * LBS); }
    if (it < IT_RT) { const long r = (it - IT_OUTAB) >> 1; constexpr int NBK = D / 32; return mk_desc(c.in[I_WOUTAB], D, (2 * (int)(r / NBK) + sub) * 64, (int)(r % NBK) * 32, WSP(bf16_t, W_OUTAB), D, (int)(r % NBK) * 32, 0, nullptr); }
    if (it < IT_GU0) { const long r = (it - IT_RT) >> 1; constexpr int NBK = E / 32; constexpr long PER = (long)(D / 128) * NBK; const int l = (int)(r / PER); const long w = r % PER;
        return mk_desc(c.in[I_WROUTER] + (size_t)l * D * E, E, (2 * (int)(w / NBK) + sub) * 64, (int)(w % NBK) * 32, WSP(bf16_t, W_RT) + (size_t)l * E * D, D, (int)(w % NBK) * 32, 0, nullptr); }
    if (it < IT_INCD || (it >= IT_GU1)) {
        const int l = it >= IT_GU1 ? 1 : 0; const long base_gu = l ? IT_GU1 : IT_GU0, base_dn = l ? IT_DN1 : IT_DN0;
        if (it < base_dn) { const long r = (it - base_gu) >> 1; constexpr int NBK = FF / 32; constexpr long PER = (long)(D / 128) * NBK; const long q = r / PER, w = r % PER; const int up = (int)(q & 1), e = (int)(q >> 1); const int kb = 2 * (int)(w / NBK) + sub, nb = (int)(w % NBK); const int col = nb * 32;
            const float* src = e < E ? (up ? c.in[I_WUP] : c.in[I_WGATE]) + ((size_t)l * E + e) * D * FF : (up ? c.in[I_WSU] : c.in[I_WSG]) + (size_t)l * D * FF;
            return mk_desc(src, FF, kb * 64, col, c.ws + W_GU + ((size_t)l * (E + 1) + e) * 2 * FF * D * (MF8 ? 1 : 2), D, (col / 128) * 256 + up * 128 + (col % 128), 0, nullptr, MF8, MGU); }
        { const long r = (it - base_dn) >> 1; constexpr int NBK = D / 32; constexpr long PER = (long)(FF / 128) * NBK; const int e = (int)(r / PER); const long w = r % PER;
            const float* src = e < E ? c.in[I_WDOWN] + ((size_t)l * E + e) * FF * D : c.in[I_WSD] + (size_t)l * FF * D;
            return mk_desc(src, D, (2 * (int)(w / NBK) + sub) * 64, (int)(w % NBK) * 32, c.ws + W_DN + ((size_t)l * (E + 1) + e) * D * FF * (MF8 ? 1 : 2), FF, (int)(w % NBK) * 32, 0, nullptr, MF8, MDN); } }
    if (it < IT_OUTCD) { const long r = (it - IT_INCD) >> 1; constexpr int NBK = CD_N / 32; return mk_desc(c.in[I_WINCD], CD_N, (2 * (int)(r / NBK) + sub) * 64, (int)(r % NBK) * 32, WSP(bf16_t, W_INCD), D, (int)(r % NBK) * 32, 0, nullptr); }
    { const long r = (it - IT_OUTCD) >> 1; constexpr int NBK = D / 32; return mk_desc(c.in[I_WOUTCD], D, (2 * (int)(r / NBK) + sub) * 64, (int)(r % NBK) * 32, WSP(bf16_t, W_OUTCD), D, (int)(r % NBK) * 32, 0, nullptr); }
}
__device__ __forceinline__ void conv_items(Frame& F, long lo, long hi, int pidx = -1, int np = 0) {
    if (pidx < 0) { pidx = F.vcu; np = F.G; }
    const Ctx& c = F.c; LAS float* scr = (LAS float*)(F.lds + F.wave * 16384); const int lane = F.lane(); const long step = 2 * (long)np * NWAVES;
    long it = lo + 2 * ((long)pidx * NWAVES + F.wave); float va[32], vb[32];
    if (it < hi) { CvtDesc da = p0_desc(c, it); cvt_load(da, va, lane);
        for (;;) {
            CvtDesc db = p0_desc(c, it + 1); cvt_load(db, vb, lane);
            cvt_finish(da, va, scr, lane);
            const long i2 = it + step; const bool h2 = i2 < hi; if (h2) { da = p0_desc(c, i2); cvt_load(da, va, lane); }
            cvt_finish(db, vb, scr, lane); if (!h2) break;
            it = i2; } }
}
__device__ __forceinline__ void conv_slice(Frame& F, long lo, long hi, int k0, int k1, int n, int pidx = -1, int np = 0) { const long npair = (hi - lo) / 2; conv_items(F, lo + 2 * (npair * k0 / n), lo + 2 * (npair * k1 / n), pidx, np); }
__device__ __forceinline__ void mod_units(Frame& F, int l) {
    const Ctx& c = F.c; LAS float* cact = (LAS float*)F.lds; LAS float* red = (LAS float*)(F.lds + 65536);
    for (int i = F.tid(); i < NB * D; i += NTHR) cact[i] = siluf(c.in[I_C][i]);
    __syncthreads();
    constexpr int UW = 48, NU = 6 * D / UW, KW = D / NWAVES; static_assert(6 * D % UW == 0 && KW % 64 == 0 && NB * UW <= NTHR, "mod units");
    for (int u = F.vcu; u < NU; u += F.G) { const int col0 = u * UW; const int rg = F.lane() >> 4, cl = (F.lane() & 15) < 12 ? (F.lane() & 15) : 11;
        const float* w = c.in[I_WMOD] + (size_t)l * D * 6 * D + col0 + 4 * cl; f32x4 a[NB];
#pragma unroll
        for (int b = 0; b < NB; ++b) a[b] = f32x4{0.f, 0.f, 0.f, 0.f};
        const int kbeg = F.wave * KW + rg;
#pragma unroll 1
        for (int i0 = 0; i0 < KW / 4; i0 += 16) { f32x4 wv[16];
#pragma unroll
            for (int j = 0; j < 16; ++j) wv[j] = __builtin_nontemporal_load((const f32x4*)(w + (size_t)(kbeg + 4 * (i0 + j)) * 6 * D));
#pragma unroll
            for (int j = 0; j < 16; ++j) { const int k = kbeg + 4 * (i0 + j);
#pragma unroll
                for (int b = 0; b < NB; ++b) a[b] += wv[j] * cact[b * D + k]; } }
#pragma unroll
        for (int b = 0; b < NB; ++b)
#pragma unroll
            for (int q = 0; q < 4; ++q) { float s = a[b][q]; s += __shfl_xor(s, 16); s += __shfl_xor(s, 32); a[b][q] = s; }
        if (F.lane() < 12) {
#pragma unroll
            for (int b = 0; b < NB; ++b) *(LAS f32x4*)(red + (F.wave * NB + b) * UW + 4 * F.lane()) = a[b]; }
        __syncthreads();
        if (F.tid() < NB * UW) { const int b = F.tid() / UW, cc = F.tid() % UW; float s = c.in[I_BMOD][l * 6 * D + col0 + cc];
#pragma unroll
            for (int w8 = 0; w8 < NWAVES; ++w8) s += red[(w8 * NB + b) * UW + cc];
            WSP(float, WS_MOD)[((size_t)l * NB + b) * 6 * D + col0 + cc] = s; }
        __syncthreads();
    }
    __syncthreads();
}

__device__ __forceinline__ void p0_phase(Frame& F) {
    const Ctx& c = F.c;
    mod_units(F, 0);
#ifndef SPREAD_CONV
    mod_units(F, 1);
#endif
    const long gt = (long)F.vcu * NTHR + F.tid(), NGT = (long)F.G * NTHR;
    for (long i = gt; i < (long)S * (ROPE / 2 + DK / 2); i += NGT) { TabF f; f.c = c; f(i); }
    static_assert(LBS % 64 == 0 && LBS % NWAVES == 0, "gate bias units");
    for (int u = F.vcu; u < 4 * LW / 64; u += F.G) { const int i = u * 64 + F.lane(); const int ch = i % LW, half = (i / LW) & 1, d = i / (2 * LW); const int g = ch / LBS, j = ch % LBS;
        LAS float* red = (LAS float*)(F.lds + 65536);
        const float* wm = (half ? c.in[I_LWX] : c.in[I_LWA]) + ((size_t)(d * (LW / LBS) + g) * LBS) * LBS + j; float s = 0.f;
#pragma unroll
        for (int kk = 0; kk < LBS / NWAVES; ++kk) { const int k = F.wave * (LBS / NWAVES) + kk; s += c.in[I_CONVB][g * LBS + k] * wm[(size_t)k * LBS]; }
        red[F.wave * 64 + F.lane()] = s; __syncthreads();
        if (F.wave == 0) { float t = (half ? c.in[I_LBX] : c.in[I_LBA])[d * LW + ch];
#pragma unroll
            for (int w8 = 0; w8 < NWAVES; ++w8) t += red[w8 * 64 + F.lane()];
            WSP(float, W_GB)[i] = t; }
        __syncthreads(); }
    for (long i = gt; i < 2 * LW; i += NGT) WSP(float, W_GB)[4 * LW + i] = -8.0f * log1pf(expf(-c.in[I_LLAM][i]));
    for (long i = gt; i < (long)NB * 4 * LW; i += NGT) { const int b = (int)(i / (4 * LW)), rr = (int)((i / LW) % 4), ch = (int)(i % LW); WSP(bf16_t, WS_LXP)[((size_t)b * (S + 4) + (rr < 2 ? rr : S + rr)) * LW + ch] = 0; }
    __syncthreads();
#ifdef SPREAD_CONV
    conv_items(F, IT_INAB, IT_OUTAB);
#else
    conv_items(F, IT_INAB, IT_END);
#endif
}
__device__ __forceinline__ void build_offt(Frame& F, int l) {
    LAS int* offt = (LAS int*)(F.lds + TAB_OFF); static_assert(E <= 64, "one lane per routed expert");
    if (F.wave == 0) { const int lane = F.lane(); LAS unsigned char* texp = (LAS unsigned char*)(offt + 2 * E + 4);
        const int n = lane < E ? __hip_atomic_load((const int*)(F.c.ws + CTL_CNT) + cnt_idx(l, lane), RLX_AGENT) : 0; const int nt = (n + RT - 1) / RT; int inc = nt;
#pragma unroll
        for (int o = 1; o < 64; o <<= 1) { const int v = __shfl_up(inc, o); if (lane >= o) inc += v; }
        const int off = inc - nt, tot = __shfl(inc, 63); constexpr int NTS = (M + RT - 1) / RT;
        if (lane < E) { offt[lane] = off; offt[E + 2 + lane] = n; for (int t = 0; t < nt; ++t) texp[off + t] = (unsigned char)lane; }
        if (lane == 0) { offt[E] = tot; offt[E + 1] = tot + NTS; }
        for (int t = lane; t < NTS; t += 64) texp[tot + t] = (unsigned char)E; }
    __syncthreads();
}

__device__ __forceinline__ void modulate_row(const float* xrow, const float* gain, const float* sc, const float* sh, bf16_t* orow, int lane, unsigned char* orow8 = nullptr) {
    f32x4 v[D / 256]; float s = 0.f;
#pragma unroll
    for (int j = 0; j < D / 256; ++j) { v[j] = *((const f32x4*)xrow + lane + 64 * j); s += (v[j][0] * v[j][0] + v[j][1] * v[j][1]) + (v[j][2] * v[j][2] + v[j][3] * v[j][3]); }
    const float r = 1.0f / sqrtf(wave_sum(s) * (1.0f / D) + EPS);
#pragma unroll
    for (int j = 0; j < D / 256; ++j) { const int col = 4 * lane + 256 * j; const f32x4 g = *(const f32x4*)(gain + col), a = *(const f32x4*)(sc + col), b = *(const f32x4*)(sh + col);
        const f32x4 o = v[j] * r * g * (1.0f + a) + b; u32x2 w; w.x = cvt_pk_bf16(o[0], o[1]); w.y = cvt_pk_bf16(o[2], o[3]); *(u32x2*)(orow + col) = w;
        if (orow8) *(unsigned*)(orow8 + col) = pg8::pack_fp8x4(o[0] * pg8::F8_H, o[1] * pg8::F8_H, o[2] * pg8::F8_H, o[3] * pg8::F8_H); }
}
template <int NR> __device__ __forceinline__ void modulate_rows(const float* X, int m0, const float* gain, const float* sc, const float* sh, bf16_t* HM, unsigned char* HM8, int lane) {
    f32x4 v[NR][D / 256]; float s[NR];
#pragma unroll
    for (int r = 0; r < NR; ++r) { s[r] = 0.f;
#pragma unroll
        for (int j = 0; j < D / 256; ++j) v[r][j] = __builtin_nontemporal_load((const f32x4*)(X + (size_t)(m0 + r) * D) + lane + 64 * j); }
#pragma unroll
    for (int r = 0; r < NR; ++r)
#pragma unroll
        for (int j = 0; j < D / 256; ++j) s[r] += (v[r][j][0] * v[r][j][0] + v[r][j][1] * v[r][j][1]) + (v[r][j][2] * v[r][j][2] + v[r][j][3] * v[r][j][3]);
#pragma unroll
    for (int o = 1; o < 64; o <<= 1)
#pragma unroll
        for (int r = 0; r < NR; ++r) s[r] += __shfl_xor(s[r], o);
#pragma unroll
    for (int j = 0; j < D / 256; ++j) { const int col = 4 * lane + 256 * j; const f32x4 g = *(const f32x4*)(gain + col), a = *(const f32x4*)(sc + col), b = *(const f32x4*)(sh + col);
#pragma unroll
        for (int r = 0; r < NR; ++r) { const float rs = 1.0f / sqrtf(s[r] * (1.0f / D) + EPS); const f32x4 o = v[r][j] * rs * g * (1.0f + a) + b; u32x2 w; w.x = cvt_pk_bf16(o[0], o[1]); w.y = cvt_pk_bf16(o[2], o[3]);
            *(u32x2*)(HM + (size_t)(m0 + r) * D + col) = w;
            if (HM8) *(unsigned*)(HM8 + (size_t)(m0 + r) * D + col) = pg8::pack_fp8x4(o[0] * pg8::F8_H, o[1] * pg8::F8_H, o[2] * pg8::F8_H, o[3] * pg8::F8_H); } }
}
__device__ __forceinline__ void modulate_phase(Frame& F, const float* X, const float* gain, const float* sc, const float* sh) {
    const int gw = F.vcu * NWAVES + F.wave, NGW = F.G * NWAVES;
    for (int m0 = 4 * gw; m0 < M; m0 += 4 * NGW) { const int b = m0 / S;
        modulate_rows<4>(X, m0, gain, sc + (size_t)b * 6 * D, sh + (size_t)b * 6 * D, (bf16_t*)(F.c.ws + WS_HM), nullptr, F.lane()); }
}
__device__ __forceinline__ void skinny32x64(Frame& F, const bf16_t* A, const bf16_t* Bt) {
    const int r = F.lane() & 31, h = F.lane() >> 5; constexpr int KW = D / NWAVES; const int k0 = F.wave * KW;
    f32x16 acc0 = {}, acc1 = {};
    const bf16_t* ap = A + (size_t)r * D + k0 + 8 * h; const bf16_t* b0p = Bt + (size_t)r * D + k0 + 8 * h; const bf16_t* b1p = Bt + (size_t)(32 + r) * D + k0 + 8 * h;
#pragma unroll 8
    for (int s = 0; s < KW / 16; ++s) { const bf16x8 a = *(const bf16x8*)(ap + 16 * s), b0 = *(const bf16x8*)(b0p + 16 * s), b1 = *(const bf16x8*)(b1p + 16 * s);
        acc0 = __builtin_amdgcn_mfma_f32_32x32x16_bf16(a, b0, acc0, 0, 0, 0); acc1 = __builtin_amdgcn_mfma_f32_32x32x16_bf16(a, b1, acc1, 0, 0, 0); }
    LAS float* red = (LAS float*)F.lds;
#pragma unroll
    for (int q = 0; q < 16; ++q) { const int row = (q & 3) + 8 * (q >> 2) + 4 * h; red[(F.wave * 32 + row) * 64 + r] = acc0[q]; red[(F.wave * 32 + row) * 64 + 32 + r] = acc1[q]; }
    __syncthreads();
    LAS float* res = (LAS float*)(F.lds + 65536);
    { const int row = F.tid() >> 4, c4 = (F.tid() & 15) * 4; f32x4 s = *(const LAS f32x4*)(red + row * 64 + c4);
#pragma unroll
      for (int w = 1; w < NWAVES; ++w) s += *(const LAS f32x4*)(red + (w * 32 + row) * 64 + c4);
      *(LAS f32x4*)(res + row * 64 + c4) = s; }
    __syncthreads();
}
__device__ __forceinline__ void krope_units(Frame& F) {
    const Ctx& c = F.c;
    for (int u = F.vcu; u < M / 32; u += F.G) { const int row0 = u * 32;
        skinny32x64(F, WSP(bf16_t, WS_HM) + (size_t)row0 * D, WSP(bf16_t, W_INAB) + (size_t)P0_N * D);
        const LAS float* res = (const LAS float*)(F.lds + 65536);
        { const int row = F.tid() >> 4, i0 = (F.tid() & 15) * 2; const int m = row0 + row, t = m % S; float o1[2], o2[2];
#pragma unroll
          for (int q = 0; q < 2; ++q) { const int ii = i0 + q; const float x1 = res[row * 64 + ii], x2 = res[row * 64 + 32 + ii], cs = WSP(float, WS_TAB + TAB_CR)[t * (ROPE / 2) + ii], sn = WSP(float, WS_TAB + TAB_SR)[t * (ROPE / 2) + ii];
              o1[q] = x1 * cs - x2 * sn; o2[q] = x2 * cs + x1 * sn; }
          const unsigned w1 = cvt_pk_bf16(o1[0], o1[1]), w2 = cvt_pk_bf16(o2[0], o2[1]);
#pragma unroll
          for (int hh = 0; hh < H_A; ++hh) { bf16_t* K = WSP(bf16_t, WS_KC) + ((size_t)m * H_A + hh) * QK + NOPE; *(unsigned*)(K + i0) = w1; *(unsigned*)(K + ROPE / 2 + i0) = w2; } }
        __syncthreads();
    }
}
__device__ __forceinline__ float wave_max(float v) {
#pragma unroll
    for (int o = 1; o < 64; o <<= 1) v = fmaxf(v, __shfl_xor(v, o));
    return v; }
__device__ __forceinline__ void route_phase(Frame& F, int l) {
    const Ctx& c = F.c; const float* mod = WSP(float, WS_MOD) + (size_t)l * NB * 6 * D; const float* X1 = WSP(float, WS_X1);
    for (int u = F.vcu; u < M / 32; u += F.G) { const int row0 = u * 32;
        { const int m0 = row0 + F.wave * 4; const int b = m0 / S;
          modulate_rows<4>(X1, m0, c.in[I_NFFN] + l * D, mod + (size_t)b * 6 * D + 4 * D, mod + (size_t)b * 6 * D + 3 * D, WSP(bf16_t, WS_HM), WSP(unsigned char, WS_HM8), F.lane()); }
        __syncthreads();
        skinny32x64(F, WSP(bf16_t, WS_HM) + (size_t)row0 * D, WSP(bf16_t, W_RT) + (size_t)l * E * D);
        const LAS float* res = (const LAS float*)(F.lds + 65536);
        int* cnt = WSP(int, CTL_CNT); LAS int* lcnt = (LAS int*)(F.lds + 65536 + 8192);
        if (F.tid() < E) lcnt[F.tid()] = 0;
        __syncthreads();
        int pe[4], pr[4]; float pw[4];
        { const int lane = F.lane(), grp = lane >> 3; float sg[4], bz[4], gs[4]; unsigned gsel[4]; const float rb = c.in[I_RBIAS][l * E + lane];
#pragma unroll
          for (int q = 0; q < 4; ++q) { const int row = F.wave * 4 + q; sg[q] = 1.0f / (1.0f + expf(-res[row * 64 + lane])); bz[q] = sg[q] + rb; }
          { float m1[4], m2[4];
#pragma unroll
            for (int q = 0; q < 4; ++q) m1[q] = bz[q];
#pragma unroll
            for (int o = 1; o < 8; o <<= 1)
#pragma unroll
                for (int q = 0; q < 4; ++q) m1[q] = fmaxf(m1[q], __shfl_xor(m1[q], o));
#pragma unroll
            for (int q = 0; q < 4; ++q) { const unsigned long long eq1 = __ballot(bz[q] == m1[q]); const int first = __builtin_ctz((unsigned)((eq1 >> (grp * 8)) & 0xffull)); m2[q] = ((lane & 7) == first) ? -INFINITY : bz[q]; }
#pragma unroll
            for (int o = 1; o < 8; o <<= 1)
#pragma unroll
                for (int q = 0; q < 4; ++q) m2[q] = fmaxf(m2[q], __shfl_xor(m2[q], o));
#pragma unroll
            for (int q = 0; q < 4; ++q) { gs[q] = m1[q] + m2[q]; gsel[q] = 0u; } }
#pragma unroll 1
          for (int it = 0; it < TG; ++it) { float cand[4], mx[4];
#pragma unroll
              for (int q = 0; q < 4; ++q) { cand[q] = ((gsel[q] >> grp) & 1u) ? -INFINITY : gs[q]; mx[q] = cand[q]; }
#pragma unroll
              for (int o = 1; o < 64; o <<= 1)
#pragma unroll
                  for (int q = 0; q < 4; ++q) mx[q] = fmaxf(mx[q], __shfl_xor(mx[q], o));
#pragma unroll
              for (int q = 0; q < 4; ++q) { const unsigned long long eq = __ballot(cand[q] == mx[q]); gsel[q] |= 1u << (__builtin_ctzll(eq) >> 3); } }
          unsigned long long taken[4]; float wsum[4], my_s[4]; int my_e[4];
#pragma unroll
          for (int q = 0; q < 4; ++q) { taken[q] = 0ull; wsum[q] = 0.f; my_s[q] = 0.f; my_e[q] = 0; }
#pragma unroll 1
          for (int k = 0; k < TOPK; ++k) { float cand[4], mx[4];
#pragma unroll
              for (int q = 0; q < 4; ++q) { cand[q] = (((gsel[q] >> grp) & 1u) && !((taken[q] >> lane) & 1ull)) ? bz[q] : -INFINITY; mx[q] = cand[q]; }
#pragma unroll
              for (int o = 1; o < 64; o <<= 1)
#pragma unroll
                  for (int q = 0; q < 4; ++q) mx[q] = fmaxf(mx[q], __shfl_xor(mx[q], o));
#pragma unroll
              for (int q = 0; q < 4; ++q) { const unsigned long long eq = __ballot(cand[q] == mx[q]); const int ek = __builtin_ctzll(eq); taken[q] |= 1ull << ek; const float sk = __shfl(sg[q], ek); wsum[q] += sk; if (lane == k) { my_e[q] = ek; my_s[q] = sk; } } }
#pragma unroll
          for (int q = 0; q < 4; ++q) { pe[q] = my_e[q]; pw[q] = my_s[q] / wsum[q] * 2.5f; pr[q] = 0;
              if (lane < TOPK) pr[q] = __hip_atomic_fetch_add(lcnt + my_e[q], 1, __ATOMIC_RELAXED, __HIP_MEMORY_SCOPE_WORKGROUP); } }
        __syncthreads();
        if (F.tid() < E) { const int n = lcnt[F.tid()]; lcnt[E + F.tid()] = n > 0 ? atomicAdd(cnt + cnt_idx(l, F.tid()), n) : 0; }
        __syncthreads();
#pragma unroll
        for (int q = 0; q < 4; ++q) { const int m = row0 + F.wave * 4 + q; const int lane = F.lane();
            if (lane < TOPK) { const int rank = lcnt[E + pe[q]] + pr[q];
                WSP(int, WS_SELE)[(size_t)m * TOPK + lane] = pe[q]; WSP(int, WS_SELR)[(size_t)m * TOPK + lane] = rank; WSP(float, WS_SELW)[(size_t)m * TOPK + lane] = pw[q];
                WSP(int, WS_TOK)[(size_t)pe[q] * M + rank] = m; WSP(float, WS_WT)[(size_t)pe[q] * M + rank] = pw[q]; } }
        __syncthreads();
    }
}
__device__ __forceinline__ void combine_phase(Frame& F, int l) {
    build_offt(F, l);
    const Ctx& c = F.c; const LAS int* offt = (const LAS int*)(F.lds + TAB_OFF); const float* X1 = WSP(float, WS_X1); float* X2 = WSP(float, WS_X2);
    const float* mod = WSP(float, WS_MOD) + (size_t)l * NB * 6 * D; const float* mod1 = WSP(float, WS_MOD) + (size_t)NB * 6 * D;
    const int gw = F.vcu * NWAVES + F.wave, NGW = F.G * NWAVES; static_assert(D == 2048, "lane l owns columns 16 l .. 16 l + 15 of each 1024-column half");
    for (int m = gw; m < M; m += NGW) { const int b = m / S; const int lane = F.lane();
        int e = 0, r = 0; float wsel = 1.0f; if (lane < TOPK) { e = WSP(int, WS_SELE)[(size_t)m * TOPK + lane]; r = WSP(int, WS_SELR)[(size_t)m * TOPK + lane]; wsel = WSP(float, WS_SELW)[(size_t)m * TOPK + lane]; }
        long rowi = (lane < TOPK) ? (long)offt[e] * RT + r : (long)offt[E] * RT + m;
        f32x4 acc[2][4];
#pragma unroll
        for (int h = 0; h < 2; ++h)
#pragma unroll
            for (int q = 0; q < 4; ++q) acc[h][q] = (f32x4){0.f, 0.f, 0.f, 0.f};
#pragma unroll 3
        for (int k = 0; k <= TOPK; ++k) { const long ri = __shfl(rowi, k); const float wk = __shfl(wsel, k); const unsigned char* yr = WSP(unsigned char, WS_Y) + (size_t)ri * D + 16 * lane;
#pragma unroll
            for (int h = 0; h < 2; ++h) { const v4u raw = __builtin_nontemporal_load((const v4u*)(yr + h * 1024));
#pragma unroll
                for (int q = 0; q < 4; ++q) { const auto lo = __builtin_amdgcn_cvt_pk_f32_fp8((int)raw[q], false), hi = __builtin_amdgcn_cvt_pk_f32_fp8((int)raw[q], true);
                    acc[h][q][0] += wk * lo[0]; acc[h][q][1] += wk * lo[1]; acc[h][q][2] += wk * hi[0]; acc[h][q][3] += wk * hi[1]; } } }
        float s = 0.f;
#pragma unroll
        for (int h = 0; h < 2; ++h)
#pragma unroll
            for (int q = 0; q < 4; ++q) { const int col = h * 1024 + 16 * lane + 4 * q; const f32x4 x = *(const f32x4*)(X1 + (size_t)m * D + col), g = *(const f32x4*)(mod + (size_t)b * 6 * D + 5 * D + col);
                acc[h][q] = x + g * (acc[h][q] * (1.0f / pg8::F8_Y)); s += (acc[h][q][0] * acc[h][q][0] + acc[h][q][1] * acc[h][q][1]) + (acc[h][q][2] * acc[h][q][2] + acc[h][q][3] * acc[h][q][3]);
                if (l == 0) *(f32x4*)(X2 + (size_t)m * D + col) = acc[h][q]; }
        const float rs = 1.0f / sqrtf(wave_sum(s) * (1.0f / D) + EPS);
#pragma unroll
        for (int h = 0; h < 2; ++h) {
            if (l == 0) { v4u w[2];
#pragma unroll
                for (int q = 0; q < 4; ++q) { const int col = h * 1024 + 16 * lane + 4 * q; const f32x4 g = *(const f32x4*)(c.in[I_NMIX] + D + col), a = *(const f32x4*)(mod1 + (size_t)b * 6 * D + D + col), bb = *(const f32x4*)(mod1 + (size_t)b * 6 * D + col);
                    const f32x4 o = acc[h][q] * rs * g * (1.0f + a) + bb; w[q >> 1][2 * (q & 1)] = cvt_pk_bf16(o[0], o[1]); w[q >> 1][2 * (q & 1) + 1] = cvt_pk_bf16(o[2], o[3]); }
                bf16_t* hp = WSP(bf16_t, WS_HM) + (size_t)m * D + h * 1024 + 16 * lane; *(v4u*)hp = w[0]; *(v4u*)(hp + 8) = w[1]; }
            else {
#pragma unroll
                for (int q = 0; q < 4; ++q) { const int col = h * 1024 + 16 * lane + 4 * q; const f32x4 g = *(const f32x4*)(c.in[I_FNORM] + col); *(f32x4*)(c.out + (size_t)m * D + col) = acc[h][q] * rs * g; } } }
    }
}
__device__ __forceinline__ void retnorm_phase(Frame& F) {
    const Ctx& c = F.c; const int gw = F.vcu * NWAVES + F.wave, NGW = F.G * NWAVES; static_assert(DK == 256, "one f32x4 per lane");
    for (int m0 = gw; m0 < M; m0 += 2 * NGW) { f32x4 v[2][H_C], g[H_C]; u32x2 raw[2][H_C]; float s[2][H_C];
#pragma unroll
        for (int h = 0; h < H_C; ++h) g[h] = *(const f32x4*)(c.in[I_RETGN] + h * DK + 4 * F.lane());
#pragma unroll
        for (int r = 0; r < 2; ++r) { const int m = m0 + r * NGW; const bool ok = m < M;
#pragma unroll
            for (int h = 0; h < H_C; ++h) { const int col = h * DK + 4 * F.lane(); v[r][h] = (f32x4){0.f, 0.f, 0.f, 0.f}; raw[r][h] = (u32x2){0u, 0u};
                if (ok) { v[r][h] = *(const f32x4*)(WSP(float, WS_RET) + (size_t)m * HALF + col); raw[r][h] = *(const u32x2*)(WSP(bf16_t, WS_PROJ) + (size_t)m * CD_N + 3 * H_C * DK + col); }
                s[r][h] = (v[r][h][0] * v[r][h][0] + v[r][h][1] * v[r][h][1]) + (v[r][h][2] * v[r][h][2] + v[r][h][3] * v[r][h][3]); } }
#pragma unroll
        for (int o = 1; o < 64; o <<= 1)
#pragma unroll
            for (int r = 0; r < 2; ++r)
#pragma unroll
                for (int h = 0; h < H_C; ++h) s[r][h] += __shfl_xor(s[r][h], o);
#pragma unroll
        for (int r = 0; r < 2; ++r) { const int m = m0 + r * NGW; if (m < M) {
#pragma unroll
            for (int h = 0; h < H_C; ++h) { const int col = h * DK + 4 * F.lane(); const float rs = 1.0f / sqrtf(s[r][h] * (1.0f / DK) + EPS); f32x4 o = v[r][h] * rs * g[h];
                o[0] *= __uint_as_float(raw[r][h].x << 16); o[1] *= __uint_as_float(raw[r][h].x & 0xffff0000u); o[2] *= __uint_as_float(raw[r][h].y << 16); o[3] *= __uint_as_float(raw[r][h].y & 0xffff0000u);
                u32x2 w; w.x = cvt_pk_bf16(o[0], o[1]); w.y = cvt_pk_bf16(o[2], o[3]); *(u32x2*)(WSP(bf16_t, WS_MIX) + (size_t)m * D + col) = w; } } } }
}
__device__ __forceinline__ void scan_phase(Frame& F) {
    const Ctx& c = F.c; constexpr int NCK = 64, CL = S / NCK, BLK = S * 16 + NCK * 16; static_assert(CL == 32 && 4 * BLK + 4 * NCK * 8 * 4 <= MISC_OFF, "scan LDS map");
    LAS unsigned char* lds = F.lds; LAS float* agg = (LAS float*)(lds + 4 * BLK);
#define SIDX(t) ((t) * 16 + ((t) >> 5) * 16)
    for (int u = F.vcu; u < NB * (LW / 8); u += F.G) { const int b = u / (LW / 8), c8 = u % (LW / 8);
        v4u gvp[S / NTHR];
#pragma unroll
        for (int i = 0; i < S / NTHR; ++i) { const int t = F.tid() + NTHR * i; gvp[i] = *(const v4u*)(WSP(bf16_t, WS_PROJ) + ((size_t)b * S + t) * P0_N + QR + KVR + LW + c8 * 8); }
#pragma unroll
        for (int q = 0; q < 4; ++q) { const bf16_t* src = (q & 1 ? WSP(bf16_t, WS_U) : WSP(bf16_t, WS_LA)) + lru_idx(q >> 1, b, 0, c8 * 8);
#pragma unroll
            for (int i = 0; i < S / NTHR; ++i) { const int t = F.tid() + NTHR * i; *(LAS v4u*)(lds + q * BLK + SIDX(t)) = *(const v4u*)(src + (size_t)t * 8); } }
        __syncthreads();
        const int ch = F.tid() & 7, ck = F.tid() >> 3; const LAS bf16_t* laf = (const LAS bf16_t*)(lds) + ch; const LAS bf16_t* uf = (const LAS bf16_t*)(lds + BLK) + ch;
        const LAS bf16_t* lab = (const LAS bf16_t*)(lds + 2 * BLK) + ch; const LAS bf16_t* ub = (const LAS bf16_t*)(lds + 3 * BLK) + ch;
        { float P = 1.f, H = 0.f;
#pragma unroll 8
          for (int i = 0; i < CL; ++i) { const int o = SIDX(ck * CL + i) / 2; const float a = __builtin_amdgcn_exp2f(LOG2E * bf2f(laf[o])); H = a * H + bf2f(uf[o]); P *= a; }
          agg[(0 * NCK + ck) * 8 + ch] = P; agg[(1 * NCK + ck) * 8 + ch] = H; P = 1.f; H = 0.f;
#pragma unroll 8
          for (int i = CL - 1; i >= 0; --i) { const int o = SIDX(ck * CL + i) / 2; const float a = __builtin_amdgcn_exp2f(LOG2E * bf2f(lab[o])); H = a * H + bf2f(ub[o]); P *= a; }
          agg[(2 * NCK + ck) * 8 + ch] = P; agg[(3 * NCK + ck) * 8 + ch] = H; }
        __syncthreads();
        static_assert(NCK == 64 && NWAVES == 8, "one lane per chunk, two (direction, channel) carries per wave");
#pragma unroll
        for (int i = 0; i < 2; ++i) { const int id = F.wave * 2 + i, dir = id >> 3, cc = id & 7; const int lane = F.lane(), k = dir ? NCK - 1 - lane : lane;
            float A = agg[((2 * dir) * NCK + k) * 8 + cc], B = agg[((2 * dir + 1) * NCK + k) * 8 + cc];
#pragma unroll
            for (int o = 1; o < 64; o <<= 1) { const float A2 = __shfl_up(A, o), B2 = __shfl_up(B, o); if (lane >= o) { B = A * B2 + B; A = A * A2; } }
            const float ex = __shfl_up(B, 1); agg[((2 * dir) * NCK + k) * 8 + cc] = lane ? ex : 0.f; }
        __syncthreads();
        { float hf[CL]; float H = agg[(0 * NCK + ck) * 8 + ch];
#pragma unroll
          for (int i = 0; i < CL; ++i) { const int o = SIDX(ck * CL + i) / 2; const float a = __builtin_amdgcn_exp2f(LOG2E * bf2f(laf[o])); H = a * H + bf2f(uf[o]); hf[i] = H; }
          H = agg[(2 * NCK + ck) * 8 + ch]; LAS bf16_t* so = (LAS bf16_t*)(lds + BLK) + ch;
#pragma unroll
          for (int i = CL - 1; i >= 0; --i) { const int o = SIDX(ck * CL + i) / 2; const float a = __builtin_amdgcn_exp2f(LOG2E * bf2f(lab[o])); H = a * H + bf2f(ub[o]); so[o] = f2bf(hf[i] + H); } }
        __syncthreads();
#pragma unroll
        for (int i = 0; i < S / NTHR; ++i) { const int t = F.tid() + NTHR * i; const size_t m = (size_t)b * S + t; const v4u sv = *(const LAS v4u*)(lds + BLK + SIDX(t)); const v4u gv = gvp[i];
            v4u o;
#pragma unroll
            for (int q = 0; q < 4; ++q) { const float a0 = __uint_as_float(sv[q] << 16) * __uint_as_float(gv[q] << 16), a1 = __uint_as_float(sv[q] & 0xffff0000u) * __uint_as_float(gv[q] & 0xffff0000u); o[q] = cvt_pk_bf16(a0, a1); }
            *(v4u*)(WSP(bf16_t, WS_MIX) + m * D + HALF + c8 * 8) = o; }
        __syncthreads();
    }
#undef SIDX
}
namespace attn {
#define ATT_KSWZ(row, colB, RS) ((row) * (RS) + ((colB) ^ (((row) & 7) << 4)))
__device__ __forceinline__ int crow(int r, int hi) { return (r & 3) + 8 * (r >> 2) + 4 * hi; }
__device__ __forceinline__ int v_st(int k, int c) { const int kk = (k & ~0xC) | ((k & 4) << 1) | ((k & 8) >> 1); return ((kk >> 3) * 4 + (c >> 5)) * 512 + ((kk & 7) * 32 + (c & 31)) * 2; }
__device__ __forceinline__ int v_rd_base(int lane) { return ((lane & 3) << 3) | (((lane >> 2) & 3) << 6) | (((lane >> 4) & 1) << 5) | (((lane >> 5) & 1) << 8); }
constexpr int v_rd_off(int d0, int ks, int half) { return d0 * 512 + ks * 4096 + half * 2048; }
template <int OFF> __device__ __forceinline__ s16x4 tr_read(int vb) { s16x4 r; asm volatile("ds_read_b64_tr_b16 %0, %1 offset:%2" : "=&v"(r) : "v"(vb), "i"(OFF) : "memory"); return r; }
template <int D0> __device__ __forceinline__ void pv_one(f32x16& od, int vb, bf16x8 pa0, bf16x8 pa1, bf16x8 pa2, bf16x8 pa3) {
    const s16x4 l0 = tr_read<v_rd_off(D0, 0, 0)>(vb), h0 = tr_read<v_rd_off(D0, 0, 1)>(vb), l1 = tr_read<v_rd_off(D0, 1, 0)>(vb), h1 = tr_read<v_rd_off(D0, 1, 1)>(vb);
    const s16x4 l2 = tr_read<v_rd_off(D0, 2, 0)>(vb), h2 = tr_read<v_rd_off(D0, 2, 1)>(vb), l3 = tr_read<v_rd_off(D0, 3, 0)>(vb), h3 = tr_read<v_rd_off(D0, 3, 1)>(vb);
    asm volatile("s_waitcnt lgkmcnt(0)" ::: "memory"); __builtin_amdgcn_sched_barrier(0);
#define ATT_PK(L, H) (bf16x8){L[0], L[1], L[2], L[3], H[0], H[1], H[2], H[3]}
    od = __builtin_amdgcn_mfma_f32_32x32x16_bf16(pa0, ATT_PK(l0, h0), od, 0, 0, 0);
    od = __builtin_amdgcn_mfma_f32_32x32x16_bf16(pa1, ATT_PK(l1, h1), od, 0, 0, 0);
    od = __builtin_amdgcn_mfma_f32_32x32x16_bf16(pa2, ATT_PK(l2, h2), od, 0, 0, 0);
    od = __builtin_amdgcn_mfma_f32_32x32x16_bf16(pa3, ATT_PK(l3, h3), od, 0, 0, 0);
#undef ATT_PK
}
template <int DQK, int MODE>
__device__ __forceinline__ void attn_unit(LAS unsigned char* lds, const int wave, const bf16_t* Qb, int ldq, const bf16_t* Kh, int ldk, const bf16_t* Vh, int ldv, int key0, int ntiles, int q0,
                                          float pa_, float pb_, bf16_t* Ob, float* Of, int ldo) {
    constexpr int KB = 64 * DQK * 2, VB = 64 * 128 * 2, NKP = DQK / 8, KPT = DQK / 64, RS = DQK * 2;
    constexpr int OFF_V = 2 * KB, OFF_WS = OFF_V + 2 * VB, OFF_LUT = OFF_WS + NWAVES * 64 * 4;
    const int wid = __builtin_amdgcn_readfirstlane(wave), lane = lane_id(), tid = wid * 64 + lane, r32 = lane & 31, hi = lane >> 5;
    LAS unsigned char* Kl = lds; LAS unsigned char* Vl = lds + OFF_V; LAS float* wsf = (LAS float*)(lds + OFF_WS) + wid * 64; const LAS float* lut = (const LAS float*)(lds + OFF_LUT);
    float m_reg = (MODE == 1) ? pa_ : -1e30f, l_reg = (MODE == 1) ? 1.0f : 0.f;
    f32x16 o[4] = {}; bf16x8 qr[DQK / 16];
    { const bf16_t* Qw = Qb + (size_t)(wid * 32 + r32) * ldq + hi * 8;
#pragma unroll
      for (int d0 = 0; d0 < DQK / 16; ++d0) qr[d0] = *(const bf16x8*)(Qw + d0 * 16); }
    constexpr bool REGK = (NTHR % NKP == 0) && ((NTHR / NKP) % 8 == 0);
    int koff[REGK ? 1 : KPT], kdst[REGK ? 1 : KPT];
#pragma unroll
    for (int i = 0; i < (REGK ? 1 : KPT); ++i) { const int p = tid + NTHR * i, key = p / NKP, c8 = p % NKP; koff[i] = key * ldk + c8 * 8; kdst[i] = ATT_KSWZ(key, c8 * 16, RS); }
#define ATT_KOFF(i) (REGK ? koff[0] + (i) * (NTHR / NKP) * ldk : koff[REGK ? 0 : (i)])
#define ATT_KDST(i) (REGK ? kdst[0] + (i) * (NTHR / NKP) * RS : kdst[REGK ? 0 : (i)])
    const int sr = tid >> 4, sc = (tid & 15) * 8, vst0 = v_st(sr, sc), vst1 = vst0 + 8192;
    const int vb0 = (int)(unsigned)(uintptr_t)Vl + v_rd_base(lane);
    bf16x8 ks[KPT], vs0, vs1;
#define ATT_SLOAD(kb) do { _Pragma("unroll") for (int i = 0; i < KPT; ++i) ks[i] = *(const bf16x8*)(Kh + (size_t)(kb) * ldk + ATT_KOFF(i)); \
        vs0 = *(const bf16x8*)(Vh + (size_t)((kb) + sr) * ldv + sc); vs1 = *(const bf16x8*)(Vh + (size_t)((kb) + 32 + sr) * ldv + sc); } while (0)
#define ATT_SWRITE(b) do { _Pragma("unroll") for (int i = 0; i < KPT; ++i) *(LAS bf16x8*)(Kl + (b) * KB + ATT_KDST(i)) = ks[i]; \
        *(LAS bf16x8*)(Vl + (b) * VB + vst0) = vs0; *(LAS bf16x8*)(Vl + (b) * VB + vst1) = vs1; } while (0)
    ATT_SLOAD(key0); ATT_SWRITE(0); __syncthreads();
    for (int j = 0; j < ntiles; ++j) {
        const int cur = j & 1; const int kb = key0 + j * 64;
        if (j + 1 < ntiles) ATT_SLOAD(kb + 64);
        bool live = true;
        if constexpr (MODE == 1) { const int qlo = q0 + wid * 32; live = (kb + 63 >= qlo - WIN) && (kb <= qlo + 31 + WIN); }
        if (live) {
        f32x16 p0 = {}, p1 = {};
        { const LAS unsigned char* Ks = Kl + cur * KB;
#pragma unroll
          for (int d0 = 0; d0 < DQK / 16; ++d0) { const int cb = (d0 * 16 + hi * 8) * 2;
              const bf16x8 b0 = *(const LAS bf16x8*)(Ks + ATT_KSWZ(r32, cb, RS)), b1 = *(const LAS bf16x8*)(Ks + ATT_KSWZ(32 + r32, cb, RS));
              p0 = __builtin_amdgcn_mfma_f32_32x32x16_bf16(b0, qr[d0], p0, 0, 0, 0); p1 = __builtin_amdgcn_mfma_f32_32x32x16_bf16(b1, qr[d0], p1, 0, 0, 0); } }
        if constexpr (MODE == 2) {
            const int dq = kb - (q0 + wid * 32 + r32);
#pragma unroll
            for (int r = 0; r < 16; ++r) { const int rel0 = dq + crow(r, hi), rel1 = rel0 + 32;
                p0[r] *= __builtin_amdgcn_exp2f((rel0 <= 0 ? pa_ : pb_) * (float)rel0); p1[r] *= __builtin_amdgcn_exp2f((rel1 <= 0 ? pa_ : pb_) * (float)rel1); }
        } else {
            if constexpr (MODE == 1) { const LAS float* lp = lut + (kb - (q0 + wid * 32 + r32) + 383);
#pragma unroll
                for (int r = 0; r < 16; ++r) { p0[r] += lp[crow(r, hi)]; p1[r] += lp[32 + crow(r, hi)]; } }
            float pmax = p0[0];
#pragma unroll
            for (int r = 1; r < 16; ++r) pmax = fmaxf(pmax, p0[r]);
#pragma unroll
            for (int r = 0; r < 16; ++r) pmax = fmaxf(pmax, p1[r]);
            { auto rr = __builtin_amdgcn_permlane32_swap(__float_as_uint(pmax), __float_as_uint(pmax), false, false); pmax = fmaxf(__uint_as_float(rr[0]), __uint_as_float(rr[1])); }
            float mn, alpha;
            if (__builtin_expect(__all(pmax - m_reg <= 11.5f), 1)) { mn = m_reg; alpha = 1.f; }
            else { mn = fmaxf(m_reg, pmax); alpha = __builtin_amdgcn_exp2f(m_reg - mn); m_reg = mn; }
#pragma unroll
            for (int r = 0; r < 16; ++r) { p0[r] = __builtin_amdgcn_exp2f(p0[r] - mn); p1[r] = __builtin_amdgcn_exp2f(p1[r] - mn); }
            float ps = 0.f;
#pragma unroll
            for (int r = 0; r < 16; ++r) ps += p0[r];
#pragma unroll
            for (int r = 0; r < 16; ++r) ps += p1[r];
            { auto rr = __builtin_amdgcn_permlane32_swap(__float_as_uint(ps), __float_as_uint(ps), false, false); ps = __uint_as_float(rr[0]) + __uint_as_float(rr[1]); }
            l_reg = l_reg * alpha + ps;
            if (__any(alpha < 1.f)) { if (hi == 0) wsf[32 + r32] = alpha; asm volatile("s_waitcnt lgkmcnt(0)" ::: "memory");
#pragma unroll
                for (int r = 0; r < 16; ++r) { const float a = wsf[32 + crow(r, hi)];
#pragma unroll
                    for (int d = 0; d < 4; ++d) o[d][r] *= a; } }
        }
        bf16x8 pa0, pa1, pa2, pa3;
#define ATT_PK4(P, BASE, OUT) do { unsigned a0 = cvt_pk_bf16(P[BASE + 0], P[BASE + 1]), a1 = cvt_pk_bf16(P[BASE + 2], P[BASE + 3]); \
        unsigned b0_ = cvt_pk_bf16(P[BASE + 4], P[BASE + 5]), b1_ = cvt_pk_bf16(P[BASE + 6], P[BASE + 7]); \
        auto r0 = __builtin_amdgcn_permlane32_swap(a0, b0_, false, false); auto r1 = __builtin_amdgcn_permlane32_swap(a1, b1_, false, false); \
        v4u w = {r0[0], r1[0], r0[1], r1[1]}; OUT = *reinterpret_cast<bf16x8*>(&w); } while (0)
        ATT_PK4(p0, 0, pa0); ATT_PK4(p0, 8, pa1); ATT_PK4(p1, 0, pa2); ATT_PK4(p1, 8, pa3);
#undef ATT_PK4
        { const int vb = vb0 + cur * VB; pv_one<0>(o[0], vb, pa0, pa1, pa2, pa3); pv_one<1>(o[1], vb, pa0, pa1, pa2, pa3); pv_one<2>(o[2], vb, pa0, pa1, pa2, pa3); pv_one<3>(o[3], vb, pa0, pa1, pa2, pa3); }
        }
        if (j + 1 < ntiles) ATT_SWRITE(cur ^ 1);
        __syncthreads();
    }
#undef ATT_SLOAD
#undef ATT_SWRITE
#undef ATT_KOFF
#undef ATT_KDST
    if constexpr (MODE == 2) {
#pragma unroll
        for (int r = 0; r < 16; ++r) { float* orow = Of + (size_t)(wid * 32 + crow(r, hi)) * ldo + r32;
#pragma unroll
            for (int d0 = 0; d0 < 4; ++d0) orow[d0 * 32] = o[d0][r]; }
    } else {
        if (hi == 0) wsf[r32] = l_reg; asm volatile("s_waitcnt lgkmcnt(0)" ::: "memory");
#pragma unroll
        for (int r = 0; r < 16; ++r) { const float rl = __builtin_amdgcn_rcpf(wsf[crow(r, hi)]); bf16_t* orow = Ob + (size_t)(wid * 32 + crow(r, hi)) * ldo + r32;
#pragma unroll
            for (int d0 = 0; d0 < 4; ++d0) orow[d0 * 32] = f2bf(o[d0][r] * rl); }
    }
    __syncthreads();
}
#undef ATT_KSWZ
}

__device__ __forceinline__ void att0_phase(Frame& F) {
    const Ctx& c = F.c;
    for (int u = F.vcu; u < NB * H_A * (S / 256); u += F.G) { const int qb = u % (S / 256), h = (u / (S / 256)) % H_A, b = u / ((S / 256) * H_A);
        attn::attn_unit<QK, 0>(F.lds, F.wave, WSP(bf16_t, WS_Q) + ((size_t)(b * S + qb * 256) * H_A + h) * QK, H_A * QK, WSP(bf16_t, WS_KC) + ((size_t)b * S * H_A + h) * QK, H_A * QK,
                               WSP(bf16_t, WS_V) + ((size_t)b * S * H_A + h) * VD, H_A * VD, 0, S / 64, qb * 256, 0.f, 0.f, WSP(bf16_t, WS_MIX) + (size_t)(b * S + qb * 256) * D + h * VD, nullptr, D); }
}
__device__ __forceinline__ void ret1_phase(Frame& F) {
    const Ctx& c = F.c;
    for (int u = F.vcu; u < NB * H_C * (S / 256) * 2; u += F.G) { const int dvh = u & 1, qb = (u >> 1) % (S / 256), h = (u / (2 * (S / 256))) % H_C, b = u / (2 * (S / 256) * H_C);
        const bf16_t* Pb = WSP(bf16_t, WS_PROJ) + (size_t)b * S * CD_N;
        const float lgf = log2f(1.0f - exp2f(-5.0f - (float)h)), lgb = log2f(1.0f - exp2f(-5.0f - (float)(H_C - 1 - h)));
        const int df = (int)(11.0f / -lgf) + 1, db = (int)(11.0f / -lgb) + 1; int t0 = (qb * 256 - df - 63) / 64; if (t0 < 0) t0 = 0; int t1 = (qb * 256 + 255 + db) / 64 + 1; if (t1 > S / 64) t1 = S / 64;
        attn::attn_unit<DK, 2>(F.lds, F.wave, Pb + (size_t)qb * 256 * CD_N + h * DK, CD_N, Pb + H_C * DK + h * DK, CD_N, Pb + 2 * H_C * DK + h * DK + dvh * 128, CD_N, t0 * 64, t1 - t0, qb * 256, -lgf, lgb,
                               nullptr, WSP(float, WS_RET) + (size_t)(b * S + qb * 256) * HALF + h * DK + dvh * 128, HALF); }
}
__device__ __forceinline__ void swa1_phase(Frame& F) {
    const Ctx& c = F.c; constexpr int OFF_LUT = 2 * 64 * HDS * 2 + 2 * 64 * 128 * 2 + NWAVES * 64 * 4; LAS float* lut = (LAS float*)(F.lds + OFF_LUT);
    for (int u = F.vcu; u < NB * H_D * (S / 256); u += F.G) { const int qb = u % (S / 256), hd = (u / (S / 256)) % H_D, b = u / ((S / 256) * H_D); const int kvh = hd / (H_D / KVH);
        for (int i = F.tid(); i < 767; i += NTHR) { const int rel = i - 383; lut[i] = (rel < -WIN || rel > WIN) ? -1e30f : c.in[I_RELB][t5_bucket(rel) * H_D + hd] * LOG2E; }
        __syncthreads();
        const bf16_t* Pb = WSP(bf16_t, WS_PROJ) + (size_t)b * S * CD_N + 4 * H_C * DK;
        const int klo = qb * 256 - WIN < 0 ? 0 : qb * 256 - WIN, khi = qb * 256 + 256 + WIN > S ? S : qb * 256 + 256 + WIN;
        attn::attn_unit<HDS, 1>(F.lds, F.wave, Pb + (size_t)qb * 256 * CD_N + hd * HDS, CD_N, Pb + H_D * HDS + kvh * HDS, CD_N, Pb + H_D * HDS + KVH * HDS + kvh * HDS, CD_N, klo, (khi - klo) / 64, qb * 256,
                                c.in[I_SINKS][hd] * LOG2E, 0.f, WSP(bf16_t, WS_MIX) + (size_t)(b * S + qb * 256) * D + HALF + hd * HDS, nullptr, D); }
}


#ifndef OPT_MASK
#define OPT_MASK 0
#endif
struct MArgs { Ctx c; long ph_lo, ph_hi, use_bar, pad; };
__global__ void __launch_bounds__(NTHR, 2) mega_fwd(MArgs args) {
    extern __shared__ __attribute__((aligned(16))) unsigned char lds_raw[];
    Frame F; F.lds = (LAS unsigned char*)lds_raw; F.c = args.c;
    F.wave = __builtin_amdgcn_readfirstlane((int)threadIdx.x >> 6);
    F.G = gridDim.x; { const int bx = blockIdx.x; F.vcu = (F.G % 8 == 0) ? (bx % 8) * (F.G / 8) + bx / 8 : bx; }
    const Ctx& c = F.c;
    volatile LAS unsigned* MISC = (volatile LAS unsigned*)(F.lds + MISC_OFF);
    for (int u = F.tid(); u < 256; u += NTHR) MISC[u] = 0u;
    __syncthreads();
    XcdBarrier bar; bar.bar = (unsigned*)(c.ws + 16384); bar.x = 0; bar.st = MISC + 8; bar.wave = F.wave;
    if (args.use_bar) bar = xcd_barrier_post((unsigned*)(c.ws + 16384), MISC + 8, F.wave);
    const int lo = (int)args.ph_lo, hi = (int)args.ph_hi;
#define IN(k) (lo <= (k) && (k) < hi)
#define SEAM(k) do { if (IN(k) && IN((k) + 1)) xcd_barrier(bar); } while (0)
    float* mod = WSP(float, WS_MOD);
#ifdef SPREAD_CONV
#define CONV_EARLY(call) do { if (!(blockIdx.x & 1)) { call; __syncthreads(); } } while (0)
#define CONV_LATE(call)  do { if (blockIdx.x & 1) { __syncthreads(); call; __syncthreads(); } } while (0)
#else
#define CONV_EARLY(call) do { } while (0)
#define CONV_LATE(call)  do { } while (0)
#endif
#define CONV_GU0(k0, k1) conv_slice(F, IT_GU0, IT_DN0, k0, k1, 20)
#define CONV_GU1(k0, k1) conv_slice(F, IT_GU1, IT_DN1, k0, k1, 17)

    if (IN(PH_P0)) { p0_phase(F); } SEAM(PH_P0);
#ifdef HAVE_THIN
    if (IN(PH_MOD0)) { modulate_phase(F, c.in[I_X], c.in[I_NMIX], mod + D, mod); } SEAM(PH_MOD0);
#endif
    if (IN(PH_G1)) {
        pg8::DenseOrder S_; S_.A = (const char*)WSP(bf16_t, WS_HM); S_.B = (const char*)WSP(bf16_t, W_INAB); S_.nM = M / 256; S_.nN = P0_N / 256; S_.G = F.G; S_.c = (int)blockIdx.x; S_.a_tile = (long)256 * D * 2; S_.b_tile = (long)256 * D * 2;
        pg8::EpiG1 E_{WSP(bf16_t, WS_PROJ), WSP(bf16_t, WS_LXP), WSP(float, CTL_SSQ)};
        pg8::gemm_phase<pg8::EpiG1, pg8::DenseOrder, pg8::APlain, false, true>(F.lds, F.wave, (const char*)c.ws, D, D, D, S_, E_);
#ifdef HAVE_SKINNY
        krope_units(F);
#endif
#ifdef SPREAD_CONV
        if ((int)blockIdx.x >= F.G / 2) { __syncthreads(); const int pi = (int)blockIdx.x - F.G / 2, np = F.G - F.G / 2;
            conv_items(F, IT_OUTAB, IT_GU0, pi, np); conv_slice(F, IT_GU0, IT_DN0, 0, 4, 20, pi, np); __syncthreads(); }
#endif
    } SEAM(PH_G1);
    if (IN(PH_G2)) {
        CONV_EARLY(CONV_GU0(4, 8));
        { pg8::OrderG2 S_{(const char*)WSP(bf16_t, WS_PROJ), (const char*)WSP(bf16_t, W_UQ), (const char*)WSP(bf16_t, W_UKV), F.G, (int)blockIdx.x};
          pg8::EpiG2 E_{WSP(bf16_t, WS_Q), WSP(bf16_t, WS_KC), WSP(bf16_t, WS_V), WSP(float, CTL_SSQ), WSP(float, WS_TAB + TAB_CR), WSP(float, WS_TAB + TAB_SR), LOG2E / sqrtf((float)QK)};
          pg8::gemm_phase<pg8::EpiG2, pg8::OrderG2, pg8::APlain, false, true>(F.lds, F.wave, (const char*)c.ws, P0_N, QR, QR, S_, E_); }
        { pg8::OrderGates S_{(const char*)WSP(bf16_t, WS_LXP), (const char*)WSP(bf16_t, W_LRU), F.G, (int)((blockIdx.x + F.G / 2) % F.G)};
          pg8::EpiGates E_{WSP(bf16_t, WS_LA), WSP(bf16_t, WS_U), WSP(bf16_t, WS_LXP), WSP(float, W_GB), WSP(float, W_GB) + 4 * LW, c.in[I_CONVW], c.in[I_CONVB]};
          pg8::gemm_phase<pg8::EpiGates, pg8::OrderGates, pg8::AConv, false, true>(F.lds, F.wave, (const char*)c.ws, LW, 4 * LBS, 4 * LBS, S_, E_); }
        CONV_LATE(CONV_GU0(4, 8));
    } SEAM(PH_G2);
#ifdef HAVE_THIN
    if (IN(PH_SCAN0)) { scan_phase(F); }
#endif
#ifdef HAVE_ATT0
    if (IN(PH_ATT0)) { CONV_EARLY(CONV_GU0(8, 14)); att0_phase(F); CONV_LATE(CONV_GU0(8, 14)); } SEAM(PH_ATT0);
#endif
    if (IN(PH_OUT0)) {
        CONV_EARLY(CONV_GU0(14, 17));
        pg8::DenseOrder S_; S_.A = (const char*)WSP(bf16_t, WS_MIX); S_.B = (const char*)WSP(bf16_t, W_OUTAB); S_.nM = M / 256; S_.nN = D / 256; S_.G = F.G; S_.c = (int)blockIdx.x; S_.a_tile = (long)256 * D * 2; S_.b_tile = (long)256 * D * 2;
        pg8::EpiOut E_{c.in[I_X], WSP(float, WS_X1), mod + 2 * D};
        pg8::gemm_phase<pg8::EpiOut, pg8::DenseOrder, pg8::APlain, false, true>(F.lds, F.wave, (const char*)c.ws, D, D, D, S_, E_);
        CONV_LATE(CONV_GU0(14, 17));
    } SEAM(PH_OUT0);
#ifdef HAVE_RT
    if (IN(PH_RT0)) { CONV_EARLY(CONV_GU0(17, 20)); route_phase(F, 0); CONV_LATE(CONV_GU0(17, 20)); } SEAM(PH_RT0);
#endif
    if (IN(PH_M1_0)) {
#ifdef SPREAD_CONV
        mod_units(F, 1);
#endif
        CONV_EARLY(conv_items(F, IT_DN0, IT_GU1));
        build_offt(F, 0);
#ifdef MOE_FP8
        typedef pg8::OrderMoeT<2 * FF / 256, true, WS_HM8, W_GU + (size_t)0 * (E + 1) * 2 * FF * D, (long)2 * FF * D, (long)256 * D, 0> OM1;
#ifdef MOE_CONTIG
        const int tot1_ = ((const LAS int*)(F.lds + TAB_OFF))[E + 1] * (2 * FF / 256), lo1_ = (int)((long)tot1_ * F.vcu / F.G), hi1_ = (int)((long)tot1_ * (F.vcu + 1) / F.G);
        OM1 S_{c.ws, lo1_, hi1_ - lo1_};
#else
        OM1 S_{c.ws, F.G, F.vcu};
#endif
        pg8::EpiM1F8 E_{c.ws};
        pg8::gemm_phase<pg8::EpiM1F8, OM1, pg8::APlain, true, true, 1>(F.lds, F.wave, (const char*)c.ws, D / 2, D / 2, D / 2, S_, E_);
#else
        pg8::OrderMoe S_{(const LAS int*)(F.lds + TAB_OFF), (const char*)WSP(bf16_t, WS_HM), (const char*)WSP(bf16_t, W_GU), WSP(int, WS_TOK), 2 * FF / 256, F.G, F.vcu, 1, (long)2 * FF * D * 2, (long)256 * D * 2, 0};
        pg8::EpiM1 E_{WSP(bf16_t, WS_ACT)};
        pg8::gemm_phase<pg8::EpiM1, pg8::OrderMoe, pg8::APlain, true, true>(F.lds, F.wave, (const char*)c.ws, D, D, D, S_, E_);
#endif
        CONV_LATE(conv_items(F, IT_DN0, IT_GU1));
    } SEAM(PH_M1_0);
    if (IN(PH_M2_0)) { CONV_EARLY(CONV_GU1(0, 6)); build_offt(F, 0);
#ifdef MOE_FP8
        typedef pg8::OrderMoeT<D / 256, false, WS_ACT, W_DN + (size_t)0 * (E + 1) * D * FF, (long)D * FF, (long)256 * FF, (long)256 * FF> OM2;
#ifdef MOE_CONTIG
        const int tot2_ = ((const LAS int*)(F.lds + TAB_OFF))[E + 1] * (D / 256), lo2_ = (int)((long)tot2_ * F.vcu / F.G), hi2_ = (int)((long)tot2_ * (F.vcu + 1) / F.G);
        OM2 S_{c.ws, lo2_, hi2_ - lo2_};
#else
        OM2 S_{c.ws, F.G, F.vcu};
#endif
        pg8::EpiM2F8 E_{c.ws};
        pg8::gemm_phase<pg8::EpiM2F8, OM2, pg8::APlain, false, true, 1>(F.lds, F.wave, (const char*)c.ws, FF / 2, FF / 2, FF / 2, S_, E_);
#else
        pg8::OrderMoe S_{(const LAS int*)(F.lds + TAB_OFF), (const char*)WSP(bf16_t, WS_ACT), (const char*)WSP(bf16_t, W_DN), WSP(int, WS_TOK), D / 256, F.G, F.vcu, 0, (long)D * FF * 2, (long)256 * FF * 2, (long)256 * FF * 2};
        pg8::EpiM2 E_{WSP(bf16_t, WS_Y), WSP(float, WS_WT), (const LAS int*)(F.lds + TAB_OFF), 1.0f};
        pg8::gemm_phase<pg8::EpiM2, pg8::OrderMoe, pg8::APlain, false, true>(F.lds, F.wave, (const char*)c.ws, FF, FF, FF, S_, E_);
#endif
        CONV_LATE(CONV_GU1(0, 6));
    } SEAM(PH_M2_0);
#ifdef HAVE_THIN
    if (IN(PH_CMB0)) { combine_phase(F, 0); } SEAM(PH_CMB0);
#endif
    if (IN(PH_G3)) {
        pg8::DenseOrder S_; S_.A = (const char*)WSP(bf16_t, WS_HM); S_.B = (const char*)WSP(bf16_t, W_INCD); S_.nM = M / 256; S_.nN = CD_N / 256; S_.G = F.G; S_.c = (int)blockIdx.x; S_.a_tile = (long)256 * D * 2; S_.b_tile = (long)256 * D * 2;
        pg8::EpiG3 E_{WSP(bf16_t, WS_PROJ), WSP(float, WS_TAB + TAB_CT), WSP(float, WS_TAB + TAB_ST), LOG2E / sqrtf((float)HDS)};
        pg8::gemm_phase<pg8::EpiG3, pg8::DenseOrder, pg8::APlain, false, true>(F.lds, F.wave, (const char*)c.ws, D, D, D, S_, E_);
#ifdef SPREAD_CONV
        { const int nu = (M / 256) * (CD_N / 256), rem = nu % F.G;
          if (rem != 0 && (int)blockIdx.x >= rem) { __syncthreads(); conv_slice(F, IT_GU1, IT_DN1, 6, 8, 17, (int)blockIdx.x - rem, F.G - rem); __syncthreads(); }
          else if (rem == 0) { __syncthreads(); CONV_GU1(6, 8); __syncthreads(); } }
#endif
    } SEAM(PH_G3);
#ifdef HAVE_RET1
    if (IN(PH_RET1)) { CONV_EARLY(CONV_GU1(8, 12)); ret1_phase(F); CONV_LATE(CONV_GU1(8, 12)); }
#endif
#ifdef HAVE_SWA1
    if (IN(PH_SWA1)) { CONV_EARLY(CONV_GU1(12, 13)); swa1_phase(F); CONV_LATE(CONV_GU1(12, 13)); } SEAM(PH_SWA1);
#endif
#ifdef HAVE_THIN
    if (IN(PH_RN1)) { retnorm_phase(F); } SEAM(PH_RN1);
#endif
    if (IN(PH_OUT1)) {
        CONV_EARLY(CONV_GU1(13, 15));
        pg8::DenseOrder S_; S_.A = (const char*)WSP(bf16_t, WS_MIX); S_.B = (const char*)WSP(bf16_t, W_OUTCD); S_.nM = M / 256; S_.nN = D / 256; S_.G = F.G; S_.c = (int)blockIdx.x; S_.a_tile = (long)256 * D * 2; S_.b_tile = (long)256 * D * 2;
        pg8::EpiOut E_{WSP(float, WS_X2), WSP(float, WS_X1), mod + (size_t)NB * 6 * D + 2 * D};
        pg8::gemm_phase<pg8::EpiOut, pg8::DenseOrder, pg8::APlain, false, true>(F.lds, F.wave, (const char*)c.ws, D, D, D, S_, E_);
        CONV_LATE(CONV_GU1(13, 15));
    } SEAM(PH_OUT1);
#ifdef HAVE_RT
    if (IN(PH_RT1)) { CONV_EARLY(CONV_GU1(15, 17)); route_phase(F, 1); CONV_LATE(CONV_GU1(15, 17)); } SEAM(PH_RT1);
#endif
    if (IN(PH_M1_1)) { CONV_EARLY(conv_items(F, IT_DN1, IT_END)); build_offt(F, 1);
#ifdef MOE_FP8
        typedef pg8::OrderMoeT<2 * FF / 256, true, WS_HM8, W_GU + (size_t)1 * (E + 1) * 2 * FF * D, (long)2 * FF * D, (long)256 * D, 0> OM1;
#ifdef MOE_CONTIG
        const int tot1_ = ((const LAS int*)(F.lds + TAB_OFF))[E + 1] * (2 * FF / 256), lo1_ = (int)((long)tot1_ * F.vcu / F.G), hi1_ = (int)((long)tot1_ * (F.vcu + 1) / F.G);
        OM1 S_{c.ws, lo1_, hi1_ - lo1_};
#else
        OM1 S_{c.ws, F.G, F.vcu};
#endif
        pg8::EpiM1F8 E_{c.ws};
        pg8::gemm_phase<pg8::EpiM1F8, OM1, pg8::APlain, true, true, 1>(F.lds, F.wave, (const char*)c.ws, D / 2, D / 2, D / 2, S_, E_);
#else
        pg8::OrderMoe S_{(const LAS int*)(F.lds + TAB_OFF), (const char*)WSP(bf16_t, WS_HM), (const char*)(WSP(bf16_t, W_GU) + (size_t)(E + 1) * 2 * FF * D), WSP(int, WS_TOK), 2 * FF / 256, F.G, F.vcu, 1, (long)2 * FF * D * 2, (long)256 * D * 2, 0};
        pg8::EpiM1 E_{WSP(bf16_t, WS_ACT)};
        pg8::gemm_phase<pg8::EpiM1, pg8::OrderMoe, pg8::APlain, true, true>(F.lds, F.wave, (const char*)c.ws, D, D, D, S_, E_);
#endif
        CONV_LATE(conv_items(F, IT_DN1, IT_END));
    } SEAM(PH_M1_1);
    if (IN(PH_M2_1)) { build_offt(F, 1);
#ifdef MOE_FP8
        typedef pg8::OrderMoeT<D / 256, false, WS_ACT, W_DN + (size_t)1 * (E + 1) * D * FF, (long)D * FF, (long)256 * FF, (long)256 * FF> OM2;
#ifdef MOE_CONTIG
        const int tot2_ = ((const LAS int*)(F.lds + TAB_OFF))[E + 1] * (D / 256), lo2_ = (int)((long)tot2_ * F.vcu / F.G), hi2_ = (int)((long)tot2_ * (F.vcu + 1) / F.G);
        OM2 S_{c.ws, lo2_, hi2_ - lo2_};
#else
        OM2 S_{c.ws, F.G, F.vcu};
#endif
        pg8::EpiM2F8 E_{c.ws};
        pg8::gemm_phase<pg8::EpiM2F8, OM2, pg8::APlain, false, true, 1>(F.lds, F.wave, (const char*)c.ws, FF / 2, FF / 2, FF / 2, S_, E_);
#else
        pg8::OrderMoe S_{(const LAS int*)(F.lds + TAB_OFF), (const char*)WSP(bf16_t, WS_ACT), (const char*)(WSP(bf16_t, W_DN) + (size_t)(E + 1) * D * FF), WSP(int, WS_TOK), D / 256, F.G, F.vcu, 0, (long)D * FF * 2, (long)256 * FF * 2, (long)256 * FF * 2};
        pg8::EpiM2 E_{WSP(bf16_t, WS_Y), WSP(float, WS_WT), (const LAS int*)(F.lds + TAB_OFF), 1.0f};
        pg8::gemm_phase<pg8::EpiM2, pg8::OrderMoe, pg8::APlain, false, true>(F.lds, F.wave, (const char*)c.ws, FF, FF, FF, S_, E_);
#endif
    } SEAM(PH_M2_1);
#ifdef HAVE_THIN
    if (IN(PH_CMB1)) { combine_phase(F, 1); }
#endif
#undef IN
#undef SEAM
}

extern "C" void kernel_launch(void* const* d_in, const int* in_sizes, int n_in, void* d_out, int out_size, void* d_ws, size_t ws_size, hipStream_t stream) {
    static int grid = 0;
    if (grid == 0) {
        if (n_in != N_IN || out_size != M * D || ws_size < WS_END) { fprintf(stderr, "kernel_launch: unexpected shapes (n_in %d, out %d, ws %zu < %zu)\n", n_in, out_size, ws_size, (size_t)WS_END); grid = -1; return; }
        int dev = 0, cus = 0;
        if (hipGetDevice(&dev) != hipSuccess || hipDeviceGetAttribute(&cus, hipDeviceAttributeMultiprocessorCount, dev) != hipSuccess) { grid = -1; return; }
        if (hipFuncSetAttribute((const void*)mega_fwd, hipFuncAttributeMaxDynamicSharedMemorySize, LDS_BYTES) != hipSuccess) { fprintf(stderr, "kernel_launch: hipFuncSetAttribute failed\n"); grid = -1; return; }
        int per_cu = 0; (void)hipOccupancyMaxActiveBlocksPerMultiprocessor(&per_cu, (const void*)mega_fwd, NTHR, LDS_BYTES); (void)hipGetLastError();
        if (per_cu < 1) fprintf(stderr, "kernel_launch: occupancy query reports %d\n", per_cu);
        grid = cus;
    }
    if (grid < 0) return;
    Ctx c; memset((void*)&c, 0, sizeof(c));
    for (int i = 0; i < N_IN; ++i) c.in[i] = (const float*)d_in[i];
    c.out = (float*)d_out; c.ws = (unsigned char*)d_ws;
    (void)hipMemsetAsync((char*)d_ws + WS_CTL, 0, CTL_BYTES, stream);
    Launcher go{stream};
    const unsigned mask = (unsigned)(OPT_MASK);
    int n_mega = 0; for (int p = 0; p < N_PHASES; ++p) n_mega += (mask >> p) & 1u;
#ifdef FORCE_SPLIT
    const bool one = false;
#else
    const bool one = (mask == (1u << N_PHASES) - 1u);
#endif
    for (int ph = 0; ph < N_PHASES; ) {
        if ((mask >> ph) & 1u) {
            int hi = ph + 1; if (one) hi = N_PHASES;
            MArgs a; memset((void*)&a, 0, sizeof(a)); a.c = c; a.ph_lo = ph; a.ph_hi = hi; a.use_bar = one ? 1 : 0;
            hipLaunchKernelGGL(mega_fwd, dim3(grid), dim3(NTHR), LDS_BYTES, stream, a);
#ifdef DUP_PHASE
            if (!one && ph == (DUP_PHASE)) hipLaunchKernelGGL(mega_fwd, dim3(grid), dim3(NTHR), LDS_BYTES, stream, a);
#endif
            if (!one && (ph == PH_RT0 || ph == PH_RT1)) naive_offt(go, c, ph == PH_RT1);
            ph = hi;
        } else {
            naive_phase(go, c, ph);
            if (ph == PH_RT0 || ph == PH_RT1) naive_offt(go, c, ph == PH_RT1);
            ++ph;
        }
    }
}


#endif
```
